# Optimizing an MI355X kernel written in HIP

```python
import math
import jax, jax.numpy as jnp
from jax import lax
import numpy as np

D_MODEL = 1024
BATCH = 32
SEQ = 2048
DEPTH = 1

CHUNK = 64
D_SSM = D_MODEL // 2
SSM_GROUP = 16
N_SSM_GROUPS = D_SSM // SSM_GROUP
SSM_STATE = 64
HEAD_DIM = 64
D_ATT = D_MODEL // 2
N_HEADS = D_ATT // HEAD_DIM
Q_BLOCK = 128
D_IN = D_SSM + 3 * D_ATT
N_EXPERT_GROUPS = 4
EXPERTS_PER_GROUP = 8
N_EXPERTS = N_EXPERT_GROUPS * EXPERTS_PER_GROUP
TOP_K = 2
D_EXPERT = D_MODEL // 2
MOE_BLOCK = 128
EPS = 1e-6

kernel_name = "hybrid_s5_stickbreaking_hmoe_block"


def rms_norm(x, g):
    xf = x.astype(jnp.float32)
    y = xf * lax.rsqrt(jnp.mean(xf * xf, axis=-1, keepdims=True) + EPS)
    return (y * g.astype(jnp.float32)).astype(x.dtype)


def s5_mixer(u, lam_re, lam_im, log_dt, b_re, b_im, c_re, c_im, d_skip, w_glu, b_glu):
    bsz, t_len, _ = u.shape
    f32 = jnp.float32
    uf = u.astype(f32).reshape(bsz, t_len, N_SSM_GROUPS, SSM_GROUP)
    dt = jnp.exp(log_dt.astype(f32))[:, None]
    lr, li = lam_re.astype(f32), lam_im.astype(f32)
    mag = jnp.exp(lr * dt)
    abar_r, abar_i = mag * jnp.cos(li * dt), mag * jnp.sin(li * dt)
    den = lr * lr + li * li
    nr, ni = abar_r - 1.0, abar_i
    coef_r = (nr * lr + ni * li) / den
    coef_i = (ni * lr - nr * li) / den
    br, bi = b_re.astype(f32), b_im.astype(f32)
    bbar_r = coef_r[..., None] * br - coef_i[..., None] * bi
    bbar_i = coef_r[..., None] * bi + coef_i[..., None] * br
    bu_r = jnp.einsum('btgh,gph->tbgp', uf, bbar_r)
    bu_i = jnp.einsum('btgh,gph->tbgp', uf, bbar_i)
    a_r = jnp.broadcast_to(abar_r, (t_len, N_SSM_GROUPS, SSM_STATE))
    a_i = jnp.broadcast_to(abar_i, (t_len, N_SSM_GROUPS, SSM_STATE))

    def combine(e1, e2):
        a1r, a1i, b1r, b1i = e1
        a2r, a2i, b2r, b2i = e2
        ar = a1r * a2r - a1i * a2i
        ai = a1r * a2i + a1i * a2r
        a2rb, a2ib = a2r[:, None], a2i[:, None]
        outr = a2rb * b1r - a2ib * b1i + b2r
        outi = a2rb * b1i + a2ib * b1r + b2i
        return (ar, ai, outr, outi)

    _, _, h_r, h_i = lax.associative_scan(combine, (a_r, a_i, bu_r, bu_i), axis=0)
    y = (jnp.einsum('ghp,tbgp->btgh', c_re.astype(f32), h_r)
         - jnp.einsum('ghp,tbgp->btgh', c_im.astype(f32), h_i)
         + d_skip.astype(f32) * uf)
    y = jax.nn.gelu(y.reshape(bsz, t_len, D_SSM))
    y = y * jax.nn.sigmoid(y @ w_glu.astype(f32) + b_glu.astype(f32))
    return y.astype(u.dtype)


def stick_breaking_attention(q, k, v):
    t_len = q.shape[1]
    scale = 1.0 / math.sqrt(HEAD_DIM)
    outs = []
    for i in range(t_len // Q_BLOCK):
        start, end = i * Q_BLOCK, (i + 1) * Q_BLOCK
        qb, kb, vb = q[:, start:end], k[:, :end], v[:, :end]
        z = jnp.einsum('bqhd,bkhd->bhqk', qb, kb).astype(jnp.float32) * scale
        qpos = jnp.arange(start, end)
        kpos = jnp.arange(end)
        causal = kpos[None, :] < qpos[:, None]
        log_1m = jnp.where(causal, jax.nn.log_sigmoid(-z), 0.0)
        after = lax.cumsum(log_1m, axis=3, reverse=True) - log_1m
        att = jnp.where(causal, jnp.exp(jax.nn.log_sigmoid(z) + after), 0.0)
        outs.append(jnp.einsum('bhqk,bkhd->bqhd', att.astype(v.dtype), vb))
    return jnp.concatenate(outs, axis=1)


def hierarchical_moe(h, w_rg, b_rg, w_re, b_re, w_gate, w_up, w_down):
    bsz, t_len, d = h.shape
    n_tok = bsz * t_len
    hf = h.reshape(n_tok, d)
    g_logits = (hf @ w_rg).astype(jnp.float32) + b_rg.astype(jnp.float32)
    g_prob = jax.nn.softmax(g_logits, axis=-1)
    p_grp, grp = lax.top_k(g_prob, 1)
    e_logits = (jnp.einsum('nd,dge->nge', hf, w_re).astype(jnp.float32)
                + b_re.astype(jnp.float32))
    sel = e_logits[jnp.arange(n_tok), grp[:, 0]]
    e_prob = jax.nn.softmax(sel, axis=-1)
    top_p, top_i = lax.top_k(e_prob, TOP_K)
    top_p = top_p / jnp.sum(top_p, axis=-1, keepdims=True)
    gates = p_grp * top_p
    expert_id = grp * EXPERTS_PER_GROUP + top_i

    nk = n_tok * TOP_K
    flat_e = expert_id.reshape(nk).astype(jnp.int32)
    flat_tok = jnp.repeat(jnp.arange(n_tok, dtype=jnp.int32), TOP_K)
    flat_g = gates.reshape(nk)
    order = jnp.argsort(flat_e)
    se, stok, sg = flat_e[order], flat_tok[order], flat_g[order]
    counts = jax.ops.segment_sum(jnp.ones_like(flat_e), flat_e, num_segments=N_EXPERTS)
    starts = jnp.cumsum(counts) - counts
    pcounts = ((counts + MOE_BLOCK - 1) // MOE_BLOCK) * MOE_BLOCK
    pends = jnp.cumsum(pcounts)
    pstarts = pends - pcounts
    dest = pstarts[se] + (jnp.arange(nk, dtype=jnp.int32) - starts[se])
    n_rows = nk + N_EXPERTS * MOE_BLOCK
    n_blk = n_rows // MOE_BLOCK
    buf = jnp.zeros((n_rows, d), h.dtype).at[dest].set(hf[stok])
    blk_e = jnp.clip(jnp.searchsorted(pends, jnp.arange(n_blk, dtype=jnp.int32) * MOE_BLOCK,
                                      side='right'), 0, N_EXPERTS - 1)

    def expert_block(args):
        xb, e = args
        return (jax.nn.silu(xb @ w_gate[e]) * (xb @ w_up[e])) @ w_down[e]

    out = lax.map(expert_block, (buf.reshape(n_blk, MOE_BLOCK, d), blk_e)).reshape(n_rows, d)
    y = jnp.zeros((n_tok, d), h.dtype).at[stok].add(out[dest] * sg[:, None].astype(h.dtype))
    return y.reshape(bsz, t_len, d)


def setup_inputs(seed: int = 0) -> dict:
    key = jax.random.key(seed)
    ks = jax.random.split(key, 32)
    f32 = jnp.float32
    L, G, P, GS = DEPTH, N_SSM_GROUPS, SSM_STATE, SSM_GROUP
    nrm = lambda k, shape, s: jax.random.normal(k, shape, f32) * s
    lam_im0 = jnp.pi * jnp.arange(P, dtype=f32)
    return {
        "x": jax.random.normal(ks[0], (BATCH, SEQ, D_MODEL), f32),
        "g_mix": 1.0 + nrm(ks[1], (L, D_MODEL), 0.02),
        "w_in": nrm(ks[2], (L, D_MODEL, D_IN), D_MODEL ** -0.5),
        "ssm_lambda_re": -0.5 + nrm(ks[3], (L, G, P), 0.01),
        "ssm_lambda_im": lam_im0 + nrm(ks[4], (L, G, P), 0.01),
        "ssm_log_dt": jax.random.uniform(ks[5], (L, G), f32, math.log(1e-3), math.log(1e-1)),
        "ssm_b_re": nrm(ks[6], (L, G, P, GS), (2.0 * GS) ** -0.5),
        "ssm_b_im": nrm(ks[7], (L, G, P, GS), (2.0 * GS) ** -0.5),
        "ssm_c_re": nrm(ks[8], (L, G, GS, P), (2.0 * P) ** -0.5),
        "ssm_c_im": nrm(ks[9], (L, G, GS, P), (2.0 * P) ** -0.5),
        "ssm_d": nrm(ks[10], (L, G, GS), 1.0),
        "ssm_w_glu": nrm(ks[11], (L, D_SSM, D_SSM), D_SSM ** -0.5),
        "ssm_b_glu": nrm(ks[12], (L, D_SSM), 0.01),
        "g_q": 1.0 + nrm(ks[13], (L, HEAD_DIM), 0.02),
        "g_k": 1.0 + nrm(ks[14], (L, HEAD_DIM), 0.02),
        "g_ssm_out": 1.0 + nrm(ks[15], (L, D_SSM), 0.02),
        "g_attn_out": 1.0 + nrm(ks[16], (L, D_ATT), 0.02),
        "w_out": nrm(ks[17], (L, D_SSM + D_ATT, D_MODEL), (D_SSM + D_ATT) ** -0.5),
        "g_ffn": 1.0 + nrm(ks[18], (L, D_MODEL), 0.02),
        "w_router_group": nrm(ks[19], (L, D_MODEL, N_EXPERT_GROUPS), D_MODEL ** -0.5),
        "b_router_group": nrm(ks[20], (L, N_EXPERT_GROUPS), 0.01),
        "w_router_expert": nrm(ks[21], (L, D_MODEL, N_EXPERT_GROUPS, EXPERTS_PER_GROUP), D_MODEL ** -0.5),
        "b_router_expert": nrm(ks[22], (L, N_EXPERT_GROUPS, EXPERTS_PER_GROUP), 0.01),
        "w_gate": nrm(ks[23], (L, N_EXPERTS, D_MODEL, D_EXPERT), D_MODEL ** -0.5),
        "w_up": nrm(ks[24], (L, N_EXPERTS, D_MODEL, D_EXPERT), D_MODEL ** -0.5),
        "w_down": nrm(ks[25], (L, N_EXPERTS, D_EXPERT, D_MODEL), D_EXPERT ** -0.5),
    }


def reference(x, g_mix, w_in, ssm_lambda_re, ssm_lambda_im, ssm_log_dt, ssm_b_re, ssm_b_im,
              ssm_c_re, ssm_c_im, ssm_d, ssm_w_glu, ssm_b_glu, g_q, g_k, g_ssm_out, g_attn_out,
              w_out, g_ffn, w_router_group, b_router_group, w_router_expert, b_router_expert,
              w_gate, w_up, w_down):
    bsz, t_len, _ = x.shape
    for l in range(DEPTH):
        h = rms_norm(x, g_mix[l])
        proj = h @ w_in[l]
        u = proj[..., :D_SSM]
        q = proj[..., D_SSM:D_SSM + D_ATT].reshape(bsz, t_len, N_HEADS, HEAD_DIM)
        k = proj[..., D_SSM + D_ATT:D_SSM + 2 * D_ATT].reshape(bsz, t_len, N_HEADS, HEAD_DIM)
        v = proj[..., D_SSM + 2 * D_ATT:].reshape(bsz, t_len, N_HEADS, HEAD_DIM)
        y_ssm = s5_mixer(u, ssm_lambda_re[l], ssm_lambda_im[l], ssm_log_dt[l], ssm_b_re[l],
                         ssm_b_im[l], ssm_c_re[l], ssm_c_im[l], ssm_d[l], ssm_w_glu[l], ssm_b_glu[l])
        q = rms_norm(q, g_q[l])
        k = rms_norm(k, g_k[l])
        y_att = stick_breaking_attention(q, k, v).reshape(bsz, t_len, D_ATT)
        mixed = jnp.concatenate([rms_norm(y_ssm, g_ssm_out[l]), rms_norm(y_att, g_attn_out[l])], axis=-1)
        x = x + mixed @ w_out[l]
        h2 = rms_norm(x, g_ffn[l])
        x = x + hierarchical_moe(h2, w_router_group[l], b_router_group[l], w_router_expert[l],
                                 b_router_expert[l], w_gate[l], w_up[l], w_down[l])
    return x
```

```cpp
#include <hip/hip_runtime.h>
#include <cstdio>
#include <cstdint>

typedef unsigned short bf16;
typedef float f32x4 __attribute__((ext_vector_type(4)));
typedef unsigned u32x4 __attribute__((ext_vector_type(4)));
typedef unsigned u32x2 __attribute__((ext_vector_type(2)));

constexpr int DM = 1024, BATCH = 32, SEQ = 2048, M = BATCH * SEQ;
constexpr int DSSM = 512, NG = 32, GS = 16, PST = 64, HD = 64, DATT = 512, NH = 8, DIN = 2048;
constexpr int NEG = 4, EPG = 8, NE = 32, DE = 512;
constexpr float EPS = 1e-6f;
constexpr int LCH = 32;
constexpr int NCH = M / LCH;
constexpr int U2P = 640;
constexpr float C2 = 0.125f * 1.4426950408889634f;

constexpr size_t MiB = 1u << 20;
constexpr size_t WS_CTL = 0;
constexpr size_t WS_TOK = 2 * MiB;
constexpr size_t WS_XN = 8 * MiB;
constexpr size_t WS_Q = WS_XN + 128 * MiB;
constexpr size_t WS_K = WS_Q + 64 * MiB;
constexpr size_t WS_V = WS_K + 64 * MiB;
constexpr size_t WS_U2 = WS_V + 64 * MiB;
constexpr size_t WS_Z = WS_U2 + 80 * MiB;
constexpr size_t WS_YS = WS_Z + 64 * MiB;
constexpr size_t WS_YA = WS_YS + 64 * MiB;
constexpr size_t WS_MIX = WS_YA + 64 * MiB;
constexpr size_t WS_H2 = WS_XN;
constexpr size_t WS_PROJ = WS_Z;
constexpr size_t WS_END = WS_PROJ + 512 * MiB;

__device__ __forceinline__ unsigned f2bf(float f) { unsigned u = __builtin_bit_cast(unsigned, f); return (u + 0x7fffu + ((u >> 16) & 1u)) >> 16; }
__device__ __forceinline__ float bf2f(unsigned short h) { return __builtin_bit_cast(float, (unsigned)h << 16); }
__device__ __forceinline__ unsigned pk2(float lo, float hi) { return f2bf(lo) | (f2bf(hi) << 16); }
__device__ __forceinline__ float wave_sum(float v) {
#pragma unroll
    for (int o = 1; o < 64; o <<= 1) v += __shfl_xor(v, o);
    return v;
}
__device__ __forceinline__ void sincos_d(double th, double& s, double& c) {
    const double q = rint(th * 0.63661977236758134308);
    const double r = (th - q * 1.57079632679489655800) - q * 6.12323399573676603587e-17;
    const double r2 = r * r;
    double sp = -1.0 / 1307674368000.0; sp = sp * r2 + 1.0 / 6227020800.0; sp = sp * r2 - 1.0 / 39916800.0; sp = sp * r2 + 1.0 / 362880.0; sp = sp * r2 - 1.0 / 5040.0; sp = sp * r2 + 1.0 / 120.0; sp = sp * r2 - 1.0 / 6.0; sp = sp * r2 + 1.0;
    const double sn = sp * r;
    double cp = 1.0 / 20922789888000.0; cp = cp * r2 - 1.0 / 87178291200.0; cp = cp * r2 + 1.0 / 479001600.0; cp = cp * r2 - 1.0 / 3628800.0; cp = cp * r2 + 1.0 / 40320.0; cp = cp * r2 - 1.0 / 720.0; cp = cp * r2 + 1.0 / 24.0; cp = cp * r2 - 0.5; cp = cp * r2 + 1.0;
    const int qi = ((int)q) & 3;
    s = (qi == 0) ? sn : (qi == 1) ? cp : (qi == 2) ? -sn : -cp;
    c = (qi == 0) ? cp : (qi == 1) ? -sn : (qi == 2) ? -cp : sn;
}
__device__ __forceinline__ float gelu_tanh(float x) {
    const float u = 0.7978845608028654f * (x + 0.044715f * x * x * x);
    const float e = __expf(2.f * u);
    const float t = 1.f - 2.f / (e + 1.f);
    return 0.5f * x * (1.f + t);
}
__device__ __forceinline__ float sigmoidf_(float x) { return 1.f / (1.f + __expf(-x)); }

namespace nv {
__global__ __launch_bounds__(256) void k_xn(const float* __restrict__ x, bf16* __restrict__ xn) {
    const int lane = threadIdx.x & 63, gw = (blockIdx.x * 256 + threadIdx.x) >> 6, ngw = gridDim.x * 4;
    for (int m = gw; m < M; m += ngw) {
        const f32x4* xr = (const f32x4*)(x + (size_t)m * DM) + lane;
        f32x4 v[4]; float s = 0.f;
#pragma unroll
        for (int j = 0; j < 4; ++j) { v[j] = xr[64 * j]; s += v[j].x * v[j].x + v[j].y * v[j].y + v[j].z * v[j].z + v[j].w * v[j].w; }
        const float rstd = 1.f / sqrtf(wave_sum(s) * (1.f / DM) + EPS);
        u32x2* o = (u32x2*)(xn + (size_t)m * DM) + lane;
#pragma unroll
        for (int j = 0; j < 4; ++j) { u32x2 w; w.x = pk2(v[j].x * rstd, v[j].y * rstd); w.y = pk2(v[j].z * rstd, v[j].w * rstd); o[64 * j] = w; }
    }
}
struct GArgs { const bf16* A; int lda; const float* ascale; const float* B; int ldb; int K; float* Cf; int ldc; const float* bias; const bf16* Zin; bf16* Ob; const float* X; float* Out; };
template <int EPI> __global__ __launch_bounds__(256) void k_gemm(GArgs g) {
    __shared__ float As[16][68], Bs[16][68];
    const int tid = threadIdx.x, tx = tid & 15, ty = tid >> 4, m0 = blockIdx.y * 64, n0 = blockIdx.x * 64;
    float acc[4][4] = {};
    for (int k0 = 0; k0 < g.K; k0 += 16) {
        { const int r = tid >> 2, kk = (tid & 3) * 4; const u32x2 w = *(const u32x2*)(g.A + (size_t)(m0 + r) * g.lda + k0 + kk);
          float a0 = bf2f(w.x & 0xffff), a1 = bf2f(w.x >> 16), a2 = bf2f(w.y & 0xffff), a3 = bf2f(w.y >> 16);
          if (g.ascale) { a0 *= g.ascale[k0 + kk]; a1 *= g.ascale[k0 + kk + 1]; a2 *= g.ascale[k0 + kk + 2]; a3 *= g.ascale[k0 + kk + 3]; }
          As[kk][r] = a0; As[kk + 1][r] = a1; As[kk + 2][r] = a2; As[kk + 3][r] = a3; }
        { const int kk = tid >> 4, nn = (tid & 15) * 4; const f32x4 b = *(const f32x4*)(g.B + (size_t)(k0 + kk) * g.ldb + n0 + nn);
          Bs[kk][nn] = b.x; Bs[kk][nn + 1] = b.y; Bs[kk][nn + 2] = b.z; Bs[kk][nn + 3] = b.w; }
        __syncthreads();
#pragma unroll
        for (int k = 0; k < 16; ++k) { float a[4], b[4];
#pragma unroll
            for (int i = 0; i < 4; ++i) { a[i] = As[k][ty * 4 + i]; b[i] = Bs[k][tx * 4 + i]; }
#pragma unroll
            for (int i = 0; i < 4; ++i)
#pragma unroll
                for (int j = 0; j < 4; ++j) acc[i][j] += a[i] * b[j]; }
        __syncthreads();
    }
#pragma unroll
    for (int i = 0; i < 4; ++i) { const int m = m0 + ty * 4 + i;
#pragma unroll
        for (int j = 0; j < 4; ++j) { const int n = n0 + tx * 4 + j; const float v = acc[i][j];
            if (EPI == 0) g.Cf[(size_t)m * g.ldc + n] = v;
            else if (EPI == 1) { const float z = bf2f(g.Zin[(size_t)m * g.ldc + n]); g.Ob[(size_t)m * g.ldc + n] = (bf16)f2bf(z * sigmoidf_(v + g.bias[n])); }
            else if (EPI == 2) g.Out[(size_t)m * g.ldc + n] = g.X[(size_t)m * g.ldc + n] + v; } }
}
__global__ __launch_bounds__(256) void k_projpost(const float* __restrict__ P, const float* __restrict__ gq, const float* __restrict__ gk, bf16* U2, bf16* Q, bf16* Kb, bf16* V) {
    const int lane = threadIdx.x & 63, gw = (blockIdx.x * 256 + threadIdx.x) >> 6, ngw = gridDim.x * 4;
    for (int m = gw; m < M; m += ngw) {
        const float* pr = P + (size_t)m * DIN;
        for (int c = 0; c < 32; ++c) {
            const float v = pr[c * 64 + lane];
            if (c < 8) { const int ch = c * 64 + lane, g = ch >> 4, h = ch & 15; U2[((size_t)g * NCH + (m >> 5)) * U2P + (m & 31) * 16 + h] = (bf16)f2bf(v); }
            else if (c < 24) { const float rstd = 1.f / sqrtf(wave_sum(v * v) * (1.f / 64.f) + EPS);
                if (c < 16) Q[(size_t)m * DATT + (c - 8) * 64 + lane] = (bf16)f2bf(v * rstd * gq[lane] * C2);
                else Kb[(size_t)m * DATT + (c - 16) * 64 + lane] = (bf16)f2bf(v * rstd * gk[lane]); }
            else V[(size_t)m * DATT + (c - 24) * 64 + lane] = (bf16)f2bf(v);
        }
    }
}
__global__ __launch_bounds__(64) void k_s5(const bf16* __restrict__ U2, const float* lre, const float* lim, const float* ldt, const float* bre, const float* bim, const float* cre, const float* cim, const float* dsk, bf16* Z) {
    const int p = threadIdx.x, b = blockIdx.x >> 5, g = blockIdx.x & 31;
    const double dt = exp((double)ldt[g]), lr = lre[g * PST + p], li = lim[g * PST + p];
    double sn, cs; sincos_d(li * dt, sn, cs); const double mag = exp(lr * dt);
    const double ar = mag * cs, ai = mag * sn, den = lr * lr + li * li, nr = ar - 1.0, ni = ai;
    const double cfr = (nr * lr + ni * li) / den, cfi = (ni * lr - nr * li) / den;
    const float far = (float)ar, fai = (float)ai;
    float bbr[16], bbi[16], ccr[16], cci[16];
#pragma unroll
    for (int h = 0; h < 16; ++h) { const double br = bre[(g * PST + p) * GS + h], bi = bim[(g * PST + p) * GS + h];
        bbr[h] = (float)(cfr * br - cfi * bi); bbi[h] = (float)(cfr * bi + cfi * br);
        ccr[h] = cre[(g * GS + h) * PST + p]; cci[h] = cim[(g * GS + h) * PST + p]; }
    const float dme = dsk[g * GS + (p & 15)];
    float xr = 0.f, xi = 0.f;
    for (int t = 0; t < SEQ; ++t) {
        const int m = b * SEQ + t;
        const bf16* up = U2 + ((size_t)g * NCH + (m >> 5)) * U2P + (m & 31) * 16;
        const u32x4 w0 = *(const u32x4*)up, w1 = *(const u32x4*)(up + 8);
        float u[16];
        u[0] = bf2f(w0.x & 0xffff); u[1] = bf2f(w0.x >> 16); u[2] = bf2f(w0.y & 0xffff); u[3] = bf2f(w0.y >> 16); u[4] = bf2f(w0.z & 0xffff); u[5] = bf2f(w0.z >> 16); u[6] = bf2f(w0.w & 0xffff); u[7] = bf2f(w0.w >> 16);
        u[8] = bf2f(w1.x & 0xffff); u[9] = bf2f(w1.x >> 16); u[10] = bf2f(w1.y & 0xffff); u[11] = bf2f(w1.y >> 16); u[12] = bf2f(w1.z & 0xffff); u[13] = bf2f(w1.z >> 16); u[14] = bf2f(w1.w & 0xffff); u[15] = bf2f(w1.w >> 16);
        float br = 0.f, bi = 0.f;
#pragma unroll
        for (int h = 0; h < 16; ++h) { br += bbr[h] * u[h]; bi += bbi[h] * u[h]; }
        const float nxr = far * xr - fai * xi + br, nxi = far * xi + fai * xr + bi; xr = nxr; xi = nxi;
        float ymine = 0.f;
#pragma unroll
        for (int h = 0; h < 16; ++h) { const float s = wave_sum(ccr[h] * xr - cci[h] * xi); if ((p & 15) == h) ymine = s; }
        if (p < 16) { float uh = 0.f;
#pragma unroll
            for (int h = 0; h < 16; ++h) if (p == h) uh = u[h];
            Z[(size_t)m * DSSM + g * GS + p] = (bf16)f2bf(gelu_tanh(ymine + dme * uh)); }
    }
}
__global__ __launch_bounds__(64) void k_attn(const bf16* __restrict__ Q, const bf16* __restrict__ Kb, const bf16* __restrict__ V, bf16* YA) {
    const int t = blockIdx.x * 64 + threadIdx.x, h = blockIdx.y, b = blockIdx.z;
    const size_t row0 = (size_t)b * SEQ;
    float q[64], o[64];
    { const u32x4* qp = (const u32x4*)(Q + (row0 + t) * DATT + h * HD);
#pragma unroll
      for (int i = 0; i < 8; ++i) { const u32x4 w = qp[i]; q[8 * i] = bf2f(w.x & 0xffff); q[8 * i + 1] = bf2f(w.x >> 16); q[8 * i + 2] = bf2f(w.y & 0xffff); q[8 * i + 3] = bf2f(w.y >> 16); q[8 * i + 4] = bf2f(w.z & 0xffff); q[8 * i + 5] = bf2f(w.z >> 16); q[8 * i + 6] = bf2f(w.w & 0xffff); q[8 * i + 7] = bf2f(w.w >> 16); } }
#pragma unroll
    for (int i = 0; i < 64; ++i) o[i] = 0.f;
    float R = 0.f;
    for (int s = t - 1; s >= 0; --s) {
        const u32x4* kp = (const u32x4*)(Kb + (row0 + s) * DATT + h * HD);
        float z = 0.f;
#pragma unroll
        for (int i = 0; i < 8; ++i) { const u32x4 w = kp[i]; z += q[8 * i] * bf2f(w.x & 0xffff) + q[8 * i + 1] * bf2f(w.x >> 16) + q[8 * i + 2] * bf2f(w.y & 0xffff) + q[8 * i + 3] * bf2f(w.y >> 16) + q[8 * i + 4] * bf2f(w.z & 0xffff) + q[8 * i + 5] * bf2f(w.z >> 16) + q[8 * i + 6] * bf2f(w.w & 0xffff) + q[8 * i + 7] * bf2f(w.w >> 16); }
        const float e = exp2f(z), l = -log2f(1.f + e), a = exp2f(z + l + R);
        R += l;
        const u32x4* vp = (const u32x4*)(V + (row0 + s) * DATT + h * HD);
#pragma unroll
        for (int i = 0; i < 8; ++i) { const u32x4 w = vp[i]; o[8 * i] += a * bf2f(w.x & 0xffff); o[8 * i + 1] += a * bf2f(w.x >> 16); o[8 * i + 2] += a * bf2f(w.y & 0xffff); o[8 * i + 3] += a * bf2f(w.y >> 16); o[8 * i + 4] += a * bf2f(w.z & 0xffff); o[8 * i + 5] += a * bf2f(w.z >> 16); o[8 * i + 6] += a * bf2f(w.w & 0xffff); o[8 * i + 7] += a * bf2f(w.w >> 16); }
    }
    u32x4* op = (u32x4*)(YA + (row0 + t) * DATT + h * HD);
#pragma unroll
    for (int i = 0; i < 8; ++i) { u32x4 w; w.x = pk2(o[8 * i], o[8 * i + 1]); w.y = pk2(o[8 * i + 2], o[8 * i + 3]); w.z = pk2(o[8 * i + 4], o[8 * i + 5]); w.w = pk2(o[8 * i + 6], o[8 * i + 7]); op[i] = w; }
}
__global__ __launch_bounds__(256) void k_mixnorm(const bf16* __restrict__ YS, const bf16* __restrict__ YA, const float* gs, const float* ga, bf16* MIX, int gains) {
    const int lane = threadIdx.x & 63, gw = (blockIdx.x * 256 + threadIdx.x) >> 6, ngw = gridDim.x * 4;
    for (int m = gw; m < M; m += ngw) {
#pragma unroll
        for (int half = 0; half < 2; ++half) {
            const bf16* src = (half ? YA : YS) + (size_t)m * 512 + lane * 8; const float* gg = (half ? ga : gs) + lane * 8;
            const u32x4 w = *(const u32x4*)src; float v[8];
            v[0] = bf2f(w.x & 0xffff); v[1] = bf2f(w.x >> 16); v[2] = bf2f(w.y & 0xffff); v[3] = bf2f(w.y >> 16); v[4] = bf2f(w.z & 0xffff); v[5] = bf2f(w.z >> 16); v[6] = bf2f(w.w & 0xffff); v[7] = bf2f(w.w >> 16);
            float s = 0.f;
#pragma unroll
            for (int i = 0; i < 8; ++i) s += v[i] * v[i];
            const float rstd = 1.f / sqrtf(wave_sum(s) * (1.f / 512.f) + EPS);
#pragma unroll
            for (int i = 0; i < 8; ++i) v[i] *= rstd * (gains ? gg[i] : 1.f);
            u32x4 o; o.x = pk2(v[0], v[1]); o.y = pk2(v[2], v[3]); o.z = pk2(v[4], v[5]); o.w = pk2(v[6], v[7]);
            *(u32x4*)(MIX + (size_t)m * DM + half * 512 + lane * 8) = o;
        }
    }
}
__global__ __launch_bounds__(256) void k_router(const float* __restrict__ x1, const float* gffn, const float* wrg, const float* brg, const float* wre, const float* bre_, bf16* H2, int* TOK, int gains) {
    const int lane = threadIdx.x & 63, gw = (blockIdx.x * 256 + threadIdx.x) >> 6, ngw = gridDim.x * 4;
    for (int m = gw; m < M; m += ngw) {
        const f32x4* xr = (const f32x4*)(x1 + (size_t)m * DM) + lane;
        f32x4 v[4]; float s = 0.f;
#pragma unroll
        for (int j = 0; j < 4; ++j) { v[j] = xr[64 * j]; s += v[j].x * v[j].x + v[j].y * v[j].y + v[j].z * v[j].z + v[j].w * v[j].w; }
        const float rstd = 1.f / sqrtf(wave_sum(s) * (1.f / DM) + EPS);
        float hv[16];
#pragma unroll
        for (int j = 0; j < 4; ++j) { const f32x4 gg = ((const f32x4*)gffn)[64 * j + lane];
            hv[4 * j] = v[j].x * rstd * gg.x; hv[4 * j + 1] = v[j].y * rstd * gg.y; hv[4 * j + 2] = v[j].z * rstd * gg.z; hv[4 * j + 3] = v[j].w * rstd * gg.w;
            u32x2 w; if (gains) { w.x = pk2(hv[4 * j], hv[4 * j + 1]); w.y = pk2(hv[4 * j + 2], hv[4 * j + 3]); } else { w.x = pk2(v[j].x * rstd, v[j].y * rstd); w.y = pk2(v[j].z * rstd, v[j].w * rstd); }
            ((u32x2*)(H2 + (size_t)m * DM))[64 * j + lane] = w; }
        float lg[36];
#pragma unroll
        for (int c = 0; c < 36; ++c) { float a = 0.f;
#pragma unroll
            for (int j = 0; j < 4; ++j)
#pragma unroll
                for (int i = 0; i < 4; ++i) { const int k = 256 * j + 4 * lane + i; a += hv[4 * j + i] * (c < 4 ? wrg[k * 4 + c] : wre[k * 32 + (c - 4)]); }
            lg[c] = wave_sum(a) + (c < 4 ? brg[c] : bre_[c - 4]); }
        if (lane == 0) {
            int gi = 0; float gm = lg[0];
#pragma unroll
            for (int c = 1; c < 4; ++c) if (lg[c] > gm) { gm = lg[c]; gi = c; }
            float gsum = 0.f;
#pragma unroll
            for (int c = 0; c < 4; ++c) gsum += __expf(lg[c] - gm);
            const float pgrp = 1.f / gsum;
            float el[8];
#pragma unroll
            for (int e = 0; e < 8; ++e) { float t = 0.f;
#pragma unroll
                for (int g2 = 0; g2 < 4; ++g2) if (g2 == gi) t = lg[4 + g2 * 8 + e];
                el[e] = t; }
            int i0 = 0; float m0 = el[0];
#pragma unroll
            for (int e = 1; e < 8; ++e) if (el[e] > m0) { m0 = el[e]; i0 = e; }
            int i1 = -1; float m1 = -3.0e38f;
#pragma unroll
            for (int e = 0; e < 8; ++e) if (e != i0 && el[e] > m1) { m1 = el[e]; i1 = e; }
            const float e1 = __expf(m1 - m0), p0 = 1.f / (1.f + e1), p1 = e1 / (1.f + e1);
            int* tk = TOK + (size_t)m * 8;
            tk[0] = gi * 8 + i0; tk[1] = gi * 8 + i1; tk[2] = __float_as_int(pgrp * p0); tk[3] = __float_as_int(pgrp * p1);
        }
    }
}
__global__ __launch_bounds__(256) void k_moe(const bf16* __restrict__ H2, const int* __restrict__ TOK, const float* __restrict__ wg, const float* __restrict__ wu, const float* __restrict__ wd, float* out) {
    __shared__ float hs[DM]; __shared__ float hid[DE];
    const int m = blockIdx.x, tid = threadIdx.x;
    for (int k = tid; k < DM; k += 256) hs[k] = bf2f(H2[(size_t)m * DM + k]);
    __syncthreads();
    float oacc[4] = {0.f, 0.f, 0.f, 0.f};
    for (int kk = 0; kk < 2; ++kk) {
        const int e = TOK[(size_t)m * 8 + kk]; const float gate = __int_as_float(TOK[(size_t)m * 8 + 2 + kk]);
        const float* Wg = wg + (size_t)e * DM * DE; const float* Wu = wu + (size_t)e * DM * DE; const float* Wd = wd + (size_t)e * DE * DM;
        float g0 = 0.f, g1 = 0.f, u0 = 0.f, u1 = 0.f;
        for (int k = 0; k < DM; ++k) { const float hvv = hs[k]; g0 += hvv * Wg[(size_t)k * DE + tid]; g1 += hvv * Wg[(size_t)k * DE + tid + 256]; u0 += hvv * Wu[(size_t)k * DE + tid]; u1 += hvv * Wu[(size_t)k * DE + tid + 256]; }
        __syncthreads();
        hid[tid] = g0 * sigmoidf_(g0) * u0; hid[tid + 256] = g1 * sigmoidf_(g1) * u1;
        __syncthreads();
        float d[4] = {0.f, 0.f, 0.f, 0.f};
        for (int k = 0; k < DE; ++k) { const float hh = hid[k];
#pragma unroll
            for (int j = 0; j < 4; ++j) d[j] += hh * Wd[(size_t)k * DM + tid + 256 * j]; }
#pragma unroll
        for (int j = 0; j < 4; ++j) oacc[j] += gate * d[j];
    }
#pragma unroll
    for (int j = 0; j < 4; ++j) out[(size_t)m * DM + tid + 256 * j] += oacc[j];
}
}

extern "C" void kernel_launch(void* const* d_in, const int* in_sizes, int n_in, void* d_out, int out_size, void* d_ws, size_t ws_size, hipStream_t stream) {
    if (n_in != 26 || out_size != M * DM || ws_size < WS_END) { fprintf(stderr, "kernel_launch: unexpected shapes (n_in %d out %d ws %zu, need %zu)\n", n_in, out_size, ws_size, (size_t)WS_END); return; }
    const float* x = (const float*)d_in[0]; const float* g_mix = (const float*)d_in[1]; const float* w_in = (const float*)d_in[2];
    const float* lre = (const float*)d_in[3]; const float* lim = (const float*)d_in[4]; const float* ldt = (const float*)d_in[5];
    const float* bre = (const float*)d_in[6]; const float* bim = (const float*)d_in[7]; const float* cre = (const float*)d_in[8]; const float* cim = (const float*)d_in[9];
    const float* dsk = (const float*)d_in[10]; const float* w_glu = (const float*)d_in[11]; const float* b_glu = (const float*)d_in[12];
    const float* g_q = (const float*)d_in[13]; const float* g_k = (const float*)d_in[14]; const float* g_so = (const float*)d_in[15]; const float* g_ao = (const float*)d_in[16];
    const float* w_out = (const float*)d_in[17]; const float* g_ffn = (const float*)d_in[18]; const float* w_rg = (const float*)d_in[19]; const float* b_rg = (const float*)d_in[20];
    const float* w_re = (const float*)d_in[21]; const float* b_re = (const float*)d_in[22]; const float* w_gate = (const float*)d_in[23]; const float* w_up = (const float*)d_in[24]; const float* w_down = (const float*)d_in[25];
    unsigned char* ws = (unsigned char*)d_ws; float* out = (float*)d_out;
    bf16* XN = (bf16*)(ws + WS_XN); bf16* Q = (bf16*)(ws + WS_Q); bf16* Kb = (bf16*)(ws + WS_K); bf16* V = (bf16*)(ws + WS_V); bf16* U2 = (bf16*)(ws + WS_U2);
    bf16* Z = (bf16*)(ws + WS_Z); bf16* YS = (bf16*)(ws + WS_YS); bf16* YA = (bf16*)(ws + WS_YA); bf16* MIX = (bf16*)(ws + WS_MIX); bf16* H2 = (bf16*)(ws + WS_H2);
    float* PROJ = (float*)(ws + WS_PROJ); int* TOK = (int*)(ws + WS_TOK);

    nv::k_xn<<<2048, 256, 0, stream>>>(x, XN);
    { nv::GArgs g{}; g.A = XN; g.lda = DM; g.ascale = g_mix; g.B = w_in; g.ldb = DIN; g.K = DM; g.Cf = PROJ; g.ldc = DIN;
      nv::k_gemm<0><<<dim3(DIN / 64, M / 64), 256, 0, stream>>>(g); }
    nv::k_projpost<<<2048, 256, 0, stream>>>(PROJ, g_q, g_k, U2, Q, Kb, V);
    nv::k_s5<<<BATCH * NG, 64, 0, stream>>>(U2, lre, lim, ldt, bre, bim, cre, cim, dsk, Z);
    { nv::GArgs g{}; g.A = Z; g.lda = DSSM; g.ascale = nullptr; g.B = w_glu; g.ldb = DSSM; g.K = DSSM; g.ldc = DSSM; g.bias = b_glu; g.Zin = Z; g.Ob = YS;
      nv::k_gemm<1><<<dim3(DSSM / 64, M / 64), 256, 0, stream>>>(g); }
    nv::k_attn<<<dim3(SEQ / 64, NH, BATCH), 64, 0, stream>>>(Q, Kb, V, YA);
    nv::k_mixnorm<<<2048, 256, 0, stream>>>(YS, YA, g_so, g_ao, MIX, 1);
    { nv::GArgs g{}; g.A = MIX; g.lda = DM; g.ascale = nullptr; g.B = w_out; g.ldb = DM; g.K = DM; g.ldc = DM; g.X = x; g.Out = out;
      nv::k_gemm<2><<<dim3(DM / 64, M / 64), 256, 0, stream>>>(g); }
    nv::k_router<<<2048, 256, 0, stream>>>(out, g_ffn, w_rg, b_rg, w_re, b_re, H2, TOK, 1);
    nv::k_moe<<<M, 256, 0, stream>>>(H2, TOK, w_gate, w_up, w_down, out);
}
```

```cpp
#define FAST_UPTO 12

#include <hip/hip_runtime.h>
#include <cstdio>
#include <cstdint>

typedef unsigned short bf16;
typedef float f32x4 __attribute__((ext_vector_type(4)));
typedef unsigned u32x4 __attribute__((ext_vector_type(4)));
typedef unsigned u32x2 __attribute__((ext_vector_type(2)));

constexpr int DM = 1024, BATCH = 32, SEQ = 2048, M = BATCH * SEQ;
constexpr int DSSM = 512, NG = 32, GS = 16, PST = 64, HD = 64, DATT = 512, NH = 8, DIN = 2048;
constexpr int NEG = 4, EPG = 8, NE = 32, DE = 512;
constexpr float EPS = 1e-6f;
constexpr int LCH = 32;
constexpr int NCH = M / LCH;
constexpr int U2P = 640;
constexpr float C2 = 0.125f * 1.4426950408889634f;

constexpr size_t MiB = 1u << 20;
constexpr size_t WS_CTL = 0;
constexpr size_t WS_TOK = 2 * MiB;
constexpr size_t WS_XN = 8 * MiB;
constexpr size_t WS_Q = WS_XN + 128 * MiB;
constexpr size_t WS_K = WS_Q + 64 * MiB;
constexpr size_t WS_V = WS_K + 64 * MiB;
constexpr size_t WS_U2 = WS_V + 64 * MiB;
constexpr size_t WS_Z = WS_U2 + 80 * MiB;
constexpr size_t WS_YS = WS_Z + 64 * MiB;
constexpr size_t WS_YA = WS_YS + 64 * MiB;
constexpr size_t WS_MIX = WS_YA + 64 * MiB;
constexpr size_t WS_H2 = WS_XN;
constexpr size_t WS_PROJ = WS_Z;
constexpr size_t WS_END = WS_PROJ + 512 * MiB;

__device__ __forceinline__ unsigned f2bf(float f) { unsigned u = __builtin_bit_cast(unsigned, f); return (u + 0x7fffu + ((u >> 16) & 1u)) >> 16; }
__device__ __forceinline__ float bf2f(unsigned short h) { return __builtin_bit_cast(float, (unsigned)h << 16); }
__device__ __forceinline__ unsigned pk2(float lo, float hi) { return f2bf(lo) | (f2bf(hi) << 16); }
__device__ __forceinline__ float wave_sum(float v) {
#pragma unroll
    for (int o = 1; o < 64; o <<= 1) v += __shfl_xor(v, o);
    return v;
}
__device__ __forceinline__ void sincos_d(double th, double& s, double& c) {
    const double q = rint(th * 0.63661977236758134308);
    const double r = (th - q * 1.57079632679489655800) - q * 6.12323399573676603587e-17;
    const double r2 = r * r;
    double sp = -1.0 / 1307674368000.0; sp = sp * r2 + 1.0 / 6227020800.0; sp = sp * r2 - 1.0 / 39916800.0; sp = sp * r2 + 1.0 / 362880.0; sp = sp * r2 - 1.0 / 5040.0; sp = sp * r2 + 1.0 / 120.0; sp = sp * r2 - 1.0 / 6.0; sp = sp * r2 + 1.0;
    const double sn = sp * r;
    double cp = 1.0 / 20922789888000.0; cp = cp * r2 - 1.0 / 87178291200.0; cp = cp * r2 + 1.0 / 479001600.0; cp = cp * r2 - 1.0 / 3628800.0; cp = cp * r2 + 1.0 / 40320.0; cp = cp * r2 - 1.0 / 720.0; cp = cp * r2 + 1.0 / 24.0; cp = cp * r2 - 0.5; cp = cp * r2 + 1.0;
    const int qi = ((int)q) & 3;
    s = (qi == 0) ? sn : (qi == 1) ? cp : (qi == 2) ? -sn : -cp;
    c = (qi == 0) ? cp : (qi == 1) ? -sn : (qi == 2) ? -cp : sn;
}
__device__ __forceinline__ float gelu_tanh(float x) {
    const float u = 0.7978845608028654f * (x + 0.044715f * x * x * x);
    const float e = __expf(2.f * u);
    const float t = 1.f - 2.f / (e + 1.f);
    return 0.5f * x * (1.f + t);
}
__device__ __forceinline__ float sigmoidf_(float x) { return 1.f / (1.f + __expf(-x)); }

namespace nv {
__global__ __launch_bounds__(256) void k_xn(const float* __restrict__ x, bf16* __restrict__ xn) {
    const int lane = threadIdx.x & 63, gw = (blockIdx.x * 256 + threadIdx.x) >> 6, ngw = gridDim.x * 4;
    for (int m = gw; m < M; m += ngw) {
        const f32x4* xr = (const f32x4*)(x + (size_t)m * DM) + lane;
        f32x4 v[4]; float s = 0.f;
#pragma unroll
        for (int j = 0; j < 4; ++j) { v[j] = xr[64 * j]; s += v[j].x * v[j].x + v[j].y * v[j].y + v[j].z * v[j].z + v[j].w * v[j].w; }
        const float rstd = 1.f / sqrtf(wave_sum(s) * (1.f / DM) + EPS);
        u32x2* o = (u32x2*)(xn + (size_t)m * DM) + lane;
#pragma unroll
        for (int j = 0; j < 4; ++j) { u32x2 w; w.x = pk2(v[j].x * rstd, v[j].y * rstd); w.y = pk2(v[j].z * rstd, v[j].w * rstd); o[64 * j] = w; }
    }
}
struct GArgs { const bf16* A; int lda; const float* ascale; const float* B; int ldb; int K; float* Cf; int ldc; const float* bias; const bf16* Zin; bf16* Ob; const float* X; float* Out; };
template <int EPI> __global__ __launch_bounds__(256) void k_gemm(GArgs g) {
    __shared__ float As[16][68], Bs[16][68];
    const int tid = threadIdx.x, tx = tid & 15, ty = tid >> 4, m0 = blockIdx.y * 64, n0 = blockIdx.x * 64;
    float acc[4][4] = {};
    for (int k0 = 0; k0 < g.K; k0 += 16) {
        { const int r = tid >> 2, kk = (tid & 3) * 4; const u32x2 w = *(const u32x2*)(g.A + (size_t)(m0 + r) * g.lda + k0 + kk);
          float a0 = bf2f(w.x & 0xffff), a1 = bf2f(w.x >> 16), a2 = bf2f(w.y & 0xffff), a3 = bf2f(w.y >> 16);
          if (g.ascale) { a0 *= g.ascale[k0 + kk]; a1 *= g.ascale[k0 + kk + 1]; a2 *= g.ascale[k0 + kk + 2]; a3 *= g.ascale[k0 + kk + 3]; }
          As[kk][r] = a0; As[kk + 1][r] = a1; As[kk + 2][r] = a2; As[kk + 3][r] = a3; }
        { const int kk = tid >> 4, nn = (tid & 15) * 4; const f32x4 b = *(const f32x4*)(g.B + (size_t)(k0 + kk) * g.ldb + n0 + nn);
          Bs[kk][nn] = b.x; Bs[kk][nn + 1] = b.y; Bs[kk][nn + 2] = b.z; Bs[kk][nn + 3] = b.w; }
        __syncthreads();
#pragma unroll
        for (int k = 0; k < 16; ++k) { float a[4], b[4];
#pragma unroll
            for (int i = 0; i < 4; ++i) { a[i] = As[k][ty * 4 + i]; b[i] = Bs[k][tx * 4 + i]; }
#pragma unroll
            for (int i = 0; i < 4; ++i)
#pragma unroll
                for (int j = 0; j < 4; ++j) acc[i][j] += a[i] * b[j]; }
        __syncthreads();
    }
#pragma unroll
    for (int i = 0; i < 4; ++i) { const int m = m0 + ty * 4 + i;
#pragma unroll
        for (int j = 0; j < 4; ++j) { const int n = n0 + tx * 4 + j; const float v = acc[i][j];
            if (EPI == 0) g.Cf[(size_t)m * g.ldc + n] = v;
            else if (EPI == 1) { const float z = bf2f(g.Zin[(size_t)m * g.ldc + n]); g.Ob[(size_t)m * g.ldc + n] = (bf16)f2bf(z * sigmoidf_(v + g.bias[n])); }
            else if (EPI == 2) g.Out[(size_t)m * g.ldc + n] = g.X[(size_t)m * g.ldc + n] + v; } }
}
__global__ __launch_bounds__(256) void k_projpost(const float* __restrict__ P, const float* __restrict__ gq, const float* __restrict__ gk, bf16* U2, bf16* Q, bf16* Kb, bf16* V) {
    const int lane = threadIdx.x & 63, gw = (blockIdx.x * 256 + threadIdx.x) >> 6, ngw = gridDim.x * 4;
    for (int m = gw; m < M; m += ngw) {
        const float* pr = P + (size_t)m * DIN;
        for (int c = 0; c < 32; ++c) {
            const float v = pr[c * 64 + lane];
            if (c < 8) { const int ch = c * 64 + lane, g = ch >> 4, h = ch & 15; U2[((size_t)g * NCH + (m >> 5)) * U2P + (m & 31) * 16 + h] = (bf16)f2bf(v); }
            else if (c < 24) { const float rstd = 1.f / sqrtf(wave_sum(v * v) * (1.f / 64.f) + EPS);
                if (c < 16) Q[(size_t)m * DATT + (c - 8) * 64 + lane] = (bf16)f2bf(v * rstd * gq[lane] * C2);
                else Kb[(size_t)m * DATT + (c - 16) * 64 + lane] = (bf16)f2bf(v * rstd * gk[lane]); }
            else V[(size_t)m * DATT + (c - 24) * 64 + lane] = (bf16)f2bf(v);
        }
    }
}
__global__ __launch_bounds__(64) void k_s5(const bf16* __restrict__ U2, const float* lre, const float* lim, const float* ldt, const float* bre, const float* bim, const float* cre, const float* cim, const float* dsk, bf16* Z) {
    const int p = threadIdx.x, b = blockIdx.x >> 5, g = blockIdx.x & 31;
    const double dt = exp((double)ldt[g]), lr = lre[g * PST + p], li = lim[g * PST + p];
    double sn, cs; sincos_d(li * dt, sn, cs); const double mag = exp(lr * dt);
    const double ar = mag * cs, ai = mag * sn, den = lr * lr + li * li, nr = ar - 1.0, ni = ai;
    const double cfr = (nr * lr + ni * li) / den, cfi = (ni * lr - nr * li) / den;
    const float far = (float)ar, fai = (float)ai;
    float bbr[16], bbi[16], ccr[16], cci[16];
#pragma unroll
    for (int h = 0; h < 16; ++h) { const double br = bre[(g * PST + p) * GS + h], bi = bim[(g * PST + p) * GS + h];
        bbr[h] = (float)(cfr * br - cfi * bi); bbi[h] = (float)(cfr * bi + cfi * br);
        ccr[h] = cre[(g * GS + h) * PST + p]; cci[h] = cim[(g * GS + h) * PST + p]; }
    const float dme = dsk[g * GS + (p & 15)];
    float xr = 0.f, xi = 0.f;
    for (int t = 0; t < SEQ; ++t) {
        const int m = b * SEQ + t;
        const bf16* up = U2 + ((size_t)g * NCH + (m >> 5)) * U2P + (m & 31) * 16;
        const u32x4 w0 = *(const u32x4*)up, w1 = *(const u32x4*)(up + 8);
        float u[16];
        u[0] = bf2f(w0.x & 0xffff); u[1] = bf2f(w0.x >> 16); u[2] = bf2f(w0.y & 0xffff); u[3] = bf2f(w0.y >> 16); u[4] = bf2f(w0.z & 0xffff); u[5] = bf2f(w0.z >> 16); u[6] = bf2f(w0.w & 0xffff); u[7] = bf2f(w0.w >> 16);
        u[8] = bf2f(w1.x & 0xffff); u[9] = bf2f(w1.x >> 16); u[10] = bf2f(w1.y & 0xffff); u[11] = bf2f(w1.y >> 16); u[12] = bf2f(w1.z & 0xffff); u[13] = bf2f(w1.z >> 16); u[14] = bf2f(w1.w & 0xffff); u[15] = bf2f(w1.w >> 16);
        float br = 0.f, bi = 0.f;
#pragma unroll
        for (int h = 0; h < 16; ++h) { br += bbr[h] * u[h]; bi += bbi[h] * u[h]; }
        const float nxr = far * xr - fai * xi + br, nxi = far * xi + fai * xr + bi; xr = nxr; xi = nxi;
        float ymine = 0.f;
#pragma unroll
        for (int h = 0; h < 16; ++h) { const float s = wave_sum(ccr[h] * xr - cci[h] * xi); if ((p & 15) == h) ymine = s; }
        if (p < 16) { float uh = 0.f;
#pragma unroll
            for (int h = 0; h < 16; ++h) if (p == h) uh = u[h];
            Z[(size_t)m * DSSM + g * GS + p] = (bf16)f2bf(gelu_tanh(ymine + dme * uh)); }
    }
}
__global__ __launch_bounds__(64) void k_attn(const bf16* __restrict__ Q, const bf16* __restrict__ Kb, const bf16* __restrict__ V, bf16* YA) {
    const int t = blockIdx.x * 64 + threadIdx.x, h = blockIdx.y, b = blockIdx.z;
    const size_t row0 = (size_t)b * SEQ;
    float q[64], o[64];
    { const u32x4* qp = (const u32x4*)(Q + (row0 + t) * DATT + h * HD);
#pragma unroll
      for (int i = 0; i < 8; ++i) { const u32x4 w = qp[i]; q[8 * i] = bf2f(w.x & 0xffff); q[8 * i + 1] = bf2f(w.x >> 16); q[8 * i + 2] = bf2f(w.y & 0xffff); q[8 * i + 3] = bf2f(w.y >> 16); q[8 * i + 4] = bf2f(w.z & 0xffff); q[8 * i + 5] = bf2f(w.z >> 16); q[8 * i + 6] = bf2f(w.w & 0xffff); q[8 * i + 7] = bf2f(w.w >> 16); } }
#pragma unroll
    for (int i = 0; i < 64; ++i) o[i] = 0.f;
    float R = 0.f;
    for (int s = t - 1; s >= 0; --s) {
        const u32x4* kp = (const u32x4*)(Kb + (row0 + s) * DATT + h * HD);
        float z = 0.f;
#pragma unroll
        for (int i = 0; i < 8; ++i) { const u32x4 w = kp[i]; z += q[8 * i] * bf2f(w.x & 0xffff) + q[8 * i + 1] * bf2f(w.x >> 16) + q[8 * i + 2] * bf2f(w.y & 0xffff) + q[8 * i + 3] * bf2f(w.y >> 16) + q[8 * i + 4] * bf2f(w.z & 0xffff) + q[8 * i + 5] * bf2f(w.z >> 16) + q[8 * i + 6] * bf2f(w.w & 0xffff) + q[8 * i + 7] * bf2f(w.w >> 16); }
        const float e = exp2f(z), l = -log2f(1.f + e), a = exp2f(z + l + R);
        R += l;
        const u32x4* vp = (const u32x4*)(V + (row0 + s) * DATT + h * HD);
#pragma unroll
        for (int i = 0; i < 8; ++i) { const u32x4 w = vp[i]; o[8 * i] += a * bf2f(w.x & 0xffff); o[8 * i + 1] += a * bf2f(w.x >> 16); o[8 * i + 2] += a * bf2f(w.y & 0xffff); o[8 * i + 3] += a * bf2f(w.y >> 16); o[8 * i + 4] += a * bf2f(w.z & 0xffff); o[8 * i + 5] += a * bf2f(w.z >> 16); o[8 * i + 6] += a * bf2f(w.w & 0xffff); o[8 * i + 7] += a * bf2f(w.w >> 16); }
    }
    u32x4* op = (u32x4*)(YA + (row0 + t) * DATT + h * HD);
#pragma unroll
    for (int i = 0; i < 8; ++i) { u32x4 w; w.x = pk2(o[8 * i], o[8 * i + 1]); w.y = pk2(o[8 * i + 2], o[8 * i + 3]); w.z = pk2(o[8 * i + 4], o[8 * i + 5]); w.w = pk2(o[8 * i + 6], o[8 * i + 7]); op[i] = w; }
}
__global__ __launch_bounds__(256) void k_mixnorm(const bf16* __restrict__ YS, const bf16* __restrict__ YA, const float* gs, const float* ga, bf16* MIX, int gains) {
    const int lane = threadIdx.x & 63, gw = (blockIdx.x * 256 + threadIdx.x) >> 6, ngw = gridDim.x * 4;
    for (int m = gw; m < M; m += ngw) {
#pragma unroll
        for (int half = 0; half < 2; ++half) {
            const bf16* src = (half ? YA : YS) + (size_t)m * 512 + lane * 8; const float* gg = (half ? ga : gs) + lane * 8;
            const u32x4 w = *(const u32x4*)src; float v[8];
            v[0] = bf2f(w.x & 0xffff); v[1] = bf2f(w.x >> 16); v[2] = bf2f(w.y & 0xffff); v[3] = bf2f(w.y >> 16); v[4] = bf2f(w.z & 0xffff); v[5] = bf2f(w.z >> 16); v[6] = bf2f(w.w & 0xffff); v[7] = bf2f(w.w >> 16);
            float s = 0.f;
#pragma unroll
            for (int i = 0; i < 8; ++i) s += v[i] * v[i];
            const float rstd = 1.f / sqrtf(wave_sum(s) * (1.f / 512.f) + EPS);
#pragma unroll
            for (int i = 0; i < 8; ++i) v[i] *= rstd * (gains ? gg[i] : 1.f);
            u32x4 o; o.x = pk2(v[0], v[1]); o.y = pk2(v[2], v[3]); o.z = pk2(v[4], v[5]); o.w = pk2(v[6], v[7]);
            *(u32x4*)(MIX + (size_t)m * DM + half * 512 + lane * 8) = o;
        }
    }
}
__global__ __launch_bounds__(256) void k_router(const float* __restrict__ x1, const float* gffn, const float* wrg, const float* brg, const float* wre, const float* bre_, bf16* H2, int* TOK, int gains) {
    const int lane = threadIdx.x & 63, gw = (blockIdx.x * 256 + threadIdx.x) >> 6, ngw = gridDim.x * 4;
    for (int m = gw; m < M; m += ngw) {
        const f32x4* xr = (const f32x4*)(x1 + (size_t)m * DM) + lane;
        f32x4 v[4]; float s = 0.f;
#pragma unroll
        for (int j = 0; j < 4; ++j) { v[j] = xr[64 * j]; s += v[j].x * v[j].x + v[j].y * v[j].y + v[j].z * v[j].z + v[j].w * v[j].w; }
        const float rstd = 1.f / sqrtf(wave_sum(s) * (1.f / DM) + EPS);
        float hv[16];
#pragma unroll
        for (int j = 0; j < 4; ++j) { const f32x4 gg = ((const f32x4*)gffn)[64 * j + lane];
            hv[4 * j] = v[j].x * rstd * gg.x; hv[4 * j + 1] = v[j].y * rstd * gg.y; hv[4 * j + 2] = v[j].z * rstd * gg.z; hv[4 * j + 3] = v[j].w * rstd * gg.w;
            u32x2 w; if (gains) { w.x = pk2(hv[4 * j], hv[4 * j + 1]); w.y = pk2(hv[4 * j + 2], hv[4 * j + 3]); } else { w.x = pk2(v[j].x * rstd, v[j].y * rstd); w.y = pk2(v[j].z * rstd, v[j].w * rstd); }
            ((u32x2*)(H2 + (size_t)m * DM))[64 * j + lane] = w; }
        float lg[36];
#pragma unroll
        for (int c = 0; c < 36; ++c) { float a = 0.f;
#pragma unroll
            for (int j = 0; j < 4; ++j)
#pragma unroll
                for (int i = 0; i < 4; ++i) { const int k = 256 * j + 4 * lane + i; a += hv[4 * j + i] * (c < 4 ? wrg[k * 4 + c] : wre[k * 32 + (c - 4)]); }
            lg[c] = wave_sum(a) + (c < 4 ? brg[c] : bre_[c - 4]); }
        if (lane == 0) {
            int gi = 0; float gm = lg[0];
#pragma unroll
            for (int c = 1; c < 4; ++c) if (lg[c] > gm) { gm = lg[c]; gi = c; }
            float gsum = 0.f;
#pragma unroll
            for (int c = 0; c < 4; ++c) gsum += __expf(lg[c] - gm);
            const float pgrp = 1.f / gsum;
            float el[8];
#pragma unroll
            for (int e = 0; e < 8; ++e) { float t = 0.f;
#pragma unroll
                for (int g2 = 0; g2 < 4; ++g2) if (g2 == gi) t = lg[4 + g2 * 8 + e];
                el[e] = t; }
            int i0 = 0; float m0 = el[0];
#pragma unroll
            for (int e = 1; e < 8; ++e) if (el[e] > m0) { m0 = el[e]; i0 = e; }
            int i1 = -1; float m1 = -3.0e38f;
#pragma unroll
            for (int e = 0; e < 8; ++e) if (e != i0 && el[e] > m1) { m1 = el[e]; i1 = e; }
            const float e1 = __expf(m1 - m0), p0 = 1.f / (1.f + e1), p1 = e1 / (1.f + e1);
            int* tk = TOK + (size_t)m * 8;
            tk[0] = gi * 8 + i0; tk[1] = gi * 8 + i1; tk[2] = __float_as_int(pgrp * p0); tk[3] = __float_as_int(pgrp * p1);
        }
    }
}
__global__ __launch_bounds__(256) void k_moe(const bf16* __restrict__ H2, const int* __restrict__ TOK, const float* __restrict__ wg, const float* __restrict__ wu, const float* __restrict__ wd, float* out) {
    __shared__ float hs[DM]; __shared__ float hid[DE];
    const int m = blockIdx.x, tid = threadIdx.x;
    for (int k = tid; k < DM; k += 256) hs[k] = bf2f(H2[(size_t)m * DM + k]);
    __syncthreads();
    float oacc[4] = {0.f, 0.f, 0.f, 0.f};
    for (int kk = 0; kk < 2; ++kk) {
        const int e = TOK[(size_t)m * 8 + kk]; const float gate = __int_as_float(TOK[(size_t)m * 8 + 2 + kk]);
        const float* Wg = wg + (size_t)e * DM * DE; const float* Wu = wu + (size_t)e * DM * DE; const float* Wd = wd + (size_t)e * DE * DM;
        float g0 = 0.f, g1 = 0.f, u0 = 0.f, u1 = 0.f;
        for (int k = 0; k < DM; ++k) { const float hvv = hs[k]; g0 += hvv * Wg[(size_t)k * DE + tid]; g1 += hvv * Wg[(size_t)k * DE + tid + 256]; u0 += hvv * Wu[(size_t)k * DE + tid]; u1 += hvv * Wu[(size_t)k * DE + tid + 256]; }
        __syncthreads();
        hid[tid] = g0 * sigmoidf_(g0) * u0; hid[tid + 256] = g1 * sigmoidf_(g1) * u1;
        __syncthreads();
        float d[4] = {0.f, 0.f, 0.f, 0.f};
        for (int k = 0; k < DE; ++k) { const float hh = hid[k];
#pragma unroll
            for (int j = 0; j < 4; ++j) d[j] += hh * Wd[(size_t)k * DM + tid + 256 * j]; }
#pragma unroll
        for (int j = 0; j < 4; ++j) oacc[j] += gate * d[j];
    }
#pragma unroll
    for (int j = 0; j < 4; ++j) out[(size_t)m * DM + tid + 256 * j] += oacc[j];
}
}


namespace mk {
#define LAS __attribute__((address_space(3)))
#define GAS __attribute__((address_space(1)))
typedef short bf16x8 __attribute__((ext_vector_type(8)));
typedef short s16x4 __attribute__((ext_vector_type(4)));
typedef float f32x16 __attribute__((ext_vector_type(16)));
typedef float f32x2 __attribute__((ext_vector_type(2)));
typedef __bf16 bf16x2_t __attribute__((ext_vector_type(2)));
typedef GAS unsigned gu32;

constexpr int NWAVES = 8, NTHR = 512;
constexpr int RING_BYTES = 131072, SCR2_OFF = RING_BYTES, SCR2_BYTES = 16128, MISC_OFF = SCR2_OFF + SCR2_BYTES, LDS_BYTES = 147456;
static_assert(MISC_OFF + 256 == LDS_BYTES, "LDS map");

constexpr size_t FW_TOK = 2 * MiB, FW_WIN = 4 * MiB, FW_WOUT = 8 * MiB, FW_WGLU = 10 * MiB, FW_WR = 10 * MiB + 512 * 1024, FW_TB = 12 * MiB, FW_W1 = 32 * MiB,
                 FW_WGU = 40 * MiB, FW_WD = 104 * MiB, FW_SST = 136 * MiB, FW_XN = 168 * MiB, FW_Q = 296 * MiB, FW_K = 360 * MiB, FW_V = 424 * MiB, FW_U2 = 488 * MiB,
                 FW_Z = 568 * MiB, FW_YS = 632 * MiB, FW_YA = 696 * MiB, FW_MIX = 760 * MiB, FW_END = 888 * MiB,
                 FW_H2 = FW_XN, FW_XG = 296 * MiB, FW_HH = 568 * MiB, FW_YE = FW_XG;
static_assert(FW_K - FW_Q == (size_t)M * 512 * 2 && FW_V - FW_K == (size_t)M * 512 * 2, "Q|K|V contiguous");
constexpr int MAXTILES = 544;
static_assert(FW_XG + (size_t)MAXTILES * 256 * DM * 2 <= FW_HH && FW_HH + (size_t)MAXTILES * 256 * DE * 2 <= FW_END, "MoE overlay");
constexpr int CW_TMO = 0, CW_CNT = 64, CW_BAR = 4096;
constexpr size_t CTL_ZERO_BYTES = 1 * MiB;

#define RLX_AGENT __ATOMIC_RELAXED, __HIP_MEMORY_SCOPE_AGENT
__device__ __forceinline__ unsigned cvtpk(float lo, float hi) { f32x2 v = {lo, hi}; bf16x2_t b = __builtin_convertvector(v, bf16x2_t); return __builtin_bit_cast(unsigned, b); }

#define XB_TMO      128
#define XB_XCNT(j)  (256  + 64 * (j))
#define XB_XSUB(j)  (1280 + 64 * (j))
#define XB_XGEN(j)  (2304 + 64 * (j))
#define XB_TOP      3328
#define XB_TOPGEN   3392
#define XCD_BAR_WORDS 3456
#define XB_SPIN_CAP (1u << 18)
__device__ __forceinline__ unsigned xb_ld(unsigned* p)              { return __hip_atomic_load(p, __ATOMIC_RELAXED, __HIP_MEMORY_SCOPE_AGENT); }
__device__ __forceinline__ unsigned xb_add(unsigned* p, unsigned v) { return __hip_atomic_fetch_add(p, v, __ATOMIC_RELAXED, __HIP_MEMORY_SCOPE_AGENT); }
__device__ __forceinline__ unsigned xb_xcc_id() { return (unsigned)__builtin_amdgcn_s_getreg((3 << 11) | 20) & 0xFu; }
#define XB_SPIN(cond, bar) do { unsigned _sp = 0; while (cond) { __builtin_amdgcn_s_sleep(1); \
    if ((++_sp & 255u) == 0u) { if (xb_ld(&(bar)[XB_TMO])) break; if (_sp > XB_SPIN_CAP) { atomicAdd(&(bar)[XB_TMO], 1u); break; } } } } while (0)
struct XcdBarrier { unsigned* bar; unsigned x; volatile LAS unsigned* st; };
__device__ __forceinline__ XcdBarrier xcd_barrier_post(unsigned* bar, volatile LAS unsigned* st) {
    XcdBarrier b; b.bar = bar; b.x = xb_xcc_id(); b.st = st;
    if (threadIdx.x == 0) (void)xb_add(&bar[XB_XCNT(b.x)], 1u);
    return b;
}
__device__ __forceinline__ void xcd_barrier_complete(unsigned* bar, unsigned x, unsigned& nloc, unsigned& nx) {
    const unsigned G = gridDim.x * gridDim.y * gridDim.z;
    unsigned sum, cnt, mine, sp = 0u;
    for (;;) {
        sum = 0u; cnt = 0u; mine = 0u;
#pragma unroll
        for (unsigned j = 0; j < 16; ++j) { const unsigned c = xb_ld(&bar[XB_XCNT(j)]); sum += c; cnt += (c > 0u) ? 1u : 0u; mine = (j == x) ? c : mine; }
        if (sum == G) break;
        __builtin_amdgcn_s_sleep(1);
        if ((++sp & 255u) == 0u) { if (xb_ld(&bar[XB_TMO])) break; if (sp > XB_SPIN_CAP) { atomicAdd(&bar[XB_TMO], 1u); break; } }
    }
    nloc = mine > 0u ? mine : 1u; nx = cnt > 0u ? cnt : 1u;
}
__device__ __forceinline__ void xcd_barrier(const XcdBarrier& b) {
    asm volatile("s_waitcnt vmcnt(0)" ::: "memory");
    __syncthreads();
    if (threadIdx.x == 0) {
        unsigned* bar = b.bar;
        __builtin_amdgcn_s_waitcnt(0);
        unsigned nloc = b.st[0], nx = b.st[1];
        if (nloc == 0u) { xcd_barrier_complete(bar, b.x, nloc, nx); b.st[0] = nloc; b.st[1] = nx; }
        const unsigned old = xb_add(&bar[XB_XSUB(b.x)], 1u);
        const unsigned gen = old / nloc;
        if (old + 1u == (gen + 1u) * nloc) {
            __builtin_amdgcn_fence(__ATOMIC_RELEASE, "agent");
            asm volatile("s_waitcnt vmcnt(0)" ::: "memory");
            const unsigned og = xb_add(&bar[XB_TOP], 1u);
            const unsigned tg = og / nx;
            if (og + 1u == (tg + 1u) * nx) xb_add(&bar[XB_TOPGEN], 1u);
            else XB_SPIN(xb_ld(&bar[XB_TOPGEN]) == tg, bar);
            __builtin_amdgcn_fence(__ATOMIC_ACQUIRE, "agent");
            xb_add(&bar[XB_XGEN(b.x)], 1u);
            asm volatile("s_waitcnt vmcnt(0)" ::: "memory");
        } else {
            XB_SPIN(xb_ld(&bar[XB_XGEN(b.x)]) == gen, bar);
            __builtin_amdgcn_fence(__ATOMIC_ACQUIRE, "agent");
            asm volatile("s_waitcnt vmcnt(0)" ::: "memory");
        }
    }
    __syncthreads();
}

constexpr int BM = 256, BK = 64, HALF = 128, HTB = HALF * BK * 2;
__device__ __forceinline__ int lds_byte(int r, int c) { const int st = (r >> 4) * 2 + (c >> 5), rr = r & 15, cc = c & 31, ob = rr * 64 + cc * 2; return st * 1024 + (ob ^ (((ob >> 9) & 1) << 5)); }
__device__ __forceinline__ void stage_rc(int b, int& R, int& C) { const int st = b / 1024, sb = b % 1024, swz = sb ^ (((sb >> 9) & 1) << 5); R = (st >> 1) * 16 + swz / 64; C = (st & 1) * 32 + (swz % 64) / 2; }
__device__ __forceinline__ int perm32(int rho) { const int n = rho >> 4, i = rho & 15; return 8 * (i >> 2) + 4 * n + (i & 3); }
struct Unit { const char* a; const char* b; int pm, pn, aux; };
struct GemmP { int lda_b, ldb_b, K; };

template <class Epi, class Sched>
__device__ __forceinline__ void gemm_phase(LAS unsigned char* lds, const GemmP g, const Sched& S, const Epi& E) {
    const int tid = threadIdx.x, wid = __builtin_amdgcn_readfirstlane(tid >> 6), lane = tid & 63, wr = wid >> 2, wc = wid & 3, fr = lane & 15, fq = lane >> 4;
    const int nt = g.K / BK;
    unsigned voffA[2], voffB[2];
#pragma unroll
    for (int i = 0; i < 2; ++i) { int R, C; stage_rc(tid * 16 + i * 8192, R, C); const int Rb = Epi::PERM ? ((R & ~31) + perm32(R & 31)) : R;
        voffA[i] = (unsigned)(R * g.lda_b + C * 2); voffB[i] = (unsigned)(Rb * g.ldb_b + C * 2); }
    const size_t kstep = (size_t)(BK * 2);
    const size_t hstepA = (size_t)HALF * g.lda_b, hstepB = (size_t)HALF * g.ldb_b;
    const unsigned ldsw = (unsigned)wid * 1024u;
    const int aoff = lds_byte(wr * 64 + fr, fq * 8), boff = lds_byte(wc * 32 + fr, fq * 8);
#define PG8_SA(b, h) (((b) * 2 + (h)) * HTB)
#define PG8_SB(b, h) ((4 + (b) * 2 + (h)) * HTB)
#define PG8_STAGE(bufoff, gbase, voff) do { _Pragma("unroll") for (int _i = 0; _i < 2; ++_i) \
        __builtin_amdgcn_global_load_lds((const unsigned*)((const char*)(gbase) + (voff)[_i]), (LAS unsigned*)(lds + (bufoff) + ldsw + _i * 8192), 16, 0, 0); } while (0)
#define PG8_LDA(dst, b, h) do { _Pragma("unroll") for (int m = 0; m < 4; ++m) _Pragma("unroll") for (int k = 0; k < 2; ++k) dst[m][k] = *(const LAS bf16x8*)(lds + PG8_SA(b, h) + aoff + m * 2048 + k * 1024); } while (0)
#define PG8_LDB(dst, b, h) do { _Pragma("unroll") for (int n = 0; n < 2; ++n) _Pragma("unroll") for (int k = 0; k < 2; ++k) dst[n][k] = *(const LAS bf16x8*)(lds + PG8_SB(b, h) + boff + n * 2048 + k * 1024); } while (0)
#define PG8_MMA(ai, bj, At, Bt) do { __builtin_amdgcn_s_setprio(1); _Pragma("unroll") for (int m = 0; m < 4; ++m) _Pragma("unroll") for (int n = 0; n < 2; ++n) _Pragma("unroll") for (int k = 0; k < 2; ++k) \
        acc[ai][bj][m][n] = __builtin_amdgcn_mfma_f32_16x16x32_bf16(Bt[n][k], At[m][k], acc[ai][bj][m][n], 0, 0, 0); __builtin_amdgcn_s_setprio(0); } while (0)
#define PG8_WAIT_V(n) asm volatile("s_waitcnt vmcnt(" #n ")" ::: "memory")
#define PG8_WAIT_L(n) asm volatile("s_waitcnt lgkmcnt(" #n ")" ::: "memory")
#define PG8_BAR __builtin_amdgcn_s_barrier()
#define PG8_SCHED __builtin_amdgcn_sched_barrier(0)
    Unit cur, nxt; int ui = 0;
    if (!S.next(0, cur)) return;
    f32x4 acc[2][2][4][2];
#pragma unroll
    for (int a = 0; a < 2; ++a)
#pragma unroll
        for (int b = 0; b < 2; ++b)
#pragma unroll
            for (int m = 0; m < 4; ++m)
#pragma unroll
                for (int n = 0; n < 2; ++n) acc[a][b][m][n] = (f32x4){0.f, 0.f, 0.f, 0.f};
    bf16x8 At[4][2], B0[2][2], B1[2][2];
    const char* cA = cur.a; const char* cB = cur.b;
    PG8_STAGE(PG8_SB(0, 0), cB, voffB); PG8_STAGE(PG8_SB(0, 1), cB + hstepB, voffB); PG8_STAGE(PG8_SA(0, 0), cA, voffA); PG8_STAGE(PG8_SA(0, 1), cA + hstepA, voffA);
    if (wr == 1) PG8_BAR;
    PG8_WAIT_V(2); PG8_BAR;
    PG8_STAGE(PG8_SB(1, 0), cB + kstep, voffB); PG8_STAGE(PG8_SA(1, 0), cA + kstep, voffA); PG8_STAGE(PG8_SB(1, 1), cB + hstepB + kstep, voffB);
    PG8_WAIT_V(6); PG8_BAR;
    for (;;) {
        const bool has_next = S.next(ui + 1, nxt);
        const char* nA = has_next ? nxt.a : cA; const char* nB = has_next ? nxt.b : cB;
        for (int t = 0; t < nt; t += 2) {
            const bool last = (t == nt - 2);
            const char* a1 = cA + (size_t)(t + 1) * kstep;
            const char* a2 = last ? nA : cA + (size_t)(t + 2) * kstep; const char* b2 = last ? nB : cB + (size_t)(t + 2) * kstep;
            const char* a3 = a2 + kstep; const char* b3 = b2 + kstep;
            PG8_LDB(B0, 0, 0); PG8_LDB(B1, 0, 1); PG8_SCHED; PG8_LDA(At, 0, 0); PG8_STAGE(PG8_SA(1, 1), a1 + hstepA, voffA);
            PG8_WAIT_V(8); PG8_WAIT_L(0); PG8_BAR; PG8_MMA(0, 0, At, B0); PG8_MMA(0, 1, At, B1); PG8_BAR; PG8_SCHED;
            PG8_LDA(At, 0, 1); PG8_STAGE(PG8_SB(0, 0), b2, voffB); PG8_STAGE(PG8_SB(0, 1), b2 + hstepB, voffB); PG8_STAGE(PG8_SA(0, 0), a2, voffA);
            PG8_WAIT_V(8); PG8_WAIT_L(0); PG8_BAR; PG8_MMA(1, 0, At, B0); PG8_MMA(1, 1, At, B1); PG8_BAR; PG8_SCHED;
            PG8_LDB(B0, 1, 0); PG8_LDB(B1, 1, 1); PG8_SCHED; PG8_LDA(At, 1, 0); PG8_STAGE(PG8_SA(0, 1), a2 + hstepA, voffA);
            PG8_WAIT_V(8); PG8_WAIT_L(0); PG8_BAR; PG8_MMA(0, 0, At, B0); PG8_MMA(0, 1, At, B1); PG8_BAR; PG8_SCHED;
            PG8_LDA(At, 1, 1); PG8_STAGE(PG8_SB(1, 0), b3, voffB); PG8_STAGE(PG8_SB(1, 1), b3 + hstepB, voffB); PG8_STAGE(PG8_SA(1, 0), a3, voffA);
            PG8_WAIT_V(8); PG8_WAIT_L(0); PG8_BAR; PG8_MMA(1, 0, At, B0); PG8_MMA(1, 1, At, B1); PG8_BAR; PG8_SCHED;
        }
        if (wr == 0) PG8_BAR;
        E(acc, cur, wr, wc, fr, fq);
        if (!has_next) break;
#pragma unroll
        for (int a = 0; a < 2; ++a)
#pragma unroll
            for (int b = 0; b < 2; ++b)
#pragma unroll
                for (int m = 0; m < 4; ++m)
#pragma unroll
                    for (int n = 0; n < 2; ++n) acc[a][b][m][n] = (f32x4){0.f, 0.f, 0.f, 0.f};
        cur = nxt; cA = nA; cB = nB; ++ui;
        if (wr == 1) PG8_BAR;
    }
    PG8_WAIT_V(0);
    PG8_BAR;
#undef PG8_SA
#undef PG8_SB
#undef PG8_STAGE
#undef PG8_LDA
#undef PG8_LDB
#undef PG8_MMA
#undef PG8_WAIT_V
#undef PG8_WAIT_L
#undef PG8_BAR
#undef PG8_SCHED
}

struct DenseOrder {
    const char* A; const char* B; size_t a_tile, b_tile; int nM, nN, nwg, G, c;
    __device__ __forceinline__ bool next(int i, Unit& u) const {
        const long L = (long)i * G + c; if (L >= nwg) return false;
        int wgid = (int)L; { const int q = nwg / 8, r = nwg % 8, xcd = wgid % 8, off = wgid / 8; wgid = (xcd < r ? xcd * (q + 1) : r * (q + 1) + (xcd - r) * q) + off; }
        const int nig = 8 * nN, gid = wgid / nig, fm = gid * 8, gsz = (nM - fm) < 8 ? (nM - fm) : 8;
        u.pm = fm + ((wgid % nig) % gsz); u.pn = (wgid % nig) / gsz; u.aux = 0;
        u.a = A + (size_t)u.pm * a_tile; u.b = B + (size_t)u.pn * b_tile; return true;
    }
};
struct GroupOrder {
    const char* A; const char* B; size_t a_grp, b_grp, a_tile, b_tile; int nM, nN, nwg, G, c;
    __device__ __forceinline__ bool next(int i, Unit& u) const {
        const long L = (long)i * G + c; if (L >= nwg) return false;
        const int per = nM * nN, g = (int)L / per, r = (int)L % per;
        u.pn = r / nM; u.pm = r % nM; u.aux = g;
        u.a = A + (size_t)g * a_grp + (size_t)u.pm * a_tile; u.b = B + (size_t)g * b_grp + (size_t)u.pn * b_tile; return true;
    }
};
struct MoeOrder {
    const char* A; const char* B; size_t a_tile, b_exp, b_tile; const LAS unsigned char* t2e; int ntiles, G, c;
    __device__ __forceinline__ bool next(int i, Unit& u) const {
        const long L = (long)i * G + c; if (L >= (long)ntiles * 4) return false;
        u.pm = (int)(L >> 2); u.pn = (int)(L & 3); u.aux = t2e[u.pm];
        u.a = A + (size_t)u.pm * a_tile; u.b = B + (size_t)u.aux * b_exp + (size_t)u.pn * b_tile; return true;
    }
};

typedef f32x4 Acc[2][2][4][2];
struct EpiProj {
    static constexpr bool PERM = true;
    bf16* U2; bf16* QKV; const float* gq; const float* gk;
    __device__ __forceinline__ void operator()(const Acc& acc, const Unit& u, int wr, int wc, int fr, int fq) const {
        const int typ = u.pn >> 1, sub = u.pn & 1;
        const bool nrm = (typ == 1 || typ == 2);
        const float* gg = (typ == 1) ? gq : gk; const float sc = (typ == 1) ? C2 : 1.f;
        f32x4 gn[2][2];
#pragma unroll
        for (int bj = 0; bj < 2; ++bj)
#pragma unroll
            for (int n = 0; n < 2; ++n) gn[bj][n] = *(const f32x4*)(gg + 32 * bj + 8 * fq + 4 * n) * sc;
#pragma unroll
        for (int ai = 0; ai < 2; ++ai)
#pragma unroll
            for (int m = 0; m < 4; ++m) {
                const int r = u.pm * BM + ai * HALF + wr * 64 + m * 16 + fr;
                f32x4 v[2][2];
#pragma unroll
                for (int bj = 0; bj < 2; ++bj)
#pragma unroll
                    for (int n = 0; n < 2; ++n) v[bj][n] = acc[ai][bj][m][n];
                {
                    float s = 0.f;
#pragma unroll
                    for (int bj = 0; bj < 2; ++bj)
#pragma unroll
                        for (int n = 0; n < 2; ++n) s += (v[bj][n].x * v[bj][n].x + v[bj][n].y * v[bj][n].y) + (v[bj][n].z * v[bj][n].z + v[bj][n].w * v[bj][n].w);
                    s += __shfl_xor(s, 16); s += __shfl_xor(s, 32);
                    const float rstd = 1.f / sqrtf(s * (1.f / 64.f) + EPS);
#pragma unroll
                    for (int bj = 0; bj < 2; ++bj)
#pragma unroll
                        for (int n = 0; n < 2; ++n) { const f32x4 mul = nrm ? gn[bj][n] * rstd : (f32x4){1.f, 1.f, 1.f, 1.f}; v[bj][n] = v[bj][n] * mul; }
                }
#pragma unroll
                for (int bj = 0; bj < 2; ++bj) {
                    u32x4 w; w.x = cvtpk(v[bj][0].x, v[bj][0].y); w.y = cvtpk(v[bj][0].z, v[bj][0].w); w.z = cvtpk(v[bj][1].x, v[bj][1].y); w.w = cvtpk(v[bj][1].z, v[bj][1].w);
                    const int f = sub * 256 + 64 * wc + 32 * bj + 8 * fq;
                    if (typ == 0) { const int g = f >> 4, h = f & 15; *(u32x4*)(U2 + ((size_t)g * NCH + (r >> 5)) * U2P + (r & 31) * 16 + h) = w; }
                    else { *(u32x4*)(QKV + (size_t)(typ - 1) * ((size_t)M * 512) + (size_t)r * 512 + f) = w; }
                }
            }
    }
};
struct EpiState {
    static constexpr bool PERM = false;
    float* SST;
    __device__ __forceinline__ void operator()(const Acc& acc, const Unit& u, int wr, int wc, int fr, int fq) const {
#pragma unroll
        for (int ai = 0; ai < 2; ++ai)
#pragma unroll
            for (int m = 0; m < 4; ++m) { const int r = u.pm * BM + ai * HALF + wr * 64 + m * 16 + fr;
#pragma unroll
                for (int n = 0; n < 2; ++n) *(f32x4*)(SST + ((size_t)u.aux * NCH + r) * 128 + 32 * wc + 16 * n + 4 * fq) = acc[ai][0][m][n]; }
    }
};
struct EpiS5 {
    static constexpr bool PERM = true;
    bf16* Z;
    __device__ __forceinline__ void operator()(const Acc& acc, const Unit& u, int wr, int wc, int fr, int fq) const {
#pragma unroll
        for (int ai = 0; ai < 2; ++ai)
#pragma unroll
            for (int m = 0; m < 4; ++m) { const int r = u.pm * BM + ai * HALF + wr * 64 + m * 16 + fr;
#pragma unroll
                for (int bj = 0; bj < 2; ++bj) { const int c0 = u.pn * BM + bj * HALF + 32 * wc + 8 * fq, i = c0 >> 4, h = c0 & 15;
                    const f32x4 a = acc[ai][bj][m][0], b = acc[ai][bj][m][1];
                    u32x4 w; w.x = cvtpk(gelu_tanh(a.x), gelu_tanh(a.y)); w.y = cvtpk(gelu_tanh(a.z), gelu_tanh(a.w)); w.z = cvtpk(gelu_tanh(b.x), gelu_tanh(b.y)); w.w = cvtpk(gelu_tanh(b.z), gelu_tanh(b.w));
                    *(u32x4*)(Z + ((size_t)r * 32 + i) * DSSM + u.aux * 16 + h) = w; } }
    }
};
struct EpiGlu {
    static constexpr bool PERM = true;
    const bf16* Z; const float* bias; bf16* YS;
    __device__ __forceinline__ void operator()(const Acc& acc, const Unit& u, int wr, int wc, int fr, int fq) const {
#pragma unroll
        for (int bj = 0; bj < 2; ++bj) { const int c0 = u.pn * BM + bj * HALF + 32 * wc + 8 * fq;
            const f32x4 b0 = *(const f32x4*)(bias + c0), b1 = *(const f32x4*)(bias + c0 + 4);
#pragma unroll
            for (int ai = 0; ai < 2; ++ai)
#pragma unroll
                for (int m = 0; m < 4; ++m) { const size_t off = (size_t)(u.pm * BM + ai * HALF + wr * 64 + m * 16 + fr) * DSSM + c0;
                    const u32x4 zz = *(const u32x4*)(Z + off);
                    const f32x4 a = acc[ai][bj][m][0] + b0, b = acc[ai][bj][m][1] + b1;
                    u32x4 w;
                    w.x = cvtpk(bf2f(zz.x & 0xffff) * sigmoidf_(a.x), bf2f(zz.x >> 16) * sigmoidf_(a.y)); w.y = cvtpk(bf2f(zz.y & 0xffff) * sigmoidf_(a.z), bf2f(zz.y >> 16) * sigmoidf_(a.w));
                    w.z = cvtpk(bf2f(zz.z & 0xffff) * sigmoidf_(b.x), bf2f(zz.z >> 16) * sigmoidf_(b.y)); w.w = cvtpk(bf2f(zz.w & 0xffff) * sigmoidf_(b.z), bf2f(zz.w >> 16) * sigmoidf_(b.w));
                    *(u32x4*)(YS + off) = w; } }
    }
};
struct EpiOut {
    static constexpr bool PERM = false;
    const float* X; float* Out;
    __device__ __forceinline__ void operator()(const Acc& acc, const Unit& u, int wr, int wc, int fr, int fq) const {
#pragma unroll
        for (int ai = 0; ai < 2; ++ai)
#pragma unroll
            for (int m = 0; m < 4; ++m) { const size_t ro = (size_t)(u.pm * BM + ai * HALF + wr * 64 + m * 16 + fr) * DM + u.pn * BM + 32 * wc + 4 * fq;
#pragma unroll
                for (int bj = 0; bj < 2; ++bj)
#pragma unroll
                    for (int n = 0; n < 2; ++n) { const size_t o = ro + bj * HALF + 16 * n; *(f32x4*)(Out + o) = *(const f32x4*)(X + o) + acc[ai][bj][m][n]; } }
    }
};
struct EpiGU {
    static constexpr bool PERM = true;
    bf16* HH;
    __device__ __forceinline__ void operator()(const Acc& acc, const Unit& u, int wr, int wc, int fr, int fq) const {
#pragma unroll
        for (int ai = 0; ai < 2; ++ai)
#pragma unroll
            for (int m = 0; m < 4; ++m) { const size_t off = (size_t)(u.pm * BM + ai * HALF + wr * 64 + m * 16 + fr) * DE + u.pn * 128 + 32 * wc + 8 * fq;
                float hv[8];
#pragma unroll
                for (int n = 0; n < 2; ++n) { const f32x4 gt = acc[ai][0][m][n], up = acc[ai][1][m][n];
                    hv[4 * n] = gt.x * sigmoidf_(gt.x) * up.x; hv[4 * n + 1] = gt.y * sigmoidf_(gt.y) * up.y; hv[4 * n + 2] = gt.z * sigmoidf_(gt.z) * up.z; hv[4 * n + 3] = gt.w * sigmoidf_(gt.w) * up.w; }
                u32x4 w; w.x = cvtpk(hv[0], hv[1]); w.y = cvtpk(hv[2], hv[3]); w.z = cvtpk(hv[4], hv[5]); w.w = cvtpk(hv[6], hv[7]);
                *(u32x4*)(HH + off) = w; }
    }
};
struct EpiDown {
    static constexpr bool PERM = true;
    bf16* YE;
    __device__ __forceinline__ void operator()(const Acc& acc, const Unit& u, int wr, int wc, int fr, int fq) const {
#pragma unroll
        for (int ai = 0; ai < 2; ++ai)
#pragma unroll
            for (int m = 0; m < 4; ++m) { const size_t ro = (size_t)(u.pm * BM + ai * HALF + wr * 64 + m * 16 + fr) * DM + u.pn * BM + 32 * wc + 8 * fq;
#pragma unroll
                for (int bj = 0; bj < 2; ++bj) { const f32x4 a = acc[ai][bj][m][0], b = acc[ai][bj][m][1];
                    u32x4 w; w.x = cvtpk(a.x, a.y); w.y = cvtpk(a.z, a.w); w.z = cvtpk(b.x, b.y); w.w = cvtpk(b.z, b.w);
                    *(u32x4*)(YE + ro + bj * HALF) = w; } }
    }
};

struct Args { const float* in[26]; float* out; unsigned char* ws; int ph_lo, ph_hi; };
struct Frame { LAS unsigned char* lds; volatile LAS unsigned* MISC; unsigned* ctl; int tid, lane, wave, G, c; };

__device__ __forceinline__ void transpose_item(const float* W, int ldw, int srccol0, const float* kscale, bf16* WT, int ldt, int dstrow0, int k0, LAS float* scr, int lane) {
#pragma unroll 8
    for (int i = 0; i < 32; ++i) { const int kk = 2 * i + (lane >> 5); float v = W[(size_t)(k0 + kk) * ldw + srccol0 + (lane & 31)]; if (kscale) v *= kscale[k0 + kk]; scr[kk * 33 + (lane & 31)] = v; }
    asm volatile("s_waitcnt lgkmcnt(0)" ::: "memory");
    const int c = lane & 7;
#pragma unroll
    for (int j = 0; j < 4; ++j) { const int n = (lane >> 3) + 8 * j; const LAS float* s = scr + (8 * c) * 33 + n;
        u32x4 o; o.x = pk2(s[0 * 33], s[1 * 33]); o.y = pk2(s[2 * 33], s[3 * 33]); o.z = pk2(s[4 * 33], s[5 * 33]); o.w = pk2(s[6 * 33], s[7 * 33]);
        *(u32x4*)(WT + (size_t)(dstrow0 + n) * ldt + k0 + 8 * c) = o; }
    asm volatile("s_waitcnt lgkmcnt(0)" ::: "memory");
}
__device__ __forceinline__ void s5_tables_item(Frame& F, const Args& a, int g, int part) {
    const float* lre = a.in[3]; const float* lim = a.in[4]; const float* ldt = a.in[5]; const float* bre = a.in[6]; const float* bim = a.in[7];
    const float* cre = a.in[8]; const float* cim = a.in[9]; const float* dsk = a.in[10];
    LAS float* PWr = (LAS float*)F.lds; LAS float* PWi = PWr + 33 * 64; LAS float* BBr = PWi + 33 * 64; LAS float* BBi = BBr + 1024; LAS float* CCr = BBi + 1024; LAS float* CCi = CCr + 1024; LAS float* CF = CCi + 1024;
    const int tid = F.tid;
    if (tid < 64) { const int p = tid;
        const double dt = exp((double)ldt[g]), lr = lre[g * PST + p], li = lim[g * PST + p];
        double sn, cs; sincos_d(li * dt, sn, cs); const double mag = exp(lr * dt);
        const double ar = mag * cs, ai = mag * sn, den = lr * lr + li * li, nr = ar - 1.0, ni = ai;
        CF[2 * p] = (float)((nr * lr + ni * li) / den); CF[2 * p + 1] = (float)((ni * lr - nr * li) / den);
        double pr = 1.0, pi = 0.0;
        for (int l = 0; l <= 32; ++l) { PWr[l * 64 + p] = (float)pr; PWi[l * 64 + p] = (float)pi; const double t = pr * ar - pi * ai; pi = pr * ai + pi * ar; pr = t; }
    }
    __syncthreads();
    for (int idx = tid; idx < 1024; idx += NTHR) { const int p = idx >> 4; const float cfr = CF[2 * p], cfi = CF[2 * p + 1], br = bre[(size_t)g * 1024 + idx], bi = bim[(size_t)g * 1024 + idx];
        BBr[idx] = cfr * br - cfi * bi; BBi[idx] = cfr * bi + cfi * br; CCr[idx] = cre[(size_t)g * 1024 + idx]; CCi[idx] = cim[(size_t)g * 1024 + idx]; }
    __syncthreads();
    bf16* TBg = (bf16*)(a.ws + FW_TB) + (size_t)g * 512 * U2P; bf16* W1g = (bf16*)(a.ws + FW_W1) + (size_t)g * 256 * 512;
    for (int l = part; l < 32; l += 8) {
        if (tid < 256) { const int h = tid >> 4, hp = tid & 15; float k = 0.f;
            for (int p = 0; p < 64; ++p) { const float wr_ = PWr[l * 64 + p], wi_ = PWi[l * 64 + p], br = BBr[p * 16 + hp], bi = BBi[p * 16 + hp];
                k += CCr[h * 64 + p] * (wr_ * br - wi_ * bi) - CCi[h * 64 + p] * (wr_ * bi + wi_ * br); }
            if (l == 0 && h == hp) k += dsk[g * 16 + h];
            const bf16 v = (bf16)f2bf(k);
            for (int i = l; i < 32; ++i) TBg[(size_t)(i * 16 + h) * U2P + (i - l) * 16 + hp] = v;
            if (l >= 1) for (int i = 0; i < 32 - l; ++i) TBg[(size_t)(i * 16 + h) * U2P + (i + l) * 16 + hp] = 0;
        } else { const int t2 = tid - 256;
#pragma unroll
            for (int x = 0; x < 8; ++x) { const int e = t2 * 8 + x;
                { const int h = e >> 7, q = e & 127, p = q & 63; const float cr = CCr[h * 64 + p], ci = CCi[h * 64 + p], wr_ = PWr[(l + 1) * 64 + p], wi_ = PWi[(l + 1) * 64 + p];
                  const float re = cr * wr_ - ci * wi_, im = cr * wi_ + ci * wr_; TBg[(size_t)(l * 16 + h) * U2P + 512 + q] = (bf16)f2bf(q < 64 ? re : -im); }
                { const int rho = e >> 4, hp = e & 15, p = rho & 63; const float wr_ = PWr[(31 - l) * 64 + p], wi_ = PWi[(31 - l) * 64 + p], br = BBr[p * 16 + hp], bi = BBi[p * 16 + hp];
                  const float re = wr_ * br - wi_ * bi, im = wr_ * bi + wi_ * br; W1g[(size_t)rho * 512 + l * 16 + hp] = (bf16)f2bf(rho < 64 ? re : im); W1g[(size_t)(128 + rho) * 512 + l * 16 + hp] = 0; }
            }
        }
    }
    __syncthreads();
}
__device__ __forceinline__ void p0_prologue(Frame& F, const Args& a) {
    const float* x = a.in[0];
    for (int it = F.c; it < 256; it += F.G) s5_tables_item(F, a, it >> 3, it & 7);
    LAS float* scr = (LAS float*)(F.lds + F.wave * 16384);
    const int gw = F.c * NWAVES + F.wave, NGW = F.G * NWAVES;
    constexpr int I_IN = 16 * 64, I_GLU = 8 * 16, I_OUT = 16 * 32, I_GU = 32 * 16 * 32, I_D = 32 * 8 * 32, NITEMS = I_IN + I_GLU + I_OUT + I_GU + I_D;
    bf16* WIN = (bf16*)(a.ws + FW_WIN); bf16* WGLU = (bf16*)(a.ws + FW_WGLU); bf16* WOUT = (bf16*)(a.ws + FW_WOUT); bf16* WGU = (bf16*)(a.ws + FW_WGU); bf16* WD = (bf16*)(a.ws + FW_WD);
    for (int it = gw; it < NITEMS; it += NGW) {
        int r = it;
        if (r < I_IN) { const int kb = r >> 6, d = r & 63, pn = d >> 3, beta = d & 7, bj = beta >> 2, wc = beta & 3;
            transpose_item(a.in[2], DIN, 256 * pn + 32 * (2 * wc + bj), a.in[1], WIN, DM, 32 * d, 64 * kb, scr, F.lane); continue; } r -= I_IN;
        if (r < I_GLU) { const int kb = r >> 4, d = r & 15; transpose_item(a.in[11], DSSM, 32 * d, nullptr, WGLU, DSSM, 32 * d, 64 * kb, scr, F.lane); continue; } r -= I_GLU;
        if (r < I_OUT) { const int kb = r >> 5, d = r & 31; const float* ks = (kb < 8) ? a.in[15] : (a.in[16] - 512);
            transpose_item(a.in[17], DM, 32 * d, ks, WOUT, DM, 32 * d, 64 * kb, scr, F.lane); continue; } r -= I_OUT;
        if (r < I_GU) { const int e = r >> 9, q = r & 511, kb = q >> 5, d = q & 31, pn = d >> 3, beta = d & 7;
            const float* W = (beta < 4 ? a.in[23] : a.in[24]) + (size_t)e * DM * DE;
            transpose_item(W, DE, 128 * pn + 32 * (beta & 3), a.in[18], WGU + (size_t)e * DM * DM, DM, 32 * d, 64 * kb, scr, F.lane); continue; } r -= I_GU;
        { const int e = r >> 8, q = r & 255, kb = q >> 5, d = q & 31;
          transpose_item(a.in[25] + (size_t)e * DE * DM, DM, 32 * d, nullptr, WD + (size_t)e * DM * DE, DE, 32 * d, 64 * kb, scr, F.lane); }
    }
    { bf16* WR = (bf16*)(a.ws + FW_WR);
      for (int idx = F.c * NTHR + F.tid; idx < 64 * DM; idx += F.G * NTHR) { const int n = idx >> 10, k = idx & 1023;
          float v = 0.f; if (n < 4) v = a.in[19][k * 4 + n]; else if (n < 36) v = a.in[21][k * 32 + (n - 4)];
          WR[idx] = (bf16)f2bf(v * a.in[18][k]); } }
    bf16* XN = (bf16*)(a.ws + FW_XN);
    for (int m = gw; m < M; m += NGW) {
        const f32x4* xr = (const f32x4*)(x + (size_t)m * DM) + F.lane;
        f32x4 v[4]; float s = 0.f;
#pragma unroll
        for (int j = 0; j < 4; ++j) { v[j] = xr[64 * j]; s += v[j].x * v[j].x + v[j].y * v[j].y + v[j].z * v[j].z + v[j].w * v[j].w; }
        const float rstd = 1.f / sqrtf(wave_sum(s) * (1.f / DM) + EPS);
        u32x2* o = (u32x2*)(XN + (size_t)m * DM) + F.lane;
#pragma unroll
        for (int j = 0; j < 4; ++j) { u32x2 w; w.x = cvtpk(v[j].x * rstd, v[j].y * rstd); w.y = cvtpk(v[j].z * rstd, v[j].w * rstd); o[64 * j] = w; }
    }
}

__device__ __forceinline__ void s5_scan(Frame& F, const Args& a) {
    const float* SST = (const float*)(a.ws + FW_SST); bf16* U2 = (bf16*)(a.ws + FW_U2);
    for (int idx = F.c * NTHR + F.tid; idx < BATCH * NG * PST; idx += F.G * NTHR) {
        const int p = idx & 63, g = (idx >> 6) & 31, b = idx >> 11;
        const double dt = exp((double)a.in[5][g]), lr = a.in[3][g * PST + p], li = a.in[4][g * PST + p];
        double sn, cs; sincos_d(32.0 * li * dt, sn, cs); const double mag = exp(32.0 * lr * dt);
        const float ar = (float)(mag * cs), ai = (float)(mag * sn);
        float xr = 0.f, xi = 0.f;
        const size_t row0 = (size_t)g * NCH + (size_t)b * 64;
        for (int c0 = 0; c0 < 64; c0 += 16) {
            float sr[16], si[16];
#pragma unroll
            for (int j = 0; j < 16; ++j) { sr[j] = SST[(row0 + c0 + j) * 128 + p]; si[j] = SST[(row0 + c0 + j) * 128 + 64 + p]; }
#pragma unroll
            for (int j = 0; j < 16; ++j) { bf16* up = U2 + (row0 + c0 + j) * U2P + 512; up[p] = (bf16)f2bf(xr); up[64 + p] = (bf16)f2bf(xi);
                const float t = ar * xr - ai * xi + sr[j]; xi = ar * xi + ai * xr + si[j]; xr = t; }
        }
    }
}

constexpr float ATT_THR = -100.f;
__device__ __forceinline__ s16x4 vtr(const LAS unsigned char* p) { typedef short v4i16_t __attribute__((ext_vector_type(4))); return __builtin_bit_cast(s16x4, __builtin_amdgcn_ds_read_tr16_b64_v4i16((LAS v4i16_t*)p)); }
__device__ __forceinline__ int crow(int r, int hi) { return (r & 3) + 8 * (r >> 2) + 4 * hi; }
#define MFMA32(a, b, c) __builtin_amdgcn_mfma_f32_32x32x16_bf16((a), (b), (c), 0, 0, 0)
template <bool DIAG, int P>
__device__ __forceinline__ float attn_half(const LAS unsigned char* Kb, const LAS unsigned char* Vb, const bf16x8 (&qr)[4], const bf16x8 (&tri)[2], f32x16 (&o)[2], float base, int lim, int lane) {
    const int r32 = lane & 31, hi = lane >> 5;
    const LAS unsigned char* kp = Kb + hi * 1024 + r32 * 16 + P * 512;
    const int lim2 = lim - 4 * hi;
    f32x16 z = {};
#pragma unroll
    for (int d0 = 0; d0 < 4; ++d0) { const bf16x8 kf = *(const LAS bf16x8*)(kp + d0 * 2048); z = MFMA32(kf, qr[d0], z); }
    float l[16];
#pragma unroll
    for (int r = 0; r < 16; ++r) { l[r] = -__builtin_amdgcn_logf(1.f + __builtin_amdgcn_exp2f(z[r])); if (DIAG) { if (!((r & 3) + 8 * (r >> 2) + 32 * P < lim2)) l[r] = 0.f; } }
    const bf16x8 ones = {(short)0x3F80, (short)0x3F80, (short)0x3F80, (short)0x3F80, (short)0x3F80, (short)0x3F80, (short)0x3F80, (short)0x3F80};
    u32x4 wa, wb;
    wa.x = cvtpk(l[0], l[1]); wa.y = cvtpk(l[2], l[3]); wa.z = cvtpk(l[4], l[5]); wa.w = cvtpk(l[6], l[7]);
    wb.x = cvtpk(l[8], l[9]); wb.y = cvtpk(l[10], l[11]); wb.z = cvtpk(l[12], l[13]); wb.w = cvtpk(l[14], l[15]);
    const bf16x8 La = __builtin_bit_cast(bf16x8, wa), Lb = __builtin_bit_cast(bf16x8, wb);
    f32x16 T = {}, TT = {};
    T = MFMA32(tri[0], La, T); T = MFMA32(tri[1], Lb, T);
    TT = MFMA32(ones, La, TT); TT = MFMA32(ones, Lb, TT);
    float av[16];
#pragma unroll
    for (int r = 0; r < 16; ++r) { av[r] = __builtin_amdgcn_exp2f((z[r] + base) + T[r]); if (DIAG) { if (!((r & 3) + 8 * (r >> 2) + 32 * P < lim2)) av[r] = 0.f; } }
    wa.x = cvtpk(av[0], av[1]); wa.y = cvtpk(av[2], av[3]); wa.z = cvtpk(av[4], av[5]); wa.w = cvtpk(av[6], av[7]);
    wb.x = cvtpk(av[8], av[9]); wb.y = cvtpk(av[10], av[11]); wb.z = cvtpk(av[12], av[13]); wb.w = cvtpk(av[14], av[15]);
    const bf16x8 Pa = __builtin_bit_cast(bf16x8, wa), Pb = __builtin_bit_cast(bf16x8, wb);
    const LAS unsigned char* vp = Vb + ((lane >> 4) & 1) * 32 + (lane & 3) * 8 + (4 * hi + ((lane & 15) >> 2)) * 64 + P * 2048;
#pragma unroll
    for (int d0 = 0; d0 < 2; ++d0) {
        const s16x4 lo0 = vtr(vp + d0 * 4096), hi0 = vtr(vp + d0 * 4096 + 512), lo1 = vtr(vp + d0 * 4096 + 1024), hi1 = vtr(vp + d0 * 4096 + 1536);
        const bf16x8 v0 = {lo0[0], lo0[1], lo0[2], lo0[3], hi0[0], hi0[1], hi0[2], hi0[3]}, v1 = {lo1[0], lo1[1], lo1[2], lo1[3], hi1[0], hi1[1], hi1[2], hi1[3]};
        o[d0] = MFMA32(Pa, v0, o[d0]); o[d0] = MFMA32(Pb, v1, o[d0]);
    }
    return TT[0];
}
template <bool DIAG>
__device__ __forceinline__ void attn_tile(const LAS unsigned char* Kb, const LAS unsigned char* Vb, const bf16x8 (&qr)[4], const bf16x8 (&tri)[2], f32x16 (&o)[2], float& Rc, int lim, int lane) {
    const float s1 = attn_half<DIAG, 1>(Kb, Vb, qr, tri, o, Rc, lim, lane);
    const float s0 = attn_half<DIAG, 0>(Kb, Vb, qr, tri, o, Rc + s1, lim, lane);
    Rc += s1 + s0;
}
__device__ __forceinline__ void attn_unit(Frame& F, const bf16* Q, const bf16* Kg, const bf16* Vg, bf16* YA, int b, int h, int qb) {
    const int tid = F.tid, lane = F.lane, wid = F.wave, r32 = lane & 31, hi = lane >> 5;
    LAS unsigned char* KB0 = F.lds; LAS unsigned char* VB0 = F.lds + 16384; volatile LAS int* FLG = (volatile LAS int*)(F.lds + 32768);
    const size_t row0 = (size_t)b * SEQ; const int q0 = qb * 256, qg = q0 + 32 * wid + r32;
    bf16x8 qr[4];
#pragma unroll
    for (int d0 = 0; d0 < 4; ++d0) qr[d0] = *(const bf16x8*)(Q + (row0 + qg) * DATT + h * HD + d0 * 16 + hi * 8);
    bf16x8 tri[2];
#pragma unroll
    for (int s = 0; s < 2; ++s)
#pragma unroll
        for (int j = 0; j < 8; ++j) tri[s][j] = ((16 * s + 8 * (j >> 2) + 4 * hi + (j & 3)) >= r32) ? (short)0x3F80 : (short)0;
    f32x16 o[2] = {}; float Rc = 0.f;
    const int jt = 4 * qb + 3, jd = 4 * qb + (wid >> 1);
    bool done = false;
    const bf16* ksrc = Kg + (row0 + lane) * DATT + h * HD + wid * 8;
    const bf16* vsrc = Vg + (row0 + 16 * (wid & 3) + (lane >> 2)) * DATT + h * HD + (wid >> 2) * 32 + (lane & 3) * 8;
    u32x4 kreg = *(const u32x4*)(ksrc + (size_t)jt * 64 * DATT), vreg = *(const u32x4*)(vsrc + (size_t)jt * 64 * DATT);
    for (int j = jt;; --j) {
        const int buf = (jt - j) & 1;
        LAS unsigned char* Kb = KB0 + buf * 8192; LAS unsigned char* Vb = VB0 + buf * 8192;
        *(LAS u32x4*)(Kb + wid * 1024 + lane * 16) = kreg; *(LAS u32x4*)(Vb + wid * 1024 + lane * 16) = vreg;
        __syncthreads();
        if (j > 0) { kreg = *(const u32x4*)(ksrc + (size_t)(j - 1) * 64 * DATT); vreg = *(const u32x4*)(vsrc + (size_t)(j - 1) * 64 * DATT); }
        if (!done && j <= jd) {
            const int lim = qg - 64 * j;
            if (64 * j + 63 >= q0 + 32 * wid) attn_tile<true>(Kb, Vb, qr, tri, o, Rc, lim, lane);
            else attn_tile<false>(Kb, Vb, qr, tri, o, Rc, lim, lane);
            done = __all(Rc < ATT_THR);
        }
        if (lane == 0) FLG[wid] = done ? 1 : 0;
        __syncthreads();
        if (j == 0) break;
        int alld = 1;
#pragma unroll
        for (int w = 0; w < 8; ++w) alld &= FLG[w];
        if (alld) break;
    }
    { LAS unsigned char* stg = F.lds + 40960 + wid * 4096; LAS unsigned short* sp = (LAS unsigned short*)(stg + hi * 512 + r32 * 2);
#pragma unroll
      for (int r = 0; r < 16; ++r) { const int ro = ((r & 3) + 8 * (r >> 2)) * 64; sp[ro] = (unsigned short)f2bf(o[0][r]); sp[ro + 32] = (unsigned short)f2bf(o[1][r]); }
      asm volatile("s_waitcnt lgkmcnt(0)" ::: "memory");
      bf16* ow = YA + (row0 + q0 + 32 * wid) * DATT + h * HD;
#pragma unroll
      for (int i = 0; i < 4; ++i) { const int row = i * 8 + (lane >> 3), ch = lane & 7; const u32x4 v = *(const LAS u32x4*)(stg + row * 128 + ch * 16); *(u32x4*)(ow + (size_t)row * DATT + ch * 8) = v; } }
    __syncthreads();
}

__device__ __forceinline__ void mixnorm(Frame& F, const Args& a) {
    const bf16* YS = (const bf16*)(a.ws + FW_YS); const bf16* YA = (const bf16*)(a.ws + FW_YA); bf16* MIX = (bf16*)(a.ws + FW_MIX);
    const int gw = F.c * NWAVES + F.wave, NGW = F.G * NWAVES, lane = F.lane;
    for (int m = gw; m < M; m += NGW) {
#pragma unroll
        for (int half = 0; half < 2; ++half) {
            const u32x4 w = *(const u32x4*)((half ? YA : YS) + (size_t)m * 512 + lane * 8); float v[8];
            v[0] = bf2f(w.x & 0xffff); v[1] = bf2f(w.x >> 16); v[2] = bf2f(w.y & 0xffff); v[3] = bf2f(w.y >> 16); v[4] = bf2f(w.z & 0xffff); v[5] = bf2f(w.z >> 16); v[6] = bf2f(w.w & 0xffff); v[7] = bf2f(w.w >> 16);
            float s = 0.f;
#pragma unroll
            for (int i = 0; i < 8; ++i) s += v[i] * v[i];
            const float rstd = 1.f / sqrtf(wave_sum(s) * (1.f / 512.f) + EPS);
            u32x4 o; o.x = cvtpk(v[0] * rstd, v[1] * rstd); o.y = cvtpk(v[2] * rstd, v[3] * rstd); o.z = cvtpk(v[4] * rstd, v[5] * rstd); o.w = cvtpk(v[6] * rstd, v[7] * rstd);
            *(u32x4*)(MIX + (size_t)m * DM + half * 512 + lane * 8) = o;
        }
    }
}

constexpr int RT_PITCH = 2064;
__device__ __forceinline__ void router_phase(Frame& F, const Args& a) {
    const float* x1 = a.out; bf16* H2 = (bf16*)(a.ws + FW_H2); int* TOK = (int*)(a.ws + FW_TOK); const bf16* WR = (const bf16*)(a.ws + FW_WR);
    const float* brg = a.in[20]; const float* bre_ = a.in[22];
    const int tid = F.tid, lane = F.lane, wid = F.wave, r32 = lane & 31, hi = lane >> 5;
    LAS unsigned char* TILE = F.lds;
    LAS float* PART = (LAS float*)(F.lds + 66048);
    LAS float* LOGIT = (LAS float*)(F.lds + 66048 + 65536);
    LAS int* HIST = (LAS int*)(F.lds + 66048 + 65536 + 5120);
    LAS int* TREC = HIST + 64;
    static_assert(66048 + 65536 + 5120 + 256 + 4096 <= MISC_OFF, "router LDS");
    bf16x8 Bf[8][2];
#pragma unroll
    for (int s = 0; s < 8; ++s)
#pragma unroll
        for (int nb = 0; nb < 2; ++nb) Bf[s][nb] = *(const bf16x8*)(WR + (size_t)(32 * nb + r32) * DM + 128 * wid + 16 * s + 8 * hi);
    if (tid < 64) HIST[tid] = 0;
    __syncthreads();
    int ntl = 0;
    for (int tile = F.c; tile < M / 32; tile += F.G, ++ntl) {
#pragma unroll
        for (int rr = 0; rr < 4; ++rr) { const int lr = 4 * wid + rr, m = tile * 32 + lr;
            const f32x4* xr = (const f32x4*)(x1 + (size_t)m * DM) + lane;
            f32x4 v[4]; float s = 0.f;
#pragma unroll
            for (int j = 0; j < 4; ++j) { v[j] = xr[64 * j]; s += v[j].x * v[j].x + v[j].y * v[j].y + v[j].z * v[j].z + v[j].w * v[j].w; }
            const float rstd = 1.f / sqrtf(wave_sum(s) * (1.f / DM) + EPS);
#pragma unroll
            for (int j = 0; j < 4; ++j) { u32x2 w; w.x = cvtpk(v[j].x * rstd, v[j].y * rstd); w.y = cvtpk(v[j].z * rstd, v[j].w * rstd);
                ((u32x2*)(H2 + (size_t)m * DM))[64 * j + lane] = w; *(LAS u32x2*)(TILE + lr * RT_PITCH + (64 * j + lane) * 8) = w; }
        }
        __syncthreads();
        { f32x16 c0 = {}, c1 = {};
#pragma unroll
          for (int s = 0; s < 8; ++s) { const bf16x8 af = *(const LAS bf16x8*)(TILE + r32 * RT_PITCH + (128 * wid + 16 * s + 8 * hi) * 2);
              c0 = MFMA32(af, Bf[s][0], c0); c1 = MFMA32(af, Bf[s][1], c1); }
#pragma unroll
          for (int r = 0; r < 16; ++r) { const int t = crow(r, hi); PART[(wid * 32 + t) * 64 + r32] = c0[r]; PART[(wid * 32 + t) * 64 + 32 + r32] = c1[r]; } }
        __syncthreads();
        { const int t = tid >> 4, c4 = (tid & 15) * 4;
          if (c4 < 40) { f32x4 s = {0.f, 0.f, 0.f, 0.f};
#pragma unroll
              for (int w = 0; w < 8; ++w) s += *(const LAS f32x4*)(PART + (w * 32 + t) * 64 + c4);
              *(LAS f32x4*)(LOGIT + t * 40 + c4) = s; } }
        __syncthreads();
        if (tid < 32) { const int m = tile * 32 + tid; float lg[36];
#pragma unroll
            for (int c = 0; c < 36; ++c) lg[c] = LOGIT[tid * 40 + c] + (c < 4 ? brg[c] : bre_[c - 4]);
            int gi = 0; float gm = lg[0];
#pragma unroll
            for (int c = 1; c < 4; ++c) if (lg[c] > gm) { gm = lg[c]; gi = c; }
            float gsum = 0.f;
#pragma unroll
            for (int c = 0; c < 4; ++c) gsum += __expf(lg[c] - gm);
            const float pgrp = 1.f / gsum;
            float el[8];
#pragma unroll
            for (int e = 0; e < 8; ++e) { float t = 0.f;
#pragma unroll
                for (int g2 = 0; g2 < 4; ++g2) if (g2 == gi) t = lg[4 + g2 * 8 + e];
                el[e] = t; }
            int i0 = 0; float m0 = el[0];
#pragma unroll
            for (int e = 1; e < 8; ++e) if (el[e] > m0) { m0 = el[e]; i0 = e; }
            int i1 = 0; float m1 = -3.0e38f;
#pragma unroll
            for (int e = 0; e < 8; ++e) if (e != i0 && el[e] > m1) { m1 = el[e]; i1 = e; }
            const float e1 = __expf(m1 - m0), p0 = 1.f / (1.f + e1), p1 = e1 / (1.f + e1);
            const int ex0 = gi * 8 + i0, ex1 = gi * 8 + i1;
            const int rk0 = atomicAdd((int*)&HIST[ex0], 1), rk1 = atomicAdd((int*)&HIST[ex1], 1);
            int* tk = TOK + (size_t)m * 8; tk[0] = ex0; tk[1] = ex1; tk[2] = __float_as_int(pgrp * p0); tk[3] = __float_as_int(pgrp * p1);
            LAS int* tr = TREC + (ntl * 32 + tid) * 4; tr[0] = ex0; tr[1] = ex1; tr[2] = rk0; tr[3] = rk1;
        }
        __syncthreads();
    }
    if (tid < 32) { const int cnt = HIST[tid]; int base = 0; if (cnt > 0) base = (int)__hip_atomic_fetch_add(F.ctl + CW_CNT + tid, (unsigned)cnt, RLX_AGENT); HIST[32 + tid] = base; }
    __syncthreads();
    for (int i = tid; i < ntl * 32; i += NTHR) { const int tile = F.c + (i >> 5) * F.G, m = tile * 32 + (i & 31); const LAS int* tr = TREC + i * 4;
        int* tk = TOK + (size_t)m * 8; tk[4] = HIST[32 + tr[0]] + tr[2]; tk[5] = HIST[32 + tr[1]] + tr[3]; }
    __syncthreads();
}
__device__ __forceinline__ int moe_tables(Frame& F) {
    LAS int* TST = (LAS int*)(F.lds + SCR2_OFF); LAS unsigned char* T2E = F.lds + SCR2_OFF + 256;
    if (F.tid == 0) { int acc = 0;
        for (int e = 0; e < NE; ++e) { TST[e] = acc; const int cnt = (int)__hip_atomic_load(F.ctl + CW_CNT + e, RLX_AGENT); const int nt = (cnt + 255) >> 8;
            for (int t = 0; t < nt; ++t) T2E[acc + t] = (unsigned char)e; acc += nt; }
        TST[NE] = acc; }
    __syncthreads();
    return TST[NE];
}
__device__ __forceinline__ void gather_phase(Frame& F, const Args& a) {
    const bf16* H2 = (const bf16*)(a.ws + FW_H2); bf16* XG = (bf16*)(a.ws + FW_XG); const int* TOK = (const int*)(a.ws + FW_TOK);
    const LAS int* TST = (const LAS int*)(F.lds + SCR2_OFF);
    const int gw = F.c * NWAVES + F.wave, NGW = F.G * NWAVES, lane = F.lane;
    for (int m = gw; m < M; m += NGW) {
        const int* tk = TOK + (size_t)m * 8; const int e0 = tk[0], e1 = tk[1], s0 = tk[4], s1 = tk[5];
        const size_t p0 = (size_t)TST[e0] * 256 + s0, p1 = (size_t)TST[e1] * 256 + s1;
        const u32x4* src = (const u32x4*)(H2 + (size_t)m * DM); const u32x4 v0 = src[lane], v1 = src[64 + lane];
        u32x4* d0 = (u32x4*)(XG + p0 * DM); u32x4* d1 = (u32x4*)(XG + p1 * DM);
        d0[lane] = v0; d0[64 + lane] = v1; d1[lane] = v0; d1[64 + lane] = v1;
    }
}
__device__ __forceinline__ void combine_phase(Frame& F, const Args& a) {
    const bf16* YE = (const bf16*)(a.ws + FW_YE); const int* TOK = (const int*)(a.ws + FW_TOK); float* out = a.out;
    const LAS int* TST = (const LAS int*)(F.lds + SCR2_OFF);
    const int gw = F.c * NWAVES + F.wave, NGW = F.G * NWAVES, lane = F.lane;
    for (int m = gw; m < M; m += NGW) {
        const int* tk = TOK + (size_t)m * 8; const int e0 = tk[0], e1 = tk[1], s0 = tk[4], s1 = tk[5]; const float g0 = __int_as_float(tk[2]), g1 = __int_as_float(tk[3]);
        const size_t p0 = (size_t)TST[e0] * 256 + s0, p1 = (size_t)TST[e1] * 256 + s1;
        const u32x4* y0 = (const u32x4*)(YE + p0 * DM); const u32x4* y1 = (const u32x4*)(YE + p1 * DM);
        f32x4* o = (f32x4*)(out + (size_t)m * DM);
#pragma unroll
        for (int j = 0; j < 2; ++j) { const u32x4 a0 = y0[64 * j + lane], a1 = y1[64 * j + lane];
            f32x4 x0 = o[2 * (64 * j + lane)], x1v = o[2 * (64 * j + lane) + 1];
            x0.x += g0 * bf2f(a0.x & 0xffff) + g1 * bf2f(a1.x & 0xffff); x0.y += g0 * bf2f(a0.x >> 16) + g1 * bf2f(a1.x >> 16);
            x0.z += g0 * bf2f(a0.y & 0xffff) + g1 * bf2f(a1.y & 0xffff); x0.w += g0 * bf2f(a0.y >> 16) + g1 * bf2f(a1.y >> 16);
            x1v.x += g0 * bf2f(a0.z & 0xffff) + g1 * bf2f(a1.z & 0xffff); x1v.y += g0 * bf2f(a0.z >> 16) + g1 * bf2f(a1.z >> 16);
            x1v.z += g0 * bf2f(a0.w & 0xffff) + g1 * bf2f(a1.w & 0xffff); x1v.w += g0 * bf2f(a0.w >> 16) + g1 * bf2f(a1.w >> 16);
            o[2 * (64 * j + lane)] = x0; o[2 * (64 * j + lane) + 1] = x1v; }
    }
}

constexpr int NPHASE = 13;
__global__ void __launch_bounds__(NTHR, 2) mk_fwd(Args args) {
    extern __shared__ __attribute__((aligned(16))) unsigned char lds_raw[];
    Frame F;
    F.lds = (LAS unsigned char*)lds_raw; F.MISC = (volatile LAS unsigned*)(F.lds + MISC_OFF);
    F.tid = threadIdx.x; F.lane = F.tid & 63; F.wave = __builtin_amdgcn_readfirstlane(F.tid >> 6);
    F.G = gridDim.x; F.c = blockIdx.x; F.ctl = (unsigned*)(args.ws + WS_CTL);
    if (F.tid < 64) F.MISC[F.tid] = 0u;
    __syncthreads();
    XcdBarrier bar = xcd_barrier_post(F.ctl + CW_BAR, F.MISC + 8);
    const int lo = args.ph_lo, hi = args.ph_hi;
    unsigned char* ws = args.ws;
#ifndef PH_MASK
#define PH_MASK 0x1fff
#endif
#define IN(k) ((((PH_MASK) >> (k)) & 1) && lo <= (k) && (k) < hi)
#define SEAM(k) do { if (IN(k) && IN((k) + 1)) xcd_barrier(bar); } while (0)
    if (IN(0)) { p0_prologue(F, args); } SEAM(0);
    if (IN(1)) {
        GemmP g{DM * 2, DM * 2, DM}; DenseOrder S{(const char*)(ws + FW_XN), (const char*)(ws + FW_WIN), (size_t)256 * DM * 2, (size_t)256 * DM * 2, M / 256, DIN / 256, (M / 256) * (DIN / 256), F.G, F.c};
        EpiProj E{(bf16*)(ws + FW_U2), (bf16*)(ws + FW_Q), args.in[13], args.in[14]};
        gemm_phase(F.lds, g, S, E); } SEAM(1);
    if (IN(2)) {
        GemmP g{U2P * 2, 512 * 2, 512}; GroupOrder S{(const char*)(ws + FW_U2), (const char*)(ws + FW_W1), (size_t)NCH * U2P * 2, (size_t)256 * 512 * 2, (size_t)256 * U2P * 2, 0, NCH / 256, 1, NG * (NCH / 256), F.G, F.c};
        EpiState E{(float*)(ws + FW_SST)};
        gemm_phase(F.lds, g, S, E); } SEAM(2);
    if (IN(3)) {
#ifndef NO_SCAN
        s5_scan(F, args);
#endif
#ifndef NO_ATTN
        const bf16* Q = (const bf16*)(ws + FW_Q); const bf16* Kg = (const bf16*)(ws + FW_K); const bf16* Vg = (const bf16*)(ws + FW_V); bf16* YA = (bf16*)(ws + FW_YA);
        for (int L = F.c; L < BATCH * NH * 8; L += F.G) { const int bh = L >> 3, qb = L & 7; attn_unit(F, Q, Kg, Vg, YA, bh >> 3, bh & 7, qb); }
#endif
    } SEAM(3);
    if (IN(4)) {
        GemmP g{U2P * 2, U2P * 2, U2P}; GroupOrder S{(const char*)(ws + FW_U2), (const char*)(ws + FW_TB), (size_t)NCH * U2P * 2, (size_t)512 * U2P * 2, (size_t)256 * U2P * 2, (size_t)256 * U2P * 2, NCH / 256, 2, NG * (NCH / 256) * 2, F.G, F.c};
        EpiS5 E{(bf16*)(ws + FW_Z)};
        gemm_phase(F.lds, g, S, E); } SEAM(4);
    if (IN(5)) {
        GemmP g{DSSM * 2, DSSM * 2, DSSM}; DenseOrder S{(const char*)(ws + FW_Z), (const char*)(ws + FW_WGLU), (size_t)256 * DSSM * 2, (size_t)256 * DSSM * 2, M / 256, 2, (M / 256) * 2, F.G, F.c};
        EpiGlu E{(const bf16*)(ws + FW_Z), args.in[12], (bf16*)(ws + FW_YS)};
        gemm_phase(F.lds, g, S, E); } SEAM(5);
    if (IN(6)) { mixnorm(F, args); } SEAM(6);
    if (IN(7)) {
        GemmP g{DM * 2, DM * 2, DM}; DenseOrder S{(const char*)(ws + FW_MIX), (const char*)(ws + FW_WOUT), (size_t)256 * DM * 2, (size_t)256 * DM * 2, M / 256, 4, (M / 256) * 4, F.G, F.c};
        EpiOut E{args.in[0], args.out};
        gemm_phase(F.lds, g, S, E); } SEAM(7);
    if (IN(8)) { router_phase(F, args); } SEAM(8);
    int ntiles = 0;
    if (IN(9) || IN(10) || IN(11) || IN(12)) ntiles = moe_tables(F);
    if (IN(9)) { gather_phase(F, args); } SEAM(9);
    if (IN(10)) {
        GemmP g{DM * 2, DM * 2, DM}; MoeOrder S{(const char*)(ws + FW_XG), (const char*)(ws + FW_WGU), (size_t)256 * DM * 2, (size_t)DM * DM * 2, (size_t)256 * DM * 2, F.lds + SCR2_OFF + 256, ntiles, F.G, F.c};
        EpiGU E{(bf16*)(ws + FW_HH)};
        gemm_phase(F.lds, g, S, E); } SEAM(10);
    if (IN(11)) {
        GemmP g{DE * 2, DE * 2, DE}; MoeOrder S{(const char*)(ws + FW_HH), (const char*)(ws + FW_WD), (size_t)256 * DE * 2, (size_t)DM * DE * 2, (size_t)256 * DE * 2, F.lds + SCR2_OFF + 256, ntiles, F.G, F.c};
        EpiDown E{(bf16*)(ws + FW_YE)};
        gemm_phase(F.lds, g, S, E); } SEAM(11);
    if (IN(12)) { combine_phase(F, args); }
#undef IN
#undef SEAM
}
}

#ifndef FAST_UPTO
#define FAST_UPTO 12
#endif
#ifndef NAIVE_ATTN_OVERRIDE
#define NAIVE_ATTN_OVERRIDE 0
#endif
#ifndef NAIVE_S5_OVERRIDE
#define NAIVE_S5_OVERRIDE 0
#endif
extern "C" void kernel_launch(void* const* d_in, const int* in_sizes, int n_in, void* d_out, int out_size, void* d_ws, size_t ws_size, hipStream_t stream) {
    static int grid = 0;
    if (grid == 0) {
        if (n_in != 26 || out_size != M * DM || ws_size < mk::FW_END) { fprintf(stderr, "kernel_launch: unexpected shapes (n_in %d out %d ws %zu, need %zu)\n", n_in, out_size, ws_size, (size_t)mk::FW_END); grid = -1; return; }
        int dev = 0, cus = 0, per_cu = 0;
        if (hipGetDevice(&dev) != hipSuccess || hipDeviceGetAttribute(&cus, hipDeviceAttributeMultiprocessorCount, dev) != hipSuccess) { grid = -1; return; }
        if (hipFuncSetAttribute((const void*)mk::mk_fwd, hipFuncAttributeMaxDynamicSharedMemorySize, mk::LDS_BYTES) != hipSuccess) { fprintf(stderr, "kernel_launch: hipFuncSetAttribute failed\n"); grid = -1; return; }
        if (hipOccupancyMaxActiveBlocksPerMultiprocessor(&per_cu, (const void*)mk::mk_fwd, mk::NTHR, mk::LDS_BYTES) != hipSuccess || per_cu < 1) { fprintf(stderr, "kernel_launch: occupancy query says %d\n", per_cu); }
        (void)hipGetLastError();
        grid = cus;
        if (grid != 256) fprintf(stderr, "kernel_launch: %d CUs (built for 256)\n", grid);
    }
    if (grid < 0) return;
    const float* const* in = (const float* const*)d_in;
    unsigned char* ws = (unsigned char*)d_ws; float* out = (float*)d_out;
    mk::Args a{};
    for (int i = 0; i < 26; ++i) a.in[i] = in[i];
    a.out = out; a.ws = ws;
    auto launch = [&](int lo, int hi) {
        (void)hipMemsetAsync(ws + WS_CTL, 0, mk::CTL_ZERO_BYTES, stream);
        a.ph_lo = lo; a.ph_hi = hi;
        hipLaunchKernelGGL(mk::mk_fwd, dim3(grid), dim3(mk::NTHR), mk::LDS_BYTES, stream, a);
    };
#if FAST_UPTO == 12 && !NAIVE_ATTN_OVERRIDE && !NAIVE_S5_OVERRIDE
    launch(0, mk::NPHASE);
#else
    bf16* Q = (bf16*)(ws + mk::FW_Q); bf16* Kb = (bf16*)(ws + mk::FW_K); bf16* V = (bf16*)(ws + mk::FW_V); bf16* U2 = (bf16*)(ws + mk::FW_U2);
    bf16* Z = (bf16*)(ws + mk::FW_Z); bf16* YS = (bf16*)(ws + mk::FW_YS); bf16* YA = (bf16*)(ws + mk::FW_YA); bf16* MIX = (bf16*)(ws + mk::FW_MIX); bf16* H2 = (bf16*)(ws + mk::FW_H2);
    int* TOK = (int*)(ws + mk::FW_TOK);
    launch(0, (FAST_UPTO < 5 ? FAST_UPTO : 5) + 1);
    if (FAST_UPTO < 5 || NAIVE_S5_OVERRIDE) {
        nv::k_s5<<<BATCH * NG, 64, 0, stream>>>(U2, in[3], in[4], in[5], in[6], in[7], in[8], in[9], in[10], Z);
        nv::GArgs g{}; g.A = Z; g.lda = DSSM; g.ascale = nullptr; g.B = in[11]; g.ldb = DSSM; g.K = DSSM; g.ldc = DSSM; g.bias = in[12]; g.Zin = Z; g.Ob = YS;
        nv::k_gemm<1><<<dim3(DSSM / 64, M / 64), 256, 0, stream>>>(g);
    }
    if (FAST_UPTO < 3 || NAIVE_ATTN_OVERRIDE) nv::k_attn<<<dim3(SEQ / 64, NH, BATCH), 64, 0, stream>>>(Q, Kb, V, YA);
    if (FAST_UPTO >= 7) launch(6, 8);
    else {
        nv::k_mixnorm<<<2048, 256, 0, stream>>>(YS, YA, in[15], in[16], MIX, 1);
        nv::GArgs g{}; g.A = MIX; g.lda = DM; g.ascale = nullptr; g.B = in[17]; g.ldb = DM; g.K = DM; g.ldc = DM; g.X = in[0]; g.Out = out;
        nv::k_gemm<2><<<dim3(DM / 64, M / 64), 256, 0, stream>>>(g);
    }
    if (FAST_UPTO >= 12) launch(8, 13);
    else {
        nv::k_router<<<2048, 256, 0, stream>>>(out, in[18], in[19], in[20], in[21], in[22], H2, TOK, 1);
        nv::k_moe<<<M, 256, 0, stream>>>(H2, TOK, in[23], in[24], in[25], out);
    }
#endif
}
```

```cpp
#define FAST_UPTO 12

#include <hip/hip_runtime.h>
#include <cstdio>
#include <cstdint>

typedef unsigned short bf16;
typedef float f32x4 __attribute__((ext_vector_type(4)));
typedef unsigned u32x4 __attribute__((ext_vector_type(4)));
typedef unsigned u32x2 __attribute__((ext_vector_type(2)));

constexpr int DM = 1024, BATCH = 32, SEQ = 2048, M = BATCH * SEQ;
constexpr int DSSM = 512, NG = 32, GS = 16, PST = 64, HD = 64, DATT = 512, NH = 8, DIN = 2048;
constexpr int NEG = 4, EPG = 8, NE = 32, DE = 512;
constexpr float EPS = 1e-6f;
constexpr int LCH = 32;
constexpr int NCH = M / LCH;
constexpr int U2P = 640;
constexpr float C2 = 0.125f * 1.4426950408889634f;

constexpr size_t MiB = 1u << 20;
constexpr size_t WS_CTL = 0;
constexpr size_t WS_TOK = 2 * MiB;
constexpr size_t WS_XN = 8 * MiB;
constexpr size_t WS_Q = WS_XN + 128 * MiB;
constexpr size_t WS_K = WS_Q + 64 * MiB;
constexpr size_t WS_V = WS_K + 64 * MiB;
constexpr size_t WS_U2 = WS_V + 64 * MiB;
constexpr size_t WS_Z = WS_U2 + 80 * MiB;
constexpr size_t WS_YS = WS_Z + 64 * MiB;
constexpr size_t WS_YA = WS_YS + 64 * MiB;
constexpr size_t WS_MIX = WS_YA + 64 * MiB;
constexpr size_t WS_H2 = WS_XN;
constexpr size_t WS_PROJ = WS_Z;
constexpr size_t WS_END = WS_PROJ + 512 * MiB;

__device__ __forceinline__ unsigned f2bf(float f) { unsigned u = __builtin_bit_cast(unsigned, f); return (u + 0x7fffu + ((u >> 16) & 1u)) >> 16; }
__device__ __forceinline__ float bf2f(unsigned short h) { return __builtin_bit_cast(float, (unsigned)h << 16); }
__device__ __forceinline__ unsigned pk2(float lo, float hi) { return f2bf(lo) | (f2bf(hi) << 16); }
__device__ __forceinline__ float wave_sum(float v) {
#pragma unroll
    for (int o = 1; o < 64; o <<= 1) v += __shfl_xor(v, o);
    return v;
}
__device__ __forceinline__ void sincos_d(double th, double& s, double& c) {
    const double q = rint(th * 0.63661977236758134308);
    const double r = (th - q * 1.57079632679489655800) - q * 6.12323399573676603587e-17;
    const double r2 = r * r;
    double sp = -1.0 / 1307674368000.0; sp = sp * r2 + 1.0 / 6227020800.0; sp = sp * r2 - 1.0 / 39916800.0; sp = sp * r2 + 1.0 / 362880.0; sp = sp * r2 - 1.0 / 5040.0; sp = sp * r2 + 1.0 / 120.0; sp = sp * r2 - 1.0 / 6.0; sp = sp * r2 + 1.0;
    const double sn = sp * r;
    double cp = 1.0 / 20922789888000.0; cp = cp * r2 - 1.0 / 87178291200.0; cp = cp * r2 + 1.0 / 479001600.0; cp = cp * r2 - 1.0 / 3628800.0; cp = cp * r2 + 1.0 / 40320.0; cp = cp * r2 - 1.0 / 720.0; cp = cp * r2 + 1.0 / 24.0; cp = cp * r2 - 0.5; cp = cp * r2 + 1.0;
    const int qi = ((int)q) & 3;
    s = (qi == 0) ? sn : (qi == 1) ? cp : (qi == 2) ? -sn : -cp;
    c = (qi == 0) ? cp : (qi == 1) ? -sn : (qi == 2) ? -cp : sn;
}
__device__ __forceinline__ float gelu_tanh(float x) {
    const float u = 0.7978845608028654f * (x + 0.044715f * x * x * x);
    const float e = __expf(2.f * u);
    const float t = 1.f - 2.f / (e + 1.f);
    return 0.5f * x * (1.f + t);
}
__device__ __forceinline__ float sigmoidf_(float x) { return 1.f / (1.f + __expf(-x)); }

namespace nv {
__global__ __launch_bounds__(256) void k_xn(const float* __restrict__ x, bf16* __restrict__ xn) {
    const int lane = threadIdx.x & 63, gw = (blockIdx.x * 256 + threadIdx.x) >> 6, ngw = gridDim.x * 4;
    for (int m = gw; m < M; m += ngw) {
        const f32x4* xr = (const f32x4*)(x + (size_t)m * DM) + lane;
        f32x4 v[4]; float s = 0.f;
#pragma unroll
        for (int j = 0; j < 4; ++j) { v[j] = xr[64 * j]; s += v[j].x * v[j].x + v[j].y * v[j].y + v[j].z * v[j].z + v[j].w * v[j].w; }
        const float rstd = 1.f / sqrtf(wave_sum(s) * (1.f / DM) + EPS);
        u32x2* o = (u32x2*)(xn + (size_t)m * DM) + lane;
#pragma unroll
        for (int j = 0; j < 4; ++j) { u32x2 w; w.x = pk2(v[j].x * rstd, v[j].y * rstd); w.y = pk2(v[j].z * rstd, v[j].w * rstd); o[64 * j] = w; }
    }
}
struct GArgs { const bf16* A; int lda; const float* ascale; const float* B; int ldb; int K; float* Cf; int ldc; const float* bias; const bf16* Zin; bf16* Ob; const float* X; float* Out; };
template <int EPI> __global__ __launch_bounds__(256) void k_gemm(GArgs g) {
    __shared__ float As[16][68], Bs[16][68];
    const int tid = threadIdx.x, tx = tid & 15, ty = tid >> 4, m0 = blockIdx.y * 64, n0 = blockIdx.x * 64;
    float acc[4][4] = {};
    for (int k0 = 0; k0 < g.K; k0 += 16) {
        { const int r = tid >> 2, kk = (tid & 3) * 4; const u32x2 w = *(const u32x2*)(g.A + (size_t)(m0 + r) * g.lda + k0 + kk);
          float a0 = bf2f(w.x & 0xffff), a1 = bf2f(w.x >> 16), a2 = bf2f(w.y & 0xffff), a3 = bf2f(w.y >> 16);
          if (g.ascale) { a0 *= g.ascale[k0 + kk]; a1 *= g.ascale[k0 + kk + 1]; a2 *= g.ascale[k0 + kk + 2]; a3 *= g.ascale[k0 + kk + 3]; }
          As[kk][r] = a0; As[kk + 1][r] = a1; As[kk + 2][r] = a2; As[kk + 3][r] = a3; }
        { const int kk = tid >> 4, nn = (tid & 15) * 4; const f32x4 b = *(const f32x4*)(g.B + (size_t)(k0 + kk) * g.ldb + n0 + nn);
          Bs[kk][nn] = b.x; Bs[kk][nn + 1] = b.y; Bs[kk][nn + 2] = b.z; Bs[kk][nn + 3] = b.w; }
        __syncthreads();
#pragma unroll
        for (int k = 0; k < 16; ++k) { float a[4], b[4];
#pragma unroll
            for (int i = 0; i < 4; ++i) { a[i] = As[k][ty * 4 + i]; b[i] = Bs[k][tx * 4 + i]; }
#pragma unroll
            for (int i = 0; i < 4; ++i)
#pragma unroll
                for (int j = 0; j < 4; ++j) acc[i][j] += a[i] * b[j]; }
        __syncthreads();
    }
#pragma unroll
    for (int i = 0; i < 4; ++i) { const int m = m0 + ty * 4 + i;
#pragma unroll
        for (int j = 0; j < 4; ++j) { const int n = n0 + tx * 4 + j; const float v = acc[i][j];
            if (EPI == 0) g.Cf[(size_t)m * g.ldc + n] = v;
            else if (EPI == 1) { const float z = bf2f(g.Zin[(size_t)m * g.ldc + n]); g.Ob[(size_t)m * g.ldc + n] = (bf16)f2bf(z * sigmoidf_(v + g.bias[n])); }
            else if (EPI == 2) g.Out[(size_t)m * g.ldc + n] = g.X[(size_t)m * g.ldc + n] + v; } }
}
__global__ __launch_bounds__(256) void k_projpost(const float* __restrict__ P, const float* __restrict__ gq, const float* __restrict__ gk, bf16* U2, bf16* Q, bf16* Kb, bf16* V) {
    const int lane = threadIdx.x & 63, gw = (blockIdx.x * 256 + threadIdx.x) >> 6, ngw = gridDim.x * 4;
    for (int m = gw; m < M; m += ngw) {
        const float* pr = P + (size_t)m * DIN;
        for (int c = 0; c < 32; ++c) {
            const float v = pr[c * 64 + lane];
            if (c < 8) { const int ch = c * 64 + lane, g = ch >> 4, h = ch & 15; U2[((size_t)g * NCH + (m >> 5)) * U2P + (m & 31) * 16 + h] = (bf16)f2bf(v); }
            else if (c < 24) { const float rstd = 1.f / sqrtf(wave_sum(v * v) * (1.f / 64.f) + EPS);
                if (c < 16) Q[(size_t)m * DATT + (c - 8) * 64 + lane] = (bf16)f2bf(v * rstd * gq[lane] * C2);
                else Kb[(size_t)m * DATT + (c - 16) * 64 + lane] = (bf16)f2bf(v * rstd * gk[lane]); }
            else V[(size_t)m * DATT + (c - 24) * 64 + lane] = (bf16)f2bf(v);
        }
    }
}
__global__ __launch_bounds__(64) void k_s5(const bf16* __restrict__ U2, const float* lre, const float* lim, const float* ldt, const float* bre, const float* bim, const float* cre, const float* cim, const float* dsk, bf16* Z) {
    const int p = threadIdx.x, b = blockIdx.x >> 5, g = blockIdx.x & 31;
    const double dt = exp((double)ldt[g]), lr = lre[g * PST + p], li = lim[g * PST + p];
    double sn, cs; sincos_d(li * dt, sn, cs); const double mag = exp(lr * dt);
    const double ar = mag * cs, ai = mag * sn, den = lr * lr + li * li, nr = ar - 1.0, ni = ai;
    const double cfr = (nr * lr + ni * li) / den, cfi = (ni * lr - nr * li) / den;
    const float far = (float)ar, fai = (float)ai;
    float bbr[16], bbi[16], ccr[16], cci[16];
#pragma unroll
    for (int h = 0; h < 16; ++h) { const double br = bre[(g * PST + p) * GS + h], bi = bim[(g * PST + p) * GS + h];
        bbr[h] = (float)(cfr * br - cfi * bi); bbi[h] = (float)(cfr * bi + cfi * br);
        ccr[h] = cre[(g * GS + h) * PST + p]; cci[h] = cim[(g * GS + h) * PST + p]; }
    const float dme = dsk[g * GS + (p & 15)];
    float xr = 0.f, xi = 0.f;
    for (int t = 0; t < SEQ; ++t) {
        const int m = b * SEQ + t;
        const bf16* up = U2 + ((size_t)g * NCH + (m >> 5)) * U2P + (m & 31) * 16;
        const u32x4 w0 = *(const u32x4*)up, w1 = *(const u32x4*)(up + 8);
        float u[16];
        u[0] = bf2f(w0.x & 0xffff); u[1] = bf2f(w0.x >> 16); u[2] = bf2f(w0.y & 0xffff); u[3] = bf2f(w0.y >> 16); u[4] = bf2f(w0.z & 0xffff); u[5] = bf2f(w0.z >> 16); u[6] = bf2f(w0.w & 0xffff); u[7] = bf2f(w0.w >> 16);
        u[8] = bf2f(w1.x & 0xffff); u[9] = bf2f(w1.x >> 16); u[10] = bf2f(w1.y & 0xffff); u[11] = bf2f(w1.y >> 16); u[12] = bf2f(w1.z & 0xffff); u[13] = bf2f(w1.z >> 16); u[14] = bf2f(w1.w & 0xffff); u[15] = bf2f(w1.w >> 16);
        float br = 0.f, bi = 0.f;
#pragma unroll
        for (int h = 0; h < 16; ++h) { br += bbr[h] * u[h]; bi += bbi[h] * u[h]; }
        const float nxr = far * xr - fai * xi + br, nxi = far * xi + fai * xr + bi; xr = nxr; xi = nxi;
        float ymine = 0.f;
#pragma unroll
        for (int h = 0; h < 16; ++h) { const float s = wave_sum(ccr[h] * xr - cci[h] * xi); if ((p & 15) == h) ymine = s; }
        if (p < 16) { float uh = 0.f;
#pragma unroll
            for (int h = 0; h < 16; ++h) if (p == h) uh = u[h];
            Z[(size_t)m * DSSM + g * GS + p] = (bf16)f2bf(gelu_tanh(ymine + dme * uh)); }
    }
}
__global__ __launch_bounds__(64) void k_attn(const bf16* __restrict__ Q, const bf16* __restrict__ Kb, const bf16* __restrict__ V, bf16* YA) {
    const int t = blockIdx.x * 64 + threadIdx.x, h = blockIdx.y, b = blockIdx.z;
    const size_t row0 = (size_t)b * SEQ;
    float q[64], o[64];
    { const u32x4* qp = (const u32x4*)(Q + (row0 + t) * DATT + h * HD);
#pragma unroll
      for (int i = 0; i < 8; ++i) { const u32x4 w = qp[i]; q[8 * i] = bf2f(w.x & 0xffff); q[8 * i + 1] = bf2f(w.x >> 16); q[8 * i + 2] = bf2f(w.y & 0xffff); q[8 * i + 3] = bf2f(w.y >> 16); q[8 * i + 4] = bf2f(w.z & 0xffff); q[8 * i + 5] = bf2f(w.z >> 16); q[8 * i + 6] = bf2f(w.w & 0xffff); q[8 * i + 7] = bf2f(w.w >> 16); } }
#pragma unroll
    for (int i = 0; i < 64; ++i) o[i] = 0.f;
    float R = 0.f;
    for (int s = t - 1; s >= 0; --s) {
        const u32x4* kp = (const u32x4*)(Kb + (row0 + s) * DATT + h * HD);
        float z = 0.f;
#pragma unroll
        for (int i = 0; i < 8; ++i) { const u32x4 w = kp[i]; z += q[8 * i] * bf2f(w.x & 0xffff) + q[8 * i + 1] * bf2f(w.x >> 16) + q[8 * i + 2] * bf2f(w.y & 0xffff) + q[8 * i + 3] * bf2f(w.y >> 16) + q[8 * i + 4] * bf2f(w.z & 0xffff) + q[8 * i + 5] * bf2f(w.z >> 16) + q[8 * i + 6] * bf2f(w.w & 0xffff) + q[8 * i + 7] * bf2f(w.w >> 16); }
        const float e = exp2f(z), l = -log2f(1.f + e), a = exp2f(z + l + R);
        R += l;
        const u32x4* vp = (const u32x4*)(V + (row0 + s) * DATT + h * HD);
#pragma unroll
        for (int i = 0; i < 8; ++i) { const u32x4 w = vp[i]; o[8 * i] += a * bf2f(w.x & 0xffff); o[8 * i + 1] += a * bf2f(w.x >> 16); o[8 * i + 2] += a * bf2f(w.y & 0xffff); o[8 * i + 3] += a * bf2f(w.y >> 16); o[8 * i + 4] += a * bf2f(w.z & 0xffff); o[8 * i + 5] += a * bf2f(w.z >> 16); o[8 * i + 6] += a * bf2f(w.w & 0xffff); o[8 * i + 7] += a * bf2f(w.w >> 16); }
    }
    u32x4* op = (u32x4*)(YA + (row0 + t) * DATT + h * HD);
#pragma unroll
    for (int i = 0; i < 8; ++i) { u32x4 w; w.x = pk2(o[8 * i], o[8 * i + 1]); w.y = pk2(o[8 * i + 2], o[8 * i + 3]); w.z = pk2(o[8 * i + 4], o[8 * i + 5]); w.w = pk2(o[8 * i + 6], o[8 * i + 7]); op[i] = w; }
}
__global__ __launch_bounds__(256) void k_mixnorm(const bf16* __restrict__ YS, const bf16* __restrict__ YA, const float* gs, const float* ga, bf16* MIX, int gains) {
    const int lane = threadIdx.x & 63, gw = (blockIdx.x * 256 + threadIdx.x) >> 6, ngw = gridDim.x * 4;
    for (int m = gw; m < M; m += ngw) {
#pragma unroll
        for (int half = 0; half < 2; ++half) {
            const bf16* src = (half ? YA : YS) + (size_t)m * 512 + lane * 8; const float* gg = (half ? ga : gs) + lane * 8;
            const u32x4 w = *(const u32x4*)src; float v[8];
            v[0] = bf2f(w.x & 0xffff); v[1] = bf2f(w.x >> 16); v[2] = bf2f(w.y & 0xffff); v[3] = bf2f(w.y >> 16); v[4] = bf2f(w.z & 0xffff); v[5] = bf2f(w.z >> 16); v[6] = bf2f(w.w & 0xffff); v[7] = bf2f(w.w >> 16);
            float s = 0.f;
#pragma unroll
            for (int i = 0; i < 8; ++i) s += v[i] * v[i];
            const float rstd = 1.f / sqrtf(wave_sum(s) * (1.f / 512.f) + EPS);
#pragma unroll
            for (int i = 0; i < 8; ++i) v[i] *= rstd * (gains ? gg[i] : 1.f);
            u32x4 o; o.x = pk2(v[0], v[1]); o.y = pk2(v[2], v[3]); o.z = pk2(v[4], v[5]); o.w = pk2(v[6], v[7]);
            *(u32x4*)(MIX + (size_t)m * DM + half * 512 + lane * 8) = o;
        }
    }
}
__global__ __launch_bounds__(256) void k_router(const float* __restrict__ x1, const float* gffn, const float* wrg, const float* brg, const float* wre, const float* bre_, bf16* H2, int* TOK, int gains) {
    const int lane = threadIdx.x & 63, gw = (blockIdx.x * 256 + threadIdx.x) >> 6, ngw = gridDim.x * 4;
    for (int m = gw; m < M; m += ngw) {
        const f32x4* xr = (const f32x4*)(x1 + (size_t)m * DM) + lane;
        f32x4 v[4]; float s = 0.f;
#pragma unroll
        for (int j = 0; j < 4; ++j) { v[j] = xr[64 * j]; s += v[j].x * v[j].x + v[j].y * v[j].y + v[j].z * v[j].z + v[j].w * v[j].w; }
        const float rstd = 1.f / sqrtf(wave_sum(s) * (1.f / DM) + EPS);
        float hv[16];
#pragma unroll
        for (int j = 0; j < 4; ++j) { const f32x4 gg = ((const f32x4*)gffn)[64 * j + lane];
            hv[4 * j] = v[j].x * rstd * gg.x; hv[4 * j + 1] = v[j].y * rstd * gg.y; hv[4 * j + 2] = v[j].z * rstd * gg.z; hv[4 * j + 3] = v[j].w * rstd * gg.w;
            u32x2 w; if (gains) { w.x = pk2(hv[4 * j], hv[4 * j + 1]); w.y = pk2(hv[4 * j + 2], hv[4 * j + 3]); } else { w.x = pk2(v[j].x * rstd, v[j].y * rstd); w.y = pk2(v[j].z * rstd, v[j].w * rstd); }
            ((u32x2*)(H2 + (size_t)m * DM))[64 * j + lane] = w; }
        float lg[36];
#pragma unroll
        for (int c = 0; c < 36; ++c) { float a = 0.f;
#pragma unroll
            for (int j = 0; j < 4; ++j)
#pragma unroll
                for (int i = 0; i < 4; ++i) { const int k = 256 * j + 4 * lane + i; a += hv[4 * j + i] * (c < 4 ? wrg[k * 4 + c] : wre[k * 32 + (c - 4)]); }
            lg[c] = wave_sum(a) + (c < 4 ? brg[c] : bre_[c - 4]); }
        if (lane == 0) {
            int gi = 0; float gm = lg[0];
#pragma unroll
            for (int c = 1; c < 4; ++c) if (lg[c] > gm) { gm = lg[c]; gi = c; }
            float gsum = 0.f;
#pragma unroll
            for (int c = 0; c < 4; ++c) gsum += __expf(lg[c] - gm);
            const float pgrp = 1.f / gsum;
            float el[8];
#pragma unroll
            for (int e = 0; e < 8; ++e) { float t = 0.f;
#pragma unroll
                for (int g2 = 0; g2 < 4; ++g2) if (g2 == gi) t = lg[4 + g2 * 8 + e];
                el[e] = t; }
            int i0 = 0; float m0 = el[0];
#pragma unroll
            for (int e = 1; e < 8; ++e) if (el[e] > m0) { m0 = el[e]; i0 = e; }
            int i1 = -1; float m1 = -3.0e38f;
#pragma unroll
            for (int e = 0; e < 8; ++e) if (e != i0 && el[e] > m1) { m1 = el[e]; i1 = e; }
            const float e1 = __expf(m1 - m0), p0 = 1.f / (1.f + e1), p1 = e1 / (1.f + e1);
            int* tk = TOK + (size_t)m * 8;
            tk[0] = gi * 8 + i0; tk[1] = gi * 8 + i1; tk[2] = __float_as_int(pgrp * p0); tk[3] = __float_as_int(pgrp * p1);
        }
    }
}
__global__ __launch_bounds__(256) void k_moe(const bf16* __restrict__ H2, const int* __restrict__ TOK, const float* __restrict__ wg, const float* __restrict__ wu, const float* __restrict__ wd, float* out) {
    __shared__ float hs[DM]; __shared__ float hid[DE];
    const int m = blockIdx.x, tid = threadIdx.x;
    for (int k = tid; k < DM; k += 256) hs[k] = bf2f(H2[(size_t)m * DM + k]);
    __syncthreads();
    float oacc[4] = {0.f, 0.f, 0.f, 0.f};
    for (int kk = 0; kk < 2; ++kk) {
        const int e = TOK[(size_t)m * 8 + kk]; const float gate = __int_as_float(TOK[(size_t)m * 8 + 2 + kk]);
        const float* Wg = wg + (size_t)e * DM * DE; const float* Wu = wu + (size_t)e * DM * DE; const float* Wd = wd + (size_t)e * DE * DM;
        float g0 = 0.f, g1 = 0.f, u0 = 0.f, u1 = 0.f;
        for (int k = 0; k < DM; ++k) { const float hvv = hs[k]; g0 += hvv * Wg[(size_t)k * DE + tid]; g1 += hvv * Wg[(size_t)k * DE + tid + 256]; u0 += hvv * Wu[(size_t)k * DE + tid]; u1 += hvv * Wu[(size_t)k * DE + tid + 256]; }
        __syncthreads();
        hid[tid] = g0 * sigmoidf_(g0) * u0; hid[tid + 256] = g1 * sigmoidf_(g1) * u1;
        __syncthreads();
        float d[4] = {0.f, 0.f, 0.f, 0.f};
        for (int k = 0; k < DE; ++k) { const float hh = hid[k];
#pragma unroll
            for (int j = 0; j < 4; ++j) d[j] += hh * Wd[(size_t)k * DM + tid + 256 * j]; }
#pragma unroll
        for (int j = 0; j < 4; ++j) oacc[j] += gate * d[j];
    }
#pragma unroll
    for (int j = 0; j < 4; ++j) out[(size_t)m * DM + tid + 256 * j] += oacc[j];
}
}


namespace mk {
#define LAS __attribute__((address_space(3)))
#define GAS __attribute__((address_space(1)))
typedef short bf16x8 __attribute__((ext_vector_type(8)));
typedef short s16x4 __attribute__((ext_vector_type(4)));
typedef float f32x16 __attribute__((ext_vector_type(16)));
typedef float f32x2 __attribute__((ext_vector_type(2)));
typedef __bf16 bf16x2_t __attribute__((ext_vector_type(2)));
typedef GAS unsigned gu32;

constexpr int NWAVES = 8, NTHR = 512;
constexpr int RING_BYTES = 131072, SCR2_OFF = RING_BYTES, SCR2_BYTES = 16128, MISC_OFF = SCR2_OFF + SCR2_BYTES, LDS_BYTES = 147456;
static_assert(MISC_OFF + 256 == LDS_BYTES, "LDS map");

constexpr size_t FW_TOK = 2 * MiB, FW_WIN = 4 * MiB, FW_WOUT = 8 * MiB, FW_WGLU = 10 * MiB, FW_WR = 10 * MiB + 512 * 1024, FW_TB = 12 * MiB, FW_W1 = 32 * MiB,
                 FW_WGU = 40 * MiB, FW_WD = 104 * MiB, FW_SST = 136 * MiB, FW_XN = 168 * MiB, FW_Q = 296 * MiB, FW_K = 360 * MiB, FW_V = 424 * MiB, FW_U2 = 488 * MiB,
                 FW_Z = 568 * MiB, FW_YS = 632 * MiB, FW_YA = 696 * MiB, FW_MIX = 760 * MiB, FW_END = 888 * MiB,
                 FW_H2 = FW_XN, FW_XG = 296 * MiB, FW_HH = 568 * MiB, FW_YE = FW_XG;
static_assert(FW_K - FW_Q == (size_t)M * 512 * 2 && FW_V - FW_K == (size_t)M * 512 * 2, "Q|K|V contiguous");
constexpr int MAXTILES = 544;
static_assert(FW_XG + (size_t)MAXTILES * 256 * DM * 2 <= FW_HH && FW_HH + (size_t)MAXTILES * 256 * DE * 2 <= FW_END, "MoE overlay");
constexpr int CW_TMO = 0, CW_CNT = 64, CW_BAR = 4096;
constexpr size_t CTL_ZERO_BYTES = 1 * MiB;

#define RLX_AGENT __ATOMIC_RELAXED, __HIP_MEMORY_SCOPE_AGENT
__device__ __forceinline__ unsigned cvtpk(float lo, float hi) { f32x2 v = {lo, hi}; bf16x2_t b = __builtin_convertvector(v, bf16x2_t); return __builtin_bit_cast(unsigned, b); }

#define XB_TMO      128
#define XB_XCNT(j)  (256  + 64 * (j))
#define XB_XSUB(j)  (1280 + 64 * (j))
#define XB_XGEN(j)  (2304 + 64 * (j))
#define XB_TOP      3328
#define XB_TOPGEN   3392
#define XCD_BAR_WORDS 3456
#define XB_SPIN_CAP (1u << 18)
__device__ __forceinline__ unsigned xb_ld(unsigned* p)              { return __hip_atomic_load(p, __ATOMIC_RELAXED, __HIP_MEMORY_SCOPE_AGENT); }
__device__ __forceinline__ unsigned xb_add(unsigned* p, unsigned v) { return __hip_atomic_fetch_add(p, v, __ATOMIC_RELAXED, __HIP_MEMORY_SCOPE_AGENT); }
__device__ __forceinline__ unsigned xb_xcc_id() { return (unsigned)__builtin_amdgcn_s_getreg((3 << 11) | 20) & 0xFu; }
#define XB_SPIN(cond, bar) do { unsigned _sp = 0; while (cond) { __builtin_amdgcn_s_sleep(1); \
    if ((++_sp & 255u) == 0u) { if (xb_ld(&(bar)[XB_TMO])) break; if (_sp > XB_SPIN_CAP) { atomicAdd(&(bar)[XB_TMO], 1u); break; } } } } while (0)
struct XcdBarrier { unsigned* bar; unsigned x; volatile LAS unsigned* st; };
__device__ __forceinline__ XcdBarrier xcd_barrier_post(unsigned* bar, volatile LAS unsigned* st) {
    XcdBarrier b; b.bar = bar; b.x = xb_xcc_id(); b.st = st;
    if (threadIdx.x == 0) (void)xb_add(&bar[XB_XCNT(b.x)], 1u);
    return b;
}
__device__ __forceinline__ void xcd_barrier_complete(unsigned* bar, unsigned x, unsigned& nloc, unsigned& nx) {
    const unsigned G = gridDim.x * gridDim.y * gridDim.z;
    unsigned sum, cnt, mine, sp = 0u;
    for (;;) {
        sum = 0u; cnt = 0u; mine = 0u;
#pragma unroll
        for (unsigned j = 0; j < 16; ++j) { const unsigned c = xb_ld(&bar[XB_XCNT(j)]); sum += c; cnt += (c > 0u) ? 1u : 0u; mine = (j == x) ? c : mine; }
        if (sum == G) break;
        __builtin_amdgcn_s_sleep(1);
        if ((++sp & 255u) == 0u) { if (xb_ld(&bar[XB_TMO])) break; if (sp > XB_SPIN_CAP) { atomicAdd(&bar[XB_TMO], 1u); break; } }
    }
    nloc = mine > 0u ? mine : 1u; nx = cnt > 0u ? cnt : 1u;
}
__device__ __forceinline__ void xcd_barrier(const XcdBarrier& b) {
    asm volatile("s_waitcnt vmcnt(0)" ::: "memory");
    __syncthreads();
    if (threadIdx.x == 0) {
        unsigned* bar = b.bar;
        __builtin_amdgcn_s_waitcnt(0);
        unsigned nloc = b.st[0], nx = b.st[1];
        if (nloc == 0u) { xcd_barrier_complete(bar, b.x, nloc, nx); b.st[0] = nloc; b.st[1] = nx; }
        const unsigned old = xb_add(&bar[XB_XSUB(b.x)], 1u);
        const unsigned gen = old / nloc;
        if (old + 1u == (gen + 1u) * nloc) {
            __builtin_amdgcn_fence(__ATOMIC_RELEASE, "agent");
            asm volatile("s_waitcnt vmcnt(0)" ::: "memory");
            const unsigned og = xb_add(&bar[XB_TOP], 1u);
            const unsigned tg = og / nx;
            if (og + 1u == (tg + 1u) * nx) xb_add(&bar[XB_TOPGEN], 1u);
            else XB_SPIN(xb_ld(&bar[XB_TOPGEN]) == tg, bar);
            __builtin_amdgcn_fence(__ATOMIC_ACQUIRE, "agent");
            xb_add(&bar[XB_XGEN(b.x)], 1u);
            asm volatile("s_waitcnt vmcnt(0)" ::: "memory");
        } else {
            XB_SPIN(xb_ld(&bar[XB_XGEN(b.x)]) == gen, bar);
            __builtin_amdgcn_fence(__ATOMIC_ACQUIRE, "agent");
            asm volatile("s_waitcnt vmcnt(0)" ::: "memory");
        }
    }
    __syncthreads();
}

constexpr int BM = 256, BK = 64, HALF = 128, HTB = HALF * BK * 2;
__device__ __forceinline__ int lds_byte(int r, int c) { const int st = (r >> 4) * 2 + (c >> 5), rr = r & 15, cc = c & 31, ob = rr * 64 + cc * 2; return st * 1024 + (ob ^ (((ob >> 9) & 1) << 5)); }
__device__ __forceinline__ void stage_rc(int b, int& R, int& C) { const int st = b / 1024, sb = b % 1024, swz = sb ^ (((sb >> 9) & 1) << 5); R = (st >> 1) * 16 + swz / 64; C = (st & 1) * 32 + (swz % 64) / 2; }
__device__ __forceinline__ int perm32(int rho) { const int n = rho >> 4, i = rho & 15; return 8 * (i >> 2) + 4 * n + (i & 3); }
struct Unit { const char* a; const char* b; int pm, pn, aux; };
struct GemmP { int lda_b, ldb_b, K; };

template <class Epi, class Sched>
__device__ __forceinline__ void gemm_phase(LAS unsigned char* lds, const GemmP g, const Sched& S, const Epi& E) {
    const int tid = threadIdx.x, wid = __builtin_amdgcn_readfirstlane(tid >> 6), lane = tid & 63, wr = wid >> 2, wc = wid & 3, fr = lane & 15, fq = lane >> 4;
    const int nt = g.K / BK;
    unsigned voffA[2], voffB[2];
#pragma unroll
    for (int i = 0; i < 2; ++i) { int R, C; stage_rc(tid * 16 + i * 8192, R, C); const int Rb = Epi::PERM ? ((R & ~31) + perm32(R & 31)) : R;
        voffA[i] = (unsigned)(R * g.lda_b + C * 2); voffB[i] = (unsigned)(Rb * g.ldb_b + C * 2); }
    const size_t kstep = (size_t)(BK * 2);
    const size_t hstepA = (size_t)HALF * g.lda_b, hstepB = (size_t)HALF * g.ldb_b;
    const unsigned ldsw = (unsigned)wid * 1024u;
    const int aoff = lds_byte(wr * 64 + fr, fq * 8), boff = lds_byte(wc * 32 + fr, fq * 8);
#define PG8_SA(b, h) (((b) * 2 + (h)) * HTB)
#define PG8_SB(b, h) ((4 + (b) * 2 + (h)) * HTB)
#define PG8_STAGE(bufoff, gbase, voff) do { _Pragma("unroll") for (int _i = 0; _i < 2; ++_i) \
        __builtin_amdgcn_global_load_lds((const unsigned*)((const char*)(gbase) + (voff)[_i]), (LAS unsigned*)(lds + (bufoff) + ldsw + _i * 8192), 16, 0, 0); } while (0)
#define PG8_LDA(dst, b, h) do { _Pragma("unroll") for (int m = 0; m < 4; ++m) _Pragma("unroll") for (int k = 0; k < 2; ++k) dst[m][k] = *(const LAS bf16x8*)(lds + PG8_SA(b, h) + aoff + m * 2048 + k * 1024); } while (0)
#define PG8_LDB(dst, b, h) do { _Pragma("unroll") for (int n = 0; n < 2; ++n) _Pragma("unroll") for (int k = 0; k < 2; ++k) dst[n][k] = *(const LAS bf16x8*)(lds + PG8_SB(b, h) + boff + n * 2048 + k * 1024); } while (0)
#define PG8_MMA(ai, bj, At, Bt) do { __builtin_amdgcn_s_setprio(1); _Pragma("unroll") for (int m = 0; m < 4; ++m) _Pragma("unroll") for (int n = 0; n < 2; ++n) _Pragma("unroll") for (int k = 0; k < 2; ++k) \
        acc[ai][bj][m][n] = __builtin_amdgcn_mfma_f32_16x16x32_bf16(Bt[n][k], At[m][k], acc[ai][bj][m][n], 0, 0, 0); __builtin_amdgcn_s_setprio(0); } while (0)
#define PG8_WAIT_V(n) asm volatile("s_waitcnt vmcnt(" #n ")" ::: "memory")
#define PG8_WAIT_L(n) asm volatile("s_waitcnt lgkmcnt(" #n ")" ::: "memory")
#define PG8_BAR __builtin_amdgcn_s_barrier()
#define PG8_SCHED __builtin_amdgcn_sched_barrier(0)
    Unit cur, nxt; int ui = 0;
    if (!S.next(0, cur)) return;
    f32x4 acc[2][2][4][2];
#pragma unroll
    for (int a = 0; a < 2; ++a)
#pragma unroll
        for (int b = 0; b < 2; ++b)
#pragma unroll
            for (int m = 0; m < 4; ++m)
#pragma unroll
                for (int n = 0; n < 2; ++n) acc[a][b][m][n] = (f32x4){0.f, 0.f, 0.f, 0.f};
    bf16x8 At[4][2], B0[2][2], B1[2][2];
    const char* cA = cur.a; const char* cB = cur.b;
    PG8_STAGE(PG8_SB(0, 0), cB, voffB); PG8_STAGE(PG8_SB(0, 1), cB + hstepB, voffB); PG8_STAGE(PG8_SA(0, 0), cA, voffA); PG8_STAGE(PG8_SA(0, 1), cA + hstepA, voffA);
    if (wr == 1) PG8_BAR;
    PG8_WAIT_V(2); PG8_BAR;
    PG8_STAGE(PG8_SB(1, 0), cB + kstep, voffB); PG8_STAGE(PG8_SA(1, 0), cA + kstep, voffA); PG8_STAGE(PG8_SB(1, 1), cB + hstepB + kstep, voffB);
    PG8_WAIT_V(6); PG8_BAR;
    for (;;) {
        const bool has_next = S.next(ui + 1, nxt);
        const char* nA = has_next ? nxt.a : cA; const char* nB = has_next ? nxt.b : cB;
        for (int t = 0; t < nt; t += 2) {
            const bool last = (t == nt - 2);
            const char* a1 = cA + (size_t)(t + 1) * kstep;
            const char* a2 = last ? nA : cA + (size_t)(t + 2) * kstep; const char* b2 = last ? nB : cB + (size_t)(t + 2) * kstep;
            const char* a3 = a2 + kstep; const char* b3 = b2 + kstep;
            PG8_LDB(B0, 0, 0); PG8_LDB(B1, 0, 1); PG8_SCHED; PG8_LDA(At, 0, 0); PG8_STAGE(PG8_SA(1, 1), a1 + hstepA, voffA);
            PG8_WAIT_V(8); PG8_WAIT_L(0); PG8_BAR; PG8_MMA(0, 0, At, B0); PG8_MMA(0, 1, At, B1); PG8_BAR; PG8_SCHED;
            PG8_LDA(At, 0, 1); PG8_STAGE(PG8_SB(0, 0), b2, voffB); PG8_STAGE(PG8_SB(0, 1), b2 + hstepB, voffB); PG8_STAGE(PG8_SA(0, 0), a2, voffA);
            PG8_WAIT_V(8); PG8_WAIT_L(0); PG8_BAR; PG8_MMA(1, 0, At, B0); PG8_MMA(1, 1, At, B1); PG8_BAR; PG8_SCHED;
            PG8_LDB(B0, 1, 0); PG8_LDB(B1, 1, 1); PG8_SCHED; PG8_LDA(At, 1, 0); PG8_STAGE(PG8_SA(0, 1), a2 + hstepA, voffA);
            PG8_WAIT_V(8); PG8_WAIT_L(0); PG8_BAR; PG8_MMA(0, 0, At, B0); PG8_MMA(0, 1, At, B1); PG8_BAR; PG8_SCHED;
            PG8_LDA(At, 1, 1); PG8_STAGE(PG8_SB(1, 0), b3, voffB); PG8_STAGE(PG8_SB(1, 1), b3 + hstepB, voffB); PG8_STAGE(PG8_SA(1, 0), a3, voffA);
            PG8_WAIT_V(8); PG8_WAIT_L(0); PG8_BAR; PG8_MMA(1, 0, At, B0); PG8_MMA(1, 1, At, B1); PG8_BAR; PG8_SCHED;
        }
        if (wr == 0) PG8_BAR;
        E(acc, cur, wr, wc, fr, fq);
        if (!has_next) break;
#pragma unroll
        for (int a = 0; a < 2; ++a)
#pragma unroll
            for (int b = 0; b < 2; ++b)
#pragma unroll
                for (int m = 0; m < 4; ++m)
#pragma unroll
                    for (int n = 0; n < 2; ++n) acc[a][b][m][n] = (f32x4){0.f, 0.f, 0.f, 0.f};
        cur = nxt; cA = nA; cB = nB; ++ui;
        if (wr == 1) PG8_BAR;
    }
    PG8_WAIT_V(0);
    PG8_BAR;
#undef PG8_SA
#undef PG8_SB
#undef PG8_STAGE
#undef PG8_LDA
#undef PG8_LDB
#undef PG8_MMA
#undef PG8_WAIT_V
#undef PG8_WAIT_L
#undef PG8_BAR
#undef PG8_SCHED
}

struct DenseOrder {
    const char* A; const char* B; size_t a_tile, b_tile; int nM, nN, nwg, G, c;
    __device__ __forceinline__ bool next(int i, Unit& u) const {
        const long L = (long)i * G + c; if (L >= nwg) return false;
        int wgid = (int)L; { const int q = nwg / 8, r = nwg % 8, xcd = wgid % 8, off = wgid / 8; wgid = (xcd < r ? xcd * (q + 1) : r * (q + 1) + (xcd - r) * q) + off; }
        const int nig = 8 * nN, gid = wgid / nig, fm = gid * 8, gsz = (nM - fm) < 8 ? (nM - fm) : 8;
        u.pm = fm + ((wgid % nig) % gsz); u.pn = (wgid % nig) / gsz; u.aux = 0;
        u.a = A + (size_t)u.pm * a_tile; u.b = B + (size_t)u.pn * b_tile; return true;
    }
};
struct GroupOrder {
    const char* A; const char* B; size_t a_grp, b_grp, a_tile, b_tile; int nM, nN, nwg, G, c;
    __device__ __forceinline__ bool next(int i, Unit& u) const {
        const long L = (long)i * G + c; if (L >= nwg) return false;
        const int per = nM * nN, g = (int)L / per, r = (int)L % per;
        u.pn = r / nM; u.pm = r % nM; u.aux = g;
        u.a = A + (size_t)g * a_grp + (size_t)u.pm * a_tile; u.b = B + (size_t)g * b_grp + (size_t)u.pn * b_tile; return true;
    }
};
struct MoeOrder {
    const char* A; const char* B; size_t a_tile, b_exp, b_tile; const LAS unsigned char* t2e; int ntiles, G, c;
    __device__ __forceinline__ bool next(int i, Unit& u) const {
        const long L = (long)i * G + c; if (L >= (long)ntiles * 4) return false;
        u.pm = (int)(L >> 2); u.pn = (int)(L & 3); u.aux = t2e[u.pm];
        u.a = A + (size_t)u.pm * a_tile; u.b = B + (size_t)u.aux * b_exp + (size_t)u.pn * b_tile; return true;
    }
};

typedef f32x4 Acc[2][2][4][2];
struct EpiProj {
    static constexpr bool PERM = true;
    bf16* U2; bf16* QKV; const float* gq; const float* gk;
    __device__ __forceinline__ void operator()(const Acc& acc, const Unit& u, int wr, int wc, int fr, int fq) const {
        const int typ = u.pn >> 1, sub = u.pn & 1;
        const bool nrm = (typ == 1 || typ == 2);
        const float* gg = (typ == 1) ? gq : gk; const float sc = (typ == 1) ? C2 : 1.f;
        f32x4 gn[2][2];
#pragma unroll
        for (int bj = 0; bj < 2; ++bj)
#pragma unroll
            for (int n = 0; n < 2; ++n) gn[bj][n] = *(const f32x4*)(gg + 32 * bj + 8 * fq + 4 * n) * sc;
#pragma unroll
        for (int ai = 0; ai < 2; ++ai)
#pragma unroll
            for (int m = 0; m < 4; ++m) {
                const int r = u.pm * BM + ai * HALF + wr * 64 + m * 16 + fr;
                f32x4 v[2][2];
#pragma unroll
                for (int bj = 0; bj < 2; ++bj)
#pragma unroll
                    for (int n = 0; n < 2; ++n) v[bj][n] = acc[ai][bj][m][n];
                {
                    float s = 0.f;
#pragma unroll
                    for (int bj = 0; bj < 2; ++bj)
#pragma unroll
                        for (int n = 0; n < 2; ++n) s += (v[bj][n].x * v[bj][n].x + v[bj][n].y * v[bj][n].y) + (v[bj][n].z * v[bj][n].z + v[bj][n].w * v[bj][n].w);
                    s += __shfl_xor(s, 16); s += __shfl_xor(s, 32);
                    const float rstd = 1.f / sqrtf(s * (1.f / 64.f) + EPS);
#pragma unroll
                    for (int bj = 0; bj < 2; ++bj)
#pragma unroll
                        for (int n = 0; n < 2; ++n) { const f32x4 mul = nrm ? gn[bj][n] * rstd : (f32x4){1.f, 1.f, 1.f, 1.f}; v[bj][n] = v[bj][n] * mul; }
                }
#pragma unroll
                for (int bj = 0; bj < 2; ++bj) {
                    u32x4 w; w.x = cvtpk(v[bj][0].x, v[bj][0].y); w.y = cvtpk(v[bj][0].z, v[bj][0].w); w.z = cvtpk(v[bj][1].x, v[bj][1].y); w.w = cvtpk(v[bj][1].z, v[bj][1].w);
                    const int f = sub * 256 + 64 * wc + 32 * bj + 8 * fq;
                    if (typ == 0) { const int g = f >> 4, h = f & 15; *(u32x4*)(U2 + ((size_t)g * NCH + (r >> 5)) * U2P + (r & 31) * 16 + h) = w; }
                    else { *(u32x4*)(QKV + (size_t)(typ - 1) * ((size_t)M * 512) + (size_t)r * 512 + f) = w; }
                }
            }
    }
};
struct EpiState {
    static constexpr bool PERM = false;
    float* SST;
    __device__ __forceinline__ void operator()(const Acc& acc, const Unit& u, int wr, int wc, int fr, int fq) const {
#pragma unroll
        for (int ai = 0; ai < 2; ++ai)
#pragma unroll
            for (int m = 0; m < 4; ++m) { const int r = u.pm * BM + ai * HALF + wr * 64 + m * 16 + fr;
#pragma unroll
                for (int n = 0; n < 2; ++n) *(f32x4*)(SST + ((size_t)u.aux * NCH + r) * 128 + 32 * wc + 16 * n + 4 * fq) = acc[ai][0][m][n]; }
    }
};
struct EpiS5 {
    static constexpr bool PERM = true;
    bf16* Z;
    __device__ __forceinline__ void operator()(const Acc& acc, const Unit& u, int wr, int wc, int fr, int fq) const {
#pragma unroll
        for (int ai = 0; ai < 2; ++ai)
#pragma unroll
            for (int m = 0; m < 4; ++m) { const int r = u.pm * BM + ai * HALF + wr * 64 + m * 16 + fr;
#pragma unroll
                for (int bj = 0; bj < 2; ++bj) { const int c0 = u.pn * BM + bj * HALF + 32 * wc + 8 * fq, i = c0 >> 4, h = c0 & 15;
                    const f32x4 a = acc[ai][bj][m][0], b = acc[ai][bj][m][1];
                    u32x4 w; w.x = cvtpk(gelu_tanh(a.x), gelu_tanh(a.y)); w.y = cvtpk(gelu_tanh(a.z), gelu_tanh(a.w)); w.z = cvtpk(gelu_tanh(b.x), gelu_tanh(b.y)); w.w = cvtpk(gelu_tanh(b.z), gelu_tanh(b.w));
                    *(u32x4*)(Z + ((size_t)r * 32 + i) * DSSM + u.aux * 16 + h) = w; } }
    }
};
struct EpiGlu {
    static constexpr bool PERM = true;
    const bf16* Z; const float* bias; bf16* YS;
    __device__ __forceinline__ void operator()(const Acc& acc, const Unit& u, int wr, int wc, int fr, int fq) const {
#pragma unroll
        for (int bj = 0; bj < 2; ++bj) { const int c0 = u.pn * BM + bj * HALF + 32 * wc + 8 * fq;
            const f32x4 b0 = *(const f32x4*)(bias + c0), b1 = *(const f32x4*)(bias + c0 + 4);
#pragma unroll
            for (int ai = 0; ai < 2; ++ai)
#pragma unroll
                for (int m = 0; m < 4; ++m) { const size_t off = (size_t)(u.pm * BM + ai * HALF + wr * 64 + m * 16 + fr) * DSSM + c0;
                    const u32x4 zz = *(const u32x4*)(Z + off);
                    const f32x4 a = acc[ai][bj][m][0] + b0, b = acc[ai][bj][m][1] + b1;
                    u32x4 w;
                    w.x = cvtpk(bf2f(zz.x & 0xffff) * sigmoidf_(a.x), bf2f(zz.x >> 16) * sigmoidf_(a.y)); w.y = cvtpk(bf2f(zz.y & 0xffff) * sigmoidf_(a.z), bf2f(zz.y >> 16) * sigmoidf_(a.w));
                    w.z = cvtpk(bf2f(zz.z & 0xffff) * sigmoidf_(b.x), bf2f(zz.z >> 16) * sigmoidf_(b.y)); w.w = cvtpk(bf2f(zz.w & 0xffff) * sigmoidf_(b.z), bf2f(zz.w >> 16) * sigmoidf_(b.w));
                    *(u32x4*)(YS + off) = w; } }
    }
};
struct EpiOut {
    static constexpr bool PERM = false;
    const float* X; float* Out;
    __device__ __forceinline__ void operator()(const Acc& acc, const Unit& u, int wr, int wc, int fr, int fq) const {
#pragma unroll
        for (int ai = 0; ai < 2; ++ai)
#pragma unroll
            for (int m = 0; m < 4; ++m) { const size_t ro = (size_t)(u.pm * BM + ai * HALF + wr * 64 + m * 16 + fr) * DM + u.pn * BM + 32 * wc + 4 * fq;
#pragma unroll
                for (int bj = 0; bj < 2; ++bj)
#pragma unroll
                    for (int n = 0; n < 2; ++n) { const size_t o = ro + bj * HALF + 16 * n; *(f32x4*)(Out + o) = *(const f32x4*)(X + o) + acc[ai][bj][m][n]; } }
    }
};
struct EpiGU {
    static constexpr bool PERM = true;
    bf16* HH;
    __device__ __forceinline__ void operator()(const Acc& acc, const Unit& u, int wr, int wc, int fr, int fq) const {
#pragma unroll
        for (int ai = 0; ai < 2; ++ai)
#pragma unroll
            for (int m = 0; m < 4; ++m) { const size_t off = (size_t)(u.pm * BM + ai * HALF + wr * 64 + m * 16 + fr) * DE + u.pn * 128 + 32 * wc + 8 * fq;
                float hv[8];
#pragma unroll
                for (int n = 0; n < 2; ++n) { const f32x4 gt = acc[ai][0][m][n], up = acc[ai][1][m][n];
                    hv[4 * n] = gt.x * sigmoidf_(gt.x) * up.x; hv[4 * n + 1] = gt.y * sigmoidf_(gt.y) * up.y; hv[4 * n + 2] = gt.z * sigmoidf_(gt.z) * up.z; hv[4 * n + 3] = gt.w * sigmoidf_(gt.w) * up.w; }
                u32x4 w; w.x = cvtpk(hv[0], hv[1]); w.y = cvtpk(hv[2], hv[3]); w.z = cvtpk(hv[4], hv[5]); w.w = cvtpk(hv[6], hv[7]);
                *(u32x4*)(HH + off) = w; }
    }
};
struct EpiDown {
    static constexpr bool PERM = true;
    bf16* YE;
    __device__ __forceinline__ void operator()(const Acc& acc, const Unit& u, int wr, int wc, int fr, int fq) const {
#pragma unroll
        for (int ai = 0; ai < 2; ++ai)
#pragma unroll
            for (int m = 0; m < 4; ++m) { const size_t ro = (size_t)(u.pm * BM + ai * HALF + wr * 64 + m * 16 + fr) * DM + u.pn * BM + 32 * wc + 8 * fq;
#pragma unroll
                for (int bj = 0; bj < 2; ++bj) { const f32x4 a = acc[ai][bj][m][0], b = acc[ai][bj][m][1];
                    u32x4 w; w.x = cvtpk(a.x, a.y); w.y = cvtpk(a.z, a.w); w.z = cvtpk(b.x, b.y); w.w = cvtpk(b.z, b.w);
                    *(u32x4*)(YE + ro + bj * HALF) = w; } }
    }
};

struct Args { const float* in[26]; float* out; unsigned char* ws; int ph_lo, ph_hi; };
struct Frame { LAS unsigned char* lds; volatile LAS unsigned* MISC; unsigned* ctl; int tid, lane, wave, G, c; };

struct TItem { const float* W; int ldw, srccol0; const float* kscale; bf16* WT; int ldt, dstrow0, k0; };
__device__ __forceinline__ void titem_load(const TItem& t, int lane, f32x4 (&v)[8]) {
#pragma unroll
    for (int i = 0; i < 8; ++i) { const int kk = 8 * i + (lane >> 3); v[i] = *(const f32x4*)(t.W + (size_t)(t.k0 + kk) * t.ldw + t.srccol0 + (lane & 7) * 4); }
}
__device__ __forceinline__ void titem_store(const TItem& t, int lane, const f32x4 (&v)[8], LAS float* scr) {
#pragma unroll
    for (int i = 0; i < 8; ++i) { const int kk = 8 * i + (lane >> 3); const float sc = t.kscale ? t.kscale[t.k0 + kk] : 1.f; LAS float* d = scr + kk * 33 + (lane & 7) * 4;
        d[0] = v[i].x * sc; d[1] = v[i].y * sc; d[2] = v[i].z * sc; d[3] = v[i].w * sc; }
    asm volatile("s_waitcnt lgkmcnt(0)" ::: "memory");
    const int c = lane & 7;
#pragma unroll
    for (int j = 0; j < 4; ++j) { const int n = (lane >> 3) + 8 * j; const LAS float* s = scr + (8 * c) * 33 + n;
        u32x4 o; o.x = pk2(s[0 * 33], s[1 * 33]); o.y = pk2(s[2 * 33], s[3 * 33]); o.z = pk2(s[4 * 33], s[5 * 33]); o.w = pk2(s[6 * 33], s[7 * 33]);
        *(u32x4*)(t.WT + (size_t)(t.dstrow0 + n) * t.ldt + t.k0 + 8 * c) = o; }
    asm volatile("s_waitcnt lgkmcnt(0)" ::: "memory");
}
__device__ __forceinline__ void s5_tables_item(Frame& F, const Args& a, int g, int part) {
    const float* lre = a.in[3]; const float* lim = a.in[4]; const float* ldt = a.in[5]; const float* bre = a.in[6]; const float* bim = a.in[7];
    const float* cre = a.in[8]; const float* cim = a.in[9]; const float* dsk = a.in[10];
    LAS float* PWr = (LAS float*)F.lds; LAS float* PWi = PWr + 33 * 64; LAS float* BBr = PWi + 33 * 64; LAS float* BBi = BBr + 1024; LAS float* CCr = BBi + 1024; LAS float* CCi = CCr + 1024; LAS float* CF = CCi + 1024;
    const int tid = F.tid;
    if (tid < 64) { const int p = tid;
        const double dt = exp((double)ldt[g]), lr = lre[g * PST + p], li = lim[g * PST + p];
        double sn, cs; sincos_d(li * dt, sn, cs); const double mag = exp(lr * dt);
        const double ar = mag * cs, ai = mag * sn, den = lr * lr + li * li, nr = ar - 1.0, ni = ai;
        CF[2 * p] = (float)((nr * lr + ni * li) / den); CF[2 * p + 1] = (float)((ni * lr - nr * li) / den);
        double pr = 1.0, pi = 0.0;
        for (int l = 0; l <= 32; ++l) { PWr[l * 64 + p] = (float)pr; PWi[l * 64 + p] = (float)pi; const double t = pr * ar - pi * ai; pi = pr * ai + pi * ar; pr = t; }
    }
    __syncthreads();
    for (int idx = tid; idx < 1024; idx += NTHR) { const int p = idx >> 4; const float cfr = CF[2 * p], cfi = CF[2 * p + 1], br = bre[(size_t)g * 1024 + idx], bi = bim[(size_t)g * 1024 + idx];
        BBr[idx] = cfr * br - cfi * bi; BBi[idx] = cfr * bi + cfi * br; CCr[idx] = cre[(size_t)g * 1024 + idx]; CCi[idx] = cim[(size_t)g * 1024 + idx]; }
    __syncthreads();
    bf16* TBg = (bf16*)(a.ws + FW_TB) + (size_t)g * 512 * U2P; bf16* W1g = (bf16*)(a.ws + FW_W1) + (size_t)g * 256 * 512;
    for (int l = part; l < 32; l += 8) {
        if (tid < 256) { const int h = tid >> 4, hp = tid & 15; float k = 0.f;
            for (int p = 0; p < 64; ++p) { const float wr_ = PWr[l * 64 + p], wi_ = PWi[l * 64 + p], br = BBr[p * 16 + hp], bi = BBi[p * 16 + hp];
                k += CCr[h * 64 + p] * (wr_ * br - wi_ * bi) - CCi[h * 64 + p] * (wr_ * bi + wi_ * br); }
            if (l == 0 && h == hp) k += dsk[g * 16 + h];
            const bf16 v = (bf16)f2bf(k);
            for (int i = l; i < 32; ++i) TBg[(size_t)(i * 16 + h) * U2P + (i - l) * 16 + hp] = v;
            if (l >= 1) for (int i = 0; i < 32 - l; ++i) TBg[(size_t)(i * 16 + h) * U2P + (i + l) * 16 + hp] = 0;
        } else { const int t2 = tid - 256;
#pragma unroll
            for (int x = 0; x < 8; ++x) { const int e = t2 * 8 + x;
                { const int h = e >> 7, q = e & 127, p = q & 63; const float cr = CCr[h * 64 + p], ci = CCi[h * 64 + p], wr_ = PWr[(l + 1) * 64 + p], wi_ = PWi[(l + 1) * 64 + p];
                  const float re = cr * wr_ - ci * wi_, im = cr * wi_ + ci * wr_; TBg[(size_t)(l * 16 + h) * U2P + 512 + q] = (bf16)f2bf(q < 64 ? re : -im); }
                { const int rho = e >> 4, hp = e & 15, p = rho & 63; const float wr_ = PWr[(31 - l) * 64 + p], wi_ = PWi[(31 - l) * 64 + p], br = BBr[p * 16 + hp], bi = BBi[p * 16 + hp];
                  const float re = wr_ * br - wi_ * bi, im = wr_ * bi + wi_ * br; W1g[(size_t)rho * 512 + l * 16 + hp] = (bf16)f2bf(rho < 64 ? re : im); W1g[(size_t)(128 + rho) * 512 + l * 16 + hp] = 0; }
            }
        }
    }
    __syncthreads();
}
__device__ __forceinline__ void p0_prologue(Frame& F, const Args& a) {
    const float* x = a.in[0];
    for (int it = F.c; it < 256; it += F.G) s5_tables_item(F, a, it >> 3, it & 7);
    LAS float* scr = (LAS float*)(F.lds + F.wave * 16384);
    const int gw = F.c * NWAVES + F.wave, NGW = F.G * NWAVES;
    constexpr int I_IN = 16 * 64, I_GLU = 8 * 16, I_OUT = 16 * 32, I_GU = 32 * 16 * 32, I_D = 32 * 8 * 32, NITEMS = I_IN + I_GLU + I_OUT + I_GU + I_D;
    bf16* WIN = (bf16*)(a.ws + FW_WIN); bf16* WGLU = (bf16*)(a.ws + FW_WGLU); bf16* WOUT = (bf16*)(a.ws + FW_WOUT); bf16* WGU = (bf16*)(a.ws + FW_WGU); bf16* WD = (bf16*)(a.ws + FW_WD);
    auto mkitem = [&](int it) -> TItem {
        int r = it;
        if (r < I_IN) { const int kb = r >> 6, d = r & 63, pn = d >> 3, beta = d & 7, bj = beta >> 2, wc = beta & 3;
            return TItem{a.in[2], DIN, 256 * pn + 32 * (2 * wc + bj), a.in[1], WIN, DM, 32 * d, 64 * kb}; } r -= I_IN;
        if (r < I_GLU) { const int kb = r >> 4, d = r & 15; return TItem{a.in[11], DSSM, 32 * d, nullptr, WGLU, DSSM, 32 * d, 64 * kb}; } r -= I_GLU;
        if (r < I_OUT) { const int kb = r >> 5, d = r & 31; const float* ks = (kb < 8) ? a.in[15] : (a.in[16] - 512);
            return TItem{a.in[17], DM, 32 * d, ks, WOUT, DM, 32 * d, 64 * kb}; } r -= I_OUT;
        if (r < I_GU) { const int e = r >> 9, q = r & 511, kb = q >> 5, d = q & 31, pn = d >> 3, beta = d & 7;
            const float* W = (beta < 4 ? a.in[23] : a.in[24]) + (size_t)e * DM * DE;
            return TItem{W, DE, 128 * pn + 32 * (beta & 3), a.in[18], WGU + (size_t)e * DM * DM, DM, 32 * d, 64 * kb}; } r -= I_GU;
        const int e = r >> 8, q = r & 255, kb = q >> 5, d = q & 31;
        return TItem{a.in[25] + (size_t)e * DE * DM, DM, 32 * d, nullptr, WD + (size_t)e * DM * DE, DE, 32 * d, 64 * kb};
    };
    if (gw < NITEMS) {
        TItem cur = mkitem(gw); f32x4 vc[8]; titem_load(cur, F.lane, vc);
        for (int it = gw; it < NITEMS; it += NGW) {
            const bool more = it + NGW < NITEMS; TItem nxt = cur; f32x4 vn[8];
            if (more) { nxt = mkitem(it + NGW); titem_load(nxt, F.lane, vn); }
            titem_store(cur, F.lane, vc, scr);
            if (more) { cur = nxt;
#pragma unroll
                for (int i = 0; i < 8; ++i) vc[i] = vn[i]; }
        }
    }
    { bf16* WR = (bf16*)(a.ws + FW_WR);
      for (int idx = F.c * NTHR + F.tid; idx < 64 * DM; idx += F.G * NTHR) { const int n = idx >> 10, k = idx & 1023;
          float v = 0.f; if (n < 4) v = a.in[19][k * 4 + n]; else if (n < 36) v = a.in[21][k * 32 + (n - 4)];
          WR[idx] = (bf16)f2bf(v * a.in[18][k]); } }
    bf16* XN = (bf16*)(a.ws + FW_XN);
    for (int m0 = gw * 4; m0 < M; m0 += NGW * 4) {
        f32x4 v[4][4];
#pragma unroll
        for (int rr = 0; rr < 4; ++rr)
#pragma unroll
            for (int j = 0; j < 4; ++j) v[rr][j] = ((const f32x4*)(x + (size_t)(m0 + rr) * DM))[64 * j + F.lane];
#pragma unroll
        for (int rr = 0; rr < 4; ++rr) { float s = 0.f;
#pragma unroll
            for (int j = 0; j < 4; ++j) s += v[rr][j].x * v[rr][j].x + v[rr][j].y * v[rr][j].y + v[rr][j].z * v[rr][j].z + v[rr][j].w * v[rr][j].w;
            const float rstd = 1.f / sqrtf(wave_sum(s) * (1.f / DM) + EPS);
            u32x2* o = (u32x2*)(XN + (size_t)(m0 + rr) * DM) + F.lane;
#pragma unroll
            for (int j = 0; j < 4; ++j) { u32x2 w; w.x = cvtpk(v[rr][j].x * rstd, v[rr][j].y * rstd); w.y = cvtpk(v[rr][j].z * rstd, v[rr][j].w * rstd); o[64 * j] = w; } }
    }
}

__device__ __forceinline__ void s5_scan(Frame& F, const Args& a) {
    const float* SST = (const float*)(a.ws + FW_SST); bf16* U2 = (bf16*)(a.ws + FW_U2);
    for (int idx = F.c * NTHR + F.tid; idx < BATCH * NG * PST; idx += F.G * NTHR) {
        const int p = idx & 63, g = (idx >> 6) & 31, b = idx >> 11;
        const double dt = exp((double)a.in[5][g]), lr = a.in[3][g * PST + p], li = a.in[4][g * PST + p];
        double sn, cs; sincos_d(32.0 * li * dt, sn, cs); const double mag = exp(32.0 * lr * dt);
        const float ar = (float)(mag * cs), ai = (float)(mag * sn);
        float xr = 0.f, xi = 0.f;
        const size_t row0 = (size_t)g * NCH + (size_t)b * 64;
        for (int c0 = 0; c0 < 64; c0 += 16) {
            float sr[16], si[16];
#pragma unroll
            for (int j = 0; j < 16; ++j) { sr[j] = SST[(row0 + c0 + j) * 128 + p]; si[j] = SST[(row0 + c0 + j) * 128 + 64 + p]; }
#pragma unroll
            for (int j = 0; j < 16; ++j) { bf16* up = U2 + (row0 + c0 + j) * U2P + 512; up[p] = (bf16)f2bf(xr); up[64 + p] = (bf16)f2bf(xi);
                const float t = ar * xr - ai * xi + sr[j]; xi = ar * xi + ai * xr + si[j]; xr = t; }
        }
    }
}

constexpr float ATT_THR = -100.f;
__device__ __forceinline__ s16x4 vtr(const LAS unsigned char* p) { typedef short v4i16_t __attribute__((ext_vector_type(4))); return __builtin_bit_cast(s16x4, __builtin_amdgcn_ds_read_tr16_b64_v4i16((LAS v4i16_t*)p)); }
__device__ __forceinline__ int crow(int r, int hi) { return (r & 3) + 8 * (r >> 2) + 4 * hi; }
#define MFMA32(a, b, c) __builtin_amdgcn_mfma_f32_32x32x16_bf16((a), (b), (c), 0, 0, 0)
template <bool DIAG, int P, int KH, int KD, int VD>
__device__ __forceinline__ float attn_half(const LAS unsigned char* Kb, const LAS unsigned char* Vb, const bf16x8 (&qr)[4], const bf16x8 (&tri)[2], f32x16 (&o)[2], float base, int lim, int lane) {
    const int r32 = lane & 31, hi = lane >> 5;
    const LAS unsigned char* kp = Kb + hi * KH + r32 * 16 + P * 512;
    const int lim2 = lim - 4 * hi;
    f32x16 z = {};
#pragma unroll
    for (int d0 = 0; d0 < 4; ++d0) { const bf16x8 kf = *(const LAS bf16x8*)(kp + d0 * KD); z = MFMA32(kf, qr[d0], z); }
    float l[16];
#pragma unroll
    for (int r = 0; r < 16; ++r) { l[r] = -__builtin_amdgcn_logf(1.f + __builtin_amdgcn_exp2f(z[r])); if (DIAG) { if (!((r & 3) + 8 * (r >> 2) + 32 * P < lim2)) l[r] = 0.f; } }
    const bf16x8 ones = {(short)0x3F80, (short)0x3F80, (short)0x3F80, (short)0x3F80, (short)0x3F80, (short)0x3F80, (short)0x3F80, (short)0x3F80};
    u32x4 wa, wb;
    wa.x = cvtpk(l[0], l[1]); wa.y = cvtpk(l[2], l[3]); wa.z = cvtpk(l[4], l[5]); wa.w = cvtpk(l[6], l[7]);
    wb.x = cvtpk(l[8], l[9]); wb.y = cvtpk(l[10], l[11]); wb.z = cvtpk(l[12], l[13]); wb.w = cvtpk(l[14], l[15]);
    const bf16x8 La = __builtin_bit_cast(bf16x8, wa), Lb = __builtin_bit_cast(bf16x8, wb);
    f32x16 T = {}, TT = {};
    T = MFMA32(tri[0], La, T); T = MFMA32(tri[1], Lb, T);
    TT = MFMA32(ones, La, TT); TT = MFMA32(ones, Lb, TT);
    float av[16];
#pragma unroll
    for (int r = 0; r < 16; ++r) { av[r] = __builtin_amdgcn_exp2f((z[r] + base) + T[r]); if (DIAG) { if (!((r & 3) + 8 * (r >> 2) + 32 * P < lim2)) av[r] = 0.f; } }
    wa.x = cvtpk(av[0], av[1]); wa.y = cvtpk(av[2], av[3]); wa.z = cvtpk(av[4], av[5]); wa.w = cvtpk(av[6], av[7]);
    wb.x = cvtpk(av[8], av[9]); wb.y = cvtpk(av[10], av[11]); wb.z = cvtpk(av[12], av[13]); wb.w = cvtpk(av[14], av[15]);
    const bf16x8 Pa = __builtin_bit_cast(bf16x8, wa), Pb = __builtin_bit_cast(bf16x8, wb);
    const LAS unsigned char* vp = Vb + ((lane >> 4) & 1) * 32 + (lane & 3) * 8 + (4 * hi + ((lane & 15) >> 2)) * 64 + P * 2048;
#pragma unroll
    for (int d0 = 0; d0 < 2; ++d0) {
        const s16x4 lo0 = vtr(vp + d0 * VD), hi0 = vtr(vp + d0 * VD + 512), lo1 = vtr(vp + d0 * VD + 1024), hi1 = vtr(vp + d0 * VD + 1536);
        const bf16x8 v0 = {lo0[0], lo0[1], lo0[2], lo0[3], hi0[0], hi0[1], hi0[2], hi0[3]}, v1 = {lo1[0], lo1[1], lo1[2], lo1[3], hi1[0], hi1[1], hi1[2], hi1[3]};
        o[d0] = MFMA32(Pa, v0, o[d0]); o[d0] = MFMA32(Pb, v1, o[d0]);
    }
    return TT[0];
}
template <bool DIAG>
__device__ __forceinline__ void attn_tile(const LAS unsigned char* Kb, const LAS unsigned char* Vb, const bf16x8 (&qr)[4], const bf16x8 (&tri)[2], f32x16 (&o)[2], float& Rc, int lim, int lane) {
    const float s1 = attn_half<DIAG, 1, 1024, 2048, 4096>(Kb, Vb, qr, tri, o, Rc, lim, lane);
    const float s0 = attn_half<DIAG, 0, 1024, 2048, 4096>(Kb, Vb, qr, tri, o, Rc + s1, lim, lane);
    Rc += s1 + s0;
}
__device__ __forceinline__ void attn_unit(Frame& F, const bf16* Q, const bf16* Kg, const bf16* Vg, bf16* YA, int b, int h, int qb) {
    const int tid = F.tid, lane = F.lane, wid = F.wave, r32 = lane & 31, hi = lane >> 5;
    LAS unsigned char* KB0 = F.lds; LAS unsigned char* VB0 = F.lds + 16384; volatile LAS int* FLG = (volatile LAS int*)(F.lds + 32768);
    const size_t row0 = (size_t)b * SEQ; const int q0 = qb * 256, qg = q0 + 32 * wid + r32;
    bf16x8 qr[4];
#pragma unroll
    for (int d0 = 0; d0 < 4; ++d0) qr[d0] = *(const bf16x8*)(Q + (row0 + qg) * DATT + h * HD + d0 * 16 + hi * 8);
    bf16x8 tri[2];
#pragma unroll
    for (int s = 0; s < 2; ++s)
#pragma unroll
        for (int j = 0; j < 8; ++j) tri[s][j] = ((16 * s + 8 * (j >> 2) + 4 * hi + (j & 3)) >= r32) ? (short)0x3F80 : (short)0;
    f32x16 o[2] = {}; float Rc = 0.f;
    const int jt = 4 * qb + 3, jd = 4 * qb + (wid >> 1);
    bool done = false;
    const bf16* ksrc = Kg + (row0 + lane) * DATT + h * HD + wid * 8;
    const bf16* vsrc = Vg + (row0 + 16 * (wid & 3) + (lane >> 2)) * DATT + h * HD + (wid >> 2) * 32 + (lane & 3) * 8;
    u32x4 kreg = *(const u32x4*)(ksrc + (size_t)jt * 64 * DATT), vreg = *(const u32x4*)(vsrc + (size_t)jt * 64 * DATT);
    for (int j = jt;; --j) {
        const int buf = (jt - j) & 1;
        LAS unsigned char* Kb = KB0 + buf * 8192; LAS unsigned char* Vb = VB0 + buf * 8192;
        *(LAS u32x4*)(Kb + wid * 1024 + lane * 16) = kreg; *(LAS u32x4*)(Vb + wid * 1024 + lane * 16) = vreg;
        __syncthreads();
        if (j > 0) { kreg = *(const u32x4*)(ksrc + (size_t)(j - 1) * 64 * DATT); vreg = *(const u32x4*)(vsrc + (size_t)(j - 1) * 64 * DATT); }
        if (!done && j <= jd) {
            const int lim = qg - 64 * j;
            if (64 * j + 63 >= q0 + 32 * wid) attn_tile<true>(Kb, Vb, qr, tri, o, Rc, lim, lane);
            else attn_tile<false>(Kb, Vb, qr, tri, o, Rc, lim, lane);
            done = __all(Rc < ATT_THR);
        }
        if (lane == 0) FLG[wid] = done ? 1 : 0;
        __syncthreads();
        if (j == 0) break;
        int alld = 1;
#pragma unroll
        for (int w = 0; w < 8; ++w) alld &= FLG[w];
        if (alld) break;
    }
    { LAS unsigned char* stg = F.lds + 40960 + wid * 4096; LAS unsigned short* sp = (LAS unsigned short*)(stg + hi * 512 + r32 * 2);
#pragma unroll
      for (int r = 0; r < 16; ++r) { const int ro = ((r & 3) + 8 * (r >> 2)) * 64; sp[ro] = (unsigned short)f2bf(o[0][r]); sp[ro + 32] = (unsigned short)f2bf(o[1][r]); }
      asm volatile("s_waitcnt lgkmcnt(0)" ::: "memory");
      bf16* ow = YA + (row0 + q0 + 32 * wid) * DATT + h * HD;
#pragma unroll
      for (int i = 0; i < 4; ++i) { const int row = i * 8 + (lane >> 3), ch = lane & 7; const u32x4 v = *(const LAS u32x4*)(stg + row * 128 + ch * 16); *(u32x4*)(ow + (size_t)row * DATT + ch * 8) = v; } }
    __syncthreads();
}

__device__ __forceinline__ void attn_wave_phase(Frame& F, const bf16* Q, const bf16* Kg, const bf16* Vg, bf16* YA) {
    const int lane = F.lane, r32 = lane & 31, hi = lane >> 5;
    LAS unsigned char* wb = F.lds + F.wave * 16384;
    bf16x8 tri[2];
#pragma unroll
    for (int s = 0; s < 2; ++s)
#pragma unroll
        for (int j = 0; j < 8; ++j) tri[s][j] = ((16 * s + 8 * (j >> 2) + 4 * hi + (j & 3)) >= r32) ? (short)0x3F80 : (short)0;
    const int gw = F.c * NWAVES + F.wave, NGW = F.G * NWAVES;
    for (int u = gw; u < BATCH * NH * (SEQ / 32); u += NGW) {
        const int bh = u >> 6, a = u & 63, b = bh >> 3, h = bh & 7;
        const size_t row0 = (size_t)b * SEQ; const int qg = 32 * a + r32;
        bf16x8 qr[4];
#pragma unroll
        for (int d0 = 0; d0 < 4; ++d0) qr[d0] = *(const bf16x8*)(Q + (row0 + qg) * DATT + h * HD + d0 * 16 + hi * 8);
        const bf16* ksrc = Kg + (row0 + (lane & 31)) * DATT + h * HD + (lane >> 5) * 8;
        const bf16* vsrc = Vg + (row0 + (lane >> 2)) * DATT + h * HD + (lane & 3) * 8;
#define ATT_DMA(jj, slot) do { _Pragma("unroll") for (int i_ = 0; i_ < 4; ++i_) { \
            __builtin_amdgcn_global_load_lds((const unsigned*)(ksrc + (size_t)(32 * (jj)) * DATT + 16 * i_), (LAS unsigned*)(wb + (slot) * 8192 + i_ * 1024), 16, 0, 0); \
            __builtin_amdgcn_global_load_lds((const unsigned*)(vsrc + (size_t)(32 * (jj) + 16 * (i_ & 1)) * DATT + 32 * (i_ >> 1)), (LAS unsigned*)(wb + (slot) * 8192 + 4096 + i_ * 1024), 16, 0, 0); } } while (0)
        f32x16 o[2] = {}; float Rc = 0.f;
        ATT_DMA(a, 0);
        int it = 0;
        for (int jj = a;; --jj, ++it) {
            const int slot = it & 1;
            if (jj > 0) { ATT_DMA(jj - 1, slot ^ 1); asm volatile("s_waitcnt vmcnt(8)" ::: "memory"); }
            else asm volatile("s_waitcnt vmcnt(0)" ::: "memory");
            const LAS unsigned char* Kb = wb + slot * 8192; const LAS unsigned char* Vb = Kb + 4096;
            const int lim = qg - 32 * jj;
            float sh;
            if (jj == a) sh = attn_half<true, 0, 512, 1024, 2048>(Kb, Vb, qr, tri, o, Rc, lim, lane);
            else sh = attn_half<false, 0, 512, 1024, 2048>(Kb, Vb, qr, tri, o, Rc, lim, lane);
            Rc += sh;
            if (jj == 0 || __all(Rc < ATT_THR)) break;
        }
#undef ATT_DMA
        { LAS unsigned char* stg = wb + (it & 1) * 8192; LAS unsigned short* sp = (LAS unsigned short*)(stg + hi * 512 + r32 * 2);
          asm volatile("s_waitcnt lgkmcnt(0)" ::: "memory");
#pragma unroll
          for (int r = 0; r < 16; ++r) { const int ro = ((r & 3) + 8 * (r >> 2)) * 64; sp[ro] = (unsigned short)f2bf(o[0][r]); sp[ro + 32] = (unsigned short)f2bf(o[1][r]); }
          asm volatile("s_waitcnt lgkmcnt(0)" ::: "memory");
          bf16* ow = YA + (row0 + 32 * a) * DATT + h * HD;
#pragma unroll
          for (int i = 0; i < 4; ++i) { const int row = i * 8 + (lane >> 3), ch = lane & 7; const u32x4 v = *(const LAS u32x4*)(stg + row * 128 + ch * 16); *(u32x4*)(ow + (size_t)row * DATT + ch * 8) = v; }
          asm volatile("s_waitcnt lgkmcnt(0)" ::: "memory"); }
    }
    asm volatile("s_waitcnt vmcnt(0)" ::: "memory");
    __syncthreads();
}

__device__ __forceinline__ void mixnorm(Frame& F, const Args& a) {
    const bf16* YS = (const bf16*)(a.ws + FW_YS); const bf16* YA = (const bf16*)(a.ws + FW_YA); bf16* MIX = (bf16*)(a.ws + FW_MIX);
    const int gw = F.c * NWAVES + F.wave, NGW = F.G * NWAVES, lane = F.lane;
    for (int m = gw; m < M; m += NGW) {
#pragma unroll
        for (int half = 0; half < 2; ++half) {
            const u32x4 w = *(const u32x4*)((half ? YA : YS) + (size_t)m * 512 + lane * 8); float v[8];
            v[0] = bf2f(w.x & 0xffff); v[1] = bf2f(w.x >> 16); v[2] = bf2f(w.y & 0xffff); v[3] = bf2f(w.y >> 16); v[4] = bf2f(w.z & 0xffff); v[5] = bf2f(w.z >> 16); v[6] = bf2f(w.w & 0xffff); v[7] = bf2f(w.w >> 16);
            float s = 0.f;
#pragma unroll
            for (int i = 0; i < 8; ++i) s += v[i] * v[i];
            const float rstd = 1.f / sqrtf(wave_sum(s) * (1.f / 512.f) + EPS);
            u32x4 o; o.x = cvtpk(v[0] * rstd, v[1] * rstd); o.y = cvtpk(v[2] * rstd, v[3] * rstd); o.z = cvtpk(v[4] * rstd, v[5] * rstd); o.w = cvtpk(v[6] * rstd, v[7] * rstd);
            *(u32x4*)(MIX + (size_t)m * DM + half * 512 + lane * 8) = o;
        }
    }
}

constexpr int RT_PITCH = 2064;
__device__ __forceinline__ void router_phase(Frame& F, const Args& a) {
    const float* x1 = a.out; bf16* H2 = (bf16*)(a.ws + FW_H2); int* TOK = (int*)(a.ws + FW_TOK); const bf16* WR = (const bf16*)(a.ws + FW_WR);
    const float* brg = a.in[20]; const float* bre_ = a.in[22];
    const int tid = F.tid, lane = F.lane, wid = F.wave, r32 = lane & 31, hi = lane >> 5;
    LAS unsigned char* TILE = F.lds;
    LAS float* PART = (LAS float*)(F.lds + 66048);
    LAS float* LOGIT = (LAS float*)(F.lds + 66048 + 65536);
    LAS int* HIST = (LAS int*)(F.lds + 66048 + 65536 + 5120);
    LAS int* TREC = HIST + 64;
    static_assert(66048 + 65536 + 5120 + 256 + 4096 <= MISC_OFF, "router LDS");
    bf16x8 Bf[8][2];
#pragma unroll
    for (int s = 0; s < 8; ++s)
#pragma unroll
        for (int nb = 0; nb < 2; ++nb) Bf[s][nb] = *(const bf16x8*)(WR + (size_t)(32 * nb + r32) * DM + 128 * wid + 16 * s + 8 * hi);
    if (tid < 64) HIST[tid] = 0;
    __syncthreads();
    int ntl = 0;
    for (int tile = F.c; tile < M / 32; tile += F.G, ++ntl) {
#pragma unroll
        for (int rr = 0; rr < 4; ++rr) { const int lr = 4 * wid + rr, m = tile * 32 + lr;
            const f32x4* xr = (const f32x4*)(x1 + (size_t)m * DM) + lane;
            f32x4 v[4]; float s = 0.f;
#pragma unroll
            for (int j = 0; j < 4; ++j) { v[j] = xr[64 * j]; s += v[j].x * v[j].x + v[j].y * v[j].y + v[j].z * v[j].z + v[j].w * v[j].w; }
            const float rstd = 1.f / sqrtf(wave_sum(s) * (1.f / DM) + EPS);
#pragma unroll
            for (int j = 0; j < 4; ++j) { u32x2 w; w.x = cvtpk(v[j].x * rstd, v[j].y * rstd); w.y = cvtpk(v[j].z * rstd, v[j].w * rstd);
                ((u32x2*)(H2 + (size_t)m * DM))[64 * j + lane] = w; *(LAS u32x2*)(TILE + lr * RT_PITCH + (64 * j + lane) * 8) = w; }
        }
        __syncthreads();
        { f32x16 c0 = {}, c1 = {};
#pragma unroll
          for (int s = 0; s < 8; ++s) { const bf16x8 af = *(const LAS bf16x8*)(TILE + r32 * RT_PITCH + (128 * wid + 16 * s + 8 * hi) * 2);
              c0 = MFMA32(af, Bf[s][0], c0); c1 = MFMA32(af, Bf[s][1], c1); }
#pragma unroll
          for (int r = 0; r < 16; ++r) { const int t = crow(r, hi); PART[(wid * 32 + t) * 64 + r32] = c0[r]; PART[(wid * 32 + t) * 64 + 32 + r32] = c1[r]; } }
        __syncthreads();
        { const int t = tid >> 4, c4 = (tid & 15) * 4;
          if (c4 < 40) { f32x4 s = {0.f, 0.f, 0.f, 0.f};
#pragma unroll
              for (int w = 0; w < 8; ++w) s += *(const LAS f32x4*)(PART + (w * 32 + t) * 64 + c4);
              *(LAS f32x4*)(LOGIT + t * 40 + c4) = s; } }
        __syncthreads();
        if (tid < 32) { const int m = tile * 32 + tid; float lg[36];
#pragma unroll
            for (int c = 0; c < 36; ++c) lg[c] = LOGIT[tid * 40 + c] + (c < 4 ? brg[c] : bre_[c - 4]);
            int gi = 0; float gm = lg[0];
#pragma unroll
            for (int c = 1; c < 4; ++c) if (lg[c] > gm) { gm = lg[c]; gi = c; }
            float gsum = 0.f;
#pragma unroll
            for (int c = 0; c < 4; ++c) gsum += __expf(lg[c] - gm);
            const float pgrp = 1.f / gsum;
            float el[8];
#pragma unroll
            for (int e = 0; e < 8; ++e) { float t = 0.f;
#pragma unroll
                for (int g2 = 0; g2 < 4; ++g2) if (g2 == gi) t = lg[4 + g2 * 8 + e];
                el[e] = t; }
            int i0 = 0; float m0 = el[0];
#pragma unroll
            for (int e = 1; e < 8; ++e) if (el[e] > m0) { m0 = el[e]; i0 = e; }
            int i1 = 0; float m1 = -3.0e38f;
#pragma unroll
            for (int e = 0; e < 8; ++e) if (e != i0 && el[e] > m1) { m1 = el[e]; i1 = e; }
            const float e1 = __expf(m1 - m0), p0 = 1.f / (1.f + e1), p1 = e1 / (1.f + e1);
            const int ex0 = gi * 8 + i0, ex1 = gi * 8 + i1;
            const int rk0 = atomicAdd((int*)&HIST[ex0], 1), rk1 = atomicAdd((int*)&HIST[ex1], 1);
            int* tk = TOK + (size_t)m * 8; tk[0] = ex0; tk[1] = ex1; tk[2] = __float_as_int(pgrp * p0); tk[3] = __float_as_int(pgrp * p1);
            LAS int* tr = TREC + (ntl * 32 + tid) * 4; tr[0] = ex0; tr[1] = ex1; tr[2] = rk0; tr[3] = rk1;
        }
        __syncthreads();
    }
    if (tid < 32) { const int cnt = HIST[tid]; int base = 0; if (cnt > 0) base = (int)__hip_atomic_fetch_add(F.ctl + CW_CNT + tid, (unsigned)cnt, RLX_AGENT); HIST[32 + tid] = base; }
    __syncthreads();
    for (int i = tid; i < ntl * 32; i += NTHR) { const int tile = F.c + (i >> 5) * F.G, m = tile * 32 + (i & 31); const LAS int* tr = TREC + i * 4;
        int* tk = TOK + (size_t)m * 8; tk[4] = HIST[32 + tr[0]] + tr[2]; tk[5] = HIST[32 + tr[1]] + tr[3]; }
    __syncthreads();
}
__device__ __forceinline__ int moe_tables(Frame& F) {
    LAS int* TST = (LAS int*)(F.lds + SCR2_OFF); LAS unsigned char* T2E = F.lds + SCR2_OFF + 256;
    if (F.tid == 0) { int acc = 0;
        for (int e = 0; e < NE; ++e) { TST[e] = acc; const int cnt = (int)__hip_atomic_load(F.ctl + CW_CNT + e, RLX_AGENT); const int nt = (cnt + 255) >> 8;
            for (int t = 0; t < nt; ++t) T2E[acc + t] = (unsigned char)e; acc += nt; }
        TST[NE] = acc; }
    __syncthreads();
    return TST[NE];
}
__device__ __forceinline__ void gather_phase(Frame& F, const Args& a) {
    const bf16* H2 = (const bf16*)(a.ws + FW_H2); bf16* XG = (bf16*)(a.ws + FW_XG); const int* TOK = (const int*)(a.ws + FW_TOK);
    const LAS int* TST = (const LAS int*)(F.lds + SCR2_OFF);
    const int gw = F.c * NWAVES + F.wave, NGW = F.G * NWAVES, lane = F.lane;
    for (int m = gw; m < M; m += NGW) {
        const int* tk = TOK + (size_t)m * 8; const int e0 = tk[0], e1 = tk[1], s0 = tk[4], s1 = tk[5];
        const size_t p0 = (size_t)TST[e0] * 256 + s0, p1 = (size_t)TST[e1] * 256 + s1;
        const u32x4* src = (const u32x4*)(H2 + (size_t)m * DM); const u32x4 v0 = src[lane], v1 = src[64 + lane];
        u32x4* d0 = (u32x4*)(XG + p0 * DM); u32x4* d1 = (u32x4*)(XG + p1 * DM);
        d0[lane] = v0; d0[64 + lane] = v1; d1[lane] = v0; d1[64 + lane] = v1;
    }
}
__device__ __forceinline__ void combine_phase(Frame& F, const Args& a) {
    const bf16* YE = (const bf16*)(a.ws + FW_YE); const int* TOK = (const int*)(a.ws + FW_TOK); float* out = a.out;
    const LAS int* TST = (const LAS int*)(F.lds + SCR2_OFF);
    const int gw = F.c * NWAVES + F.wave, NGW = F.G * NWAVES, lane = F.lane;
    for (int m = gw; m < M; m += NGW) {
        const int* tk = TOK + (size_t)m * 8; const int e0 = tk[0], e1 = tk[1], s0 = tk[4], s1 = tk[5]; const float g0 = __int_as_float(tk[2]), g1 = __int_as_float(tk[3]);
        const size_t p0 = (size_t)TST[e0] * 256 + s0, p1 = (size_t)TST[e1] * 256 + s1;
        const u32x4* y0 = (const u32x4*)(YE + p0 * DM); const u32x4* y1 = (const u32x4*)(YE + p1 * DM);
        f32x4* o = (f32x4*)(out + (size_t)m * DM);
#pragma unroll
        for (int j = 0; j < 2; ++j) { const u32x4 a0 = y0[64 * j + lane], a1 = y1[64 * j + lane];
            f32x4 x0 = o[2 * (64 * j + lane)], x1v = o[2 * (64 * j + lane) + 1];
            x0.x += g0 * bf2f(a0.x & 0xffff) + g1 * bf2f(a1.x & 0xffff); x0.y += g0 * bf2f(a0.x >> 16) + g1 * bf2f(a1.x >> 16);
            x0.z += g0 * bf2f(a0.y & 0xffff) + g1 * bf2f(a1.y & 0xffff); x0.w += g0 * bf2f(a0.y >> 16) + g1 * bf2f(a1.y >> 16);
            x1v.x += g0 * bf2f(a0.z & 0xffff) + g1 * bf2f(a1.z & 0xffff); x1v.y += g0 * bf2f(a0.z >> 16) + g1 * bf2f(a1.z >> 16);
            x1v.z += g0 * bf2f(a0.w & 0xffff) + g1 * bf2f(a1.w & 0xffff); x1v.w += g0 * bf2f(a0.w >> 16) + g1 * bf2f(a1.w >> 16);
            o[2 * (64 * j + lane)] = x0; o[2 * (64 * j + lane) + 1] = x1v; }
    }
}

constexpr int NPHASE = 13;
__global__ void __launch_bounds__(NTHR, 2) mk_fwd(Args args) {
    extern __shared__ __attribute__((aligned(16))) unsigned char lds_raw[];
    Frame F;
    F.lds = (LAS unsigned char*)lds_raw; F.MISC = (volatile LAS unsigned*)(F.lds + MISC_OFF);
    F.tid = threadIdx.x; F.lane = F.tid & 63; F.wave = __builtin_amdgcn_readfirstlane(F.tid >> 6);
    F.G = gridDim.x; F.c = blockIdx.x; F.ctl = (unsigned*)(args.ws + WS_CTL);
    if (F.tid < 64) F.MISC[F.tid] = 0u;
    __syncthreads();
    XcdBarrier bar = xcd_barrier_post(F.ctl + CW_BAR, F.MISC + 8);
    const int lo = args.ph_lo, hi = args.ph_hi;
    unsigned char* ws = args.ws;
#ifndef PH_MASK
#define PH_MASK 0x1fff
#endif
#define IN(k) ((((PH_MASK) >> (k)) & 1) && lo <= (k) && (k) < hi)
#define SEAM(k) do { if (IN(k) && IN((k) + 1)) xcd_barrier(bar); } while (0)
#ifndef REP_MASK
#define REP_MASK 0
#endif
#define REPS(k) _Pragma("unroll") for (int rep_ = 0; rep_ < ((((REP_MASK) >> (k)) & 1) ? 2 : 1); ++rep_)
    if (IN(0)) REPS(0) { p0_prologue(F, args); } SEAM(0);
    if (IN(1)) REPS(1) {
        GemmP g{DM * 2, DM * 2, DM}; DenseOrder S{(const char*)(ws + FW_XN), (const char*)(ws + FW_WIN), (size_t)256 * DM * 2, (size_t)256 * DM * 2, M / 256, DIN / 256, (M / 256) * (DIN / 256), F.G, F.c};
        EpiProj E{(bf16*)(ws + FW_U2), (bf16*)(ws + FW_Q), args.in[13], args.in[14]};
        gemm_phase(F.lds, g, S, E); } SEAM(1);
    if (IN(2)) REPS(2) {
        GemmP g{U2P * 2, 512 * 2, 512}; GroupOrder S{(const char*)(ws + FW_U2), (const char*)(ws + FW_W1), (size_t)NCH * U2P * 2, (size_t)256 * 512 * 2, (size_t)256 * U2P * 2, 0, NCH / 256, 1, NG * (NCH / 256), F.G, F.c};
        EpiState E{(float*)(ws + FW_SST)};
        gemm_phase(F.lds, g, S, E); } SEAM(2);
    if (IN(3)) REPS(3) {
#ifndef NO_SCAN
        s5_scan(F, args);
#endif
#ifndef NO_ATTN
        const bf16* Q = (const bf16*)(ws + FW_Q); const bf16* Kg = (const bf16*)(ws + FW_K); const bf16* Vg = (const bf16*)(ws + FW_V); bf16* YA = (bf16*)(ws + FW_YA);
#ifdef ATTN_V1
        for (int L = F.c; L < BATCH * NH * 8; L += F.G) { const int bh = L >> 3, qb = L & 7; attn_unit(F, Q, Kg, Vg, YA, bh >> 3, bh & 7, qb); }
#else
        attn_wave_phase(F, Q, Kg, Vg, YA);
#endif
#endif
    } SEAM(3);
    if (IN(4)) REPS(4) {
        GemmP g{U2P * 2, U2P * 2, U2P}; GroupOrder S{(const char*)(ws + FW_U2), (const char*)(ws + FW_TB), (size_t)NCH * U2P * 2, (size_t)512 * U2P * 2, (size_t)256 * U2P * 2, (size_t)256 * U2P * 2, NCH / 256, 2, NG * (NCH / 256) * 2, F.G, F.c};
        EpiS5 E{(bf16*)(ws + FW_Z)};
        gemm_phase(F.lds, g, S, E); } SEAM(4);
    if (IN(5)) REPS(5) {
        GemmP g{DSSM * 2, DSSM * 2, DSSM}; DenseOrder S{(const char*)(ws + FW_Z), (const char*)(ws + FW_WGLU), (size_t)256 * DSSM * 2, (size_t)256 * DSSM * 2, M / 256, 2, (M / 256) * 2, F.G, F.c};
        EpiGlu E{(const bf16*)(ws + FW_Z), args.in[12], (bf16*)(ws + FW_YS)};
        gemm_phase(F.lds, g, S, E); } SEAM(5);
    if (IN(6)) REPS(6) { mixnorm(F, args); } SEAM(6);
    if (IN(7)) REPS(7) {
        GemmP g{DM * 2, DM * 2, DM}; DenseOrder S{(const char*)(ws + FW_MIX), (const char*)(ws + FW_WOUT), (size_t)256 * DM * 2, (size_t)256 * DM * 2, M / 256, 4, (M / 256) * 4, F.G, F.c};
        EpiOut E{args.in[0], args.out};
        gemm_phase(F.lds, g, S, E); } SEAM(7);
    if (IN(8)) { router_phase(F, args); } SEAM(8);
    int ntiles = 0;
    if (IN(9) || IN(10) || IN(11) || IN(12)) ntiles = moe_tables(F);
    if (IN(9)) REPS(9) { gather_phase(F, args); } SEAM(9);
    if (IN(10)) REPS(10) {
        GemmP g{DM * 2, DM * 2, DM}; MoeOrder S{(const char*)(ws + FW_XG), (const char*)(ws + FW_WGU), (size_t)256 * DM * 2, (size_t)DM * DM * 2, (size_t)256 * DM * 2, F.lds + SCR2_OFF + 256, ntiles, F.G, F.c};
        EpiGU E{(bf16*)(ws + FW_HH)};
        gemm_phase(F.lds, g, S, E); } SEAM(10);
    if (IN(11)) REPS(11) {
        GemmP g{DE * 2, DE * 2, DE}; MoeOrder S{(const char*)(ws + FW_HH), (const char*)(ws + FW_WD), (size_t)256 * DE * 2, (size_t)DM * DE * 2, (size_t)256 * DE * 2, F.lds + SCR2_OFF + 256, ntiles, F.G, F.c};
        EpiDown E{(bf16*)(ws + FW_YE)};
        gemm_phase(F.lds, g, S, E); } SEAM(11);
    if (IN(12)) { combine_phase(F, args); }
#undef IN
#undef SEAM
}
}

#ifndef FAST_UPTO
#define FAST_UPTO 12
#endif
#ifndef NAIVE_ATTN_OVERRIDE
#define NAIVE_ATTN_OVERRIDE 0
#endif
#ifndef NAIVE_S5_OVERRIDE
#define NAIVE_S5_OVERRIDE 0
#endif
extern "C" void kernel_launch(void* const* d_in, const int* in_sizes, int n_in, void* d_out, int out_size, void* d_ws, size_t ws_size, hipStream_t stream) {
    static int grid = 0;
    if (grid == 0) {
        if (n_in != 26 || out_size != M * DM || ws_size < mk::FW_END) { fprintf(stderr, "kernel_launch: unexpected shapes (n_in %d out %d ws %zu, need %zu)\n", n_in, out_size, ws_size, (size_t)mk::FW_END); grid = -1; return; }
        int dev = 0, cus = 0, per_cu = 0;
        if (hipGetDevice(&dev) != hipSuccess || hipDeviceGetAttribute(&cus, hipDeviceAttributeMultiprocessorCount, dev) != hipSuccess) { grid = -1; return; }
        if (hipFuncSetAttribute((const void*)mk::mk_fwd, hipFuncAttributeMaxDynamicSharedMemorySize, mk::LDS_BYTES) != hipSuccess) { fprintf(stderr, "kernel_launch: hipFuncSetAttribute failed\n"); grid = -1; return; }
        if (hipOccupancyMaxActiveBlocksPerMultiprocessor(&per_cu, (const void*)mk::mk_fwd, mk::NTHR, mk::LDS_BYTES) != hipSuccess || per_cu < 1) { fprintf(stderr, "kernel_launch: occupancy query says %d\n", per_cu); }
        (void)hipGetLastError();
        grid = cus;
        if (grid != 256) fprintf(stderr, "kernel_launch: %d CUs (built for 256)\n", grid);
    }
    if (grid < 0) return;
    const float* const* in = (const float* const*)d_in;
    unsigned char* ws = (unsigned char*)d_ws; float* out = (float*)d_out;
    mk::Args a{};
    for (int i = 0; i < 26; ++i) a.in[i] = in[i];
    a.out = out; a.ws = ws;
    auto launch = [&](int lo, int hi) {
        (void)hipMemsetAsync(ws + WS_CTL, 0, mk::CTL_ZERO_BYTES, stream);
        a.ph_lo = lo; a.ph_hi = hi;
        hipLaunchKernelGGL(mk::mk_fwd, dim3(grid), dim3(mk::NTHR), mk::LDS_BYTES, stream, a);
    };
#if FAST_UPTO == 12 && !NAIVE_ATTN_OVERRIDE && !NAIVE_S5_OVERRIDE
    launch(0, mk::NPHASE);
#else
    bf16* Q = (bf16*)(ws + mk::FW_Q); bf16* Kb = (bf16*)(ws + mk::FW_K); bf16* V = (bf16*)(ws + mk::FW_V); bf16* U2 = (bf16*)(ws + mk::FW_U2);
    bf16* Z = (bf16*)(ws + mk::FW_Z); bf16* YS = (bf16*)(ws + mk::FW_YS); bf16* YA = (bf16*)(ws + mk::FW_YA); bf16* MIX = (bf16*)(ws + mk::FW_MIX); bf16* H2 = (bf16*)(ws + mk::FW_H2);
    int* TOK = (int*)(ws + mk::FW_TOK);
    launch(0, (FAST_UPTO < 5 ? FAST_UPTO : 5) + 1);
    if (FAST_UPTO < 5 || NAIVE_S5_OVERRIDE) {
        nv::k_s5<<<BATCH * NG, 64, 0, stream>>>(U2, in[3], in[4], in[5], in[6], in[7], in[8], in[9], in[10], Z);
        nv::GArgs g{}; g.A = Z; g.lda = DSSM; g.ascale = nullptr; g.B = in[11]; g.ldb = DSSM; g.K = DSSM; g.ldc = DSSM; g.bias = in[12]; g.Zin = Z; g.Ob = YS;
        nv::k_gemm<1><<<dim3(DSSM / 64, M / 64), 256, 0, stream>>>(g);
    }
    if (FAST_UPTO < 3 || NAIVE_ATTN_OVERRIDE) nv::k_attn<<<dim3(SEQ / 64, NH, BATCH), 64, 0, stream>>>(Q, Kb, V, YA);
    if (FAST_UPTO >= 7) launch(6, 8);
    else {
        nv::k_mixnorm<<<2048, 256, 0, stream>>>(YS, YA, in[15], in[16], MIX, 1);
        nv::GArgs g{}; g.A = MIX; g.lda = DM; g.ascale = nullptr; g.B = in[17]; g.ldb = DM; g.K = DM; g.ldc = DM; g.X = in[0]; g.Out = out;
        nv::k_gemm<2><<<dim3(DM / 64, M / 64), 256, 0, stream>>>(g);
    }
    if (FAST_UPTO >= 12) launch(8, 13);
    else {
        nv::k_router<<<2048, 256, 0, stream>>>(out, in[18], in[19], in[20], in[21], in[22], H2, TOK, 1);
        nv::k_moe<<<M, 256, 0, stream>>>(H2, TOK, in[23], in[24], in[25], out);
    }
#endif
}
```

```cpp
#define FAST_UPTO 12

#include <hip/hip_runtime.h>
#include <cstdio>
#include <cstdint>

typedef unsigned short bf16;
typedef float f32x4 __attribute__((ext_vector_type(4)));
typedef unsigned u32x4 __attribute__((ext_vector_type(4)));
typedef unsigned u32x2 __attribute__((ext_vector_type(2)));

constexpr int DM = 1024, BATCH = 32, SEQ = 2048, M = BATCH * SEQ;
constexpr int DSSM = 512, NG = 32, GS = 16, PST = 64, HD = 64, DATT = 512, NH = 8, DIN = 2048;
constexpr int NEG = 4, EPG = 8, NE = 32, DE = 512;
constexpr float EPS = 1e-6f;
constexpr int LCH = 32;
constexpr int NCH = M / LCH;
constexpr int U2P = 640;
constexpr float C2 = 0.125f * 1.4426950408889634f;

constexpr size_t MiB = 1u << 20;
constexpr size_t WS_CTL = 0;
constexpr size_t WS_TOK = 2 * MiB;
constexpr size_t WS_XN = 8 * MiB;
constexpr size_t WS_Q = WS_XN + 128 * MiB;
constexpr size_t WS_K = WS_Q + 64 * MiB;
constexpr size_t WS_V = WS_K + 64 * MiB;
constexpr size_t WS_U2 = WS_V + 64 * MiB;
constexpr size_t WS_Z = WS_U2 + 80 * MiB;
constexpr size_t WS_YS = WS_Z + 64 * MiB;
constexpr size_t WS_YA = WS_YS + 64 * MiB;
constexpr size_t WS_MIX = WS_YA + 64 * MiB;
constexpr size_t WS_H2 = WS_XN;
constexpr size_t WS_PROJ = WS_Z;
constexpr size_t WS_END = WS_PROJ + 512 * MiB;

__device__ __forceinline__ unsigned f2bf(float f) { unsigned u = __builtin_bit_cast(unsigned, f); return (u + 0x7fffu + ((u >> 16) & 1u)) >> 16; }
__device__ __forceinline__ float bf2f(unsigned short h) { return __builtin_bit_cast(float, (unsigned)h << 16); }
__device__ __forceinline__ unsigned pk2(float lo, float hi) { return f2bf(lo) | (f2bf(hi) << 16); }
__device__ __forceinline__ float wave_sum(float v) {
#pragma unroll
    for (int o = 1; o < 64; o <<= 1) v += __shfl_xor(v, o);
    return v;
}
__device__ __forceinline__ void sincos_d(double th, double& s, double& c) {
    const double q = rint(th * 0.63661977236758134308);
    const double r = (th - q * 1.57079632679489655800) - q * 6.12323399573676603587e-17;
    const double r2 = r * r;
    double sp = -1.0 / 1307674368000.0; sp = sp * r2 + 1.0 / 6227020800.0; sp = sp * r2 - 1.0 / 39916800.0; sp = sp * r2 + 1.0 / 362880.0; sp = sp * r2 - 1.0 / 5040.0; sp = sp * r2 + 1.0 / 120.0; sp = sp * r2 - 1.0 / 6.0; sp = sp * r2 + 1.0;
    const double sn = sp * r;
    double cp = 1.0 / 20922789888000.0; cp = cp * r2 - 1.0 / 87178291200.0; cp = cp * r2 + 1.0 / 479001600.0; cp = cp * r2 - 1.0 / 3628800.0; cp = cp * r2 + 1.0 / 40320.0; cp = cp * r2 - 1.0 / 720.0; cp = cp * r2 + 1.0 / 24.0; cp = cp * r2 - 0.5; cp = cp * r2 + 1.0;
    const int qi = ((int)q) & 3;
    s = (qi == 0) ? sn : (qi == 1) ? cp : (qi == 2) ? -sn : -cp;
    c = (qi == 0) ? cp : (qi == 1) ? -sn : (qi == 2) ? -cp : sn;
}
__device__ __forceinline__ float gelu_tanh(float x) {
    const float u = 0.7978845608028654f * (x + 0.044715f * x * x * x);
    const float e = __expf(2.f * u);
    const float t = 1.f - 2.f / (e + 1.f);
    return 0.5f * x * (1.f + t);
}
__device__ __forceinline__ float sigmoidf_(float x) { return 1.f / (1.f + __expf(-x)); }

namespace nv {
__global__ __launch_bounds__(256) void k_xn(const float* __restrict__ x, bf16* __restrict__ xn) {
    const int lane = threadIdx.x & 63, gw = (blockIdx.x * 256 + threadIdx.x) >> 6, ngw = gridDim.x * 4;
    for (int m = gw; m < M; m += ngw) {
        const f32x4* xr = (const f32x4*)(x + (size_t)m * DM) + lane;
        f32x4 v[4]; float s = 0.f;
#pragma unroll
        for (int j = 0; j < 4; ++j) { v[j] = xr[64 * j]; s += v[j].x * v[j].x + v[j].y * v[j].y + v[j].z * v[j].z + v[j].w * v[j].w; }
        const float rstd = 1.f / sqrtf(wave_sum(s) * (1.f / DM) + EPS);
        u32x2* o = (u32x2*)(xn + (size_t)m * DM) + lane;
#pragma unroll
        for (int j = 0; j < 4; ++j) { u32x2 w; w.x = pk2(v[j].x * rstd, v[j].y * rstd); w.y = pk2(v[j].z * rstd, v[j].w * rstd); o[64 * j] = w; }
    }
}
struct GArgs { const bf16* A; int lda; const float* ascale; const float* B; int ldb; int K; float* Cf; int ldc; const float* bias; const bf16* Zin; bf16* Ob; const float* X; float* Out; };
template <int EPI> __global__ __launch_bounds__(256) void k_gemm(GArgs g) {
    __shared__ float As[16][68], Bs[16][68];
    const int tid = threadIdx.x, tx = tid & 15, ty = tid >> 4, m0 = blockIdx.y * 64, n0 = blockIdx.x * 64;
    float acc[4][4] = {};
    for (int k0 = 0; k0 < g.K; k0 += 16) {
        { const int r = tid >> 2, kk = (tid & 3) * 4; const u32x2 w = *(const u32x2*)(g.A + (size_t)(m0 + r) * g.lda + k0 + kk);
          float a0 = bf2f(w.x & 0xffff), a1 = bf2f(w.x >> 16), a2 = bf2f(w.y & 0xffff), a3 = bf2f(w.y >> 16);
          if (g.ascale) { a0 *= g.ascale[k0 + kk]; a1 *= g.ascale[k0 + kk + 1]; a2 *= g.ascale[k0 + kk + 2]; a3 *= g.ascale[k0 + kk + 3]; }
          As[kk][r] = a0; As[kk + 1][r] = a1; As[kk + 2][r] = a2; As[kk + 3][r] = a3; }
        { const int kk = tid >> 4, nn = (tid & 15) * 4; const f32x4 b = *(const f32x4*)(g.B + (size_t)(k0 + kk) * g.ldb + n0 + nn);
          Bs[kk][nn] = b.x; Bs[kk][nn + 1] = b.y; Bs[kk][nn + 2] = b.z; Bs[kk][nn + 3] = b.w; }
        __syncthreads();
#pragma unroll
        for (int k = 0; k < 16; ++k) { float a[4], b[4];
#pragma unroll
            for (int i = 0; i < 4; ++i) { a[i] = As[k][ty * 4 + i]; b[i] = Bs[k][tx * 4 + i]; }
#pragma unroll
            for (int i = 0; i < 4; ++i)
#pragma unroll
                for (int j = 0; j < 4; ++j) acc[i][j] += a[i] * b[j]; }
        __syncthreads();
    }
#pragma unroll
    for (int i = 0; i < 4; ++i) { const int m = m0 + ty * 4 + i;
#pragma unroll
        for (int j = 0; j < 4; ++j) { const int n = n0 + tx * 4 + j; const float v = acc[i][j];
            if (EPI == 0) g.Cf[(size_t)m * g.ldc + n] = v;
            else if (EPI == 1) { const float z = bf2f(g.Zin[(size_t)m * g.ldc + n]); g.Ob[(size_t)m * g.ldc + n] = (bf16)f2bf(z * sigmoidf_(v + g.bias[n])); }
            else if (EPI == 2) g.Out[(size_t)m * g.ldc + n] = g.X[(size_t)m * g.ldc + n] + v; } }
}
__global__ __launch_bounds__(256) void k_projpost(const float* __restrict__ P, const float* __restrict__ gq, const float* __restrict__ gk, bf16* U2, bf16* Q, bf16* Kb, bf16* V) {
    const int lane = threadIdx.x & 63, gw = (blockIdx.x * 256 + threadIdx.x) >> 6, ngw = gridDim.x * 4;
    for (int m = gw; m < M; m += ngw) {
        const float* pr = P + (size_t)m * DIN;
        for (int c = 0; c < 32; ++c) {
            const float v = pr[c * 64 + lane];
            if (c < 8) { const int ch = c * 64 + lane, g = ch >> 4, h = ch & 15; U2[((size_t)g * NCH + (m >> 5)) * U2P + (m & 31) * 16 + h] = (bf16)f2bf(v); }
            else if (c < 24) { const float rstd = 1.f / sqrtf(wave_sum(v * v) * (1.f / 64.f) + EPS);
                if (c < 16) Q[(size_t)m * DATT + (c - 8) * 64 + lane] = (bf16)f2bf(v * rstd * gq[lane] * C2);
                else Kb[(size_t)m * DATT + (c - 16) * 64 + lane] = (bf16)f2bf(v * rstd * gk[lane]); }
            else V[(size_t)m * DATT + (c - 24) * 64 + lane] = (bf16)f2bf(v);
        }
    }
}
__global__ __launch_bounds__(64) void k_s5(const bf16* __restrict__ U2, const float* lre, const float* lim, const float* ldt, const float* bre, const float* bim, const float* cre, const float* cim, const float* dsk, bf16* Z) {
    const int p = threadIdx.x, b = blockIdx.x >> 5, g = blockIdx.x & 31;
    const double dt = exp((double)ldt[g]), lr = lre[g * PST + p], li = lim[g * PST + p];
    double sn, cs; sincos_d(li * dt, sn, cs); const double mag = exp(lr * dt);
    const double ar = mag * cs, ai = mag * sn, den = lr * lr + li * li, nr = ar - 1.0, ni = ai;
    const double cfr = (nr * lr + ni * li) / den, cfi = (ni * lr - nr * li) / den;
    const float far = (float)ar, fai = (float)ai;
    float bbr[16], bbi[16], ccr[16], cci[16];
#pragma unroll
    for (int h = 0; h < 16; ++h) { const double br = bre[(g * PST + p) * GS + h], bi = bim[(g * PST + p) * GS + h];
        bbr[h] = (float)(cfr * br - cfi * bi); bbi[h] = (float)(cfr * bi + cfi * br);
        ccr[h] = cre[(g * GS + h) * PST + p]; cci[h] = cim[(g * GS + h) * PST + p]; }
    const float dme = dsk[g * GS + (p & 15)];
    float xr = 0.f, xi = 0.f;
    for (int t = 0; t < SEQ; ++t) {
        const int m = b * SEQ + t;
        const bf16* up = U2 + ((size_t)g * NCH + (m >> 5)) * U2P + (m & 31) * 16;
        const u32x4 w0 = *(const u32x4*)up, w1 = *(const u32x4*)(up + 8);
        float u[16];
        u[0] = bf2f(w0.x & 0xffff); u[1] = bf2f(w0.x >> 16); u[2] = bf2f(w0.y & 0xffff); u[3] = bf2f(w0.y >> 16); u[4] = bf2f(w0.z & 0xffff); u[5] = bf2f(w0.z >> 16); u[6] = bf2f(w0.w & 0xffff); u[7] = bf2f(w0.w >> 16);
        u[8] = bf2f(w1.x & 0xffff); u[9] = bf2f(w1.x >> 16); u[10] = bf2f(w1.y & 0xffff); u[11] = bf2f(w1.y >> 16); u[12] = bf2f(w1.z & 0xffff); u[13] = bf2f(w1.z >> 16); u[14] = bf2f(w1.w & 0xffff); u[15] = bf2f(w1.w >> 16);
        float br = 0.f, bi = 0.f;
#pragma unroll
        for (int h = 0; h < 16; ++h) { br += bbr[h] * u[h]; bi += bbi[h] * u[h]; }
        const float nxr = far * xr - fai * xi + br, nxi = far * xi + fai * xr + bi; xr = nxr; xi = nxi;
        float ymine = 0.f;
#pragma unroll
        for (int h = 0; h < 16; ++h) { const float s = wave_sum(ccr[h] * xr - cci[h] * xi); if ((p & 15) == h) ymine = s; }
        if (p < 16) { float uh = 0.f;
#pragma unroll
            for (int h = 0; h < 16; ++h) if (p == h) uh = u[h];
            Z[(size_t)m * DSSM + g * GS + p] = (bf16)f2bf(gelu_tanh(ymine + dme * uh)); }
    }
}
__global__ __launch_bounds__(64) void k_attn(const bf16* __restrict__ Q, const bf16* __restrict__ Kb, const bf16* __restrict__ V, bf16* YA) {
    const int t = blockIdx.x * 64 + threadIdx.x, h = blockIdx.y, b = blockIdx.z;
    const size_t row0 = (size_t)b * SEQ;
    float q[64], o[64];
    { const u32x4* qp = (const u32x4*)(Q + (row0 + t) * DATT + h * HD);
#pragma unroll
      for (int i = 0; i < 8; ++i) { const u32x4 w = qp[i]; q[8 * i] = bf2f(w.x & 0xffff); q[8 * i + 1] = bf2f(w.x >> 16); q[8 * i + 2] = bf2f(w.y & 0xffff); q[8 * i + 3] = bf2f(w.y >> 16); q[8 * i + 4] = bf2f(w.z & 0xffff); q[8 * i + 5] = bf2f(w.z >> 16); q[8 * i + 6] = bf2f(w.w & 0xffff); q[8 * i + 7] = bf2f(w.w >> 16); } }
#pragma unroll
    for (int i = 0; i < 64; ++i) o[i] = 0.f;
    float R = 0.f;
    for (int s = t - 1; s >= 0; --s) {
        const u32x4* kp = (const u32x4*)(Kb + (row0 + s) * DATT + h * HD);
        float z = 0.f;
#pragma unroll
        for (int i = 0; i < 8; ++i) { const u32x4 w = kp[i]; z += q[8 * i] * bf2f(w.x & 0xffff) + q[8 * i + 1] * bf2f(w.x >> 16) + q[8 * i + 2] * bf2f(w.y & 0xffff) + q[8 * i + 3] * bf2f(w.y >> 16) + q[8 * i + 4] * bf2f(w.z & 0xffff) + q[8 * i + 5] * bf2f(w.z >> 16) + q[8 * i + 6] * bf2f(w.w & 0xffff) + q[8 * i + 7] * bf2f(w.w >> 16); }
        const float e = exp2f(z), l = -log2f(1.f + e), a = exp2f(z + l + R);
        R += l;
        const u32x4* vp = (const u32x4*)(V + (row0 + s) * DATT + h * HD);
#pragma unroll
        for (int i = 0; i < 8; ++i) { const u32x4 w = vp[i]; o[8 * i] += a * bf2f(w.x & 0xffff); o[8 * i + 1] += a * bf2f(w.x >> 16); o[8 * i + 2] += a * bf2f(w.y & 0xffff); o[8 * i + 3] += a * bf2f(w.y >> 16); o[8 * i + 4] += a * bf2f(w.z & 0xffff); o[8 * i + 5] += a * bf2f(w.z >> 16); o[8 * i + 6] += a * bf2f(w.w & 0xffff); o[8 * i + 7] += a * bf2f(w.w >> 16); }
    }
    u32x4* op = (u32x4*)(YA + (row0 + t) * DATT + h * HD);
#pragma unroll
    for (int i = 0; i < 8; ++i) { u32x4 w; w.x = pk2(o[8 * i], o[8 * i + 1]); w.y = pk2(o[8 * i + 2], o[8 * i + 3]); w.z = pk2(o[8 * i + 4], o[8 * i + 5]); w.w = pk2(o[8 * i + 6], o[8 * i + 7]); op[i] = w; }
}
__global__ __launch_bounds__(256) void k_mixnorm(const bf16* __restrict__ YS, const bf16* __restrict__ YA, const float* gs, const float* ga, bf16* MIX, int gains) {
    const int lane = threadIdx.x & 63, gw = (blockIdx.x * 256 + threadIdx.x) >> 6, ngw = gridDim.x * 4;
    for (int m = gw; m < M; m += ngw) {
#pragma unroll
        for (int half = 0; half < 2; ++half) {
            const bf16* src = (half ? YA : YS) + (size_t)m * 512 + lane * 8; const float* gg = (half ? ga : gs) + lane * 8;
            const u32x4 w = *(const u32x4*)src; float v[8];
            v[0] = bf2f(w.x & 0xffff); v[1] = bf2f(w.x >> 16); v[2] = bf2f(w.y & 0xffff); v[3] = bf2f(w.y >> 16); v[4] = bf2f(w.z & 0xffff); v[5] = bf2f(w.z >> 16); v[6] = bf2f(w.w & 0xffff); v[7] = bf2f(w.w >> 16);
            float s = 0.f;
#pragma unroll
            for (int i = 0; i < 8; ++i) s += v[i] * v[i];
            const float rstd = 1.f / sqrtf(wave_sum(s) * (1.f / 512.f) + EPS);
#pragma unroll
            for (int i = 0; i < 8; ++i) v[i] *= rstd * (gains ? gg[i] : 1.f);
            u32x4 o; o.x = pk2(v[0], v[1]); o.y = pk2(v[2], v[3]); o.z = pk2(v[4], v[5]); o.w = pk2(v[6], v[7]);
            *(u32x4*)(MIX + (size_t)m * DM + half * 512 + lane * 8) = o;
        }
    }
}
__global__ __launch_bounds__(256) void k_router(const float* __restrict__ x1, const float* gffn, const float* wrg, const float* brg, const float* wre, const float* bre_, bf16* H2, int* TOK, int gains) {
    const int lane = threadIdx.x & 63, gw = (blockIdx.x * 256 + threadIdx.x) >> 6, ngw = gridDim.x * 4;
    for (int m = gw; m < M; m += ngw) {
        const f32x4* xr = (const f32x4*)(x1 + (size_t)m * DM) + lane;
        f32x4 v[4]; float s = 0.f;
#pragma unroll
        for (int j = 0; j < 4; ++j) { v[j] = xr[64 * j]; s += v[j].x * v[j].x + v[j].y * v[j].y + v[j].z * v[j].z + v[j].w * v[j].w; }
        const float rstd = 1.f / sqrtf(wave_sum(s) * (1.f / DM) + EPS);
        float hv[16];
#pragma unroll
        for (int j = 0; j < 4; ++j) { const f32x4 gg = ((const f32x4*)gffn)[64 * j + lane];
            hv[4 * j] = v[j].x * rstd * gg.x; hv[4 * j + 1] = v[j].y * rstd * gg.y; hv[4 * j + 2] = v[j].z * rstd * gg.z; hv[4 * j + 3] = v[j].w * rstd * gg.w;
            u32x2 w; if (gains) { w.x = pk2(hv[4 * j], hv[4 * j + 1]); w.y = pk2(hv[4 * j + 2], hv[4 * j + 3]); } else { w.x = pk2(v[j].x * rstd, v[j].y * rstd); w.y = pk2(v[j].z * rstd, v[j].w * rstd); }
            ((u32x2*)(H2 + (size_t)m * DM))[64 * j + lane] = w; }
        float lg[36];
#pragma unroll
        for (int c = 0; c < 36; ++c) { float a = 0.f;
#pragma unroll
            for (int j = 0; j < 4; ++j)
#pragma unroll
                for (int i = 0; i < 4; ++i) { const int k = 256 * j + 4 * lane + i; a += hv[4 * j + i] * (c < 4 ? wrg[k * 4 + c] : wre[k * 32 + (c - 4)]); }
            lg[c] = wave_sum(a) + (c < 4 ? brg[c] : bre_[c - 4]); }
        if (lane == 0) {
            int gi = 0; float gm = lg[0];
#pragma unroll
            for (int c = 1; c < 4; ++c) if (lg[c] > gm) { gm = lg[c]; gi = c; }
            float gsum = 0.f;
#pragma unroll
            for (int c = 0; c < 4; ++c) gsum += __expf(lg[c] - gm);
            const float pgrp = 1.f / gsum;
            float el[8];
#pragma unroll
            for (int e = 0; e < 8; ++e) { float t = 0.f;
#pragma unroll
                for (int g2 = 0; g2 < 4; ++g2) if (g2 == gi) t = lg[4 + g2 * 8 + e];
                el[e] = t; }
            int i0 = 0; float m0 = el[0];
#pragma unroll
            for (int e = 1; e < 8; ++e) if (el[e] > m0) { m0 = el[e]; i0 = e; }
            int i1 = -1; float m1 = -3.0e38f;
#pragma unroll
            for (int e = 0; e < 8; ++e) if (e != i0 && el[e] > m1) { m1 = el[e]; i1 = e; }
            const float e1 = __expf(m1 - m0), p0 = 1.f / (1.f + e1), p1 = e1 / (1.f + e1);
            int* tk = TOK + (size_t)m * 8;
            tk[0] = gi * 8 + i0; tk[1] = gi * 8 + i1; tk[2] = __float_as_int(pgrp * p0); tk[3] = __float_as_int(pgrp * p1);
        }
    }
}
__global__ __launch_bounds__(256) void k_moe(const bf16* __restrict__ H2, const int* __restrict__ TOK, const float* __restrict__ wg, const float* __restrict__ wu, const float* __restrict__ wd, float* out) {
    __shared__ float hs[DM]; __shared__ float hid[DE];
    const int m = blockIdx.x, tid = threadIdx.x;
    for (int k = tid; k < DM; k += 256) hs[k] = bf2f(H2[(size_t)m * DM + k]);
    __syncthreads();
    float oacc[4] = {0.f, 0.f, 0.f, 0.f};
    for (int kk = 0; kk < 2; ++kk) {
        const int e = TOK[(size_t)m * 8 + kk]; const float gate = __int_as_float(TOK[(size_t)m * 8 + 2 + kk]);
        const float* Wg = wg + (size_t)e * DM * DE; const float* Wu = wu + (size_t)e * DM * DE; const float* Wd = wd + (size_t)e * DE * DM;
        float g0 = 0.f, g1 = 0.f, u0 = 0.f, u1 = 0.f;
        for (int k = 0; k < DM; ++k) { const float hvv = hs[k]; g0 += hvv * Wg[(size_t)k * DE + tid]; g1 += hvv * Wg[(size_t)k * DE + tid + 256]; u0 += hvv * Wu[(size_t)k * DE + tid]; u1 += hvv * Wu[(size_t)k * DE + tid + 256]; }
        __syncthreads();
        hid[tid] = g0 * sigmoidf_(g0) * u0; hid[tid + 256] = g1 * sigmoidf_(g1) * u1;
        __syncthreads();
        float d[4] = {0.f, 0.f, 0.f, 0.f};
        for (int k = 0; k < DE; ++k) { const float hh = hid[k];
#pragma unroll
            for (int j = 0; j < 4; ++j) d[j] += hh * Wd[(size_t)k * DM + tid + 256 * j]; }
#pragma unroll
        for (int j = 0; j < 4; ++j) oacc[j] += gate * d[j];
    }
#pragma unroll
    for (int j = 0; j < 4; ++j) out[(size_t)m * DM + tid + 256 * j] += oacc[j];
}
}


namespace mk {
#define LAS __attribute__((address_space(3)))
#define GAS __attribute__((address_space(1)))
typedef short bf16x8 __attribute__((ext_vector_type(8)));
typedef short s16x4 __attribute__((ext_vector_type(4)));
typedef float f32x16 __attribute__((ext_vector_type(16)));
typedef float f32x2 __attribute__((ext_vector_type(2)));
typedef __bf16 bf16x2_t __attribute__((ext_vector_type(2)));
typedef GAS unsigned gu32;

constexpr int NWAVES = 8, NTHR = 512;
constexpr int RING_BYTES = 131072, SCR2_OFF = RING_BYTES, SCR2_BYTES = 16128, MISC_OFF = SCR2_OFF + SCR2_BYTES, LDS_BYTES = 147456;
static_assert(MISC_OFF + 256 == LDS_BYTES, "LDS map");

constexpr size_t FW_TOK = 2 * MiB, FW_WIN = 4 * MiB, FW_WOUT = 8 * MiB, FW_WGLU = 10 * MiB, FW_WR = 10 * MiB + 512 * 1024, FW_TB = 12 * MiB, FW_W1 = 32 * MiB,
                 FW_WGU = 40 * MiB, FW_WD = 104 * MiB, FW_SST = 136 * MiB, FW_XN = 168 * MiB, FW_Q = 296 * MiB, FW_K = 360 * MiB, FW_V = 424 * MiB, FW_U2 = 488 * MiB,
                 FW_Z = 568 * MiB, FW_YS = 632 * MiB, FW_YA = 696 * MiB, FW_MIX = 760 * MiB, FW_END = 888 * MiB,
                 FW_H2 = FW_XN, FW_X1B = FW_XN, FW_XG = 296 * MiB, FW_HH = 568 * MiB, FW_YE = FW_XG, FW_ROW = 888 * MiB, FW_END2 = 890 * MiB;
static_assert(FW_K - FW_Q == (size_t)M * 512 * 2 && FW_V - FW_K == (size_t)M * 512 * 2, "Q|K|V contiguous");
constexpr int MAXTILES = 544, MAXROWS = MAXTILES * 256;
static_assert(FW_ROW + (size_t)3 * MAXROWS * 4 <= FW_END2, "row arrays");
static_assert(FW_XG + (size_t)MAXTILES * 256 * DM * 2 <= FW_HH && FW_HH + (size_t)MAXTILES * 256 * DE * 2 <= FW_END, "MoE overlay");
constexpr int CW_TMO = 0, CW_CNT = 64, CW_BAR = 4096;
constexpr size_t CTL_ZERO_BYTES = 1 * MiB;

#define RLX_AGENT __ATOMIC_RELAXED, __HIP_MEMORY_SCOPE_AGENT
__device__ __forceinline__ unsigned cvtpk(float lo, float hi) { f32x2 v = {lo, hi}; bf16x2_t b = __builtin_convertvector(v, bf16x2_t); return __builtin_bit_cast(unsigned, b); }

#define XB_TMO      128
#define XB_XCNT(j)  (256  + 64 * (j))
#define XB_XSUB(j)  (1280 + 64 * (j))
#define XB_XGEN(j)  (2304 + 64 * (j))
#define XB_TOP      3328
#define XB_TOPGEN   3392
#define XCD_BAR_WORDS 3456
#define XB_SPIN_CAP (1u << 18)
__device__ __forceinline__ unsigned xb_ld(unsigned* p)              { return __hip_atomic_load(p, __ATOMIC_RELAXED, __HIP_MEMORY_SCOPE_AGENT); }
__device__ __forceinline__ unsigned xb_add(unsigned* p, unsigned v) { return __hip_atomic_fetch_add(p, v, __ATOMIC_RELAXED, __HIP_MEMORY_SCOPE_AGENT); }
__device__ __forceinline__ unsigned xb_xcc_id() { return (unsigned)__builtin_amdgcn_s_getreg((3 << 11) | 20) & 0xFu; }
#define XB_SPIN(cond, bar) do { unsigned _sp = 0; while (cond) { __builtin_amdgcn_s_sleep(1); \
    if ((++_sp & 255u) == 0u) { if (xb_ld(&(bar)[XB_TMO])) break; if (_sp > XB_SPIN_CAP) { atomicAdd(&(bar)[XB_TMO], 1u); break; } } } } while (0)
struct XcdBarrier { unsigned* bar; unsigned x; volatile LAS unsigned* st; };
__device__ __forceinline__ XcdBarrier xcd_barrier_post(unsigned* bar, volatile LAS unsigned* st) {
    XcdBarrier b; b.bar = bar; b.x = xb_xcc_id(); b.st = st;
    if (threadIdx.x == 0) (void)xb_add(&bar[XB_XCNT(b.x)], 1u);
    return b;
}
__device__ __forceinline__ void xcd_barrier_complete(unsigned* bar, unsigned x, unsigned& nloc, unsigned& nx) {
    const unsigned G = gridDim.x * gridDim.y * gridDim.z;
    unsigned sum, cnt, mine, sp = 0u;
    for (;;) {
        sum = 0u; cnt = 0u; mine = 0u;
#pragma unroll
        for (unsigned j = 0; j < 16; ++j) { const unsigned c = xb_ld(&bar[XB_XCNT(j)]); sum += c; cnt += (c > 0u) ? 1u : 0u; mine = (j == x) ? c : mine; }
        if (sum == G) break;
        __builtin_amdgcn_s_sleep(1);
        if ((++sp & 255u) == 0u) { if (xb_ld(&bar[XB_TMO])) break; if (sp > XB_SPIN_CAP) { atomicAdd(&bar[XB_TMO], 1u); break; } }
    }
    nloc = mine > 0u ? mine : 1u; nx = cnt > 0u ? cnt : 1u;
}
__device__ __forceinline__ void xcd_barrier(const XcdBarrier& b) {
    asm volatile("s_waitcnt vmcnt(0)" ::: "memory");
    __syncthreads();
    if (threadIdx.x == 0) {
        unsigned* bar = b.bar;
        __builtin_amdgcn_s_waitcnt(0);
        unsigned nloc = b.st[0], nx = b.st[1];
        if (nloc == 0u) { xcd_barrier_complete(bar, b.x, nloc, nx); b.st[0] = nloc; b.st[1] = nx; }
        const unsigned old = xb_add(&bar[XB_XSUB(b.x)], 1u);
        const unsigned gen = old / nloc;
        if (old + 1u == (gen + 1u) * nloc) {
            __builtin_amdgcn_fence(__ATOMIC_RELEASE, "agent");
            asm volatile("s_waitcnt vmcnt(0)" ::: "memory");
            const unsigned og = xb_add(&bar[XB_TOP], 1u);
            const unsigned tg = og / nx;
            if (og + 1u == (tg + 1u) * nx) xb_add(&bar[XB_TOPGEN], 1u);
            else XB_SPIN(xb_ld(&bar[XB_TOPGEN]) == tg, bar);
            __builtin_amdgcn_fence(__ATOMIC_ACQUIRE, "agent");
            xb_add(&bar[XB_XGEN(b.x)], 1u);
            asm volatile("s_waitcnt vmcnt(0)" ::: "memory");
        } else {
            XB_SPIN(xb_ld(&bar[XB_XGEN(b.x)]) == gen, bar);
            __builtin_amdgcn_fence(__ATOMIC_ACQUIRE, "agent");
            asm volatile("s_waitcnt vmcnt(0)" ::: "memory");
        }
    }
    __syncthreads();
}

constexpr int BM = 256, BK = 64, HALF = 128, HTB = HALF * BK * 2;
__device__ __forceinline__ int lds_byte(int r, int c) { const int st = (r >> 4) * 2 + (c >> 5), rr = r & 15, cc = c & 31, ob = rr * 64 + cc * 2; return st * 1024 + (ob ^ (((ob >> 9) & 1) << 5)); }
__device__ __forceinline__ void stage_rc(int b, int& R, int& C) { const int st = b / 1024, sb = b % 1024, swz = sb ^ (((sb >> 9) & 1) << 5); R = (st >> 1) * 16 + swz / 64; C = (st & 1) * 32 + (swz % 64) / 2; }
__device__ __forceinline__ int perm32(int rho) { const int n = rho >> 4, i = rho & 15; return 8 * (i >> 2) + 4 * n + (i & 3); }
struct Unit { const char* a; const char* b; int pm, pn, aux; };
struct GemmP { int lda_b, ldb_b, K; };

template <class Epi, class Sched, bool GATHER = false>
__device__ __forceinline__ void gemm_phase(LAS unsigned char* lds, const GemmP g, const Sched& S, const Epi& E, const LAS int* rowcache = nullptr) {
    const int tid = threadIdx.x, wid = __builtin_amdgcn_readfirstlane(tid >> 6), lane = tid & 63, wr = wid >> 2, wc = wid & 3, fr = lane & 15, fq = lane >> 4;
    const int nt = g.K / BK;
    unsigned voffA[2], voffB[2]; int gR[2], gC[2];
#pragma unroll
    for (int i = 0; i < 2; ++i) { int R, C; stage_rc(tid * 16 + i * 8192, R, C); const int Rb = Epi::PERM ? ((R & ~31) + perm32(R & 31)) : R; gR[i] = R; gC[i] = C * 2;
        voffA[i] = (unsigned)(R * g.lda_b + C * 2); voffB[i] = (unsigned)(Rb * g.ldb_b + C * 2); }
    unsigned vc0[2] = {voffA[0], voffA[1]}, vc1[2] = {voffA[0], voffA[1]}, vn0[2] = {voffA[0], voffA[1]}, vn1[2] = {voffA[0], voffA[1]};
#define PG8_GOFF(dst0, dst1, ui_) do { _Pragma("unroll") for (int _i = 0; _i < 2; ++_i) { \
        dst0[_i] = (unsigned)rowcache[(ui_) * 256 + gR[_i]] * (unsigned)g.lda_b + (unsigned)gC[_i]; dst1[_i] = (unsigned)rowcache[(ui_) * 256 + 128 + gR[_i]] * (unsigned)g.lda_b + (unsigned)gC[_i]; } } while (0)
    const size_t kstep = (size_t)(BK * 2);
    const size_t hstepA = GATHER ? 0 : (size_t)HALF * g.lda_b, hstepB = (size_t)HALF * g.ldb_b;
    const unsigned ldsw = (unsigned)wid * 1024u;
    const int aoff = lds_byte(wr * 64 + fr, fq * 8), boff = lds_byte(wc * 32 + fr, fq * 8);
#define PG8_SA(b, h) (((b) * 2 + (h)) * HTB)
#define PG8_SB(b, h) ((4 + (b) * 2 + (h)) * HTB)
#define PG8_STAGE(bufoff, gbase, voff) do { _Pragma("unroll") for (int _i = 0; _i < 2; ++_i) \
        __builtin_amdgcn_global_load_lds((const unsigned*)((const char*)(gbase) + (voff)[_i]), (LAS unsigned*)(lds + (bufoff) + ldsw + _i * 8192), 16, 0, 0); } while (0)
#define PG8_LDA(dst, b, h) do { _Pragma("unroll") for (int m = 0; m < 4; ++m) _Pragma("unroll") for (int k = 0; k < 2; ++k) dst[m][k] = *(const LAS bf16x8*)(lds + PG8_SA(b, h) + aoff + m * 2048 + k * 1024); } while (0)
#define PG8_LDB(dst, b, h) do { _Pragma("unroll") for (int n = 0; n < 2; ++n) _Pragma("unroll") for (int k = 0; k < 2; ++k) dst[n][k] = *(const LAS bf16x8*)(lds + PG8_SB(b, h) + boff + n * 2048 + k * 1024); } while (0)
#define PG8_MMA(ai, bj, At, Bt) do { __builtin_amdgcn_s_setprio(1); _Pragma("unroll") for (int m = 0; m < 4; ++m) _Pragma("unroll") for (int n = 0; n < 2; ++n) _Pragma("unroll") for (int k = 0; k < 2; ++k) \
        acc[ai][bj][m][n] = __builtin_amdgcn_mfma_f32_16x16x32_bf16(Bt[n][k], At[m][k], acc[ai][bj][m][n], 0, 0, 0); __builtin_amdgcn_s_setprio(0); } while (0)
#define PG8_WAIT_V(n) asm volatile("s_waitcnt vmcnt(" #n ")" ::: "memory")
#define PG8_WAIT_L(n) asm volatile("s_waitcnt lgkmcnt(" #n ")" ::: "memory")
#define PG8_BAR __builtin_amdgcn_s_barrier()
#define PG8_SCHED __builtin_amdgcn_sched_barrier(0)
    Unit cur, nxt; int ui = 0;
    if (!S.next(0, cur)) return;
    f32x4 acc[2][2][4][2];
#pragma unroll
    for (int a = 0; a < 2; ++a)
#pragma unroll
        for (int b = 0; b < 2; ++b)
#pragma unroll
            for (int m = 0; m < 4; ++m)
#pragma unroll
                for (int n = 0; n < 2; ++n) acc[a][b][m][n] = (f32x4){0.f, 0.f, 0.f, 0.f};
    bf16x8 At[4][2], B0[2][2], B1[2][2];
    const char* cA = cur.a; const char* cB = cur.b;
    if (GATHER) { PG8_GOFF(vc0, vc1, 0); }
    PG8_STAGE(PG8_SB(0, 0), cB, voffB); PG8_STAGE(PG8_SB(0, 1), cB + hstepB, voffB); PG8_STAGE(PG8_SA(0, 0), cA, vc0); PG8_STAGE(PG8_SA(0, 1), cA + hstepA, vc1);
    if (wr == 1) PG8_BAR;
    PG8_WAIT_V(2); PG8_BAR;
    PG8_STAGE(PG8_SB(1, 0), cB + kstep, voffB); PG8_STAGE(PG8_SA(1, 0), cA + kstep, vc0); PG8_STAGE(PG8_SB(1, 1), cB + hstepB + kstep, voffB);
    PG8_WAIT_V(6); PG8_BAR;
    for (;;) {
        const bool has_next = S.next(ui + 1, nxt);
        const char* nA = has_next ? nxt.a : cA; const char* nB = has_next ? nxt.b : cB;
        if (GATHER) { if (has_next) { PG8_GOFF(vn0, vn1, ui + 1); } else { vn0[0] = vc0[0]; vn0[1] = vc0[1]; vn1[0] = vc1[0]; vn1[1] = vc1[1]; } }
        for (int t = 0; t < nt; t += 2) {
            const bool last = (t == nt - 2);
            const char* a1 = cA + (size_t)(t + 1) * kstep;
            const char* a2 = last ? nA : cA + (size_t)(t + 2) * kstep; const char* b2 = last ? nB : cB + (size_t)(t + 2) * kstep;
            const char* a3 = a2 + kstep; const char* b3 = b2 + kstep;
            unsigned w0[2], w1[2];
            w0[0] = (GATHER && last) ? vn0[0] : vc0[0]; w0[1] = (GATHER && last) ? vn0[1] : vc0[1]; w1[0] = (GATHER && last) ? vn1[0] : vc1[0]; w1[1] = (GATHER && last) ? vn1[1] : vc1[1];
            PG8_LDB(B0, 0, 0); PG8_LDB(B1, 0, 1); PG8_SCHED; PG8_LDA(At, 0, 0); PG8_STAGE(PG8_SA(1, 1), a1 + hstepA, vc1);
            PG8_WAIT_V(8); PG8_WAIT_L(0); PG8_BAR; PG8_MMA(0, 0, At, B0); PG8_MMA(0, 1, At, B1); PG8_BAR; PG8_SCHED;
            PG8_LDA(At, 0, 1); PG8_STAGE(PG8_SB(0, 0), b2, voffB); PG8_STAGE(PG8_SB(0, 1), b2 + hstepB, voffB); PG8_STAGE(PG8_SA(0, 0), a2, w0);
            PG8_WAIT_V(8); PG8_WAIT_L(0); PG8_BAR; PG8_MMA(1, 0, At, B0); PG8_MMA(1, 1, At, B1); PG8_BAR; PG8_SCHED;
            PG8_LDB(B0, 1, 0); PG8_LDB(B1, 1, 1); PG8_SCHED; PG8_LDA(At, 1, 0); PG8_STAGE(PG8_SA(0, 1), a2 + hstepA, w1);
            PG8_WAIT_V(8); PG8_WAIT_L(0); PG8_BAR; PG8_MMA(0, 0, At, B0); PG8_MMA(0, 1, At, B1); PG8_BAR; PG8_SCHED;
            PG8_LDA(At, 1, 1); PG8_STAGE(PG8_SB(1, 0), b3, voffB); PG8_STAGE(PG8_SB(1, 1), b3 + hstepB, voffB); PG8_STAGE(PG8_SA(1, 0), a3, w0);
            PG8_WAIT_V(8); PG8_WAIT_L(0); PG8_BAR; PG8_MMA(1, 0, At, B0); PG8_MMA(1, 1, At, B1); PG8_BAR; PG8_SCHED;
        }
        if (wr == 0) PG8_BAR;
        E(acc, cur, wr, wc, fr, fq);
        if (!has_next) break;
#pragma unroll
        for (int a = 0; a < 2; ++a)
#pragma unroll
            for (int b = 0; b < 2; ++b)
#pragma unroll
                for (int m = 0; m < 4; ++m)
#pragma unroll
                    for (int n = 0; n < 2; ++n) acc[a][b][m][n] = (f32x4){0.f, 0.f, 0.f, 0.f};
        cur = nxt; cA = nA; cB = nB; ++ui;
        if (GATHER) { vc0[0] = vn0[0]; vc0[1] = vn0[1]; vc1[0] = vn1[0]; vc1[1] = vn1[1]; }
        if (wr == 1) PG8_BAR;
    }
    PG8_WAIT_V(0);
    PG8_BAR;
#undef PG8_GOFF
#undef PG8_SA
#undef PG8_SB
#undef PG8_STAGE
#undef PG8_LDA
#undef PG8_LDB
#undef PG8_MMA
#undef PG8_WAIT_V
#undef PG8_WAIT_L
#undef PG8_BAR
#undef PG8_SCHED
}

struct DenseOrder {
    const char* A; const char* B; size_t a_tile, b_tile; int nM, nN, nwg, G, c;
    __device__ __forceinline__ bool next(int i, Unit& u) const {
        const long L = (long)i * G + c; if (L >= nwg) return false;
        int wgid = (int)L; { const int q = nwg / 8, r = nwg % 8, xcd = wgid % 8, off = wgid / 8; wgid = (xcd < r ? xcd * (q + 1) : r * (q + 1) + (xcd - r) * q) + off; }
        const int nig = 8 * nN, gid = wgid / nig, fm = gid * 8, gsz = (nM - fm) < 8 ? (nM - fm) : 8;
        u.pm = fm + ((wgid % nig) % gsz); u.pn = (wgid % nig) / gsz; u.aux = 0;
        u.a = A + (size_t)u.pm * a_tile; u.b = B + (size_t)u.pn * b_tile; return true;
    }
};
struct GroupOrder {
    const char* A; const char* B; size_t a_grp, b_grp, a_tile, b_tile; int nM, nN, nwg, G, c;
    __device__ __forceinline__ bool next(int i, Unit& u) const {
        const long L = (long)i * G + c; if (L >= nwg) return false;
        const int per = nM * nN, g = (int)L / per, r = (int)L % per;
        u.pn = r / nM; u.pm = r % nM; u.aux = g;
        u.a = A + (size_t)g * a_grp + (size_t)u.pm * a_tile; u.b = B + (size_t)g * b_grp + (size_t)u.pn * b_tile; return true;
    }
};
struct MoeOrder {
    const char* A; const char* B; size_t a_tile, b_exp, b_tile; const LAS unsigned char* t2e; int ntiles, G, c;
    __device__ __forceinline__ bool next(int i, Unit& u) const {
        const long L = (long)i * G + c; if (L >= (long)ntiles * 4) return false;
        u.pm = (int)(L >> 2); u.pn = (int)(L & 3); u.aux = t2e[u.pm];
        u.a = A + (size_t)u.pm * a_tile; u.b = B + (size_t)u.aux * b_exp + (size_t)u.pn * b_tile; return true;
    }
};

typedef f32x4 Acc[2][2][4][2];
struct EpiProj {
    static constexpr bool PERM = true;
    bf16* U2; bf16* QKV; const float* gq; const float* gk;
    __device__ __forceinline__ void operator()(const Acc& acc, const Unit& u, int wr, int wc, int fr, int fq) const {
        const int typ = u.pn >> 1, sub = u.pn & 1;
        const bool nrm = (typ == 1 || typ == 2);
        const float* gg = (typ == 1) ? gq : gk; const float sc = (typ == 1) ? C2 : 1.f;
        f32x4 gn[2][2];
#pragma unroll
        for (int bj = 0; bj < 2; ++bj)
#pragma unroll
            for (int n = 0; n < 2; ++n) gn[bj][n] = *(const f32x4*)(gg + 32 * bj + 8 * fq + 4 * n) * sc;
#pragma unroll
        for (int ai = 0; ai < 2; ++ai)
#pragma unroll
            for (int m = 0; m < 4; ++m) {
                const int r = u.pm * BM + ai * HALF + wr * 64 + m * 16 + fr;
                f32x4 v[2][2];
#pragma unroll
                for (int bj = 0; bj < 2; ++bj)
#pragma unroll
                    for (int n = 0; n < 2; ++n) v[bj][n] = acc[ai][bj][m][n];
                {
                    float s = 0.f;
#pragma unroll
                    for (int bj = 0; bj < 2; ++bj)
#pragma unroll
                        for (int n = 0; n < 2; ++n) s += (v[bj][n].x * v[bj][n].x + v[bj][n].y * v[bj][n].y) + (v[bj][n].z * v[bj][n].z + v[bj][n].w * v[bj][n].w);
                    s += __shfl_xor(s, 16); s += __shfl_xor(s, 32);
                    const float rstd = 1.f / sqrtf(s * (1.f / 64.f) + EPS);
#pragma unroll
                    for (int bj = 0; bj < 2; ++bj)
#pragma unroll
                        for (int n = 0; n < 2; ++n) { const f32x4 mul = nrm ? gn[bj][n] * rstd : (f32x4){1.f, 1.f, 1.f, 1.f}; v[bj][n] = v[bj][n] * mul; }
                }
#pragma unroll
                for (int bj = 0; bj < 2; ++bj) {
                    u32x4 w; w.x = cvtpk(v[bj][0].x, v[bj][0].y); w.y = cvtpk(v[bj][0].z, v[bj][0].w); w.z = cvtpk(v[bj][1].x, v[bj][1].y); w.w = cvtpk(v[bj][1].z, v[bj][1].w);
                    const int f = sub * 256 + 64 * wc + 32 * bj + 8 * fq;
                    if (typ == 0) { const int g = f >> 4, h = f & 15; *(u32x4*)(U2 + ((size_t)g * NCH + (r >> 5)) * U2P + (r & 31) * 16 + h) = w; }
                    else { *(u32x4*)(QKV + (size_t)(typ - 1) * ((size_t)M * 512) + (size_t)r * 512 + f) = w; }
                }
            }
    }
};
struct EpiState {
    static constexpr bool PERM = false;
    float* SST;
    __device__ __forceinline__ void operator()(const Acc& acc, const Unit& u, int wr, int wc, int fr, int fq) const {
#pragma unroll
        for (int ai = 0; ai < 2; ++ai)
#pragma unroll
            for (int m = 0; m < 4; ++m) { const int r = u.pm * BM + ai * HALF + wr * 64 + m * 16 + fr;
#pragma unroll
                for (int n = 0; n < 2; ++n) *(f32x4*)(SST + ((size_t)u.aux * NCH + r) * 128 + 32 * wc + 16 * n + 4 * fq) = acc[ai][0][m][n]; }
    }
};
struct EpiS5 {
    static constexpr bool PERM = true;
    bf16* Z;
    __device__ __forceinline__ void operator()(const Acc& acc, const Unit& u, int wr, int wc, int fr, int fq) const {
#pragma unroll
        for (int ai = 0; ai < 2; ++ai)
#pragma unroll
            for (int m = 0; m < 4; ++m) { const int r = u.pm * BM + ai * HALF + wr * 64 + m * 16 + fr;
#pragma unroll
                for (int bj = 0; bj < 2; ++bj) { const int c0 = u.pn * BM + bj * HALF + 32 * wc + 8 * fq, i = c0 >> 4, h = c0 & 15;
                    const f32x4 a = acc[ai][bj][m][0], b = acc[ai][bj][m][1];
                    u32x4 w; w.x = cvtpk(gelu_tanh(a.x), gelu_tanh(a.y)); w.y = cvtpk(gelu_tanh(a.z), gelu_tanh(a.w)); w.z = cvtpk(gelu_tanh(b.x), gelu_tanh(b.y)); w.w = cvtpk(gelu_tanh(b.z), gelu_tanh(b.w));
                    *(u32x4*)(Z + ((size_t)r * 32 + i) * DSSM + u.aux * 16 + h) = w; } }
    }
};
struct EpiGlu {
    static constexpr bool PERM = true;
    const bf16* Z; const float* bias; bf16* YS;
    __device__ __forceinline__ void operator()(const Acc& acc, const Unit& u, int wr, int wc, int fr, int fq) const {
#pragma unroll
        for (int bj = 0; bj < 2; ++bj) { const int c0 = u.pn * BM + bj * HALF + 32 * wc + 8 * fq;
            const f32x4 b0 = *(const f32x4*)(bias + c0), b1 = *(const f32x4*)(bias + c0 + 4);
#pragma unroll
            for (int ai = 0; ai < 2; ++ai)
#pragma unroll
                for (int m = 0; m < 4; ++m) { const size_t off = (size_t)(u.pm * BM + ai * HALF + wr * 64 + m * 16 + fr) * DSSM + c0;
                    const u32x4 zz = *(const u32x4*)(Z + off);
                    const f32x4 a = acc[ai][bj][m][0] + b0, b = acc[ai][bj][m][1] + b1;
                    u32x4 w;
                    w.x = cvtpk(bf2f(zz.x & 0xffff) * sigmoidf_(a.x), bf2f(zz.x >> 16) * sigmoidf_(a.y)); w.y = cvtpk(bf2f(zz.y & 0xffff) * sigmoidf_(a.z), bf2f(zz.y >> 16) * sigmoidf_(a.w));
                    w.z = cvtpk(bf2f(zz.z & 0xffff) * sigmoidf_(b.x), bf2f(zz.z >> 16) * sigmoidf_(b.y)); w.w = cvtpk(bf2f(zz.w & 0xffff) * sigmoidf_(b.z), bf2f(zz.w >> 16) * sigmoidf_(b.w));
                    *(u32x4*)(YS + off) = w; } }
    }
};
struct EpiX1B {
    static constexpr bool PERM = true;
    const float* X; bf16* X1B;
    __device__ __forceinline__ void operator()(const Acc& acc, const Unit& u, int wr, int wc, int fr, int fq) const {
#pragma unroll
        for (int ai = 0; ai < 2; ++ai)
#pragma unroll
            for (int m = 0; m < 4; ++m) { const size_t ro = (size_t)(u.pm * BM + ai * HALF + wr * 64 + m * 16 + fr) * DM + u.pn * BM + 32 * wc + 8 * fq;
#pragma unroll
                for (int bj = 0; bj < 2; ++bj) { const size_t o = ro + bj * HALF;
                    const f32x4 a = *(const f32x4*)(X + o) + acc[ai][bj][m][0], b = *(const f32x4*)(X + o + 4) + acc[ai][bj][m][1];
                    u32x4 w; w.x = cvtpk(a.x, a.y); w.y = cvtpk(a.z, a.w); w.z = cvtpk(b.x, b.y); w.w = cvtpk(b.z, b.w);
                    *(u32x4*)(X1B + o) = w; } }
    }
};
struct EpiGU {
    static constexpr bool PERM = true;
    bf16* HH; const float* ROWSC;
    __device__ __forceinline__ void operator()(const Acc& acc, const Unit& u, int wr, int wc, int fr, int fq) const {
#pragma unroll
        for (int ai = 0; ai < 2; ++ai)
#pragma unroll
            for (int m = 0; m < 4; ++m) { const int rr = u.pm * BM + ai * HALF + wr * 64 + m * 16 + fr; const size_t off = (size_t)rr * DE + u.pn * 128 + 32 * wc + 8 * fq;
                const float sc = ROWSC[rr];
                float hv[8];
#pragma unroll
                for (int n = 0; n < 2; ++n) { const f32x4 gt = acc[ai][0][m][n] * sc, up = acc[ai][1][m][n] * sc;
                    hv[4 * n] = gt.x * sigmoidf_(gt.x) * up.x; hv[4 * n + 1] = gt.y * sigmoidf_(gt.y) * up.y; hv[4 * n + 2] = gt.z * sigmoidf_(gt.z) * up.z; hv[4 * n + 3] = gt.w * sigmoidf_(gt.w) * up.w; }
                u32x4 w; w.x = cvtpk(hv[0], hv[1]); w.y = cvtpk(hv[2], hv[3]); w.z = cvtpk(hv[4], hv[5]); w.w = cvtpk(hv[6], hv[7]);
                *(u32x4*)(HH + off) = w; }
    }
};
struct EpiDown {
    static constexpr bool PERM = true;
    bf16* YE; const float* ROWG;
    __device__ __forceinline__ void operator()(const Acc& acc, const Unit& u, int wr, int wc, int fr, int fq) const {
#pragma unroll
        for (int ai = 0; ai < 2; ++ai)
#pragma unroll
            for (int m = 0; m < 4; ++m) { const int rr = u.pm * BM + ai * HALF + wr * 64 + m * 16 + fr; const size_t ro = (size_t)rr * DM + u.pn * BM + 32 * wc + 8 * fq; const float gw_ = ROWG[rr];
#pragma unroll
                for (int bj = 0; bj < 2; ++bj) { const f32x4 a = acc[ai][bj][m][0] * gw_, b = acc[ai][bj][m][1] * gw_;
                    u32x4 w; w.x = cvtpk(a.x, a.y); w.y = cvtpk(a.z, a.w); w.z = cvtpk(b.x, b.y); w.w = cvtpk(b.z, b.w);
                    *(u32x4*)(YE + ro + bj * HALF) = w; } }
    }
};

struct Args { const float* in[26]; float* out; unsigned char* ws; int ph_lo, ph_hi; };
struct Frame { LAS unsigned char* lds; volatile LAS unsigned* MISC; unsigned* ctl; int tid, lane, wave, G, c; };

struct TItem { const float* W; int ldw, srccol0; const float* kscale; bf16* WT; int ldt, dstrow0, k0; };
__device__ __forceinline__ void titem_load(const TItem& t, int lane, f32x4 (&v)[8]) {
#pragma unroll
    for (int i = 0; i < 8; ++i) { const int kk = 8 * i + (lane >> 3); v[i] = *(const f32x4*)(t.W + (size_t)(t.k0 + kk) * t.ldw + t.srccol0 + (lane & 7) * 4); }
}
__device__ __forceinline__ void titem_store(const TItem& t, int lane, const f32x4 (&v)[8], LAS float* scr) {
#pragma unroll
    for (int i = 0; i < 8; ++i) { const int kk = 8 * i + (lane >> 3); const float sc = t.kscale ? t.kscale[t.k0 + kk] : 1.f; LAS float* d = scr + kk * 33 + (lane & 7) * 4;
        d[0] = v[i].x * sc; d[1] = v[i].y * sc; d[2] = v[i].z * sc; d[3] = v[i].w * sc; }
    asm volatile("s_waitcnt lgkmcnt(0)" ::: "memory");
    const int c = lane & 7;
#pragma unroll
    for (int j = 0; j < 4; ++j) { const int n = (lane >> 3) + 8 * j; const LAS float* s = scr + (8 * c) * 33 + n;
        u32x4 o; o.x = pk2(s[0 * 33], s[1 * 33]); o.y = pk2(s[2 * 33], s[3 * 33]); o.z = pk2(s[4 * 33], s[5 * 33]); o.w = pk2(s[6 * 33], s[7 * 33]);
        *(u32x4*)(t.WT + (size_t)(t.dstrow0 + n) * t.ldt + t.k0 + 8 * c) = o; }
    asm volatile("s_waitcnt lgkmcnt(0)" ::: "memory");
}
__device__ __forceinline__ void s5_tables_item(Frame& F, const Args& a, int g, int part) {
    const float* lre = a.in[3]; const float* lim = a.in[4]; const float* ldt = a.in[5]; const float* bre = a.in[6]; const float* bim = a.in[7];
    const float* cre = a.in[8]; const float* cim = a.in[9]; const float* dsk = a.in[10];
    LAS float* PWr = (LAS float*)F.lds; LAS float* PWi = PWr + 33 * 64; LAS float* BBr = PWi + 33 * 64; LAS float* BBi = BBr + 1024; LAS float* CCr = BBi + 1024; LAS float* CCi = CCr + 1024; LAS float* CF = CCi + 1024;
    const int tid = F.tid;
    if (tid < 64) { const int p = tid;
        const double dt = exp((double)ldt[g]), lr = lre[g * PST + p], li = lim[g * PST + p];
        double sn, cs; sincos_d(li * dt, sn, cs); const double mag = exp(lr * dt);
        const double ar = mag * cs, ai = mag * sn, den = lr * lr + li * li, nr = ar - 1.0, ni = ai;
        CF[2 * p] = (float)((nr * lr + ni * li) / den); CF[2 * p + 1] = (float)((ni * lr - nr * li) / den);
        double pr = 1.0, pi = 0.0;
        for (int l = 0; l <= 32; ++l) { PWr[l * 64 + p] = (float)pr; PWi[l * 64 + p] = (float)pi; const double t = pr * ar - pi * ai; pi = pr * ai + pi * ar; pr = t; }
    }
    __syncthreads();
    for (int idx = tid; idx < 1024; idx += NTHR) { const int p = idx >> 4; const float cfr = CF[2 * p], cfi = CF[2 * p + 1], br = bre[(size_t)g * 1024 + idx], bi = bim[(size_t)g * 1024 + idx];
        BBr[idx] = cfr * br - cfi * bi; BBi[idx] = cfr * bi + cfi * br; CCr[idx] = cre[(size_t)g * 1024 + idx]; CCi[idx] = cim[(size_t)g * 1024 + idx]; }
    __syncthreads();
    bf16* TBg = (bf16*)(a.ws + FW_TB) + (size_t)g * 512 * U2P; bf16* W1g = (bf16*)(a.ws + FW_W1) + (size_t)g * 256 * 512;
    for (int l = part; l < 32; l += 8) {
        if (tid < 256) { const int h = tid >> 4, hp = tid & 15; float k = 0.f;
            for (int p = 0; p < 64; ++p) { const float wr_ = PWr[l * 64 + p], wi_ = PWi[l * 64 + p], br = BBr[p * 16 + hp], bi = BBi[p * 16 + hp];
                k += CCr[h * 64 + p] * (wr_ * br - wi_ * bi) - CCi[h * 64 + p] * (wr_ * bi + wi_ * br); }
            if (l == 0 && h == hp) k += dsk[g * 16 + h];
            const bf16 v = (bf16)f2bf(k);
            for (int i = l; i < 32; ++i) TBg[(size_t)(i * 16 + h) * U2P + (i - l) * 16 + hp] = v;
            if (l >= 1) for (int i = 0; i < 32 - l; ++i) TBg[(size_t)(i * 16 + h) * U2P + (i + l) * 16 + hp] = 0;
        } else { const int t2 = tid - 256;
#pragma unroll
            for (int x = 0; x < 8; ++x) { const int e = t2 * 8 + x;
                { const int h = e >> 7, q = e & 127, p = q & 63; const float cr = CCr[h * 64 + p], ci = CCi[h * 64 + p], wr_ = PWr[(l + 1) * 64 + p], wi_ = PWi[(l + 1) * 64 + p];
                  const float re = cr * wr_ - ci * wi_, im = cr * wi_ + ci * wr_; TBg[(size_t)(l * 16 + h) * U2P + 512 + q] = (bf16)f2bf(q < 64 ? re : -im); }
                { const int rho = e >> 4, hp = e & 15, p = rho & 63; const float wr_ = PWr[(31 - l) * 64 + p], wi_ = PWi[(31 - l) * 64 + p], br = BBr[p * 16 + hp], bi = BBi[p * 16 + hp];
                  const float re = wr_ * br - wi_ * bi, im = wr_ * bi + wi_ * br; W1g[(size_t)rho * 512 + l * 16 + hp] = (bf16)f2bf(rho < 64 ? re : im); W1g[(size_t)(128 + rho) * 512 + l * 16 + hp] = 0; }
            }
        }
    }
    __syncthreads();
}
__device__ __forceinline__ void p0_prologue(Frame& F, const Args& a) {
    const float* x = a.in[0];
    for (int it = F.c; it < 256; it += F.G) s5_tables_item(F, a, it >> 3, it & 7);
    LAS float* scr = (LAS float*)(F.lds + F.wave * 16384);
    const int gw = F.c * NWAVES + F.wave, NGW = F.G * NWAVES;
    constexpr int I_IN = 16 * 64, I_GLU = 8 * 16, I_OUT = 16 * 32, I_GU = 32 * 16 * 32, I_D = 32 * 8 * 32, NITEMS = I_IN + I_GLU + I_OUT + I_GU + I_D;
    bf16* WIN = (bf16*)(a.ws + FW_WIN); bf16* WGLU = (bf16*)(a.ws + FW_WGLU); bf16* WOUT = (bf16*)(a.ws + FW_WOUT); bf16* WGU = (bf16*)(a.ws + FW_WGU); bf16* WD = (bf16*)(a.ws + FW_WD);
    auto mkitem = [&](int it) -> TItem {
        int r = it;
        if (r < I_IN) { const int kb = r >> 6, d = r & 63, pn = d >> 3, beta = d & 7, bj = beta >> 2, wc = beta & 3;
            return TItem{a.in[2], DIN, 256 * pn + 32 * (2 * wc + bj), a.in[1], WIN, DM, 32 * d, 64 * kb}; } r -= I_IN;
        if (r < I_GLU) { const int kb = r >> 4, d = r & 15; return TItem{a.in[11], DSSM, 32 * d, nullptr, WGLU, DSSM, 32 * d, 64 * kb}; } r -= I_GLU;
        if (r < I_OUT) { const int kb = r >> 5, d = r & 31; const float* ks = (kb < 8) ? a.in[15] : (a.in[16] - 512);
            return TItem{a.in[17], DM, 32 * d, ks, WOUT, DM, 32 * d, 64 * kb}; } r -= I_OUT;
        if (r < I_GU) { const int e = r >> 9, q = r & 511, kb = q >> 5, d = q & 31, pn = d >> 3, beta = d & 7;
            const float* W = (beta < 4 ? a.in[23] : a.in[24]) + (size_t)e * DM * DE;
            return TItem{W, DE, 128 * pn + 32 * (beta & 3), a.in[18], WGU + (size_t)e * DM * DM, DM, 32 * d, 64 * kb}; } r -= I_GU;
        const int e = r >> 8, q = r & 255, kb = q >> 5, d = q & 31;
        return TItem{a.in[25] + (size_t)e * DE * DM, DM, 32 * d, nullptr, WD + (size_t)e * DM * DE, DE, 32 * d, 64 * kb};
    };
    if (gw < NITEMS) {
        TItem cur = mkitem(gw); f32x4 vc[8]; titem_load(cur, F.lane, vc);
        for (int it = gw; it < NITEMS; it += NGW) {
            const bool more = it + NGW < NITEMS; TItem nxt = cur; f32x4 vn[8];
            if (more) { nxt = mkitem(it + NGW); titem_load(nxt, F.lane, vn); }
            titem_store(cur, F.lane, vc, scr);
            if (more) { cur = nxt;
#pragma unroll
                for (int i = 0; i < 8; ++i) vc[i] = vn[i]; }
        }
    }
    { bf16* WR = (bf16*)(a.ws + FW_WR);
      for (int idx = F.c * NTHR + F.tid; idx < 64 * DM; idx += F.G * NTHR) { const int n = idx >> 10, k = idx & 1023;
          float v = 0.f; if (n < 4) v = a.in[19][k * 4 + n]; else if (n < 36) v = a.in[21][k * 32 + (n - 4)];
          WR[idx] = (bf16)f2bf(v * a.in[18][k]); } }
    { unsigned* RW = (unsigned*)(a.ws + FW_ROW); for (int idx = F.c * NTHR + F.tid; idx < 3 * MAXROWS; idx += F.G * NTHR) RW[idx] = 0u; }
    bf16* XN = (bf16*)(a.ws + FW_XN);
    for (int m0 = gw * 4; m0 < M; m0 += NGW * 4) {
        f32x4 v[4][4];
#pragma unroll
        for (int rr = 0; rr < 4; ++rr)
#pragma unroll
            for (int j = 0; j < 4; ++j) v[rr][j] = ((const f32x4*)(x + (size_t)(m0 + rr) * DM))[64 * j + F.lane];
#pragma unroll
        for (int rr = 0; rr < 4; ++rr) { float s = 0.f;
#pragma unroll
            for (int j = 0; j < 4; ++j) s += v[rr][j].x * v[rr][j].x + v[rr][j].y * v[rr][j].y + v[rr][j].z * v[rr][j].z + v[rr][j].w * v[rr][j].w;
            const float rstd = 1.f / sqrtf(wave_sum(s) * (1.f / DM) + EPS);
            u32x2* o = (u32x2*)(XN + (size_t)(m0 + rr) * DM) + F.lane;
#pragma unroll
            for (int j = 0; j < 4; ++j) { u32x2 w; w.x = cvtpk(v[rr][j].x * rstd, v[rr][j].y * rstd); w.y = cvtpk(v[rr][j].z * rstd, v[rr][j].w * rstd); o[64 * j] = w; } }
    }
}

__device__ __forceinline__ void s5_scan(Frame& F, const Args& a) {
    const float* SST = (const float*)(a.ws + FW_SST); bf16* U2 = (bf16*)(a.ws + FW_U2);
    for (int idx = F.c * NTHR + F.tid; idx < BATCH * NG * PST; idx += F.G * NTHR) {
        const int p = idx & 63, g = (idx >> 6) & 31, b = idx >> 11;
        const double dt = exp((double)a.in[5][g]), lr = a.in[3][g * PST + p], li = a.in[4][g * PST + p];
        double sn, cs; sincos_d(32.0 * li * dt, sn, cs); const double mag = exp(32.0 * lr * dt);
        const float ar = (float)(mag * cs), ai = (float)(mag * sn);
        float xr = 0.f, xi = 0.f;
        const size_t row0 = (size_t)g * NCH + (size_t)b * 64;
        for (int c0 = 0; c0 < 64; c0 += 16) {
            float sr[16], si[16];
#pragma unroll
            for (int j = 0; j < 16; ++j) { sr[j] = SST[(row0 + c0 + j) * 128 + p]; si[j] = SST[(row0 + c0 + j) * 128 + 64 + p]; }
#pragma unroll
            for (int j = 0; j < 16; ++j) { bf16* up = U2 + (row0 + c0 + j) * U2P + 512; up[p] = (bf16)f2bf(xr); up[64 + p] = (bf16)f2bf(xi);
                const float t = ar * xr - ai * xi + sr[j]; xi = ar * xi + ai * xr + si[j]; xr = t; }
        }
    }
}

constexpr float ATT_THR = -100.f;
__device__ __forceinline__ s16x4 vtr(const LAS unsigned char* p) { typedef short v4i16_t __attribute__((ext_vector_type(4))); return __builtin_bit_cast(s16x4, __builtin_amdgcn_ds_read_tr16_b64_v4i16((LAS v4i16_t*)p)); }
__device__ __forceinline__ int crow(int r, int hi) { return (r & 3) + 8 * (r >> 2) + 4 * hi; }
#define MFMA32(a, b, c) __builtin_amdgcn_mfma_f32_32x32x16_bf16((a), (b), (c), 0, 0, 0)
template <bool DIAG, int P, int KH, int KD, int VD>
__device__ __forceinline__ float attn_half(const LAS unsigned char* Kb, const LAS unsigned char* Vb, const bf16x8 (&qr)[4], const bf16x8 (&tri)[2], f32x16 (&o)[2], float base, int lim, int lane) {
    const int r32 = lane & 31, hi = lane >> 5;
    const LAS unsigned char* kp = Kb + hi * KH + r32 * 16 + P * 512;
    const int lim2 = lim - 4 * hi;
    f32x16 z = {};
#pragma unroll
    for (int d0 = 0; d0 < 4; ++d0) { const bf16x8 kf = *(const LAS bf16x8*)(kp + d0 * KD); z = MFMA32(kf, qr[d0], z); }
    float l[16];
#pragma unroll
    for (int r = 0; r < 16; ++r) { l[r] = -__builtin_amdgcn_logf(1.f + __builtin_amdgcn_exp2f(z[r])); if (DIAG) { if (!((r & 3) + 8 * (r >> 2) + 32 * P < lim2)) l[r] = 0.f; } }
    const bf16x8 ones = {(short)0x3F80, (short)0x3F80, (short)0x3F80, (short)0x3F80, (short)0x3F80, (short)0x3F80, (short)0x3F80, (short)0x3F80};
    u32x4 wa, wb;
    wa.x = cvtpk(l[0], l[1]); wa.y = cvtpk(l[2], l[3]); wa.z = cvtpk(l[4], l[5]); wa.w = cvtpk(l[6], l[7]);
    wb.x = cvtpk(l[8], l[9]); wb.y = cvtpk(l[10], l[11]); wb.z = cvtpk(l[12], l[13]); wb.w = cvtpk(l[14], l[15]);
    const bf16x8 La = __builtin_bit_cast(bf16x8, wa), Lb = __builtin_bit_cast(bf16x8, wb);
    f32x16 T = {}, TT = {};
    T = MFMA32(tri[0], La, T); T = MFMA32(tri[1], Lb, T);
    TT = MFMA32(ones, La, TT); TT = MFMA32(ones, Lb, TT);
    float av[16];
#pragma unroll
    for (int r = 0; r < 16; ++r) { av[r] = __builtin_amdgcn_exp2f((z[r] + base) + T[r]); if (DIAG) { if (!((r & 3) + 8 * (r >> 2) + 32 * P < lim2)) av[r] = 0.f; } }
    wa.x = cvtpk(av[0], av[1]); wa.y = cvtpk(av[2], av[3]); wa.z = cvtpk(av[4], av[5]); wa.w = cvtpk(av[6], av[7]);
    wb.x = cvtpk(av[8], av[9]); wb.y = cvtpk(av[10], av[11]); wb.z = cvtpk(av[12], av[13]); wb.w = cvtpk(av[14], av[15]);
    const bf16x8 Pa = __builtin_bit_cast(bf16x8, wa), Pb = __builtin_bit_cast(bf16x8, wb);
    const LAS unsigned char* vp = Vb + ((lane >> 4) & 1) * 32 + (lane & 3) * 8 + (4 * hi + ((lane & 15) >> 2)) * 64 + P * 2048;
#pragma unroll
    for (int d0 = 0; d0 < 2; ++d0) {
        const s16x4 lo0 = vtr(vp + d0 * VD), hi0 = vtr(vp + d0 * VD + 512), lo1 = vtr(vp + d0 * VD + 1024), hi1 = vtr(vp + d0 * VD + 1536);
        const bf16x8 v0 = {lo0[0], lo0[1], lo0[2], lo0[3], hi0[0], hi0[1], hi0[2], hi0[3]}, v1 = {lo1[0], lo1[1], lo1[2], lo1[3], hi1[0], hi1[1], hi1[2], hi1[3]};
        o[d0] = MFMA32(Pa, v0, o[d0]); o[d0] = MFMA32(Pb, v1, o[d0]);
    }
    return TT[0];
}
template <bool DIAG>
__device__ __forceinline__ void attn_tile(const LAS unsigned char* Kb, const LAS unsigned char* Vb, const bf16x8 (&qr)[4], const bf16x8 (&tri)[2], f32x16 (&o)[2], float& Rc, int lim, int lane) {
    const float s1 = attn_half<DIAG, 1, 1024, 2048, 4096>(Kb, Vb, qr, tri, o, Rc, lim, lane);
    const float s0 = attn_half<DIAG, 0, 1024, 2048, 4096>(Kb, Vb, qr, tri, o, Rc + s1, lim, lane);
    Rc += s1 + s0;
}
__device__ __forceinline__ void attn_unit(Frame& F, const bf16* Q, const bf16* Kg, const bf16* Vg, bf16* YA, int b, int h, int qb) {
    const int tid = F.tid, lane = F.lane, wid = F.wave, r32 = lane & 31, hi = lane >> 5;
    LAS unsigned char* KB0 = F.lds; LAS unsigned char* VB0 = F.lds + 16384; volatile LAS int* FLG = (volatile LAS int*)(F.lds + 32768);
    const size_t row0 = (size_t)b * SEQ; const int q0 = qb * 256, qg = q0 + 32 * wid + r32;
    bf16x8 qr[4];
#pragma unroll
    for (int d0 = 0; d0 < 4; ++d0) qr[d0] = *(const bf16x8*)(Q + (row0 + qg) * DATT + h * HD + d0 * 16 + hi * 8);
    bf16x8 tri[2];
#pragma unroll
    for (int s = 0; s < 2; ++s)
#pragma unroll
        for (int j = 0; j < 8; ++j) tri[s][j] = ((16 * s + 8 * (j >> 2) + 4 * hi + (j & 3)) >= r32) ? (short)0x3F80 : (short)0;
    f32x16 o[2] = {}; float Rc = 0.f;
    const int jt = 4 * qb + 3, jd = 4 * qb + (wid >> 1);
    bool done = false;
    const bf16* ksrc = Kg + (row0 + lane) * DATT + h * HD + wid * 8;
    const bf16* vsrc = Vg + (row0 + 16 * (wid & 3) + (lane >> 2)) * DATT + h * HD + (wid >> 2) * 32 + (lane & 3) * 8;
    u32x4 kreg = *(const u32x4*)(ksrc + (size_t)jt * 64 * DATT), vreg = *(const u32x4*)(vsrc + (size_t)jt * 64 * DATT);
    for (int j = jt;; --j) {
        const int buf = (jt - j) & 1;
        LAS unsigned char* Kb = KB0 + buf * 8192; LAS unsigned char* Vb = VB0 + buf * 8192;
        *(LAS u32x4*)(Kb + wid * 1024 + lane * 16) = kreg; *(LAS u32x4*)(Vb + wid * 1024 + lane * 16) = vreg;
        __syncthreads();
        if (j > 0) { kreg = *(const u32x4*)(ksrc + (size_t)(j - 1) * 64 * DATT); vreg = *(const u32x4*)(vsrc + (size_t)(j - 1) * 64 * DATT); }
        if (!done && j <= jd) {
            const int lim = qg - 64 * j;
            if (64 * j + 63 >= q0 + 32 * wid) attn_tile<true>(Kb, Vb, qr, tri, o, Rc, lim, lane);
            else attn_tile<false>(Kb, Vb, qr, tri, o, Rc, lim, lane);
            done = __all(Rc < ATT_THR);
        }
        if (lane == 0) FLG[wid] = done ? 1 : 0;
        __syncthreads();
        if (j == 0) break;
        int alld = 1;
#pragma unroll
        for (int w = 0; w < 8; ++w) alld &= FLG[w];
        if (alld) break;
    }
    { LAS unsigned char* stg = F.lds + 40960 + wid * 4096; LAS unsigned short* sp = (LAS unsigned short*)(stg + hi * 512 + r32 * 2);
#pragma unroll
      for (int r = 0; r < 16; ++r) { const int ro = ((r & 3) + 8 * (r >> 2)) * 64; sp[ro] = (unsigned short)f2bf(o[0][r]); sp[ro + 32] = (unsigned short)f2bf(o[1][r]); }
      asm volatile("s_waitcnt lgkmcnt(0)" ::: "memory");
      bf16* ow = YA + (row0 + q0 + 32 * wid) * DATT + h * HD;
#pragma unroll
      for (int i = 0; i < 4; ++i) { const int row = i * 8 + (lane >> 3), ch = lane & 7; const u32x4 v = *(const LAS u32x4*)(stg + row * 128 + ch * 16); *(u32x4*)(ow + (size_t)row * DATT + ch * 8) = v; } }
    __syncthreads();
}

__device__ __forceinline__ void attn_wave_phase(Frame& F, const bf16* Q, const bf16* Kg, const bf16* Vg, bf16* YA) {
    const int lane = F.lane, r32 = lane & 31, hi = lane >> 5;
    LAS unsigned char* wb = F.lds + F.wave * 16384;
    bf16x8 tri[2];
#pragma unroll
    for (int s = 0; s < 2; ++s)
#pragma unroll
        for (int j = 0; j < 8; ++j) tri[s][j] = ((16 * s + 8 * (j >> 2) + 4 * hi + (j & 3)) >= r32) ? (short)0x3F80 : (short)0;
    const int gw = F.c * NWAVES + F.wave, NGW = F.G * NWAVES;
    for (int u = gw; u < BATCH * NH * (SEQ / 32); u += NGW) {
        const int bh = u >> 6, a = u & 63, b = bh >> 3, h = bh & 7;
        const size_t row0 = (size_t)b * SEQ; const int qg = 32 * a + r32;
        bf16x8 qr[4];
#pragma unroll
        for (int d0 = 0; d0 < 4; ++d0) qr[d0] = *(const bf16x8*)(Q + (row0 + qg) * DATT + h * HD + d0 * 16 + hi * 8);
        const bf16* ksrc = Kg + (row0 + (lane & 31)) * DATT + h * HD + (lane >> 5) * 8;
        const bf16* vsrc = Vg + (row0 + (lane >> 2)) * DATT + h * HD + (lane & 3) * 8;
#define ATT_DMA(jj, slot) do { _Pragma("unroll") for (int i_ = 0; i_ < 4; ++i_) { \
            __builtin_amdgcn_global_load_lds((const unsigned*)(ksrc + (size_t)(32 * (jj)) * DATT + 16 * i_), (LAS unsigned*)(wb + (slot) * 8192 + i_ * 1024), 16, 0, 0); \
            __builtin_amdgcn_global_load_lds((const unsigned*)(vsrc + (size_t)(32 * (jj) + 16 * (i_ & 1)) * DATT + 32 * (i_ >> 1)), (LAS unsigned*)(wb + (slot) * 8192 + 4096 + i_ * 1024), 16, 0, 0); } } while (0)
        f32x16 o[2] = {}; float Rc = 0.f;
        ATT_DMA(a, 0);
        int it = 0;
        for (int jj = a;; --jj, ++it) {
            const int slot = it & 1;
            if (jj > 0) { ATT_DMA(jj - 1, slot ^ 1); asm volatile("s_waitcnt vmcnt(8)" ::: "memory"); }
            else asm volatile("s_waitcnt vmcnt(0)" ::: "memory");
            const LAS unsigned char* Kb = wb + slot * 8192; const LAS unsigned char* Vb = Kb + 4096;
            const int lim = qg - 32 * jj;
            float sh;
            if (jj == a) sh = attn_half<true, 0, 512, 1024, 2048>(Kb, Vb, qr, tri, o, Rc, lim, lane);
            else sh = attn_half<false, 0, 512, 1024, 2048>(Kb, Vb, qr, tri, o, Rc, lim, lane);
            Rc += sh;
            if (jj == 0 || __all(Rc < ATT_THR)) break;
        }
#undef ATT_DMA
        { LAS unsigned char* stg = wb + (it & 1) * 8192; LAS unsigned short* sp = (LAS unsigned short*)(stg + hi * 512 + r32 * 2);
          asm volatile("s_waitcnt lgkmcnt(0)" ::: "memory");
#pragma unroll
          for (int r = 0; r < 16; ++r) { const int ro = ((r & 3) + 8 * (r >> 2)) * 64; sp[ro] = (unsigned short)f2bf(o[0][r]); sp[ro + 32] = (unsigned short)f2bf(o[1][r]); }
          asm volatile("s_waitcnt lgkmcnt(0)" ::: "memory");
          bf16* ow = YA + (row0 + 32 * a) * DATT + h * HD;
#pragma unroll
          for (int i = 0; i < 4; ++i) { const int row = i * 8 + (lane >> 3), ch = lane & 7; const u32x4 v = *(const LAS u32x4*)(stg + row * 128 + ch * 16); *(u32x4*)(ow + (size_t)row * DATT + ch * 8) = v; }
          asm volatile("s_waitcnt lgkmcnt(0)" ::: "memory"); }
    }
    asm volatile("s_waitcnt vmcnt(0)" ::: "memory");
    __syncthreads();
}

constexpr int ASPAN = 13;
__device__ __forceinline__ void attn_span_phase(Frame& F, const bf16* Q, const bf16* Kg, const bf16* Vg, bf16* YA) {
    const int lane = F.lane, wid = F.wave, r32 = lane & 31, hi = lane >> 5;
    volatile LAS int* FLG = (volatile LAS int*)(F.lds + ASPAN * 8192 + 8 * 4096);
    bf16x8 tri[2];
#pragma unroll
    for (int s = 0; s < 2; ++s)
#pragma unroll
        for (int j = 0; j < 8; ++j) tri[s][j] = ((16 * s + 8 * (j >> 2) + 4 * hi + (j & 3)) >= r32) ? (short)0x3F80 : (short)0;
    for (int L = F.c; L < BATCH * NH * 8; L += F.G) {
        const int bh = L >> 3, qb = L & 7, b = bh >> 3, h = bh & 7, a0 = 8 * qb, a = a0 + wid;
        const size_t row0 = (size_t)b * SEQ; const int qg = 32 * a + r32;
        bf16x8 qr[4];
#pragma unroll
        for (int d0 = 0; d0 < 4; ++d0) qr[d0] = *(const bf16x8*)(Q + (row0 + qg) * DATT + h * HD + d0 * 16 + hi * 8);
        const bf16* src = (wid < 4) ? (Kg + (row0 + (lane & 31)) * DATT + h * HD + (lane >> 5) * 8 + 16 * wid)
                                    : (Vg + (row0 + 16 * (wid & 1) + (lane >> 2)) * DATT + h * HD + (lane & 3) * 8 + 32 * ((wid - 4) >> 1));
        const int dsto = (wid < 4) ? wid * 1024 : 4096 + (wid - 4) * 1024;
        f32x16 o[2] = {}; float Rc = 0.f; bool done = false;
        for (int k = 0;; ++k) {
            const int top = a0 + 7 - ASPAN * k, bot = (top - (ASPAN - 1) > 0) ? top - (ASPAN - 1) : 0;
#pragma unroll 1
            for (int jj = top; jj >= bot; --jj)
                __builtin_amdgcn_global_load_lds((const unsigned*)(src + (size_t)(32 * jj) * DATT), (LAS unsigned*)(F.lds + (top - jj) * 8192 + dsto), 16, 0, 0);
            asm volatile("s_waitcnt vmcnt(0)" ::: "memory");
            __syncthreads();
            if (!done) {
                for (int jj = (a < top ? a : top); jj >= bot; --jj) {
                    const LAS unsigned char* Kb = F.lds + (top - jj) * 8192; const LAS unsigned char* Vb = Kb + 4096;
                    const int lim = qg - 32 * jj;
                    float sh;
                    if (jj == a) sh = attn_half<true, 0, 512, 1024, 2048>(Kb, Vb, qr, tri, o, Rc, lim, lane);
                    else sh = attn_half<false, 0, 512, 1024, 2048>(Kb, Vb, qr, tri, o, Rc, lim, lane);
                    Rc += sh;
                    if (jj == 0 || __all(Rc < ATT_THR)) { done = true; break; }
                }
            }
            if (lane == 0) FLG[wid] = done ? 1 : 0;
            asm volatile("s_waitcnt lgkmcnt(0)" ::: "memory");
            __syncthreads();
            if (bot == 0) break;
            int alld = 1;
#pragma unroll
            for (int w = 0; w < 8; ++w) alld &= FLG[w];
            if (alld) break;
        }
        { LAS unsigned char* stg = F.lds + ASPAN * 8192 + wid * 4096; LAS unsigned short* sp = (LAS unsigned short*)(stg + hi * 512 + r32 * 2);
#pragma unroll
          for (int r = 0; r < 16; ++r) { const int ro = ((r & 3) + 8 * (r >> 2)) * 64; sp[ro] = (unsigned short)f2bf(o[0][r]); sp[ro + 32] = (unsigned short)f2bf(o[1][r]); }
          asm volatile("s_waitcnt lgkmcnt(0)" ::: "memory");
          bf16* ow = YA + (row0 + 32 * a) * DATT + h * HD;
#pragma unroll
          for (int i = 0; i < 4; ++i) { const int row = i * 8 + (lane >> 3), ch = lane & 7; const u32x4 v = *(const LAS u32x4*)(stg + row * 128 + ch * 16); *(u32x4*)(ow + (size_t)row * DATT + ch * 8) = v; }
          asm volatile("s_waitcnt lgkmcnt(0)" ::: "memory"); }
    }
    asm volatile("s_waitcnt vmcnt(0)" ::: "memory");
    __syncthreads();
}
static_assert(ASPAN * 8192 + 8 * 4096 + 64 <= MISC_OFF, "attention LDS map");

__device__ __forceinline__ void mixnorm(Frame& F, const Args& a) {
    const bf16* YS = (const bf16*)(a.ws + FW_YS); const bf16* YA = (const bf16*)(a.ws + FW_YA); bf16* MIX = (bf16*)(a.ws + FW_MIX);
    const int gw = F.c * NWAVES + F.wave, NGW = F.G * NWAVES, lane = F.lane;
    for (int m = gw; m < M; m += NGW) {
#pragma unroll
        for (int half = 0; half < 2; ++half) {
            const u32x4 w = *(const u32x4*)((half ? YA : YS) + (size_t)m * 512 + lane * 8); float v[8];
            v[0] = bf2f(w.x & 0xffff); v[1] = bf2f(w.x >> 16); v[2] = bf2f(w.y & 0xffff); v[3] = bf2f(w.y >> 16); v[4] = bf2f(w.z & 0xffff); v[5] = bf2f(w.z >> 16); v[6] = bf2f(w.w & 0xffff); v[7] = bf2f(w.w >> 16);
            float s = 0.f;
#pragma unroll
            for (int i = 0; i < 8; ++i) s += v[i] * v[i];
            const float rstd = 1.f / sqrtf(wave_sum(s) * (1.f / 512.f) + EPS);
            u32x4 o; o.x = cvtpk(v[0] * rstd, v[1] * rstd); o.y = cvtpk(v[2] * rstd, v[3] * rstd); o.z = cvtpk(v[4] * rstd, v[5] * rstd); o.w = cvtpk(v[6] * rstd, v[7] * rstd);
            *(u32x4*)(MIX + (size_t)m * DM + half * 512 + lane * 8) = o;
        }
    }
}

constexpr int RT_PITCH = 2064;
__device__ __forceinline__ void router_phase(Frame& F, const Args& a) {
    const bf16* X1B = (const bf16*)(a.ws + FW_X1B); int* TOK = (int*)(a.ws + FW_TOK); const bf16* WR = (const bf16*)(a.ws + FW_WR);
    const float* brg = a.in[20]; const float* bre_ = a.in[22];
    const int tid = F.tid, lane = F.lane, wid = F.wave, r32 = lane & 31, hi = lane >> 5;
    LAS unsigned char* TILE = F.lds;
    LAS float* PART = (LAS float*)(F.lds + 66048);
    LAS float* LOGIT = (LAS float*)(F.lds + 66048 + 65536);
    LAS int* HIST = (LAS int*)(F.lds + 66048 + 65536 + 5120);
    LAS int* TREC = HIST + 64;
    LAS float* RS = (LAS float*)(TREC + 1024);
    static_assert(66048 + 65536 + 5120 + 256 + 4096 + 128 <= MISC_OFF, "router LDS");
    bf16x8 Bf[8][2];
#pragma unroll
    for (int s = 0; s < 8; ++s)
#pragma unroll
        for (int nb = 0; nb < 2; ++nb) Bf[s][nb] = *(const bf16x8*)(WR + (size_t)(32 * nb + r32) * DM + 128 * wid + 16 * s + 8 * hi);
    if (tid < 64) HIST[tid] = 0;
    __syncthreads();
    int ntl = 0;
    for (int tile = F.c; tile < M / 32; tile += F.G, ++ntl) {
        { u32x4 v[4][2];
#pragma unroll
          for (int rr = 0; rr < 4; ++rr) { const u32x4* xr = (const u32x4*)(X1B + (size_t)(tile * 32 + 4 * wid + rr) * DM); v[rr][0] = xr[lane]; v[rr][1] = xr[64 + lane]; }
#pragma unroll
          for (int rr = 0; rr < 4; ++rr) { const int lr = 4 * wid + rr; float s = 0.f;
#pragma unroll
              for (int j = 0; j < 2; ++j) { const u32x4 w = v[rr][j];
                  const float f0 = bf2f(w.x & 0xffff), f1 = bf2f(w.x >> 16), f2 = bf2f(w.y & 0xffff), f3 = bf2f(w.y >> 16), f4 = bf2f(w.z & 0xffff), f5 = bf2f(w.z >> 16), f6 = bf2f(w.w & 0xffff), f7 = bf2f(w.w >> 16);
                  s += (f0 * f0 + f1 * f1) + (f2 * f2 + f3 * f3) + (f4 * f4 + f5 * f5) + (f6 * f6 + f7 * f7);
                  *(LAS u32x4*)(TILE + lr * RT_PITCH + (64 * j + lane) * 16) = w; }
              const float rstd = 1.f / sqrtf(wave_sum(s) * (1.f / DM) + EPS);
              if (lane == 0) RS[lr] = rstd; } }
        __syncthreads();
        { f32x16 c0 = {}, c1 = {};
#pragma unroll
          for (int s = 0; s < 8; ++s) { const bf16x8 af = *(const LAS bf16x8*)(TILE + r32 * RT_PITCH + (128 * wid + 16 * s + 8 * hi) * 2);
              c0 = MFMA32(af, Bf[s][0], c0); c1 = MFMA32(af, Bf[s][1], c1); }
#pragma unroll
          for (int r = 0; r < 16; ++r) { const int t = crow(r, hi); PART[(wid * 32 + t) * 64 + r32] = c0[r]; PART[(wid * 32 + t) * 64 + 32 + r32] = c1[r]; } }
        __syncthreads();
        { const int t = tid >> 4, c4 = (tid & 15) * 4;
          if (c4 < 40) { f32x4 s = {0.f, 0.f, 0.f, 0.f};
#pragma unroll
              for (int w = 0; w < 8; ++w) s += *(const LAS f32x4*)(PART + (w * 32 + t) * 64 + c4);
              *(LAS f32x4*)(LOGIT + t * 40 + c4) = s * RS[t]; } }
        __syncthreads();
        if (tid < 32) { const int m = tile * 32 + tid; float lg[36];
#pragma unroll
            for (int c = 0; c < 36; ++c) lg[c] = LOGIT[tid * 40 + c] + (c < 4 ? brg[c] : bre_[c - 4]);
            int gi = 0; float gm = lg[0];
#pragma unroll
            for (int c = 1; c < 4; ++c) if (lg[c] > gm) { gm = lg[c]; gi = c; }
            float gsum = 0.f;
#pragma unroll
            for (int c = 0; c < 4; ++c) gsum += __expf(lg[c] - gm);
            const float pgrp = 1.f / gsum;
            float el[8];
#pragma unroll
            for (int e = 0; e < 8; ++e) { float t = 0.f;
#pragma unroll
                for (int g2 = 0; g2 < 4; ++g2) if (g2 == gi) t = lg[4 + g2 * 8 + e];
                el[e] = t; }
            int i0 = 0; float m0 = el[0];
#pragma unroll
            for (int e = 1; e < 8; ++e) if (el[e] > m0) { m0 = el[e]; i0 = e; }
            int i1 = 0; float m1 = -3.0e38f;
#pragma unroll
            for (int e = 0; e < 8; ++e) if (e != i0 && el[e] > m1) { m1 = el[e]; i1 = e; }
            const float e1 = __expf(m1 - m0), p0 = 1.f / (1.f + e1), p1 = e1 / (1.f + e1);
            const int ex0 = gi * 8 + i0, ex1 = gi * 8 + i1;
            const int rk0 = atomicAdd((int*)&HIST[ex0], 1), rk1 = atomicAdd((int*)&HIST[ex1], 1);
            int* tk = TOK + (size_t)m * 8; tk[0] = ex0; tk[1] = ex1; tk[2] = __float_as_int(pgrp * p0); tk[3] = __float_as_int(pgrp * p1); tk[6] = __float_as_int(RS[tid]);
            LAS int* tr = TREC + (ntl * 32 + tid) * 4; tr[0] = ex0; tr[1] = ex1; tr[2] = rk0; tr[3] = rk1;
        }
        __syncthreads();
    }
    if (tid < 32) { const int cnt = HIST[tid]; int base = 0; if (cnt > 0) base = (int)__hip_atomic_fetch_add(F.ctl + CW_CNT + tid, (unsigned)cnt, RLX_AGENT); HIST[32 + tid] = base; }
    __syncthreads();
    for (int i = tid; i < ntl * 32; i += NTHR) { const int tile = F.c + (i >> 5) * F.G, m = tile * 32 + (i & 31); const LAS int* tr = TREC + i * 4;
        int* tk = TOK + (size_t)m * 8; tk[4] = HIST[32 + tr[0]] + tr[2]; tk[5] = HIST[32 + tr[1]] + tr[3]; }
    __syncthreads();
}
__device__ __forceinline__ int moe_tables(Frame& F) {
    LAS int* TST = (LAS int*)(F.lds + SCR2_OFF); LAS unsigned char* T2E = F.lds + SCR2_OFF + 256;
    if (F.tid == 0) { int acc = 0;
        for (int e = 0; e < NE; ++e) { TST[e] = acc; const int cnt = (int)__hip_atomic_load(F.ctl + CW_CNT + e, RLX_AGENT); const int nt = (cnt + 255) >> 8;
            for (int t = 0; t < nt; ++t) T2E[acc + t] = (unsigned char)e; acc += nt; }
        TST[NE] = acc; }
    __syncthreads();
    return TST[NE];
}
__device__ __forceinline__ void scatter_phase(Frame& F, const Args& a) {
    const int* TOK = (const int*)(a.ws + FW_TOK); int* ROWTOK = (int*)(a.ws + FW_ROW); float* ROWSC = (float*)(a.ws + FW_ROW) + MAXROWS; float* ROWG = (float*)(a.ws + FW_ROW) + 2 * MAXROWS;
    const LAS int* TST = (const LAS int*)(F.lds + SCR2_OFF);
    for (int m = F.c * NTHR + F.tid; m < M; m += F.G * NTHR) {
        const u32x4 t0 = *(const u32x4*)(TOK + (size_t)m * 8), t1 = *(const u32x4*)(TOK + (size_t)m * 8 + 4);
        const int p0 = TST[t0.x] * 256 + (int)t1.x, p1 = TST[t0.y] * 256 + (int)t1.y; const float rs = __uint_as_float(t1.z);
        ROWTOK[p0] = m; ROWSC[p0] = rs; ROWG[p0] = __uint_as_float(t0.z);
        ROWTOK[p1] = m; ROWSC[p1] = rs; ROWG[p1] = __uint_as_float(t0.w);
    }
}
__device__ __forceinline__ void combine_phase(Frame& F, const Args& a) {
    const bf16* YE = (const bf16*)(a.ws + FW_YE); const bf16* X1B = (const bf16*)(a.ws + FW_X1B); const int* TOK = (const int*)(a.ws + FW_TOK); float* out = a.out;
    const LAS int* TST = (const LAS int*)(F.lds + SCR2_OFF);
    const int gw = F.c * NWAVES + F.wave, NGW = F.G * NWAVES, lane = F.lane;
    for (int m0 = gw * 2; m0 < M; m0 += NGW * 2) {
        u32x4 xv[2][2], y0[2][2], y1[2][2];
#pragma unroll
        for (int t = 0; t < 2; ++t) { const int m = m0 + t; const int* tk = TOK + (size_t)m * 8;
            const size_t p0 = (size_t)TST[tk[0]] * 256 + tk[4], p1 = (size_t)TST[tk[1]] * 256 + tk[5];
            const u32x4* xs = (const u32x4*)(X1B + (size_t)m * DM); const u32x4* a0 = (const u32x4*)(YE + p0 * DM); const u32x4* a1 = (const u32x4*)(YE + p1 * DM);
#pragma unroll
            for (int j = 0; j < 2; ++j) { xv[t][j] = xs[64 * j + lane]; y0[t][j] = a0[64 * j + lane]; y1[t][j] = a1[64 * j + lane]; } }
#pragma unroll
        for (int t = 0; t < 2; ++t) { f32x4* o = (f32x4*)(out + (size_t)(m0 + t) * DM);
#pragma unroll
            for (int j = 0; j < 2; ++j) { const u32x4 x = xv[t][j], p = y0[t][j], q = y1[t][j]; f32x4 r0, r1;
                r0.x = bf2f(x.x & 0xffff) + (bf2f(p.x & 0xffff) + bf2f(q.x & 0xffff)); r0.y = bf2f(x.x >> 16) + (bf2f(p.x >> 16) + bf2f(q.x >> 16));
                r0.z = bf2f(x.y & 0xffff) + (bf2f(p.y & 0xffff) + bf2f(q.y & 0xffff)); r0.w = bf2f(x.y >> 16) + (bf2f(p.y >> 16) + bf2f(q.y >> 16));
                r1.x = bf2f(x.z & 0xffff) + (bf2f(p.z & 0xffff) + bf2f(q.z & 0xffff)); r1.y = bf2f(x.z >> 16) + (bf2f(p.z >> 16) + bf2f(q.z >> 16));
                r1.z = bf2f(x.w & 0xffff) + (bf2f(p.w & 0xffff) + bf2f(q.w & 0xffff)); r1.w = bf2f(x.w >> 16) + (bf2f(p.w >> 16) + bf2f(q.w >> 16));
                o[2 * (64 * j + lane)] = r0; o[2 * (64 * j + lane) + 1] = r1; } }
    }
}

constexpr int NPHASE = 13;
__global__ void __launch_bounds__(NTHR, 2) mk_fwd(Args args) {
    extern __shared__ __attribute__((aligned(16))) unsigned char lds_raw[];
    Frame F;
    F.lds = (LAS unsigned char*)lds_raw; F.MISC = (volatile LAS unsigned*)(F.lds + MISC_OFF);
    F.tid = threadIdx.x; F.lane = F.tid & 63; F.wave = __builtin_amdgcn_readfirstlane(F.tid >> 6);
    F.G = gridDim.x; F.c = blockIdx.x; F.ctl = (unsigned*)(args.ws + WS_CTL);
    if (F.tid < 64) F.MISC[F.tid] = 0u;
    __syncthreads();
    XcdBarrier bar = xcd_barrier_post(F.ctl + CW_BAR, F.MISC + 8);
    const int lo = args.ph_lo, hi = args.ph_hi;
    unsigned char* ws = args.ws;
#ifndef PH_MASK
#define PH_MASK 0x1fff
#endif
#define IN(k) ((((PH_MASK) >> (k)) & 1) && lo <= (k) && (k) < hi)
#define SEAM(k) do { if (IN(k) && IN((k) + 1)) xcd_barrier(bar); } while (0)
#ifndef REP_MASK
#define REP_MASK 0
#endif
#define REPS(k) _Pragma("unroll") for (int rep_ = 0; rep_ < ((((REP_MASK) >> (k)) & 1) ? 2 : 1); ++rep_)
    if (IN(0)) REPS(0) { p0_prologue(F, args); } SEAM(0);
    if (IN(1)) REPS(1) {
        GemmP g{DM * 2, DM * 2, DM}; DenseOrder S{(const char*)(ws + FW_XN), (const char*)(ws + FW_WIN), (size_t)256 * DM * 2, (size_t)256 * DM * 2, M / 256, DIN / 256, (M / 256) * (DIN / 256), F.G, F.c};
        EpiProj E{(bf16*)(ws + FW_U2), (bf16*)(ws + FW_Q), args.in[13], args.in[14]};
        gemm_phase(F.lds, g, S, E); } SEAM(1);
    if (IN(2)) REPS(2) {
        GemmP g{U2P * 2, 512 * 2, 512}; GroupOrder S{(const char*)(ws + FW_U2), (const char*)(ws + FW_W1), (size_t)NCH * U2P * 2, (size_t)256 * 512 * 2, (size_t)256 * U2P * 2, 0, NCH / 256, 1, NG * (NCH / 256), F.G, F.c};
        EpiState E{(float*)(ws + FW_SST)};
        gemm_phase(F.lds, g, S, E); } SEAM(2);
    if (IN(3)) REPS(3) {
#ifndef NO_SCAN
        s5_scan(F, args);
#ifdef REP_SCAN
        s5_scan(F, args);
#endif
#endif
#ifndef NO_ATTN
        const bf16* Q = (const bf16*)(ws + FW_Q); const bf16* Kg = (const bf16*)(ws + FW_K); const bf16* Vg = (const bf16*)(ws + FW_V); bf16* YA = (bf16*)(ws + FW_YA);
#ifdef ATTN_V1
        for (int L = F.c; L < BATCH * NH * 8; L += F.G) { const int bh = L >> 3, qb = L & 7; attn_unit(F, Q, Kg, Vg, YA, bh >> 3, bh & 7, qb); }
#elif defined(ATTN_V2)
        attn_wave_phase(F, Q, Kg, Vg, YA);
#else
        attn_span_phase(F, Q, Kg, Vg, YA);
#ifdef REP_ATTN
        attn_span_phase(F, Q, Kg, Vg, YA);
#endif
#endif
#endif
    } SEAM(3);
    if (IN(4)) REPS(4) {
        GemmP g{U2P * 2, U2P * 2, U2P}; GroupOrder S{(const char*)(ws + FW_U2), (const char*)(ws + FW_TB), (size_t)NCH * U2P * 2, (size_t)512 * U2P * 2, (size_t)256 * U2P * 2, (size_t)256 * U2P * 2, NCH / 256, 2, NG * (NCH / 256) * 2, F.G, F.c};
        EpiS5 E{(bf16*)(ws + FW_Z)};
        gemm_phase(F.lds, g, S, E); } SEAM(4);
    if (IN(5)) REPS(5) {
        GemmP g{DSSM * 2, DSSM * 2, DSSM}; DenseOrder S{(const char*)(ws + FW_Z), (const char*)(ws + FW_WGLU), (size_t)256 * DSSM * 2, (size_t)256 * DSSM * 2, M / 256, 2, (M / 256) * 2, F.G, F.c};
        EpiGlu E{(const bf16*)(ws + FW_Z), args.in[12], (bf16*)(ws + FW_YS)};
        gemm_phase(F.lds, g, S, E); } SEAM(5);
    if (IN(6)) REPS(6) { mixnorm(F, args); } SEAM(6);
    if (IN(7)) REPS(7) {
        GemmP g{DM * 2, DM * 2, DM}; DenseOrder S{(const char*)(ws + FW_MIX), (const char*)(ws + FW_WOUT), (size_t)256 * DM * 2, (size_t)256 * DM * 2, M / 256, 4, (M / 256) * 4, F.G, F.c};
        EpiX1B E{args.in[0], (bf16*)(ws + FW_X1B)};
        gemm_phase(F.lds, g, S, E); } SEAM(7);
    if (IN(8)) { router_phase(F, args); } SEAM(8);
    int ntiles = 0;
    if (IN(9) || IN(10) || IN(11) || IN(12)) ntiles = moe_tables(F);
    if (IN(9)) REPS(9) { scatter_phase(F, args); } SEAM(9);
    if (IN(10)) REPS(10) {
        LAS int* RC = (LAS int*)(F.lds + SCR2_OFF + 1024); const int* ROWTOK = (const int*)(ws + FW_ROW);
        for (int i = 0; (long)i * F.G + F.c < (long)ntiles * 4; ++i) { const int pm = (int)(((long)i * F.G + F.c) >> 2); if (F.tid < 256) RC[i * 256 + F.tid] = ROWTOK[pm * 256 + F.tid]; }
        __syncthreads();
        GemmP g{DM * 2, DM * 2, DM}; MoeOrder S{(const char*)(ws + FW_X1B), (const char*)(ws + FW_WGU), (size_t)0, (size_t)DM * DM * 2, (size_t)256 * DM * 2, F.lds + SCR2_OFF + 256, ntiles, F.G, F.c};
        EpiGU E{(bf16*)(ws + FW_HH), (const float*)(ws + FW_ROW) + MAXROWS};
        gemm_phase<EpiGU, MoeOrder, true>(F.lds, g, S, E, RC); } SEAM(10);
    if (IN(11)) REPS(11) {
        GemmP g{DE * 2, DE * 2, DE}; MoeOrder S{(const char*)(ws + FW_HH), (const char*)(ws + FW_WD), (size_t)256 * DE * 2, (size_t)DM * DE * 2, (size_t)256 * DE * 2, F.lds + SCR2_OFF + 256, ntiles, F.G, F.c};
        EpiDown E{(bf16*)(ws + FW_YE), (const float*)(ws + FW_ROW) + 2 * MAXROWS};
        gemm_phase(F.lds, g, S, E); } SEAM(11);
    if (IN(12)) { combine_phase(F, args); }
#undef IN
#undef SEAM
}
}

#ifndef FAST_UPTO
#define FAST_UPTO 12
#endif
#ifndef NAIVE_ATTN_OVERRIDE
#define NAIVE_ATTN_OVERRIDE 0
#endif
#ifndef NAIVE_S5_OVERRIDE
#define NAIVE_S5_OVERRIDE 0
#endif
extern "C" void kernel_launch(void* const* d_in, const int* in_sizes, int n_in, void* d_out, int out_size, void* d_ws, size_t ws_size, hipStream_t stream) {
    static int grid = 0;
    if (grid == 0) {
        if (n_in != 26 || out_size != M * DM || ws_size < mk::FW_END2) { fprintf(stderr, "kernel_launch: unexpected shapes (n_in %d out %d ws %zu, need %zu)\n", n_in, out_size, ws_size, (size_t)mk::FW_END2); grid = -1; return; }
        int dev = 0, cus = 0, per_cu = 0;
        if (hipGetDevice(&dev) != hipSuccess || hipDeviceGetAttribute(&cus, hipDeviceAttributeMultiprocessorCount, dev) != hipSuccess) { grid = -1; return; }
        if (hipFuncSetAttribute((const void*)mk::mk_fwd, hipFuncAttributeMaxDynamicSharedMemorySize, mk::LDS_BYTES) != hipSuccess) { fprintf(stderr, "kernel_launch: hipFuncSetAttribute failed\n"); grid = -1; return; }
        if (hipOccupancyMaxActiveBlocksPerMultiprocessor(&per_cu, (const void*)mk::mk_fwd, mk::NTHR, mk::LDS_BYTES) != hipSuccess || per_cu < 1) { fprintf(stderr, "kernel_launch: occupancy query says %d\n", per_cu); }
        (void)hipGetLastError();
        grid = cus;
        if (grid != 256) fprintf(stderr, "kernel_launch: %d CUs (built for 256)\n", grid);
    }
    if (grid < 0) return;
    const float* const* in = (const float* const*)d_in;
    unsigned char* ws = (unsigned char*)d_ws; float* out = (float*)d_out;
    mk::Args a{};
    for (int i = 0; i < 26; ++i) a.in[i] = in[i];
    a.out = out; a.ws = ws;
    auto launch = [&](int lo, int hi) {
        (void)hipMemsetAsync(ws + WS_CTL, 0, mk::CTL_ZERO_BYTES, stream);
        a.ph_lo = lo; a.ph_hi = hi;
        hipLaunchKernelGGL(mk::mk_fwd, dim3(grid), dim3(mk::NTHR), mk::LDS_BYTES, stream, a);
    };
#if FAST_UPTO == 12 && !NAIVE_ATTN_OVERRIDE && !NAIVE_S5_OVERRIDE
    launch(0, mk::NPHASE);
#else
    bf16* Q = (bf16*)(ws + mk::FW_Q); bf16* Kb = (bf16*)(ws + mk::FW_K); bf16* V = (bf16*)(ws + mk::FW_V); bf16* U2 = (bf16*)(ws + mk::FW_U2);
    bf16* Z = (bf16*)(ws + mk::FW_Z); bf16* YS = (bf16*)(ws + mk::FW_YS); bf16* YA = (bf16*)(ws + mk::FW_YA); bf16* MIX = (bf16*)(ws + mk::FW_MIX); bf16* H2 = (bf16*)(ws + mk::FW_H2);
    int* TOK = (int*)(ws + mk::FW_TOK);
    launch(0, (FAST_UPTO < 5 ? FAST_UPTO : 5) + 1);
    if (FAST_UPTO < 5 || NAIVE_S5_OVERRIDE) {
        nv::k_s5<<<BATCH * NG, 64, 0, stream>>>(U2, in[3], in[4], in[5], in[6], in[7], in[8], in[9], in[10], Z);
        nv::GArgs g{}; g.A = Z; g.lda = DSSM; g.ascale = nullptr; g.B = in[11]; g.ldb = DSSM; g.K = DSSM; g.ldc = DSSM; g.bias = in[12]; g.Zin = Z; g.Ob = YS;
        nv::k_gemm<1><<<dim3(DSSM / 64, M / 64), 256, 0, stream>>>(g);
    }
    if (FAST_UPTO < 3 || NAIVE_ATTN_OVERRIDE) nv::k_attn<<<dim3(SEQ / 64, NH, BATCH), 64, 0, stream>>>(Q, Kb, V, YA);
    if (FAST_UPTO >= 7) launch(6, 8);
    else {
        nv::k_mixnorm<<<2048, 256, 0, stream>>>(YS, YA, in[15], in[16], MIX, 1);
        nv::GArgs g{}; g.A = MIX; g.lda = DM; g.ascale = nullptr; g.B = in[17]; g.ldb = DM; g.K = DM; g.ldc = DM; g.X = in[0]; g.Out = out;
        nv::k_gemm<2><<<dim3(DM / 64, M / 64), 256, 0, stream>>>(g);
    }
    if (FAST_UPTO >= 12) launch(8, 13);
    else {
        nv::k_router<<<2048, 256, 0, stream>>>(out, in[18], in[19], in[20], in[21], in[22], H2, TOK, 1);
        nv::k_moe<<<M, 256, 0, stream>>>(H2, TOK, in[23], in[24], in[25], out);
    }
#endif
}
```

```cpp
#define FAST_UPTO 12

#include <hip/hip_runtime.h>
#include <cstdio>
#include <cstdint>

typedef unsigned short bf16;
typedef float f32x4 __attribute__((ext_vector_type(4)));
typedef unsigned u32x4 __attribute__((ext_vector_type(4)));
typedef unsigned u32x2 __attribute__((ext_vector_type(2)));

constexpr int DM = 1024, BATCH = 32, SEQ = 2048, M = BATCH * SEQ;
constexpr int DSSM = 512, NG = 32, GS = 16, PST = 64, HD = 64, DATT = 512, NH = 8, DIN = 2048;
constexpr int NEG = 4, EPG = 8, NE = 32, DE = 512;
constexpr float EPS = 1e-6f;
constexpr int LCH = 32;
constexpr int NCH = M / LCH;
constexpr int U2P = 640;
constexpr float C2 = 0.125f * 1.4426950408889634f;

constexpr size_t MiB = 1u << 20;
constexpr size_t WS_CTL = 0;
constexpr size_t WS_TOK = 2 * MiB;
constexpr size_t WS_XN = 8 * MiB;
constexpr size_t WS_Q = WS_XN + 128 * MiB;
constexpr size_t WS_K = WS_Q + 64 * MiB;
constexpr size_t WS_V = WS_K + 64 * MiB;
constexpr size_t WS_U2 = WS_V + 64 * MiB;
constexpr size_t WS_Z = WS_U2 + 80 * MiB;
constexpr size_t WS_YS = WS_Z + 64 * MiB;
constexpr size_t WS_YA = WS_YS + 64 * MiB;
constexpr size_t WS_MIX = WS_YA + 64 * MiB;
constexpr size_t WS_H2 = WS_XN;
constexpr size_t WS_PROJ = WS_Z;
constexpr size_t WS_END = WS_PROJ + 512 * MiB;

__device__ __forceinline__ unsigned f2bf(float f) { unsigned u = __builtin_bit_cast(unsigned, f); return (u + 0x7fffu + ((u >> 16) & 1u)) >> 16; }
__device__ __forceinline__ float bf2f(unsigned short h) { return __builtin_bit_cast(float, (unsigned)h << 16); }
__device__ __forceinline__ unsigned pk2(float lo, float hi) { return f2bf(lo) | (f2bf(hi) << 16); }
__device__ __forceinline__ float wave_sum(float v) {
#pragma unroll
    for (int o = 1; o < 64; o <<= 1) v += __shfl_xor(v, o);
    return v;
}
__device__ __forceinline__ void sincos_d(double th, double& s, double& c) {
    const double q = rint(th * 0.63661977236758134308);
    const double r = (th - q * 1.57079632679489655800) - q * 6.12323399573676603587e-17;
    const double r2 = r * r;
    double sp = -1.0 / 1307674368000.0; sp = sp * r2 + 1.0 / 6227020800.0; sp = sp * r2 - 1.0 / 39916800.0; sp = sp * r2 + 1.0 / 362880.0; sp = sp * r2 - 1.0 / 5040.0; sp = sp * r2 + 1.0 / 120.0; sp = sp * r2 - 1.0 / 6.0; sp = sp * r2 + 1.0;
    const double sn = sp * r;
    double cp = 1.0 / 20922789888000.0; cp = cp * r2 - 1.0 / 87178291200.0; cp = cp * r2 + 1.0 / 479001600.0; cp = cp * r2 - 1.0 / 3628800.0; cp = cp * r2 + 1.0 / 40320.0; cp = cp * r2 - 1.0 / 720.0; cp = cp * r2 + 1.0 / 24.0; cp = cp * r2 - 0.5; cp = cp * r2 + 1.0;
    const int qi = ((int)q) & 3;
    s = (qi == 0) ? sn : (qi == 1) ? cp : (qi == 2) ? -sn : -cp;
    c = (qi == 0) ? cp : (qi == 1) ? -sn : (qi == 2) ? -cp : sn;
}
__device__ __forceinline__ float gelu_tanh(float x) {
    const float u = 0.7978845608028654f * (x + 0.044715f * x * x * x);
    const float e = __expf(2.f * u);
    const float t = 1.f - 2.f / (e + 1.f);
    return 0.5f * x * (1.f + t);
}
__device__ __forceinline__ float sigmoidf_(float x) { return 1.f / (1.f + __expf(-x)); }

namespace nv {
__global__ __launch_bounds__(256) void k_xn(const float* __restrict__ x, bf16* __restrict__ xn) {
    const int lane = threadIdx.x & 63, gw = (blockIdx.x * 256 + threadIdx.x) >> 6, ngw = gridDim.x * 4;
    for (int m = gw; m < M; m += ngw) {
        const f32x4* xr = (const f32x4*)(x + (size_t)m * DM) + lane;
        f32x4 v[4]; float s = 0.f;
#pragma unroll
        for (int j = 0; j < 4; ++j) { v[j] = xr[64 * j]; s += v[j].x * v[j].x + v[j].y * v[j].y + v[j].z * v[j].z + v[j].w * v[j].w; }
        const float rstd = 1.f / sqrtf(wave_sum(s) * (1.f / DM) + EPS);
        u32x2* o = (u32x2*)(xn + (size_t)m * DM) + lane;
#pragma unroll
        for (int j = 0; j < 4; ++j) { u32x2 w; w.x = pk2(v[j].x * rstd, v[j].y * rstd); w.y = pk2(v[j].z * rstd, v[j].w * rstd); o[64 * j] = w; }
    }
}
struct GArgs { const bf16* A; int lda; const float* ascale; const float* B; int ldb; int K; float* Cf; int ldc; const float* bias; const bf16* Zin; bf16* Ob; const float* X; float* Out; };
template <int EPI> __global__ __launch_bounds__(256) void k_gemm(GArgs g) {
    __shared__ float As[16][68], Bs[16][68];
    const int tid = threadIdx.x, tx = tid & 15, ty = tid >> 4, m0 = blockIdx.y * 64, n0 = blockIdx.x * 64;
    float acc[4][4] = {};
    for (int k0 = 0; k0 < g.K; k0 += 16) {
        { const int r = tid >> 2, kk = (tid & 3) * 4; const u32x2 w = *(const u32x2*)(g.A + (size_t)(m0 + r) * g.lda + k0 + kk);
          float a0 = bf2f(w.x & 0xffff), a1 = bf2f(w.x >> 16), a2 = bf2f(w.y & 0xffff), a3 = bf2f(w.y >> 16);
          if (g.ascale) { a0 *= g.ascale[k0 + kk]; a1 *= g.ascale[k0 + kk + 1]; a2 *= g.ascale[k0 + kk + 2]; a3 *= g.ascale[k0 + kk + 3]; }
          As[kk][r] = a0; As[kk + 1][r] = a1; As[kk + 2][r] = a2; As[kk + 3][r] = a3; }
        { const int kk = tid >> 4, nn = (tid & 15) * 4; const f32x4 b = *(const f32x4*)(g.B + (size_t)(k0 + kk) * g.ldb + n0 + nn);
          Bs[kk][nn] = b.x; Bs[kk][nn + 1] = b.y; Bs[kk][nn + 2] = b.z; Bs[kk][nn + 3] = b.w; }
        __syncthreads();
#pragma unroll
        for (int k = 0; k < 16; ++k) { float a[4], b[4];
#pragma unroll
            for (int i = 0; i < 4; ++i) { a[i] = As[k][ty * 4 + i]; b[i] = Bs[k][tx * 4 + i]; }
#pragma unroll
            for (int i = 0; i < 4; ++i)
#pragma unroll
                for (int j = 0; j < 4; ++j) acc[i][j] += a[i] * b[j]; }
        __syncthreads();
    }
#pragma unroll
    for (int i = 0; i < 4; ++i) { const int m = m0 + ty * 4 + i;
#pragma unroll
        for (int j = 0; j < 4; ++j) { const int n = n0 + tx * 4 + j; const float v = acc[i][j];
            if (EPI == 0) g.Cf[(size_t)m * g.ldc + n] = v;
            else if (EPI == 1) { const float z = bf2f(g.Zin[(size_t)m * g.ldc + n]); g.Ob[(size_t)m * g.ldc + n] = (bf16)f2bf(z * sigmoidf_(v + g.bias[n])); }
            else if (EPI == 2) g.Out[(size_t)m * g.ldc + n] = g.X[(size_t)m * g.ldc + n] + v; } }
}
__global__ __launch_bounds__(256) void k_projpost(const float* __restrict__ P, const float* __restrict__ gq, const float* __restrict__ gk, bf16* U2, bf16* Q, bf16* Kb, bf16* V) {
    const int lane = threadIdx.x & 63, gw = (blockIdx.x * 256 + threadIdx.x) >> 6, ngw = gridDim.x * 4;
    for (int m = gw; m < M; m += ngw) {
        const float* pr = P + (size_t)m * DIN;
        for (int c = 0; c < 32; ++c) {
            const float v = pr[c * 64 + lane];
            if (c < 8) { const int ch = c * 64 + lane, g = ch >> 4, h = ch & 15; U2[((size_t)g * NCH + (m >> 5)) * U2P + (m & 31) * 16 + h] = (bf16)f2bf(v); }
            else if (c < 24) { const float rstd = 1.f / sqrtf(wave_sum(v * v) * (1.f / 64.f) + EPS);
                if (c < 16) Q[(size_t)m * DATT + (c - 8) * 64 + lane] = (bf16)f2bf(v * rstd * gq[lane] * C2);
                else Kb[(size_t)m * DATT + (c - 16) * 64 + lane] = (bf16)f2bf(v * rstd * gk[lane]); }
            else V[(size_t)m * DATT + (c - 24) * 64 + lane] = (bf16)f2bf(v);
        }
    }
}
__global__ __launch_bounds__(64) void k_s5(const bf16* __restrict__ U2, const float* lre, const float* lim, const float* ldt, const float* bre, const float* bim, const float* cre, const float* cim, const float* dsk, bf16* Z) {
    const int p = threadIdx.x, b = blockIdx.x >> 5, g = blockIdx.x & 31;
    const double dt = exp((double)ldt[g]), lr = lre[g * PST + p], li = lim[g * PST + p];
    double sn, cs; sincos_d(li * dt, sn, cs); const double mag = exp(lr * dt);
    const double ar = mag * cs, ai = mag * sn, den = lr * lr + li * li, nr = ar - 1.0, ni = ai;
    const double cfr = (nr * lr + ni * li) / den, cfi = (ni * lr - nr * li) / den;
    const float far = (float)ar, fai = (float)ai;
    float bbr[16], bbi[16], ccr[16], cci[16];
#pragma unroll
    for (int h = 0; h < 16; ++h) { const double br = bre[(g * PST + p) * GS + h], bi = bim[(g * PST + p) * GS + h];
        bbr[h] = (float)(cfr * br - cfi * bi); bbi[h] = (float)(cfr * bi + cfi * br);
        ccr[h] = cre[(g * GS + h) * PST + p]; cci[h] = cim[(g * GS + h) * PST + p]; }
    const float dme = dsk[g * GS + (p & 15)];
    float xr = 0.f, xi = 0.f;
    for (int t = 0; t < SEQ; ++t) {
        const int m = b * SEQ + t;
        const bf16* up = U2 + ((size_t)g * NCH + (m >> 5)) * U2P + (m & 31) * 16;
        const u32x4 w0 = *(const u32x4*)up, w1 = *(const u32x4*)(up + 8);
        float u[16];
        u[0] = bf2f(w0.x & 0xffff); u[1] = bf2f(w0.x >> 16); u[2] = bf2f(w0.y & 0xffff); u[3] = bf2f(w0.y >> 16); u[4] = bf2f(w0.z & 0xffff); u[5] = bf2f(w0.z >> 16); u[6] = bf2f(w0.w & 0xffff); u[7] = bf2f(w0.w >> 16);
        u[8] = bf2f(w1.x & 0xffff); u[9] = bf2f(w1.x >> 16); u[10] = bf2f(w1.y & 0xffff); u[11] = bf2f(w1.y >> 16); u[12] = bf2f(w1.z & 0xffff); u[13] = bf2f(w1.z >> 16); u[14] = bf2f(w1.w & 0xffff); u[15] = bf2f(w1.w >> 16);
        float br = 0.f, bi = 0.f;
#pragma unroll
        for (int h = 0; h < 16; ++h) { br += bbr[h] * u[h]; bi += bbi[h] * u[h]; }
        const float nxr = far * xr - fai * xi + br, nxi = far * xi + fai * xr + bi; xr = nxr; xi = nxi;
        float ymine = 0.f;
#pragma unroll
        for (int h = 0; h < 16; ++h) { const float s = wave_sum(ccr[h] * xr - cci[h] * xi); if ((p & 15) == h) ymine = s; }
        if (p < 16) { float uh = 0.f;
#pragma unroll
            for (int h = 0; h < 16; ++h) if (p == h) uh = u[h];
            Z[(size_t)m * DSSM + g * GS + p] = (bf16)f2bf(gelu_tanh(ymine + dme * uh)); }
    }
}
__global__ __launch_bounds__(64) void k_attn(const bf16* __restrict__ Q, const bf16* __restrict__ Kb, const bf16* __restrict__ V, bf16* YA) {
    const int t = blockIdx.x * 64 + threadIdx.x, h = blockIdx.y, b = blockIdx.z;
    const size_t row0 = (size_t)b * SEQ;
    float q[64], o[64];
    { const u32x4* qp = (const u32x4*)(Q + (row0 + t) * DATT + h * HD);
#pragma unroll
      for (int i = 0; i < 8; ++i) { const u32x4 w = qp[i]; q[8 * i] = bf2f(w.x & 0xffff); q[8 * i + 1] = bf2f(w.x >> 16); q[8 * i + 2] = bf2f(w.y & 0xffff); q[8 * i + 3] = bf2f(w.y >> 16); q[8 * i + 4] = bf2f(w.z & 0xffff); q[8 * i + 5] = bf2f(w.z >> 16); q[8 * i + 6] = bf2f(w.w & 0xffff); q[8 * i + 7] = bf2f(w.w >> 16); } }
#pragma unroll
    for (int i = 0; i < 64; ++i) o[i] = 0.f;
    float R = 0.f;
    for (int s = t - 1; s >= 0; --s) {
        const u32x4* kp = (const u32x4*)(Kb + (row0 + s) * DATT + h * HD);
        float z = 0.f;
#pragma unroll
        for (int i = 0; i < 8; ++i) { const u32x4 w = kp[i]; z += q[8 * i] * bf2f(w.x & 0xffff) + q[8 * i + 1] * bf2f(w.x >> 16) + q[8 * i + 2] * bf2f(w.y & 0xffff) + q[8 * i + 3] * bf2f(w.y >> 16) + q[8 * i + 4] * bf2f(w.z & 0xffff) + q[8 * i + 5] * bf2f(w.z >> 16) + q[8 * i + 6] * bf2f(w.w & 0xffff) + q[8 * i + 7] * bf2f(w.w >> 16); }
        const float e = exp2f(z), l = -log2f(1.f + e), a = exp2f(z + l + R);
        R += l;
        const u32x4* vp = (const u32x4*)(V + (row0 + s) * DATT + h * HD);
#pragma unroll
        for (int i = 0; i < 8; ++i) { const u32x4 w = vp[i]; o[8 * i] += a * bf2f(w.x & 0xffff); o[8 * i + 1] += a * bf2f(w.x >> 16); o[8 * i + 2] += a * bf2f(w.y & 0xffff); o[8 * i + 3] += a * bf2f(w.y >> 16); o[8 * i + 4] += a * bf2f(w.z & 0xffff); o[8 * i + 5] += a * bf2f(w.z >> 16); o[8 * i + 6] += a * bf2f(w.w & 0xffff); o[8 * i + 7] += a * bf2f(w.w >> 16); }
    }
    u32x4* op = (u32x4*)(YA + (row0 + t) * DATT + h * HD);
#pragma unroll
    for (int i = 0; i < 8; ++i) { u32x4 w; w.x = pk2(o[8 * i], o[8 * i + 1]); w.y = pk2(o[8 * i + 2], o[8 * i + 3]); w.z = pk2(o[8 * i + 4], o[8 * i + 5]); w.w = pk2(o[8 * i + 6], o[8 * i + 7]); op[i] = w; }
}
__global__ __launch_bounds__(256) void k_mixnorm(const bf16* __restrict__ YS, const bf16* __restrict__ YA, const float* gs, const float* ga, bf16* MIX, int gains) {
    const int lane = threadIdx.x & 63, gw = (blockIdx.x * 256 + threadIdx.x) >> 6, ngw = gridDim.x * 4;
    for (int m = gw; m < M; m += ngw) {
#pragma unroll
        for (int half = 0; half < 2; ++half) {
            const bf16* src = (half ? YA : YS) + (size_t)m * 512 + lane * 8; const float* gg = (half ? ga : gs) + lane * 8;
            const u32x4 w = *(const u32x4*)src; float v[8];
            v[0] = bf2f(w.x & 0xffff); v[1] = bf2f(w.x >> 16); v[2] = bf2f(w.y & 0xffff); v[3] = bf2f(w.y >> 16); v[4] = bf2f(w.z & 0xffff); v[5] = bf2f(w.z >> 16); v[6] = bf2f(w.w & 0xffff); v[7] = bf2f(w.w >> 16);
            float s = 0.f;
#pragma unroll
            for (int i = 0; i < 8; ++i) s += v[i] * v[i];
            const float rstd = 1.f / sqrtf(wave_sum(s) * (1.f / 512.f) + EPS);
#pragma unroll
            for (int i = 0; i < 8; ++i) v[i] *= rstd * (gains ? gg[i] : 1.f);
            u32x4 o; o.x = pk2(v[0], v[1]); o.y = pk2(v[2], v[3]); o.z = pk2(v[4], v[5]); o.w = pk2(v[6], v[7]);
            *(u32x4*)(MIX + (size_t)m * DM + half * 512 + lane * 8) = o;
        }
    }
}
__global__ __launch_bounds__(256) void k_router(const float* __restrict__ x1, const float* gffn, const float* wrg, const float* brg, const float* wre, const float* bre_, bf16* H2, int* TOK, int gains) {
    const int lane = threadIdx.x & 63, gw = (blockIdx.x * 256 + threadIdx.x) >> 6, ngw = gridDim.x * 4;
    for (int m = gw; m < M; m += ngw) {
        const f32x4* xr = (const f32x4*)(x1 + (size_t)m * DM) + lane;
        f32x4 v[4]; float s = 0.f;
#pragma unroll
        for (int j = 0; j < 4; ++j) { v[j] = xr[64 * j]; s += v[j].x * v[j].x + v[j].y * v[j].y + v[j].z * v[j].z + v[j].w * v[j].w; }
        const float rstd = 1.f / sqrtf(wave_sum(s) * (1.f / DM) + EPS);
        float hv[16];
#pragma unroll
        for (int j = 0; j < 4; ++j) { const f32x4 gg = ((const f32x4*)gffn)[64 * j + lane];
            hv[4 * j] = v[j].x * rstd * gg.x; hv[4 * j + 1] = v[j].y * rstd * gg.y; hv[4 * j + 2] = v[j].z * rstd * gg.z; hv[4 * j + 3] = v[j].w * rstd * gg.w;
            u32x2 w; if (gains) { w.x = pk2(hv[4 * j], hv[4 * j + 1]); w.y = pk2(hv[4 * j + 2], hv[4 * j + 3]); } else { w.x = pk2(v[j].x * rstd, v[j].y * rstd); w.y = pk2(v[j].z * rstd, v[j].w * rstd); }
            ((u32x2*)(H2 + (size_t)m * DM))[64 * j + lane] = w; }
        float lg[36];
#pragma unroll
        for (int c = 0; c < 36; ++c) { float a = 0.f;
#pragma unroll
            for (int j = 0; j < 4; ++j)
#pragma unroll
                for (int i = 0; i < 4; ++i) { const int k = 256 * j + 4 * lane + i; a += hv[4 * j + i] * (c < 4 ? wrg[k * 4 + c] : wre[k * 32 + (c - 4)]); }
            lg[c] = wave_sum(a) + (c < 4 ? brg[c] : bre_[c - 4]); }
        if (lane == 0) {
            int gi = 0; float gm = lg[0];
#pragma unroll
            for (int c = 1; c < 4; ++c) if (lg[c] > gm) { gm = lg[c]; gi = c; }
            float gsum = 0.f;
#pragma unroll
            for (int c = 0; c < 4; ++c) gsum += __expf(lg[c] - gm);
            const float pgrp = 1.f / gsum;
            float el[8];
#pragma unroll
            for (int e = 0; e < 8; ++e) { float t = 0.f;
#pragma unroll
                for (int g2 = 0; g2 < 4; ++g2) if (g2 == gi) t = lg[4 + g2 * 8 + e];
                el[e] = t; }
            int i0 = 0; float m0 = el[0];
#pragma unroll
            for (int e = 1; e < 8; ++e) if (el[e] > m0) { m0 = el[e]; i0 = e; }
            int i1 = -1; float m1 = -3.0e38f;
#pragma unroll
            for (int e = 0; e < 8; ++e) if (e != i0 && el[e] > m1) { m1 = el[e]; i1 = e; }
            const float e1 = __expf(m1 - m0), p0 = 1.f / (1.f + e1), p1 = e1 / (1.f + e1);
            int* tk = TOK + (size_t)m * 8;
            tk[0] = gi * 8 + i0; tk[1] = gi * 8 + i1; tk[2] = __float_as_int(pgrp * p0); tk[3] = __float_as_int(pgrp * p1);
        }
    }
}
__global__ __launch_bounds__(256) void k_moe(const bf16* __restrict__ H2, const int* __restrict__ TOK, const float* __restrict__ wg, const float* __restrict__ wu, const float* __restrict__ wd, float* out) {
    __shared__ float hs[DM]; __shared__ float hid[DE];
    const int m = blockIdx.x, tid = threadIdx.x;
    for (int k = tid; k < DM; k += 256) hs[k] = bf2f(H2[(size_t)m * DM + k]);
    __syncthreads();
    float oacc[4] = {0.f, 0.f, 0.f, 0.f};
    for (int kk = 0; kk < 2; ++kk) {
        const int e = TOK[(size_t)m * 8 + kk]; const float gate = __int_as_float(TOK[(size_t)m * 8 + 2 + kk]);
        const float* Wg = wg + (size_t)e * DM * DE; const float* Wu = wu + (size_t)e * DM * DE; const float* Wd = wd + (size_t)e * DE * DM;
        float g0 = 0.f, g1 = 0.f, u0 = 0.f, u1 = 0.f;
        for (int k = 0; k < DM; ++k) { const float hvv = hs[k]; g0 += hvv * Wg[(size_t)k * DE + tid]; g1 += hvv * Wg[(size_t)k * DE + tid + 256]; u0 += hvv * Wu[(size_t)k * DE + tid]; u1 += hvv * Wu[(size_t)k * DE + tid + 256]; }
        __syncthreads();
        hid[tid] = g0 * sigmoidf_(g0) * u0; hid[tid + 256] = g1 * sigmoidf_(g1) * u1;
        __syncthreads();
        float d[4] = {0.f, 0.f, 0.f, 0.f};
        for (int k = 0; k < DE; ++k) { const float hh = hid[k];
#pragma unroll
            for (int j = 0; j < 4; ++j) d[j] += hh * Wd[(size_t)k * DM + tid + 256 * j]; }
#pragma unroll
        for (int j = 0; j < 4; ++j) oacc[j] += gate * d[j];
    }
#pragma unroll
    for (int j = 0; j < 4; ++j) out[(size_t)m * DM + tid + 256 * j] += oacc[j];
}
}


namespace mk {
#define LAS __attribute__((address_space(3)))
#define GAS __attribute__((address_space(1)))
typedef short bf16x8 __attribute__((ext_vector_type(8)));
typedef short s16x4 __attribute__((ext_vector_type(4)));
typedef float f32x16 __attribute__((ext_vector_type(16)));
typedef float f32x2 __attribute__((ext_vector_type(2)));
typedef __bf16 bf16x2_t __attribute__((ext_vector_type(2)));
typedef GAS unsigned gu32;

constexpr int NWAVES = 8, NTHR = 512;
constexpr int RING_BYTES = 131072, SCR2_OFF = RING_BYTES, SCR2_BYTES = 16128, MISC_OFF = SCR2_OFF + SCR2_BYTES, LDS_BYTES = 147456;
static_assert(MISC_OFF + 256 == LDS_BYTES, "LDS map");

constexpr size_t FW_TOK = 2 * MiB, FW_WIN = 4 * MiB, FW_WOUT = 8 * MiB, FW_WGLU = 10 * MiB, FW_WR = 10 * MiB + 512 * 1024, FW_TB = 12 * MiB, FW_W1 = 32 * MiB,
                 FW_WGU = 40 * MiB, FW_WD = 104 * MiB, FW_SST = 136 * MiB, FW_XN = 168 * MiB, FW_Q = 296 * MiB, FW_K = 360 * MiB, FW_V = 424 * MiB, FW_U2 = 488 * MiB,
                 FW_Z = 568 * MiB, FW_YS = 632 * MiB, FW_YA = 696 * MiB, FW_MIX = 760 * MiB, FW_END = 888 * MiB,
                 FW_H2 = FW_XN, FW_X1B = FW_XN, FW_XG = 296 * MiB, FW_HH = 568 * MiB, FW_YE = FW_XG, FW_ROW = 888 * MiB, FW_END2 = 890 * MiB;
static_assert(FW_K - FW_Q == (size_t)M * 512 * 2 && FW_V - FW_K == (size_t)M * 512 * 2, "Q|K|V contiguous");
constexpr int MAXTILES = 544, MAXROWS = MAXTILES * 256;
static_assert(FW_ROW + (size_t)3 * MAXROWS * 4 <= FW_END2, "row arrays");
static_assert(FW_XG + (size_t)MAXTILES * 256 * DM * 2 <= FW_HH && FW_HH + (size_t)MAXTILES * 256 * DE * 2 <= FW_END, "MoE overlay");
constexpr int CW_TMO = 0, CW_CNT = 64, CW_BAR = 4096, CW_SSQS = 65536, CW_SSQA = 131072;
static_assert((CW_SSQA + M) * 4 <= (int)(1 * MiB), "ssq arrays inside the memset region");
constexpr size_t CTL_ZERO_BYTES = 1 * MiB;

#define RLX_AGENT __ATOMIC_RELAXED, __HIP_MEMORY_SCOPE_AGENT
__device__ __forceinline__ unsigned cvtpk(float lo, float hi) { f32x2 v = {lo, hi}; bf16x2_t b = __builtin_convertvector(v, bf16x2_t); return __builtin_bit_cast(unsigned, b); }

#define XB_TMO      128
#define XB_XCNT(j)  (256  + 64 * (j))
#define XB_XSUB(j)  (1280 + 64 * (j))
#define XB_XGEN(j)  (2304 + 64 * (j))
#define XB_TOP      3328
#define XB_TOPGEN   3392
#define XCD_BAR_WORDS 3456
#define XB_SPIN_CAP (1u << 18)
__device__ __forceinline__ unsigned xb_ld(unsigned* p)              { return __hip_atomic_load(p, __ATOMIC_RELAXED, __HIP_MEMORY_SCOPE_AGENT); }
__device__ __forceinline__ unsigned xb_add(unsigned* p, unsigned v) { return __hip_atomic_fetch_add(p, v, __ATOMIC_RELAXED, __HIP_MEMORY_SCOPE_AGENT); }
__device__ __forceinline__ unsigned xb_xcc_id() { return (unsigned)__builtin_amdgcn_s_getreg((3 << 11) | 20) & 0xFu; }
#define XB_SPIN(cond, bar) do { unsigned _sp = 0; while (cond) { __builtin_amdgcn_s_sleep(1); \
    if ((++_sp & 255u) == 0u) { if (xb_ld(&(bar)[XB_TMO])) break; if (_sp > XB_SPIN_CAP) { atomicAdd(&(bar)[XB_TMO], 1u); break; } } } } while (0)
struct XcdBarrier { unsigned* bar; unsigned x; volatile LAS unsigned* st; };
__device__ __forceinline__ XcdBarrier xcd_barrier_post(unsigned* bar, volatile LAS unsigned* st) {
    XcdBarrier b; b.bar = bar; b.x = xb_xcc_id(); b.st = st;
    if (threadIdx.x == 0) (void)xb_add(&bar[XB_XCNT(b.x)], 1u);
    return b;
}
__device__ __forceinline__ void xcd_barrier_complete(unsigned* bar, unsigned x, unsigned& nloc, unsigned& nx) {
    const unsigned G = gridDim.x * gridDim.y * gridDim.z;
    unsigned sum, cnt, mine, sp = 0u;
    for (;;) {
        sum = 0u; cnt = 0u; mine = 0u;
#pragma unroll
        for (unsigned j = 0; j < 16; ++j) { const unsigned c = xb_ld(&bar[XB_XCNT(j)]); sum += c; cnt += (c > 0u) ? 1u : 0u; mine = (j == x) ? c : mine; }
        if (sum == G) break;
        __builtin_amdgcn_s_sleep(1);
        if ((++sp & 255u) == 0u) { if (xb_ld(&bar[XB_TMO])) break; if (sp > XB_SPIN_CAP) { atomicAdd(&bar[XB_TMO], 1u); break; } }
    }
    nloc = mine > 0u ? mine : 1u; nx = cnt > 0u ? cnt : 1u;
}
__device__ __forceinline__ void xcd_barrier(const XcdBarrier& b) {
    asm volatile("s_waitcnt vmcnt(0)" ::: "memory");
    __syncthreads();
    if (threadIdx.x == 0) {
        unsigned* bar = b.bar;
        __builtin_amdgcn_s_waitcnt(0);
        unsigned nloc = b.st[0], nx = b.st[1];
        if (nloc == 0u) { xcd_barrier_complete(bar, b.x, nloc, nx); b.st[0] = nloc; b.st[1] = nx; }
        const unsigned old = xb_add(&bar[XB_XSUB(b.x)], 1u);
        const unsigned gen = old / nloc;
        if (old + 1u == (gen + 1u) * nloc) {
            __builtin_amdgcn_fence(__ATOMIC_RELEASE, "agent");
            asm volatile("s_waitcnt vmcnt(0)" ::: "memory");
            const unsigned og = xb_add(&bar[XB_TOP], 1u);
            const unsigned tg = og / nx;
            if (og + 1u == (tg + 1u) * nx) xb_add(&bar[XB_TOPGEN], 1u);
            else XB_SPIN(xb_ld(&bar[XB_TOPGEN]) == tg, bar);
            __builtin_amdgcn_fence(__ATOMIC_ACQUIRE, "agent");
            xb_add(&bar[XB_XGEN(b.x)], 1u);
            asm volatile("s_waitcnt vmcnt(0)" ::: "memory");
        } else {
            XB_SPIN(xb_ld(&bar[XB_XGEN(b.x)]) == gen, bar);
            __builtin_amdgcn_fence(__ATOMIC_ACQUIRE, "agent");
            asm volatile("s_waitcnt vmcnt(0)" ::: "memory");
        }
    }
    __syncthreads();
}

constexpr int BM = 256, BK = 64, HALF = 128, HTB = HALF * BK * 2;
__device__ __forceinline__ int lds_byte(int r, int c) { const int st = (r >> 4) * 2 + (c >> 5), rr = r & 15, cc = c & 31, ob = rr * 64 + cc * 2; return st * 1024 + (ob ^ (((ob >> 9) & 1) << 5)); }
__device__ __forceinline__ void stage_rc(int b, int& R, int& C) { const int st = b / 1024, sb = b % 1024, swz = sb ^ (((sb >> 9) & 1) << 5); R = (st >> 1) * 16 + swz / 64; C = (st & 1) * 32 + (swz % 64) / 2; }
__device__ __forceinline__ int perm32(int rho) { const int n = rho >> 4, i = rho & 15; return 8 * (i >> 2) + 4 * n + (i & 3); }
struct Unit { const char* a; const char* b; int pm, pn, aux; };
struct GemmP { int lda_b, ldb_b, K; };

template <class Epi, class Sched, bool GATHER = false>
__device__ __forceinline__ void gemm_phase(LAS unsigned char* lds, const GemmP g, const Sched& S, const Epi& E, const LAS int* rowcache = nullptr) {
    const int tid = threadIdx.x, wid = __builtin_amdgcn_readfirstlane(tid >> 6), lane = tid & 63, wr = wid >> 2, wc = wid & 3, fr = lane & 15, fq = lane >> 4;
    const int nt = g.K / BK;
    unsigned voffA[2], voffB[2]; int gR[2], gC[2];
#pragma unroll
    for (int i = 0; i < 2; ++i) { int R, C; stage_rc(tid * 16 + i * 8192, R, C); const int Rb = Epi::PERM ? ((R & ~31) + perm32(R & 31)) : R; gR[i] = R; gC[i] = C * 2;
        voffA[i] = (unsigned)(R * g.lda_b + C * 2); voffB[i] = (unsigned)(Rb * g.ldb_b + C * 2); }
    unsigned vc0[2] = {voffA[0], voffA[1]}, vc1[2] = {voffA[0], voffA[1]}, vn0[2] = {voffA[0], voffA[1]}, vn1[2] = {voffA[0], voffA[1]};
#define PG8_GOFF(dst0, dst1, ui_) do { _Pragma("unroll") for (int _i = 0; _i < 2; ++_i) { \
        dst0[_i] = (unsigned)rowcache[(ui_) * 256 + gR[_i]] * (unsigned)g.lda_b + (unsigned)gC[_i]; dst1[_i] = (unsigned)rowcache[(ui_) * 256 + 128 + gR[_i]] * (unsigned)g.lda_b + (unsigned)gC[_i]; } } while (0)
    const size_t kstep = (size_t)(BK * 2);
    const size_t hstepA = GATHER ? 0 : (size_t)HALF * g.lda_b, hstepB = (size_t)HALF * g.ldb_b;
    const unsigned ldsw = (unsigned)wid * 1024u;
    const int aoff = lds_byte(wr * 64 + fr, fq * 8), boff = lds_byte(wc * 32 + fr, fq * 8);
#define PG8_SA(b, h) (((b) * 2 + (h)) * HTB)
#define PG8_SB(b, h) ((4 + (b) * 2 + (h)) * HTB)
#define PG8_STAGE(bufoff, gbase, voff) do { _Pragma("unroll") for (int _i = 0; _i < 2; ++_i) \
        __builtin_amdgcn_global_load_lds((const unsigned*)((const char*)(gbase) + (voff)[_i]), (LAS unsigned*)(lds + (bufoff) + ldsw + _i * 8192), 16, 0, 0); } while (0)
#define PG8_LDA(dst, b, h) do { _Pragma("unroll") for (int m = 0; m < 4; ++m) _Pragma("unroll") for (int k = 0; k < 2; ++k) dst[m][k] = *(const LAS bf16x8*)(lds + PG8_SA(b, h) + aoff + m * 2048 + k * 1024); } while (0)
#define PG8_LDB(dst, b, h) do { _Pragma("unroll") for (int n = 0; n < 2; ++n) _Pragma("unroll") for (int k = 0; k < 2; ++k) dst[n][k] = *(const LAS bf16x8*)(lds + PG8_SB(b, h) + boff + n * 2048 + k * 1024); } while (0)
#define PG8_MMA(ai, bj, At, Bt) do { __builtin_amdgcn_s_setprio(1); _Pragma("unroll") for (int m = 0; m < 4; ++m) _Pragma("unroll") for (int n = 0; n < 2; ++n) _Pragma("unroll") for (int k = 0; k < 2; ++k) \
        acc[ai][bj][m][n] = __builtin_amdgcn_mfma_f32_16x16x32_bf16(Bt[n][k], At[m][k], acc[ai][bj][m][n], 0, 0, 0); __builtin_amdgcn_s_setprio(0); } while (0)
#define PG8_WAIT_V(n) asm volatile("s_waitcnt vmcnt(" #n ")" ::: "memory")
#define PG8_WAIT_L(n) asm volatile("s_waitcnt lgkmcnt(" #n ")" ::: "memory")
#define PG8_BAR __builtin_amdgcn_s_barrier()
#define PG8_SCHED __builtin_amdgcn_sched_barrier(0)
    Unit cur, nxt; int ui = 0;
    if (!S.next(0, cur)) return;
    f32x4 acc[2][2][4][2];
#pragma unroll
    for (int a = 0; a < 2; ++a)
#pragma unroll
        for (int b = 0; b < 2; ++b)
#pragma unroll
            for (int m = 0; m < 4; ++m)
#pragma unroll
                for (int n = 0; n < 2; ++n) acc[a][b][m][n] = (f32x4){0.f, 0.f, 0.f, 0.f};
    bf16x8 At[4][2], B0[2][2], B1[2][2];
    const char* cA = cur.a; const char* cB = cur.b;
    if (GATHER) { PG8_GOFF(vc0, vc1, 0); }
    PG8_STAGE(PG8_SB(0, 0), cB, voffB); PG8_STAGE(PG8_SB(0, 1), cB + hstepB, voffB); PG8_STAGE(PG8_SA(0, 0), cA, vc0); PG8_STAGE(PG8_SA(0, 1), cA + hstepA, vc1);
    if (wr == 1) PG8_BAR;
    PG8_WAIT_V(2); PG8_BAR;
    PG8_STAGE(PG8_SB(1, 0), cB + kstep, voffB); PG8_STAGE(PG8_SA(1, 0), cA + kstep, vc0); PG8_STAGE(PG8_SB(1, 1), cB + hstepB + kstep, voffB);
    PG8_WAIT_V(6); PG8_BAR;
    for (;;) {
        const bool has_next = S.next(ui + 1, nxt);
        const char* nA = has_next ? nxt.a : cA; const char* nB = has_next ? nxt.b : cB;
        if constexpr (Epi::HOOKS) E.begin(cur, ui, tid);
        if (GATHER) { if (has_next) { PG8_GOFF(vn0, vn1, ui + 1); } else { vn0[0] = vc0[0]; vn0[1] = vc0[1]; vn1[0] = vc1[0]; vn1[1] = vc1[1]; } }
        for (int t = 0; t < nt; t += 2) {
            const bool last = (t == nt - 2);
            if constexpr (Epi::HOOKS) { if (t == nt / 2) E.mid(acc, ui, wr, fr); }
            const char* a1 = cA + (size_t)(t + 1) * kstep;
            const char* a2 = last ? nA : cA + (size_t)(t + 2) * kstep; const char* b2 = last ? nB : cB + (size_t)(t + 2) * kstep;
            const char* a3 = a2 + kstep; const char* b3 = b2 + kstep;
            unsigned w0[2], w1[2];
            w0[0] = (GATHER && last) ? vn0[0] : vc0[0]; w0[1] = (GATHER && last) ? vn0[1] : vc0[1]; w1[0] = (GATHER && last) ? vn1[0] : vc1[0]; w1[1] = (GATHER && last) ? vn1[1] : vc1[1];
            PG8_LDB(B0, 0, 0); PG8_LDB(B1, 0, 1); PG8_SCHED; PG8_LDA(At, 0, 0); PG8_STAGE(PG8_SA(1, 1), a1 + hstepA, vc1);
            PG8_WAIT_V(8); PG8_WAIT_L(0); PG8_BAR; PG8_MMA(0, 0, At, B0); PG8_MMA(0, 1, At, B1); PG8_BAR; PG8_SCHED;
            PG8_LDA(At, 0, 1); PG8_STAGE(PG8_SB(0, 0), b2, voffB); PG8_STAGE(PG8_SB(0, 1), b2 + hstepB, voffB); PG8_STAGE(PG8_SA(0, 0), a2, w0);
            PG8_WAIT_V(8); PG8_WAIT_L(0); PG8_BAR; PG8_MMA(1, 0, At, B0); PG8_MMA(1, 1, At, B1); PG8_BAR; PG8_SCHED;
            PG8_LDB(B0, 1, 0); PG8_LDB(B1, 1, 1); PG8_SCHED; PG8_LDA(At, 1, 0); PG8_STAGE(PG8_SA(0, 1), a2 + hstepA, w1);
            PG8_WAIT_V(8); PG8_WAIT_L(0); PG8_BAR; PG8_MMA(0, 0, At, B0); PG8_MMA(0, 1, At, B1); PG8_BAR; PG8_SCHED;
            PG8_LDA(At, 1, 1); PG8_STAGE(PG8_SB(1, 0), b3, voffB); PG8_STAGE(PG8_SB(1, 1), b3 + hstepB, voffB); PG8_STAGE(PG8_SA(1, 0), a3, w0);
            PG8_WAIT_V(8); PG8_WAIT_L(0); PG8_BAR; PG8_MMA(1, 0, At, B0); PG8_MMA(1, 1, At, B1); PG8_BAR; PG8_SCHED;
        }
        if (wr == 0) PG8_BAR;
        if constexpr (Epi::HOOKS) E.fin(acc, cur, ui, wr, wc, fr, fq); else E(acc, cur, wr, wc, fr, fq);
        if (!has_next) break;
#pragma unroll
        for (int a = 0; a < 2; ++a)
#pragma unroll
            for (int b = 0; b < 2; ++b)
#pragma unroll
                for (int m = 0; m < 4; ++m)
#pragma unroll
                    for (int n = 0; n < 2; ++n) acc[a][b][m][n] = (f32x4){0.f, 0.f, 0.f, 0.f};
        cur = nxt; cA = nA; cB = nB; ++ui;
        if (GATHER) { vc0[0] = vn0[0]; vc0[1] = vn0[1]; vc1[0] = vn1[0]; vc1[1] = vn1[1]; }
        if (wr == 1) PG8_BAR;
    }
    PG8_WAIT_V(0);
    PG8_BAR;
#undef PG8_GOFF
#undef PG8_SA
#undef PG8_SB
#undef PG8_STAGE
#undef PG8_LDA
#undef PG8_LDB
#undef PG8_MMA
#undef PG8_WAIT_V
#undef PG8_WAIT_L
#undef PG8_BAR
#undef PG8_SCHED
}

struct DenseOrder {
    const char* A; const char* B; size_t a_tile, b_tile; int nM, nN, nwg, G, c;
    __device__ __forceinline__ bool next(int i, Unit& u) const {
        const long L = (long)i * G + c; if (L >= nwg) return false;
        int wgid = (int)L; { const int q = nwg / 8, r = nwg % 8, xcd = wgid % 8, off = wgid / 8; wgid = (xcd < r ? xcd * (q + 1) : r * (q + 1) + (xcd - r) * q) + off; }
        const int nig = 8 * nN, gid = wgid / nig, fm = gid * 8, gsz = (nM - fm) < 8 ? (nM - fm) : 8;
        u.pm = fm + ((wgid % nig) % gsz); u.pn = (wgid % nig) / gsz; u.aux = 0;
        u.a = A + (size_t)u.pm * a_tile; u.b = B + (size_t)u.pn * b_tile; return true;
    }
};
struct GroupOrder {
    const char* A; const char* B; size_t a_grp, b_grp, a_tile, b_tile; int nM, nN, nwg, G, c;
    __device__ __forceinline__ bool next(int i, Unit& u) const {
        const long L = (long)i * G + c; if (L >= nwg) return false;
        const int per = nM * nN, g = (int)L / per, r = (int)L % per;
        u.pn = r / nM; u.pm = r % nM; u.aux = g;
        u.a = A + (size_t)g * a_grp + (size_t)u.pm * a_tile; u.b = B + (size_t)g * b_grp + (size_t)u.pn * b_tile; return true;
    }
};
struct MoeOrder {
    const char* A; const char* B; size_t a_tile, b_exp, b_tile; const LAS unsigned char* t2e; int ntiles, G, c;
    __device__ __forceinline__ bool next(int i, Unit& u) const {
        const long L = (long)i * G + c; if (L >= (long)ntiles * 4) return false;
        u.pm = (int)(L >> 2); u.pn = (int)(L & 3); u.aux = t2e[u.pm];
        u.a = A + (size_t)u.pm * a_tile; u.b = B + (size_t)u.aux * b_exp + (size_t)u.pn * b_tile; return true;
    }
};

typedef f32x4 Acc[2][2][4][2];
struct EpiProj {
    static constexpr bool HOOKS = false, PERM = true;
    bf16* U2; bf16* QKV; const float* gq; const float* gk;
    __device__ __forceinline__ void operator()(const Acc& acc, const Unit& u, int wr, int wc, int fr, int fq) const {
        const int typ = u.pn >> 1, sub = u.pn & 1;
        const bool nrm = (typ == 1 || typ == 2);
        const float* gg = (typ == 1) ? gq : gk; const float sc = (typ == 1) ? C2 : 1.f;
        f32x4 gn[2][2];
#pragma unroll
        for (int bj = 0; bj < 2; ++bj)
#pragma unroll
            for (int n = 0; n < 2; ++n) gn[bj][n] = *(const f32x4*)(gg + 32 * bj + 8 * fq + 4 * n) * sc;
#pragma unroll
        for (int ai = 0; ai < 2; ++ai)
#pragma unroll
            for (int m = 0; m < 4; ++m) {
                const int r = u.pm * BM + ai * HALF + wr * 64 + m * 16 + fr;
                f32x4 v[2][2];
#pragma unroll
                for (int bj = 0; bj < 2; ++bj)
#pragma unroll
                    for (int n = 0; n < 2; ++n) v[bj][n] = acc[ai][bj][m][n];
                {
                    float s = 0.f;
#pragma unroll
                    for (int bj = 0; bj < 2; ++bj)
#pragma unroll
                        for (int n = 0; n < 2; ++n) s += (v[bj][n].x * v[bj][n].x + v[bj][n].y * v[bj][n].y) + (v[bj][n].z * v[bj][n].z + v[bj][n].w * v[bj][n].w);
                    s += __shfl_xor(s, 16); s += __shfl_xor(s, 32);
                    const float rstd = 1.f / sqrtf(s * (1.f / 64.f) + EPS);
#pragma unroll
                    for (int bj = 0; bj < 2; ++bj)
#pragma unroll
                        for (int n = 0; n < 2; ++n) { const f32x4 mul = nrm ? gn[bj][n] * rstd : (f32x4){1.f, 1.f, 1.f, 1.f}; v[bj][n] = v[bj][n] * mul; }
                }
#pragma unroll
                for (int bj = 0; bj < 2; ++bj) {
                    u32x4 w; w.x = cvtpk(v[bj][0].x, v[bj][0].y); w.y = cvtpk(v[bj][0].z, v[bj][0].w); w.z = cvtpk(v[bj][1].x, v[bj][1].y); w.w = cvtpk(v[bj][1].z, v[bj][1].w);
                    const int f = sub * 256 + 64 * wc + 32 * bj + 8 * fq;
                    if (typ == 0) { const int g = f >> 4, h = f & 15; *(u32x4*)(U2 + ((size_t)g * NCH + (r >> 5)) * U2P + (r & 31) * 16 + h) = w; }
                    else { *(u32x4*)(QKV + (size_t)(typ - 1) * ((size_t)M * 512) + (size_t)r * 512 + f) = w; }
                }
            }
    }
};
struct EpiState {
    static constexpr bool HOOKS = false, PERM = false;
    float* SST;
    __device__ __forceinline__ void operator()(const Acc& acc, const Unit& u, int wr, int wc, int fr, int fq) const {
#pragma unroll
        for (int ai = 0; ai < 2; ++ai)
#pragma unroll
            for (int m = 0; m < 4; ++m) { const int r = u.pm * BM + ai * HALF + wr * 64 + m * 16 + fr;
#pragma unroll
                for (int n = 0; n < 2; ++n) *(f32x4*)(SST + ((size_t)u.aux * NCH + r) * 128 + 32 * wc + 16 * n + 4 * fq) = acc[ai][0][m][n]; }
    }
};
struct EpiS5 {
    static constexpr bool HOOKS = false, PERM = true;
    bf16* Z;
    __device__ __forceinline__ void operator()(const Acc& acc, const Unit& u, int wr, int wc, int fr, int fq) const {
#pragma unroll
        for (int ai = 0; ai < 2; ++ai)
#pragma unroll
            for (int m = 0; m < 4; ++m) { const int r = u.pm * BM + ai * HALF + wr * 64 + m * 16 + fr;
#pragma unroll
                for (int bj = 0; bj < 2; ++bj) { const int c0 = u.pn * BM + bj * HALF + 32 * wc + 8 * fq, i = c0 >> 4, h = c0 & 15;
                    const f32x4 a = acc[ai][bj][m][0], b = acc[ai][bj][m][1];
                    u32x4 w; w.x = cvtpk(gelu_tanh(a.x), gelu_tanh(a.y)); w.y = cvtpk(gelu_tanh(a.z), gelu_tanh(a.w)); w.z = cvtpk(gelu_tanh(b.x), gelu_tanh(b.y)); w.w = cvtpk(gelu_tanh(b.z), gelu_tanh(b.w));
                    *(u32x4*)(Z + ((size_t)r * 32 + i) * DSSM + u.aux * 16 + h) = w; } }
    }
};
struct EpiGlu {
    static constexpr bool HOOKS = false, PERM = true;
    const bf16* Z; const float* bias; bf16* MIX; float* SSQ;
    __device__ __forceinline__ void operator()(const Acc& acc, const Unit& u, int wr, int wc, int fr, int fq) const {
        float ss[2][4];
#pragma unroll
        for (int ai = 0; ai < 2; ++ai)
#pragma unroll
            for (int m = 0; m < 4; ++m) ss[ai][m] = 0.f;
#pragma unroll
        for (int bj = 0; bj < 2; ++bj) { const int c0 = u.pn * BM + bj * HALF + 32 * wc + 8 * fq;
            const f32x4 b0 = *(const f32x4*)(bias + c0), b1 = *(const f32x4*)(bias + c0 + 4);
#pragma unroll
            for (int ai = 0; ai < 2; ++ai)
#pragma unroll
                for (int m = 0; m < 4; ++m) { const size_t row = (size_t)(u.pm * BM + ai * HALF + wr * 64 + m * 16 + fr);
                    const u32x4 zz = *(const u32x4*)(Z + row * DSSM + c0);
                    const f32x4 a = acc[ai][bj][m][0] + b0, b = acc[ai][bj][m][1] + b1;
                    float y[8];
                    y[0] = bf2f(zz.x & 0xffff) * sigmoidf_(a.x); y[1] = bf2f(zz.x >> 16) * sigmoidf_(a.y); y[2] = bf2f(zz.y & 0xffff) * sigmoidf_(a.z); y[3] = bf2f(zz.y >> 16) * sigmoidf_(a.w);
                    y[4] = bf2f(zz.z & 0xffff) * sigmoidf_(b.x); y[5] = bf2f(zz.z >> 16) * sigmoidf_(b.y); y[6] = bf2f(zz.w & 0xffff) * sigmoidf_(b.z); y[7] = bf2f(zz.w >> 16) * sigmoidf_(b.w);
                    ss[ai][m] += ((y[0] * y[0] + y[1] * y[1]) + (y[2] * y[2] + y[3] * y[3])) + ((y[4] * y[4] + y[5] * y[5]) + (y[6] * y[6] + y[7] * y[7]));
                    u32x4 w; w.x = cvtpk(y[0], y[1]); w.y = cvtpk(y[2], y[3]); w.z = cvtpk(y[4], y[5]); w.w = cvtpk(y[6], y[7]);
                    *(u32x4*)(MIX + row * DM + c0) = w; } }
#pragma unroll
        for (int ai = 0; ai < 2; ++ai)
#pragma unroll
            for (int m = 0; m < 4; ++m) { float v = ss[ai][m]; v += __shfl_xor(v, 16); v += __shfl_xor(v, 32);
                if (fq == 0) atomicAdd(SSQ + (u.pm * BM + ai * HALF + wr * 64 + m * 16 + fr), v); }
    }
};
struct EpiX1B {
    static constexpr bool HOOKS = true, PERM = true;
    const float* X; bf16* X1B; const float* SSQS; const float* SSQA; LAS float* RSC;
    __device__ __forceinline__ void begin(const Unit& u, int ui, int tid) const {
        if (tid < 256) { const int row = u.pm * BM + tid; const float rs = 1.f / sqrtf(SSQS[row] * (1.f / 512.f) + EPS), ra = 1.f / sqrtf(SSQA[row] * (1.f / 512.f) + EPS);
            LAS float* d = RSC + ((ui & 1) * 256 + tid) * 2; d[0] = rs / ra; d[1] = ra; }
    }
    __device__ __forceinline__ void mid(Acc& acc, int ui, int wr, int fr) const {
#pragma unroll
        for (int ai = 0; ai < 2; ++ai)
#pragma unroll
            for (int m = 0; m < 4; ++m) { const float f = RSC[((ui & 1) * 256 + ai * HALF + wr * 64 + m * 16 + fr) * 2];
#pragma unroll
                for (int bj = 0; bj < 2; ++bj)
#pragma unroll
                    for (int n = 0; n < 2; ++n) acc[ai][bj][m][n] = acc[ai][bj][m][n] * f; }
    }
    __device__ __forceinline__ void fin(const Acc& acc, const Unit& u, int ui, int wr, int wc, int fr, int fq) const {
#pragma unroll
        for (int ai = 0; ai < 2; ++ai)
#pragma unroll
            for (int m = 0; m < 4; ++m) { const int rl = ai * HALF + wr * 64 + m * 16 + fr; const float ra = RSC[((ui & 1) * 256 + rl) * 2 + 1];
                const size_t ro = (size_t)(u.pm * BM + rl) * DM + u.pn * BM + 32 * wc + 8 * fq;
#pragma unroll
                for (int bj = 0; bj < 2; ++bj) { const size_t o = ro + bj * HALF;
                    const f32x4 a = *(const f32x4*)(X + o) + acc[ai][bj][m][0] * ra, b = *(const f32x4*)(X + o + 4) + acc[ai][bj][m][1] * ra;
                    u32x4 w; w.x = cvtpk(a.x, a.y); w.y = cvtpk(a.z, a.w); w.z = cvtpk(b.x, b.y); w.w = cvtpk(b.z, b.w);
                    *(u32x4*)(X1B + o) = w; } }
    }
};
struct EpiGU {
    static constexpr bool HOOKS = false, PERM = true;
    bf16* HH; const float* ROWSC;
    __device__ __forceinline__ void operator()(const Acc& acc, const Unit& u, int wr, int wc, int fr, int fq) const {
#pragma unroll
        for (int ai = 0; ai < 2; ++ai)
#pragma unroll
            for (int m = 0; m < 4; ++m) { const int rr = u.pm * BM + ai * HALF + wr * 64 + m * 16 + fr; const size_t off = (size_t)rr * DE + u.pn * 128 + 32 * wc + 8 * fq;
                const float sc = ROWSC[rr];
                float hv[8];
#pragma unroll
                for (int n = 0; n < 2; ++n) { const f32x4 gt = acc[ai][0][m][n] * sc, up = acc[ai][1][m][n] * sc;
                    hv[4 * n] = gt.x * sigmoidf_(gt.x) * up.x; hv[4 * n + 1] = gt.y * sigmoidf_(gt.y) * up.y; hv[4 * n + 2] = gt.z * sigmoidf_(gt.z) * up.z; hv[4 * n + 3] = gt.w * sigmoidf_(gt.w) * up.w; }
                u32x4 w; w.x = cvtpk(hv[0], hv[1]); w.y = cvtpk(hv[2], hv[3]); w.z = cvtpk(hv[4], hv[5]); w.w = cvtpk(hv[6], hv[7]);
                *(u32x4*)(HH + off) = w; }
    }
};
struct EpiDown {
    static constexpr bool HOOKS = false, PERM = true;
    bf16* YE; const float* ROWG;
    __device__ __forceinline__ void operator()(const Acc& acc, const Unit& u, int wr, int wc, int fr, int fq) const {
#pragma unroll
        for (int ai = 0; ai < 2; ++ai)
#pragma unroll
            for (int m = 0; m < 4; ++m) { const int rr = u.pm * BM + ai * HALF + wr * 64 + m * 16 + fr; const size_t ro = (size_t)rr * DM + u.pn * BM + 32 * wc + 8 * fq; const float gw_ = ROWG[rr];
#pragma unroll
                for (int bj = 0; bj < 2; ++bj) { const f32x4 a = acc[ai][bj][m][0] * gw_, b = acc[ai][bj][m][1] * gw_;
                    u32x4 w; w.x = cvtpk(a.x, a.y); w.y = cvtpk(a.z, a.w); w.z = cvtpk(b.x, b.y); w.w = cvtpk(b.z, b.w);
                    *(u32x4*)(YE + ro + bj * HALF) = w; } }
    }
};

struct Args { const float* in[26]; float* out; unsigned char* ws; int ph_lo, ph_hi; };
struct Frame { LAS unsigned char* lds; volatile LAS unsigned* MISC; unsigned* ctl; int tid, lane, wave, G, c; };

struct TItem { const float* W; int ldw, srccol0; const float* kscale; bf16* WT; int ldt, dstrow0, k0; };
__device__ __forceinline__ void titem_load(const TItem& t, int lane, f32x4 (&v)[8]) {
#pragma unroll
    for (int i = 0; i < 8; ++i) { const int kk = 8 * i + (lane >> 3); v[i] = *(const f32x4*)(t.W + (size_t)(t.k0 + kk) * t.ldw + t.srccol0 + (lane & 7) * 4); }
}
__device__ __forceinline__ void titem_store(const TItem& t, int lane, const f32x4 (&v)[8], LAS float* scr) {
#pragma unroll
    for (int i = 0; i < 8; ++i) { const int kk = 8 * i + (lane >> 3); const float sc = t.kscale ? t.kscale[t.k0 + kk] : 1.f; LAS float* d = scr + kk * 33 + (lane & 7) * 4;
        d[0] = v[i].x * sc; d[1] = v[i].y * sc; d[2] = v[i].z * sc; d[3] = v[i].w * sc; }
    asm volatile("s_waitcnt lgkmcnt(0)" ::: "memory");
    const int c = lane & 7;
#pragma unroll
    for (int j = 0; j < 4; ++j) { const int n = (lane >> 3) + 8 * j; const LAS float* s = scr + (8 * c) * 33 + n;
        u32x4 o; o.x = pk2(s[0 * 33], s[1 * 33]); o.y = pk2(s[2 * 33], s[3 * 33]); o.z = pk2(s[4 * 33], s[5 * 33]); o.w = pk2(s[6 * 33], s[7 * 33]);
        *(u32x4*)(t.WT + (size_t)(t.dstrow0 + n) * t.ldt + t.k0 + 8 * c) = o; }
    asm volatile("s_waitcnt lgkmcnt(0)" ::: "memory");
}
__device__ __forceinline__ void s5_tables_item(Frame& F, const Args& a, int g, int part) {
    const float* lre = a.in[3]; const float* lim = a.in[4]; const float* ldt = a.in[5]; const float* bre = a.in[6]; const float* bim = a.in[7];
    const float* cre = a.in[8]; const float* cim = a.in[9]; const float* dsk = a.in[10];
    LAS float* PWr = (LAS float*)F.lds; LAS float* PWi = PWr + 33 * 64; LAS float* BBr = PWi + 33 * 64; LAS float* BBi = BBr + 1024; LAS float* CCr = BBi + 1024; LAS float* CCi = CCr + 1024; LAS float* CF = CCi + 1024;
    const int tid = F.tid;
    if (tid < 64) { const int p = tid;
        const double dt = exp((double)ldt[g]), lr = lre[g * PST + p], li = lim[g * PST + p];
        double sn, cs; sincos_d(li * dt, sn, cs); const double mag = exp(lr * dt);
        const double ar = mag * cs, ai = mag * sn, den = lr * lr + li * li, nr = ar - 1.0, ni = ai;
        CF[2 * p] = (float)((nr * lr + ni * li) / den); CF[2 * p + 1] = (float)((ni * lr - nr * li) / den);
        double pr = 1.0, pi = 0.0;
        for (int l = 0; l <= 32; ++l) { PWr[l * 64 + p] = (float)pr; PWi[l * 64 + p] = (float)pi; const double t = pr * ar - pi * ai; pi = pr * ai + pi * ar; pr = t; }
    }
    __syncthreads();
    for (int idx = tid; idx < 1024; idx += NTHR) { const int p = idx >> 4; const float cfr = CF[2 * p], cfi = CF[2 * p + 1], br = bre[(size_t)g * 1024 + idx], bi = bim[(size_t)g * 1024 + idx];
        BBr[idx] = cfr * br - cfi * bi; BBi[idx] = cfr * bi + cfi * br; CCr[idx] = cre[(size_t)g * 1024 + idx]; CCi[idx] = cim[(size_t)g * 1024 + idx]; }
    __syncthreads();
    bf16* TBg = (bf16*)(a.ws + FW_TB) + (size_t)g * 512 * U2P; bf16* W1g = (bf16*)(a.ws + FW_W1) + (size_t)g * 256 * 512;
    for (int l = part; l < 32; l += 8) {
        if (tid < 256) { const int h = tid >> 4, hp = tid & 15; float k = 0.f;
            for (int p = 0; p < 64; ++p) { const float wr_ = PWr[l * 64 + p], wi_ = PWi[l * 64 + p], br = BBr[p * 16 + hp], bi = BBi[p * 16 + hp];
                k += CCr[h * 64 + p] * (wr_ * br - wi_ * bi) - CCi[h * 64 + p] * (wr_ * bi + wi_ * br); }
            if (l == 0 && h == hp) k += dsk[g * 16 + h];
            const bf16 v = (bf16)f2bf(k);
            for (int i = l; i < 32; ++i) TBg[(size_t)(i * 16 + h) * U2P + (i - l) * 16 + hp] = v;
            if (l >= 1) for (int i = 0; i < 32 - l; ++i) TBg[(size_t)(i * 16 + h) * U2P + (i + l) * 16 + hp] = 0;
        } else { const int t2 = tid - 256;
#pragma unroll
            for (int x = 0; x < 8; ++x) { const int e = t2 * 8 + x;
                { const int h = e >> 7, q = e & 127, p = q & 63; const float cr = CCr[h * 64 + p], ci = CCi[h * 64 + p], wr_ = PWr[(l + 1) * 64 + p], wi_ = PWi[(l + 1) * 64 + p];
                  const float re = cr * wr_ - ci * wi_, im = cr * wi_ + ci * wr_; TBg[(size_t)(l * 16 + h) * U2P + 512 + q] = (bf16)f2bf(q < 64 ? re : -im); }
                { const int rho = e >> 4, hp = e & 15, p = rho & 63; const float wr_ = PWr[(31 - l) * 64 + p], wi_ = PWi[(31 - l) * 64 + p], br = BBr[p * 16 + hp], bi = BBi[p * 16 + hp];
                  const float re = wr_ * br - wi_ * bi, im = wr_ * bi + wi_ * br; W1g[(size_t)rho * 512 + l * 16 + hp] = (bf16)f2bf(rho < 64 ? re : im); W1g[(size_t)(128 + rho) * 512 + l * 16 + hp] = 0; }
            }
        }
    }
    __syncthreads();
}
__device__ __forceinline__ void p0_prologue(Frame& F, const Args& a) {
    const float* x = a.in[0];
    for (int it = F.c; it < 256; it += F.G) s5_tables_item(F, a, it >> 3, it & 7);
    LAS float* scr = (LAS float*)(F.lds + F.wave * 16384);
    const int gw = F.c * NWAVES + F.wave, NGW = F.G * NWAVES;
    constexpr int I_IN = 16 * 64, I_GLU = 8 * 16, I_OUT = 16 * 32, I_GU = 32 * 16 * 32, I_D = 32 * 8 * 32, NITEMS = I_IN + I_GLU + I_OUT + I_GU + I_D;
    bf16* WIN = (bf16*)(a.ws + FW_WIN); bf16* WGLU = (bf16*)(a.ws + FW_WGLU); bf16* WOUT = (bf16*)(a.ws + FW_WOUT); bf16* WGU = (bf16*)(a.ws + FW_WGU); bf16* WD = (bf16*)(a.ws + FW_WD);
    auto mkitem = [&](int it) -> TItem {
        int r = it;
        if (r < I_IN) { const int kb = r >> 6, d = r & 63, pn = d >> 3, beta = d & 7, bj = beta >> 2, wc = beta & 3;
            return TItem{a.in[2], DIN, 256 * pn + 32 * (2 * wc + bj), a.in[1], WIN, DM, 32 * d, 64 * kb}; } r -= I_IN;
        if (r < I_GLU) { const int kb = r >> 4, d = r & 15; return TItem{a.in[11], DSSM, 32 * d, nullptr, WGLU, DSSM, 32 * d, 64 * kb}; } r -= I_GLU;
        if (r < I_OUT) { const int kb = r >> 5, d = r & 31; const float* ks = (kb < 8) ? a.in[15] : (a.in[16] - 512);
            return TItem{a.in[17], DM, 32 * d, ks, WOUT, DM, 32 * d, 64 * kb}; } r -= I_OUT;
        if (r < I_GU) { const int e = r >> 9, q = r & 511, kb = q >> 5, d = q & 31, pn = d >> 3, beta = d & 7;
            const float* W = (beta < 4 ? a.in[23] : a.in[24]) + (size_t)e * DM * DE;
            return TItem{W, DE, 128 * pn + 32 * (beta & 3), a.in[18], WGU + (size_t)e * DM * DM, DM, 32 * d, 64 * kb}; } r -= I_GU;
        const int e = r >> 8, q = r & 255, kb = q >> 5, d = q & 31;
        return TItem{a.in[25] + (size_t)e * DE * DM, DM, 32 * d, nullptr, WD + (size_t)e * DM * DE, DE, 32 * d, 64 * kb};
    };
    if (gw < NITEMS) {
        TItem cur = mkitem(gw); f32x4 vc[8]; titem_load(cur, F.lane, vc);
        for (int it = gw; it < NITEMS; it += NGW) {
            const bool more = it + NGW < NITEMS; TItem nxt = cur; f32x4 vn[8];
            if (more) { nxt = mkitem(it + NGW); titem_load(nxt, F.lane, vn); }
            titem_store(cur, F.lane, vc, scr);
            if (more) { cur = nxt;
#pragma unroll
                for (int i = 0; i < 8; ++i) vc[i] = vn[i]; }
        }
    }
    { bf16* WR = (bf16*)(a.ws + FW_WR);
      for (int idx = F.c * NTHR + F.tid; idx < 64 * DM; idx += F.G * NTHR) { const int n = idx >> 10, k = idx & 1023;
          float v = 0.f; if (n < 4) v = a.in[19][k * 4 + n]; else if (n < 36) v = a.in[21][k * 32 + (n - 4)];
          WR[idx] = (bf16)f2bf(v * a.in[18][k]); } }
    { unsigned* RW = (unsigned*)(a.ws + FW_ROW); for (int idx = F.c * NTHR + F.tid; idx < 3 * MAXROWS; idx += F.G * NTHR) RW[idx] = 0u; }
    bf16* XN = (bf16*)(a.ws + FW_XN);
    for (int m0 = gw * 4; m0 < M; m0 += NGW * 4) {
        f32x4 v[4][4];
#pragma unroll
        for (int rr = 0; rr < 4; ++rr)
#pragma unroll
            for (int j = 0; j < 4; ++j) v[rr][j] = ((const f32x4*)(x + (size_t)(m0 + rr) * DM))[64 * j + F.lane];
#pragma unroll
        for (int rr = 0; rr < 4; ++rr) { float s = 0.f;
#pragma unroll
            for (int j = 0; j < 4; ++j) s += v[rr][j].x * v[rr][j].x + v[rr][j].y * v[rr][j].y + v[rr][j].z * v[rr][j].z + v[rr][j].w * v[rr][j].w;
            const float rstd = 1.f / sqrtf(wave_sum(s) * (1.f / DM) + EPS);
            u32x2* o = (u32x2*)(XN + (size_t)(m0 + rr) * DM) + F.lane;
#pragma unroll
            for (int j = 0; j < 4; ++j) { u32x2 w; w.x = cvtpk(v[rr][j].x * rstd, v[rr][j].y * rstd); w.y = cvtpk(v[rr][j].z * rstd, v[rr][j].w * rstd); o[64 * j] = w; } }
    }
}

__device__ __forceinline__ void s5_scan(Frame& F, const Args& a) {
    const float* SST = (const float*)(a.ws + FW_SST); bf16* U2 = (bf16*)(a.ws + FW_U2);
    for (int idx = F.c * NTHR + F.tid; idx < BATCH * NG * PST; idx += F.G * NTHR) {
        const int p = idx & 63, g = (idx >> 6) & 31, b = idx >> 11;
        const double dt = exp((double)a.in[5][g]), lr = a.in[3][g * PST + p], li = a.in[4][g * PST + p];
        double sn, cs; sincos_d(32.0 * li * dt, sn, cs); const double mag = exp(32.0 * lr * dt);
        const float ar = (float)(mag * cs), ai = (float)(mag * sn);
        float xr = 0.f, xi = 0.f;
        const size_t row0 = (size_t)g * NCH + (size_t)b * 64;
        for (int c0 = 0; c0 < 64; c0 += 16) {
            float sr[16], si[16];
#pragma unroll
            for (int j = 0; j < 16; ++j) { sr[j] = SST[(row0 + c0 + j) * 128 + p]; si[j] = SST[(row0 + c0 + j) * 128 + 64 + p]; }
#pragma unroll
            for (int j = 0; j < 16; ++j) { bf16* up = U2 + (row0 + c0 + j) * U2P + 512; up[p] = (bf16)f2bf(xr); up[64 + p] = (bf16)f2bf(xi);
                const float t = ar * xr - ai * xi + sr[j]; xi = ar * xi + ai * xr + si[j]; xr = t; }
        }
    }
}

constexpr float ATT_THR = -100.f;
__device__ __forceinline__ s16x4 vtr(const LAS unsigned char* p) { typedef short v4i16_t __attribute__((ext_vector_type(4))); return __builtin_bit_cast(s16x4, __builtin_amdgcn_ds_read_tr16_b64_v4i16((LAS v4i16_t*)p)); }
__device__ __forceinline__ int crow(int r, int hi) { return (r & 3) + 8 * (r >> 2) + 4 * hi; }
#define MFMA32(a, b, c) __builtin_amdgcn_mfma_f32_32x32x16_bf16((a), (b), (c), 0, 0, 0)
template <bool DIAG, int P, int KH, int KD, int VD>
__device__ __forceinline__ float attn_half(const LAS unsigned char* Kb, const LAS unsigned char* Vb, const bf16x8 (&qr)[4], const bf16x8 (&tri)[2], f32x16 (&o)[2], float base, int lim, int lane) {
    const int r32 = lane & 31, hi = lane >> 5;
    const LAS unsigned char* kp = Kb + hi * KH + r32 * 16 + P * 512;
    const int lim2 = lim - 4 * hi;
    f32x16 z = {};
#pragma unroll
    for (int d0 = 0; d0 < 4; ++d0) { const bf16x8 kf = *(const LAS bf16x8*)(kp + d0 * KD); z = MFMA32(kf, qr[d0], z); }
    float l[16];
#pragma unroll
    for (int r = 0; r < 16; ++r) { l[r] = -__builtin_amdgcn_logf(1.f + __builtin_amdgcn_exp2f(z[r])); if (DIAG) { if (!((r & 3) + 8 * (r >> 2) + 32 * P < lim2)) l[r] = 0.f; } }
    const bf16x8 ones = {(short)0x3F80, (short)0x3F80, (short)0x3F80, (short)0x3F80, (short)0x3F80, (short)0x3F80, (short)0x3F80, (short)0x3F80};
    u32x4 wa, wb;
    wa.x = cvtpk(l[0], l[1]); wa.y = cvtpk(l[2], l[3]); wa.z = cvtpk(l[4], l[5]); wa.w = cvtpk(l[6], l[7]);
    wb.x = cvtpk(l[8], l[9]); wb.y = cvtpk(l[10], l[11]); wb.z = cvtpk(l[12], l[13]); wb.w = cvtpk(l[14], l[15]);
    const bf16x8 La = __builtin_bit_cast(bf16x8, wa), Lb = __builtin_bit_cast(bf16x8, wb);
    f32x16 T = {}, TT = {};
    T = MFMA32(tri[0], La, T); T = MFMA32(tri[1], Lb, T);
    TT = MFMA32(ones, La, TT); TT = MFMA32(ones, Lb, TT);
    float av[16];
#pragma unroll
    for (int r = 0; r < 16; ++r) { av[r] = __builtin_amdgcn_exp2f((z[r] + base) + T[r]); if (DIAG) { if (!((r & 3) + 8 * (r >> 2) + 32 * P < lim2)) av[r] = 0.f; } }
    wa.x = cvtpk(av[0], av[1]); wa.y = cvtpk(av[2], av[3]); wa.z = cvtpk(av[4], av[5]); wa.w = cvtpk(av[6], av[7]);
    wb.x = cvtpk(av[8], av[9]); wb.y = cvtpk(av[10], av[11]); wb.z = cvtpk(av[12], av[13]); wb.w = cvtpk(av[14], av[15]);
    const bf16x8 Pa = __builtin_bit_cast(bf16x8, wa), Pb = __builtin_bit_cast(bf16x8, wb);
    const LAS unsigned char* vp = Vb + ((lane >> 4) & 1) * 32 + (lane & 3) * 8 + (4 * hi + ((lane & 15) >> 2)) * 64 + P * 2048;
#pragma unroll
    for (int d0 = 0; d0 < 2; ++d0) {
        const s16x4 lo0 = vtr(vp + d0 * VD), hi0 = vtr(vp + d0 * VD + 512), lo1 = vtr(vp + d0 * VD + 1024), hi1 = vtr(vp + d0 * VD + 1536);
        const bf16x8 v0 = {lo0[0], lo0[1], lo0[2], lo0[3], hi0[0], hi0[1], hi0[2], hi0[3]}, v1 = {lo1[0], lo1[1], lo1[2], lo1[3], hi1[0], hi1[1], hi1[2], hi1[3]};
        o[d0] = MFMA32(Pa, v0, o[d0]); o[d0] = MFMA32(Pb, v1, o[d0]);
    }
    return TT[0];
}
constexpr int ASPAN = 13;
__device__ __forceinline__ void attn_span_phase(Frame& F, const bf16* Q, const bf16* Kg, const bf16* Vg, bf16* MIX, float* SSQA) {
    const int lane = F.lane, wid = F.wave, r32 = lane & 31, hi = lane >> 5;
    volatile LAS int* FLG = (volatile LAS int*)(F.lds + ASPAN * 8192 + 8 * 4096);
    bf16x8 tri[2];
#pragma unroll
    for (int s = 0; s < 2; ++s)
#pragma unroll
        for (int j = 0; j < 8; ++j) tri[s][j] = ((16 * s + 8 * (j >> 2) + 4 * hi + (j & 3)) >= r32) ? (short)0x3F80 : (short)0;
    for (int L = F.c; L < BATCH * NH * 8; L += F.G) {
        const int bh = L >> 3, qb = L & 7, b = bh >> 3, h = bh & 7, a0 = 8 * qb, a = a0 + wid;
        const size_t row0 = (size_t)b * SEQ; const int qg = 32 * a + r32;
        bf16x8 qr[4];
#pragma unroll
        for (int d0 = 0; d0 < 4; ++d0) qr[d0] = *(const bf16x8*)(Q + (row0 + qg) * DATT + h * HD + d0 * 16 + hi * 8);
        const bf16* src = (wid < 4) ? (Kg + (row0 + (lane & 31)) * DATT + h * HD + (lane >> 5) * 8 + 16 * wid)
                                    : (Vg + (row0 + 16 * (wid & 1) + (lane >> 2)) * DATT + h * HD + (lane & 3) * 8 + 32 * ((wid - 4) >> 1));
        const int dsto = (wid < 4) ? wid * 1024 : 4096 + (wid - 4) * 1024;
        f32x16 o[2] = {}; float Rc = 0.f; bool done = false;
        for (int k = 0;; ++k) {
            const int top = a0 + 7 - ASPAN * k, bot = (top - (ASPAN - 1) > 0) ? top - (ASPAN - 1) : 0;
#pragma unroll 1
            for (int jj = top; jj >= bot; --jj)
                __builtin_amdgcn_global_load_lds((const unsigned*)(src + (size_t)(32 * jj) * DATT), (LAS unsigned*)(F.lds + (top - jj) * 8192 + dsto), 16, 0, 0);
            asm volatile("s_waitcnt vmcnt(0)" ::: "memory");
            __syncthreads();
            if (!done) {
                for (int jj = (a < top ? a : top); jj >= bot; --jj) {
                    const LAS unsigned char* Kb = F.lds + (top - jj) * 8192; const LAS unsigned char* Vb = Kb + 4096;
                    const int lim = qg - 32 * jj;
                    float sh;
                    if (jj == a) sh = attn_half<true, 0, 512, 1024, 2048>(Kb, Vb, qr, tri, o, Rc, lim, lane);
                    else sh = attn_half<false, 0, 512, 1024, 2048>(Kb, Vb, qr, tri, o, Rc, lim, lane);
                    Rc += sh;
                    if (jj == 0 || __all(Rc < ATT_THR)) { done = true; break; }
                }
            }
            if (lane == 0) FLG[wid] = done ? 1 : 0;
            asm volatile("s_waitcnt lgkmcnt(0)" ::: "memory");
            __syncthreads();
            if (bot == 0) break;
            int alld = 1;
#pragma unroll
            for (int w = 0; w < 8; ++w) alld &= FLG[w];
            if (alld) break;
        }
        { LAS unsigned char* stg = F.lds + ASPAN * 8192 + wid * 4096; LAS unsigned short* sp = (LAS unsigned short*)(stg + hi * 512 + r32 * 2);
#pragma unroll
          for (int r = 0; r < 16; ++r) { const int ro = ((r & 3) + 8 * (r >> 2)) * 64; sp[ro] = (unsigned short)f2bf(o[0][r]); sp[ro + 32] = (unsigned short)f2bf(o[1][r]); }
          asm volatile("s_waitcnt lgkmcnt(0)" ::: "memory");
          bf16* ow = MIX + (row0 + 32 * a) * DM + 512 + h * HD;
#pragma unroll
          for (int i = 0; i < 4; ++i) { const int row = i * 8 + (lane >> 3), ch = lane & 7; const u32x4 v = *(const LAS u32x4*)(stg + row * 128 + ch * 16); *(u32x4*)(ow + (size_t)row * DM + ch * 8) = v;
              const float f0 = bf2f(v.x & 0xffff), f1 = bf2f(v.x >> 16), f2 = bf2f(v.y & 0xffff), f3 = bf2f(v.y >> 16), f4 = bf2f(v.z & 0xffff), f5 = bf2f(v.z >> 16), f6 = bf2f(v.w & 0xffff), f7 = bf2f(v.w >> 16);
              float ss = ((f0 * f0 + f1 * f1) + (f2 * f2 + f3 * f3)) + ((f4 * f4 + f5 * f5) + (f6 * f6 + f7 * f7));
              ss += __shfl_xor(ss, 1); ss += __shfl_xor(ss, 2); ss += __shfl_xor(ss, 4);
              if (ch == 0) atomicAdd(SSQA + (row0 + 32 * a + row), ss); }
          asm volatile("s_waitcnt lgkmcnt(0)" ::: "memory"); }
    }
    asm volatile("s_waitcnt vmcnt(0)" ::: "memory");
    __syncthreads();
}
static_assert(ASPAN * 8192 + 8 * 4096 + 64 <= MISC_OFF, "attention LDS map");

__device__ __forceinline__ void mixnorm(Frame& F, const Args& a) {
    const bf16* YS = (const bf16*)(a.ws + FW_YS); const bf16* YA = (const bf16*)(a.ws + FW_YA); bf16* MIX = (bf16*)(a.ws + FW_MIX);
    const int gw = F.c * NWAVES + F.wave, NGW = F.G * NWAVES, lane = F.lane;
    for (int m = gw; m < M; m += NGW) {
#pragma unroll
        for (int half = 0; half < 2; ++half) {
            const u32x4 w = *(const u32x4*)((half ? YA : YS) + (size_t)m * 512 + lane * 8); float v[8];
            v[0] = bf2f(w.x & 0xffff); v[1] = bf2f(w.x >> 16); v[2] = bf2f(w.y & 0xffff); v[3] = bf2f(w.y >> 16); v[4] = bf2f(w.z & 0xffff); v[5] = bf2f(w.z >> 16); v[6] = bf2f(w.w & 0xffff); v[7] = bf2f(w.w >> 16);
            float s = 0.f;
#pragma unroll
            for (int i = 0; i < 8; ++i) s += v[i] * v[i];
            const float rstd = 1.f / sqrtf(wave_sum(s) * (1.f / 512.f) + EPS);
            u32x4 o; o.x = cvtpk(v[0] * rstd, v[1] * rstd); o.y = cvtpk(v[2] * rstd, v[3] * rstd); o.z = cvtpk(v[4] * rstd, v[5] * rstd); o.w = cvtpk(v[6] * rstd, v[7] * rstd);
            *(u32x4*)(MIX + (size_t)m * DM + half * 512 + lane * 8) = o;
        }
    }
}

constexpr int RT_PITCH = 2064;
__device__ __forceinline__ void router_phase(Frame& F, const Args& a) {
    const bf16* X1B = (const bf16*)(a.ws + FW_X1B); int* TOK = (int*)(a.ws + FW_TOK); const bf16* WR = (const bf16*)(a.ws + FW_WR);
    const float* brg = a.in[20]; const float* bre_ = a.in[22];
    const int tid = F.tid, lane = F.lane, wid = F.wave, r32 = lane & 31, hi = lane >> 5;
    LAS unsigned char* TILE = F.lds;
    LAS float* PART = (LAS float*)(F.lds + 66048);
    LAS float* LOGIT = (LAS float*)(F.lds + 66048 + 65536);
    LAS int* HIST = (LAS int*)(F.lds + 66048 + 65536 + 5120);
    LAS int* TREC = HIST + 64;
    LAS float* RS = (LAS float*)(TREC + 1024);
    static_assert(66048 + 65536 + 5120 + 256 + 4096 + 128 <= MISC_OFF, "router LDS");
    bf16x8 Bf[8][2];
#pragma unroll
    for (int s = 0; s < 8; ++s)
#pragma unroll
        for (int nb = 0; nb < 2; ++nb) Bf[s][nb] = *(const bf16x8*)(WR + (size_t)(32 * nb + r32) * DM + 128 * wid + 16 * s + 8 * hi);
    if (tid < 64) HIST[tid] = 0;
    __syncthreads();
    int ntl = 0;
    for (int tile = F.c; tile < M / 32; tile += F.G, ++ntl) {
        { u32x4 v[4][2];
#pragma unroll
          for (int rr = 0; rr < 4; ++rr) { const u32x4* xr = (const u32x4*)(X1B + (size_t)(tile * 32 + 4 * wid + rr) * DM); v[rr][0] = xr[lane]; v[rr][1] = xr[64 + lane]; }
#pragma unroll
          for (int rr = 0; rr < 4; ++rr) { const int lr = 4 * wid + rr; float s = 0.f;
#pragma unroll
              for (int j = 0; j < 2; ++j) { const u32x4 w = v[rr][j];
                  const float f0 = bf2f(w.x & 0xffff), f1 = bf2f(w.x >> 16), f2 = bf2f(w.y & 0xffff), f3 = bf2f(w.y >> 16), f4 = bf2f(w.z & 0xffff), f5 = bf2f(w.z >> 16), f6 = bf2f(w.w & 0xffff), f7 = bf2f(w.w >> 16);
                  s += (f0 * f0 + f1 * f1) + (f2 * f2 + f3 * f3) + (f4 * f4 + f5 * f5) + (f6 * f6 + f7 * f7);
                  *(LAS u32x4*)(TILE + lr * RT_PITCH + (64 * j + lane) * 16) = w; }
              const float rstd = 1.f / sqrtf(wave_sum(s) * (1.f / DM) + EPS);
              if (lane == 0) RS[lr] = rstd; } }
        __syncthreads();
        { f32x16 c0 = {}, c1 = {};
#pragma unroll
          for (int s = 0; s < 8; ++s) { const bf16x8 af = *(const LAS bf16x8*)(TILE + r32 * RT_PITCH + (128 * wid + 16 * s + 8 * hi) * 2);
              c0 = MFMA32(af, Bf[s][0], c0); c1 = MFMA32(af, Bf[s][1], c1); }
#pragma unroll
          for (int r = 0; r < 16; ++r) { const int t = crow(r, hi); PART[(wid * 32 + t) * 64 + r32] = c0[r]; PART[(wid * 32 + t) * 64 + 32 + r32] = c1[r]; } }
        __syncthreads();
        { const int t = tid >> 4, c4 = (tid & 15) * 4;
          if (c4 < 40) { f32x4 s = {0.f, 0.f, 0.f, 0.f};
#pragma unroll
              for (int w = 0; w < 8; ++w) s += *(const LAS f32x4*)(PART + (w * 32 + t) * 64 + c4);
              *(LAS f32x4*)(LOGIT + t * 40 + c4) = s * RS[t]; } }
        __syncthreads();
        if (tid < 32) { const int m = tile * 32 + tid; float lg[36];
#pragma unroll
            for (int c = 0; c < 36; ++c) lg[c] = LOGIT[tid * 40 + c] + (c < 4 ? brg[c] : bre_[c - 4]);
            int gi = 0; float gm = lg[0];
#pragma unroll
            for (int c = 1; c < 4; ++c) if (lg[c] > gm) { gm = lg[c]; gi = c; }
            float gsum = 0.f;
#pragma unroll
            for (int c = 0; c < 4; ++c) gsum += __expf(lg[c] - gm);
            const float pgrp = 1.f / gsum;
            float el[8];
#pragma unroll
            for (int e = 0; e < 8; ++e) { float t = 0.f;
#pragma unroll
                for (int g2 = 0; g2 < 4; ++g2) if (g2 == gi) t = lg[4 + g2 * 8 + e];
                el[e] = t; }
            int i0 = 0; float m0 = el[0];
#pragma unroll
            for (int e = 1; e < 8; ++e) if (el[e] > m0) { m0 = el[e]; i0 = e; }
            int i1 = 0; float m1 = -3.0e38f;
#pragma unroll
            for (int e = 0; e < 8; ++e) if (e != i0 && el[e] > m1) { m1 = el[e]; i1 = e; }
            const float e1 = __expf(m1 - m0), p0 = 1.f / (1.f + e1), p1 = e1 / (1.f + e1);
            const int ex0 = gi * 8 + i0, ex1 = gi * 8 + i1;
            const int rk0 = atomicAdd((int*)&HIST[ex0], 1), rk1 = atomicAdd((int*)&HIST[ex1], 1);
            int* tk = TOK + (size_t)m * 8; tk[0] = ex0; tk[1] = ex1; tk[2] = __float_as_int(pgrp * p0); tk[3] = __float_as_int(pgrp * p1); tk[6] = __float_as_int(RS[tid]);
            LAS int* tr = TREC + (ntl * 32 + tid) * 4; tr[0] = ex0; tr[1] = ex1; tr[2] = rk0; tr[3] = rk1;
        }
        __syncthreads();
    }
    if (tid < 32) { const int cnt = HIST[tid]; int base = 0; if (cnt > 0) base = (int)__hip_atomic_fetch_add(F.ctl + CW_CNT + tid, (unsigned)cnt, RLX_AGENT); HIST[32 + tid] = base; }
    __syncthreads();
    for (int i = tid; i < ntl * 32; i += NTHR) { const int tile = F.c + (i >> 5) * F.G, m = tile * 32 + (i & 31); const LAS int* tr = TREC + i * 4;
        int* tk = TOK + (size_t)m * 8; tk[4] = HIST[32 + tr[0]] + tr[2]; tk[5] = HIST[32 + tr[1]] + tr[3]; }
    __syncthreads();
}
__device__ __forceinline__ int moe_tables(Frame& F) {
    LAS int* TST = (LAS int*)(F.lds + SCR2_OFF); LAS unsigned char* T2E = F.lds + SCR2_OFF + 256;
    if (F.tid == 0) { int acc = 0;
        for (int e = 0; e < NE; ++e) { TST[e] = acc; const int cnt = (int)__hip_atomic_load(F.ctl + CW_CNT + e, RLX_AGENT); const int nt = (cnt + 255) >> 8;
            for (int t = 0; t < nt; ++t) T2E[acc + t] = (unsigned char)e; acc += nt; }
        TST[NE] = acc; }
    __syncthreads();
    return TST[NE];
}
__device__ __forceinline__ void scatter_phase(Frame& F, const Args& a) {
    const int* TOK = (const int*)(a.ws + FW_TOK); int* ROWTOK = (int*)(a.ws + FW_ROW); float* ROWSC = (float*)(a.ws + FW_ROW) + MAXROWS; float* ROWG = (float*)(a.ws + FW_ROW) + 2 * MAXROWS;
    const LAS int* TST = (const LAS int*)(F.lds + SCR2_OFF);
    for (int m = F.c * NTHR + F.tid; m < M; m += F.G * NTHR) {
        const u32x4 t0 = *(const u32x4*)(TOK + (size_t)m * 8), t1 = *(const u32x4*)(TOK + (size_t)m * 8 + 4);
        const int p0 = TST[t0.x] * 256 + (int)t1.x, p1 = TST[t0.y] * 256 + (int)t1.y; const float rs = __uint_as_float(t1.z);
        ROWTOK[p0] = m; ROWSC[p0] = rs; ROWG[p0] = __uint_as_float(t0.z);
        ROWTOK[p1] = m; ROWSC[p1] = rs; ROWG[p1] = __uint_as_float(t0.w);
    }
}
__device__ __forceinline__ void combine_phase(Frame& F, const Args& a) {
    const bf16* YE = (const bf16*)(a.ws + FW_YE); const bf16* X1B = (const bf16*)(a.ws + FW_X1B); const int* TOK = (const int*)(a.ws + FW_TOK); float* out = a.out;
    const LAS int* TST = (const LAS int*)(F.lds + SCR2_OFF);
    const int gw = F.c * NWAVES + F.wave, NGW = F.G * NWAVES, lane = F.lane;
    for (int m0 = gw * 2; m0 < M; m0 += NGW * 2) {
        u32x4 xv[2][2], y0[2][2], y1[2][2];
#pragma unroll
        for (int t = 0; t < 2; ++t) { const int m = m0 + t; const int* tk = TOK + (size_t)m * 8;
            const size_t p0 = (size_t)TST[tk[0]] * 256 + tk[4], p1 = (size_t)TST[tk[1]] * 256 + tk[5];
            const u32x4* xs = (const u32x4*)(X1B + (size_t)m * DM); const u32x4* a0 = (const u32x4*)(YE + p0 * DM); const u32x4* a1 = (const u32x4*)(YE + p1 * DM);
#pragma unroll
            for (int j = 0; j < 2; ++j) { xv[t][j] = xs[64 * j + lane]; y0[t][j] = a0[64 * j + lane]; y1[t][j] = a1[64 * j + lane]; } }
#pragma unroll
        for (int t = 0; t < 2; ++t) { f32x4* o = (f32x4*)(out + (size_t)(m0 + t) * DM);
#pragma unroll
            for (int j = 0; j < 2; ++j) { const u32x4 x = xv[t][j], p = y0[t][j], q = y1[t][j]; f32x4 r0, r1;
                r0.x = bf2f(x.x & 0xffff) + (bf2f(p.x & 0xffff) + bf2f(q.x & 0xffff)); r0.y = bf2f(x.x >> 16) + (bf2f(p.x >> 16) + bf2f(q.x >> 16));
                r0.z = bf2f(x.y & 0xffff) + (bf2f(p.y & 0xffff) + bf2f(q.y & 0xffff)); r0.w = bf2f(x.y >> 16) + (bf2f(p.y >> 16) + bf2f(q.y >> 16));
                r1.x = bf2f(x.z & 0xffff) + (bf2f(p.z & 0xffff) + bf2f(q.z & 0xffff)); r1.y = bf2f(x.z >> 16) + (bf2f(p.z >> 16) + bf2f(q.z >> 16));
                r1.z = bf2f(x.w & 0xffff) + (bf2f(p.w & 0xffff) + bf2f(q.w & 0xffff)); r1.w = bf2f(x.w >> 16) + (bf2f(p.w >> 16) + bf2f(q.w >> 16));
                o[2 * (64 * j + lane)] = r0; o[2 * (64 * j + lane) + 1] = r1; } }
    }
}

constexpr int NPHASE = 13;
__global__ void __launch_bounds__(NTHR, 2) mk_fwd(Args args) {
    extern __shared__ __attribute__((aligned(16))) unsigned char lds_raw[];
    Frame F;
    F.lds = (LAS unsigned char*)lds_raw; F.MISC = (volatile LAS unsigned*)(F.lds + MISC_OFF);
    F.tid = threadIdx.x; F.lane = F.tid & 63; F.wave = __builtin_amdgcn_readfirstlane(F.tid >> 6);
    F.G = gridDim.x; F.c = blockIdx.x; F.ctl = (unsigned*)(args.ws + WS_CTL);
    if (F.tid < 64) F.MISC[F.tid] = 0u;
    __syncthreads();
    XcdBarrier bar = xcd_barrier_post(F.ctl + CW_BAR, F.MISC + 8);
    const int lo = args.ph_lo, hi = args.ph_hi;
    unsigned char* ws = args.ws;
#ifndef PH_MASK
#define PH_MASK 0x1fff
#endif
#define IN(k) ((((PH_MASK) >> (k)) & 1) && lo <= (k) && (k) < hi)
#define SEAM(k) do { if (IN(k) && IN((k) + 1)) xcd_barrier(bar); } while (0)
#ifndef REP_MASK
#define REP_MASK 0
#endif
#define REPS(k) _Pragma("unroll") for (int rep_ = 0; rep_ < ((((REP_MASK) >> (k)) & 1) ? 2 : 1); ++rep_)
    if (IN(0)) REPS(0) { p0_prologue(F, args); } SEAM(0);
    if (IN(1)) REPS(1) {
        GemmP g{DM * 2, DM * 2, DM}; DenseOrder S{(const char*)(ws + FW_XN), (const char*)(ws + FW_WIN), (size_t)256 * DM * 2, (size_t)256 * DM * 2, M / 256, DIN / 256, (M / 256) * (DIN / 256), F.G, F.c};
        EpiProj E{(bf16*)(ws + FW_U2), (bf16*)(ws + FW_Q), args.in[13], args.in[14]};
        gemm_phase(F.lds, g, S, E); } SEAM(1);
    if (IN(2)) REPS(2) {
        GemmP g{U2P * 2, 512 * 2, 512}; GroupOrder S{(const char*)(ws + FW_U2), (const char*)(ws + FW_W1), (size_t)NCH * U2P * 2, (size_t)256 * 512 * 2, (size_t)256 * U2P * 2, 0, NCH / 256, 1, NG * (NCH / 256), F.G, F.c};
        EpiState E{(float*)(ws + FW_SST)};
        gemm_phase(F.lds, g, S, E); } SEAM(2);
    if (IN(3)) REPS(3) {
#ifndef NO_SCAN
        s5_scan(F, args);
#ifdef REP_SCAN
        s5_scan(F, args);
#endif
#endif
#ifndef NO_ATTN
        const bf16* Q = (const bf16*)(ws + FW_Q); const bf16* Kg = (const bf16*)(ws + FW_K); const bf16* Vg = (const bf16*)(ws + FW_V);
        attn_span_phase(F, Q, Kg, Vg, (bf16*)(ws + FW_MIX), (float*)(F.ctl + CW_SSQA));
#endif
    } SEAM(3);
    if (IN(4)) REPS(4) {
        GemmP g{U2P * 2, U2P * 2, U2P}; GroupOrder S{(const char*)(ws + FW_U2), (const char*)(ws + FW_TB), (size_t)NCH * U2P * 2, (size_t)512 * U2P * 2, (size_t)256 * U2P * 2, (size_t)256 * U2P * 2, NCH / 256, 2, NG * (NCH / 256) * 2, F.G, F.c};
        EpiS5 E{(bf16*)(ws + FW_Z)};
        gemm_phase(F.lds, g, S, E); } SEAM(4);
    if (IN(5)) REPS(5) {
        GemmP g{DSSM * 2, DSSM * 2, DSSM}; DenseOrder S{(const char*)(ws + FW_Z), (const char*)(ws + FW_WGLU), (size_t)256 * DSSM * 2, (size_t)256 * DSSM * 2, M / 256, 2, (M / 256) * 2, F.G, F.c};
        EpiGlu E{(const bf16*)(ws + FW_Z), args.in[12], (bf16*)(ws + FW_MIX), (float*)(F.ctl + CW_SSQS)};
        gemm_phase(F.lds, g, S, E); } if (IN(5) && IN(7)) xcd_barrier(bar);
    if (IN(7)) REPS(7) {
        GemmP g{DM * 2, DM * 2, DM}; DenseOrder S{(const char*)(ws + FW_MIX), (const char*)(ws + FW_WOUT), (size_t)256 * DM * 2, (size_t)256 * DM * 2, M / 256, 4, (M / 256) * 4, F.G, F.c};
        EpiX1B E{args.in[0], (bf16*)(ws + FW_X1B), (const float*)(F.ctl + CW_SSQS), (const float*)(F.ctl + CW_SSQA), (LAS float*)(F.lds + SCR2_OFF + 8192)};
        gemm_phase(F.lds, g, S, E); } SEAM(7);
    if (IN(8)) { router_phase(F, args); } SEAM(8);
    int ntiles = 0;
    if (IN(9) || IN(10) || IN(11) || IN(12)) ntiles = moe_tables(F);
    if (IN(9)) REPS(9) { scatter_phase(F, args); } SEAM(9);
    if (IN(10)) REPS(10) {
        LAS int* RC = (LAS int*)(F.lds + SCR2_OFF + 1024); const int* ROWTOK = (const int*)(ws + FW_ROW);
        for (int i = 0; (long)i * F.G + F.c < (long)ntiles * 4; ++i) { const int pm = (int)(((long)i * F.G + F.c) >> 2); if (F.tid < 256) RC[i * 256 + F.tid] = ROWTOK[pm * 256 + F.tid]; }
        __syncthreads();
        GemmP g{DM * 2, DM * 2, DM}; MoeOrder S{(const char*)(ws + FW_X1B), (const char*)(ws + FW_WGU), (size_t)0, (size_t)DM * DM * 2, (size_t)256 * DM * 2, F.lds + SCR2_OFF + 256, ntiles, F.G, F.c};
        EpiGU E{(bf16*)(ws + FW_HH), (const float*)(ws + FW_ROW) + MAXROWS};
        gemm_phase<EpiGU, MoeOrder, true>(F.lds, g, S, E, RC); } SEAM(10);
    if (IN(11)) REPS(11) {
        GemmP g{DE * 2, DE * 2, DE}; MoeOrder S{(const char*)(ws + FW_HH), (const char*)(ws + FW_WD), (size_t)256 * DE * 2, (size_t)DM * DE * 2, (size_t)256 * DE * 2, F.lds + SCR2_OFF + 256, ntiles, F.G, F.c};
        EpiDown E{(bf16*)(ws + FW_YE), (const float*)(ws + FW_ROW) + 2 * MAXROWS};
        gemm_phase(F.lds, g, S, E); } SEAM(11);
    if (IN(12)) { combine_phase(F, args); }
#undef IN
#undef SEAM
}
}

#ifndef FAST_UPTO
#define FAST_UPTO 12
#endif
#ifndef NAIVE_ATTN_OVERRIDE
#define NAIVE_ATTN_OVERRIDE 0
#endif
#ifndef NAIVE_S5_OVERRIDE
#define NAIVE_S5_OVERRIDE 0
#endif
extern "C" void kernel_launch(void* const* d_in, const int* in_sizes, int n_in, void* d_out, int out_size, void* d_ws, size_t ws_size, hipStream_t stream) {
    static int grid = 0;
    if (grid == 0) {
        if (n_in != 26 || out_size != M * DM || ws_size < mk::FW_END2) { fprintf(stderr, "kernel_launch: unexpected shapes (n_in %d out %d ws %zu, need %zu)\n", n_in, out_size, ws_size, (size_t)mk::FW_END2); grid = -1; return; }
        int dev = 0, cus = 0, per_cu = 0;
        if (hipGetDevice(&dev) != hipSuccess || hipDeviceGetAttribute(&cus, hipDeviceAttributeMultiprocessorCount, dev) != hipSuccess) { grid = -1; return; }
        if (hipFuncSetAttribute((const void*)mk::mk_fwd, hipFuncAttributeMaxDynamicSharedMemorySize, mk::LDS_BYTES) != hipSuccess) { fprintf(stderr, "kernel_launch: hipFuncSetAttribute failed\n"); grid = -1; return; }
        if (hipOccupancyMaxActiveBlocksPerMultiprocessor(&per_cu, (const void*)mk::mk_fwd, mk::NTHR, mk::LDS_BYTES) != hipSuccess || per_cu < 1) { fprintf(stderr, "kernel_launch: occupancy query says %d\n", per_cu); }
        (void)hipGetLastError();
        grid = cus;
        if (grid != 256) fprintf(stderr, "kernel_launch: %d CUs (built for 256)\n", grid);
    }
    if (grid < 0) return;
    const float* const* in = (const float* const*)d_in;
    unsigned char* ws = (unsigned char*)d_ws; float* out = (float*)d_out;
    mk::Args a{};
    for (int i = 0; i < 26; ++i) a.in[i] = in[i];
    a.out = out; a.ws = ws;
    auto launch = [&](int lo, int hi) {
        (void)hipMemsetAsync(ws + WS_CTL, 0, mk::CTL_ZERO_BYTES, stream);
        a.ph_lo = lo; a.ph_hi = hi;
        hipLaunchKernelGGL(mk::mk_fwd, dim3(grid), dim3(mk::NTHR), mk::LDS_BYTES, stream, a);
    };
#if FAST_UPTO == 12 && !NAIVE_ATTN_OVERRIDE && !NAIVE_S5_OVERRIDE
    launch(0, mk::NPHASE);
#else
    bf16* Q = (bf16*)(ws + mk::FW_Q); bf16* Kb = (bf16*)(ws + mk::FW_K); bf16* V = (bf16*)(ws + mk::FW_V); bf16* U2 = (bf16*)(ws + mk::FW_U2);
    bf16* Z = (bf16*)(ws + mk::FW_Z); bf16* YS = (bf16*)(ws + mk::FW_YS); bf16* YA = (bf16*)(ws + mk::FW_YA); bf16* MIX = (bf16*)(ws + mk::FW_MIX); bf16* H2 = (bf16*)(ws + mk::FW_H2);
    int* TOK = (int*)(ws + mk::FW_TOK);
    launch(0, (FAST_UPTO < 5 ? FAST_UPTO : 5) + 1);
    if (FAST_UPTO < 5 || NAIVE_S5_OVERRIDE) {
        nv::k_s5<<<BATCH * NG, 64, 0, stream>>>(U2, in[3], in[4], in[5], in[6], in[7], in[8], in[9], in[10], Z);
        nv::GArgs g{}; g.A = Z; g.lda = DSSM; g.ascale = nullptr; g.B = in[11]; g.ldb = DSSM; g.K = DSSM; g.ldc = DSSM; g.bias = in[12]; g.Zin = Z; g.Ob = YS;
        nv::k_gemm<1><<<dim3(DSSM / 64, M / 64), 256, 0, stream>>>(g);
    }
    if (FAST_UPTO < 3 || NAIVE_ATTN_OVERRIDE) nv::k_attn<<<dim3(SEQ / 64, NH, BATCH), 64, 0, stream>>>(Q, Kb, V, YA);
    if (FAST_UPTO >= 7) launch(6, 8);
    else {
        nv::k_mixnorm<<<2048, 256, 0, stream>>>(YS, YA, in[15], in[16], MIX, 1);
        nv::GArgs g{}; g.A = MIX; g.lda = DM; g.ascale = nullptr; g.B = in[17]; g.ldb = DM; g.K = DM; g.ldc = DM; g.X = in[0]; g.Out = out;
        nv::k_gemm<2><<<dim3(DM / 64, M / 64), 256, 0, stream>>>(g);
    }
    if (FAST_UPTO >= 12) launch(8, 13);
    else {
        nv::k_router<<<2048, 256, 0, stream>>>(out, in[18], in[19], in[20], in[21], in[22], H2, TOK, 1);
        nv::k_moe<<<M, 256, 0, stream>>>(H2, TOK, in[23], in[24], in[25], out);
    }
#endif
}
```

```cpp
#define ASPAN_N 10
#define PADX 0

#include <hip/hip_runtime.h>
#include <cstdio>
#include <cstdint>

typedef unsigned short bf16;
typedef float f32x4 __attribute__((ext_vector_type(4)));
typedef unsigned u32x4 __attribute__((ext_vector_type(4)));
typedef unsigned u32x2 __attribute__((ext_vector_type(2)));

constexpr int DM = 1024, BATCH = 32, SEQ = 2048, M = BATCH * SEQ;
constexpr int DSSM = 512, NG = 32, GS = 16, PST = 64, HD = 64, DATT = 512, NH = 8, DIN = 2048;
constexpr int NEG = 4, EPG = 8, NE = 32, DE = 512;
constexpr float EPS = 1e-6f;
constexpr int LCH = 32;
constexpr int NCH = M / LCH;
constexpr int U2P = 640;
constexpr float C2 = 0.125f * 1.4426950408889634f;

constexpr size_t MiB = 1u << 20;
constexpr size_t WS_CTL = 0;
constexpr size_t WS_TOK = 2 * MiB;
constexpr size_t WS_XN = 8 * MiB;
constexpr size_t WS_Q = WS_XN + 128 * MiB;
constexpr size_t WS_K = WS_Q + 64 * MiB;
constexpr size_t WS_V = WS_K + 64 * MiB;
constexpr size_t WS_U2 = WS_V + 64 * MiB;
constexpr size_t WS_Z = WS_U2 + 80 * MiB;
constexpr size_t WS_YS = WS_Z + 64 * MiB;
constexpr size_t WS_YA = WS_YS + 64 * MiB;
constexpr size_t WS_MIX = WS_YA + 64 * MiB;
constexpr size_t WS_H2 = WS_XN;
constexpr size_t WS_PROJ = WS_Z;
constexpr size_t WS_END = WS_PROJ + 512 * MiB;

__device__ __forceinline__ unsigned f2bf(float f) { unsigned u = __builtin_bit_cast(unsigned, f); return (u + 0x7fffu + ((u >> 16) & 1u)) >> 16; }
__device__ __forceinline__ float bf2f(unsigned short h) { return __builtin_bit_cast(float, (unsigned)h << 16); }
__device__ __forceinline__ unsigned pk2(float lo, float hi) { return f2bf(lo) | (f2bf(hi) << 16); }
template <int CTRL> __device__ __forceinline__ float dppf(float x) { return __builtin_bit_cast(float, __builtin_amdgcn_update_dpp(0, __builtin_bit_cast(int, x), CTRL, 0xF, 0xF, true)); }
template <int CTRL> __device__ __forceinline__ unsigned dppu(unsigned x) { return (unsigned)__builtin_amdgcn_update_dpp(0, (int)x, CTRL, 0xF, 0xF, true); }
__device__ __forceinline__ float xor16_sum(float v) { const unsigned u = __builtin_bit_cast(unsigned, v); auto r = __builtin_amdgcn_permlane16_swap(u, u, false, false); return __builtin_bit_cast(float, (unsigned)r[0]) + __builtin_bit_cast(float, (unsigned)r[1]); }
__device__ __forceinline__ float xor32_sum(float v) { const unsigned u = __builtin_bit_cast(unsigned, v); auto r = __builtin_amdgcn_permlane32_swap(u, u, false, false); return __builtin_bit_cast(float, (unsigned)r[0]) + __builtin_bit_cast(float, (unsigned)r[1]); }
__device__ __forceinline__ unsigned xor16_get(unsigned u, bool odd_row) { auto r = __builtin_amdgcn_permlane16_swap(u, u, false, false); return odd_row ? (unsigned)r[0] : (unsigned)r[1]; }
__device__ __forceinline__ float wave_sum(float v) {
    v += dppf<0xB1>(v); v += dppf<0x4E>(v); v += dppf<0x141>(v); v += dppf<0x140>(v);
    return xor32_sum(xor16_sum(v));
}
__device__ __forceinline__ void sincos_d(double th, double& s, double& c) {
    const double q = rint(th * 0.63661977236758134308);
    const double r = (th - q * 1.57079632679489655800) - q * 6.12323399573676603587e-17;
    const double r2 = r * r;
    double sp = -1.0 / 1307674368000.0; sp = sp * r2 + 1.0 / 6227020800.0; sp = sp * r2 - 1.0 / 39916800.0; sp = sp * r2 + 1.0 / 362880.0; sp = sp * r2 - 1.0 / 5040.0; sp = sp * r2 + 1.0 / 120.0; sp = sp * r2 - 1.0 / 6.0; sp = sp * r2 + 1.0;
    const double sn = sp * r;
    double cp = 1.0 / 20922789888000.0; cp = cp * r2 - 1.0 / 87178291200.0; cp = cp * r2 + 1.0 / 479001600.0; cp = cp * r2 - 1.0 / 3628800.0; cp = cp * r2 + 1.0 / 40320.0; cp = cp * r2 - 1.0 / 720.0; cp = cp * r2 + 1.0 / 24.0; cp = cp * r2 - 0.5; cp = cp * r2 + 1.0;
    const int qi = ((int)q) & 3;
    s = (qi == 0) ? sn : (qi == 1) ? cp : (qi == 2) ? -sn : -cp;
    c = (qi == 0) ? cp : (qi == 1) ? -sn : (qi == 2) ? -cp : sn;
}
__device__ __forceinline__ float gelu_tanh(float x) {
    constexpr float K1 = -2.885390081777927f * 0.7978845608028654f, K3 = K1 * 0.044715f;
    const float e = __builtin_amdgcn_exp2f(x * (K1 + K3 * (x * x)));
    return x * __builtin_amdgcn_rcpf(1.f + e);
}
__device__ __forceinline__ float sigmoidf_(float x) { return __builtin_amdgcn_rcpf(1.f + __builtin_amdgcn_exp2f(-1.4426950408889634f * x)); }


#include <type_traits>
namespace mk {
#define LAS __attribute__((address_space(3)))
#define GAS __attribute__((address_space(1)))
typedef short bf16x8 __attribute__((ext_vector_type(8)));
typedef short s16x4 __attribute__((ext_vector_type(4)));
typedef float f32x16 __attribute__((ext_vector_type(16)));
typedef float f32x2 __attribute__((ext_vector_type(2)));
typedef __bf16 bf16x2_t __attribute__((ext_vector_type(2)));
typedef GAS unsigned gu32;

constexpr int NWAVES = 8, NTHR = 512;
constexpr int RING_BYTES = 131072, SCR2_OFF = RING_BYTES, SCR2_BYTES = 16128, MISC_OFF = SCR2_OFF + SCR2_BYTES, LDS_BYTES = 147456;
static_assert(MISC_OFF + 256 == LDS_BYTES, "LDS map");

#ifndef PADX
#define PADX 64
#endif
constexpr int PX = DM + PADX;
constexpr int PW = DM + PADX;
constexpr size_t FW_TOK = 2 * MiB, FW_WIN = 4 * MiB, FW_WOUT = 9 * MiB, FW_WGLU = 12 * MiB - 512 * 1024, FW_WR = 12 * MiB, FW_TB = 13 * MiB, FW_W1 = 33 * MiB,
                 FW_WGU = 41 * MiB, FW_WD = 110 * MiB, FW_SST = 142 * MiB, FW_XN = 174 * MiB, FW_Q = 310 * MiB, FW_K = 374 * MiB, FW_V = 438 * MiB, FW_U2 = 502 * MiB,
                 FW_Z = 582 * MiB, FW_MIX = 646 * MiB, FW_ROW = 782 * MiB, FW_END2 = 784 * MiB,
                 FW_X1B = FW_XN, FW_HH = 582 * MiB, FW_YE = FW_Q;
static_assert(FW_WIN + (size_t)DIN * PW * 2 <= FW_WOUT && FW_WOUT + (size_t)DM * PW * 2 <= FW_WGLU && FW_WGU + (size_t)NE * DM * PW * 2 <= FW_WD && FW_XN + (size_t)M * PX * 2 <= FW_Q && FW_MIX + (size_t)M * PX * 2 <= FW_ROW, "padded buffers");
static_assert(FW_K - FW_Q == (size_t)M * 512 * 2 && FW_V - FW_K == (size_t)M * 512 * 2, "Q|K|V contiguous");
constexpr size_t FW_RSTDX = FW_ROW + 3 * (size_t)(544 * 256) * 4;
constexpr size_t FW_ETOK = FW_SST, FW_EG = FW_SST + (size_t)NE * M * 4;
static_assert(FW_EG + (size_t)NE * M * 4 <= FW_XN, "expert lists");
constexpr float W8SC = 64.f;
constexpr size_t FW_X1Q = FW_U2;
static_assert(FW_X1Q + (size_t)M * DM <= FW_HH && FW_YE + (size_t)(544 * 256) * DM <= FW_X1Q && FW_HH + (size_t)(544 * 256) * DE <= FW_ROW, "X1Q / HH / YE must not overlap");
constexpr size_t FW_A32 = FW_WR + 256 * 1024;
constexpr int MAXTILES = 544, MAXROWS = MAXTILES * 256;
static_assert(FW_RSTDX + (size_t)M * 4 <= FW_END2, "row arrays");
static_assert(FW_YE + (size_t)MAXROWS * DM <= FW_U2 && FW_HH + (size_t)MAXROWS * DE * 2 <= FW_ROW, "MoE overlay");
constexpr int CW_TMO = 0, CW_CNT = 64, CW_BAR = 4096, CW_SSQS = 65536, CW_SSQA = 131072;
static_assert((CW_SSQA + M) * 4 <= (int)(1 * MiB), "ssq arrays inside the memset region");
constexpr size_t CTL_ZERO_BYTES = 1 * MiB;

#define RLX_AGENT __ATOMIC_RELAXED, __HIP_MEMORY_SCOPE_AGENT
__device__ __forceinline__ unsigned cvtpk(float lo, float hi) { f32x2 v = {lo, hi}; bf16x2_t b = __builtin_convertvector(v, bf16x2_t); return __builtin_bit_cast(unsigned, b); }

#define XB_TMO      128
#define XB_XCNT(j)  (256  + 64 * (j))
#define XB_XSUB(j)  (1280 + 64 * (j))
#define XB_XGEN(j)  (2304 + 64 * (j))
#define XB_TOP      3328
#define XB_TOPGEN   3392
#define XCD_BAR_WORDS 3456
#define XB_SPIN_CAP (1u << 18)
__device__ __forceinline__ unsigned xb_ld(unsigned* p)              { return __hip_atomic_load(p, __ATOMIC_RELAXED, __HIP_MEMORY_SCOPE_AGENT); }
__device__ __forceinline__ unsigned xb_add(unsigned* p, unsigned v) { return __hip_atomic_fetch_add(p, v, __ATOMIC_RELAXED, __HIP_MEMORY_SCOPE_AGENT); }
__device__ __forceinline__ unsigned xb_xcc_id() { return (unsigned)__builtin_amdgcn_s_getreg((3 << 11) | 20) & 0xFu; }
#define XB_SPIN(cond, bar) do { unsigned _sp = 0; while (cond) { __builtin_amdgcn_s_sleep(1); \
    if ((++_sp & 255u) == 0u) { if (xb_ld(&(bar)[XB_TMO])) break; if (_sp > XB_SPIN_CAP) { atomicAdd(&(bar)[XB_TMO], 1u); break; } } } } while (0)
struct XcdBarrier { unsigned* bar; unsigned x; volatile LAS unsigned* st; };
__device__ __forceinline__ XcdBarrier xcd_barrier_post(unsigned* bar, volatile LAS unsigned* st) {
    XcdBarrier b; b.bar = bar; b.x = xb_xcc_id(); b.st = st;
    if (threadIdx.x == 0) (void)xb_add(&bar[XB_XCNT(b.x)], 1u);
    return b;
}
__device__ __forceinline__ void xcd_barrier_complete(unsigned* bar, unsigned x, unsigned& nloc, unsigned& nx) {
    const unsigned G = gridDim.x * gridDim.y * gridDim.z;
    unsigned sum, cnt, mine, sp = 0u;
    for (;;) {
        sum = 0u; cnt = 0u; mine = 0u;
#pragma unroll
        for (unsigned j = 0; j < 16; ++j) { const unsigned c = xb_ld(&bar[XB_XCNT(j)]); sum += c; cnt += (c > 0u) ? 1u : 0u; mine = (j == x) ? c : mine; }
        if (sum == G) break;
        __builtin_amdgcn_s_sleep(1);
        if ((++sp & 255u) == 0u) { if (xb_ld(&bar[XB_TMO])) break; if (sp > XB_SPIN_CAP) { atomicAdd(&bar[XB_TMO], 1u); break; } }
    }
    nloc = mine > 0u ? mine : 1u; nx = cnt > 0u ? cnt : 1u;
}
__device__ __forceinline__ void xcd_barrier(const XcdBarrier& b) {
    asm volatile("s_waitcnt vmcnt(0)" ::: "memory");
    __syncthreads();
    if (threadIdx.x == 0) {
        unsigned* bar = b.bar;
        __builtin_amdgcn_s_waitcnt(0);
        unsigned nloc = b.st[0], nx = b.st[1];
        if (nloc == 0u) { xcd_barrier_complete(bar, b.x, nloc, nx); b.st[0] = nloc; b.st[1] = nx; }
        const unsigned old = xb_add(&bar[XB_XSUB(b.x)], 1u);
        const unsigned gen = old / nloc;
        if (old + 1u == (gen + 1u) * nloc) {
            __builtin_amdgcn_fence(__ATOMIC_RELEASE, "agent");
            asm volatile("s_waitcnt vmcnt(0)" ::: "memory");
            const unsigned og = xb_add(&bar[XB_TOP], 1u);
            const unsigned tg = og / nx;
            if (og + 1u == (tg + 1u) * nx) xb_add(&bar[XB_TOPGEN], 1u);
            else XB_SPIN(xb_ld(&bar[XB_TOPGEN]) == tg, bar);
            __builtin_amdgcn_fence(__ATOMIC_ACQUIRE, "agent");
            xb_add(&bar[XB_XGEN(b.x)], 1u);
            asm volatile("s_waitcnt vmcnt(0)" ::: "memory");
        } else {
            XB_SPIN(xb_ld(&bar[XB_XGEN(b.x)]) == gen, bar);
            __builtin_amdgcn_fence(__ATOMIC_ACQUIRE, "agent");
            asm volatile("s_waitcnt vmcnt(0)" ::: "memory");
        }
    }
    __syncthreads();
}

constexpr int BM = 256, BK = 64, HALF = 128, HTB = HALF * BK * 2;
__device__ __forceinline__ int lds_byte(int r, int c) { const int st = (r >> 4) * 2 + (c >> 5), rr = r & 15, cc = c & 31, ob = rr * 64 + cc * 2; return st * 1024 + (ob ^ (((ob >> 9) & 1) << 5)); }
__device__ __forceinline__ void stage_rc(int b, int& R, int& C) { const int st = b / 1024, sb = b % 1024, swz = sb ^ (((sb >> 9) & 1) << 5); R = (st >> 1) * 16 + swz / 64; C = (st & 1) * 32 + (swz % 64) / 2; }
__device__ __forceinline__ int perm32(int rho) { const int n = rho >> 4, i = rho & 15; return 8 * (i >> 2) + 4 * n + (i & 3); }
struct Unit { const char* a; const char* b; int pm, pn, aux; };
struct GemmP { int lda_b, ldb_b, K; };

template <class Epi, class Sched, bool GATHER = false, int KREP = 1, bool FP8 = false>
__device__ __forceinline__ void gemm_phase(LAS unsigned char* lds, const GemmP g, const Sched& S, const Epi& E, const LAS int* rowcache = nullptr, int stagger_ticks = 0) {
    const int tid = threadIdx.x, wid = __builtin_amdgcn_readfirstlane(tid >> 6), lane = tid & 63, wr = wid >> 2, wc = wid & 3, fr = lane & 15, fq = lane >> 4;
    const int ntk = g.K / BK, nt = ntk * (KREP == 3 ? 1 : KREP);
    unsigned voffA[2], voffB[2]; int gR[2], gC[2];
#pragma unroll
    for (int i = 0; i < 2; ++i) { int R, C; stage_rc(tid * 16 + i * 8192, R, C); const int Rb = Epi::PERM ? ((R & ~31) + perm32(R & 31)) : R; gR[i] = R; gC[i] = C * 2;
        voffA[i] = (unsigned)(R * g.lda_b + C * 2); voffB[i] = (unsigned)(Rb * g.ldb_b + C * 2); }
    unsigned vc0[2] = {voffA[0], voffA[1]}, vc1[2] = {voffA[0], voffA[1]}, vn0[2] = {voffA[0], voffA[1]}, vn1[2] = {voffA[0], voffA[1]};
#define PG8_GOFF(dst0, dst1, ui_) do { _Pragma("unroll") for (int _i = 0; _i < 2; ++_i) { \
        dst0[_i] = ((unsigned)rowcache[(ui_) * 256 + gR[_i]] & 0xffffu) * (unsigned)g.lda_b + (unsigned)gC[_i]; dst1[_i] = ((unsigned)rowcache[(ui_) * 256 + 128 + gR[_i]] & 0xffffu) * (unsigned)g.lda_b + (unsigned)gC[_i]; } } while (0)
    const size_t kstep = (size_t)(BK * 2);
    const size_t hstepA = GATHER ? 0 : (size_t)HALF * g.lda_b, hstepB = (size_t)HALF * g.ldb_b;
    const unsigned ldsw = (unsigned)wid * 1024u;
    const int aoff = lds_byte(wr * 64 + fr, fq * 8), boff = lds_byte(wc * 32 + fr, fq * 8);
#define PG8_SA(b, h) (((b) * 2 + (h)) * HTB)
#define PG8_SB(b, h) ((4 + (b) * 2 + (h)) * HTB)
#define PG8_STAGE(bufoff, gbase, voff) do { _Pragma("unroll") for (int _i = 0; _i < 2; ++_i) \
        __builtin_amdgcn_global_load_lds((const unsigned*)((const char*)(gbase) + (voff)[_i]), (LAS unsigned*)(lds + (bufoff) + ldsw + _i * 8192), 16, 0, 0); } while (0)
#define PG8_LDA(dst, b, h) do { _Pragma("unroll") for (int m = 0; m < 4; ++m) { const LAS unsigned char* p_ = lds + PG8_SA(b, h) + aoff + m * 2048; \
        if constexpr (FP8) { dst[m].v.lo = *(const LAS v4i_*)p_; dst[m].v.hi = *(const LAS v4i_*)(p_ + 1024); } else { dst[m].v[0] = *(const LAS bf16x8*)p_; dst[m].v[1] = *(const LAS bf16x8*)(p_ + 1024); } } } while (0)
#define PG8_LDB(dst, b, h) do { _Pragma("unroll") for (int n = 0; n < 2; ++n) { const LAS unsigned char* p_ = lds + PG8_SB(b, h) + boff + n * 2048; \
        if constexpr (FP8) { dst[n].v.lo = *(const LAS v4i_*)p_; dst[n].v.hi = *(const LAS v4i_*)(p_ + 1024); } else { dst[n].v[0] = *(const LAS bf16x8*)p_; dst[n].v[1] = *(const LAS bf16x8*)(p_ + 1024); } } } while (0)
#define PG8_MMA(ai, bj, At, Bt) do { if (Epi::HALFN && (bj) == 1) break; __builtin_amdgcn_s_setprio(1); \
        if constexpr (FP8) { asm volatile("s_nop 1\n\t" "v_mfma_scale_f32_16x16x128_f8f6f4 %0, %8, %10, %0, %14, %14 op_sel_hi:[0,0,0]\n\t" "v_mfma_scale_f32_16x16x128_f8f6f4 %1, %9, %10, %1, %14, %14 op_sel_hi:[0,0,0]\n\t" "v_mfma_scale_f32_16x16x128_f8f6f4 %2, %8, %11, %2, %14, %14 op_sel_hi:[0,0,0]\n\t" "v_mfma_scale_f32_16x16x128_f8f6f4 %3, %9, %11, %3, %14, %14 op_sel_hi:[0,0,0]\n\t" "v_mfma_scale_f32_16x16x128_f8f6f4 %4, %8, %12, %4, %14, %14 op_sel_hi:[0,0,0]\n\t" "v_mfma_scale_f32_16x16x128_f8f6f4 %5, %9, %12, %5, %14, %14 op_sel_hi:[0,0,0]\n\t" "v_mfma_scale_f32_16x16x128_f8f6f4 %6, %8, %13, %6, %14, %14 op_sel_hi:[0,0,0]\n\t" "v_mfma_scale_f32_16x16x128_f8f6f4 %7, %9, %13, %7, %14, %14 op_sel_hi:[0,0,0]\n\t" "s_nop 1" \
            : "+v"(acc[ai][bj][0][0]), "+v"(acc[ai][bj][0][1]), "+v"(acc[ai][bj][1][0]), "+v"(acc[ai][bj][1][1]), "+v"(acc[ai][bj][2][0]), "+v"(acc[ai][bj][2][1]), "+v"(acc[ai][bj][3][0]), "+v"(acc[ai][bj][3][1]) \
            : "v"(Bt[0].v), "v"(Bt[1].v), "v"(At[0].v), "v"(At[1].v), "v"(At[2].v), "v"(At[3].v), "v"(mxs)); } \
        else { _Pragma("unroll") for (int m = 0; m < 4; ++m) _Pragma("unroll") for (int n = 0; n < 2; ++n) _Pragma("unroll") for (int k = 0; k < 2; ++k) \
            acc[ai][bj][m][n] = __builtin_amdgcn_mfma_f32_16x16x32_bf16(Bt[n].v[k], At[m].v[k], acc[ai][bj][m][n], 0, 0, 0); } \
        __builtin_amdgcn_s_setprio(0); } while (0)
#define PG8_WAIT_V(n) asm volatile("s_waitcnt vmcnt(" #n ")" ::: "memory")
#define PG8_WAIT_L(n) asm volatile("s_waitcnt lgkmcnt(" #n ")" ::: "memory")
#define PG8_BAR __builtin_amdgcn_s_barrier()
#define PG8_SCHED __builtin_amdgcn_sched_barrier(0)
    int mxs = 0x7F7F7F7F; asm volatile("" : "+v"(mxs));
    Unit cur, nxt; int ui = 0;
    if (!S.next(0, cur)) return;
    if (stagger_ticks > 0) { const unsigned long long t0 = __builtin_amdgcn_s_memrealtime(); while ((long long)(__builtin_amdgcn_s_memrealtime() - t0) < (long long)stagger_ticks) __builtin_amdgcn_s_sleep(8); }
    f32x4 acc[2][2][4][2];
#pragma unroll
    for (int a = 0; a < 2; ++a)
#pragma unroll
        for (int b = 0; b < 2; ++b)
#pragma unroll
            for (int m = 0; m < 4; ++m)
#pragma unroll
                for (int n = 0; n < 2; ++n) acc[a][b][m][n] = (f32x4){0.f, 0.f, 0.f, 0.f};
    typedef int v4i_ __attribute__((ext_vector_type(4))); typedef int v8i_ __attribute__((ext_vector_type(8)));
    struct FragB { bf16x8 v[2]; }; struct Frag8 { v8i_ v; };
    typename std::conditional<FP8, Frag8, FragB>::type At[4], B0[2], B1[2];
    const char* cA = cur.a; const char* cB = cur.b;
    if (GATHER) { PG8_GOFF(vc0, vc1, 0); }
    PG8_STAGE(PG8_SB(0, 0), cB, voffB); PG8_STAGE(PG8_SB(0, 1), cB + hstepB, voffB); PG8_STAGE(PG8_SA(0, 0), cA, vc0); PG8_STAGE(PG8_SA(0, 1), cA + hstepA, vc1);
    if (wr == 1) PG8_BAR;
    PG8_WAIT_V(2); PG8_BAR;
    PG8_STAGE(PG8_SB(1, 0), cB + kstep, voffB); PG8_STAGE(PG8_SA(1, 0), cA + kstep, vc0); PG8_STAGE(PG8_SB(1, 1), cB + hstepB + kstep, voffB);
    PG8_WAIT_V(6); PG8_BAR;
    for (;;) {
        const bool has_next = S.next(ui + 1, nxt);
        const char* nA = has_next ? nxt.a : cA; const char* nB = has_next ? nxt.b : cB;
        if constexpr (Epi::HOOKS) E.begin(cur, ui, tid);
        if (GATHER) { if (has_next) { PG8_GOFF(vn0, vn1, ui + 1); } else { vn0[0] = vc0[0]; vn0[1] = vc0[1]; vn1[0] = vc1[0]; vn1[1] = vc1[1]; } }
        for (int t = 0; t < nt; t += 2) {
            const bool last = (t == nt - 2);
            if constexpr (Epi::HOOKS) { if (t == nt / 2) E.mid(acc, ui, wr, fr); }
#ifdef PROBE_EPI_TWICE
            if constexpr (KREP == 3) { if (t == ntk / 2) E.fin(acc, cur, ui, wr, wc, fr, fq); }
#endif
            const char* a1 = cA + (size_t)((t + 1) % ntk) * kstep;
            const char* a2 = last ? nA : cA + (size_t)((t + 2) % ntk) * kstep; const char* b2 = last ? nB : cB + (size_t)((t + 2) % ntk) * kstep;
            const char* a3 = a2 + kstep; const char* b3 = b2 + kstep;
            unsigned w0[2], w1[2];
            w0[0] = (GATHER && last) ? vn0[0] : vc0[0]; w0[1] = (GATHER && last) ? vn0[1] : vc0[1]; w1[0] = (GATHER && last) ? vn1[0] : vc1[0]; w1[1] = (GATHER && last) ? vn1[1] : vc1[1];
            PG8_LDB(B0, 0, 0); PG8_LDB(B1, 0, 1); PG8_SCHED; PG8_LDA(At, 0, 0); PG8_STAGE(PG8_SA(1, 1), a1 + hstepA, vc1);
            PG8_WAIT_V(8); PG8_WAIT_L(0); PG8_BAR; PG8_MMA(0, 0, At, B0); PG8_MMA(0, 1, At, B1); PG8_BAR; PG8_SCHED;
            PG8_LDA(At, 0, 1); PG8_STAGE(PG8_SB(0, 0), b2, voffB); PG8_STAGE(PG8_SB(0, 1), b2 + hstepB, voffB); PG8_STAGE(PG8_SA(0, 0), a2, w0);
            PG8_WAIT_V(8); PG8_WAIT_L(0); PG8_BAR; PG8_MMA(1, 0, At, B0); PG8_MMA(1, 1, At, B1); PG8_BAR; PG8_SCHED;
            PG8_LDB(B0, 1, 0); PG8_LDB(B1, 1, 1); PG8_SCHED; PG8_LDA(At, 1, 0); PG8_STAGE(PG8_SA(0, 1), a2 + hstepA, w1);
            PG8_WAIT_V(8); PG8_WAIT_L(0); PG8_BAR; PG8_MMA(0, 0, At, B0); PG8_MMA(0, 1, At, B1); PG8_BAR; PG8_SCHED;
            PG8_LDA(At, 1, 1); PG8_STAGE(PG8_SB(1, 0), b3, voffB); PG8_STAGE(PG8_SB(1, 1), b3 + hstepB, voffB); PG8_STAGE(PG8_SA(1, 0), a3, w0);
            PG8_WAIT_V(8); PG8_WAIT_L(0); PG8_BAR; PG8_MMA(1, 0, At, B0); PG8_MMA(1, 1, At, B1); PG8_BAR; PG8_SCHED;
        }
        if (wr == 0) PG8_BAR;
        if constexpr (FP8) asm volatile("s_nop 15\n\ts_nop 7" ::: "memory");
        if constexpr (KREP > 1) {
#pragma unroll
            for (int a = 0; a < 2; ++a)
#pragma unroll
                for (int b = 0; b < 2; ++b)
#pragma unroll
                    for (int m = 0; m < 4; ++m)
#pragma unroll
                        for (int n = 0; n < 2; ++n) acc[a][b][m][n] = acc[a][b][m][n] * (KREP == 3 ? 1.f : 1.f / KREP); }
        if constexpr (Epi::HOOKS) E.fin(acc, cur, ui, wr, wc, fr, fq); else E(acc, cur, wr, wc, fr, fq);
        if (!has_next) break;
#pragma unroll
        for (int a = 0; a < 2; ++a)
#pragma unroll
            for (int b = 0; b < 2; ++b)
#pragma unroll
                for (int m = 0; m < 4; ++m)
#pragma unroll
                    for (int n = 0; n < 2; ++n) acc[a][b][m][n] = (f32x4){0.f, 0.f, 0.f, 0.f};
        cur = nxt; cA = nA; cB = nB; ++ui;
        if (GATHER) { vc0[0] = vn0[0]; vc0[1] = vn0[1]; vc1[0] = vn1[0]; vc1[1] = vn1[1]; }
        if (wr == 1) PG8_BAR;
    }
    PG8_WAIT_V(0);
    PG8_BAR;
#undef PG8_GOFF
#undef PG8_SA
#undef PG8_SB
#undef PG8_STAGE
#undef PG8_LDA
#undef PG8_LDB
#undef PG8_MMA
#undef PG8_WAIT_V
#undef PG8_WAIT_L
#undef PG8_BAR
#undef PG8_SCHED
}

struct DenseOrder {
    const char* A; const char* B; size_t a_tile, b_tile; int nM, nN, nwg, G, c;
    __device__ __forceinline__ bool next(int i, Unit& u) const {
        const long L = (long)i * G + c; if (L >= nwg) return false;
        int wgid = (int)L; { const int q = nwg / 8, r = nwg % 8, xcd = wgid % 8, off = wgid / 8; wgid = (xcd < r ? xcd * (q + 1) : r * (q + 1) + (xcd - r) * q) + off; }
        const int nig = 8 * nN, gid = wgid / nig, fm = gid * 8, gsz = (nM - fm) < 8 ? (nM - fm) : 8;
        u.pm = fm + ((wgid % nig) % gsz); u.pn = (wgid % nig) / gsz; u.aux = 0;
        u.a = A + (size_t)u.pm * a_tile; u.b = B + (size_t)u.pn * b_tile; return true;
    }
};
struct GroupOrder {
    const char* A; const char* B; size_t a_grp, b_grp, a_tile, b_tile; int nM, nN, nwg, G, c;
    __device__ __forceinline__ bool next(int i, Unit& u) const {
        const long L = (long)i * G + c; if (L >= nwg) return false;
        const int per = nM * nN, g = (int)L / per, r = (int)L % per;
        u.pn = r / nM; u.pm = r % nM; u.aux = g;
        u.a = A + (size_t)g * a_grp + (size_t)u.pm * a_tile; u.b = B + (size_t)g * b_grp + (size_t)u.pn * b_tile; return true;
    }
};
__device__ __forceinline__ void moe_unit(int L, int ntiles, int& pm, int& pn) {
    const int j = L >> 5, full = ntiles >> 3;
    if (j < full) { const int r = L & 31; pm = 8 * j + (r & 7); pn = r >> 3; }
    else { const int gsz = ntiles - 8 * full, r = L - 32 * full; pm = 8 * full + r % gsz; pn = r / gsz; }
}
struct MoeOrder {
    const char* A; const char* B; size_t a_tile, b_exp, b_tile; const LAS unsigned char* t2e; int ntiles, G, c;
    __device__ __forceinline__ bool next(int i, Unit& u) const {
        const long L = (long)i * G + c; if (L >= (long)ntiles * 4) return false;
        moe_unit((int)L, ntiles, u.pm, u.pn); u.aux = t2e[u.pm];
        u.a = A + (size_t)u.pm * a_tile; u.b = B + (size_t)u.aux * b_exp + (size_t)u.pn * b_tile; return true;
    }
};

typedef f32x4 Acc[2][2][4][2];
constexpr float YE_SCALE = 8.f;
__device__ __forceinline__ unsigned pk4_fp8(float a, float b, float c, float d) { int w = 0; w = __builtin_amdgcn_cvt_pk_fp8_f32(a, b, w, false); w = __builtin_amdgcn_cvt_pk_fp8_f32(c, d, w, true); return (unsigned)w; }

__device__ __forceinline__ void store_pair(bf16* row_even, size_t pitch, u32x4 p0, u32x4 p1, int fr, int fq) {
    const bool odd = fr & 1;
    const u32x4 send = odd ? p0 : p1; u32x4 recv;
    recv.x = dppu<0xB1>(send.x); recv.y = dppu<0xB1>(send.y); recv.z = dppu<0xB1>(send.z); recv.w = dppu<0xB1>(send.w);
    const u32x4 a = odd ? recv : p0, b = odd ? p1 : recv;
    bf16* d = row_even + (odd ? 32 : 0) + 8 * fq;
#ifdef NT_STORES
    __builtin_nontemporal_store(a, (u32x4*)d); __builtin_nontemporal_store(b, (u32x4*)(d + pitch));
#else
    *(u32x4*)d = a; *(u32x4*)(d + pitch) = b;
#endif
}
struct EpiProj {
    static constexpr bool HALFN = false, HOOKS = false, PERM = true;
    bf16* U2; bf16* QKV; const LAS float* GQK;
    __device__ __forceinline__ void operator()(const Acc& acc, const Unit& u, int wr, int wc, int fr, int fq) const {
        const int typ = u.pn >> 1;
        if (typ == 1 || typ == 2) run<true>(acc, u, wr, wc, fr, fq); else run<false>(acc, u, wr, wc, fr, fq);
    }
    template <bool nrm> __device__ __forceinline__ void run(const Acc& acc, const Unit& u, int wr, int wc, int fr, int fq) const {
        const int typ = u.pn >> 1, sub = u.pn & 1;
        const LAS float* gg = GQK + ((typ == 1) ? 0 : 64);
        f32x4 gn[2][2];
#pragma unroll
        for (int bj = 0; bj < 2; ++bj)
#pragma unroll
            for (int n = 0; n < 2; ++n) gn[bj][n] = nrm ? *(const LAS f32x4*)(gg + 32 * bj + 8 * fq + 4 * n) : (f32x4){1.f, 1.f, 1.f, 1.f};
#pragma unroll
        for (int ai = 0; ai < 2; ++ai)
#pragma unroll
            for (int m = 0; m < 4; ++m) {
                const int r = u.pm * BM + ai * HALF + wr * 64 + m * 16 + fr;
                f32x4 v[2][2];
#pragma unroll
                for (int bj = 0; bj < 2; ++bj)
#pragma unroll
                    for (int n = 0; n < 2; ++n) v[bj][n] = acc[ai][bj][m][n];
                if constexpr (nrm) {
                    float s = 0.f;
#pragma unroll
                    for (int bj = 0; bj < 2; ++bj)
#pragma unroll
                        for (int n = 0; n < 2; ++n) s += (v[bj][n].x * v[bj][n].x + v[bj][n].y * v[bj][n].y) + (v[bj][n].z * v[bj][n].z + v[bj][n].w * v[bj][n].w);
                    s = xor32_sum(xor16_sum(s));
                    const float rstd = nrm ? __builtin_amdgcn_rsqf(s * (1.f / 64.f) + EPS) : 1.f;
#pragma unroll
                    for (int bj = 0; bj < 2; ++bj)
#pragma unroll
                        for (int n = 0; n < 2; ++n) v[bj][n] = v[bj][n] * (gn[bj][n] * rstd);
                }
                u32x4 p[2];
#pragma unroll
                for (int bj = 0; bj < 2; ++bj) { p[bj].x = cvtpk(v[bj][0].x, v[bj][0].y); p[bj].y = cvtpk(v[bj][0].z, v[bj][0].w); p[bj].z = cvtpk(v[bj][1].x, v[bj][1].y); p[bj].w = cvtpk(v[bj][1].z, v[bj][1].w); }
                if (!nrm && typ == 0) {
#pragma unroll
                    for (int bj = 0; bj < 2; ++bj) { const int f = sub * 256 + 64 * wc + 32 * bj + 8 * fq, g = f >> 4, h = f & 15;
                        *(u32x4*)(U2 + ((size_t)g * NCH + (r >> 5)) * U2P + (r & 31) * 16 + h) = p[bj]; }
                } else store_pair(QKV + (size_t)(typ - 1) * ((size_t)M * 512) + (size_t)(r & ~1) * 512 + sub * 256 + 64 * wc, 512, p[0], p[1], fr, fq);
            }
    }
};
struct EpiState {
    static constexpr bool HALFN = true, HOOKS = false, PERM = false;
    float* SST;
    __device__ __forceinline__ void operator()(const Acc& acc, const Unit& u, int wr, int wc, int fr, int fq) const {
#pragma unroll
        for (int ai = 0; ai < 2; ++ai)
#pragma unroll
            for (int m = 0; m < 4; ++m) { const int r = u.pm * BM + ai * HALF + wr * 64 + m * 16 + fr;
#pragma unroll
                for (int n = 0; n < 2; ++n) *(f32x4*)(SST + ((size_t)u.aux * NCH + r) * 128 + 32 * wc + 16 * n + 4 * fq) = acc[ai][0][m][n]; }
    }
};
struct EpiS5 {
    static constexpr bool HALFN = false, HOOKS = false, PERM = true;
    bf16* Z;
    __device__ __forceinline__ void operator()(const Acc& acc, const Unit& u, int wr, int wc, int fr, int fq) const {
#pragma unroll
        for (int ai = 0; ai < 2; ++ai)
#pragma unroll
            for (int m = 0; m < 4; ++m) { const int r = u.pm * BM + ai * HALF + wr * 64 + m * 16 + fr;
#pragma unroll
                for (int bj = 0; bj < 2; ++bj) { const int c0 = u.pn * BM + bj * HALF + 32 * wc + 8 * fq, i = c0 >> 4, h = c0 & 15;
                    const f32x4 a = acc[ai][bj][m][0], b = acc[ai][bj][m][1];
                    u32x4 w; w.x = cvtpk(gelu_tanh(a.x), gelu_tanh(a.y)); w.y = cvtpk(gelu_tanh(a.z), gelu_tanh(a.w)); w.z = cvtpk(gelu_tanh(b.x), gelu_tanh(b.y)); w.w = cvtpk(gelu_tanh(b.z), gelu_tanh(b.w));
                    *(u32x4*)(Z + ((size_t)r * 32 + i) * DSSM + u.aux * 16 + h) = w; } }
    }
};
struct EpiGlu {
    static constexpr bool HALFN = false, HOOKS = false, PERM = true;
    const bf16* Z; const float* bias; bf16* MIX; float* SSQ;
    __device__ __forceinline__ void operator()(const Acc& acc, const Unit& u, int wr, int wc, int fr, int fq) const {
        float ss[2][4];
#pragma unroll
        for (int ai = 0; ai < 2; ++ai)
#pragma unroll
            for (int m = 0; m < 4; ++m) ss[ai][m] = 0.f;
#pragma unroll
        for (int bj = 0; bj < 2; ++bj) { const int c0 = u.pn * BM + bj * HALF + 32 * wc + 8 * fq;
            constexpr float NL2E = -1.4426950408889634f;
            const f32x4 b0 = *(const GAS f32x4*)(bias + c0) * NL2E, b1 = *(const GAS f32x4*)(bias + c0 + 4) * NL2E;
#pragma unroll
            for (int ai = 0; ai < 2; ++ai)
#pragma unroll
                for (int m = 0; m < 4; ++m) { const size_t row = (size_t)(u.pm * BM + ai * HALF + wr * 64 + m * 16 + fr);
                    const u32x4 zz = *(const u32x4*)(Z + row * DSSM + c0);
                    const f32x4 a = acc[ai][bj][m][0], b = acc[ai][bj][m][1];
#define GLU_SG(v_, b_) __builtin_amdgcn_rcpf(1.f + __builtin_amdgcn_exp2f(__builtin_fmaf((v_), NL2E, (b_))))
                    float y[8];
                    y[0] = bf2f(zz.x & 0xffff) * GLU_SG(a.x, b0.x); y[1] = bf2f(zz.x >> 16) * GLU_SG(a.y, b0.y); y[2] = bf2f(zz.y & 0xffff) * GLU_SG(a.z, b0.z); y[3] = bf2f(zz.y >> 16) * GLU_SG(a.w, b0.w);
                    y[4] = bf2f(zz.z & 0xffff) * GLU_SG(b.x, b1.x); y[5] = bf2f(zz.z >> 16) * GLU_SG(b.y, b1.y); y[6] = bf2f(zz.w & 0xffff) * GLU_SG(b.z, b1.z); y[7] = bf2f(zz.w >> 16) * GLU_SG(b.w, b1.w);
#undef GLU_SG
                    { float sq = ss[ai][m];
#pragma unroll
                      for (int e = 0; e < 8; ++e) sq = __builtin_fmaf(y[e], y[e], sq);
                      ss[ai][m] = sq; }
                    u32x4 w; w.x = cvtpk(y[0], y[1]); w.y = cvtpk(y[2], y[3]); w.z = cvtpk(y[4], y[5]); w.w = cvtpk(y[6], y[7]);
                    *(u32x4*)(MIX + row * PX + c0) = w; } }
#pragma unroll
        for (int ai = 0; ai < 2; ++ai)
#pragma unroll
            for (int m = 0; m < 4; ++m) { float v = xor32_sum(xor16_sum(ss[ai][m]));
                if (fq == 0) atomicAdd(SSQ + (u.pm * BM + ai * HALF + wr * 64 + m * 16 + fr), v); }
    }
};
struct EpiX1B {
    static constexpr bool HALFN = false, HOOKS = true, PERM = true;
    const float* RSTDX; bf16* X1B; const float* SSQS; const float* SSQA; LAS float* RSC;
    __device__ __forceinline__ void begin(const Unit&, int, int) const {}
    __device__ __forceinline__ void fill(int ui, int pm, int tid) const {
        if (tid < 256) { const int row = pm * BM + tid; const float rs = __builtin_amdgcn_rsqf(SSQS[row] * (1.f / 512.f) + EPS), ra = __builtin_amdgcn_rsqf(SSQA[row] * (1.f / 512.f) + EPS);
            LAS float* d = RSC + (ui * 256 + tid) * 3; d[0] = rs * __builtin_amdgcn_rcpf(ra); d[1] = ra; d[2] = __builtin_amdgcn_rcpf(RSTDX[row]); }
    }
    __device__ __forceinline__ void mid(Acc& acc, int ui, int wr, int fr) const {
#pragma unroll
        for (int ai = 0; ai < 2; ++ai)
#pragma unroll
            for (int m = 0; m < 4; ++m) { const float f = RSC[(ui * 256 + ai * HALF + wr * 64 + m * 16 + fr) * 3];
#pragma unroll
                for (int bj = 0; bj < 2; ++bj)
#pragma unroll
                    for (int n = 0; n < 2; ++n) acc[ai][bj][m][n] = acc[ai][bj][m][n] * f; }
    }
    __device__ __forceinline__ void fin(const Acc& acc, const Unit& u, int ui, int wr, int wc, int fr, int fq) const {
#pragma unroll
        for (int ai = 0; ai < 2; ++ai)
#pragma unroll
            for (int m = 0; m < 4; ++m) { const int rl = ai * HALF + wr * 64 + m * 16 + fr; const LAS float* rc = RSC + (ui * 256 + rl) * 3; const float ra = rc[1], ix = rc[2];
                const size_t ro = (size_t)(u.pm * BM + rl) * PX + u.pn * BM + 64 * wc + 8 * fq;
                u32x4 p[2];
#pragma unroll
                for (int bj = 0; bj < 2; ++bj) { const u32x4 xn = *(const u32x4*)(X1B + ro + 32 * bj);
                    const f32x4 xa = (f32x4){bf2f(xn.x & 0xffff), bf2f(xn.x >> 16), bf2f(xn.y & 0xffff), bf2f(xn.y >> 16)} * ix, xb = (f32x4){bf2f(xn.z & 0xffff), bf2f(xn.z >> 16), bf2f(xn.w & 0xffff), bf2f(xn.w >> 16)} * ix;
                    const f32x4 a = xa + acc[ai][bj][m][0] * ra, b = xb + acc[ai][bj][m][1] * ra;
                    p[bj].x = cvtpk(a.x, a.y); p[bj].y = cvtpk(a.z, a.w); p[bj].z = cvtpk(b.x, b.y); p[bj].w = cvtpk(b.z, b.w); }
                store_pair(X1B + (size_t)(u.pm * BM + (rl & ~1)) * PX + u.pn * BM + 64 * wc, PX, p[0], p[1], fr, fq); }
    }
};
struct EpiGU {
    static constexpr bool HALFN = false, HOOKS = true, PERM = true;
    __device__ __forceinline__ void begin(const Unit&, int, int) const {}
    __device__ __forceinline__ void mid(Acc&, int, int, int) const {}
    unsigned char* HH; const LAS unsigned* RCW;
    __device__ __forceinline__ void fin(const Acc& acc, const Unit& u, int ui, int wr, int wc, int fr, int fq) const {
#pragma unroll
        for (int ai = 0; ai < 2; ++ai)
#pragma unroll
            for (int m = 0; m < 4; ++m) { const int rl = ai * HALF + wr * 64 + m * 16 + fr, rr = u.pm * BM + rl; const size_t off = (size_t)rr * DE + u.pn * 128 + 32 * wc + 8 * fq;
                const float sc = __uint_as_float(RCW[ui * 256 + rl] & 0xffff0000u) * (1.f / W8SC), k1 = sc * -1.4426950408889634f, sc2 = sc * sc;
#define GU_H(g_, u_) (((g_) * (u_)) * __builtin_amdgcn_rcpf(1.f + __builtin_amdgcn_exp2f((g_) * k1)) * sc2)
                float hv[8];
#pragma unroll
                for (int n = 0; n < 2; ++n) { const f32x4 gt = acc[ai][0][m][n], up = acc[ai][1][m][n];
                    hv[4 * n] = GU_H(gt.x, up.x); hv[4 * n + 1] = GU_H(gt.y, up.y); hv[4 * n + 2] = GU_H(gt.z, up.z); hv[4 * n + 3] = GU_H(gt.w, up.w); }
#undef GU_H
                u32x2 w; w.x = pk4_fp8(hv[0], hv[1], hv[2], hv[3]); w.y = pk4_fp8(hv[4], hv[5], hv[6], hv[7]);
                *(u32x2*)(HH + off) = w; }
    }
};
struct EpiDown {
    static constexpr bool HALFN = false, HOOKS = true, PERM = true;
    __device__ __forceinline__ void begin(const Unit&, int, int) const {}
    __device__ __forceinline__ void mid(Acc&, int, int, int) const {}
    unsigned char* YE; const LAS float* RGC;
    __device__ __forceinline__ void fin(const Acc& acc, const Unit& u, int ui, int wr, int wc, int fr, int fq) const {
#pragma unroll
        for (int ai = 0; ai < 2; ++ai)
#pragma unroll
            for (int m = 0; m < 4; ++m) { const int rl = ai * HALF + wr * 64 + m * 16 + fr; const float gw_ = RGC[ui * 256 + rl] * (YE_SCALE / W8SC);
                u32x2 p[2];
#pragma unroll
                for (int bj = 0; bj < 2; ++bj) { const f32x4 a = acc[ai][bj][m][0] * gw_, b = acc[ai][bj][m][1] * gw_; p[bj].x = pk4_fp8(a.x, a.y, a.z, a.w); p[bj].y = pk4_fp8(b.x, b.y, b.z, b.w); }
                const bool od = fq & 1; const u32x2 send = od ? p[0] : p[1]; u32x2 recv; recv.x = xor16_get(send.x, od); recv.y = xor16_get(send.y, od);
                u32x4 w; if (od) { w.x = recv.x; w.y = recv.y; w.z = p[1].x; w.w = p[1].y; } else { w.x = p[0].x; w.y = p[0].y; w.z = recv.x; w.w = recv.y; }
                *(u32x4*)(YE + (size_t)(u.pm * BM + rl) * DM + u.pn * BM + 64 * wc + (od ? 32 : 0) + 8 * (fq & ~1)) = w; }
    }
};

template <int K> __device__ __forceinline__ const float* karg() {
    const float* p;
    asm volatile("s_load_dwordx2 %0, %1, %2\n\ts_waitcnt lgkmcnt(0)" : "=s"(p) : "s"(__builtin_amdgcn_kernarg_segment_ptr()), "i"(K * 8) : "memory");
    return p;
}
struct Args { const float* in[26]; float* out; unsigned char* ws; int ph_lo, ph_hi; };
struct Frame { LAS unsigned char* lds; volatile LAS unsigned* MISC; unsigned* ctl; int tid, lane, wave, G, c; };

struct TItem { const float* W; int ldw, srccol0; const float* kscale; bf16* WT; int ldt, dstrow0, k0; int fp8; };
__device__ __forceinline__ void titem_load(const TItem& t, int lane, f32x4 (&v)[8]) {
#pragma unroll
    for (int i = 0; i < 8; ++i) { const int kk = 8 * i + (lane >> 3); v[i] = *(const GAS f32x4*)(t.W + (size_t)(t.k0 + kk) * t.ldw + t.srccol0 + (lane & 7) * 4); }
}
__device__ __forceinline__ void titem_store(const TItem& t, int lane, const f32x4 (&v)[8], LAS float* scr) {
#pragma unroll
    for (int i = 0; i < 8; ++i) { const int kk = 8 * i + (lane >> 3); const float sc = t.kscale ? t.kscale[t.k0 + kk] : 1.f; LAS float* d = scr + kk * 33 + (lane & 7) * 4;
        d[0] = v[i].x * sc; d[1] = v[i].y * sc; d[2] = v[i].z * sc; d[3] = v[i].w * sc; }
    asm volatile("s_waitcnt lgkmcnt(0)" ::: "memory");
    const int c = lane & 7;
#pragma unroll
    for (int j = 0; j < 4; ++j) { const int n = (lane >> 3) + 8 * j; const LAS float* s = scr + (8 * c) * 33 + n;
        if (t.fp8) { u32x2 o; o.x = pk4_fp8(s[0 * 33] * W8SC, s[1 * 33] * W8SC, s[2 * 33] * W8SC, s[3 * 33] * W8SC); o.y = pk4_fp8(s[4 * 33] * W8SC, s[5 * 33] * W8SC, s[6 * 33] * W8SC, s[7 * 33] * W8SC);
            *(u32x2*)((unsigned char*)t.WT + (size_t)(t.dstrow0 + n) * t.ldt + t.k0 + 8 * c) = o; }
        else { u32x4 o; o.x = pk2(s[0 * 33], s[1 * 33]); o.y = pk2(s[2 * 33], s[3 * 33]); o.z = pk2(s[4 * 33], s[5 * 33]); o.w = pk2(s[6 * 33], s[7 * 33]);
            *(u32x4*)(t.WT + (size_t)(t.dstrow0 + n) * t.ldt + t.k0 + 8 * c) = o; } }
    asm volatile("s_waitcnt lgkmcnt(0)" ::: "memory");
}
__device__ __forceinline__ void s5_tables_item(Frame& F, const Args& a, int g, int part) {
    const float* lre = karg<3>(); const float* lim = karg<4>(); const float* ldt = karg<5>(); const float* bre = karg<6>(); const float* bim = karg<7>();
    const float* cre = karg<8>(); const float* cim = karg<9>(); const float* dsk = karg<10>();
    LAS float* PWr = (LAS float*)F.lds; LAS float* PWi = PWr + 33 * 64; LAS float* BBr = PWi + 33 * 64; LAS float* BBi = BBr + 1024; LAS float* CCr = BBi + 1024; LAS float* CCi = CCr + 1024; LAS float* CF = CCi + 1024;
    const int tid = F.tid;
    if (tid < 64) { const int p = tid;
        const double dt = exp((double)ldt[g]), lr = lre[g * PST + p], li = lim[g * PST + p];
        double sn, cs; sincos_d(li * dt, sn, cs); const double mag = exp(lr * dt);
        const double ar = mag * cs, ai = mag * sn, den = lr * lr + li * li, nr = ar - 1.0, ni = ai;
        CF[2 * p] = (float)((nr * lr + ni * li) / den); CF[2 * p + 1] = (float)((ni * lr - nr * li) / den);
        double pr = 1.0, pi = 0.0;
        for (int l = 0; l <= 32; ++l) { PWr[l * 64 + p] = (float)pr; PWi[l * 64 + p] = (float)pi; if (l == 32 && part == 0) { float* A32 = (float*)(a.ws + FW_A32) + (g * PST + p) * 2; A32[0] = (float)pr; A32[1] = (float)pi; }
            const double t = pr * ar - pi * ai; pi = pr * ai + pi * ar; pr = t; }
    }
    __syncthreads();
    for (int idx = tid; idx < 1024; idx += NTHR) { const int p = idx >> 4; const float cfr = CF[2 * p], cfi = CF[2 * p + 1], br = bre[(size_t)g * 1024 + idx], bi = bim[(size_t)g * 1024 + idx];
        BBr[idx] = cfr * br - cfi * bi; BBi[idx] = cfr * bi + cfi * br; CCr[idx] = cre[(size_t)g * 1024 + idx]; CCi[idx] = cim[(size_t)g * 1024 + idx]; }
    __syncthreads();
    bf16* TBg = (bf16*)(a.ws + FW_TB) + (size_t)g * 512 * U2P; bf16* W1g = (bf16*)(a.ws + FW_W1) + (size_t)g * 256 * 512;
    for (int l = part; l < 32; l += 8) {
        if (tid < 256) { const int h = tid >> 4, hp = tid & 15; float k = 0.f;
#pragma unroll 16
            for (int p = 0; p < 64; ++p) { const float wr_ = PWr[l * 64 + p], wi_ = PWi[l * 64 + p], br = BBr[p * 16 + hp], bi = BBi[p * 16 + hp];
                k += CCr[h * 64 + p] * (wr_ * br - wi_ * bi) - CCi[h * 64 + p] * (wr_ * bi + wi_ * br); }
            if (l == 0 && h == hp) k += dsk[g * 16 + h];
            const bf16 v = (bf16)f2bf(k);
            for (int i = l; i < 32; ++i) TBg[(size_t)(i * 16 + h) * U2P + (i - l) * 16 + hp] = v;
            if (l >= 1) for (int i = 0; i < 32 - l; ++i) TBg[(size_t)(i * 16 + h) * U2P + (i + l) * 16 + hp] = 0;
        } else { const int t2 = tid - 256;
#pragma unroll
            for (int x = 0; x < 8; ++x) { const int e = t2 * 8 + x;
                { const int h = e >> 7, q = e & 127, p = q & 63; const float cr = CCr[h * 64 + p], ci = CCi[h * 64 + p], wr_ = PWr[(l + 1) * 64 + p], wi_ = PWi[(l + 1) * 64 + p];
                  const float re = cr * wr_ - ci * wi_, im = cr * wi_ + ci * wr_; TBg[(size_t)(l * 16 + h) * U2P + 512 + q] = (bf16)f2bf(q < 64 ? re : -im); }
                { const int rho = e >> 4, hp = e & 15, p = rho & 63; const float wr_ = PWr[(31 - l) * 64 + p], wi_ = PWi[(31 - l) * 64 + p], br = BBr[p * 16 + hp], bi = BBi[p * 16 + hp];
                  const float re = wr_ * br - wi_ * bi, im = wr_ * bi + wi_ * br; W1g[(size_t)rho * 512 + l * 16 + hp] = (bf16)f2bf(rho < 64 ? re : im); W1g[(size_t)(128 + rho) * 512 + l * 16 + hp] = 0; }
            }
        }
    }
    __syncthreads();
}
#ifndef XNR
#define XNR 8
#endif
__device__ __forceinline__ void p0_prologue(Frame& F, const Args& a) {
    const float* x = karg<0>();
    const bool stag = (F.G == 256);
    const int slot = stag ? (F.c % 3) : 0;
    LAS float* scr = (LAS float*)(F.lds + F.wave * 16384);
    const int gw = F.c * NWAVES + F.wave, NGW = F.G * NWAVES;
    constexpr int I_IN = 16 * 64, I_GLU = 8 * 16, I_OUT = 16 * 32, I_GU = 32 * 16 * 32, I_D = 32 * 8 * 32, NITEMS = I_IN + I_GLU + I_OUT + I_GU + I_D;
    bf16* WIN = (bf16*)(a.ws + FW_WIN); bf16* WGLU = (bf16*)(a.ws + FW_WGLU); bf16* WOUT = (bf16*)(a.ws + FW_WOUT); bf16* WGU = (bf16*)(a.ws + FW_WGU); bf16* WD = (bf16*)(a.ws + FW_WD);
    auto mkitem = [&](int it) -> TItem {
        int r = it;
        if (r < I_IN) { const int kb = r >> 6, d = r & 63, pn = d >> 3, beta = d & 7, bj = beta >> 2, wc = beta & 3;
            return TItem{karg<2>(), DIN, 256 * pn + 32 * (2 * wc + bj), karg<1>(), WIN, PW, 32 * d, 64 * kb, 0}; } r -= I_IN;
        if (r < I_GLU) { const int kb = r >> 4, d = r & 15; return TItem{karg<11>(), DSSM, 32 * d, nullptr, WGLU, DSSM, 32 * d, 64 * kb, 0}; } r -= I_GLU;
        if (r < I_OUT) { const int kb = r >> 5, d = r & 31; const float* ks = (kb < 8) ? karg<15>() : (karg<16>() - 512);
            return TItem{karg<17>(), DM, 32 * (8 * (d >> 3) + 2 * (d & 3) + ((d & 7) >> 2)), ks, WOUT, PW, 32 * d, 64 * kb, 0}; } r -= I_OUT;
        if (r < I_GU) { const int e = r >> 9, q = r & 511, kb = q >> 5, d = q & 31, pn = d >> 3, beta = d & 7;
            const float* W = (beta < 4 ? karg<23>() : karg<24>()) + (size_t)e * DM * DE;
            return TItem{W, DE, 128 * pn + 32 * (beta & 3), karg<18>(), (bf16*)((unsigned char*)WGU + (size_t)e * DM * DM), DM, 32 * d, 64 * kb, 1}; } r -= I_GU;
        const int e = r >> 8, q = r & 255, kb = q >> 5, d = q & 31;
        return TItem{karg<25>() + (size_t)e * DE * DM, DM, 32 * (8 * (d >> 3) + 2 * (d & 3) + ((d & 7) >> 2)), nullptr, (bf16*)((unsigned char*)WD + (size_t)e * DM * DE), DE, 32 * d, 64 * kb, 1};
    };
    bf16* XN = (bf16*)(a.ws + FW_XN); float* RSTDX = (float*)(a.ws + FW_RSTDX);
    auto xn_trip = [&](int m0) {
        f32x4 v[XNR][4];
#pragma unroll
        for (int rr = 0; rr < XNR; ++rr) { const GAS f32x4* xr = (const GAS f32x4*)(x + (size_t)(m0 + rr) * DM);
            v[rr][0] = __builtin_nontemporal_load(xr + 2 * F.lane); v[rr][1] = __builtin_nontemporal_load(xr + 2 * F.lane + 1);
            v[rr][2] = __builtin_nontemporal_load(xr + 128 + 2 * F.lane); v[rr][3] = __builtin_nontemporal_load(xr + 128 + 2 * F.lane + 1); }
#pragma unroll
        for (int rr = 0; rr < XNR; ++rr) { float s = 0.f;
#pragma unroll
            for (int j = 0; j < 4; ++j) s += v[rr][j].x * v[rr][j].x + v[rr][j].y * v[rr][j].y + v[rr][j].z * v[rr][j].z + v[rr][j].w * v[rr][j].w;
            const float rstd = __builtin_amdgcn_rsqf(wave_sum(s) * (1.f / DM) + EPS);
            if (F.lane == 0) RSTDX[m0 + rr] = rstd;
            u32x4* o = (u32x4*)(XN + (size_t)(m0 + rr) * PX);
#pragma unroll
            for (int j = 0; j < 2; ++j) { const f32x4 a = v[rr][2 * j] * rstd, b = v[rr][2 * j + 1] * rstd; u32x4 w; w.x = cvtpk(a.x, a.y); w.y = cvtpk(a.z, a.w); w.z = cvtpk(b.x, b.y); w.w = cvtpk(b.z, b.w); o[64 * j + F.lane] = w; } }
    };
    if (slot == 0) { for (int it = F.c; it < 256; it += F.G) s5_tables_item(F, a, it >> 3, it & 7); }
    if (gw < NITEMS) {
        TItem cur = mkitem(gw); f32x4 vc[8]; titem_load(cur, F.lane, vc);
        for (int it = gw; it < NITEMS; it += NGW) {
            const bool more = it + NGW < NITEMS; TItem nxt = cur; f32x4 vn[8];
            if (more) { nxt = mkitem(it + NGW); titem_load(nxt, F.lane, vn); }
            titem_store(cur, F.lane, vc, scr);
            if (more) { cur = nxt;
#pragma unroll
                for (int i = 0; i < 8; ++i) vc[i] = vn[i]; }
        }
    }
    { bf16* WR = (bf16*)(a.ws + FW_WR);
      for (int idx = F.c * NTHR + F.tid; idx < 64 * DM; idx += F.G * NTHR) { const int n = idx >> 10, k = idx & 1023;
          float v = 0.f; if (n < 4) v = karg<19>()[k * 4 + n]; else if (n < 36) v = karg<21>()[k * 32 + (n - 4)];
          WR[idx] = (bf16)f2bf(v * karg<18>()[k]); } }
    if (!stag) { for (int m0 = gw * XNR; m0 < M; m0 += NGW * XNR) xn_trip(m0); return; }
    if (slot == 1) { __syncthreads(); s5_tables_item(F, a, F.c >> 3, F.c & 7); }
    xn_trip(gw * XNR); xn_trip(gw * XNR + NGW * XNR);
    if (slot == 2) { __syncthreads(); s5_tables_item(F, a, F.c >> 3, F.c & 7); }
    xn_trip(gw * XNR + 2 * NGW * XNR); xn_trip(gw * XNR + 3 * NGW * XNR);
}

__device__ __forceinline__ void s5_scan_local(Frame& F, const Args& a, int g, int pm) {
    const float* SST = (const float*)(a.ws + FW_SST); bf16* U2 = (bf16*)(a.ws + FW_U2);
    if (F.tid < 256) {
        const int p = F.tid & 63;
        const float* A32 = (const float*)(a.ws + FW_A32) + (g * PST + p) * 2; const float ar = A32[0], ai = A32[1];
        float xr = 0.f, xi = 0.f;
        const size_t row0 = (size_t)g * NCH + (size_t)pm * 256 + (size_t)(F.tid >> 6) * 64;
        for (int c0 = 0; c0 < 64; c0 += 16) {
            float sr[16], si[16];
#pragma unroll
            for (int j = 0; j < 16; ++j) { sr[j] = SST[(row0 + c0 + j) * 128 + p]; si[j] = SST[(row0 + c0 + j) * 128 + 64 + p]; }
#pragma unroll
            for (int j = 0; j < 16; ++j) { bf16* up = U2 + (row0 + c0 + j) * U2P + 512; up[p] = (bf16)f2bf(xr); up[64 + p] = (bf16)f2bf(xi);
                const float t = ar * xr - ai * xi + sr[j]; xi = ar * xi + ai * xr + si[j]; xr = t; }
        }
    }
}
__device__ __forceinline__ void s5_scan(Frame& F, const Args& a) {
    const float* SST = (const float*)(a.ws + FW_SST); bf16* U2 = (bf16*)(a.ws + FW_U2);
    for (int idx = F.c * NTHR + F.tid; idx < BATCH * NG * PST; idx += F.G * NTHR) {
        const int p = idx & 63, g = (idx >> 6) & 31, b = idx >> 11;
        const double dt = exp((double)karg<5>()[g]), lr = karg<3>()[g * PST + p], li = karg<4>()[g * PST + p];
        double sn, cs; sincos_d(32.0 * li * dt, sn, cs); const double mag = exp(32.0 * lr * dt);
        const float ar = (float)(mag * cs), ai = (float)(mag * sn);
        float xr = 0.f, xi = 0.f;
        const size_t row0 = (size_t)g * NCH + (size_t)b * 64;
        for (int c0 = 0; c0 < 64; c0 += 16) {
            float sr[16], si[16];
#pragma unroll
            for (int j = 0; j < 16; ++j) { sr[j] = SST[(row0 + c0 + j) * 128 + p]; si[j] = SST[(row0 + c0 + j) * 128 + 64 + p]; }
#pragma unroll
            for (int j = 0; j < 16; ++j) { bf16* up = U2 + (row0 + c0 + j) * U2P + 512; up[p] = (bf16)f2bf(xr); up[64 + p] = (bf16)f2bf(xi);
                const float t = ar * xr - ai * xi + sr[j]; xi = ar * xi + ai * xr + si[j]; xr = t; }
        }
    }
}

#ifndef ATT_THR_V
#define ATT_THR_V -32.f
#endif
constexpr float ATT_THR = ATT_THR_V;
__device__ __forceinline__ s16x4 vtr(const LAS unsigned char* p) { typedef short v4i16_t __attribute__((ext_vector_type(4))); return __builtin_bit_cast(s16x4, __builtin_amdgcn_ds_read_tr16_b64_v4i16((LAS v4i16_t*)p)); }
__device__ __forceinline__ int crow(int r, int hi) { return (r & 3) + 8 * (r >> 2) + 4 * hi; }
#define MFMA32(a, b, c) __builtin_amdgcn_mfma_f32_32x32x16_bf16((a), (b), (c), 0, 0, 0)
template <bool DIAG, int P, int KH, int KD, int VD>
__device__ __forceinline__ float attn_half(const LAS unsigned char* Kb, const LAS unsigned char* Vb, const bf16x8 (&qr)[4], const bf16x8 (&tri)[2], f32x16 (&o)[2], float base, int lim, int lane) {
    const int r32 = lane & 31, hi = lane >> 5;
    const LAS unsigned char* kp = Kb + hi * KH + r32 * 16 + P * 512;
    const int lim2 = lim - 4 * hi;
    f32x16 z = {};
#pragma unroll
    for (int d0 = 0; d0 < 4; ++d0) { const bf16x8 kf = *(const LAS bf16x8*)(kp + d0 * KD); z = MFMA32(kf, qr[d0], z); }
    float l[16];
#pragma unroll
    for (int r = 0; r < 16; ++r) { l[r] = -__builtin_amdgcn_logf(1.f + __builtin_amdgcn_exp2f(z[r])); if (DIAG) { if (!((r & 3) + 8 * (r >> 2) + 32 * P < lim2)) l[r] = 0.f; } }
    u32x4 wa, wb;
    wa.x = cvtpk(l[0], l[1]); wa.y = cvtpk(l[2], l[3]); wa.z = cvtpk(l[4], l[5]); wa.w = cvtpk(l[6], l[7]);
    wb.x = cvtpk(l[8], l[9]); wb.y = cvtpk(l[10], l[11]); wb.z = cvtpk(l[12], l[13]); wb.w = cvtpk(l[14], l[15]);
    const bf16x8 La = __builtin_bit_cast(bf16x8, wa), Lb = __builtin_bit_cast(bf16x8, wb);
    f32x16 T = {};
    T = MFMA32(tri[0], La, T); T = MFMA32(tri[1], Lb, T);
    float av[16];
#pragma unroll
    for (int r = 0; r < 16; ++r) { av[r] = __builtin_amdgcn_exp2f((z[r] + base) + T[r]); if (DIAG) { if (!((r & 3) + 8 * (r >> 2) + 32 * P < lim2)) av[r] = 0.f; } }
    wa.x = cvtpk(av[0], av[1]); wa.y = cvtpk(av[2], av[3]); wa.z = cvtpk(av[4], av[5]); wa.w = cvtpk(av[6], av[7]);
    wb.x = cvtpk(av[8], av[9]); wb.y = cvtpk(av[10], av[11]); wb.z = cvtpk(av[12], av[13]); wb.w = cvtpk(av[14], av[15]);
    const bf16x8 Pa = __builtin_bit_cast(bf16x8, wa), Pb = __builtin_bit_cast(bf16x8, wb);
    const LAS unsigned char* vp = Vb + ((lane >> 4) & 1) * 32 + (lane & 3) * 8 + (4 * hi + ((lane & 15) >> 2)) * 64 + P * 2048;
#pragma unroll
    for (int d0 = 0; d0 < 2; ++d0) {
        const s16x4 lo0 = vtr(vp + d0 * VD), hi0 = vtr(vp + d0 * VD + 512), lo1 = vtr(vp + d0 * VD + 1024), hi1 = vtr(vp + d0 * VD + 1536);
        const bf16x8 v0 = {lo0[0], lo0[1], lo0[2], lo0[3], hi0[0], hi0[1], hi0[2], hi0[3]}, v1 = {lo1[0], lo1[1], lo1[2], lo1[3], hi1[0], hi1[1], hi1[2], hi1[3]};
        o[d0] = MFMA32(Pa, v0, o[d0]); o[d0] = MFMA32(Pb, v1, o[d0]);
    }
    { const unsigned u = __builtin_bit_cast(unsigned, T[0]); auto r = __builtin_amdgcn_permlane32_swap(u, u, false, false); return __builtin_bit_cast(float, (unsigned)r[0]); }
}
#ifndef ASPAN_N
#define ASPAN_N 13
#endif
constexpr int ASPAN = ASPAN_N;
__device__ __forceinline__ void attn_span_phase(Frame& F, const bf16* Q, const bf16* Kg, const bf16* Vg, bf16* MIX, float* SSQA) {
    const int lane = F.lane, wid = F.wave, r32 = lane & 31, hi = lane >> 5;
    volatile LAS int* FLG = (volatile LAS int*)(F.lds + ASPAN * 8192 + 8 * 4096);
    bf16x8 tri[2];
#pragma unroll
    for (int s = 0; s < 2; ++s)
#pragma unroll
        for (int j = 0; j < 8; ++j) tri[s][j] = ((16 * s + 8 * (j >> 2) + 4 * hi + (j & 3)) >= r32) ? (short)0x3F80 : (short)0;
    for (int L = F.c; L < BATCH * NH * 8; L += F.G) {
        const int bh = L >> 3, qb = L & 7, b = bh >> 3, h = bh & 7, a0 = 8 * qb, a = a0 + wid;
        const size_t row0 = (size_t)b * SEQ; const int qg = 32 * a + r32;
        bf16x8 qr[4];
#pragma unroll
        for (int d0 = 0; d0 < 4; ++d0) qr[d0] = *(const bf16x8*)(Q + (row0 + qg) * DATT + h * HD + d0 * 16 + hi * 8);
        const bf16* src = (wid < 4) ? (Kg + (row0 + (lane & 31)) * DATT + h * HD + (lane >> 5) * 8 + 16 * wid)
                                    : (Vg + (row0 + 16 * (wid & 1) + (lane >> 2)) * DATT + h * HD + (lane & 3) * 8 + 32 * ((wid - 4) >> 1));
        const int dsto = (wid < 4) ? wid * 1024 : 4096 + (wid - 4) * 1024;
        f32x16 o[2] = {}; float Rc = 0.f; bool done = false;
        for (int k = 0;; ++k) {
            const int top = a0 + 7 - ASPAN * k, bot = (top - (ASPAN - 1) > 0) ? top - (ASPAN - 1) : 0;
#pragma unroll 1
            for (int jj = top; jj >= bot; --jj)
                __builtin_amdgcn_global_load_lds((const unsigned*)(src + (size_t)(32 * jj) * DATT), (LAS unsigned*)(F.lds + (top - jj) * 8192 + dsto), 16, 0, 0);
            asm volatile("s_waitcnt vmcnt(0)" ::: "memory");
            __syncthreads();
            if (!done) {
                for (int jj = (a < top ? a : top); jj >= bot; --jj) {
                    const LAS unsigned char* Kb = F.lds + (top - jj) * 8192; const LAS unsigned char* Vb = Kb + 4096;
                    const int lim = qg - 32 * jj;
                    float sh;
                    if (jj == a) sh = attn_half<true, 0, 512, 1024, 2048>(Kb, Vb, qr, tri, o, Rc, lim, lane);
                    else sh = attn_half<false, 0, 512, 1024, 2048>(Kb, Vb, qr, tri, o, Rc, lim, lane);
                    Rc += sh;
                    if (jj == 0 || __all(Rc < ATT_THR)) { done = true; break; }
                }
            }
            if (lane == 0) FLG[wid] = done ? 1 : 0;
            asm volatile("s_waitcnt lgkmcnt(0)" ::: "memory");
            __syncthreads();
            if (bot == 0) break;
            int alld = 1;
#pragma unroll
            for (int w = 0; w < 8; ++w) alld &= FLG[w];
            if (alld) break;
        }
        { LAS unsigned char* stg = F.lds + ASPAN * 8192 + wid * 4096; LAS unsigned short* sp = (LAS unsigned short*)(stg + hi * 512 + r32 * 2);
#pragma unroll
          for (int r = 0; r < 16; ++r) { const int ro = ((r & 3) + 8 * (r >> 2)) * 64; sp[ro] = (unsigned short)f2bf(o[0][r]); sp[ro + 32] = (unsigned short)f2bf(o[1][r]); }
          asm volatile("s_waitcnt lgkmcnt(0)" ::: "memory");
          bf16* ow = MIX + (row0 + 32 * a) * PX + 512 + h * HD;
#pragma unroll
          for (int i = 0; i < 4; ++i) { const int row = i * 8 + (lane >> 3), ch = lane & 7; const u32x4 v = *(const LAS u32x4*)(stg + row * 128 + ch * 16); *(u32x4*)(ow + (size_t)row * PX + ch * 8) = v;
              const float f0 = bf2f(v.x & 0xffff), f1 = bf2f(v.x >> 16), f2 = bf2f(v.y & 0xffff), f3 = bf2f(v.y >> 16), f4 = bf2f(v.z & 0xffff), f5 = bf2f(v.z >> 16), f6 = bf2f(v.w & 0xffff), f7 = bf2f(v.w >> 16);
              float ss = ((f0 * f0 + f1 * f1) + (f2 * f2 + f3 * f3)) + ((f4 * f4 + f5 * f5) + (f6 * f6 + f7 * f7));
              ss += dppf<0xB1>(ss); ss += dppf<0x4E>(ss); ss += dppf<0x141>(ss);
              if (ch == 0) atomicAdd(SSQA + (row0 + 32 * a + row), ss); }
          asm volatile("s_waitcnt lgkmcnt(0)" ::: "memory"); }
    }
    asm volatile("s_waitcnt vmcnt(0)" ::: "memory");
    __syncthreads();
}
static_assert(ASPAN * 8192 + 8 * 4096 + 64 <= MISC_OFF, "attention LDS map");

constexpr int RT_PITCH = 2064;
__device__ __forceinline__ void router_phase(Frame& F, const Args& a) {
    const bf16* X1B = (const bf16*)(a.ws + FW_X1B); unsigned char* X1Q = (unsigned char*)(a.ws + FW_X1Q); int* TOK = (int*)(a.ws + FW_TOK); const bf16* WR = (const bf16*)(a.ws + FW_WR);
    const float* brg = karg<20>(); const float* bre_ = karg<22>();
    const int tid = F.tid, lane = F.lane, wid = F.wave, r32 = lane & 31, hi = lane >> 5;
    LAS unsigned char* TILE = F.lds;
    LAS float* PART = (LAS float*)(F.lds + 66048);
    LAS float* LOGIT = (LAS float*)(F.lds + 66048 + 65536);
    LAS int* HIST = (LAS int*)(F.lds + 66048 + 65536 + 5120);
    LAS int* TREC = HIST + 64;
    LAS float* RS = (LAS float*)(TREC + 1024);
    LAS float* TRS = RS + 32;
    LAS float* TRG = TRS + 256;
    LAS float* BIAS = TRG + 512;
    static_assert(66048 + 65536 + 5120 + 256 + 4096 + 128 + 1024 + 2048 + 160 <= MISC_OFF, "router LDS");
    bf16x8 Bf[8][2];
#pragma unroll
    for (int s = 0; s < 8; ++s)
#pragma unroll
        for (int nb = 0; nb < 2; ++nb) Bf[s][nb] = *(const bf16x8*)(WR + (size_t)(32 * nb + r32) * DM + 128 * wid + 16 * s + 8 * hi);
    if (tid < 64) HIST[tid] = 0;
    if (tid >= 64 && tid < 104) { const int c = tid - 64; BIAS[c] = c < 4 ? brg[c] : (c < 36 ? bre_[c - 4] : 0.f); }
    __syncthreads();
    int ntl = 0;
#define RT_BAR() do { asm volatile("s_waitcnt lgkmcnt(0)" ::: "memory"); __builtin_amdgcn_s_barrier(); asm volatile("" ::: "memory"); } while (0)
#define RT_LOAD(tile_) do { _Pragma("unroll") for (int rr = 0; rr < 4; ++rr) { const u32x4* xr = (const u32x4*)(X1B + (size_t)((tile_) * 32 + 4 * wid + rr) * PX); v[rr][0] = xr[lane]; v[rr][1] = xr[64 + lane]; } } while (0)
    u32x4 v[4][2];
    if (F.c < M / 32) RT_LOAD(F.c);
    for (int tile = F.c; tile < M / 32; tile += F.G, ++ntl) {
        {
#pragma unroll
          for (int rr = 0; rr < 4; ++rr) { const int lr = 4 * wid + rr; float s = 0.f;
#pragma unroll
              for (int j = 0; j < 2; ++j) { const u32x4 w = v[rr][j];
                  const float f0 = bf2f(w.x & 0xffff), f1 = bf2f(w.x >> 16), f2 = bf2f(w.y & 0xffff), f3 = bf2f(w.y >> 16), f4 = bf2f(w.z & 0xffff), f5 = bf2f(w.z >> 16), f6 = bf2f(w.w & 0xffff), f7 = bf2f(w.w >> 16);
                  s += (f0 * f0 + f1 * f1) + (f2 * f2 + f3 * f3) + (f4 * f4 + f5 * f5) + (f6 * f6 + f7 * f7);
                  { u32x2 q8; q8.x = pk4_fp8(f0, f1, f2, f3); q8.y = pk4_fp8(f4, f5, f6, f7); *(u32x2*)(X1Q + (size_t)(tile * 32 + lr) * DM + (64 * j + lane) * 8) = q8; }
                  *(LAS u32x4*)(TILE + lr * RT_PITCH + (64 * j + lane) * 16) = w; }
              const float rstd = __builtin_amdgcn_rsqf(wave_sum(s) * (1.f / DM) + EPS);
              if (lane == 0) RS[lr] = rstd; } }
        if (tile + F.G < M / 32) RT_LOAD(tile + F.G);
        RT_BAR();
        { f32x16 c0 = {}, c1 = {};
#pragma unroll
          for (int s = 0; s < 8; ++s) { const bf16x8 af = *(const LAS bf16x8*)(TILE + r32 * RT_PITCH + (128 * wid + 16 * s + 8 * hi) * 2);
              c0 = MFMA32(af, Bf[s][0], c0); c1 = MFMA32(af, Bf[s][1], c1); }
#pragma unroll
          for (int r = 0; r < 16; ++r) { const int t = crow(r, hi); PART[(wid * 32 + t) * 64 + r32] = c0[r]; PART[(wid * 32 + t) * 64 + 32 + r32] = c1[r]; } }
        RT_BAR();
        { const int t = tid >> 4, c4 = (tid & 15) * 4;
          if (c4 < 40) { f32x4 s = {0.f, 0.f, 0.f, 0.f};
#pragma unroll
              for (int w = 0; w < 8; ++w) s += *(const LAS f32x4*)(PART + (w * 32 + t) * 64 + c4);
              *(LAS f32x4*)(LOGIT + t * 40 + c4) = s * RS[t] + *(const LAS f32x4*)(BIAS + c4); } }
        RT_BAR();
        if (tid < 32) { const int m = tile * 32 + tid; float lg[36];
#pragma unroll
            for (int c = 0; c < 36; ++c) lg[c] = LOGIT[tid * 40 + c];
            int gi = 0; float gm = lg[0];
#pragma unroll
            for (int c = 1; c < 4; ++c) if (lg[c] > gm) { gm = lg[c]; gi = c; }
            float gsum = 0.f;
#pragma unroll
            for (int c = 0; c < 4; ++c) gsum += __expf(lg[c] - gm);
            const float pgrp = 1.f / gsum;
            float el[8];
#pragma unroll
            for (int e = 0; e < 8; ++e) { float t = 0.f;
#pragma unroll
                for (int g2 = 0; g2 < 4; ++g2) if (g2 == gi) t = lg[4 + g2 * 8 + e];
                el[e] = t; }
            int i0 = 0; float m0 = el[0];
#pragma unroll
            for (int e = 1; e < 8; ++e) if (el[e] > m0) { m0 = el[e]; i0 = e; }
            int i1 = 0; float m1 = -3.0e38f;
#pragma unroll
            for (int e = 0; e < 8; ++e) if (e != i0 && el[e] > m1) { m1 = el[e]; i1 = e; }
            const float e1 = __expf(m1 - m0), p0 = 1.f / (1.f + e1), p1 = e1 / (1.f + e1);
            const int ex0 = gi * 8 + i0, ex1 = gi * 8 + i1;
            const int rk0 = atomicAdd((int*)&HIST[ex0], 1), rk1 = atomicAdd((int*)&HIST[ex1], 1);
            int* tk = TOK + (size_t)m * 8; tk[0] = ex0; tk[1] = ex1; tk[2] = __float_as_int(pgrp * p0); tk[3] = __float_as_int(pgrp * p1);
            LAS int* tr = TREC + (ntl * 32 + tid) * 4; tr[0] = ex0; tr[1] = ex1; tr[2] = rk0; tr[3] = rk1;
            TRS[ntl * 32 + tid] = RS[tid]; TRG[2 * (ntl * 32 + tid)] = pgrp * p0; TRG[2 * (ntl * 32 + tid) + 1] = pgrp * p1;
        }
        RT_BAR();
    }
#undef RT_BAR
#undef RT_LOAD
    if (tid < 32) { const int cnt = HIST[tid]; int base = 0; if (cnt > 0) base = (int)__hip_atomic_fetch_add(F.ctl + CW_CNT + tid, (unsigned)cnt, RLX_AGENT); HIST[32 + tid] = base; }
    __syncthreads();
    unsigned* ETOK = (unsigned*)(a.ws + FW_ETOK); float* EG = (float*)(a.ws + FW_EG);
    for (int i = tid; i < ntl * 32; i += NTHR) { const int tile = F.c + (i >> 5) * F.G, m = tile * 32 + (i & 31); const LAS int* tr = TREC + i * 4;
        int* tk = TOK + (size_t)m * 8; const int s0 = HIST[32 + tr[0]] + tr[2], s1 = HIST[32 + tr[1]] + tr[3]; tk[4] = s0; tk[5] = s1;
        const unsigned word = (unsigned)m | (f2bf(TRS[i]) << 16);
        ETOK[(size_t)tr[0] * M + s0] = word; ETOK[(size_t)tr[1] * M + s1] = word; EG[(size_t)tr[0] * M + s0] = TRG[2 * i]; EG[(size_t)tr[1] * M + s1] = TRG[2 * i + 1]; }
    __syncthreads();
}
__device__ __forceinline__ int moe_tables(Frame& F) {
    LAS int* TST = (LAS int*)(F.lds + SCR2_OFF); LAS unsigned char* T2E = F.lds + SCR2_OFF + 256;
    if (F.tid < 64) {
        const int e = F.tid; int nt = 0;
        if (e < NE) { const int cnt = (int)__hip_atomic_load(F.ctl + CW_CNT + e, RLX_AGENT); nt = (cnt + 255) >> 8; TST[208 + e] = cnt; }
        int incl = nt;
#pragma unroll
        for (int o = 1; o < 32; o <<= 1) { const int v = __shfl_up(incl, o); if ((e & 31) >= o) incl += v; }
        const int start = incl - nt;
        if (e < NE) { TST[e] = start; for (int t = 0; t < nt; ++t) T2E[start + t] = (unsigned char)e; }
        if (e == NE - 1) TST[NE] = incl;
    }
    __syncthreads();
    return TST[NE];
}
#ifndef CTPT
#define CTPT 4
#endif
__device__ __forceinline__ void combine_phase(Frame& F, const Args& a) {
    const unsigned char* YE = (const unsigned char*)(a.ws + FW_YE); const bf16* X1B = (const bf16*)(a.ws + FW_X1B); const int* TOK = (const int*)(a.ws + FW_TOK); float* out = a.out;
    const LAS int* TST = (const LAS int*)(F.lds + SCR2_OFF);
    const int gw = F.c * NWAVES + F.wave, NGW = F.G * NWAVES, lane = F.lane;
    static_assert(CTPT * 8 <= 64, "one routing word per lane");
    int m0 = gw * CTPT;
    int w = 0; if (m0 < M) w = TOK[(size_t)m0 * 8 + (lane & (CTPT * 8 - 1))];
    for (; m0 < M; m0 += NGW * CTPT) {
        const int mn = m0 + NGW * CTPT;
        int wn = 0; if (mn < M) wn = TOK[(size_t)mn * 8 + (lane & (CTPT * 8 - 1))];
        const int tl = TST[w & 31];
        u32x2 xv[CTPT][4]; unsigned y0[CTPT][4], y1[CTPT][4];
#pragma unroll
        for (int t = 0; t < CTPT; ++t) {
            const size_t p0 = (size_t)__builtin_amdgcn_readlane(tl, 8 * t) * 256 + (size_t)__builtin_amdgcn_readlane(w, 8 * t + 4), p1 = (size_t)__builtin_amdgcn_readlane(tl, 8 * t + 1) * 256 + (size_t)__builtin_amdgcn_readlane(w, 8 * t + 5);
            const bf16* xr = X1B + (size_t)(m0 + t) * PX + 4 * lane; const unsigned* ya = (const unsigned*)(YE + p0 * DM) + lane; const unsigned* yb = (const unsigned*)(YE + p1 * DM) + lane;
#pragma unroll
            for (int q = 0; q < 4; ++q) { xv[t][q] = *(const u32x2*)(xr + 256 * q); y0[t][q] = ya[64 * q]; y1[t][q] = yb[64 * q]; } }
#pragma unroll
        for (int t = 0; t < CTPT; ++t) { float* o = out + (size_t)(m0 + t) * DM + 4 * lane;
#pragma unroll
            for (int q = 0; q < 4; ++q) { const unsigned wa = y0[t][q], wb = y1[t][q]; const unsigned xa = xv[t][q].x, xb = xv[t][q].y;
                const f32x2 a0 = __builtin_amdgcn_cvt_pk_f32_fp8((int)wa, false), a1 = __builtin_amdgcn_cvt_pk_f32_fp8((int)wa, true), b0 = __builtin_amdgcn_cvt_pk_f32_fp8((int)wb, false), b1 = __builtin_amdgcn_cvt_pk_f32_fp8((int)wb, true);
                f32x4 r; r.x = bf2f(xa & 0xffff) + (a0.x + b0.x) * (1.f / YE_SCALE); r.y = bf2f(xa >> 16) + (a0.y + b0.y) * (1.f / YE_SCALE);
                r.z = bf2f(xb & 0xffff) + (a1.x + b1.x) * (1.f / YE_SCALE); r.w = bf2f(xb >> 16) + (a1.y + b1.y) * (1.f / YE_SCALE);
                *(f32x4*)(o + 256 * q) = r; } }
        w = wn;
    }
}

#ifndef STG1
#define STG1 0
#endif
#ifndef STG10
#define STG10 0
#endif
#ifndef STG11
#define STG11 0
#endif
#ifndef KREP1
#define KREP1 1
#endif
#ifndef KREP10
#define KREP10 1
#endif
#ifndef KREP11
#define KREP11 1
#endif
constexpr int NPHASE = 13;
__global__ void __launch_bounds__(NTHR, 2) mk_fwd(Args args) {
    extern __shared__ __attribute__((aligned(16))) unsigned char lds_raw[];
    Frame F;
    F.lds = (LAS unsigned char*)lds_raw; F.MISC = (volatile LAS unsigned*)(F.lds + MISC_OFF);
    F.tid = threadIdx.x; F.lane = F.tid & 63; F.wave = __builtin_amdgcn_readfirstlane(F.tid >> 6);
    F.G = gridDim.x; F.c = blockIdx.x; F.ctl = (unsigned*)(args.ws + WS_CTL);
    if (F.tid < 64) F.MISC[F.tid] = 0u;
    __syncthreads();
    XcdBarrier bar = xcd_barrier_post(F.ctl + CW_BAR, F.MISC + 8);
    const int lo = args.ph_lo, hi = args.ph_hi;
    unsigned char* ws = args.ws;
#ifndef PH_MASK
#define PH_MASK 0x1fff
#endif
#define IN(k) ((((PH_MASK) >> (k)) & 1) && lo <= (k) && (k) < hi)
#define SEAM(k) do { if (IN(k) && IN((k) + 1)) xcd_barrier(bar); } while (0)
#define REFRESH() do { int t_ = threadIdx.x; asm volatile("" : "+v"(t_)); F.tid = t_; F.lane = t_ & 63; F.wave = __builtin_amdgcn_readfirstlane(t_ >> 6); } while (0)
#ifndef REP_MASK
#define REP_MASK 0
#endif
#define REPS(k) _Pragma("unroll") for (int rep_ = 0; rep_ < ((((REP_MASK) >> (k)) & 1) ? 2 : 1); ++rep_)
    if (IN(0)) REPS(0) { REFRESH(); p0_prologue(F, args); } SEAM(0);
    if (IN(1)) REPS(1) { REFRESH();
        GemmP g{PX * 2, PW * 2, DM}; DenseOrder S{(const char*)(ws + FW_XN), (const char*)(ws + FW_WIN), (size_t)256 * PX * 2, (size_t)256 * PW * 2, M / 256, DIN / 256, (M / 256) * (DIN / 256), F.G, F.c};
        LAS float* GQK = (LAS float*)(F.lds + SCR2_OFF); if (F.tid < 128) GQK[F.tid] = (F.tid < 64) ? karg<13>()[F.tid] * C2 : karg<14>()[F.tid - 64]; __syncthreads();
        EpiProj E{(bf16*)(ws + FW_U2), (bf16*)(ws + FW_Q), (const LAS float*)GQK};
        gemm_phase<EpiProj, DenseOrder, false, KREP1>(F.lds, g, S, E, nullptr, ((F.c >> 3) & 7) * STG1); } SEAM(1);
    if (IN(2)) REPS(2) { REFRESH();
        GemmP g{U2P * 2, 512 * 2, 512}; GroupOrder S{(const char*)(ws + FW_U2), (const char*)(ws + FW_W1), (size_t)NCH * U2P * 2, (size_t)256 * 512 * 2, (size_t)256 * U2P * 2, 0, NCH / 256, 1, NG * (NCH / 256), F.G, F.c};
        EpiState E{(float*)(ws + FW_SST)};
        gemm_phase(F.lds, g, S, E);
        if (F.G == NG * (NCH / 256)) s5_scan_local(F, args, F.c >> 3, F.c & 7); }
    if (F.G != NG * (NCH / 256)) SEAM(2);
    if (IN(3)) REPS(3) { REFRESH();
#ifndef NO_SCAN
        if (F.G != NG * (NCH / 256)) s5_scan(F, args);
#ifdef REP_SCAN
        s5_scan(F, args);
#endif
#endif
#ifndef NO_ATTN
        const bf16* Q = (const bf16*)(ws + FW_Q); const bf16* Kg = (const bf16*)(ws + FW_K); const bf16* Vg = (const bf16*)(ws + FW_V);
        attn_span_phase(F, Q, Kg, Vg, (bf16*)(ws + FW_MIX), (float*)(F.ctl + CW_SSQA));
#endif
    } SEAM(3);
    if (IN(4)) REPS(4) { REFRESH();
        GemmP g{U2P * 2, U2P * 2, U2P}; GroupOrder S{(const char*)(ws + FW_U2), (const char*)(ws + FW_TB), (size_t)NCH * U2P * 2, (size_t)512 * U2P * 2, (size_t)256 * U2P * 2, (size_t)256 * U2P * 2, NCH / 256, 2, NG * (NCH / 256) * 2, F.G, F.c};
        EpiS5 E{(bf16*)(ws + FW_Z)};
        gemm_phase(F.lds, g, S, E); } SEAM(4);
    if (IN(5)) REPS(5) { REFRESH();
        GemmP g{DSSM * 2, DSSM * 2, DSSM}; DenseOrder S{(const char*)(ws + FW_Z), (const char*)(ws + FW_WGLU), (size_t)256 * DSSM * 2, (size_t)256 * DSSM * 2, M / 256, 2, (M / 256) * 2, F.G, F.c};
        EpiGlu E{(const bf16*)(ws + FW_Z), karg<12>(), (bf16*)(ws + FW_MIX), (float*)(F.ctl + CW_SSQS)};
        gemm_phase(F.lds, g, S, E); } if (IN(5) && IN(7)) xcd_barrier(bar);
    if (IN(7)) REPS(7) { REFRESH();
        GemmP g{PX * 2, PW * 2, DM}; DenseOrder S{(const char*)(ws + FW_MIX), (const char*)(ws + FW_WOUT), (size_t)256 * PX * 2, (size_t)256 * PW * 2, M / 256, 4, (M / 256) * 4, F.G, F.c};
        EpiX1B E{(const float*)(ws + FW_RSTDX), (bf16*)(ws + FW_X1B), (const float*)(F.ctl + CW_SSQS), (const float*)(F.ctl + CW_SSQA), (LAS float*)(F.lds + SCR2_OFF + 1024)};
        { Unit uu; for (int i = 0; i < 4 && S.next(i, uu); ++i) E.fill(i, uu.pm, F.tid); __syncthreads(); }
        gemm_phase(F.lds, g, S, E); } SEAM(7);
    if (IN(8)) { REFRESH(); router_phase(F, args); } if (IN(8) && IN(10)) xcd_barrier(bar);
    int ntiles = 0;
    if (IN(10) || IN(11) || IN(12)) { REFRESH(); ntiles = moe_tables(F); }
    if (IN(10)) REPS(10) { REFRESH();
        LAS int* RC = (LAS int*)(F.lds + SCR2_OFF + 1024); const unsigned* ETOK = (const unsigned*)(ws + FW_ETOK); const LAS int* TSTc = (const LAS int*)(F.lds + SCR2_OFF); const LAS unsigned char* T2Ec = F.lds + SCR2_OFF + 256;
        { unsigned v[5];
#pragma unroll
          for (int k = 0; k < 5; ++k) { const int j = F.tid + 512 * k, i = j >> 8, r = j & 255; v[k] = 0u;
              if ((long)i * F.G + F.c < (long)ntiles * 4) { int pm, pn; moe_unit(i * F.G + F.c, ntiles, pm, pn);
                  const int e = T2Ec[pm], idx = (pm - TSTc[e]) * 256 + r;
                  if (idx < TSTc[208 + e]) v[k] = ETOK[(size_t)e * M + idx]; } }
#pragma unroll
          for (int k = 0; k < 5; ++k) { const int j = F.tid + 512 * k; if ((long)(j >> 8) * F.G + F.c < (long)ntiles * 4) RC[j] = (int)v[k]; } }
        __syncthreads();
        GemmP g{DM, DM, DM / 2}; MoeOrder S{(const char*)(ws + FW_X1Q), (const char*)(ws + FW_WGU), (size_t)0, (size_t)DM * DM, (size_t)256 * DM, F.lds + SCR2_OFF + 256, ntiles, F.G, F.c};
        EpiGU E{(unsigned char*)(ws + FW_HH), (const LAS unsigned*)RC};
        gemm_phase<EpiGU, MoeOrder, true, KREP10, true>(F.lds, g, S, E, RC, ((F.c >> 3) & 7) * STG10); } SEAM(10);
    if (IN(11)) REPS(11) { REFRESH();
        LAS float* RGC = (LAS float*)(F.lds + SCR2_OFF + 1024); const float* EG = (const float*)(ws + FW_EG); const LAS int* TSTc = (const LAS int*)(F.lds + SCR2_OFF); const LAS unsigned char* T2Ec = F.lds + SCR2_OFF + 256;
        { float v[5];
#pragma unroll
          for (int k = 0; k < 5; ++k) { const int j = F.tid + 512 * k, i = j >> 8, r = j & 255; v[k] = 0.f;
              if ((long)i * F.G + F.c < (long)ntiles * 4) { int pm, pn; moe_unit(i * F.G + F.c, ntiles, pm, pn);
                  const int e = T2Ec[pm], idx = (pm - TSTc[e]) * 256 + r;
                  if (idx < TSTc[208 + e]) v[k] = EG[(size_t)e * M + idx]; } }
#pragma unroll
          for (int k = 0; k < 5; ++k) { const int j = F.tid + 512 * k; if ((long)(j >> 8) * F.G + F.c < (long)ntiles * 4) RGC[j] = v[k]; } }
        __syncthreads();
        GemmP g{DE, DE, DE / 2}; MoeOrder S{(const char*)(ws + FW_HH), (const char*)(ws + FW_WD), (size_t)256 * DE, (size_t)DM * DE, (size_t)256 * DE, F.lds + SCR2_OFF + 256, ntiles, F.G, F.c};
        EpiDown E{(unsigned char*)(ws + FW_YE), (const LAS float*)RGC};
        gemm_phase<EpiDown, MoeOrder, false, KREP11, true>(F.lds, g, S, E, nullptr, ((F.c >> 3) & 7) * STG11); } SEAM(11);
    if (IN(12)) REPS(12) { REFRESH(); combine_phase(F, args); }
#undef IN
#undef SEAM
}
}

extern "C" void kernel_launch(void* const* d_in, const int* in_sizes, int n_in, void* d_out, int out_size, void* d_ws, size_t ws_size, hipStream_t stream) {
    static int grid = 0;
    if (grid == 0) {
        if (n_in != 26 || out_size != M * DM || ws_size < mk::FW_END2) { fprintf(stderr, "kernel_launch: unexpected shapes (n_in %d out %d ws %zu, need %zu)\n", n_in, out_size, ws_size, (size_t)mk::FW_END2); grid = -1; return; }
        int dev = 0, cus = 0, per_cu = 0;
        if (hipGetDevice(&dev) != hipSuccess || hipDeviceGetAttribute(&cus, hipDeviceAttributeMultiprocessorCount, dev) != hipSuccess) { grid = -1; return; }
        if (hipFuncSetAttribute((const void*)mk::mk_fwd, hipFuncAttributeMaxDynamicSharedMemorySize, mk::LDS_BYTES) != hipSuccess) { fprintf(stderr, "kernel_launch: hipFuncSetAttribute failed\n"); grid = -1; return; }
        if (hipOccupancyMaxActiveBlocksPerMultiprocessor(&per_cu, (const void*)mk::mk_fwd, mk::NTHR, mk::LDS_BYTES) != hipSuccess || per_cu < 1) { fprintf(stderr, "kernel_launch: occupancy query says %d\n", per_cu); }
        (void)hipGetLastError();
        grid = cus;
        if (grid != 256) fprintf(stderr, "kernel_launch: %d CUs (built for 256)\n", grid);
    }
    if (grid < 0) return;
    mk::Args a{};
    for (int i = 0; i < 26; ++i) a.in[i] = (const float*)d_in[i];
    a.out = (float*)d_out; a.ws = (unsigned char*)d_ws; a.ph_lo = 0; a.ph_hi = mk::NPHASE;
    (void)hipMemsetAsync((unsigned char*)d_ws + WS_CTL, 0, mk::CTL_ZERO_BYTES, stream);
    hipLaunchKernelGGL(mk::mk_fwd, dim3(grid), dim3(mk::NTHR), mk::LDS_BYTES, stream, a);
}
```

```cpp
#define ASPAN_N 10
#define PADX 0

#include <hip/hip_runtime.h>
#include <cstdio>
#include <cstdint>

typedef unsigned short bf16;
typedef float f32x4 __attribute__((ext_vector_type(4)));
typedef unsigned u32x4 __attribute__((ext_vector_type(4)));
typedef unsigned u32x2 __attribute__((ext_vector_type(2)));

constexpr int DM = 1024, BATCH = 32, SEQ = 2048, M = BATCH * SEQ;
constexpr int DSSM = 512, NG = 32, GS = 16, PST = 64, HD = 64, DATT = 512, NH = 8, DIN = 2048;
constexpr int NEG = 4, EPG = 8, NE = 32, DE = 512;
constexpr float EPS = 1e-6f;
constexpr int LCH = 32;
constexpr int NCH = M / LCH;
constexpr int U2P = 640;
constexpr float C2 = 0.125f * 1.4426950408889634f;

constexpr size_t MiB = 1u << 20;
constexpr size_t WS_CTL = 0;
constexpr size_t WS_TOK = 2 * MiB;
constexpr size_t WS_XN = 8 * MiB;
constexpr size_t WS_Q = WS_XN + 128 * MiB;
constexpr size_t WS_K = WS_Q + 64 * MiB;
constexpr size_t WS_V = WS_K + 64 * MiB;
constexpr size_t WS_U2 = WS_V + 64 * MiB;
constexpr size_t WS_Z = WS_U2 + 80 * MiB;
constexpr size_t WS_YS = WS_Z + 64 * MiB;
constexpr size_t WS_YA = WS_YS + 64 * MiB;
constexpr size_t WS_MIX = WS_YA + 64 * MiB;
constexpr size_t WS_H2 = WS_XN;
constexpr size_t WS_PROJ = WS_Z;
constexpr size_t WS_END = WS_PROJ + 512 * MiB;

__device__ __forceinline__ unsigned f2bf(float f) { unsigned u = __builtin_bit_cast(unsigned, f); return (u + 0x7fffu + ((u >> 16) & 1u)) >> 16; }
__device__ __forceinline__ float bf2f(unsigned short h) { return __builtin_bit_cast(float, (unsigned)h << 16); }
__device__ __forceinline__ unsigned pk2(float lo, float hi) { return f2bf(lo) | (f2bf(hi) << 16); }
template <int CTRL> __device__ __forceinline__ float dppf(float x) { return __builtin_bit_cast(float, __builtin_amdgcn_update_dpp(0, __builtin_bit_cast(int, x), CTRL, 0xF, 0xF, true)); }
template <int CTRL> __device__ __forceinline__ unsigned dppu(unsigned x) { return (unsigned)__builtin_amdgcn_update_dpp(0, (int)x, CTRL, 0xF, 0xF, true); }
__device__ __forceinline__ float xor16_sum(float v) { const unsigned u = __builtin_bit_cast(unsigned, v); auto r = __builtin_amdgcn_permlane16_swap(u, u, false, false); return __builtin_bit_cast(float, (unsigned)r[0]) + __builtin_bit_cast(float, (unsigned)r[1]); }
__device__ __forceinline__ float xor32_sum(float v) { const unsigned u = __builtin_bit_cast(unsigned, v); auto r = __builtin_amdgcn_permlane32_swap(u, u, false, false); return __builtin_bit_cast(float, (unsigned)r[0]) + __builtin_bit_cast(float, (unsigned)r[1]); }
__device__ __forceinline__ unsigned xor16_get(unsigned u, bool odd_row) { auto r = __builtin_amdgcn_permlane16_swap(u, u, false, false); return odd_row ? (unsigned)r[0] : (unsigned)r[1]; }
__device__ __forceinline__ float wave_sum(float v) {
    v += dppf<0xB1>(v); v += dppf<0x4E>(v); v += dppf<0x141>(v); v += dppf<0x140>(v);
    return xor32_sum(xor16_sum(v));
}
__device__ __forceinline__ void sincos_d(double th, double& s, double& c) {
    const double q = rint(th * 0.63661977236758134308);
    const double r = (th - q * 1.57079632679489655800) - q * 6.12323399573676603587e-17;
    const double r2 = r * r;
    double sp = -1.0 / 1307674368000.0; sp = sp * r2 + 1.0 / 6227020800.0; sp = sp * r2 - 1.0 / 39916800.0; sp = sp * r2 + 1.0 / 362880.0; sp = sp * r2 - 1.0 / 5040.0; sp = sp * r2 + 1.0 / 120.0; sp = sp * r2 - 1.0 / 6.0; sp = sp * r2 + 1.0;
    const double sn = sp * r;
    double cp = 1.0 / 20922789888000.0; cp = cp * r2 - 1.0 / 87178291200.0; cp = cp * r2 + 1.0 / 479001600.0; cp = cp * r2 - 1.0 / 3628800.0; cp = cp * r2 + 1.0 / 40320.0; cp = cp * r2 - 1.0 / 720.0; cp = cp * r2 + 1.0 / 24.0; cp = cp * r2 - 0.5; cp = cp * r2 + 1.0;
    const int qi = ((int)q) & 3;
    s = (qi == 0) ? sn : (qi == 1) ? cp : (qi == 2) ? -sn : -cp;
    c = (qi == 0) ? cp : (qi == 1) ? -sn : (qi == 2) ? -cp : sn;
}
__device__ __forceinline__ float gelu_tanh(float x) {
    constexpr float K1 = -2.885390081777927f * 0.7978845608028654f, K3 = K1 * 0.044715f;
    const float e = __builtin_amdgcn_exp2f(x * (K1 + K3 * (x * x)));
    return x * __builtin_amdgcn_rcpf(1.f + e);
}
__device__ __forceinline__ float sigmoidf_(float x) { return __builtin_amdgcn_rcpf(1.f + __builtin_amdgcn_exp2f(-1.4426950408889634f * x)); }


#include <type_traits>
namespace mk {
#define LAS __attribute__((address_space(3)))
#define GAS __attribute__((address_space(1)))
typedef short bf16x8 __attribute__((ext_vector_type(8)));
typedef short s16x4 __attribute__((ext_vector_type(4)));
typedef float f32x16 __attribute__((ext_vector_type(16)));
typedef float f32x2 __attribute__((ext_vector_type(2)));
typedef __bf16 bf16x2_t __attribute__((ext_vector_type(2)));
typedef GAS unsigned gu32;

constexpr int NWAVES = 8, NTHR = 512;
constexpr int RING_BYTES = 131072, SCR2_OFF = RING_BYTES, SCR2_BYTES = 16128, MISC_OFF = SCR2_OFF + SCR2_BYTES, LDS_BYTES = 147456;
static_assert(MISC_OFF + 256 == LDS_BYTES, "LDS map");

#ifndef PADX
#define PADX 64
#endif
constexpr int PX = DM + PADX;
constexpr int PW = DM + PADX;
constexpr size_t FW_TOK = 2 * MiB, FW_WIN = 4 * MiB, FW_WOUT = 9 * MiB, FW_WGLU = 12 * MiB - 512 * 1024, FW_WR = 12 * MiB, FW_TB = 13 * MiB, FW_W1 = 33 * MiB,
                 FW_WGU = 41 * MiB, FW_WD = 110 * MiB, FW_SST = 142 * MiB, FW_XN = 174 * MiB, FW_Q = 310 * MiB, FW_K = 374 * MiB, FW_V = 438 * MiB, FW_U2 = 502 * MiB,
                 FW_Z = 582 * MiB, FW_MIX = 646 * MiB, FW_ROW = 782 * MiB, FW_END2 = 784 * MiB,
                 FW_X1B = FW_XN, FW_HH = 582 * MiB, FW_YE = FW_Q;
static_assert(FW_WIN + (size_t)DIN * PW * 2 <= FW_WOUT && FW_WOUT + (size_t)DM * PW * 2 <= FW_WGLU && FW_WGU + (size_t)NE * DM * PW * 2 <= FW_WD && FW_XN + (size_t)M * PX * 2 <= FW_Q && FW_MIX + (size_t)M * PX * 2 <= FW_ROW, "padded buffers");
static_assert(FW_K - FW_Q == (size_t)M * 512 * 2 && FW_V - FW_K == (size_t)M * 512 * 2, "Q|K|V contiguous");
constexpr size_t FW_RSTDX = FW_ROW + 3 * (size_t)(544 * 256) * 4;
constexpr size_t FW_ETOK = FW_SST, FW_EG = FW_SST + (size_t)NE * M * 4;
static_assert(FW_EG + (size_t)NE * M * 4 <= FW_XN, "expert lists");
constexpr float W8SC = 64.f;
constexpr size_t FW_X1Q = FW_U2;
static_assert(FW_X1Q + (size_t)M * DM <= FW_HH && FW_YE + (size_t)(544 * 256) * DM <= FW_X1Q && FW_HH + (size_t)(544 * 256) * DE <= FW_ROW, "X1Q / HH / YE must not overlap");
constexpr size_t FW_A32 = FW_WR + 256 * 1024;
constexpr int MAXTILES = 544, MAXROWS = MAXTILES * 256;
static_assert(FW_RSTDX + (size_t)M * 4 <= FW_END2, "row arrays");
static_assert(FW_YE + (size_t)MAXROWS * DM <= FW_U2 && FW_HH + (size_t)MAXROWS * DE * 2 <= FW_ROW, "MoE overlay");
constexpr int CW_TMO = 0, CW_CNT = 64, CW_BAR = 4096, CW_SSQS = 65536, CW_SSQA = 131072;
static_assert((CW_SSQA + M) * 4 <= (int)(1 * MiB), "ssq arrays inside the memset region");
constexpr size_t CTL_ZERO_BYTES = 1 * MiB;

#define RLX_AGENT __ATOMIC_RELAXED, __HIP_MEMORY_SCOPE_AGENT
__device__ __forceinline__ unsigned cvtpk(float lo, float hi) { f32x2 v = {lo, hi}; bf16x2_t b = __builtin_convertvector(v, bf16x2_t); return __builtin_bit_cast(unsigned, b); }

#define XB_TMO      128
#define XB_XCNT(j)  (256  + 64 * (j))
#define XB_XSUB(j)  (1280 + 64 * (j))
#define XB_XGEN(j)  (2304 + 64 * (j))
#define XB_TOP      3328
#define XB_TOPGEN   3392
#define XCD_BAR_WORDS 3456
#define XB_SPIN_CAP (1u << 18)
__device__ __forceinline__ unsigned xb_ld(unsigned* p)              { return __hip_atomic_load(p, __ATOMIC_RELAXED, __HIP_MEMORY_SCOPE_AGENT); }
__device__ __forceinline__ unsigned xb_add(unsigned* p, unsigned v) { return __hip_atomic_fetch_add(p, v, __ATOMIC_RELAXED, __HIP_MEMORY_SCOPE_AGENT); }
__device__ __forceinline__ unsigned xb_xcc_id() { return (unsigned)__builtin_amdgcn_s_getreg((3 << 11) | 20) & 0xFu; }
#define XB_SPIN(cond, bar) do { unsigned _sp = 0; while (cond) { __builtin_amdgcn_s_sleep(1); \
    if ((++_sp & 255u) == 0u) { if (xb_ld(&(bar)[XB_TMO])) break; if (_sp > XB_SPIN_CAP) { atomicAdd(&(bar)[XB_TMO], 1u); break; } } } } while (0)
struct XcdBarrier { unsigned* bar; unsigned x; volatile LAS unsigned* st; };
__device__ __forceinline__ XcdBarrier xcd_barrier_post(unsigned* bar, volatile LAS unsigned* st) {
    XcdBarrier b; b.bar = bar; b.x = xb_xcc_id(); b.st = st;
    if (threadIdx.x == 0) (void)xb_add(&bar[XB_XCNT(b.x)], 1u);
    return b;
}
__device__ __forceinline__ void xcd_barrier_complete(unsigned* bar, unsigned x, unsigned& nloc, unsigned& nx) {
    const unsigned G = gridDim.x * gridDim.y * gridDim.z;
    unsigned sum, cnt, mine, sp = 0u;
    for (;;) {
        sum = 0u; cnt = 0u; mine = 0u;
#pragma unroll
        for (unsigned j = 0; j < 16; ++j) { const unsigned c = xb_ld(&bar[XB_XCNT(j)]); sum += c; cnt += (c > 0u) ? 1u : 0u; mine = (j == x) ? c : mine; }
        if (sum == G) break;
        __builtin_amdgcn_s_sleep(1);
        if ((++sp & 255u) == 0u) { if (xb_ld(&bar[XB_TMO])) break; if (sp > XB_SPIN_CAP) { atomicAdd(&bar[XB_TMO], 1u); break; } }
    }
    nloc = mine > 0u ? mine : 1u; nx = cnt > 0u ? cnt : 1u;
}
__device__ __forceinline__ void xcd_barrier(const XcdBarrier& b) {
    asm volatile("s_waitcnt vmcnt(0)" ::: "memory");
    __syncthreads();
    if (threadIdx.x == 0) {
        unsigned* bar = b.bar;
        __builtin_amdgcn_s_waitcnt(0);
        unsigned nloc = b.st[0], nx = b.st[1];
        if (nloc == 0u) { xcd_barrier_complete(bar, b.x, nloc, nx); b.st[0] = nloc; b.st[1] = nx; }
        const unsigned old = xb_add(&bar[XB_XSUB(b.x)], 1u);
        const unsigned gen = old / nloc;
        if (old + 1u == (gen + 1u) * nloc) {
            __builtin_amdgcn_fence(__ATOMIC_RELEASE, "agent");
            asm volatile("s_waitcnt vmcnt(0)" ::: "memory");
            const unsigned og = xb_add(&bar[XB_TOP], 1u);
            const unsigned tg = og / nx;
            if (og + 1u == (tg + 1u) * nx) xb_add(&bar[XB_TOPGEN], 1u);
            else XB_SPIN(xb_ld(&bar[XB_TOPGEN]) == tg, bar);
            __builtin_amdgcn_fence(__ATOMIC_ACQUIRE, "agent");
            xb_add(&bar[XB_XGEN(b.x)], 1u);
            asm volatile("s_waitcnt vmcnt(0)" ::: "memory");
        } else {
            XB_SPIN(xb_ld(&bar[XB_XGEN(b.x)]) == gen, bar);
            __builtin_amdgcn_fence(__ATOMIC_ACQUIRE, "agent");
            asm volatile("s_waitcnt vmcnt(0)" ::: "memory");
        }
    }
    __syncthreads();
}

constexpr int BM = 256, BK = 64, HALF = 128, HTB = HALF * BK * 2;
__device__ __forceinline__ int lds_byte(int r, int c) { const int st = (r >> 4) * 2 + (c >> 5), rr = r & 15, cc = c & 31, ob = rr * 64 + cc * 2; return st * 1024 + (ob ^ (((ob >> 9) & 1) << 5)); }
__device__ __forceinline__ void stage_rc(int b, int& R, int& C) { const int st = b / 1024, sb = b % 1024, swz = sb ^ (((sb >> 9) & 1) << 5); R = (st >> 1) * 16 + swz / 64; C = (st & 1) * 32 + (swz % 64) / 2; }
__device__ __forceinline__ int perm32(int rho) { const int n = rho >> 4, i = rho & 15; return 8 * (i >> 2) + 4 * n + (i & 3); }
struct Unit { const char* a; const char* b; int pm, pn, aux; };
struct GemmP { int lda_b, ldb_b, K, ksa = 0; };

template <class Epi, class Sched, bool GATHER = false, int KREP = 1, bool FP8 = false>
__device__ __forceinline__ void gemm_phase(LAS unsigned char* lds, const GemmP g, const Sched& S, const Epi& E, const LAS int* rowcache = nullptr, int stagger_ticks = 0) {
    const int tid = threadIdx.x, wid = __builtin_amdgcn_readfirstlane(tid >> 6), lane = tid & 63, wr = wid >> 2, wc = wid & 3, fr = lane & 15, fq = lane >> 4;
    const int ntk = g.K / BK, nt = ntk * (KREP == 3 ? 1 : KREP);
    unsigned voffA[2], voffB[2]; int gR[2], gC[2];
#pragma unroll
    for (int i = 0; i < 2; ++i) { int R, C; stage_rc(tid * 16 + i * 8192, R, C); const int Rb = Epi::PERM ? ((R & ~31) + perm32(R & 31)) : R; gR[i] = R; gC[i] = C * 2;
        voffA[i] = (unsigned)(R * g.lda_b + C * 2); voffB[i] = (unsigned)(Rb * g.ldb_b + C * 2); }
    unsigned vc0[2] = {voffA[0], voffA[1]}, vc1[2] = {voffA[0], voffA[1]}, vn0[2] = {voffA[0], voffA[1]}, vn1[2] = {voffA[0], voffA[1]};
#define PG8_GOFF(dst0, dst1, ui_) do { _Pragma("unroll") for (int _i = 0; _i < 2; ++_i) { \
        dst0[_i] = ((unsigned)rowcache[(ui_) * 256 + gR[_i]] & 0xffffu) * (unsigned)g.lda_b + (unsigned)gC[_i]; dst1[_i] = ((unsigned)rowcache[(ui_) * 256 + 128 + gR[_i]] & 0xffffu) * (unsigned)g.lda_b + (unsigned)gC[_i]; } } while (0)
    const size_t kstep = (size_t)(BK * 2), kstepA = g.ksa ? (size_t)g.ksa : kstep;
    const size_t hstepA = GATHER ? 0 : (size_t)HALF * g.lda_b, hstepB = (size_t)HALF * g.ldb_b;
    const unsigned ldsw = (unsigned)wid * 1024u;
    const int aoff = lds_byte(wr * 64 + fr, fq * 8), boff = lds_byte(wc * 32 + fr, fq * 8);
#define PG8_SA(b, h) (((b) * 2 + (h)) * HTB)
#define PG8_SB(b, h) ((4 + (b) * 2 + (h)) * HTB)
#define PG8_STAGE(bufoff, gbase, voff) do { _Pragma("unroll") for (int _i = 0; _i < 2; ++_i) \
        __builtin_amdgcn_global_load_lds((const unsigned*)((const char*)(gbase) + (voff)[_i]), (LAS unsigned*)(lds + (bufoff) + ldsw + _i * 8192), 16, 0, 0); } while (0)
#define PG8_LDA(dst, b, h) do { _Pragma("unroll") for (int m = 0; m < 4; ++m) { const LAS unsigned char* p_ = lds + PG8_SA(b, h) + aoff + m * 2048; \
        if constexpr (FP8) { dst[m].v.lo = *(const LAS v4i_*)p_; dst[m].v.hi = *(const LAS v4i_*)(p_ + 1024); } else { dst[m].v[0] = *(const LAS bf16x8*)p_; dst[m].v[1] = *(const LAS bf16x8*)(p_ + 1024); } } } while (0)
#define PG8_LDB(dst, b, h) do { _Pragma("unroll") for (int n = 0; n < 2; ++n) { const LAS unsigned char* p_ = lds + PG8_SB(b, h) + boff + n * 2048; \
        if constexpr (FP8) { dst[n].v.lo = *(const LAS v4i_*)p_; dst[n].v.hi = *(const LAS v4i_*)(p_ + 1024); } else { dst[n].v[0] = *(const LAS bf16x8*)p_; dst[n].v[1] = *(const LAS bf16x8*)(p_ + 1024); } } } while (0)
#define PG8_MMA(ai, bj, At, Bt) do { if (Epi::HALFN && (bj) == 1) break; __builtin_amdgcn_s_setprio(1); \
        if constexpr (FP8) { asm volatile("s_nop 1\n\t" "v_mfma_scale_f32_16x16x128_f8f6f4 %0, %8, %10, %0, %14, %14 op_sel_hi:[0,0,0]\n\t" "v_mfma_scale_f32_16x16x128_f8f6f4 %1, %9, %10, %1, %14, %14 op_sel_hi:[0,0,0]\n\t" "v_mfma_scale_f32_16x16x128_f8f6f4 %2, %8, %11, %2, %14, %14 op_sel_hi:[0,0,0]\n\t" "v_mfma_scale_f32_16x16x128_f8f6f4 %3, %9, %11, %3, %14, %14 op_sel_hi:[0,0,0]\n\t" "v_mfma_scale_f32_16x16x128_f8f6f4 %4, %8, %12, %4, %14, %14 op_sel_hi:[0,0,0]\n\t" "v_mfma_scale_f32_16x16x128_f8f6f4 %5, %9, %12, %5, %14, %14 op_sel_hi:[0,0,0]\n\t" "v_mfma_scale_f32_16x16x128_f8f6f4 %6, %8, %13, %6, %14, %14 op_sel_hi:[0,0,0]\n\t" "v_mfma_scale_f32_16x16x128_f8f6f4 %7, %9, %13, %7, %14, %14 op_sel_hi:[0,0,0]\n\t" "s_nop 1" \
            : "+v"(acc[ai][bj][0][0]), "+v"(acc[ai][bj][0][1]), "+v"(acc[ai][bj][1][0]), "+v"(acc[ai][bj][1][1]), "+v"(acc[ai][bj][2][0]), "+v"(acc[ai][bj][2][1]), "+v"(acc[ai][bj][3][0]), "+v"(acc[ai][bj][3][1]) \
            : "v"(Bt[0].v), "v"(Bt[1].v), "v"(At[0].v), "v"(At[1].v), "v"(At[2].v), "v"(At[3].v), "v"(mxs)); } \
        else { _Pragma("unroll") for (int m = 0; m < 4; ++m) _Pragma("unroll") for (int n = 0; n < 2; ++n) _Pragma("unroll") for (int k = 0; k < 2; ++k) \
            acc[ai][bj][m][n] = __builtin_amdgcn_mfma_f32_16x16x32_bf16(Bt[n].v[k], At[m].v[k], acc[ai][bj][m][n], 0, 0, 0); } \
        __builtin_amdgcn_s_setprio(0); } while (0)
#define PG8_WAIT_V(n) asm volatile("s_waitcnt vmcnt(" #n ")" ::: "memory")
#define PG8_WAIT_L(n) asm volatile("s_waitcnt lgkmcnt(" #n ")" ::: "memory")
#define PG8_BAR __builtin_amdgcn_s_barrier()
#define PG8_SCHED __builtin_amdgcn_sched_barrier(0)
    int mxs = 0x7F7F7F7F; asm volatile("" : "+v"(mxs));
    Unit cur, nxt; int ui = 0;
    if (!S.next(0, cur)) return;
    if (stagger_ticks > 0) { const unsigned long long t0 = __builtin_amdgcn_s_memrealtime(); while ((long long)(__builtin_amdgcn_s_memrealtime() - t0) < (long long)stagger_ticks) __builtin_amdgcn_s_sleep(8); }
    f32x4 acc[2][2][4][2];
#pragma unroll
    for (int a = 0; a < 2; ++a)
#pragma unroll
        for (int b = 0; b < 2; ++b)
#pragma unroll
            for (int m = 0; m < 4; ++m)
#pragma unroll
                for (int n = 0; n < 2; ++n) acc[a][b][m][n] = (f32x4){0.f, 0.f, 0.f, 0.f};
    typedef int v4i_ __attribute__((ext_vector_type(4))); typedef int v8i_ __attribute__((ext_vector_type(8)));
    struct FragB { bf16x8 v[2]; }; struct Frag8 { v8i_ v; };
    typename std::conditional<FP8, Frag8, FragB>::type At[4], B0[2], B1[2];
    const char* cA = cur.a; const char* cB = cur.b;
    if (GATHER) { PG8_GOFF(vc0, vc1, 0); }
    PG8_STAGE(PG8_SB(0, 0), cB, voffB); PG8_STAGE(PG8_SB(0, 1), cB + hstepB, voffB); PG8_STAGE(PG8_SA(0, 0), cA, vc0); PG8_STAGE(PG8_SA(0, 1), cA + hstepA, vc1);
    if (wr == 1) PG8_BAR;
    PG8_WAIT_V(2); PG8_BAR;
    PG8_STAGE(PG8_SB(1, 0), cB + kstep, voffB); PG8_STAGE(PG8_SA(1, 0), cA + kstepA, vc0); PG8_STAGE(PG8_SB(1, 1), cB + hstepB + kstep, voffB);
    PG8_WAIT_V(6); PG8_BAR;
    for (;;) {
        const bool has_next = S.next(ui + 1, nxt);
        const char* nA = has_next ? nxt.a : cA; const char* nB = has_next ? nxt.b : cB;
        if constexpr (Epi::HOOKS) E.begin(cur, ui, tid);
        if (GATHER) { if (has_next) { PG8_GOFF(vn0, vn1, ui + 1); } else { vn0[0] = vc0[0]; vn0[1] = vc0[1]; vn1[0] = vc1[0]; vn1[1] = vc1[1]; } }
        for (int t = 0; t < nt; t += 2) {
            const bool last = (t == nt - 2);
            if constexpr (Epi::HOOKS) { if (t == nt / 2) E.mid(acc, ui, wr, fr); }
#ifdef PROBE_EPI_TWICE
            if constexpr (KREP == 3) { if (t == ntk / 2) E.fin(acc, cur, ui, wr, wc, fr, fq); }
#endif
            const char* a1 = cA + (size_t)((t + 1) % ntk) * kstepA;
            const char* a2 = last ? nA : cA + (size_t)((t + 2) % ntk) * kstepA; const char* b2 = last ? nB : cB + (size_t)((t + 2) % ntk) * kstep;
            const char* a3 = a2 + kstepA; const char* b3 = b2 + kstep;
            unsigned w0[2], w1[2];
            w0[0] = (GATHER && last) ? vn0[0] : vc0[0]; w0[1] = (GATHER && last) ? vn0[1] : vc0[1]; w1[0] = (GATHER && last) ? vn1[0] : vc1[0]; w1[1] = (GATHER && last) ? vn1[1] : vc1[1];
            PG8_LDB(B0, 0, 0); PG8_LDB(B1, 0, 1); PG8_SCHED; PG8_LDA(At, 0, 0); PG8_STAGE(PG8_SA(1, 1), a1 + hstepA, vc1);
            PG8_WAIT_V(8); PG8_WAIT_L(0); PG8_BAR; PG8_MMA(0, 0, At, B0); PG8_MMA(0, 1, At, B1); PG8_BAR; PG8_SCHED;
            PG8_LDA(At, 0, 1); PG8_STAGE(PG8_SB(0, 0), b2, voffB); PG8_STAGE(PG8_SB(0, 1), b2 + hstepB, voffB); PG8_STAGE(PG8_SA(0, 0), a2, w0);
            PG8_WAIT_V(8); PG8_WAIT_L(0); PG8_BAR; PG8_MMA(1, 0, At, B0); PG8_MMA(1, 1, At, B1); PG8_BAR; PG8_SCHED;
            PG8_LDB(B0, 1, 0); PG8_LDB(B1, 1, 1); PG8_SCHED; PG8_LDA(At, 1, 0); PG8_STAGE(PG8_SA(0, 1), a2 + hstepA, w1);
            PG8_WAIT_V(8); PG8_WAIT_L(0); PG8_BAR; PG8_MMA(0, 0, At, B0); PG8_MMA(0, 1, At, B1); PG8_BAR; PG8_SCHED;
            PG8_LDA(At, 1, 1); PG8_STAGE(PG8_SB(1, 0), b3, voffB); PG8_STAGE(PG8_SB(1, 1), b3 + hstepB, voffB); PG8_STAGE(PG8_SA(1, 0), a3, w0);
            PG8_WAIT_V(8); PG8_WAIT_L(0); PG8_BAR; PG8_MMA(1, 0, At, B0); PG8_MMA(1, 1, At, B1); PG8_BAR; PG8_SCHED;
        }
        if (wr == 0) PG8_BAR;
        if constexpr (FP8) asm volatile("s_nop 15\n\ts_nop 7" ::: "memory");
        if constexpr (KREP > 1) {
#pragma unroll
            for (int a = 0; a < 2; ++a)
#pragma unroll
                for (int b = 0; b < 2; ++b)
#pragma unroll
                    for (int m = 0; m < 4; ++m)
#pragma unroll
                        for (int n = 0; n < 2; ++n) acc[a][b][m][n] = acc[a][b][m][n] * (KREP == 3 ? 1.f : 1.f / KREP); }
        if constexpr (Epi::HOOKS) E.fin(acc, cur, ui, wr, wc, fr, fq); else E(acc, cur, wr, wc, fr, fq);
        if (!has_next) break;
#pragma unroll
        for (int a = 0; a < 2; ++a)
#pragma unroll
            for (int b = 0; b < 2; ++b)
#pragma unroll
                for (int m = 0; m < 4; ++m)
#pragma unroll
                    for (int n = 0; n < 2; ++n) acc[a][b][m][n] = (f32x4){0.f, 0.f, 0.f, 0.f};
        cur = nxt; cA = nA; cB = nB; ++ui;
        if (GATHER) { vc0[0] = vn0[0]; vc0[1] = vn0[1]; vc1[0] = vn1[0]; vc1[1] = vn1[1]; }
        if (wr == 1) PG8_BAR;
    }
    PG8_WAIT_V(0);
    PG8_BAR;
#undef PG8_GOFF
#undef PG8_SA
#undef PG8_SB
#undef PG8_STAGE
#undef PG8_LDA
#undef PG8_LDB
#undef PG8_MMA
#undef PG8_WAIT_V
#undef PG8_WAIT_L
#undef PG8_BAR
#undef PG8_SCHED
}

struct DenseOrder {
    const char* A; const char* B; size_t a_tile, b_tile; int nM, nN, nwg, G, c;
    __device__ __forceinline__ bool next(int i, Unit& u) const {
        const long L = (long)i * G + c; if (L >= nwg) return false;
        int wgid = (int)L; { const int q = nwg / 8, r = nwg % 8, xcd = wgid % 8, off = wgid / 8; wgid = (xcd < r ? xcd * (q + 1) : r * (q + 1) + (xcd - r) * q) + off; }
        const int nig = 8 * nN, gid = wgid / nig, fm = gid * 8, gsz = (nM - fm) < 8 ? (nM - fm) : 8;
        u.pm = fm + ((wgid % nig) % gsz); u.pn = (wgid % nig) / gsz; u.aux = 0;
        u.a = A + (size_t)u.pm * a_tile; u.b = B + (size_t)u.pn * b_tile; return true;
    }
};
struct GroupOrder {
    const char* A; const char* B; size_t a_grp, b_grp, a_tile, b_tile; int nM, nN, nwg, G, c;
    __device__ __forceinline__ bool next(int i, Unit& u) const {
        const long L = (long)i * G + c; if (L >= nwg) return false;
        const int per = nM * nN, g = (int)L / per, r = (int)L % per;
        u.pn = r / nM; u.pm = r % nM; u.aux = g;
        u.a = A + (size_t)g * a_grp + (size_t)u.pm * a_tile; u.b = B + (size_t)g * b_grp + (size_t)u.pn * b_tile; return true;
    }
};
__device__ __forceinline__ void moe_unit(int L, int ntiles, int& pm, int& pn) {
    const int j = L >> 5, full = ntiles >> 3;
    if (j < full) { const int r = L & 31; pm = 8 * j + (r & 7); pn = r >> 3; }
    else { const int gsz = ntiles - 8 * full, r = L - 32 * full; pm = 8 * full + r % gsz; pn = r / gsz; }
}
struct MoeOrder {
    const char* A; const char* B; size_t a_tile, b_exp, b_tile; const LAS unsigned char* t2e; int ntiles, G, c;
    __device__ __forceinline__ bool next(int i, Unit& u) const {
        const long L = (long)i * G + c; if (L >= (long)ntiles * 4) return false;
        moe_unit((int)L, ntiles, u.pm, u.pn); u.aux = t2e[u.pm];
        u.a = A + (size_t)u.pm * a_tile; u.b = B + (size_t)u.aux * b_exp + (size_t)u.pn * b_tile; return true;
    }
};

#ifndef MIX_TILED
#define MIX_TILED 1
#endif
__device__ __forceinline__ size_t mix_off(size_t m, int c) {
    if (MIX_TILED) return ((((m >> 8) * 16 + (size_t)(c >> 6)) * 256 + (m & 255)) * 64) + (size_t)(c & 63);
    return m * PX + (size_t)c;
}
typedef f32x4 Acc[2][2][4][2];
constexpr float YE_SCALE = 8.f;
__device__ __forceinline__ unsigned pk4_fp8(float a, float b, float c, float d) { int w = 0; w = __builtin_amdgcn_cvt_pk_fp8_f32(a, b, w, false); w = __builtin_amdgcn_cvt_pk_fp8_f32(c, d, w, true); return (unsigned)w; }

__device__ __forceinline__ void store_pair(bf16* row_even, size_t pitch, u32x4 p0, u32x4 p1, int fr, int fq) {
    const bool odd = fr & 1;
    const u32x4 send = odd ? p0 : p1; u32x4 recv;
    recv.x = dppu<0xB1>(send.x); recv.y = dppu<0xB1>(send.y); recv.z = dppu<0xB1>(send.z); recv.w = dppu<0xB1>(send.w);
    const u32x4 a = odd ? recv : p0, b = odd ? p1 : recv;
    bf16* d = row_even + (odd ? 32 : 0) + 8 * fq;
#ifdef NT_STORES
    __builtin_nontemporal_store(a, (u32x4*)d); __builtin_nontemporal_store(b, (u32x4*)(d + pitch));
#else
    *(u32x4*)d = a; *(u32x4*)(d + pitch) = b;
#endif
}
struct EpiProj {
    static constexpr bool HALFN = false, HOOKS = false, PERM = true;
    bf16* U2; bf16* QKV; const LAS float* GQK;
    __device__ __forceinline__ void operator()(const Acc& acc, const Unit& u, int wr, int wc, int fr, int fq) const {
        const int typ = u.pn >> 1;
        if (typ == 1 || typ == 2) run<true>(acc, u, wr, wc, fr, fq); else run<false>(acc, u, wr, wc, fr, fq);
    }
    template <bool nrm> __device__ __forceinline__ void run(const Acc& acc, const Unit& u, int wr, int wc, int fr, int fq) const {
        const int typ = u.pn >> 1, sub = u.pn & 1;
        const LAS float* gg = GQK + ((typ == 1) ? 0 : 64);
        f32x4 gn[2][2];
#pragma unroll
        for (int bj = 0; bj < 2; ++bj)
#pragma unroll
            for (int n = 0; n < 2; ++n) gn[bj][n] = nrm ? *(const LAS f32x4*)(gg + 32 * bj + 8 * fq + 4 * n) : (f32x4){1.f, 1.f, 1.f, 1.f};
#pragma unroll
        for (int ai = 0; ai < 2; ++ai)
#pragma unroll
            for (int m = 0; m < 4; ++m) {
                const int r = u.pm * BM + ai * HALF + wr * 64 + m * 16 + fr;
                f32x4 v[2][2];
#pragma unroll
                for (int bj = 0; bj < 2; ++bj)
#pragma unroll
                    for (int n = 0; n < 2; ++n) v[bj][n] = acc[ai][bj][m][n];
                if constexpr (nrm) {
                    float s = 0.f;
#pragma unroll
                    for (int bj = 0; bj < 2; ++bj)
#pragma unroll
                        for (int n = 0; n < 2; ++n) s += (v[bj][n].x * v[bj][n].x + v[bj][n].y * v[bj][n].y) + (v[bj][n].z * v[bj][n].z + v[bj][n].w * v[bj][n].w);
                    s = xor32_sum(xor16_sum(s));
                    const float rstd = nrm ? __builtin_amdgcn_rsqf(s * (1.f / 64.f) + EPS) : 1.f;
#pragma unroll
                    for (int bj = 0; bj < 2; ++bj)
#pragma unroll
                        for (int n = 0; n < 2; ++n) v[bj][n] = v[bj][n] * (gn[bj][n] * rstd);
                }
                u32x4 p[2];
#pragma unroll
                for (int bj = 0; bj < 2; ++bj) { p[bj].x = cvtpk(v[bj][0].x, v[bj][0].y); p[bj].y = cvtpk(v[bj][0].z, v[bj][0].w); p[bj].z = cvtpk(v[bj][1].x, v[bj][1].y); p[bj].w = cvtpk(v[bj][1].z, v[bj][1].w); }
                if (!nrm && typ == 0) {
#pragma unroll
                    for (int bj = 0; bj < 2; ++bj) { const int f = sub * 256 + 64 * wc + 32 * bj + 8 * fq, g = f >> 4, h = f & 15;
                        *(u32x4*)(U2 + ((size_t)g * NCH + (r >> 5)) * U2P + (r & 31) * 16 + h) = p[bj]; }
                } else store_pair(QKV + (size_t)(typ - 1) * ((size_t)M * 512) + (size_t)(r & ~1) * 512 + sub * 256 + 64 * wc, 512, p[0], p[1], fr, fq);
            }
    }
};
struct EpiState {
    static constexpr bool HALFN = true, HOOKS = false, PERM = false;
    float* SST;
    __device__ __forceinline__ void operator()(const Acc& acc, const Unit& u, int wr, int wc, int fr, int fq) const {
#pragma unroll
        for (int ai = 0; ai < 2; ++ai)
#pragma unroll
            for (int m = 0; m < 4; ++m) { const int r = u.pm * BM + ai * HALF + wr * 64 + m * 16 + fr;
#pragma unroll
                for (int n = 0; n < 2; ++n) *(f32x4*)(SST + ((size_t)u.aux * NCH + r) * 128 + 32 * wc + 16 * n + 4 * fq) = acc[ai][0][m][n]; }
    }
};
struct EpiS5 {
    static constexpr bool HALFN = false, HOOKS = false, PERM = true;
    bf16* Z;
    __device__ __forceinline__ void operator()(const Acc& acc, const Unit& u, int wr, int wc, int fr, int fq) const {
#pragma unroll
        for (int ai = 0; ai < 2; ++ai)
#pragma unroll
            for (int m = 0; m < 4; ++m) { const int r = u.pm * BM + ai * HALF + wr * 64 + m * 16 + fr;
#pragma unroll
                for (int bj = 0; bj < 2; ++bj) { const int c0 = u.pn * BM + bj * HALF + 32 * wc + 8 * fq, i = c0 >> 4, h = c0 & 15;
                    const f32x4 a = acc[ai][bj][m][0], b = acc[ai][bj][m][1];
                    u32x4 w; w.x = cvtpk(gelu_tanh(a.x), gelu_tanh(a.y)); w.y = cvtpk(gelu_tanh(a.z), gelu_tanh(a.w)); w.z = cvtpk(gelu_tanh(b.x), gelu_tanh(b.y)); w.w = cvtpk(gelu_tanh(b.z), gelu_tanh(b.w));
                    *(u32x4*)(Z + ((size_t)r * 32 + i) * DSSM + u.aux * 16 + h) = w; } }
    }
};
struct EpiGlu {
    static constexpr bool HALFN = false, HOOKS = false, PERM = true;
    const bf16* Z; const float* bias; bf16* MIX; float* SSQ;
    __device__ __forceinline__ void operator()(const Acc& acc, const Unit& u, int wr, int wc, int fr, int fq) const {
        float ss[2][4];
#pragma unroll
        for (int ai = 0; ai < 2; ++ai)
#pragma unroll
            for (int m = 0; m < 4; ++m) ss[ai][m] = 0.f;
#pragma unroll
        for (int bj = 0; bj < 2; ++bj) { const int c0 = u.pn * BM + bj * HALF + 32 * wc + 8 * fq;
            constexpr float NL2E = -1.4426950408889634f;
            const f32x4 b0 = *(const GAS f32x4*)(bias + c0) * NL2E, b1 = *(const GAS f32x4*)(bias + c0 + 4) * NL2E;
#pragma unroll
            for (int ai = 0; ai < 2; ++ai)
#pragma unroll
                for (int m = 0; m < 4; ++m) { const size_t row = (size_t)(u.pm * BM + ai * HALF + wr * 64 + m * 16 + fr);
                    const u32x4 zz = *(const u32x4*)(Z + row * DSSM + c0);
                    const f32x4 a = acc[ai][bj][m][0], b = acc[ai][bj][m][1];
#define GLU_SG(v_, b_) __builtin_amdgcn_rcpf(1.f + __builtin_amdgcn_exp2f(__builtin_fmaf((v_), NL2E, (b_))))
                    float y[8];
                    y[0] = bf2f(zz.x & 0xffff) * GLU_SG(a.x, b0.x); y[1] = bf2f(zz.x >> 16) * GLU_SG(a.y, b0.y); y[2] = bf2f(zz.y & 0xffff) * GLU_SG(a.z, b0.z); y[3] = bf2f(zz.y >> 16) * GLU_SG(a.w, b0.w);
                    y[4] = bf2f(zz.z & 0xffff) * GLU_SG(b.x, b1.x); y[5] = bf2f(zz.z >> 16) * GLU_SG(b.y, b1.y); y[6] = bf2f(zz.w & 0xffff) * GLU_SG(b.z, b1.z); y[7] = bf2f(zz.w >> 16) * GLU_SG(b.w, b1.w);
#undef GLU_SG
                    { float sq = ss[ai][m];
#pragma unroll
                      for (int e = 0; e < 8; ++e) sq = __builtin_fmaf(y[e], y[e], sq);
                      ss[ai][m] = sq; }
                    u32x4 w; w.x = cvtpk(y[0], y[1]); w.y = cvtpk(y[2], y[3]); w.z = cvtpk(y[4], y[5]); w.w = cvtpk(y[6], y[7]);
                    *(u32x4*)(MIX + mix_off(row, c0)) = w; } }
#pragma unroll
        for (int ai = 0; ai < 2; ++ai)
#pragma unroll
            for (int m = 0; m < 4; ++m) { float v = xor32_sum(xor16_sum(ss[ai][m]));
                if (fq == 0) atomicAdd(SSQ + (u.pm * BM + ai * HALF + wr * 64 + m * 16 + fr), v); }
    }
};
struct EpiX1B {
    static constexpr bool HALFN = false, HOOKS = true, PERM = true;
    const float* RSTDX; bf16* X1B; const float* SSQS; const float* SSQA; LAS float* RSC;
    __device__ __forceinline__ void begin(const Unit&, int, int) const {}
    __device__ __forceinline__ void fill(int ui, int pm, int tid) const {
        if (tid < 256) { const int row = pm * BM + tid; const float rs = __builtin_amdgcn_rsqf(SSQS[row] * (1.f / 512.f) + EPS), ra = __builtin_amdgcn_rsqf(SSQA[row] * (1.f / 512.f) + EPS);
            LAS float* d = RSC + (ui * 256 + tid) * 3; d[0] = rs * __builtin_amdgcn_rcpf(ra); d[1] = ra; d[2] = __builtin_amdgcn_rcpf(RSTDX[row]); }
    }
    __device__ __forceinline__ void mid(Acc& acc, int ui, int wr, int fr) const {
#pragma unroll
        for (int ai = 0; ai < 2; ++ai)
#pragma unroll
            for (int m = 0; m < 4; ++m) { const float f = RSC[(ui * 256 + ai * HALF + wr * 64 + m * 16 + fr) * 3];
#pragma unroll
                for (int bj = 0; bj < 2; ++bj)
#pragma unroll
                    for (int n = 0; n < 2; ++n) acc[ai][bj][m][n] = acc[ai][bj][m][n] * f; }
    }
    __device__ __forceinline__ void fin(const Acc& acc, const Unit& u, int ui, int wr, int wc, int fr, int fq) const {
#pragma unroll
        for (int ai = 0; ai < 2; ++ai)
#pragma unroll
            for (int m = 0; m < 4; ++m) { const int rl = ai * HALF + wr * 64 + m * 16 + fr; const LAS float* rc = RSC + (ui * 256 + rl) * 3; const float ra = rc[1], ix = rc[2];
                const size_t ro = (size_t)(u.pm * BM + rl) * PX + u.pn * BM + 64 * wc + 8 * fq;
                u32x4 p[2];
#pragma unroll
                for (int bj = 0; bj < 2; ++bj) { const u32x4 xn = *(const u32x4*)(X1B + ro + 32 * bj);
                    const f32x4 xa = (f32x4){bf2f(xn.x & 0xffff), bf2f(xn.x >> 16), bf2f(xn.y & 0xffff), bf2f(xn.y >> 16)} * ix, xb = (f32x4){bf2f(xn.z & 0xffff), bf2f(xn.z >> 16), bf2f(xn.w & 0xffff), bf2f(xn.w >> 16)} * ix;
                    const f32x4 a = xa + acc[ai][bj][m][0] * ra, b = xb + acc[ai][bj][m][1] * ra;
                    p[bj].x = cvtpk(a.x, a.y); p[bj].y = cvtpk(a.z, a.w); p[bj].z = cvtpk(b.x, b.y); p[bj].w = cvtpk(b.z, b.w); }
                store_pair(X1B + (size_t)(u.pm * BM + (rl & ~1)) * PX + u.pn * BM + 64 * wc, PX, p[0], p[1], fr, fq); }
    }
};
struct EpiGU {
    static constexpr bool HALFN = false, HOOKS = true, PERM = true;
    __device__ __forceinline__ void begin(const Unit&, int, int) const {}
    __device__ __forceinline__ void mid(Acc&, int, int, int) const {}
    unsigned char* HH; const LAS unsigned* RCW;
    __device__ __forceinline__ void fin(const Acc& acc, const Unit& u, int ui, int wr, int wc, int fr, int fq) const {
#pragma unroll
        for (int ai = 0; ai < 2; ++ai)
#pragma unroll
            for (int m = 0; m < 4; ++m) { const int rl = ai * HALF + wr * 64 + m * 16 + fr, rr = u.pm * BM + rl; const size_t off = (size_t)rr * DE + u.pn * 128 + 32 * wc + 8 * fq;
                const float sc = __uint_as_float(RCW[ui * 256 + rl] & 0xffff0000u) * (1.f / W8SC), k1 = sc * -1.4426950408889634f, sc2 = sc * sc;
#define GU_H(g_, u_) (((g_) * (u_)) * __builtin_amdgcn_rcpf(1.f + __builtin_amdgcn_exp2f((g_) * k1)) * sc2)
                float hv[8];
#pragma unroll
                for (int n = 0; n < 2; ++n) { const f32x4 gt = acc[ai][0][m][n], up = acc[ai][1][m][n];
                    hv[4 * n] = GU_H(gt.x, up.x); hv[4 * n + 1] = GU_H(gt.y, up.y); hv[4 * n + 2] = GU_H(gt.z, up.z); hv[4 * n + 3] = GU_H(gt.w, up.w); }
#undef GU_H
                u32x2 w; w.x = pk4_fp8(hv[0], hv[1], hv[2], hv[3]); w.y = pk4_fp8(hv[4], hv[5], hv[6], hv[7]);
                *(u32x2*)(HH + off) = w; }
    }
};
struct EpiDown {
    static constexpr bool HALFN = false, HOOKS = true, PERM = true;
    __device__ __forceinline__ void begin(const Unit&, int, int) const {}
    __device__ __forceinline__ void mid(Acc&, int, int, int) const {}
    unsigned char* YE; const LAS float* RGC;
    __device__ __forceinline__ void fin(const Acc& acc, const Unit& u, int ui, int wr, int wc, int fr, int fq) const {
#pragma unroll
        for (int ai = 0; ai < 2; ++ai)
#pragma unroll
            for (int m = 0; m < 4; ++m) { const int rl = ai * HALF + wr * 64 + m * 16 + fr; const float gw_ = RGC[ui * 256 + rl] * (YE_SCALE / W8SC);
                u32x2 p[2];
#pragma unroll
                for (int bj = 0; bj < 2; ++bj) { const f32x4 a = acc[ai][bj][m][0] * gw_, b = acc[ai][bj][m][1] * gw_; p[bj].x = pk4_fp8(a.x, a.y, a.z, a.w); p[bj].y = pk4_fp8(b.x, b.y, b.z, b.w); }
                const bool od = fq & 1; const u32x2 send = od ? p[0] : p[1]; u32x2 recv; recv.x = xor16_get(send.x, od); recv.y = xor16_get(send.y, od);
                u32x4 w; if (od) { w.x = recv.x; w.y = recv.y; w.z = p[1].x; w.w = p[1].y; } else { w.x = p[0].x; w.y = p[0].y; w.z = recv.x; w.w = recv.y; }
                *(u32x4*)(YE + (size_t)(u.pm * BM + rl) * DM + u.pn * BM + 64 * wc + (od ? 32 : 0) + 8 * (fq & ~1)) = w; }
    }
};

template <int K> __device__ __forceinline__ const float* karg() {
    const float* p;
    asm volatile("s_load_dwordx2 %0, %1, %2\n\ts_waitcnt lgkmcnt(0)" : "=s"(p) : "s"(__builtin_amdgcn_kernarg_segment_ptr()), "i"(K * 8) : "memory");
    return p;
}
struct Args { const float* in[26]; float* out; unsigned char* ws; int ph_lo, ph_hi; };
struct Frame { LAS unsigned char* lds; volatile LAS unsigned* MISC; unsigned* ctl; int tid, lane, wave, G, c; };

struct TItem { const float* W; int ldw, srccol0; const float* kscale; bf16* WT; int ldt, dstrow0, k0; int fp8; };
__device__ __forceinline__ void titem_load(const TItem& t, int lane, f32x4 (&v)[8]) {
#pragma unroll
    for (int i = 0; i < 8; ++i) { const int kk = 8 * i + (lane >> 3); v[i] = *(const GAS f32x4*)(t.W + (size_t)(t.k0 + kk) * t.ldw + t.srccol0 + (lane & 7) * 4); }
}
__device__ __forceinline__ void titem_store(const TItem& t, int lane, const f32x4 (&v)[8], LAS float* scr) {
#pragma unroll
    for (int i = 0; i < 8; ++i) { const int kk = 8 * i + (lane >> 3); const float sc = t.kscale ? t.kscale[t.k0 + kk] : 1.f; LAS float* d = scr + kk * 33 + (lane & 7) * 4;
        d[0] = v[i].x * sc; d[1] = v[i].y * sc; d[2] = v[i].z * sc; d[3] = v[i].w * sc; }
    asm volatile("s_waitcnt lgkmcnt(0)" ::: "memory");
    const int c = lane & 7;
#pragma unroll
    for (int j = 0; j < 4; ++j) { const int n = (lane >> 3) + 8 * j; const LAS float* s = scr + (8 * c) * 33 + n;
        if (t.fp8) { u32x2 o; o.x = pk4_fp8(s[0 * 33] * W8SC, s[1 * 33] * W8SC, s[2 * 33] * W8SC, s[3 * 33] * W8SC); o.y = pk4_fp8(s[4 * 33] * W8SC, s[5 * 33] * W8SC, s[6 * 33] * W8SC, s[7 * 33] * W8SC);
            *(u32x2*)((unsigned char*)t.WT + (size_t)(t.dstrow0 + n) * t.ldt + t.k0 + 8 * c) = o; }
        else { u32x4 o; o.x = pk2(s[0 * 33], s[1 * 33]); o.y = pk2(s[2 * 33], s[3 * 33]); o.z = pk2(s[4 * 33], s[5 * 33]); o.w = pk2(s[6 * 33], s[7 * 33]);
            *(u32x4*)(t.WT + (size_t)(t.dstrow0 + n) * t.ldt + t.k0 + 8 * c) = o; } }
    asm volatile("s_waitcnt lgkmcnt(0)" ::: "memory");
}
__device__ __forceinline__ void s5_tables_item(Frame& F, const Args& a, int g, int part) {
    const float* lre = karg<3>(); const float* lim = karg<4>(); const float* ldt = karg<5>(); const float* bre = karg<6>(); const float* bim = karg<7>();
    const float* cre = karg<8>(); const float* cim = karg<9>(); const float* dsk = karg<10>();
    LAS float* PWr = (LAS float*)F.lds; LAS float* PWi = PWr + 33 * 64; LAS float* BBr = PWi + 33 * 64; LAS float* BBi = BBr + 1024; LAS float* CCr = BBi + 1024; LAS float* CCi = CCr + 1024; LAS float* CF = CCi + 1024;
    const int tid = F.tid;
    if (tid < 64) { const int p = tid;
        const double dt = exp((double)ldt[g]), lr = lre[g * PST + p], li = lim[g * PST + p];
        double sn, cs; sincos_d(li * dt, sn, cs); const double mag = exp(lr * dt);
        const double ar = mag * cs, ai = mag * sn, den = lr * lr + li * li, nr = ar - 1.0, ni = ai;
        CF[2 * p] = (float)((nr * lr + ni * li) / den); CF[2 * p + 1] = (float)((ni * lr - nr * li) / den);
        double pr = 1.0, pi = 0.0;
        for (int l = 0; l <= 32; ++l) { PWr[l * 64 + p] = (float)pr; PWi[l * 64 + p] = (float)pi; if (l == 32 && part == 0) { float* A32 = (float*)(a.ws + FW_A32) + (g * PST + p) * 2; A32[0] = (float)pr; A32[1] = (float)pi; }
            const double t = pr * ar - pi * ai; pi = pr * ai + pi * ar; pr = t; }
    }
    __syncthreads();
    for (int idx = tid; idx < 1024; idx += NTHR) { const int p = idx >> 4; const float cfr = CF[2 * p], cfi = CF[2 * p + 1], br = bre[(size_t)g * 1024 + idx], bi = bim[(size_t)g * 1024 + idx];
        BBr[idx] = cfr * br - cfi * bi; BBi[idx] = cfr * bi + cfi * br; CCr[idx] = cre[(size_t)g * 1024 + idx]; CCi[idx] = cim[(size_t)g * 1024 + idx]; }
    __syncthreads();
    bf16* TBg = (bf16*)(a.ws + FW_TB) + (size_t)g * 512 * U2P; bf16* W1g = (bf16*)(a.ws + FW_W1) + (size_t)g * 256 * 512;
    for (int l = part; l < 32; l += 8) {
        if (tid < 256) { const int h = tid >> 4, hp = tid & 15; float k = 0.f;
#pragma unroll 16
            for (int p = 0; p < 64; ++p) { const float wr_ = PWr[l * 64 + p], wi_ = PWi[l * 64 + p], br = BBr[p * 16 + hp], bi = BBi[p * 16 + hp];
                k += CCr[h * 64 + p] * (wr_ * br - wi_ * bi) - CCi[h * 64 + p] * (wr_ * bi + wi_ * br); }
            if (l == 0 && h == hp) k += dsk[g * 16 + h];
            const bf16 v = (bf16)f2bf(k);
            for (int i = l; i < 32; ++i) TBg[(size_t)(i * 16 + h) * U2P + (i - l) * 16 + hp] = v;
            if (l >= 1) for (int i = 0; i < 32 - l; ++i) TBg[(size_t)(i * 16 + h) * U2P + (i + l) * 16 + hp] = 0;
        } else { const int t2 = tid - 256;
#pragma unroll
            for (int x = 0; x < 8; ++x) { const int e = t2 * 8 + x;
                { const int h = e >> 7, q = e & 127, p = q & 63; const float cr = CCr[h * 64 + p], ci = CCi[h * 64 + p], wr_ = PWr[(l + 1) * 64 + p], wi_ = PWi[(l + 1) * 64 + p];
                  const float re = cr * wr_ - ci * wi_, im = cr * wi_ + ci * wr_; TBg[(size_t)(l * 16 + h) * U2P + 512 + q] = (bf16)f2bf(q < 64 ? re : -im); }
                { const int rho = e >> 4, hp = e & 15, p = rho & 63; const float wr_ = PWr[(31 - l) * 64 + p], wi_ = PWi[(31 - l) * 64 + p], br = BBr[p * 16 + hp], bi = BBi[p * 16 + hp];
                  const float re = wr_ * br - wi_ * bi, im = wr_ * bi + wi_ * br; W1g[(size_t)rho * 512 + l * 16 + hp] = (bf16)f2bf(rho < 64 ? re : im); W1g[(size_t)(128 + rho) * 512 + l * 16 + hp] = 0; }
            }
        }
    }
    __syncthreads();
}
#ifndef XNR
#define XNR 8
#endif
__device__ __forceinline__ void p0_prologue(Frame& F, const Args& a) {
    const float* x = karg<0>();
    for (int it = F.c; it < 256; it += F.G) s5_tables_item(F, a, it >> 3, it & 7);
    LAS float* scr = (LAS float*)(F.lds + F.wave * 16384);
    const int gw = F.c * NWAVES + F.wave, NGW = F.G * NWAVES;
    constexpr int I_IN = 16 * 64, I_GLU = 8 * 16, I_OUT = 16 * 32, I_GU = 32 * 16 * 32, I_D = 32 * 8 * 32, NITEMS = I_IN + I_GLU + I_OUT + I_GU + I_D;
    bf16* WIN = (bf16*)(a.ws + FW_WIN); bf16* WGLU = (bf16*)(a.ws + FW_WGLU); bf16* WOUT = (bf16*)(a.ws + FW_WOUT); bf16* WGU = (bf16*)(a.ws + FW_WGU); bf16* WD = (bf16*)(a.ws + FW_WD);
    auto mkitem = [&](int it) -> TItem {
        int r = it;
        if (r < I_IN) { const int kb = r >> 6, d = r & 63, pn = d >> 3, beta = d & 7, bj = beta >> 2, wc = beta & 3;
            return TItem{karg<2>(), DIN, 256 * pn + 32 * (2 * wc + bj), karg<1>(), WIN, PW, 32 * d, 64 * kb, 0}; } r -= I_IN;
        if (r < I_GLU) { const int kb = r >> 4, d = r & 15; return TItem{karg<11>(), DSSM, 32 * d, nullptr, WGLU, DSSM, 32 * d, 64 * kb, 0}; } r -= I_GLU;
        if (r < I_OUT) { const int kb = r >> 5, d = r & 31; const float* ks = (kb < 8) ? karg<15>() : (karg<16>() - 512);
            return TItem{karg<17>(), DM, 32 * (8 * (d >> 3) + 2 * (d & 3) + ((d & 7) >> 2)), ks, WOUT, PW, 32 * d, 64 * kb, 0}; } r -= I_OUT;
        if (r < I_GU) { const int e = r >> 9, q = r & 511, kb = q >> 5, d = q & 31, pn = d >> 3, beta = d & 7;
            const float* W = (beta < 4 ? karg<23>() : karg<24>()) + (size_t)e * DM * DE;
            return TItem{W, DE, 128 * pn + 32 * (beta & 3), karg<18>(), (bf16*)((unsigned char*)WGU + (size_t)e * DM * DM), DM, 32 * d, 64 * kb, 1}; } r -= I_GU;
        const int e = r >> 8, q = r & 255, kb = q >> 5, d = q & 31;
        return TItem{karg<25>() + (size_t)e * DE * DM, DM, 32 * (8 * (d >> 3) + 2 * (d & 3) + ((d & 7) >> 2)), nullptr, (bf16*)((unsigned char*)WD + (size_t)e * DM * DE), DE, 32 * d, 64 * kb, 1};
    };
    if (gw < NITEMS) {
        TItem cur = mkitem(gw); f32x4 vc[8]; titem_load(cur, F.lane, vc);
        for (int it = gw; it < NITEMS; it += NGW) {
            const bool more = it + NGW < NITEMS; TItem nxt = cur; f32x4 vn[8];
            if (more) { nxt = mkitem(it + NGW); titem_load(nxt, F.lane, vn); }
            titem_store(cur, F.lane, vc, scr);
            if (more) { cur = nxt;
#pragma unroll
                for (int i = 0; i < 8; ++i) vc[i] = vn[i]; }
        }
    }
    { bf16* WR = (bf16*)(a.ws + FW_WR);
      for (int idx = F.c * NTHR + F.tid; idx < 64 * DM; idx += F.G * NTHR) { const int n = idx >> 10, k = idx & 1023;
          float v = 0.f; if (n < 4) v = karg<19>()[k * 4 + n]; else if (n < 36) v = karg<21>()[k * 32 + (n - 4)];
          WR[idx] = (bf16)f2bf(v * karg<18>()[k]); } }
    bf16* XN = (bf16*)(a.ws + FW_XN); float* RSTDX = (float*)(a.ws + FW_RSTDX);
    for (int m0 = gw * XNR; m0 < M; m0 += NGW * XNR) {
        f32x4 v[XNR][4];
#pragma unroll
        for (int rr = 0; rr < XNR; ++rr) { const GAS f32x4* xr = (const GAS f32x4*)(x + (size_t)(m0 + rr) * DM);
            v[rr][0] = __builtin_nontemporal_load(xr + 2 * F.lane); v[rr][1] = __builtin_nontemporal_load(xr + 2 * F.lane + 1);
            v[rr][2] = __builtin_nontemporal_load(xr + 128 + 2 * F.lane); v[rr][3] = __builtin_nontemporal_load(xr + 128 + 2 * F.lane + 1); }
#pragma unroll
        for (int rr = 0; rr < XNR; ++rr) { float s = 0.f;
#pragma unroll
            for (int j = 0; j < 4; ++j) s += v[rr][j].x * v[rr][j].x + v[rr][j].y * v[rr][j].y + v[rr][j].z * v[rr][j].z + v[rr][j].w * v[rr][j].w;
            const float rstd = __builtin_amdgcn_rsqf(wave_sum(s) * (1.f / DM) + EPS);
            if (F.lane == 0) RSTDX[m0 + rr] = rstd;
            u32x4* o = (u32x4*)(XN + (size_t)(m0 + rr) * PX);
#pragma unroll
            for (int j = 0; j < 2; ++j) { const f32x4 a = v[rr][2 * j] * rstd, b = v[rr][2 * j + 1] * rstd; u32x4 w; w.x = cvtpk(a.x, a.y); w.y = cvtpk(a.z, a.w); w.z = cvtpk(b.x, b.y); w.w = cvtpk(b.z, b.w); o[64 * j + F.lane] = w; } }
    }
}

__device__ __forceinline__ void s5_scan_local(Frame& F, const Args& a, int g, int pm) {
    const float* SST = (const float*)(a.ws + FW_SST); bf16* U2 = (bf16*)(a.ws + FW_U2);
    if (F.tid < 256) {
        const int p = F.tid & 63;
        const float* A32 = (const float*)(a.ws + FW_A32) + (g * PST + p) * 2; const float ar = A32[0], ai = A32[1];
        float xr = 0.f, xi = 0.f;
        const size_t row0 = (size_t)g * NCH + (size_t)pm * 256 + (size_t)(F.tid >> 6) * 64;
        for (int c0 = 0; c0 < 64; c0 += 16) {
            float sr[16], si[16];
#pragma unroll
            for (int j = 0; j < 16; ++j) { sr[j] = SST[(row0 + c0 + j) * 128 + p]; si[j] = SST[(row0 + c0 + j) * 128 + 64 + p]; }
#pragma unroll
            for (int j = 0; j < 16; ++j) { bf16* up = U2 + (row0 + c0 + j) * U2P + 512; up[p] = (bf16)f2bf(xr); up[64 + p] = (bf16)f2bf(xi);
                const float t = ar * xr - ai * xi + sr[j]; xi = ar * xi + ai * xr + si[j]; xr = t; }
        }
    }
}
__device__ __forceinline__ void s5_scan(Frame& F, const Args& a) {
    const float* SST = (const float*)(a.ws + FW_SST); bf16* U2 = (bf16*)(a.ws + FW_U2);
    for (int idx = F.c * NTHR + F.tid; idx < BATCH * NG * PST; idx += F.G * NTHR) {
        const int p = idx & 63, g = (idx >> 6) & 31, b = idx >> 11;
        const double dt = exp((double)karg<5>()[g]), lr = karg<3>()[g * PST + p], li = karg<4>()[g * PST + p];
        double sn, cs; sincos_d(32.0 * li * dt, sn, cs); const double mag = exp(32.0 * lr * dt);
        const float ar = (float)(mag * cs), ai = (float)(mag * sn);
        float xr = 0.f, xi = 0.f;
        const size_t row0 = (size_t)g * NCH + (size_t)b * 64;
        for (int c0 = 0; c0 < 64; c0 += 16) {
            float sr[16], si[16];
#pragma unroll
            for (int j = 0; j < 16; ++j) { sr[j] = SST[(row0 + c0 + j) * 128 + p]; si[j] = SST[(row0 + c0 + j) * 128 + 64 + p]; }
#pragma unroll
            for (int j = 0; j < 16; ++j) { bf16* up = U2 + (row0 + c0 + j) * U2P + 512; up[p] = (bf16)f2bf(xr); up[64 + p] = (bf16)f2bf(xi);
                const float t = ar * xr - ai * xi + sr[j]; xi = ar * xi + ai * xr + si[j]; xr = t; }
        }
    }
}

#ifndef ATT_THR_V
#define ATT_THR_V -32.f
#endif
constexpr float ATT_THR = ATT_THR_V;
__device__ __forceinline__ s16x4 vtr(const LAS unsigned char* p) { typedef short v4i16_t __attribute__((ext_vector_type(4))); return __builtin_bit_cast(s16x4, __builtin_amdgcn_ds_read_tr16_b64_v4i16((LAS v4i16_t*)p)); }
__device__ __forceinline__ int crow(int r, int hi) { return (r & 3) + 8 * (r >> 2) + 4 * hi; }
#define MFMA32(a, b, c) __builtin_amdgcn_mfma_f32_32x32x16_bf16((a), (b), (c), 0, 0, 0)
template <bool DIAG, int P, int KH, int KD, int VD>
__device__ __forceinline__ float attn_half(const LAS unsigned char* Kb, const LAS unsigned char* Vb, const bf16x8 (&qr)[4], const bf16x8 (&tri)[2], f32x16 (&o)[2], float base, int lim, int lane) {
    const int r32 = lane & 31, hi = lane >> 5;
    const LAS unsigned char* kp = Kb + hi * KH + r32 * 16 + P * 512;
    const int lim2 = lim - 4 * hi;
    f32x16 z = {};
#pragma unroll
    for (int d0 = 0; d0 < 4; ++d0) { const bf16x8 kf = *(const LAS bf16x8*)(kp + d0 * KD); z = MFMA32(kf, qr[d0], z); }
    float l[16];
#pragma unroll
    for (int r = 0; r < 16; ++r) { l[r] = -__builtin_amdgcn_logf(1.f + __builtin_amdgcn_exp2f(z[r])); if (DIAG) { if (!((r & 3) + 8 * (r >> 2) + 32 * P < lim2)) l[r] = 0.f; } }
    u32x4 wa, wb;
    wa.x = cvtpk(l[0], l[1]); wa.y = cvtpk(l[2], l[3]); wa.z = cvtpk(l[4], l[5]); wa.w = cvtpk(l[6], l[7]);
    wb.x = cvtpk(l[8], l[9]); wb.y = cvtpk(l[10], l[11]); wb.z = cvtpk(l[12], l[13]); wb.w = cvtpk(l[14], l[15]);
    const bf16x8 La = __builtin_bit_cast(bf16x8, wa), Lb = __builtin_bit_cast(bf16x8, wb);
    f32x16 T = {};
    T = MFMA32(tri[0], La, T); T = MFMA32(tri[1], Lb, T);
    float av[16];
#pragma unroll
    for (int r = 0; r < 16; ++r) { av[r] = __builtin_amdgcn_exp2f((z[r] + base) + T[r]); if (DIAG) { if (!((r & 3) + 8 * (r >> 2) + 32 * P < lim2)) av[r] = 0.f; } }
    wa.x = cvtpk(av[0], av[1]); wa.y = cvtpk(av[2], av[3]); wa.z = cvtpk(av[4], av[5]); wa.w = cvtpk(av[6], av[7]);
    wb.x = cvtpk(av[8], av[9]); wb.y = cvtpk(av[10], av[11]); wb.z = cvtpk(av[12], av[13]); wb.w = cvtpk(av[14], av[15]);
    const bf16x8 Pa = __builtin_bit_cast(bf16x8, wa), Pb = __builtin_bit_cast(bf16x8, wb);
    const LAS unsigned char* vp = Vb + ((lane >> 4) & 1) * 32 + (lane & 3) * 8 + (4 * hi + ((lane & 15) >> 2)) * 64 + P * 2048;
#pragma unroll
    for (int d0 = 0; d0 < 2; ++d0) {
        const s16x4 lo0 = vtr(vp + d0 * VD), hi0 = vtr(vp + d0 * VD + 512), lo1 = vtr(vp + d0 * VD + 1024), hi1 = vtr(vp + d0 * VD + 1536);
        const bf16x8 v0 = {lo0[0], lo0[1], lo0[2], lo0[3], hi0[0], hi0[1], hi0[2], hi0[3]}, v1 = {lo1[0], lo1[1], lo1[2], lo1[3], hi1[0], hi1[1], hi1[2], hi1[3]};
        o[d0] = MFMA32(Pa, v0, o[d0]); o[d0] = MFMA32(Pb, v1, o[d0]);
    }
    { const unsigned u = __builtin_bit_cast(unsigned, T[0]); auto r = __builtin_amdgcn_permlane32_swap(u, u, false, false); return __builtin_bit_cast(float, (unsigned)r[0]); }
}
#ifndef ASPAN_N
#define ASPAN_N 13
#endif
constexpr int ASPAN = ASPAN_N;
__device__ __forceinline__ void attn_span_phase(Frame& F, const bf16* Q, const bf16* Kg, const bf16* Vg, bf16* MIX, float* SSQA) {
    const int lane = F.lane, wid = F.wave, r32 = lane & 31, hi = lane >> 5;
    volatile LAS int* FLG = (volatile LAS int*)(F.lds + ASPAN * 8192 + 8 * 4096);
    bf16x8 tri[2];
#pragma unroll
    for (int s = 0; s < 2; ++s)
#pragma unroll
        for (int j = 0; j < 8; ++j) tri[s][j] = ((16 * s + 8 * (j >> 2) + 4 * hi + (j & 3)) >= r32) ? (short)0x3F80 : (short)0;
    for (int L = F.c; L < BATCH * NH * 8; L += F.G) {
        const int bh = L >> 3, qb = L & 7, b = bh >> 3, h = bh & 7, a0 = 8 * qb, a = a0 + wid;
        const size_t row0 = (size_t)b * SEQ; const int qg = 32 * a + r32;
        bf16x8 qr[4];
#pragma unroll
        for (int d0 = 0; d0 < 4; ++d0) qr[d0] = *(const bf16x8*)(Q + (row0 + qg) * DATT + h * HD + d0 * 16 + hi * 8);
        const bf16* src = (wid < 4) ? (Kg + (row0 + (lane & 31)) * DATT + h * HD + (lane >> 5) * 8 + 16 * wid)
                                    : (Vg + (row0 + 16 * (wid & 1) + (lane >> 2)) * DATT + h * HD + (lane & 3) * 8 + 32 * ((wid - 4) >> 1));
        const int dsto = (wid < 4) ? wid * 1024 : 4096 + (wid - 4) * 1024;
        f32x16 o[2] = {}; float Rc = 0.f; bool done = false;
        for (int k = 0;; ++k) {
            const int top = a0 + 7 - ASPAN * k, bot = (top - (ASPAN - 1) > 0) ? top - (ASPAN - 1) : 0;
#pragma unroll 1
            for (int jj = top; jj >= bot; --jj)
                __builtin_amdgcn_global_load_lds((const unsigned*)(src + (size_t)(32 * jj) * DATT), (LAS unsigned*)(F.lds + (top - jj) * 8192 + dsto), 16, 0, 0);
            asm volatile("s_waitcnt vmcnt(0)" ::: "memory");
            __syncthreads();
            if (!done) {
                for (int jj = (a < top ? a : top); jj >= bot; --jj) {
                    const LAS unsigned char* Kb = F.lds + (top - jj) * 8192; const LAS unsigned char* Vb = Kb + 4096;
                    const int lim = qg - 32 * jj;
                    float sh;
                    if (jj == a) sh = attn_half<true, 0, 512, 1024, 2048>(Kb, Vb, qr, tri, o, Rc, lim, lane);
                    else sh = attn_half<false, 0, 512, 1024, 2048>(Kb, Vb, qr, tri, o, Rc, lim, lane);
                    Rc += sh;
                    if (jj == 0 || __all(Rc < ATT_THR)) { done = true; break; }
                }
            }
            if (lane == 0) FLG[wid] = done ? 1 : 0;
            asm volatile("s_waitcnt lgkmcnt(0)" ::: "memory");
            __syncthreads();
            if (bot == 0) break;
            int alld = 1;
#pragma unroll
            for (int w = 0; w < 8; ++w) alld &= FLG[w];
            if (alld) break;
        }
        { LAS unsigned char* stg = F.lds + ASPAN * 8192 + wid * 4096; LAS unsigned short* sp = (LAS unsigned short*)(stg + hi * 512 + r32 * 2);
#pragma unroll
          for (int r = 0; r < 16; ++r) { const int ro = ((r & 3) + 8 * (r >> 2)) * 64; sp[ro] = (unsigned short)f2bf(o[0][r]); sp[ro + 32] = (unsigned short)f2bf(o[1][r]); }
          asm volatile("s_waitcnt lgkmcnt(0)" ::: "memory");
          const size_t om = row0 + 32 * a;
#pragma unroll
          for (int i = 0; i < 4; ++i) { const int row = i * 8 + (lane >> 3), ch = lane & 7; const u32x4 v = *(const LAS u32x4*)(stg + row * 128 + ch * 16); *(u32x4*)(MIX + mix_off(om + row, 512 + h * HD + ch * 8)) = v;
              const float f0 = bf2f(v.x & 0xffff), f1 = bf2f(v.x >> 16), f2 = bf2f(v.y & 0xffff), f3 = bf2f(v.y >> 16), f4 = bf2f(v.z & 0xffff), f5 = bf2f(v.z >> 16), f6 = bf2f(v.w & 0xffff), f7 = bf2f(v.w >> 16);
              float ss = ((f0 * f0 + f1 * f1) + (f2 * f2 + f3 * f3)) + ((f4 * f4 + f5 * f5) + (f6 * f6 + f7 * f7));
              ss += dppf<0xB1>(ss); ss += dppf<0x4E>(ss); ss += dppf<0x141>(ss);
              if (ch == 0) atomicAdd(SSQA + (row0 + 32 * a + row), ss); }
          asm volatile("s_waitcnt lgkmcnt(0)" ::: "memory"); }
    }
    asm volatile("s_waitcnt vmcnt(0)" ::: "memory");
    __syncthreads();
}
static_assert(ASPAN * 8192 + 8 * 4096 + 64 <= MISC_OFF, "attention LDS map");

constexpr int RT_PITCH = 2064;
__device__ __forceinline__ void router_phase(Frame& F, const Args& a) {
    const bf16* X1B = (const bf16*)(a.ws + FW_X1B); unsigned char* X1Q = (unsigned char*)(a.ws + FW_X1Q); int* TOK = (int*)(a.ws + FW_TOK); const bf16* WR = (const bf16*)(a.ws + FW_WR);
    const float* brg = karg<20>(); const float* bre_ = karg<22>();
    const int tid = F.tid, lane = F.lane, wid = F.wave, r32 = lane & 31, hi = lane >> 5;
    LAS unsigned char* TILE = F.lds;
    LAS float* PART = (LAS float*)(F.lds + 66048);
    LAS float* LOGIT = (LAS float*)(F.lds + 66048 + 65536);
    LAS int* HIST = (LAS int*)(F.lds + 66048 + 65536 + 5120);
    LAS int* TREC = HIST + 64;
    LAS float* RS = (LAS float*)(TREC + 1024);
    LAS float* TRS = RS + 32;
    LAS float* TRG = TRS + 256;
    LAS float* BIAS = TRG + 512;
    static_assert(66048 + 65536 + 5120 + 256 + 4096 + 128 + 1024 + 2048 + 160 <= MISC_OFF, "router LDS");
    bf16x8 Bf[8][2];
#pragma unroll
    for (int s = 0; s < 8; ++s)
#pragma unroll
        for (int nb = 0; nb < 2; ++nb) Bf[s][nb] = *(const bf16x8*)(WR + (size_t)(32 * nb + r32) * DM + 128 * wid + 16 * s + 8 * hi);
    if (tid < 64) HIST[tid] = 0;
    if (tid >= 64 && tid < 104) { const int c = tid - 64; BIAS[c] = c < 4 ? brg[c] : (c < 36 ? bre_[c - 4] : 0.f); }
    __syncthreads();
    int ntl = 0;
#define RT_BAR() do { asm volatile("s_waitcnt lgkmcnt(0)" ::: "memory"); __builtin_amdgcn_s_barrier(); asm volatile("" ::: "memory"); } while (0)
#define RT_LOAD(tile_) do { _Pragma("unroll") for (int rr = 0; rr < 4; ++rr) { const u32x4* xr = (const u32x4*)(X1B + (size_t)((tile_) * 32 + 4 * wid + rr) * PX); v[rr][0] = xr[lane]; v[rr][1] = xr[64 + lane]; } } while (0)
    u32x4 v[4][2];
    if (F.c < M / 32) RT_LOAD(F.c);
    for (int tile = F.c; tile < M / 32; tile += F.G, ++ntl) {
        {
#pragma unroll
          for (int rr = 0; rr < 4; ++rr) { const int lr = 4 * wid + rr; float s = 0.f;
#pragma unroll
              for (int j = 0; j < 2; ++j) { const u32x4 w = v[rr][j];
                  const float f0 = bf2f(w.x & 0xffff), f1 = bf2f(w.x >> 16), f2 = bf2f(w.y & 0xffff), f3 = bf2f(w.y >> 16), f4 = bf2f(w.z & 0xffff), f5 = bf2f(w.z >> 16), f6 = bf2f(w.w & 0xffff), f7 = bf2f(w.w >> 16);
                  s += (f0 * f0 + f1 * f1) + (f2 * f2 + f3 * f3) + (f4 * f4 + f5 * f5) + (f6 * f6 + f7 * f7);
                  { u32x2 q8; q8.x = pk4_fp8(f0, f1, f2, f3); q8.y = pk4_fp8(f4, f5, f6, f7); *(u32x2*)(X1Q + (size_t)(tile * 32 + lr) * DM + (64 * j + lane) * 8) = q8; }
                  *(LAS u32x4*)(TILE + lr * RT_PITCH + (64 * j + lane) * 16) = w; }
              const float rstd = __builtin_amdgcn_rsqf(wave_sum(s) * (1.f / DM) + EPS);
              if (lane == 0) RS[lr] = rstd; } }
        if (tile + F.G < M / 32) RT_LOAD(tile + F.G);
        RT_BAR();
        { f32x16 c0 = {}, c1 = {};
#pragma unroll
          for (int s = 0; s < 8; ++s) { const bf16x8 af = *(const LAS bf16x8*)(TILE + r32 * RT_PITCH + (128 * wid + 16 * s + 8 * hi) * 2);
              c0 = MFMA32(af, Bf[s][0], c0); c1 = MFMA32(af, Bf[s][1], c1); }
#pragma unroll
          for (int r = 0; r < 16; ++r) { const int t = crow(r, hi); PART[(wid * 32 + t) * 64 + r32] = c0[r]; PART[(wid * 32 + t) * 64 + 32 + r32] = c1[r]; } }
        RT_BAR();
        { const int t = tid >> 4, c4 = (tid & 15) * 4;
          if (c4 < 40) { f32x4 s = {0.f, 0.f, 0.f, 0.f};
#pragma unroll
              for (int w = 0; w < 8; ++w) s += *(const LAS f32x4*)(PART + (w * 32 + t) * 64 + c4);
              *(LAS f32x4*)(LOGIT + t * 40 + c4) = s * RS[t] + *(const LAS f32x4*)(BIAS + c4); } }
        RT_BAR();
        if (tid < 32) { const int m = tile * 32 + tid; float lg[36];
#pragma unroll
            for (int c = 0; c < 36; ++c) lg[c] = LOGIT[tid * 40 + c];
            int gi = 0; float gm = lg[0];
#pragma unroll
            for (int c = 1; c < 4; ++c) if (lg[c] > gm) { gm = lg[c]; gi = c; }
            float gsum = 0.f;
#pragma unroll
            for (int c = 0; c < 4; ++c) gsum += __expf(lg[c] - gm);
            const float pgrp = 1.f / gsum;
            float el[8];
#pragma unroll
            for (int e = 0; e < 8; ++e) { float t = 0.f;
#pragma unroll
                for (int g2 = 0; g2 < 4; ++g2) if (g2 == gi) t = lg[4 + g2 * 8 + e];
                el[e] = t; }
            int i0 = 0; float m0 = el[0];
#pragma unroll
            for (int e = 1; e < 8; ++e) if (el[e] > m0) { m0 = el[e]; i0 = e; }
            int i1 = 0; float m1 = -3.0e38f;
#pragma unroll
            for (int e = 0; e < 8; ++e) if (e != i0 && el[e] > m1) { m1 = el[e]; i1 = e; }
            const float e1 = __expf(m1 - m0), p0 = 1.f / (1.f + e1), p1 = e1 / (1.f + e1);
            const int ex0 = gi * 8 + i0, ex1 = gi * 8 + i1;
            const int rk0 = atomicAdd((int*)&HIST[ex0], 1), rk1 = atomicAdd((int*)&HIST[ex1], 1);
            int* tk = TOK + (size_t)m * 8; tk[0] = ex0; tk[1] = ex1; tk[2] = __float_as_int(pgrp * p0); tk[3] = __float_as_int(pgrp * p1);
            LAS int* tr = TREC + (ntl * 32 + tid) * 4; tr[0] = ex0; tr[1] = ex1; tr[2] = rk0; tr[3] = rk1;
            TRS[ntl * 32 + tid] = RS[tid]; TRG[2 * (ntl * 32 + tid)] = pgrp * p0; TRG[2 * (ntl * 32 + tid) + 1] = pgrp * p1;
        }
        RT_BAR();
    }
#undef RT_BAR
#undef RT_LOAD
    if (tid < 32) { const int cnt = HIST[tid]; int base = 0; if (cnt > 0) base = (int)__hip_atomic_fetch_add(F.ctl + CW_CNT + tid, (unsigned)cnt, RLX_AGENT); HIST[32 + tid] = base; }
    __syncthreads();
    unsigned* ETOK = (unsigned*)(a.ws + FW_ETOK); float* EG = (float*)(a.ws + FW_EG);
    for (int i = tid; i < ntl * 32; i += NTHR) { const int tile = F.c + (i >> 5) * F.G, m = tile * 32 + (i & 31); const LAS int* tr = TREC + i * 4;
        int* tk = TOK + (size_t)m * 8; const int s0 = HIST[32 + tr[0]] + tr[2], s1 = HIST[32 + tr[1]] + tr[3]; tk[4] = s0; tk[5] = s1;
        const unsigned word = (unsigned)m | (f2bf(TRS[i]) << 16);
        ETOK[(size_t)tr[0] * M + s0] = word; ETOK[(size_t)tr[1] * M + s1] = word; EG[(size_t)tr[0] * M + s0] = TRG[2 * i]; EG[(size_t)tr[1] * M + s1] = TRG[2 * i + 1]; }
    __syncthreads();
}
__device__ __forceinline__ int moe_tables(Frame& F) {
    LAS int* TST = (LAS int*)(F.lds + SCR2_OFF); LAS unsigned char* T2E = F.lds + SCR2_OFF + 256;
    if (F.tid < 64) {
        const int e = F.tid; int nt = 0;
        if (e < NE) { const int cnt = (int)__hip_atomic_load(F.ctl + CW_CNT + e, RLX_AGENT); nt = (cnt + 255) >> 8; TST[208 + e] = cnt; }
        int incl = nt;
#pragma unroll
        for (int o = 1; o < 32; o <<= 1) { const int v = __shfl_up(incl, o); if ((e & 31) >= o) incl += v; }
        const int start = incl - nt;
        if (e < NE) { TST[e] = start; for (int t = 0; t < nt; ++t) T2E[start + t] = (unsigned char)e; }
        if (e == NE - 1) TST[NE] = incl;
    }
    __syncthreads();
    return TST[NE];
}
#ifndef CTPT
#define CTPT 4
#endif
__device__ __forceinline__ void combine_phase(Frame& F, const Args& a) {
    const unsigned char* YE = (const unsigned char*)(a.ws + FW_YE); const bf16* X1B = (const bf16*)(a.ws + FW_X1B); const int* TOK = (const int*)(a.ws + FW_TOK); float* out = a.out;
    const LAS int* TST = (const LAS int*)(F.lds + SCR2_OFF);
    const int gw = F.c * NWAVES + F.wave, NGW = F.G * NWAVES, lane = F.lane;
    static_assert(CTPT * 8 <= 64, "one routing word per lane");
    int m0 = gw * CTPT;
    int w = 0; if (m0 < M) w = TOK[(size_t)m0 * 8 + (lane & (CTPT * 8 - 1))];
    for (; m0 < M; m0 += NGW * CTPT) {
        const int mn = m0 + NGW * CTPT;
        int wn = 0; if (mn < M) wn = TOK[(size_t)mn * 8 + (lane & (CTPT * 8 - 1))];
        const int tl = TST[w & 31];
        u32x2 xv[CTPT][4]; unsigned y0[CTPT][4], y1[CTPT][4];
#pragma unroll
        for (int t = 0; t < CTPT; ++t) {
            const size_t p0 = (size_t)__builtin_amdgcn_readlane(tl, 8 * t) * 256 + (size_t)__builtin_amdgcn_readlane(w, 8 * t + 4), p1 = (size_t)__builtin_amdgcn_readlane(tl, 8 * t + 1) * 256 + (size_t)__builtin_amdgcn_readlane(w, 8 * t + 5);
            const bf16* xr = X1B + (size_t)(m0 + t) * PX + 4 * lane; const unsigned* ya = (const unsigned*)(YE + p0 * DM) + lane; const unsigned* yb = (const unsigned*)(YE + p1 * DM) + lane;
#pragma unroll
            for (int q = 0; q < 4; ++q) { xv[t][q] = *(const u32x2*)(xr + 256 * q); y0[t][q] = ya[64 * q]; y1[t][q] = yb[64 * q]; } }
#pragma unroll
        for (int t = 0; t < CTPT; ++t) { float* o = out + (size_t)(m0 + t) * DM + 4 * lane;
#pragma unroll
            for (int q = 0; q < 4; ++q) { const unsigned wa = y0[t][q], wb = y1[t][q]; const unsigned xa = xv[t][q].x, xb = xv[t][q].y;
                const f32x2 a0 = __builtin_amdgcn_cvt_pk_f32_fp8((int)wa, false), a1 = __builtin_amdgcn_cvt_pk_f32_fp8((int)wa, true), b0 = __builtin_amdgcn_cvt_pk_f32_fp8((int)wb, false), b1 = __builtin_amdgcn_cvt_pk_f32_fp8((int)wb, true);
                f32x4 r; r.x = bf2f(xa & 0xffff) + (a0.x + b0.x) * (1.f / YE_SCALE); r.y = bf2f(xa >> 16) + (a0.y + b0.y) * (1.f / YE_SCALE);
                r.z = bf2f(xb & 0xffff) + (a1.x + b1.x) * (1.f / YE_SCALE); r.w = bf2f(xb >> 16) + (a1.y + b1.y) * (1.f / YE_SCALE);
                *(f32x4*)(o + 256 * q) = r; } }
        w = wn;
    }
}

#ifndef STG1
#define STG1 0
#endif
#ifndef STG10
#define STG10 0
#endif
#ifndef STG11
#define STG11 0
#endif
#ifndef KREP1
#define KREP1 1
#endif
#ifndef KREP10
#define KREP10 1
#endif
#ifndef KREP11
#define KREP11 1
#endif
constexpr int NPHASE = 13;
__global__ void __launch_bounds__(NTHR, 2) mk_fwd(Args args) {
    extern __shared__ __attribute__((aligned(16))) unsigned char lds_raw[];
    Frame F;
    F.lds = (LAS unsigned char*)lds_raw; F.MISC = (volatile LAS unsigned*)(F.lds + MISC_OFF);
    F.tid = threadIdx.x; F.lane = F.tid & 63; F.wave = __builtin_amdgcn_readfirstlane(F.tid >> 6);
    F.G = gridDim.x; F.c = blockIdx.x; F.ctl = (unsigned*)(args.ws + WS_CTL);
    if (F.tid < 64) F.MISC[F.tid] = 0u;
    __syncthreads();
    XcdBarrier bar = xcd_barrier_post(F.ctl + CW_BAR, F.MISC + 8);
    const int lo = args.ph_lo, hi = args.ph_hi;
    unsigned char* ws = args.ws;
#ifndef PH_MASK
#define PH_MASK 0x1fff
#endif
#define IN(k) ((((PH_MASK) >> (k)) & 1) && lo <= (k) && (k) < hi)
#define SEAM(k) do { if (IN(k) && IN((k) + 1)) xcd_barrier(bar); } while (0)
#define REFRESH() do { int t_ = threadIdx.x; asm volatile("" : "+v"(t_)); F.tid = t_; F.lane = t_ & 63; F.wave = __builtin_amdgcn_readfirstlane(t_ >> 6); } while (0)
#ifndef REP_MASK
#define REP_MASK 0
#endif
#define REPS(k) _Pragma("unroll") for (int rep_ = 0; rep_ < ((((REP_MASK) >> (k)) & 1) ? 2 : 1); ++rep_)
    if (IN(0)) REPS(0) { REFRESH(); p0_prologue(F, args); } SEAM(0);
    if (IN(1)) REPS(1) { REFRESH();
        GemmP g{PX * 2, PW * 2, DM}; DenseOrder S{(const char*)(ws + FW_XN), (const char*)(ws + FW_WIN), (size_t)256 * PX * 2, (size_t)256 * PW * 2, M / 256, DIN / 256, (M / 256) * (DIN / 256), F.G, F.c};
        LAS float* GQK = (LAS float*)(F.lds + SCR2_OFF); if (F.tid < 128) GQK[F.tid] = (F.tid < 64) ? karg<13>()[F.tid] * C2 : karg<14>()[F.tid - 64]; __syncthreads();
        EpiProj E{(bf16*)(ws + FW_U2), (bf16*)(ws + FW_Q), (const LAS float*)GQK};
        gemm_phase<EpiProj, DenseOrder, false, KREP1>(F.lds, g, S, E, nullptr, ((F.c >> 3) & 7) * STG1); } SEAM(1);
    if (IN(2)) REPS(2) { REFRESH();
        GemmP g{U2P * 2, 512 * 2, 512}; GroupOrder S{(const char*)(ws + FW_U2), (const char*)(ws + FW_W1), (size_t)NCH * U2P * 2, (size_t)256 * 512 * 2, (size_t)256 * U2P * 2, 0, NCH / 256, 1, NG * (NCH / 256), F.G, F.c};
        EpiState E{(float*)(ws + FW_SST)};
        gemm_phase(F.lds, g, S, E);
        if (F.G == NG * (NCH / 256)) s5_scan_local(F, args, F.c >> 3, F.c & 7); }
    if (F.G != NG * (NCH / 256)) SEAM(2);
    if (IN(3)) REPS(3) { REFRESH();
#ifndef NO_SCAN
        if (F.G != NG * (NCH / 256)) s5_scan(F, args);
#ifdef REP_SCAN
        s5_scan(F, args);
#endif
#endif
#ifndef NO_ATTN
        const bf16* Q = (const bf16*)(ws + FW_Q); const bf16* Kg = (const bf16*)(ws + FW_K); const bf16* Vg = (const bf16*)(ws + FW_V);
        attn_span_phase(F, Q, Kg, Vg, (bf16*)(ws + FW_MIX), (float*)(F.ctl + CW_SSQA));
#endif
    } SEAM(3);
    if (IN(4)) REPS(4) { REFRESH();
        GemmP g{U2P * 2, U2P * 2, U2P}; GroupOrder S{(const char*)(ws + FW_U2), (const char*)(ws + FW_TB), (size_t)NCH * U2P * 2, (size_t)512 * U2P * 2, (size_t)256 * U2P * 2, (size_t)256 * U2P * 2, NCH / 256, 2, NG * (NCH / 256) * 2, F.G, F.c};
        EpiS5 E{(bf16*)(ws + FW_Z)};
        gemm_phase(F.lds, g, S, E); } SEAM(4);
    if (IN(5)) REPS(5) { REFRESH();
        GemmP g{DSSM * 2, DSSM * 2, DSSM}; DenseOrder S{(const char*)(ws + FW_Z), (const char*)(ws + FW_WGLU), (size_t)256 * DSSM * 2, (size_t)256 * DSSM * 2, M / 256, 2, (M / 256) * 2, F.G, F.c};
        EpiGlu E{(const bf16*)(ws + FW_Z), karg<12>(), (bf16*)(ws + FW_MIX), (float*)(F.ctl + CW_SSQS)};
        gemm_phase(F.lds, g, S, E); } if (IN(5) && IN(7)) xcd_barrier(bar);
    if (IN(7)) REPS(7) { REFRESH();
        GemmP g{MIX_TILED ? 128 : PX * 2, PW * 2, DM, MIX_TILED ? 256 * 128 : 0}; DenseOrder S{(const char*)(ws + FW_MIX), (const char*)(ws + FW_WOUT), (size_t)256 * PX * 2, (size_t)256 * PW * 2, M / 256, 4, (M / 256) * 4, F.G, F.c};
        EpiX1B E{(const float*)(ws + FW_RSTDX), (bf16*)(ws + FW_X1B), (const float*)(F.ctl + CW_SSQS), (const float*)(F.ctl + CW_SSQA), (LAS float*)(F.lds + SCR2_OFF + 1024)};
        { Unit uu; for (int i = 0; i < 4 && S.next(i, uu); ++i) E.fill(i, uu.pm, F.tid); __syncthreads(); }
        gemm_phase(F.lds, g, S, E); } SEAM(7);
    if (IN(8)) { REFRESH(); router_phase(F, args); } if (IN(8) && IN(10)) xcd_barrier(bar);
    int ntiles = 0;
    if (IN(10) || IN(11) || IN(12)) { REFRESH(); ntiles = moe_tables(F); }
    if (IN(10)) REPS(10) { REFRESH();
        LAS int* RC = (LAS int*)(F.lds + SCR2_OFF + 1024); const unsigned* ETOK = (const unsigned*)(ws + FW_ETOK); const LAS int* TSTc = (const LAS int*)(F.lds + SCR2_OFF); const LAS unsigned char* T2Ec = F.lds + SCR2_OFF + 256;
        { unsigned v[5];
#pragma unroll
          for (int k = 0; k < 5; ++k) { const int j = F.tid + 512 * k, i = j >> 8, r = j & 255; v[k] = 0u;
              if ((long)i * F.G + F.c < (long)ntiles * 4) { int pm, pn; moe_unit(i * F.G + F.c, ntiles, pm, pn);
                  const int e = T2Ec[pm], idx = (pm - TSTc[e]) * 256 + r;
                  if (idx < TSTc[208 + e]) v[k] = ETOK[(size_t)e * M + idx]; } }
#pragma unroll
          for (int k = 0; k < 5; ++k) { const int j = F.tid + 512 * k; if ((long)(j >> 8) * F.G + F.c < (long)ntiles * 4) RC[j] = (int)v[k]; } }
        __syncthreads();
        GemmP g{DM, DM, DM / 2}; MoeOrder S{(const char*)(ws + FW_X1Q), (const char*)(ws + FW_WGU), (size_t)0, (size_t)DM * DM, (size_t)256 * DM, F.lds + SCR2_OFF + 256, ntiles, F.G, F.c};
        EpiGU E{(unsigned char*)(ws + FW_HH), (const LAS unsigned*)RC};
        gemm_phase<EpiGU, MoeOrder, true, KREP10, true>(F.lds, g, S, E, RC, ((F.c >> 3) & 7) * STG10); } SEAM(10);
    if (IN(11)) REPS(11) { REFRESH();
        LAS float* RGC = (LAS float*)(F.lds + SCR2_OFF + 1024); const float* EG = (const float*)(ws + FW_EG); const LAS int* TSTc = (const LAS int*)(F.lds + SCR2_OFF); const LAS unsigned char* T2Ec = F.lds + SCR2_OFF + 256;
        { float v[5];
#pragma unroll
          for (int k = 0; k < 5; ++k) { const int j = F.tid + 512 * k, i = j >> 8, r = j & 255; v[k] = 0.f;
              if ((long)i * F.G + F.c < (long)ntiles * 4) { int pm, pn; moe_unit(i * F.G + F.c, ntiles, pm, pn);
                  const int e = T2Ec[pm], idx = (pm - TSTc[e]) * 256 + r;
                  if (idx < TSTc[208 + e]) v[k] = EG[(size_t)e * M + idx]; } }
#pragma unroll
          for (int k = 0; k < 5; ++k) { const int j = F.tid + 512 * k; if ((long)(j >> 8) * F.G + F.c < (long)ntiles * 4) RGC[j] = v[k]; } }
        __syncthreads();
        GemmP g{DE, DE, DE / 2}; MoeOrder S{(const char*)(ws + FW_HH), (const char*)(ws + FW_WD), (size_t)256 * DE, (size_t)DM * DE, (size_t)256 * DE, F.lds + SCR2_OFF + 256, ntiles, F.G, F.c};
        EpiDown E{(unsigned char*)(ws + FW_YE), (const LAS float*)RGC};
        gemm_phase<EpiDown, MoeOrder, false, KREP11, true>(F.lds, g, S, E, nullptr, ((F.c >> 3) & 7) * STG11); } SEAM(11);
    if (IN(12)) REPS(12) { REFRESH(); combine_phase(F, args); }
#undef IN
#undef SEAM
}
}

extern "C" void kernel_launch(void* const* d_in, const int* in_sizes, int n_in, void* d_out, int out_size, void* d_ws, size_t ws_size, hipStream_t stream) {
    static int grid = 0;
    if (grid == 0) {
        if (n_in != 26 || out_size != M * DM || ws_size < mk::FW_END2) { fprintf(stderr, "kernel_launch: unexpected shapes (n_in %d out %d ws %zu, need %zu)\n", n_in, out_size, ws_size, (size_t)mk::FW_END2); grid = -1; return; }
        int dev = 0, cus = 0, per_cu = 0;
        if (hipGetDevice(&dev) != hipSuccess || hipDeviceGetAttribute(&cus, hipDeviceAttributeMultiprocessorCount, dev) != hipSuccess) { grid = -1; return; }
        if (hipFuncSetAttribute((const void*)mk::mk_fwd, hipFuncAttributeMaxDynamicSharedMemorySize, mk::LDS_BYTES) != hipSuccess) { fprintf(stderr, "kernel_launch: hipFuncSetAttribute failed\n"); grid = -1; return; }
        if (hipOccupancyMaxActiveBlocksPerMultiprocessor(&per_cu, (const void*)mk::mk_fwd, mk::NTHR, mk::LDS_BYTES) != hipSuccess || per_cu < 1) { fprintf(stderr, "kernel_launch: occupancy query says %d\n", per_cu); }
        (void)hipGetLastError();
        grid = cus;
        if (grid != 256) fprintf(stderr, "kernel_launch: %d CUs (built for 256)\n", grid);
    }
    if (grid < 0) return;
    mk::Args a{};
    for (int i = 0; i < 26; ++i) a.in[i] = (const float*)d_in[i];
    a.out = (float*)d_out; a.ws = (unsigned char*)d_ws; a.ph_lo = 0; a.ph_hi = mk::NPHASE;
    (void)hipMemsetAsync((unsigned char*)d_ws + WS_CTL, 0, mk::CTL_ZERO_BYTES, stream);
    hipLaunchKernelGGL(mk::mk_fwd, dim3(grid), dim3(mk::NTHR), mk::LDS_BYTES, stream, a);
}
```

```cpp
#define ASPAN_N 10
#define PADX 0

#include <hip/hip_runtime.h>
#include <cstdio>
#include <cstdint>

typedef unsigned short bf16;
typedef float f32x4 __attribute__((ext_vector_type(4)));
typedef unsigned u32x4 __attribute__((ext_vector_type(4)));
typedef unsigned u32x2 __attribute__((ext_vector_type(2)));

constexpr int DM = 1024, BATCH = 32, SEQ = 2048, M = BATCH * SEQ;
constexpr int DSSM = 512, NG = 32, GS = 16, PST = 64, HD = 64, DATT = 512, NH = 8, DIN = 2048;
constexpr int NEG = 4, EPG = 8, NE = 32, DE = 512;
constexpr float EPS = 1e-6f;
constexpr int LCH = 32;
constexpr int NCH = M / LCH;
constexpr int U2P = 640;
constexpr float C2 = 0.125f * 1.4426950408889634f;

constexpr size_t MiB = 1u << 20;
constexpr size_t WS_CTL = 0;
constexpr size_t WS_TOK = 2 * MiB;
constexpr size_t WS_XN = 8 * MiB;
constexpr size_t WS_Q = WS_XN + 128 * MiB;
constexpr size_t WS_K = WS_Q + 64 * MiB;
constexpr size_t WS_V = WS_K + 64 * MiB;
constexpr size_t WS_U2 = WS_V + 64 * MiB;
constexpr size_t WS_Z = WS_U2 + 80 * MiB;
constexpr size_t WS_YS = WS_Z + 64 * MiB;
constexpr size_t WS_YA = WS_YS + 64 * MiB;
constexpr size_t WS_MIX = WS_YA + 64 * MiB;
constexpr size_t WS_H2 = WS_XN;
constexpr size_t WS_PROJ = WS_Z;
constexpr size_t WS_END = WS_PROJ + 512 * MiB;

__device__ __forceinline__ unsigned f2bf(float f) { unsigned u = __builtin_bit_cast(unsigned, f); return (u + 0x7fffu + ((u >> 16) & 1u)) >> 16; }
__device__ __forceinline__ float bf2f(unsigned short h) { return __builtin_bit_cast(float, (unsigned)h << 16); }
__device__ __forceinline__ unsigned pk2(float lo, float hi) { return f2bf(lo) | (f2bf(hi) << 16); }
template <int CTRL> __device__ __forceinline__ float dppf(float x) { return __builtin_bit_cast(float, __builtin_amdgcn_update_dpp(0, __builtin_bit_cast(int, x), CTRL, 0xF, 0xF, true)); }
template <int CTRL> __device__ __forceinline__ unsigned dppu(unsigned x) { return (unsigned)__builtin_amdgcn_update_dpp(0, (int)x, CTRL, 0xF, 0xF, true); }
__device__ __forceinline__ float xor16_sum(float v) { const unsigned u = __builtin_bit_cast(unsigned, v); auto r = __builtin_amdgcn_permlane16_swap(u, u, false, false); return __builtin_bit_cast(float, (unsigned)r[0]) + __builtin_bit_cast(float, (unsigned)r[1]); }
__device__ __forceinline__ float xor32_sum(float v) { const unsigned u = __builtin_bit_cast(unsigned, v); auto r = __builtin_amdgcn_permlane32_swap(u, u, false, false); return __builtin_bit_cast(float, (unsigned)r[0]) + __builtin_bit_cast(float, (unsigned)r[1]); }
__device__ __forceinline__ unsigned xor16_get(unsigned u, bool odd_row) { auto r = __builtin_amdgcn_permlane16_swap(u, u, false, false); return odd_row ? (unsigned)r[0] : (unsigned)r[1]; }
__device__ __forceinline__ float wave_sum(float v) {
    v += dppf<0xB1>(v); v += dppf<0x4E>(v); v += dppf<0x141>(v); v += dppf<0x140>(v);
    return xor32_sum(xor16_sum(v));
}
__device__ __forceinline__ void sincos_d(double th, double& s, double& c) {
    const double q = rint(th * 0.63661977236758134308);
    const double r = (th - q * 1.57079632679489655800) - q * 6.12323399573676603587e-17;
    const double r2 = r * r;
    double sp = -1.0 / 1307674368000.0; sp = sp * r2 + 1.0 / 6227020800.0; sp = sp * r2 - 1.0 / 39916800.0; sp = sp * r2 + 1.0 / 362880.0; sp = sp * r2 - 1.0 / 5040.0; sp = sp * r2 + 1.0 / 120.0; sp = sp * r2 - 1.0 / 6.0; sp = sp * r2 + 1.0;
    const double sn = sp * r;
    double cp = 1.0 / 20922789888000.0; cp = cp * r2 - 1.0 / 87178291200.0; cp = cp * r2 + 1.0 / 479001600.0; cp = cp * r2 - 1.0 / 3628800.0; cp = cp * r2 + 1.0 / 40320.0; cp = cp * r2 - 1.0 / 720.0; cp = cp * r2 + 1.0 / 24.0; cp = cp * r2 - 0.5; cp = cp * r2 + 1.0;
    const int qi = ((int)q) & 3;
    s = (qi == 0) ? sn : (qi == 1) ? cp : (qi == 2) ? -sn : -cp;
    c = (qi == 0) ? cp : (qi == 1) ? -sn : (qi == 2) ? -cp : sn;
}
__device__ __forceinline__ float gelu_tanh(float x) {
    constexpr float K1 = -2.885390081777927f * 0.7978845608028654f, K3 = K1 * 0.044715f;
    const float e = __builtin_amdgcn_exp2f(x * (K1 + K3 * (x * x)));
    return x * __builtin_amdgcn_rcpf(1.f + e);
}
__device__ __forceinline__ float sigmoidf_(float x) { return __builtin_amdgcn_rcpf(1.f + __builtin_amdgcn_exp2f(-1.4426950408889634f * x)); }


#include <type_traits>
namespace mk {
#define LAS __attribute__((address_space(3)))
#define GAS __attribute__((address_space(1)))
typedef short bf16x8 __attribute__((ext_vector_type(8)));
typedef short s16x4 __attribute__((ext_vector_type(4)));
typedef float f32x16 __attribute__((ext_vector_type(16)));
typedef float f32x2 __attribute__((ext_vector_type(2)));
typedef __bf16 bf16x2_t __attribute__((ext_vector_type(2)));
typedef GAS unsigned gu32;

constexpr int NWAVES = 8, NTHR = 512;
constexpr int RING_BYTES = 131072, SCR2_OFF = RING_BYTES, SCR2_BYTES = 16128, MISC_OFF = SCR2_OFF + SCR2_BYTES, GF_OFF = MISC_OFF + 256, LDS_BYTES = GF_OFF + 4096;
static_assert(GF_OFF == 147456 && LDS_BYTES <= 163840, "LDS map");

#ifndef PADX
#define PADX 64
#endif
constexpr int PX = DM + PADX;
constexpr int PW = DM + PADX;
constexpr size_t FW_TOK = 2 * MiB, FW_WIN = 4 * MiB, FW_WOUT = 9 * MiB, FW_WGLU = 12 * MiB - 512 * 1024, FW_WR = 12 * MiB, FW_TB = 13 * MiB, FW_W1 = 33 * MiB,
                 FW_WGU = 41 * MiB, FW_WD = 110 * MiB, FW_SST = 142 * MiB, FW_XN = 174 * MiB, FW_Q = 310 * MiB, FW_K = 374 * MiB, FW_V = 438 * MiB, FW_U2 = 502 * MiB,
                 FW_Z = 582 * MiB, FW_MIX = 646 * MiB, FW_ROW = 782 * MiB, FW_END2 = 784 * MiB,
                 FW_X1B = FW_XN, FW_HH = 582 * MiB, FW_YE = FW_Q;
static_assert(FW_WIN + (size_t)DIN * PW * 2 <= FW_WOUT && FW_WOUT + (size_t)DM * PW * 2 <= FW_WGLU && FW_WGU + (size_t)NE * DM * PW * 2 <= FW_WD && FW_XN + (size_t)M * PX * 2 <= FW_Q && FW_MIX + (size_t)M * PX * 2 <= FW_ROW, "padded buffers");
static_assert(FW_K - FW_Q == (size_t)M * 512 * 2 && FW_V - FW_K == (size_t)M * 512 * 2, "Q|K|V contiguous");
constexpr size_t FW_RSTDX = FW_ROW + 3 * (size_t)(544 * 256) * 4;
constexpr size_t FW_ETOK = FW_SST, FW_EG = FW_SST + (size_t)NE * M * 4;
static_assert(FW_EG + (size_t)NE * M * 4 <= FW_XN, "expert lists");
constexpr float W8SC = 64.f;
constexpr size_t FW_X1Q = FW_U2;
static_assert(FW_X1Q + (size_t)M * DM <= FW_HH && FW_YE + (size_t)(544 * 256) * DM <= FW_X1Q && FW_HH + (size_t)(544 * 256) * DE <= FW_ROW, "X1Q / HH / YE must not overlap");
constexpr size_t FW_A32 = FW_WR + 256 * 1024;
constexpr int MAXTILES = 544, MAXROWS = MAXTILES * 256;
static_assert(FW_RSTDX + (size_t)M * 4 <= FW_END2, "row arrays");
static_assert(FW_YE + (size_t)MAXROWS * DM <= FW_U2 && FW_HH + (size_t)MAXROWS * DE * 2 <= FW_ROW, "MoE overlay");
constexpr int CW_TMO = 0, CW_CNT = 64, CW_BAR = 4096, CW_SSQS = 65536, CW_SSQA = 131072;
static_assert((CW_SSQA + M) * 4 <= (int)(1 * MiB), "ssq arrays inside the memset region");
constexpr size_t CTL_ZERO_BYTES = 1 * MiB;

#define RLX_AGENT __ATOMIC_RELAXED, __HIP_MEMORY_SCOPE_AGENT
__device__ __forceinline__ unsigned cvtpk(float lo, float hi) { f32x2 v = {lo, hi}; bf16x2_t b = __builtin_convertvector(v, bf16x2_t); return __builtin_bit_cast(unsigned, b); }

#define XB_TMO      128
#define XB_XCNT(j)  (256  + 64 * (j))
#define XB_XSUB(j)  (1280 + 64 * (j))
#define XB_XGEN(j)  (2304 + 64 * (j))
#define XB_TOP      3328
#define XB_TOPGEN   3392
#define XCD_BAR_WORDS 3456
#define XB_SPIN_CAP (1u << 18)
__device__ __forceinline__ unsigned xb_ld(unsigned* p)              { return __hip_atomic_load(p, __ATOMIC_RELAXED, __HIP_MEMORY_SCOPE_AGENT); }
__device__ __forceinline__ unsigned xb_add(unsigned* p, unsigned v) { return __hip_atomic_fetch_add(p, v, __ATOMIC_RELAXED, __HIP_MEMORY_SCOPE_AGENT); }
__device__ __forceinline__ unsigned xb_xcc_id() { return (unsigned)__builtin_amdgcn_s_getreg((3 << 11) | 20) & 0xFu; }
#define XB_SPIN(cond, bar) do { unsigned _sp = 0; while (cond) { __builtin_amdgcn_s_sleep(1); \
    if ((++_sp & 255u) == 0u) { if (xb_ld(&(bar)[XB_TMO])) break; if (_sp > XB_SPIN_CAP) { atomicAdd(&(bar)[XB_TMO], 1u); break; } } } } while (0)
struct XcdBarrier { unsigned* bar; unsigned x; volatile LAS unsigned* st; };
__device__ __forceinline__ XcdBarrier xcd_barrier_post(unsigned* bar, volatile LAS unsigned* st) {
    XcdBarrier b; b.bar = bar; b.x = xb_xcc_id(); b.st = st;
    if (threadIdx.x == 0) (void)xb_add(&bar[XB_XCNT(b.x)], 1u);
    return b;
}
__device__ __forceinline__ void xcd_barrier_complete(unsigned* bar, unsigned x, unsigned& nloc, unsigned& nx) {
    const unsigned G = gridDim.x * gridDim.y * gridDim.z;
    unsigned sum, cnt, mine, sp = 0u;
    for (;;) {
        sum = 0u; cnt = 0u; mine = 0u;
#pragma unroll
        for (unsigned j = 0; j < 16; ++j) { const unsigned c = xb_ld(&bar[XB_XCNT(j)]); sum += c; cnt += (c > 0u) ? 1u : 0u; mine = (j == x) ? c : mine; }
        if (sum == G) break;
        __builtin_amdgcn_s_sleep(1);
        if ((++sp & 255u) == 0u) { if (xb_ld(&bar[XB_TMO])) break; if (sp > XB_SPIN_CAP) { atomicAdd(&bar[XB_TMO], 1u); break; } }
    }
    nloc = mine > 0u ? mine : 1u; nx = cnt > 0u ? cnt : 1u;
}
__device__ __forceinline__ void xcd_barrier(const XcdBarrier& b) {
    asm volatile("s_waitcnt vmcnt(0)" ::: "memory");
    __syncthreads();
    if (threadIdx.x == 0) {
        unsigned* bar = b.bar;
        __builtin_amdgcn_s_waitcnt(0);
        unsigned nloc = b.st[0], nx = b.st[1];
        if (nloc == 0u) { xcd_barrier_complete(bar, b.x, nloc, nx); b.st[0] = nloc; b.st[1] = nx; }
        const unsigned old = xb_add(&bar[XB_XSUB(b.x)], 1u);
        const unsigned gen = old / nloc;
        if (old + 1u == (gen + 1u) * nloc) {
            __builtin_amdgcn_fence(__ATOMIC_RELEASE, "agent");
            asm volatile("s_waitcnt vmcnt(0)" ::: "memory");
            const unsigned og = xb_add(&bar[XB_TOP], 1u);
            const unsigned tg = og / nx;
            if (og + 1u == (tg + 1u) * nx) xb_add(&bar[XB_TOPGEN], 1u);
            else XB_SPIN(xb_ld(&bar[XB_TOPGEN]) == tg, bar);
            __builtin_amdgcn_fence(__ATOMIC_ACQUIRE, "agent");
            xb_add(&bar[XB_XGEN(b.x)], 1u);
            asm volatile("s_waitcnt vmcnt(0)" ::: "memory");
        } else {
            XB_SPIN(xb_ld(&bar[XB_XGEN(b.x)]) == gen, bar);
            __builtin_amdgcn_fence(__ATOMIC_ACQUIRE, "agent");
            asm volatile("s_waitcnt vmcnt(0)" ::: "memory");
        }
    }
    __syncthreads();
}

__device__ __forceinline__ unsigned pk4_fp8(float a, float b, float c, float d) { int w = 0; w = __builtin_amdgcn_cvt_pk_fp8_f32(a, b, w, false); w = __builtin_amdgcn_cvt_pk_fp8_f32(c, d, w, true); return (unsigned)w; }
template <int K> __device__ __forceinline__ const float* karg();
struct SideItem { const float* W; unsigned char* WT; int ldw, srccol0, ldt, dstrow0, k0, scaled; };
__device__ __forceinline__ SideItem moe_side_item(int r) {
    unsigned char* ws;
    asm volatile("s_load_dwordx2 %0, %1, 216\n\ts_waitcnt lgkmcnt(0)" : "=s"(ws) : "s"(__builtin_amdgcn_kernarg_segment_ptr()) : "memory");
    if (r < 16384) { const int e = r >> 9, q = r & 511, kb = q >> 5, d = q & 31, pn = d >> 3, beta = d & 7;
        const float* W = (beta < 4 ? karg<23>() : karg<24>()) + (size_t)e * DM * DE;
        return SideItem{W, ws + FW_WGU + (size_t)e * DM * DM, DE, 128 * pn + 32 * (beta & 3), DM, 32 * d, 64 * kb, 1}; }
    r -= 16384; const int e = r >> 8, q = r & 255, kb = q >> 5, d = q & 31;
    return SideItem{karg<25>() + (size_t)e * DE * DM, ws + FW_WD + (size_t)e * DM * DE, DM, 32 * (8 * (d >> 3) + 2 * (d & 3) + ((d & 7) >> 2)), DE, 32 * d, 64 * kb, 0};
}
__device__ __forceinline__ void side_load(const SideItem& t, int lane, int hb, f32x4 (&v)[4]) {
    asm volatile("" : "+v"(lane));
    const int kh = lane >> 3, nq = lane & 7;
#pragma unroll
    for (int i = 0; i < 4; ++i) v[i] = *(const GAS f32x4*)(t.W + (size_t)(t.k0 + 8 * kh + 4 * hb + i) * t.ldw + t.srccol0 + 4 * nq);
}
__device__ __forceinline__ void side_store(const SideItem& t, int lane, int hb, const f32x4 (&v)[4], const LAS float* GF) {
    asm volatile("" : "+v"(lane));
    const int kh = lane >> 3, nq = lane & 7;
    f32x4 g0 = (f32x4){W8SC, W8SC, W8SC, W8SC};
    if (t.scaled) g0 = *(const LAS f32x4*)(GF + t.k0 + 8 * kh + 4 * hb);
#pragma unroll
    for (int e = 0; e < 4; ++e)
        *(unsigned*)(t.WT + (size_t)(t.dstrow0 + 4 * nq + e) * t.ldt + t.k0 + 8 * kh + 4 * hb) = pk4_fp8(v[0][e] * g0.x, v[1][e] * g0.y, v[2][e] * g0.z, v[3][e] * g0.w);
}
constexpr int BM = 256, BK = 64, HALF = 128, HTB = HALF * BK * 2;
__device__ __forceinline__ int lds_byte(int r, int c) { const int st = (r >> 4) * 2 + (c >> 5), rr = r & 15, cc = c & 31, ob = rr * 64 + cc * 2; return st * 1024 + (ob ^ (((ob >> 9) & 1) << 5)); }
__device__ __forceinline__ void stage_rc(int b, int& R, int& C) { const int st = b / 1024, sb = b % 1024, swz = sb ^ (((sb >> 9) & 1) << 5); R = (st >> 1) * 16 + swz / 64; C = (st & 1) * 32 + (swz % 64) / 2; }
__device__ __forceinline__ int perm32(int rho) { const int n = rho >> 4, i = rho & 15; return 8 * (i >> 2) + 4 * n + (i & 3); }
struct Unit { const char* a; const char* b; int pm, pn, aux; };
struct GemmP { int lda_b, ldb_b, K; };

template <class Epi, class Sched, bool GATHER = false, int KREP = 1, bool FP8 = false>
__device__ __forceinline__ void gemm_phase(LAS unsigned char* lds, const GemmP g, const Sched& S, const Epi& E, const LAS int* rowcache = nullptr, int stagger_ticks = 0) {
    const int tid = threadIdx.x, wid = __builtin_amdgcn_readfirstlane(tid >> 6), lane = tid & 63, wr = wid >> 2, wc = wid & 3, fr = lane & 15, fq = lane >> 4;
    const int ntk = g.K / BK, nt = ntk * (KREP == 3 ? 1 : KREP);
    unsigned voffA[2], voffB[2]; int gR[2], gC[2];
#pragma unroll
    for (int i = 0; i < 2; ++i) { int R, C; stage_rc(tid * 16 + i * 8192, R, C); const int Rb = Epi::PERM ? ((R & ~31) + perm32(R & 31)) : R; gR[i] = R; gC[i] = C * 2;
        voffA[i] = (unsigned)(R * g.lda_b + C * 2); voffB[i] = (unsigned)(Rb * g.ldb_b + C * 2); }
    unsigned vc0[2] = {voffA[0], voffA[1]}, vc1[2] = {voffA[0], voffA[1]}, vn0[2] = {voffA[0], voffA[1]}, vn1[2] = {voffA[0], voffA[1]};
#define PG8_GOFF(dst0, dst1, ui_) do { _Pragma("unroll") for (int _i = 0; _i < 2; ++_i) { \
        dst0[_i] = ((unsigned)rowcache[(ui_) * 256 + gR[_i]] & 0xffffu) * (unsigned)g.lda_b + (unsigned)gC[_i]; dst1[_i] = ((unsigned)rowcache[(ui_) * 256 + 128 + gR[_i]] & 0xffffu) * (unsigned)g.lda_b + (unsigned)gC[_i]; } } while (0)
    const size_t kstep = (size_t)(BK * 2);
    const size_t hstepA = GATHER ? 0 : (size_t)HALF * g.lda_b, hstepB = (size_t)HALF * g.ldb_b;
    const unsigned ldsw = (unsigned)wid * 1024u;
    const int aoff = lds_byte(wr * 64 + fr, fq * 8), boff = lds_byte(wc * 32 + fr, fq * 8);
#define PG8_SA(b, h) (((b) * 2 + (h)) * HTB)
#define PG8_SB(b, h) ((4 + (b) * 2 + (h)) * HTB)
#define PG8_STAGE(bufoff, gbase, voff) do { _Pragma("unroll") for (int _i = 0; _i < 2; ++_i) \
        __builtin_amdgcn_global_load_lds((const unsigned*)((const char*)(gbase) + (voff)[_i]), (LAS unsigned*)(lds + (bufoff) + ldsw + _i * 8192), 16, 0, 0); } while (0)
#define PG8_LDA(dst, b, h) do { _Pragma("unroll") for (int m = 0; m < 4; ++m) { const LAS unsigned char* p_ = lds + PG8_SA(b, h) + aoff + m * 2048; \
        if constexpr (FP8) { dst[m].v.lo = *(const LAS v4i_*)p_; dst[m].v.hi = *(const LAS v4i_*)(p_ + 1024); } else { dst[m].v[0] = *(const LAS bf16x8*)p_; dst[m].v[1] = *(const LAS bf16x8*)(p_ + 1024); } } } while (0)
#define PG8_LDB(dst, b, h) do { _Pragma("unroll") for (int n = 0; n < 2; ++n) { const LAS unsigned char* p_ = lds + PG8_SB(b, h) + boff + n * 2048; \
        if constexpr (FP8) { dst[n].v.lo = *(const LAS v4i_*)p_; dst[n].v.hi = *(const LAS v4i_*)(p_ + 1024); } else { dst[n].v[0] = *(const LAS bf16x8*)p_; dst[n].v[1] = *(const LAS bf16x8*)(p_ + 1024); } } } while (0)
#define PG8_MMA(ai, bj, At, Bt) do { if (Epi::HALFN && (bj) == 1) break; __builtin_amdgcn_s_setprio(1); \
        if constexpr (FP8) { asm volatile("s_nop 1\n\t" "v_mfma_scale_f32_16x16x128_f8f6f4 %0, %8, %10, %0, %14, %14 op_sel_hi:[0,0,0]\n\t" "v_mfma_scale_f32_16x16x128_f8f6f4 %1, %9, %10, %1, %14, %14 op_sel_hi:[0,0,0]\n\t" "v_mfma_scale_f32_16x16x128_f8f6f4 %2, %8, %11, %2, %14, %14 op_sel_hi:[0,0,0]\n\t" "v_mfma_scale_f32_16x16x128_f8f6f4 %3, %9, %11, %3, %14, %14 op_sel_hi:[0,0,0]\n\t" "v_mfma_scale_f32_16x16x128_f8f6f4 %4, %8, %12, %4, %14, %14 op_sel_hi:[0,0,0]\n\t" "v_mfma_scale_f32_16x16x128_f8f6f4 %5, %9, %12, %5, %14, %14 op_sel_hi:[0,0,0]\n\t" "v_mfma_scale_f32_16x16x128_f8f6f4 %6, %8, %13, %6, %14, %14 op_sel_hi:[0,0,0]\n\t" "v_mfma_scale_f32_16x16x128_f8f6f4 %7, %9, %13, %7, %14, %14 op_sel_hi:[0,0,0]\n\t" "s_nop 1" \
            : "+v"(acc[ai][bj][0][0]), "+v"(acc[ai][bj][0][1]), "+v"(acc[ai][bj][1][0]), "+v"(acc[ai][bj][1][1]), "+v"(acc[ai][bj][2][0]), "+v"(acc[ai][bj][2][1]), "+v"(acc[ai][bj][3][0]), "+v"(acc[ai][bj][3][1]) \
            : "v"(Bt[0].v), "v"(Bt[1].v), "v"(At[0].v), "v"(At[1].v), "v"(At[2].v), "v"(At[3].v), "v"(mxs)); } \
        else { _Pragma("unroll") for (int m = 0; m < 4; ++m) _Pragma("unroll") for (int n = 0; n < 2; ++n) _Pragma("unroll") for (int k = 0; k < 2; ++k) \
            acc[ai][bj][m][n] = __builtin_amdgcn_mfma_f32_16x16x32_bf16(Bt[n].v[k], At[m].v[k], acc[ai][bj][m][n], 0, 0, 0); } \
        __builtin_amdgcn_s_setprio(0); } while (0)
#define PG8_WAIT_V(n) asm volatile("s_waitcnt vmcnt(" #n ")" ::: "memory")
#define PG8_WAIT_L(n) asm volatile("s_waitcnt lgkmcnt(" #n ")" ::: "memory")
#define PG8_BAR __builtin_amdgcn_s_barrier()
#define PG8_SCHED __builtin_amdgcn_sched_barrier(0)
    int mxs = 0x7F7F7F7F; asm volatile("" : "+v"(mxs));
    Unit cur, nxt; int ui = 0;
    if (!S.next(0, cur)) return;
    if (stagger_ticks > 0) { const unsigned long long t0 = __builtin_amdgcn_s_memrealtime(); while ((long long)(__builtin_amdgcn_s_memrealtime() - t0) < (long long)stagger_ticks) __builtin_amdgcn_s_sleep(8); }
    f32x4 acc[2][2][4][2];
#pragma unroll
    for (int a = 0; a < 2; ++a)
#pragma unroll
        for (int b = 0; b < 2; ++b)
#pragma unroll
            for (int m = 0; m < 4; ++m)
#pragma unroll
                for (int n = 0; n < 2; ++n) acc[a][b][m][n] = (f32x4){0.f, 0.f, 0.f, 0.f};
    typedef int v4i_ __attribute__((ext_vector_type(4))); typedef int v8i_ __attribute__((ext_vector_type(8)));
    struct FragB { bf16x8 v[2]; }; struct Frag8 { v8i_ v; };
    typename std::conditional<FP8, Frag8, FragB>::type At[4], B0[2], B1[2];
    const char* cA = cur.a; const char* cB = cur.b;
    if (GATHER) { PG8_GOFF(vc0, vc1, 0); }
    PG8_STAGE(PG8_SB(0, 0), cB, voffB); PG8_STAGE(PG8_SB(0, 1), cB + hstepB, voffB); PG8_STAGE(PG8_SA(0, 0), cA, vc0); PG8_STAGE(PG8_SA(0, 1), cA + hstepA, vc1);
    if (wr == 1) PG8_BAR;
    PG8_WAIT_V(2); PG8_BAR;
    PG8_STAGE(PG8_SB(1, 0), cB + kstep, voffB); PG8_STAGE(PG8_SA(1, 0), cA + kstep, vc0); PG8_STAGE(PG8_SB(1, 1), cB + hstepB + kstep, voffB);
    PG8_WAIT_V(6); PG8_BAR;
    for (;;) {
        const bool has_next = S.next(ui + 1, nxt);
        const char* nA = has_next ? nxt.a : cA; const char* nB = has_next ? nxt.b : cB;
        if constexpr (Epi::HOOKS) E.begin(cur, ui, tid);
        if (GATHER) { if (has_next) { PG8_GOFF(vn0, vn1, ui + 1); } else { vn0[0] = vc0[0]; vn0[1] = vc0[1]; vn1[0] = vc1[0]; vn1[1] = vc1[1]; } }
        for (int t = 0; t < nt; t += 2) {
            const bool last = (t == nt - 2);
            if constexpr (Epi::HOOKS) { if (t == nt / 2) E.mid(acc, ui, wr, fr); }
#ifdef PROBE_EPI_TWICE
            if constexpr (KREP == 3) { if (t == ntk / 2) E.fin(acc, cur, ui, wr, wc, fr, fq); }
#endif
            const char* a1 = cA + (size_t)((t + 1) % ntk) * kstep;
            const char* a2 = last ? nA : cA + (size_t)((t + 2) % ntk) * kstep; const char* b2 = last ? nB : cB + (size_t)((t + 2) % ntk) * kstep;
            const char* a3 = a2 + kstep; const char* b3 = b2 + kstep;
            unsigned w0[2], w1[2];
            w0[0] = (GATHER && last) ? vn0[0] : vc0[0]; w0[1] = (GATHER && last) ? vn0[1] : vc0[1]; w1[0] = (GATHER && last) ? vn1[0] : vc1[0]; w1[1] = (GATHER && last) ? vn1[1] : vc1[1];
            PG8_LDB(B0, 0, 0); PG8_LDB(B1, 0, 1); PG8_SCHED; PG8_LDA(At, 0, 0); PG8_STAGE(PG8_SA(1, 1), a1 + hstepA, vc1);
            PG8_WAIT_V(8); PG8_WAIT_L(0); PG8_BAR; PG8_MMA(0, 0, At, B0); PG8_MMA(0, 1, At, B1); PG8_BAR; PG8_SCHED;
            PG8_LDA(At, 0, 1); PG8_STAGE(PG8_SB(0, 0), b2, voffB); PG8_STAGE(PG8_SB(0, 1), b2 + hstepB, voffB); PG8_STAGE(PG8_SA(0, 0), a2, w0);
            PG8_WAIT_V(8); PG8_WAIT_L(0); PG8_BAR; PG8_MMA(1, 0, At, B0); PG8_MMA(1, 1, At, B1); PG8_BAR; PG8_SCHED;
            PG8_LDB(B0, 1, 0); PG8_LDB(B1, 1, 1); PG8_SCHED; PG8_LDA(At, 1, 0); PG8_STAGE(PG8_SA(0, 1), a2 + hstepA, w1);
            PG8_WAIT_V(8); PG8_WAIT_L(0); PG8_BAR; PG8_MMA(0, 0, At, B0); PG8_MMA(0, 1, At, B1); PG8_BAR; PG8_SCHED;
            PG8_LDA(At, 1, 1); PG8_STAGE(PG8_SB(1, 0), b3, voffB); PG8_STAGE(PG8_SB(1, 1), b3 + hstepB, voffB); PG8_STAGE(PG8_SA(1, 0), a3, w0);
            PG8_WAIT_V(8); PG8_WAIT_L(0); PG8_BAR; PG8_MMA(1, 0, At, B0); PG8_MMA(1, 1, At, B1); PG8_BAR; PG8_SCHED;
        }
        if (wr == 0) PG8_BAR;
        if constexpr (FP8) asm volatile("s_nop 15\n\ts_nop 7" ::: "memory");
        if constexpr (KREP > 1) {
#pragma unroll
            for (int a = 0; a < 2; ++a)
#pragma unroll
                for (int b = 0; b < 2; ++b)
#pragma unroll
                    for (int m = 0; m < 4; ++m)
#pragma unroll
                        for (int n = 0; n < 2; ++n) acc[a][b][m][n] = acc[a][b][m][n] * (KREP == 3 ? 1.f : 1.f / KREP); }
        if constexpr (Epi::SIDE) {
            SideItem sit; f32x4 sv[4]; const bool side = (E.side_r0 >= 0);
            if (side) { sit = moe_side_item(E.side_r0 + wid + 2048 * ui); side_load(sit, lane, 0, sv); }
            asm volatile("" ::: "memory"); PG8_SCHED;
            if constexpr (Epi::HOOKS) E.template finh<0>(acc, cur, ui, wr, wc, fr, fq); else E.template half<0>(acc, cur, wr, wc, fr, fq);
            asm volatile("" ::: "memory"); PG8_SCHED;
            if (side) { side_store(sit, lane, 0, sv, (const LAS float*)(lds + GF_OFF)); side_load(sit, lane, 1, sv); }
            asm volatile("" ::: "memory"); PG8_SCHED;
            if constexpr (Epi::HOOKS) E.template finh<1>(acc, cur, ui, wr, wc, fr, fq); else E.template half<1>(acc, cur, wr, wc, fr, fq);
            asm volatile("" ::: "memory"); PG8_SCHED;
            if (side) side_store(sit, lane, 1, sv, (const LAS float*)(lds + GF_OFF));
        } else { if constexpr (Epi::HOOKS) E.fin(acc, cur, ui, wr, wc, fr, fq); else E(acc, cur, wr, wc, fr, fq); }
        if (!has_next) break;
#pragma unroll
        for (int a = 0; a < 2; ++a)
#pragma unroll
            for (int b = 0; b < 2; ++b)
#pragma unroll
                for (int m = 0; m < 4; ++m)
#pragma unroll
                    for (int n = 0; n < 2; ++n) acc[a][b][m][n] = (f32x4){0.f, 0.f, 0.f, 0.f};
        cur = nxt; cA = nA; cB = nB; ++ui;
        if (GATHER) { vc0[0] = vn0[0]; vc0[1] = vn0[1]; vc1[0] = vn1[0]; vc1[1] = vn1[1]; }
        if (wr == 1) PG8_BAR;
    }
    PG8_WAIT_V(0);
    PG8_BAR;
#undef PG8_GOFF
#undef PG8_SA
#undef PG8_SB
#undef PG8_STAGE
#undef PG8_LDA
#undef PG8_LDB
#undef PG8_MMA
#undef PG8_WAIT_V
#undef PG8_WAIT_L
#undef PG8_BAR
#undef PG8_SCHED
}

struct DenseOrder {
    const char* A; const char* B; size_t a_tile, b_tile; int nM, nN, nwg, G, c;
    __device__ __forceinline__ bool next(int i, Unit& u) const {
        const long L = (long)i * G + c; if (L >= nwg) return false;
        int wgid = (int)L; { const int q = nwg / 8, r = nwg % 8, xcd = wgid % 8, off = wgid / 8; wgid = (xcd < r ? xcd * (q + 1) : r * (q + 1) + (xcd - r) * q) + off; }
        const int nig = 8 * nN, gid = wgid / nig, fm = gid * 8, gsz = (nM - fm) < 8 ? (nM - fm) : 8;
        u.pm = fm + ((wgid % nig) % gsz); u.pn = (wgid % nig) / gsz; u.aux = 0;
        u.a = A + (size_t)u.pm * a_tile; u.b = B + (size_t)u.pn * b_tile; return true;
    }
};
struct GroupOrder {
    const char* A; const char* B; size_t a_grp, b_grp, a_tile, b_tile; int nM, nN, nwg, G, c;
    __device__ __forceinline__ bool next(int i, Unit& u) const {
        const long L = (long)i * G + c; if (L >= nwg) return false;
        const int per = nM * nN, g = (int)L / per, r = (int)L % per;
        u.pn = r / nM; u.pm = r % nM; u.aux = g;
        u.a = A + (size_t)g * a_grp + (size_t)u.pm * a_tile; u.b = B + (size_t)g * b_grp + (size_t)u.pn * b_tile; return true;
    }
};
__device__ __forceinline__ void moe_unit(int L, int ntiles, int& pm, int& pn) {
    const int j = L >> 5, full = ntiles >> 3;
    if (j < full) { const int r = L & 31; pm = 8 * j + (r & 7); pn = r >> 3; }
    else { const int gsz = ntiles - 8 * full, r = L - 32 * full; pm = 8 * full + r % gsz; pn = r / gsz; }
}
struct MoeOrder {
    const char* A; const char* B; size_t a_tile, b_exp, b_tile; const LAS unsigned char* t2e; int ntiles, G, c;
    __device__ __forceinline__ bool next(int i, Unit& u) const {
        const long L = (long)i * G + c; if (L >= (long)ntiles * 4) return false;
        moe_unit((int)L, ntiles, u.pm, u.pn); u.aux = t2e[u.pm];
        u.a = A + (size_t)u.pm * a_tile; u.b = B + (size_t)u.aux * b_exp + (size_t)u.pn * b_tile; return true;
    }
};

typedef f32x4 Acc[2][2][4][2];
constexpr float YE_SCALE = 8.f;

__device__ __forceinline__ void store_pair(bf16* row_even, size_t pitch, u32x4 p0, u32x4 p1, int fr, int fq) {
    const bool odd = fr & 1;
    const u32x4 send = odd ? p0 : p1; u32x4 recv;
    recv.x = dppu<0xB1>(send.x); recv.y = dppu<0xB1>(send.y); recv.z = dppu<0xB1>(send.z); recv.w = dppu<0xB1>(send.w);
    const u32x4 a = odd ? recv : p0, b = odd ? p1 : recv;
    bf16* d = row_even + (odd ? 32 : 0) + 8 * fq;
#ifdef NT_STORES
    __builtin_nontemporal_store(a, (u32x4*)d); __builtin_nontemporal_store(b, (u32x4*)(d + pitch));
#else
    *(u32x4*)d = a; *(u32x4*)(d + pitch) = b;
#endif
}
struct EpiProj {
    static constexpr bool HALFN = false, HOOKS = false, PERM = true, SIDE = true;
    bf16* U2; bf16* QKV; const LAS float* GQK; int side_r0; unsigned char* side_ws;
    __device__ __forceinline__ void operator()(const Acc& acc, const Unit& u, int wr, int wc, int fr, int fq) const { half<0>(acc, u, wr, wc, fr, fq); half<1>(acc, u, wr, wc, fr, fq); }
    template <int AI> __device__ __forceinline__ void half(const Acc& acc, const Unit& u, int wr, int wc, int fr, int fq) const {
        asm volatile("" : "+v"(fr), "+v"(fq));
        const int typ = u.pn >> 1;
        if (typ == 1 || typ == 2) run<true, AI>(acc, u, wr, wc, fr, fq); else run<false, AI>(acc, u, wr, wc, fr, fq);
    }
    template <bool nrm, int AI> __device__ __forceinline__ void run(const Acc& acc, const Unit& u, int wr, int wc, int fr, int fq) const {
        const int typ = u.pn >> 1, sub = u.pn & 1;
        const LAS float* gg = GQK + ((typ == 1) ? 0 : 64);
        f32x4 gn[2][2];
#pragma unroll
        for (int bj = 0; bj < 2; ++bj)
#pragma unroll
            for (int n = 0; n < 2; ++n) gn[bj][n] = nrm ? *(const LAS f32x4*)(gg + 32 * bj + 8 * fq + 4 * n) : (f32x4){1.f, 1.f, 1.f, 1.f};
        { constexpr int ai = AI;
#pragma unroll
            for (int m = 0; m < 4; ++m) {
                const int r = u.pm * BM + ai * HALF + wr * 64 + m * 16 + fr;
                f32x4 v[2][2];
#pragma unroll
                for (int bj = 0; bj < 2; ++bj)
#pragma unroll
                    for (int n = 0; n < 2; ++n) v[bj][n] = acc[ai][bj][m][n];
                if constexpr (nrm) {
                    float s = 0.f;
#pragma unroll
                    for (int bj = 0; bj < 2; ++bj)
#pragma unroll
                        for (int n = 0; n < 2; ++n) s += (v[bj][n].x * v[bj][n].x + v[bj][n].y * v[bj][n].y) + (v[bj][n].z * v[bj][n].z + v[bj][n].w * v[bj][n].w);
                    s = xor32_sum(xor16_sum(s));
                    const float rstd = nrm ? __builtin_amdgcn_rsqf(s * (1.f / 64.f) + EPS) : 1.f;
#pragma unroll
                    for (int bj = 0; bj < 2; ++bj)
#pragma unroll
                        for (int n = 0; n < 2; ++n) v[bj][n] = v[bj][n] * (gn[bj][n] * rstd);
                }
                u32x4 p[2];
#pragma unroll
                for (int bj = 0; bj < 2; ++bj) { p[bj].x = cvtpk(v[bj][0].x, v[bj][0].y); p[bj].y = cvtpk(v[bj][0].z, v[bj][0].w); p[bj].z = cvtpk(v[bj][1].x, v[bj][1].y); p[bj].w = cvtpk(v[bj][1].z, v[bj][1].w); }
                if (!nrm && typ == 0) {
#pragma unroll
                    for (int bj = 0; bj < 2; ++bj) { const int f = sub * 256 + 64 * wc + 32 * bj + 8 * fq, g = f >> 4, h = f & 15;
                        *(u32x4*)(U2 + ((size_t)g * NCH + (r >> 5)) * U2P + (r & 31) * 16 + h) = p[bj]; }
                } else store_pair(QKV + (size_t)(typ - 1) * ((size_t)M * 512) + (size_t)(r & ~1) * 512 + sub * 256 + 64 * wc, 512, p[0], p[1], fr, fq);
            } }
    }
};
struct EpiState {
    static constexpr bool HALFN = true, HOOKS = false, PERM = false, SIDE = false;
    float* SST;
    __device__ __forceinline__ void operator()(const Acc& acc, const Unit& u, int wr, int wc, int fr, int fq) const {
#pragma unroll
        for (int ai = 0; ai < 2; ++ai)
#pragma unroll
            for (int m = 0; m < 4; ++m) { const int r = u.pm * BM + ai * HALF + wr * 64 + m * 16 + fr;
#pragma unroll
                for (int n = 0; n < 2; ++n) *(f32x4*)(SST + ((size_t)u.aux * NCH + r) * 128 + 32 * wc + 16 * n + 4 * fq) = acc[ai][0][m][n]; }
    }
};
struct EpiS5 {
    static constexpr bool HALFN = false, HOOKS = false, PERM = true, SIDE = false;
    bf16* Z;
    __device__ __forceinline__ void operator()(const Acc& acc, const Unit& u, int wr, int wc, int fr, int fq) const {
#pragma unroll
        for (int ai = 0; ai < 2; ++ai)
#pragma unroll
            for (int m = 0; m < 4; ++m) { const int r = u.pm * BM + ai * HALF + wr * 64 + m * 16 + fr;
#pragma unroll
                for (int bj = 0; bj < 2; ++bj) { const int c0 = u.pn * BM + bj * HALF + 32 * wc + 8 * fq, i = c0 >> 4, h = c0 & 15;
                    const f32x4 a = acc[ai][bj][m][0], b = acc[ai][bj][m][1];
                    u32x4 w; w.x = cvtpk(gelu_tanh(a.x), gelu_tanh(a.y)); w.y = cvtpk(gelu_tanh(a.z), gelu_tanh(a.w)); w.z = cvtpk(gelu_tanh(b.x), gelu_tanh(b.y)); w.w = cvtpk(gelu_tanh(b.z), gelu_tanh(b.w));
                    *(u32x4*)(Z + ((size_t)r * 32 + i) * DSSM + u.aux * 16 + h) = w; } }
    }
};
struct EpiGlu {
    static constexpr bool HALFN = false, HOOKS = false, PERM = true, SIDE = false;
    const bf16* Z; const float* bias; bf16* MIX; float* SSQ;
    __device__ __forceinline__ void operator()(const Acc& acc, const Unit& u, int wr, int wc, int fr, int fq) const {
        float ss[2][4];
#pragma unroll
        for (int ai = 0; ai < 2; ++ai)
#pragma unroll
            for (int m = 0; m < 4; ++m) ss[ai][m] = 0.f;
#pragma unroll
        for (int bj = 0; bj < 2; ++bj) { const int c0 = u.pn * BM + bj * HALF + 32 * wc + 8 * fq;
            constexpr float NL2E = -1.4426950408889634f;
            const f32x4 b0 = *(const GAS f32x4*)(bias + c0) * NL2E, b1 = *(const GAS f32x4*)(bias + c0 + 4) * NL2E;
#pragma unroll
            for (int ai = 0; ai < 2; ++ai)
#pragma unroll
                for (int m = 0; m < 4; ++m) { const size_t row = (size_t)(u.pm * BM + ai * HALF + wr * 64 + m * 16 + fr);
                    const u32x4 zz = *(const u32x4*)(Z + row * DSSM + c0);
                    const f32x4 a = acc[ai][bj][m][0], b = acc[ai][bj][m][1];
#define GLU_SG(v_, b_) __builtin_amdgcn_rcpf(1.f + __builtin_amdgcn_exp2f(__builtin_fmaf((v_), NL2E, (b_))))
                    float y[8];
                    y[0] = bf2f(zz.x & 0xffff) * GLU_SG(a.x, b0.x); y[1] = bf2f(zz.x >> 16) * GLU_SG(a.y, b0.y); y[2] = bf2f(zz.y & 0xffff) * GLU_SG(a.z, b0.z); y[3] = bf2f(zz.y >> 16) * GLU_SG(a.w, b0.w);
                    y[4] = bf2f(zz.z & 0xffff) * GLU_SG(b.x, b1.x); y[5] = bf2f(zz.z >> 16) * GLU_SG(b.y, b1.y); y[6] = bf2f(zz.w & 0xffff) * GLU_SG(b.z, b1.z); y[7] = bf2f(zz.w >> 16) * GLU_SG(b.w, b1.w);
#undef GLU_SG
                    { float sq = ss[ai][m];
#pragma unroll
                      for (int e = 0; e < 8; ++e) sq = __builtin_fmaf(y[e], y[e], sq);
                      ss[ai][m] = sq; }
                    u32x4 w; w.x = cvtpk(y[0], y[1]); w.y = cvtpk(y[2], y[3]); w.z = cvtpk(y[4], y[5]); w.w = cvtpk(y[6], y[7]);
                    *(u32x4*)(MIX + row * PX + c0) = w; } }
#pragma unroll
        for (int ai = 0; ai < 2; ++ai)
#pragma unroll
            for (int m = 0; m < 4; ++m) { float v = xor32_sum(xor16_sum(ss[ai][m]));
                if (fq == 0) atomicAdd(SSQ + (u.pm * BM + ai * HALF + wr * 64 + m * 16 + fr), v); }
    }
};
struct EpiX1B {
#ifndef SIDE7
#define SIDE7 1
#endif
    static constexpr bool HALFN = false, HOOKS = true, PERM = true, SIDE = (SIDE7 != 0);
    int side_r0; unsigned char* side_ws;
    const float* RSTDX; bf16* X1B; const float* SSQS; const float* SSQA; LAS float* RSC;
    __device__ __forceinline__ void begin(const Unit&, int, int) const {}
    __device__ __forceinline__ void fill(int ui, int pm, int tid) const {
        if (tid < 256) { const int row = pm * BM + tid; const float rs = __builtin_amdgcn_rsqf(SSQS[row] * (1.f / 512.f) + EPS), ra = __builtin_amdgcn_rsqf(SSQA[row] * (1.f / 512.f) + EPS);
            LAS float* d = RSC + (ui * 256 + tid) * 3; d[0] = rs * __builtin_amdgcn_rcpf(ra); d[1] = ra; d[2] = __builtin_amdgcn_rcpf(RSTDX[row]); }
    }
    __device__ __forceinline__ void mid(Acc& acc, int ui, int wr, int fr) const {
#pragma unroll
        for (int ai = 0; ai < 2; ++ai)
#pragma unroll
            for (int m = 0; m < 4; ++m) { const float f = RSC[(ui * 256 + ai * HALF + wr * 64 + m * 16 + fr) * 3];
#pragma unroll
                for (int bj = 0; bj < 2; ++bj)
#pragma unroll
                    for (int n = 0; n < 2; ++n) acc[ai][bj][m][n] = acc[ai][bj][m][n] * f; }
    }
    __device__ __forceinline__ void fin(const Acc& acc, const Unit& u, int ui, int wr, int wc, int fr, int fq) const { finh<0>(acc, u, ui, wr, wc, fr, fq); finh<1>(acc, u, ui, wr, wc, fr, fq); }
    template <int AI> __device__ __forceinline__ void finh(const Acc& acc, const Unit& u, int ui, int wr, int wc, int fr, int fq) const {
        constexpr int ai = AI;
#pragma unroll
            for (int m = 0; m < 4; ++m) { const int rl = ai * HALF + wr * 64 + m * 16 + fr; const LAS float* rc = RSC + (ui * 256 + rl) * 3; const float ra = rc[1], ix = rc[2];
                const size_t ro = (size_t)(u.pm * BM + rl) * PX + u.pn * BM + 64 * wc + 8 * fq;
                u32x4 p[2];
#pragma unroll
                for (int bj = 0; bj < 2; ++bj) { const u32x4 xn = *(const u32x4*)(X1B + ro + 32 * bj);
                    const f32x4 xa = (f32x4){bf2f(xn.x & 0xffff), bf2f(xn.x >> 16), bf2f(xn.y & 0xffff), bf2f(xn.y >> 16)} * ix, xb = (f32x4){bf2f(xn.z & 0xffff), bf2f(xn.z >> 16), bf2f(xn.w & 0xffff), bf2f(xn.w >> 16)} * ix;
                    const f32x4 a = xa + acc[ai][bj][m][0] * ra, b = xb + acc[ai][bj][m][1] * ra;
                    p[bj].x = cvtpk(a.x, a.y); p[bj].y = cvtpk(a.z, a.w); p[bj].z = cvtpk(b.x, b.y); p[bj].w = cvtpk(b.z, b.w); }
                store_pair(X1B + (size_t)(u.pm * BM + (rl & ~1)) * PX + u.pn * BM + 64 * wc, PX, p[0], p[1], fr, fq); }
    }
};
struct EpiGU {
    static constexpr bool HALFN = false, HOOKS = true, PERM = true, SIDE = false;
    __device__ __forceinline__ void begin(const Unit&, int, int) const {}
    __device__ __forceinline__ void mid(Acc&, int, int, int) const {}
    unsigned char* HH; const LAS unsigned* RCW;
    __device__ __forceinline__ void fin(const Acc& acc, const Unit& u, int ui, int wr, int wc, int fr, int fq) const {
#pragma unroll
        for (int ai = 0; ai < 2; ++ai)
#pragma unroll
            for (int m = 0; m < 4; ++m) { const int rl = ai * HALF + wr * 64 + m * 16 + fr, rr = u.pm * BM + rl; const size_t off = (size_t)rr * DE + u.pn * 128 + 32 * wc + 8 * fq;
                const float sc = __uint_as_float(RCW[ui * 256 + rl] & 0xffff0000u) * (1.f / W8SC), k1 = sc * -1.4426950408889634f, sc2 = sc * sc;
#define GU_H(g_, u_) (((g_) * (u_)) * __builtin_amdgcn_rcpf(1.f + __builtin_amdgcn_exp2f((g_) * k1)) * sc2)
                float hv[8];
#pragma unroll
                for (int n = 0; n < 2; ++n) { const f32x4 gt = acc[ai][0][m][n], up = acc[ai][1][m][n];
                    hv[4 * n] = GU_H(gt.x, up.x); hv[4 * n + 1] = GU_H(gt.y, up.y); hv[4 * n + 2] = GU_H(gt.z, up.z); hv[4 * n + 3] = GU_H(gt.w, up.w); }
#undef GU_H
                u32x2 w; w.x = pk4_fp8(hv[0], hv[1], hv[2], hv[3]); w.y = pk4_fp8(hv[4], hv[5], hv[6], hv[7]);
                *(u32x2*)(HH + off) = w; }
    }
};
struct EpiDown {
    static constexpr bool HALFN = false, HOOKS = true, PERM = true, SIDE = false;
    __device__ __forceinline__ void begin(const Unit&, int, int) const {}
    __device__ __forceinline__ void mid(Acc&, int, int, int) const {}
    unsigned char* YE; const LAS float* RGC;
    __device__ __forceinline__ void fin(const Acc& acc, const Unit& u, int ui, int wr, int wc, int fr, int fq) const {
#pragma unroll
        for (int ai = 0; ai < 2; ++ai)
#pragma unroll
            for (int m = 0; m < 4; ++m) { const int rl = ai * HALF + wr * 64 + m * 16 + fr; const float gw_ = RGC[ui * 256 + rl] * (YE_SCALE / W8SC);
                u32x2 p[2];
#pragma unroll
                for (int bj = 0; bj < 2; ++bj) { const f32x4 a = acc[ai][bj][m][0] * gw_, b = acc[ai][bj][m][1] * gw_; p[bj].x = pk4_fp8(a.x, a.y, a.z, a.w); p[bj].y = pk4_fp8(b.x, b.y, b.z, b.w); }
                const bool od = fq & 1; const u32x2 send = od ? p[0] : p[1]; u32x2 recv; recv.x = xor16_get(send.x, od); recv.y = xor16_get(send.y, od);
                u32x4 w; if (od) { w.x = recv.x; w.y = recv.y; w.z = p[1].x; w.w = p[1].y; } else { w.x = p[0].x; w.y = p[0].y; w.z = recv.x; w.w = recv.y; }
                *(u32x4*)(YE + (size_t)(u.pm * BM + rl) * DM + u.pn * BM + 64 * wc + (od ? 32 : 0) + 8 * (fq & ~1)) = w; }
    }
};

template <int K> __device__ __forceinline__ const float* karg() {
    const float* p;
    asm volatile("s_load_dwordx2 %0, %1, %2\n\ts_waitcnt lgkmcnt(0)" : "=s"(p) : "s"(__builtin_amdgcn_kernarg_segment_ptr()), "i"(K * 8) : "memory");
    return p;
}
struct Args { const float* in[26]; float* out; unsigned char* ws; int ph_lo, ph_hi; };
struct Frame { LAS unsigned char* lds; volatile LAS unsigned* MISC; unsigned* ctl; int tid, lane, wave, G, c; };

struct TItem { const float* W; int ldw, srccol0; const float* kscale; bf16* WT; int ldt, dstrow0, k0; int fp8; };
__device__ __forceinline__ void titem_load(const TItem& t, int lane, f32x4 (&v)[8]) {
#pragma unroll
    for (int i = 0; i < 8; ++i) { const int kk = 8 * i + (lane >> 3); v[i] = *(const GAS f32x4*)(t.W + (size_t)(t.k0 + kk) * t.ldw + t.srccol0 + (lane & 7) * 4); }
}
__device__ __forceinline__ void titem_store(const TItem& t, int lane, const f32x4 (&v)[8], LAS float* scr) {
#pragma unroll
    for (int i = 0; i < 8; ++i) { const int kk = 8 * i + (lane >> 3); const float sc = t.kscale ? t.kscale[t.k0 + kk] : 1.f; LAS float* d = scr + kk * 33 + (lane & 7) * 4;
        d[0] = v[i].x * sc; d[1] = v[i].y * sc; d[2] = v[i].z * sc; d[3] = v[i].w * sc; }
    asm volatile("s_waitcnt lgkmcnt(0)" ::: "memory");
    const int c = lane & 7;
#pragma unroll
    for (int j = 0; j < 4; ++j) { const int n = (lane >> 3) + 8 * j; const LAS float* s = scr + (8 * c) * 33 + n;
        if (t.fp8) { u32x2 o; o.x = pk4_fp8(s[0 * 33] * W8SC, s[1 * 33] * W8SC, s[2 * 33] * W8SC, s[3 * 33] * W8SC); o.y = pk4_fp8(s[4 * 33] * W8SC, s[5 * 33] * W8SC, s[6 * 33] * W8SC, s[7 * 33] * W8SC);
            *(u32x2*)((unsigned char*)t.WT + (size_t)(t.dstrow0 + n) * t.ldt + t.k0 + 8 * c) = o; }
        else { u32x4 o; o.x = pk2(s[0 * 33], s[1 * 33]); o.y = pk2(s[2 * 33], s[3 * 33]); o.z = pk2(s[4 * 33], s[5 * 33]); o.w = pk2(s[6 * 33], s[7 * 33]);
            *(u32x4*)(t.WT + (size_t)(t.dstrow0 + n) * t.ldt + t.k0 + 8 * c) = o; } }
    asm volatile("s_waitcnt lgkmcnt(0)" ::: "memory");
}
__device__ __forceinline__ void s5_tables_item(Frame& F, const Args& a, int g, int part) {
    const float* lre = karg<3>(); const float* lim = karg<4>(); const float* ldt = karg<5>(); const float* bre = karg<6>(); const float* bim = karg<7>();
    const float* cre = karg<8>(); const float* cim = karg<9>(); const float* dsk = karg<10>();
    LAS float* PWr = (LAS float*)F.lds; LAS float* PWi = PWr + 33 * 64; LAS float* BBr = PWi + 33 * 64; LAS float* BBi = BBr + 1024; LAS float* CCr = BBi + 1024; LAS float* CCi = CCr + 1024; LAS float* CF = CCi + 1024;
    const int tid = F.tid;
    if (tid < 64) { const int p = tid;
        const double dt = exp((double)ldt[g]), lr = lre[g * PST + p], li = lim[g * PST + p];
        double sn, cs; sincos_d(li * dt, sn, cs); const double mag = exp(lr * dt);
        const double ar = mag * cs, ai = mag * sn, den = lr * lr + li * li, nr = ar - 1.0, ni = ai;
        CF[2 * p] = (float)((nr * lr + ni * li) / den); CF[2 * p + 1] = (float)((ni * lr - nr * li) / den);
        double pr = 1.0, pi = 0.0;
        for (int l = 0; l <= 32; ++l) { PWr[l * 64 + p] = (float)pr; PWi[l * 64 + p] = (float)pi; if (l == 32 && part == 0) { float* A32 = (float*)(a.ws + FW_A32) + (g * PST + p) * 2; A32[0] = (float)pr; A32[1] = (float)pi; }
            const double t = pr * ar - pi * ai; pi = pr * ai + pi * ar; pr = t; }
    }
    __syncthreads();
    for (int idx = tid; idx < 1024; idx += NTHR) { const int p = idx >> 4; const float cfr = CF[2 * p], cfi = CF[2 * p + 1], br = bre[(size_t)g * 1024 + idx], bi = bim[(size_t)g * 1024 + idx];
        BBr[idx] = cfr * br - cfi * bi; BBi[idx] = cfr * bi + cfi * br; CCr[idx] = cre[(size_t)g * 1024 + idx]; CCi[idx] = cim[(size_t)g * 1024 + idx]; }
    __syncthreads();
    bf16* TBg = (bf16*)(a.ws + FW_TB) + (size_t)g * 512 * U2P; bf16* W1g = (bf16*)(a.ws + FW_W1) + (size_t)g * 256 * 512;
    for (int l = part; l < 32; l += 8) {
        if (tid < 256) { const int h = tid >> 4, hp = tid & 15; float k = 0.f;
#pragma unroll 16
            for (int p = 0; p < 64; ++p) { const float wr_ = PWr[l * 64 + p], wi_ = PWi[l * 64 + p], br = BBr[p * 16 + hp], bi = BBi[p * 16 + hp];
                k += CCr[h * 64 + p] * (wr_ * br - wi_ * bi) - CCi[h * 64 + p] * (wr_ * bi + wi_ * br); }
            if (l == 0 && h == hp) k += dsk[g * 16 + h];
            const bf16 v = (bf16)f2bf(k);
            for (int i = l; i < 32; ++i) TBg[(size_t)(i * 16 + h) * U2P + (i - l) * 16 + hp] = v;
            if (l >= 1) for (int i = 0; i < 32 - l; ++i) TBg[(size_t)(i * 16 + h) * U2P + (i + l) * 16 + hp] = 0;
        } else { const int t2 = tid - 256;
#pragma unroll
            for (int x = 0; x < 8; ++x) { const int e = t2 * 8 + x;
                { const int h = e >> 7, q = e & 127, p = q & 63; const float cr = CCr[h * 64 + p], ci = CCi[h * 64 + p], wr_ = PWr[(l + 1) * 64 + p], wi_ = PWi[(l + 1) * 64 + p];
                  const float re = cr * wr_ - ci * wi_, im = cr * wi_ + ci * wr_; TBg[(size_t)(l * 16 + h) * U2P + 512 + q] = (bf16)f2bf(q < 64 ? re : -im); }
                { const int rho = e >> 4, hp = e & 15, p = rho & 63; const float wr_ = PWr[(31 - l) * 64 + p], wi_ = PWi[(31 - l) * 64 + p], br = BBr[p * 16 + hp], bi = BBi[p * 16 + hp];
                  const float re = wr_ * br - wi_ * bi, im = wr_ * bi + wi_ * br; W1g[(size_t)rho * 512 + l * 16 + hp] = (bf16)f2bf(rho < 64 ? re : im); W1g[(size_t)(128 + rho) * 512 + l * 16 + hp] = 0; }
            }
        }
    }
    __syncthreads();
}
#ifndef XNR
#define XNR 8
#endif
__device__ __forceinline__ void p0_prologue(Frame& F, const Args& a) {
    const float* x = karg<0>();
    for (int it = F.c; it < 256; it += F.G) s5_tables_item(F, a, it >> 3, it & 7);
    LAS float* scr = (LAS float*)(F.lds + F.wave * 16384);
    const int gw = F.c * NWAVES + F.wave, NGW = F.G * NWAVES;
    constexpr int I_IN = 16 * 64, I_GLU = 8 * 16, I_OUT = 16 * 32, I_GU = 32 * 16 * 32, I_D = 32 * 8 * 32, NITEMS = I_IN + I_GLU + I_OUT + I_GU + I_D;
    bf16* WIN = (bf16*)(a.ws + FW_WIN); bf16* WGLU = (bf16*)(a.ws + FW_WGLU); bf16* WOUT = (bf16*)(a.ws + FW_WOUT); bf16* WGU = (bf16*)(a.ws + FW_WGU); bf16* WD = (bf16*)(a.ws + FW_WD);
    auto mkitem = [&](int it) -> TItem {
        int r = it;
        if (r < I_IN) { const int kb = r >> 6, d = r & 63, pn = d >> 3, beta = d & 7, bj = beta >> 2, wc = beta & 3;
            return TItem{karg<2>(), DIN, 256 * pn + 32 * (2 * wc + bj), karg<1>(), WIN, PW, 32 * d, 64 * kb, 0}; } r -= I_IN;
        if (r < I_GLU) { const int kb = r >> 4, d = r & 15; return TItem{karg<11>(), DSSM, 32 * d, nullptr, WGLU, DSSM, 32 * d, 64 * kb, 0}; } r -= I_GLU;
        if (r < I_OUT) { const int kb = r >> 5, d = r & 31; const float* ks = (kb < 8) ? karg<15>() : (karg<16>() - 512);
            return TItem{karg<17>(), DM, 32 * (8 * (d >> 3) + 2 * (d & 3) + ((d & 7) >> 2)), ks, WOUT, PW, 32 * d, 64 * kb, 0}; } r -= I_OUT;
        if (r < I_GU) { const int e = r >> 9, q = r & 511, kb = q >> 5, d = q & 31, pn = d >> 3, beta = d & 7;
            const float* W = (beta < 4 ? karg<23>() : karg<24>()) + (size_t)e * DM * DE;
            return TItem{W, DE, 128 * pn + 32 * (beta & 3), karg<18>(), (bf16*)((unsigned char*)WGU + (size_t)e * DM * DM), DM, 32 * d, 64 * kb, 1}; } r -= I_GU;
        const int e = r >> 8, q = r & 255, kb = q >> 5, d = q & 31;
        return TItem{karg<25>() + (size_t)e * DE * DM, DM, 32 * (8 * (d >> 3) + 2 * (d & 3) + ((d & 7) >> 2)), nullptr, (bf16*)((unsigned char*)WD + (size_t)e * DM * DE), DE, 32 * d, 64 * kb, 1};
    };
    const int nitems = (F.G == 256) ? (I_IN + I_GLU + I_OUT) : NITEMS;
    if (gw < nitems) {
        TItem cur = mkitem(gw); f32x4 vc[8]; titem_load(cur, F.lane, vc);
        for (int it = gw; it < nitems; it += NGW) {
            const bool more = it + NGW < nitems; TItem nxt = cur; f32x4 vn[8];
            if (more) { nxt = mkitem(it + NGW); titem_load(nxt, F.lane, vn); }
            titem_store(cur, F.lane, vc, scr);
            if (more) { cur = nxt;
#pragma unroll
                for (int i = 0; i < 8; ++i) vc[i] = vn[i]; }
        }
    }
    { bf16* WR = (bf16*)(a.ws + FW_WR);
      for (int idx = F.c * NTHR + F.tid; idx < 64 * DM; idx += F.G * NTHR) { const int n = idx >> 10, k = idx & 1023;
          float v = 0.f; if (n < 4) v = karg<19>()[k * 4 + n]; else if (n < 36) v = karg<21>()[k * 32 + (n - 4)];
          WR[idx] = (bf16)f2bf(v * karg<18>()[k]); } }
    bf16* XN = (bf16*)(a.ws + FW_XN); float* RSTDX = (float*)(a.ws + FW_RSTDX);
    for (int m0 = gw * XNR; m0 < M; m0 += NGW * XNR) {
        f32x4 v[XNR][4];
#pragma unroll
        for (int rr = 0; rr < XNR; ++rr) { const GAS f32x4* xr = (const GAS f32x4*)(x + (size_t)(m0 + rr) * DM);
            v[rr][0] = __builtin_nontemporal_load(xr + 2 * F.lane); v[rr][1] = __builtin_nontemporal_load(xr + 2 * F.lane + 1);
            v[rr][2] = __builtin_nontemporal_load(xr + 128 + 2 * F.lane); v[rr][3] = __builtin_nontemporal_load(xr + 128 + 2 * F.lane + 1); }
#pragma unroll
        for (int rr = 0; rr < XNR; ++rr) { float s = 0.f;
#pragma unroll
            for (int j = 0; j < 4; ++j) s += v[rr][j].x * v[rr][j].x + v[rr][j].y * v[rr][j].y + v[rr][j].z * v[rr][j].z + v[rr][j].w * v[rr][j].w;
            const float rstd = __builtin_amdgcn_rsqf(wave_sum(s) * (1.f / DM) + EPS);
            if (F.lane == 0) RSTDX[m0 + rr] = rstd;
            u32x4* o = (u32x4*)(XN + (size_t)(m0 + rr) * PX);
#pragma unroll
            for (int j = 0; j < 2; ++j) { const f32x4 a = v[rr][2 * j] * rstd, b = v[rr][2 * j + 1] * rstd; u32x4 w; w.x = cvtpk(a.x, a.y); w.y = cvtpk(a.z, a.w); w.z = cvtpk(b.x, b.y); w.w = cvtpk(b.z, b.w); o[64 * j + F.lane] = w; } }
    }
}

__device__ __forceinline__ void s5_scan_local(Frame& F, const Args& a, int g, int pm) {
    const float* SST = (const float*)(a.ws + FW_SST); bf16* U2 = (bf16*)(a.ws + FW_U2);
    if (F.tid < 256) {
        const int p = F.tid & 63;
        const float* A32 = (const float*)(a.ws + FW_A32) + (g * PST + p) * 2; const float ar = A32[0], ai = A32[1];
        float xr = 0.f, xi = 0.f;
        const size_t row0 = (size_t)g * NCH + (size_t)pm * 256 + (size_t)(F.tid >> 6) * 64;
        for (int c0 = 0; c0 < 64; c0 += 16) {
            float sr[16], si[16];
#pragma unroll
            for (int j = 0; j < 16; ++j) { sr[j] = SST[(row0 + c0 + j) * 128 + p]; si[j] = SST[(row0 + c0 + j) * 128 + 64 + p]; }
#pragma unroll
            for (int j = 0; j < 16; ++j) { bf16* up = U2 + (row0 + c0 + j) * U2P + 512; up[p] = (bf16)f2bf(xr); up[64 + p] = (bf16)f2bf(xi);
                const float t = ar * xr - ai * xi + sr[j]; xi = ar * xi + ai * xr + si[j]; xr = t; }
        }
    }
}
__device__ __forceinline__ void s5_scan(Frame& F, const Args& a) {
    const float* SST = (const float*)(a.ws + FW_SST); bf16* U2 = (bf16*)(a.ws + FW_U2);
    for (int idx = F.c * NTHR + F.tid; idx < BATCH * NG * PST; idx += F.G * NTHR) {
        const int p = idx & 63, g = (idx >> 6) & 31, b = idx >> 11;
        const double dt = exp((double)karg<5>()[g]), lr = karg<3>()[g * PST + p], li = karg<4>()[g * PST + p];
        double sn, cs; sincos_d(32.0 * li * dt, sn, cs); const double mag = exp(32.0 * lr * dt);
        const float ar = (float)(mag * cs), ai = (float)(mag * sn);
        float xr = 0.f, xi = 0.f;
        const size_t row0 = (size_t)g * NCH + (size_t)b * 64;
        for (int c0 = 0; c0 < 64; c0 += 16) {
            float sr[16], si[16];
#pragma unroll
            for (int j = 0; j < 16; ++j) { sr[j] = SST[(row0 + c0 + j) * 128 + p]; si[j] = SST[(row0 + c0 + j) * 128 + 64 + p]; }
#pragma unroll
            for (int j = 0; j < 16; ++j) { bf16* up = U2 + (row0 + c0 + j) * U2P + 512; up[p] = (bf16)f2bf(xr); up[64 + p] = (bf16)f2bf(xi);
                const float t = ar * xr - ai * xi + sr[j]; xi = ar * xi + ai * xr + si[j]; xr = t; }
        }
    }
}

#ifndef ATT_THR_V
#define ATT_THR_V -32.f
#endif
constexpr float ATT_THR = ATT_THR_V;
__device__ __forceinline__ s16x4 vtr(const LAS unsigned char* p) { typedef short v4i16_t __attribute__((ext_vector_type(4))); return __builtin_bit_cast(s16x4, __builtin_amdgcn_ds_read_tr16_b64_v4i16((LAS v4i16_t*)p)); }
__device__ __forceinline__ int crow(int r, int hi) { return (r & 3) + 8 * (r >> 2) + 4 * hi; }
#define MFMA32(a, b, c) __builtin_amdgcn_mfma_f32_32x32x16_bf16((a), (b), (c), 0, 0, 0)
template <bool DIAG, int P, int KH, int KD, int VD>
__device__ __forceinline__ float attn_half(const LAS unsigned char* Kb, const LAS unsigned char* Vb, const bf16x8 (&qr)[4], const bf16x8 (&tri)[2], f32x16 (&o)[2], float base, int lim, int lane) {
    const int r32 = lane & 31, hi = lane >> 5;
    const LAS unsigned char* kp = Kb + hi * KH + r32 * 16 + P * 512;
    const int lim2 = lim - 4 * hi;
    f32x16 z = {};
#pragma unroll
    for (int d0 = 0; d0 < 4; ++d0) { const bf16x8 kf = *(const LAS bf16x8*)(kp + d0 * KD); z = MFMA32(kf, qr[d0], z); }
    float l[16];
#pragma unroll
    for (int r = 0; r < 16; ++r) { l[r] = -__builtin_amdgcn_logf(1.f + __builtin_amdgcn_exp2f(z[r])); if (DIAG) { if (!((r & 3) + 8 * (r >> 2) + 32 * P < lim2)) l[r] = 0.f; } }
    u32x4 wa, wb;
    wa.x = cvtpk(l[0], l[1]); wa.y = cvtpk(l[2], l[3]); wa.z = cvtpk(l[4], l[5]); wa.w = cvtpk(l[6], l[7]);
    wb.x = cvtpk(l[8], l[9]); wb.y = cvtpk(l[10], l[11]); wb.z = cvtpk(l[12], l[13]); wb.w = cvtpk(l[14], l[15]);
    const bf16x8 La = __builtin_bit_cast(bf16x8, wa), Lb = __builtin_bit_cast(bf16x8, wb);
    f32x16 T = {};
    T = MFMA32(tri[0], La, T); T = MFMA32(tri[1], Lb, T);
    float av[16];
#pragma unroll
    for (int r = 0; r < 16; ++r) { av[r] = __builtin_amdgcn_exp2f((z[r] + base) + T[r]); if (DIAG) { if (!((r & 3) + 8 * (r >> 2) + 32 * P < lim2)) av[r] = 0.f; } }
    wa.x = cvtpk(av[0], av[1]); wa.y = cvtpk(av[2], av[3]); wa.z = cvtpk(av[4], av[5]); wa.w = cvtpk(av[6], av[7]);
    wb.x = cvtpk(av[8], av[9]); wb.y = cvtpk(av[10], av[11]); wb.z = cvtpk(av[12], av[13]); wb.w = cvtpk(av[14], av[15]);
    const bf16x8 Pa = __builtin_bit_cast(bf16x8, wa), Pb = __builtin_bit_cast(bf16x8, wb);
    const LAS unsigned char* vp = Vb + ((lane >> 4) & 1) * 32 + (lane & 3) * 8 + (4 * hi + ((lane & 15) >> 2)) * 64 + P * 2048;
#pragma unroll
    for (int d0 = 0; d0 < 2; ++d0) {
        const s16x4 lo0 = vtr(vp + d0 * VD), hi0 = vtr(vp + d0 * VD + 512), lo1 = vtr(vp + d0 * VD + 1024), hi1 = vtr(vp + d0 * VD + 1536);
        const bf16x8 v0 = {lo0[0], lo0[1], lo0[2], lo0[3], hi0[0], hi0[1], hi0[2], hi0[3]}, v1 = {lo1[0], lo1[1], lo1[2], lo1[3], hi1[0], hi1[1], hi1[2], hi1[3]};
        o[d0] = MFMA32(Pa, v0, o[d0]); o[d0] = MFMA32(Pb, v1, o[d0]);
    }
    { const unsigned u = __builtin_bit_cast(unsigned, T[0]); auto r = __builtin_amdgcn_permlane32_swap(u, u, false, false); return __builtin_bit_cast(float, (unsigned)r[0]); }
}
#ifndef ASPAN_N
#define ASPAN_N 13
#endif
constexpr int ASPAN = ASPAN_N;
__device__ __forceinline__ void attn_span_phase(Frame& F, const bf16* Q, const bf16* Kg, const bf16* Vg, bf16* MIX, float* SSQA) {
    const int lane = F.lane, wid = F.wave, r32 = lane & 31, hi = lane >> 5;
    volatile LAS int* FLG = (volatile LAS int*)(F.lds + ASPAN * 8192 + 8 * 4096);
    bf16x8 tri[2];
#pragma unroll
    for (int s = 0; s < 2; ++s)
#pragma unroll
        for (int j = 0; j < 8; ++j) tri[s][j] = ((16 * s + 8 * (j >> 2) + 4 * hi + (j & 3)) >= r32) ? (short)0x3F80 : (short)0;
    for (int L = F.c; L < BATCH * NH * 8; L += F.G) {
        const int bh = L >> 3, qb = L & 7, b = bh >> 3, h = bh & 7, a0 = 8 * qb, a = a0 + wid;
        const size_t row0 = (size_t)b * SEQ; const int qg = 32 * a + r32;
        bf16x8 qr[4];
#pragma unroll
        for (int d0 = 0; d0 < 4; ++d0) qr[d0] = *(const bf16x8*)(Q + (row0 + qg) * DATT + h * HD + d0 * 16 + hi * 8);
        const bf16* src = (wid < 4) ? (Kg + (row0 + (lane & 31)) * DATT + h * HD + (lane >> 5) * 8 + 16 * wid)
                                    : (Vg + (row0 + 16 * (wid & 1) + (lane >> 2)) * DATT + h * HD + (lane & 3) * 8 + 32 * ((wid - 4) >> 1));
        const int dsto = (wid < 4) ? wid * 1024 : 4096 + (wid - 4) * 1024;
        f32x16 o[2] = {}; float Rc = 0.f; bool done = false;
        for (int k = 0;; ++k) {
            const int top = a0 + 7 - ASPAN * k, bot = (top - (ASPAN - 1) > 0) ? top - (ASPAN - 1) : 0;
#pragma unroll 1
            for (int jj = top; jj >= bot; --jj)
                __builtin_amdgcn_global_load_lds((const unsigned*)(src + (size_t)(32 * jj) * DATT), (LAS unsigned*)(F.lds + (top - jj) * 8192 + dsto), 16, 0, 0);
            asm volatile("s_waitcnt vmcnt(0)" ::: "memory");
            __syncthreads();
            if (!done) {
                for (int jj = (a < top ? a : top); jj >= bot; --jj) {
                    const LAS unsigned char* Kb = F.lds + (top - jj) * 8192; const LAS unsigned char* Vb = Kb + 4096;
                    const int lim = qg - 32 * jj;
                    float sh;
                    if (jj == a) sh = attn_half<true, 0, 512, 1024, 2048>(Kb, Vb, qr, tri, o, Rc, lim, lane);
                    else sh = attn_half<false, 0, 512, 1024, 2048>(Kb, Vb, qr, tri, o, Rc, lim, lane);
                    Rc += sh;
                    if (jj == 0 || __all(Rc < ATT_THR)) { done = true; break; }
                }
            }
            if (lane == 0) FLG[wid] = done ? 1 : 0;
            asm volatile("s_waitcnt lgkmcnt(0)" ::: "memory");
            __syncthreads();
            if (bot == 0) break;
            int alld = 1;
#pragma unroll
            for (int w = 0; w < 8; ++w) alld &= FLG[w];
            if (alld) break;
        }
        { LAS unsigned char* stg = F.lds + ASPAN * 8192 + wid * 4096; LAS unsigned short* sp = (LAS unsigned short*)(stg + hi * 512 + r32 * 2);
#pragma unroll
          for (int r = 0; r < 16; ++r) { const int ro = ((r & 3) + 8 * (r >> 2)) * 64; sp[ro] = (unsigned short)f2bf(o[0][r]); sp[ro + 32] = (unsigned short)f2bf(o[1][r]); }
          asm volatile("s_waitcnt lgkmcnt(0)" ::: "memory");
          bf16* ow = MIX + (row0 + 32 * a) * PX + 512 + h * HD;
#pragma unroll
          for (int i = 0; i < 4; ++i) { const int row = i * 8 + (lane >> 3), ch = lane & 7; const u32x4 v = *(const LAS u32x4*)(stg + row * 128 + ch * 16); *(u32x4*)(ow + (size_t)row * PX + ch * 8) = v;
              const float f0 = bf2f(v.x & 0xffff), f1 = bf2f(v.x >> 16), f2 = bf2f(v.y & 0xffff), f3 = bf2f(v.y >> 16), f4 = bf2f(v.z & 0xffff), f5 = bf2f(v.z >> 16), f6 = bf2f(v.w & 0xffff), f7 = bf2f(v.w >> 16);
              float ss = ((f0 * f0 + f1 * f1) + (f2 * f2 + f3 * f3)) + ((f4 * f4 + f5 * f5) + (f6 * f6 + f7 * f7));
              ss += dppf<0xB1>(ss); ss += dppf<0x4E>(ss); ss += dppf<0x141>(ss);
              if (ch == 0) atomicAdd(SSQA + (row0 + 32 * a + row), ss); }
          asm volatile("s_waitcnt lgkmcnt(0)" ::: "memory"); }
    }
    asm volatile("s_waitcnt vmcnt(0)" ::: "memory");
    __syncthreads();
}
static_assert(ASPAN * 8192 + 8 * 4096 + 64 <= MISC_OFF, "attention LDS map");

constexpr int RT_PITCH = 2064;
__device__ __forceinline__ void router_phase(Frame& F, const Args& a) {
    const bf16* X1B = (const bf16*)(a.ws + FW_X1B); unsigned char* X1Q = (unsigned char*)(a.ws + FW_X1Q); int* TOK = (int*)(a.ws + FW_TOK); const bf16* WR = (const bf16*)(a.ws + FW_WR);
    const float* brg = karg<20>(); const float* bre_ = karg<22>();
    const int tid = F.tid, lane = F.lane, wid = F.wave, r32 = lane & 31, hi = lane >> 5;
    LAS unsigned char* TILE = F.lds;
    LAS float* PART = (LAS float*)(F.lds + 66048);
    LAS float* LOGIT = (LAS float*)(F.lds + 66048 + 65536);
    LAS int* HIST = (LAS int*)(F.lds + 66048 + 65536 + 5120);
    LAS int* TREC = HIST + 64;
    LAS float* RS = (LAS float*)(TREC + 1024);
    LAS float* TRS = RS + 32;
    LAS float* TRG = TRS + 256;
    LAS float* BIAS = TRG + 512;
    static_assert(66048 + 65536 + 5120 + 256 + 4096 + 128 + 1024 + 2048 + 160 <= MISC_OFF, "router LDS");
    bf16x8 Bf[8][2];
#pragma unroll
    for (int s = 0; s < 8; ++s)
#pragma unroll
        for (int nb = 0; nb < 2; ++nb) Bf[s][nb] = *(const bf16x8*)(WR + (size_t)(32 * nb + r32) * DM + 128 * wid + 16 * s + 8 * hi);
    if (tid < 64) HIST[tid] = 0;
    if (tid >= 64 && tid < 104) { const int c = tid - 64; BIAS[c] = c < 4 ? brg[c] : (c < 36 ? bre_[c - 4] : 0.f); }
    __syncthreads();
    int ntl = 0;
#define RT_BAR() do { asm volatile("s_waitcnt lgkmcnt(0)" ::: "memory"); __builtin_amdgcn_s_barrier(); asm volatile("" ::: "memory"); } while (0)
#define RT_LOAD(tile_) do { _Pragma("unroll") for (int rr = 0; rr < 4; ++rr) { const u32x4* xr = (const u32x4*)(X1B + (size_t)((tile_) * 32 + 4 * wid + rr) * PX); v[rr][0] = xr[lane]; v[rr][1] = xr[64 + lane]; } } while (0)
    u32x4 v[4][2];
    if (F.c < M / 32) RT_LOAD(F.c);
    for (int tile = F.c; tile < M / 32; tile += F.G, ++ntl) {
        {
#pragma unroll
          for (int rr = 0; rr < 4; ++rr) { const int lr = 4 * wid + rr; float s = 0.f;
#pragma unroll
              for (int j = 0; j < 2; ++j) { const u32x4 w = v[rr][j];
                  const float f0 = bf2f(w.x & 0xffff), f1 = bf2f(w.x >> 16), f2 = bf2f(w.y & 0xffff), f3 = bf2f(w.y >> 16), f4 = bf2f(w.z & 0xffff), f5 = bf2f(w.z >> 16), f6 = bf2f(w.w & 0xffff), f7 = bf2f(w.w >> 16);
                  s += (f0 * f0 + f1 * f1) + (f2 * f2 + f3 * f3) + (f4 * f4 + f5 * f5) + (f6 * f6 + f7 * f7);
                  { u32x2 q8; q8.x = pk4_fp8(f0, f1, f2, f3); q8.y = pk4_fp8(f4, f5, f6, f7); *(u32x2*)(X1Q + (size_t)(tile * 32 + lr) * DM + (64 * j + lane) * 8) = q8; }
                  *(LAS u32x4*)(TILE + lr * RT_PITCH + (64 * j + lane) * 16) = w; }
              const float rstd = __builtin_amdgcn_rsqf(wave_sum(s) * (1.f / DM) + EPS);
              if (lane == 0) RS[lr] = rstd; } }
        if (tile + F.G < M / 32) RT_LOAD(tile + F.G);
        RT_BAR();
        { f32x16 c0 = {}, c1 = {};
#pragma unroll
          for (int s = 0; s < 8; ++s) { const bf16x8 af = *(const LAS bf16x8*)(TILE + r32 * RT_PITCH + (128 * wid + 16 * s + 8 * hi) * 2);
              c0 = MFMA32(af, Bf[s][0], c0); c1 = MFMA32(af, Bf[s][1], c1); }
#pragma unroll
          for (int r = 0; r < 16; ++r) { const int t = crow(r, hi); PART[(wid * 32 + t) * 64 + r32] = c0[r]; PART[(wid * 32 + t) * 64 + 32 + r32] = c1[r]; } }
        RT_BAR();
        { const int t = tid >> 4, c4 = (tid & 15) * 4;
          if (c4 < 40) { f32x4 s = {0.f, 0.f, 0.f, 0.f};
#pragma unroll
              for (int w = 0; w < 8; ++w) s += *(const LAS f32x4*)(PART + (w * 32 + t) * 64 + c4);
              *(LAS f32x4*)(LOGIT + t * 40 + c4) = s * RS[t] + *(const LAS f32x4*)(BIAS + c4); } }
        RT_BAR();
        if (tid < 32) { const int m = tile * 32 + tid; float lg[36];
#pragma unroll
            for (int c = 0; c < 36; ++c) lg[c] = LOGIT[tid * 40 + c];
            int gi = 0; float gm = lg[0];
#pragma unroll
            for (int c = 1; c < 4; ++c) if (lg[c] > gm) { gm = lg[c]; gi = c; }
            float gsum = 0.f;
#pragma unroll
            for (int c = 0; c < 4; ++c) gsum += __expf(lg[c] - gm);
            const float pgrp = 1.f / gsum;
            float el[8];
#pragma unroll
            for (int e = 0; e < 8; ++e) { float t = 0.f;
#pragma unroll
                for (int g2 = 0; g2 < 4; ++g2) if (g2 == gi) t = lg[4 + g2 * 8 + e];
                el[e] = t; }
            int i0 = 0; float m0 = el[0];
#pragma unroll
            for (int e = 1; e < 8; ++e) if (el[e] > m0) { m0 = el[e]; i0 = e; }
            int i1 = 0; float m1 = -3.0e38f;
#pragma unroll
            for (int e = 0; e < 8; ++e) if (e != i0 && el[e] > m1) { m1 = el[e]; i1 = e; }
            const float e1 = __expf(m1 - m0), p0 = 1.f / (1.f + e1), p1 = e1 / (1.f + e1);
            const int ex0 = gi * 8 + i0, ex1 = gi * 8 + i1;
            const int rk0 = atomicAdd((int*)&HIST[ex0], 1), rk1 = atomicAdd((int*)&HIST[ex1], 1);
            int* tk = TOK + (size_t)m * 8; tk[0] = ex0; tk[1] = ex1; tk[2] = __float_as_int(pgrp * p0); tk[3] = __float_as_int(pgrp * p1);
            LAS int* tr = TREC + (ntl * 32 + tid) * 4; tr[0] = ex0; tr[1] = ex1; tr[2] = rk0; tr[3] = rk1;
            TRS[ntl * 32 + tid] = RS[tid]; TRG[2 * (ntl * 32 + tid)] = pgrp * p0; TRG[2 * (ntl * 32 + tid) + 1] = pgrp * p1;
        }
        RT_BAR();
    }
#undef RT_BAR
#undef RT_LOAD
    if (tid < 32) { const int cnt = HIST[tid]; int base = 0; if (cnt > 0) base = (int)__hip_atomic_fetch_add(F.ctl + CW_CNT + tid, (unsigned)cnt, RLX_AGENT); HIST[32 + tid] = base; }
    __syncthreads();
    unsigned* ETOK = (unsigned*)(a.ws + FW_ETOK); float* EG = (float*)(a.ws + FW_EG);
    for (int i = tid; i < ntl * 32; i += NTHR) { const int tile = F.c + (i >> 5) * F.G, m = tile * 32 + (i & 31); const LAS int* tr = TREC + i * 4;
        int* tk = TOK + (size_t)m * 8; const int s0 = HIST[32 + tr[0]] + tr[2], s1 = HIST[32 + tr[1]] + tr[3]; tk[4] = s0; tk[5] = s1;
        const unsigned word = (unsigned)m | (f2bf(TRS[i]) << 16);
        ETOK[(size_t)tr[0] * M + s0] = word; ETOK[(size_t)tr[1] * M + s1] = word; EG[(size_t)tr[0] * M + s0] = TRG[2 * i]; EG[(size_t)tr[1] * M + s1] = TRG[2 * i + 1]; }
    __syncthreads();
}
__device__ __forceinline__ int moe_tables(Frame& F) {
    LAS int* TST = (LAS int*)(F.lds + SCR2_OFF); LAS unsigned char* T2E = F.lds + SCR2_OFF + 256;
    if (F.tid < 64) {
        const int e = F.tid; int nt = 0;
        if (e < NE) { const int cnt = (int)__hip_atomic_load(F.ctl + CW_CNT + e, RLX_AGENT); nt = (cnt + 255) >> 8; TST[208 + e] = cnt; }
        int incl = nt;
#pragma unroll
        for (int o = 1; o < 32; o <<= 1) { const int v = __shfl_up(incl, o); if ((e & 31) >= o) incl += v; }
        const int start = incl - nt;
        if (e < NE) { TST[e] = start; for (int t = 0; t < nt; ++t) T2E[start + t] = (unsigned char)e; }
        if (e == NE - 1) TST[NE] = incl;
    }
    __syncthreads();
    return TST[NE];
}
#ifndef CTPT
#define CTPT 4
#endif
__device__ __forceinline__ void combine_phase(Frame& F, const Args& a) {
    const unsigned char* YE = (const unsigned char*)(a.ws + FW_YE); const bf16* X1B = (const bf16*)(a.ws + FW_X1B); const int* TOK = (const int*)(a.ws + FW_TOK); float* out = a.out;
    const LAS int* TST = (const LAS int*)(F.lds + SCR2_OFF);
    const int gw = F.c * NWAVES + F.wave, NGW = F.G * NWAVES, lane = F.lane;
    static_assert(CTPT * 8 <= 64, "one routing word per lane");
    int m0 = gw * CTPT;
    int w = 0; if (m0 < M) w = TOK[(size_t)m0 * 8 + (lane & (CTPT * 8 - 1))];
    for (; m0 < M; m0 += NGW * CTPT) {
        const int mn = m0 + NGW * CTPT;
        int wn = 0; if (mn < M) wn = TOK[(size_t)mn * 8 + (lane & (CTPT * 8 - 1))];
        const int tl = TST[w & 31];
        u32x2 xv[CTPT][4]; unsigned y0[CTPT][4], y1[CTPT][4];
#pragma unroll
        for (int t = 0; t < CTPT; ++t) {
            const size_t p0 = (size_t)__builtin_amdgcn_readlane(tl, 8 * t) * 256 + (size_t)__builtin_amdgcn_readlane(w, 8 * t + 4), p1 = (size_t)__builtin_amdgcn_readlane(tl, 8 * t + 1) * 256 + (size_t)__builtin_amdgcn_readlane(w, 8 * t + 5);
            const bf16* xr = X1B + (size_t)(m0 + t) * PX + 4 * lane; const unsigned* ya = (const unsigned*)(YE + p0 * DM) + lane; const unsigned* yb = (const unsigned*)(YE + p1 * DM) + lane;
#pragma unroll
            for (int q = 0; q < 4; ++q) { xv[t][q] = *(const u32x2*)(xr + 256 * q); y0[t][q] = ya[64 * q]; y1[t][q] = yb[64 * q]; } }
#pragma unroll
        for (int t = 0; t < CTPT; ++t) { float* o = out + (size_t)(m0 + t) * DM + 4 * lane;
#pragma unroll
            for (int q = 0; q < 4; ++q) { const unsigned wa = y0[t][q], wb = y1[t][q]; const unsigned xa = xv[t][q].x, xb = xv[t][q].y;
                const f32x2 a0 = __builtin_amdgcn_cvt_pk_f32_fp8((int)wa, false), a1 = __builtin_amdgcn_cvt_pk_f32_fp8((int)wa, true), b0 = __builtin_amdgcn_cvt_pk_f32_fp8((int)wb, false), b1 = __builtin_amdgcn_cvt_pk_f32_fp8((int)wb, true);
                f32x4 r; r.x = bf2f(xa & 0xffff) + (a0.x + b0.x) * (1.f / YE_SCALE); r.y = bf2f(xa >> 16) + (a0.y + b0.y) * (1.f / YE_SCALE);
                r.z = bf2f(xb & 0xffff) + (a1.x + b1.x) * (1.f / YE_SCALE); r.w = bf2f(xb >> 16) + (a1.y + b1.y) * (1.f / YE_SCALE);
                *(f32x4*)(o + 256 * q) = r; } }
        w = wn;
    }
}

#ifndef STG1
#define STG1 0
#endif
#ifndef STG10
#define STG10 0
#endif
#ifndef STG11
#define STG11 0
#endif
#ifndef KREP1
#define KREP1 1
#endif
#ifndef KREP10
#define KREP10 1
#endif
#ifndef KREP11
#define KREP11 1
#endif
constexpr int NPHASE = 13;
__global__ void __launch_bounds__(NTHR, 2) mk_fwd(Args args) {
    extern __shared__ __attribute__((aligned(16))) unsigned char lds_raw[];
    Frame F;
    F.lds = (LAS unsigned char*)lds_raw; F.MISC = (volatile LAS unsigned*)(F.lds + MISC_OFF);
    F.tid = threadIdx.x; F.lane = F.tid & 63; F.wave = __builtin_amdgcn_readfirstlane(F.tid >> 6);
    F.G = gridDim.x; F.c = blockIdx.x; F.ctl = (unsigned*)(args.ws + WS_CTL);
    if (F.tid < 64) F.MISC[F.tid] = 0u;
    __syncthreads();
    XcdBarrier bar = xcd_barrier_post(F.ctl + CW_BAR, F.MISC + 8);
    const int lo = args.ph_lo, hi = args.ph_hi;
    unsigned char* ws = args.ws;
#ifndef PH_MASK
#define PH_MASK 0x1fff
#endif
#define IN(k) ((((PH_MASK) >> (k)) & 1) && lo <= (k) && (k) < hi)
#define SEAM(k) do { if (IN(k) && IN((k) + 1)) xcd_barrier(bar); } while (0)
#define REFRESH() do { int t_ = threadIdx.x; asm volatile("" : "+v"(t_)); F.tid = t_; F.lane = t_ & 63; F.wave = __builtin_amdgcn_readfirstlane(t_ >> 6); } while (0)
#ifndef REP_MASK
#define REP_MASK 0
#endif
#define REPS(k) _Pragma("unroll") for (int rep_ = 0; rep_ < ((((REP_MASK) >> (k)) & 1) ? 2 : 1); ++rep_)
    if (IN(0)) REPS(0) { REFRESH(); p0_prologue(F, args); } SEAM(0);
    if (IN(1)) REPS(1) { REFRESH();
        GemmP g{PX * 2, PW * 2, DM}; DenseOrder S{(const char*)(ws + FW_XN), (const char*)(ws + FW_WIN), (size_t)256 * PX * 2, (size_t)256 * PW * 2, M / 256, DIN / 256, (M / 256) * (DIN / 256), F.G, F.c};
        LAS float* GQK = (LAS float*)(F.lds + SCR2_OFF); if (F.tid < 128) GQK[F.tid] = (F.tid < 64) ? karg<13>()[F.tid] * C2 : karg<14>()[F.tid - 64];
        { LAS float* GF = (LAS float*)(F.lds + GF_OFF); GF[F.tid] = W8SC * karg<18>()[F.tid]; GF[F.tid + 512] = W8SC * karg<18>()[F.tid + 512]; } __syncthreads();
        EpiProj E{(bf16*)(ws + FW_U2), (bf16*)(ws + FW_Q), (const LAS float*)GQK, (F.G == 256) ? F.c * NWAVES : -1, ws};
        gemm_phase<EpiProj, DenseOrder, false, KREP1>(F.lds, g, S, E, nullptr, ((F.c >> 3) & 7) * STG1); } SEAM(1);
    if (IN(2)) REPS(2) { REFRESH();
        GemmP g{U2P * 2, 512 * 2, 512}; GroupOrder S{(const char*)(ws + FW_U2), (const char*)(ws + FW_W1), (size_t)NCH * U2P * 2, (size_t)256 * 512 * 2, (size_t)256 * U2P * 2, 0, NCH / 256, 1, NG * (NCH / 256), F.G, F.c};
        EpiState E{(float*)(ws + FW_SST)};
        gemm_phase(F.lds, g, S, E);
        if (F.G == NG * (NCH / 256)) s5_scan_local(F, args, F.c >> 3, F.c & 7); }
    if (F.G != NG * (NCH / 256)) SEAM(2);
    if (IN(3)) REPS(3) { REFRESH();
#ifndef NO_SCAN
        if (F.G != NG * (NCH / 256)) s5_scan(F, args);
#ifdef REP_SCAN
        s5_scan(F, args);
#endif
#endif
#ifndef NO_ATTN
        const bf16* Q = (const bf16*)(ws + FW_Q); const bf16* Kg = (const bf16*)(ws + FW_K); const bf16* Vg = (const bf16*)(ws + FW_V);
        attn_span_phase(F, Q, Kg, Vg, (bf16*)(ws + FW_MIX), (float*)(F.ctl + CW_SSQA));
#endif
    } SEAM(3);
    if (IN(4)) REPS(4) { REFRESH();
        GemmP g{U2P * 2, U2P * 2, U2P}; GroupOrder S{(const char*)(ws + FW_U2), (const char*)(ws + FW_TB), (size_t)NCH * U2P * 2, (size_t)512 * U2P * 2, (size_t)256 * U2P * 2, (size_t)256 * U2P * 2, NCH / 256, 2, NG * (NCH / 256) * 2, F.G, F.c};
        EpiS5 E{(bf16*)(ws + FW_Z)};
        gemm_phase(F.lds, g, S, E); } SEAM(4);
    if (IN(5)) REPS(5) { REFRESH();
        GemmP g{DSSM * 2, DSSM * 2, DSSM}; DenseOrder S{(const char*)(ws + FW_Z), (const char*)(ws + FW_WGLU), (size_t)256 * DSSM * 2, (size_t)256 * DSSM * 2, M / 256, 2, (M / 256) * 2, F.G, F.c};
        EpiGlu E{(const bf16*)(ws + FW_Z), karg<12>(), (bf16*)(ws + FW_MIX), (float*)(F.ctl + CW_SSQS)};
        gemm_phase(F.lds, g, S, E); } if (IN(5) && IN(7)) xcd_barrier(bar);
    if (IN(7)) REPS(7) { REFRESH();
        GemmP g{PX * 2, PW * 2, DM}; DenseOrder S{(const char*)(ws + FW_MIX), (const char*)(ws + FW_WOUT), (size_t)256 * PX * 2, (size_t)256 * PW * 2, M / 256, 4, (M / 256) * 4, F.G, F.c};
        EpiX1B E{(F.G == 256) ? F.c * NWAVES + 2048 * 8 : -1, ws, (const float*)(ws + FW_RSTDX), (bf16*)(ws + FW_X1B), (const float*)(F.ctl + CW_SSQS), (const float*)(F.ctl + CW_SSQA), (LAS float*)(F.lds + SCR2_OFF + 1024)};
        { LAS float* GF = (LAS float*)(F.lds + GF_OFF); GF[F.tid] = W8SC * karg<18>()[F.tid]; GF[F.tid + 512] = W8SC * karg<18>()[F.tid + 512]; }
        { Unit uu; for (int i = 0; i < 4 && S.next(i, uu); ++i) E.fill(i, uu.pm, F.tid); __syncthreads(); }
        gemm_phase(F.lds, g, S, E); } SEAM(7);
    if (IN(8)) { REFRESH(); router_phase(F, args); } if (IN(8) && IN(10)) xcd_barrier(bar);
    int ntiles = 0;
    if (IN(10) || IN(11) || IN(12)) { REFRESH(); ntiles = moe_tables(F); }
    if (IN(10)) REPS(10) { REFRESH();
        LAS int* RC = (LAS int*)(F.lds + SCR2_OFF + 1024); const unsigned* ETOK = (const unsigned*)(ws + FW_ETOK); const LAS int* TSTc = (const LAS int*)(F.lds + SCR2_OFF); const LAS unsigned char* T2Ec = F.lds + SCR2_OFF + 256;
        { unsigned v[5];
#pragma unroll
          for (int k = 0; k < 5; ++k) { const int j = F.tid + 512 * k, i = j >> 8, r = j & 255; v[k] = 0u;
              if ((long)i * F.G + F.c < (long)ntiles * 4) { int pm, pn; moe_unit(i * F.G + F.c, ntiles, pm, pn);
                  const int e = T2Ec[pm], idx = (pm - TSTc[e]) * 256 + r;
                  if (idx < TSTc[208 + e]) v[k] = ETOK[(size_t)e * M + idx]; } }
#pragma unroll
          for (int k = 0; k < 5; ++k) { const int j = F.tid + 512 * k; if ((long)(j >> 8) * F.G + F.c < (long)ntiles * 4) RC[j] = (int)v[k]; } }
        __syncthreads();
        GemmP g{DM, DM, DM / 2}; MoeOrder S{(const char*)(ws + FW_X1Q), (const char*)(ws + FW_WGU), (size_t)0, (size_t)DM * DM, (size_t)256 * DM, F.lds + SCR2_OFF + 256, ntiles, F.G, F.c};
        EpiGU E{(unsigned char*)(ws + FW_HH), (const LAS unsigned*)RC};
        gemm_phase<EpiGU, MoeOrder, true, KREP10, true>(F.lds, g, S, E, RC, ((F.c >> 3) & 7) * STG10); } SEAM(10);
    if (IN(11)) REPS(11) { REFRESH();
        LAS float* RGC = (LAS float*)(F.lds + SCR2_OFF + 1024); const float* EG = (const float*)(ws + FW_EG); const LAS int* TSTc = (const LAS int*)(F.lds + SCR2_OFF); const LAS unsigned char* T2Ec = F.lds + SCR2_OFF + 256;
        { float v[5];
#pragma unroll
          for (int k = 0; k < 5; ++k) { const int j = F.tid + 512 * k, i = j >> 8, r = j & 255; v[k] = 0.f;
              if ((long)i * F.G + F.c < (long)ntiles * 4) { int pm, pn; moe_unit(i * F.G + F.c, ntiles, pm, pn);
                  const int e = T2Ec[pm], idx = (pm - TSTc[e]) * 256 + r;
                  if (idx < TSTc[208 + e]) v[k] = EG[(size_t)e * M + idx]; } }
#pragma unroll
          for (int k = 0; k < 5; ++k) { const int j = F.tid + 512 * k; if ((long)(j >> 8) * F.G + F.c < (long)ntiles * 4) RGC[j] = v[k]; } }
        __syncthreads();
        GemmP g{DE, DE, DE / 2}; MoeOrder S{(const char*)(ws + FW_HH), (const char*)(ws + FW_WD), (size_t)256 * DE, (size_t)DM * DE, (size_t)256 * DE, F.lds + SCR2_OFF + 256, ntiles, F.G, F.c};
        EpiDown E{(unsigned char*)(ws + FW_YE), (const LAS float*)RGC};
        gemm_phase<EpiDown, MoeOrder, false, KREP11, true>(F.lds, g, S, E, nullptr, ((F.c >> 3) & 7) * STG11); } SEAM(11);
    if (IN(12)) REPS(12) { REFRESH(); combine_phase(F, args); }
#undef IN
#undef SEAM
}
}

extern "C" void kernel_launch(void* const* d_in, const int* in_sizes, int n_in, void* d_out, int out_size, void* d_ws, size_t ws_size, hipStream_t stream) {
    static int grid = 0;
    if (grid == 0) {
        if (n_in != 26 || out_size != M * DM || ws_size < mk::FW_END2) { fprintf(stderr, "kernel_launch: unexpected shapes (n_in %d out %d ws %zu, need %zu)\n", n_in, out_size, ws_size, (size_t)mk::FW_END2); grid = -1; return; }
        int dev = 0, cus = 0, per_cu = 0;
        if (hipGetDevice(&dev) != hipSuccess || hipDeviceGetAttribute(&cus, hipDeviceAttributeMultiprocessorCount, dev) != hipSuccess) { grid = -1; return; }
        if (hipFuncSetAttribute((const void*)mk::mk_fwd, hipFuncAttributeMaxDynamicSharedMemorySize, mk::LDS_BYTES) != hipSuccess) { fprintf(stderr, "kernel_launch: hipFuncSetAttribute failed\n"); grid = -1; return; }
        if (hipOccupancyMaxActiveBlocksPerMultiprocessor(&per_cu, (const void*)mk::mk_fwd, mk::NTHR, mk::LDS_BYTES) != hipSuccess || per_cu < 1) { fprintf(stderr, "kernel_launch: occupancy query says %d\n", per_cu); }
        (void)hipGetLastError();
        grid = cus;
        if (grid != 256) fprintf(stderr, "kernel_launch: %d CUs (built for 256)\n", grid);
    }
    if (grid < 0) return;
    mk::Args a{};
    for (int i = 0; i < 26; ++i) a.in[i] = (const float*)d_in[i];
    a.out = (float*)d_out; a.ws = (unsigned char*)d_ws; a.ph_lo = 0; a.ph_hi = mk::NPHASE;
    (void)hipMemsetAsync((unsigned char*)d_ws + WS_CTL, 0, mk::CTL_ZERO_BYTES, stream);
    hipLaunchKernelGGL(mk::mk_fwd, dim3(grid), dim3(mk::NTHR), mk::LDS_BYTES, stream, a);
}
```

```cpp
#define ASPAN_N 10
#define PADX 0
#define SIDE7 0

#include <hip/hip_runtime.h>
#include <cstdio>
#include <cstdint>

typedef unsigned short bf16;
typedef float f32x4 __attribute__((ext_vector_type(4)));
typedef unsigned u32x4 __attribute__((ext_vector_type(4)));
typedef unsigned u32x2 __attribute__((ext_vector_type(2)));

constexpr int DM = 1024, BATCH = 32, SEQ = 2048, M = BATCH * SEQ;
constexpr int DSSM = 512, NG = 32, GS = 16, PST = 64, HD = 64, DATT = 512, NH = 8, DIN = 2048;
constexpr int NEG = 4, EPG = 8, NE = 32, DE = 512;
constexpr float EPS = 1e-6f;
constexpr int LCH = 32;
constexpr int NCH = M / LCH;
constexpr int U2P = 640;
constexpr float C2 = 0.125f * 1.4426950408889634f;

constexpr size_t MiB = 1u << 20;
constexpr size_t WS_CTL = 0;
constexpr size_t WS_TOK = 2 * MiB;
constexpr size_t WS_XN = 8 * MiB;
constexpr size_t WS_Q = WS_XN + 128 * MiB;
constexpr size_t WS_K = WS_Q + 64 * MiB;
constexpr size_t WS_V = WS_K + 64 * MiB;
constexpr size_t WS_U2 = WS_V + 64 * MiB;
constexpr size_t WS_Z = WS_U2 + 80 * MiB;
constexpr size_t WS_YS = WS_Z + 64 * MiB;
constexpr size_t WS_YA = WS_YS + 64 * MiB;
constexpr size_t WS_MIX = WS_YA + 64 * MiB;
constexpr size_t WS_H2 = WS_XN;
constexpr size_t WS_PROJ = WS_Z;
constexpr size_t WS_END = WS_PROJ + 512 * MiB;

__device__ __forceinline__ unsigned f2bf(float f) { unsigned u = __builtin_bit_cast(unsigned, f); return (u + 0x7fffu + ((u >> 16) & 1u)) >> 16; }
__device__ __forceinline__ float bf2f(unsigned short h) { return __builtin_bit_cast(float, (unsigned)h << 16); }
__device__ __forceinline__ unsigned pk2(float lo, float hi) { return f2bf(lo) | (f2bf(hi) << 16); }
template <int CTRL> __device__ __forceinline__ float dppf(float x) { return __builtin_bit_cast(float, __builtin_amdgcn_update_dpp(0, __builtin_bit_cast(int, x), CTRL, 0xF, 0xF, true)); }
template <int CTRL> __device__ __forceinline__ unsigned dppu(unsigned x) { return (unsigned)__builtin_amdgcn_update_dpp(0, (int)x, CTRL, 0xF, 0xF, true); }
__device__ __forceinline__ float xor16_sum(float v) { const unsigned u = __builtin_bit_cast(unsigned, v); auto r = __builtin_amdgcn_permlane16_swap(u, u, false, false); return __builtin_bit_cast(float, (unsigned)r[0]) + __builtin_bit_cast(float, (unsigned)r[1]); }
__device__ __forceinline__ float xor32_sum(float v) { const unsigned u = __builtin_bit_cast(unsigned, v); auto r = __builtin_amdgcn_permlane32_swap(u, u, false, false); return __builtin_bit_cast(float, (unsigned)r[0]) + __builtin_bit_cast(float, (unsigned)r[1]); }
__device__ __forceinline__ unsigned xor16_get(unsigned u, bool odd_row) { auto r = __builtin_amdgcn_permlane16_swap(u, u, false, false); return odd_row ? (unsigned)r[0] : (unsigned)r[1]; }
__device__ __forceinline__ float wave_sum(float v) {
    v += dppf<0xB1>(v); v += dppf<0x4E>(v); v += dppf<0x141>(v); v += dppf<0x140>(v);
    return xor32_sum(xor16_sum(v));
}
__device__ __forceinline__ void sincos_d(double th, double& s, double& c) {
    const double q = rint(th * 0.63661977236758134308);
    const double r = (th - q * 1.57079632679489655800) - q * 6.12323399573676603587e-17;
    const double r2 = r * r;
    double sp = -1.0 / 1307674368000.0; sp = sp * r2 + 1.0 / 6227020800.0; sp = sp * r2 - 1.0 / 39916800.0; sp = sp * r2 + 1.0 / 362880.0; sp = sp * r2 - 1.0 / 5040.0; sp = sp * r2 + 1.0 / 120.0; sp = sp * r2 - 1.0 / 6.0; sp = sp * r2 + 1.0;
    const double sn = sp * r;
    double cp = 1.0 / 20922789888000.0; cp = cp * r2 - 1.0 / 87178291200.0; cp = cp * r2 + 1.0 / 479001600.0; cp = cp * r2 - 1.0 / 3628800.0; cp = cp * r2 + 1.0 / 40320.0; cp = cp * r2 - 1.0 / 720.0; cp = cp * r2 + 1.0 / 24.0; cp = cp * r2 - 0.5; cp = cp * r2 + 1.0;
    const int qi = ((int)q) & 3;
    s = (qi == 0) ? sn : (qi == 1) ? cp : (qi == 2) ? -sn : -cp;
    c = (qi == 0) ? cp : (qi == 1) ? -sn : (qi == 2) ? -cp : sn;
}
__device__ __forceinline__ float gelu_tanh(float x) {
    constexpr float K1 = -2.885390081777927f * 0.7978845608028654f, K3 = K1 * 0.044715f;
    const float e = __builtin_amdgcn_exp2f(x * (K1 + K3 * (x * x)));
    return x * __builtin_amdgcn_rcpf(1.f + e);
}
__device__ __forceinline__ float sigmoidf_(float x) { return __builtin_amdgcn_rcpf(1.f + __builtin_amdgcn_exp2f(-1.4426950408889634f * x)); }


#include <type_traits>
namespace mk {
#define LAS __attribute__((address_space(3)))
#define GAS __attribute__((address_space(1)))
typedef short bf16x8 __attribute__((ext_vector_type(8)));
typedef short s16x4 __attribute__((ext_vector_type(4)));
typedef float f32x16 __attribute__((ext_vector_type(16)));
typedef float f32x2 __attribute__((ext_vector_type(2)));
typedef __bf16 bf16x2_t __attribute__((ext_vector_type(2)));
typedef GAS unsigned gu32;

constexpr int NWAVES = 8, NTHR = 512;
constexpr int RING_BYTES = 131072, SCR2_OFF = RING_BYTES, SCR2_BYTES = 16128, MISC_OFF = SCR2_OFF + SCR2_BYTES, GF_OFF = MISC_OFF + 256, LDS_BYTES = GF_OFF + 4096;
static_assert(GF_OFF == 147456 && LDS_BYTES <= 163840, "LDS map");

#ifndef PADX
#define PADX 64
#endif
constexpr int PX = DM + PADX;
constexpr int PW = DM + PADX;
constexpr size_t FW_TOK = 2 * MiB, FW_WIN = 4 * MiB, FW_WOUT = 9 * MiB, FW_WGLU = 12 * MiB - 512 * 1024, FW_WR = 12 * MiB, FW_TB = 13 * MiB, FW_W1 = 33 * MiB,
                 FW_WGU = 41 * MiB, FW_WD = 110 * MiB, FW_SST = 142 * MiB, FW_XN = 174 * MiB, FW_Q = 310 * MiB, FW_K = 374 * MiB, FW_V = 438 * MiB, FW_U2 = 502 * MiB,
                 FW_Z = 582 * MiB, FW_MIX = 646 * MiB, FW_ROW = 782 * MiB, FW_END2 = 784 * MiB,
                 FW_X1B = FW_XN, FW_HH = 582 * MiB, FW_YE = FW_Q;
static_assert(FW_WIN + (size_t)DIN * PW * 2 <= FW_WOUT && FW_WOUT + (size_t)DM * PW * 2 <= FW_WGLU && FW_WGU + (size_t)NE * DM * PW * 2 <= FW_WD && FW_XN + (size_t)M * PX * 2 <= FW_Q && FW_MIX + (size_t)M * PX * 2 <= FW_ROW, "padded buffers");
static_assert(FW_K - FW_Q == (size_t)M * 512 * 2 && FW_V - FW_K == (size_t)M * 512 * 2, "Q|K|V contiguous");
constexpr size_t FW_RSTDX = FW_ROW + 3 * (size_t)(544 * 256) * 4;
constexpr size_t FW_ETOK = FW_SST, FW_EG = FW_SST + (size_t)NE * M * 4;
static_assert(FW_EG + (size_t)NE * M * 4 <= FW_XN, "expert lists");
constexpr float W8SC = 64.f;
constexpr size_t FW_X1Q = FW_U2;
static_assert(FW_X1Q + (size_t)M * DM <= FW_HH && FW_YE + (size_t)(544 * 256) * DM <= FW_X1Q && FW_HH + (size_t)(544 * 256) * DE <= FW_ROW, "X1Q / HH / YE must not overlap");
constexpr size_t FW_A32 = FW_WR + 256 * 1024;
constexpr int MAXTILES = 544, MAXROWS = MAXTILES * 256;
static_assert(FW_RSTDX + (size_t)M * 4 <= FW_END2, "row arrays");
static_assert(FW_YE + (size_t)MAXROWS * DM <= FW_U2 && FW_HH + (size_t)MAXROWS * DE * 2 <= FW_ROW, "MoE overlay");
constexpr int CW_TMO = 0, CW_CNT = 64, CW_BAR = 4096, CW_SSQS = 65536, CW_SSQA = 131072;
static_assert((CW_SSQA + M) * 4 <= (int)(1 * MiB), "ssq arrays inside the memset region");
constexpr size_t CTL_ZERO_BYTES = 1 * MiB;

#define RLX_AGENT __ATOMIC_RELAXED, __HIP_MEMORY_SCOPE_AGENT
__device__ __forceinline__ unsigned cvtpk(float lo, float hi) { f32x2 v = {lo, hi}; bf16x2_t b = __builtin_convertvector(v, bf16x2_t); return __builtin_bit_cast(unsigned, b); }

#define XB_TMO      128
#define XB_XCNT(j)  (256  + 64 * (j))
#define XB_XSUB(j)  (1280 + 64 * (j))
#define XB_XGEN(j)  (2304 + 64 * (j))
#define XB_TOP      3328
#define XB_TOPGEN   3392
#define XCD_BAR_WORDS 3456
#define XB_SPIN_CAP (1u << 18)
__device__ __forceinline__ unsigned xb_ld(unsigned* p)              { return __hip_atomic_load(p, __ATOMIC_RELAXED, __HIP_MEMORY_SCOPE_AGENT); }
__device__ __forceinline__ unsigned xb_add(unsigned* p, unsigned v) { return __hip_atomic_fetch_add(p, v, __ATOMIC_RELAXED, __HIP_MEMORY_SCOPE_AGENT); }
__device__ __forceinline__ unsigned xb_xcc_id() { return (unsigned)__builtin_amdgcn_s_getreg((3 << 11) | 20) & 0xFu; }
#define XB_SPIN(cond, bar) do { unsigned _sp = 0; while (cond) { __builtin_amdgcn_s_sleep(1); \
    if ((++_sp & 255u) == 0u) { if (xb_ld(&(bar)[XB_TMO])) break; if (_sp > XB_SPIN_CAP) { atomicAdd(&(bar)[XB_TMO], 1u); break; } } } } while (0)
struct XcdBarrier { unsigned* bar; unsigned x; volatile LAS unsigned* st; };
__device__ __forceinline__ XcdBarrier xcd_barrier_post(unsigned* bar, volatile LAS unsigned* st) {
    XcdBarrier b; b.bar = bar; b.x = xb_xcc_id(); b.st = st;
    if (threadIdx.x == 0) (void)xb_add(&bar[XB_XCNT(b.x)], 1u);
    return b;
}
__device__ __forceinline__ void xcd_barrier_complete(unsigned* bar, unsigned x, unsigned& nloc, unsigned& nx) {
    const unsigned G = gridDim.x * gridDim.y * gridDim.z;
    unsigned sum, cnt, mine, sp = 0u;
    for (;;) {
        sum = 0u; cnt = 0u; mine = 0u;
#pragma unroll
        for (unsigned j = 0; j < 16; ++j) { const unsigned c = xb_ld(&bar[XB_XCNT(j)]); sum += c; cnt += (c > 0u) ? 1u : 0u; mine = (j == x) ? c : mine; }
        if (sum == G) break;
        __builtin_amdgcn_s_sleep(1);
        if ((++sp & 255u) == 0u) { if (xb_ld(&bar[XB_TMO])) break; if (sp > XB_SPIN_CAP) { atomicAdd(&bar[XB_TMO], 1u); break; } }
    }
    nloc = mine > 0u ? mine : 1u; nx = cnt > 0u ? cnt : 1u;
}
__device__ __forceinline__ void xcd_barrier(const XcdBarrier& b) {
    asm volatile("s_waitcnt vmcnt(0)" ::: "memory");
    __syncthreads();
    if (threadIdx.x == 0) {
        unsigned* bar = b.bar;
        __builtin_amdgcn_s_waitcnt(0);
        unsigned nloc = b.st[0], nx = b.st[1];
        if (nloc == 0u) { xcd_barrier_complete(bar, b.x, nloc, nx); b.st[0] = nloc; b.st[1] = nx; }
        const unsigned old = xb_add(&bar[XB_XSUB(b.x)], 1u);
        const unsigned gen = old / nloc;
        if (old + 1u == (gen + 1u) * nloc) {
            __builtin_amdgcn_fence(__ATOMIC_RELEASE, "agent");
            asm volatile("s_waitcnt vmcnt(0)" ::: "memory");
            const unsigned og = xb_add(&bar[XB_TOP], 1u);
            const unsigned tg = og / nx;
            if (og + 1u == (tg + 1u) * nx) xb_add(&bar[XB_TOPGEN], 1u);
            else XB_SPIN(xb_ld(&bar[XB_TOPGEN]) == tg, bar);
            __builtin_amdgcn_fence(__ATOMIC_ACQUIRE, "agent");
            xb_add(&bar[XB_XGEN(b.x)], 1u);
            asm volatile("s_waitcnt vmcnt(0)" ::: "memory");
        } else {
            XB_SPIN(xb_ld(&bar[XB_XGEN(b.x)]) == gen, bar);
            __builtin_amdgcn_fence(__ATOMIC_ACQUIRE, "agent");
            asm volatile("s_waitcnt vmcnt(0)" ::: "memory");
        }
    }
    __syncthreads();
}

__device__ __forceinline__ unsigned pk4_fp8(float a, float b, float c, float d) { int w = 0; w = __builtin_amdgcn_cvt_pk_fp8_f32(a, b, w, false); w = __builtin_amdgcn_cvt_pk_fp8_f32(c, d, w, true); return (unsigned)w; }
template <int K> __device__ __forceinline__ const float* karg();
struct SideItem { const float* W; unsigned char* WT; int ldw, srccol0, ldt, dstrow0, k0, scaled; };
__device__ __forceinline__ SideItem moe_side_item(int r) {
    unsigned char* ws;
    asm volatile("s_load_dwordx2 %0, %1, 216\n\ts_waitcnt lgkmcnt(0)" : "=s"(ws) : "s"(__builtin_amdgcn_kernarg_segment_ptr()) : "memory");
    if (r < 16384) { const int e = r >> 9, q = r & 511, kb = q >> 5, d = q & 31, pn = d >> 3, beta = d & 7;
        const float* W = (beta < 4 ? karg<23>() : karg<24>()) + (size_t)e * DM * DE;
        return SideItem{W, ws + FW_WGU + (size_t)e * DM * DM, DE, 128 * pn + 32 * (beta & 3), DM, 32 * d, 64 * kb, 1}; }
    r -= 16384; const int e = r >> 8, q = r & 255, kb = q >> 5, d = q & 31;
    return SideItem{karg<25>() + (size_t)e * DE * DM, ws + FW_WD + (size_t)e * DM * DE, DM, 32 * (8 * (d >> 3) + 2 * (d & 3) + ((d & 7) >> 2)), DE, 32 * d, 64 * kb, 0};
}
__device__ __forceinline__ void side_load(const SideItem& t, int lane, int hb, f32x4 (&v)[4]) {
    asm volatile("" : "+v"(lane));
    const int kh = lane >> 3, nq = lane & 7;
#pragma unroll
    for (int i = 0; i < 4; ++i) v[i] = *(const GAS f32x4*)(t.W + (size_t)(t.k0 + 8 * kh + 4 * hb + i) * t.ldw + t.srccol0 + 4 * nq);
}
__device__ __forceinline__ void side_store(const SideItem& t, int lane, int hb, const f32x4 (&v)[4], const LAS float* GF) {
    asm volatile("" : "+v"(lane));
    const int kh = lane >> 3, nq = lane & 7;
    f32x4 g0 = (f32x4){W8SC, W8SC, W8SC, W8SC};
    if (t.scaled) g0 = *(const LAS f32x4*)(GF + t.k0 + 8 * kh + 4 * hb);
#pragma unroll
    for (int e = 0; e < 4; ++e)
        *(unsigned*)(t.WT + (size_t)(t.dstrow0 + 4 * nq + e) * t.ldt + t.k0 + 8 * kh + 4 * hb) = pk4_fp8(v[0][e] * g0.x, v[1][e] * g0.y, v[2][e] * g0.z, v[3][e] * g0.w);
}
constexpr int BM = 256, BK = 64, HALF = 128, HTB = HALF * BK * 2;
__device__ __forceinline__ int lds_byte(int r, int c) { const int st = (r >> 4) * 2 + (c >> 5), rr = r & 15, cc = c & 31, ob = rr * 64 + cc * 2; return st * 1024 + (ob ^ (((ob >> 9) & 1) << 5)); }
__device__ __forceinline__ void stage_rc(int b, int& R, int& C) { const int st = b / 1024, sb = b % 1024, swz = sb ^ (((sb >> 9) & 1) << 5); R = (st >> 1) * 16 + swz / 64; C = (st & 1) * 32 + (swz % 64) / 2; }
__device__ __forceinline__ int perm32(int rho) { const int n = rho >> 4, i = rho & 15; return 8 * (i >> 2) + 4 * n + (i & 3); }
struct Unit { const char* a; const char* b; int pm, pn, aux; };
struct GemmP { int lda_b, ldb_b, K; };

template <class Epi, class Sched, bool GATHER = false, int KREP = 1, bool FP8 = false>
__device__ __forceinline__ void gemm_phase(LAS unsigned char* lds, const GemmP g, const Sched& S, const Epi& E, const LAS int* rowcache = nullptr, int stagger_ticks = 0) {
    const int tid = threadIdx.x, wid = __builtin_amdgcn_readfirstlane(tid >> 6), lane = tid & 63, wr = wid >> 2, wc = wid & 3, fr = lane & 15, fq = lane >> 4;
    const int ntk = g.K / BK, nt = ntk * (KREP == 3 ? 1 : KREP);
    unsigned voffA[2], voffB[2]; int gR[2], gC[2];
#pragma unroll
    for (int i = 0; i < 2; ++i) { int R, C; stage_rc(tid * 16 + i * 8192, R, C); const int Rb = Epi::PERM ? ((R & ~31) + perm32(R & 31)) : R; gR[i] = R; gC[i] = C * 2;
        voffA[i] = (unsigned)(R * g.lda_b + C * 2); voffB[i] = (unsigned)(Rb * g.ldb_b + C * 2); }
    unsigned vc0[2] = {voffA[0], voffA[1]}, vc1[2] = {voffA[0], voffA[1]}, vn0[2] = {voffA[0], voffA[1]}, vn1[2] = {voffA[0], voffA[1]};
#define PG8_GOFF(dst0, dst1, ui_) do { _Pragma("unroll") for (int _i = 0; _i < 2; ++_i) { \
        dst0[_i] = ((unsigned)rowcache[(ui_) * 256 + gR[_i]] & 0xffffu) * (unsigned)g.lda_b + (unsigned)gC[_i]; dst1[_i] = ((unsigned)rowcache[(ui_) * 256 + 128 + gR[_i]] & 0xffffu) * (unsigned)g.lda_b + (unsigned)gC[_i]; } } while (0)
    const size_t kstep = (size_t)(BK * 2);
    const size_t hstepA = GATHER ? 0 : (size_t)HALF * g.lda_b, hstepB = (size_t)HALF * g.ldb_b;
    const unsigned ldsw = (unsigned)wid * 1024u;
    const int aoff = lds_byte(wr * 64 + fr, fq * 8), boff = lds_byte(wc * 32 + fr, fq * 8);
#define PG8_SA(b, h) (((b) * 2 + (h)) * HTB)
#define PG8_SB(b, h) ((4 + (b) * 2 + (h)) * HTB)
#define PG8_STAGE(bufoff, gbase, voff) do { _Pragma("unroll") for (int _i = 0; _i < 2; ++_i) \
        __builtin_amdgcn_global_load_lds((const unsigned*)((const char*)(gbase) + (voff)[_i]), (LAS unsigned*)(lds + (bufoff) + ldsw + _i * 8192), 16, 0, 0); } while (0)
#define PG8_LDA(dst, b, h) do { _Pragma("unroll") for (int m = 0; m < 4; ++m) { const LAS unsigned char* p_ = lds + PG8_SA(b, h) + aoff + m * 2048; \
        if constexpr (FP8) { dst[m].v.lo = *(const LAS v4i_*)p_; dst[m].v.hi = *(const LAS v4i_*)(p_ + 1024); } else { dst[m].v[0] = *(const LAS bf16x8*)p_; dst[m].v[1] = *(const LAS bf16x8*)(p_ + 1024); } } } while (0)
#define PG8_LDB(dst, b, h) do { _Pragma("unroll") for (int n = 0; n < 2; ++n) { const LAS unsigned char* p_ = lds + PG8_SB(b, h) + boff + n * 2048; \
        if constexpr (FP8) { dst[n].v.lo = *(const LAS v4i_*)p_; dst[n].v.hi = *(const LAS v4i_*)(p_ + 1024); } else { dst[n].v[0] = *(const LAS bf16x8*)p_; dst[n].v[1] = *(const LAS bf16x8*)(p_ + 1024); } } } while (0)
#define PG8_MMA(ai, bj, At, Bt) do { if (Epi::HALFN && (bj) == 1) break; __builtin_amdgcn_s_setprio(1); \
        if constexpr (FP8) { asm volatile("s_nop 1\n\t" "v_mfma_scale_f32_16x16x128_f8f6f4 %0, %8, %10, %0, %14, %14 op_sel_hi:[0,0,0]\n\t" "v_mfma_scale_f32_16x16x128_f8f6f4 %1, %9, %10, %1, %14, %14 op_sel_hi:[0,0,0]\n\t" "v_mfma_scale_f32_16x16x128_f8f6f4 %2, %8, %11, %2, %14, %14 op_sel_hi:[0,0,0]\n\t" "v_mfma_scale_f32_16x16x128_f8f6f4 %3, %9, %11, %3, %14, %14 op_sel_hi:[0,0,0]\n\t" "v_mfma_scale_f32_16x16x128_f8f6f4 %4, %8, %12, %4, %14, %14 op_sel_hi:[0,0,0]\n\t" "v_mfma_scale_f32_16x16x128_f8f6f4 %5, %9, %12, %5, %14, %14 op_sel_hi:[0,0,0]\n\t" "v_mfma_scale_f32_16x16x128_f8f6f4 %6, %8, %13, %6, %14, %14 op_sel_hi:[0,0,0]\n\t" "v_mfma_scale_f32_16x16x128_f8f6f4 %7, %9, %13, %7, %14, %14 op_sel_hi:[0,0,0]\n\t" "s_nop 1" \
            : "+v"(acc[ai][bj][0][0]), "+v"(acc[ai][bj][0][1]), "+v"(acc[ai][bj][1][0]), "+v"(acc[ai][bj][1][1]), "+v"(acc[ai][bj][2][0]), "+v"(acc[ai][bj][2][1]), "+v"(acc[ai][bj][3][0]), "+v"(acc[ai][bj][3][1]) \
            : "v"(Bt[0].v), "v"(Bt[1].v), "v"(At[0].v), "v"(At[1].v), "v"(At[2].v), "v"(At[3].v), "v"(mxs)); } \
        else { _Pragma("unroll") for (int m = 0; m < 4; ++m) _Pragma("unroll") for (int n = 0; n < 2; ++n) _Pragma("unroll") for (int k = 0; k < 2; ++k) \
            acc[ai][bj][m][n] = __builtin_amdgcn_mfma_f32_16x16x32_bf16(Bt[n].v[k], At[m].v[k], acc[ai][bj][m][n], 0, 0, 0); } \
        __builtin_amdgcn_s_setprio(0); } while (0)
#define PG8_WAIT_V(n) asm volatile("s_waitcnt vmcnt(" #n ")" ::: "memory")
#define PG8_WAIT_L(n) asm volatile("s_waitcnt lgkmcnt(" #n ")" ::: "memory")
#define PG8_BAR __builtin_amdgcn_s_barrier()
#define PG8_SCHED __builtin_amdgcn_sched_barrier(0)
    int mxs = 0x7F7F7F7F; asm volatile("" : "+v"(mxs));
    Unit cur, nxt; int ui = 0;
    if (!S.next(0, cur)) return;
    if (stagger_ticks > 0) { const unsigned long long t0 = __builtin_amdgcn_s_memrealtime(); while ((long long)(__builtin_amdgcn_s_memrealtime() - t0) < (long long)stagger_ticks) __builtin_amdgcn_s_sleep(8); }
    f32x4 acc[2][2][4][2];
#pragma unroll
    for (int a = 0; a < 2; ++a)
#pragma unroll
        for (int b = 0; b < 2; ++b)
#pragma unroll
            for (int m = 0; m < 4; ++m)
#pragma unroll
                for (int n = 0; n < 2; ++n) acc[a][b][m][n] = (f32x4){0.f, 0.f, 0.f, 0.f};
    typedef int v4i_ __attribute__((ext_vector_type(4))); typedef int v8i_ __attribute__((ext_vector_type(8)));
    struct FragB { bf16x8 v[2]; }; struct Frag8 { v8i_ v; };
    typename std::conditional<FP8, Frag8, FragB>::type At[4], B0[2], B1[2];
    const char* cA = cur.a; const char* cB = cur.b;
    if (GATHER) { PG8_GOFF(vc0, vc1, 0); }
    PG8_STAGE(PG8_SB(0, 0), cB, voffB); PG8_STAGE(PG8_SB(0, 1), cB + hstepB, voffB); PG8_STAGE(PG8_SA(0, 0), cA, vc0); PG8_STAGE(PG8_SA(0, 1), cA + hstepA, vc1);
    if (wr == 1) PG8_BAR;
    PG8_WAIT_V(2); PG8_BAR;
    PG8_STAGE(PG8_SB(1, 0), cB + kstep, voffB); PG8_STAGE(PG8_SA(1, 0), cA + kstep, vc0); PG8_STAGE(PG8_SB(1, 1), cB + hstepB + kstep, voffB);
    PG8_WAIT_V(6); PG8_BAR;
    for (;;) {
        const bool has_next = S.next(ui + 1, nxt);
        const char* nA = has_next ? nxt.a : cA; const char* nB = has_next ? nxt.b : cB;
        if constexpr (Epi::HOOKS) E.begin(cur, ui, tid);
        if (GATHER) { if (has_next) { PG8_GOFF(vn0, vn1, ui + 1); } else { vn0[0] = vc0[0]; vn0[1] = vc0[1]; vn1[0] = vc1[0]; vn1[1] = vc1[1]; } }
        for (int t = 0; t < nt; t += 2) {
            const bool last = (t == nt - 2);
            if constexpr (Epi::HOOKS) { if (t == nt / 2) E.mid(acc, ui, wr, fr); }
#ifdef PROBE_EPI_TWICE
            if constexpr (KREP == 3) { if (t == ntk / 2) E.fin(acc, cur, ui, wr, wc, fr, fq); }
#endif
            const char* a1 = cA + (size_t)((t + 1) % ntk) * kstep;
            const char* a2 = last ? nA : cA + (size_t)((t + 2) % ntk) * kstep; const char* b2 = last ? nB : cB + (size_t)((t + 2) % ntk) * kstep;
            const char* a3 = a2 + kstep; const char* b3 = b2 + kstep;
            unsigned w0[2], w1[2];
            w0[0] = (GATHER && last) ? vn0[0] : vc0[0]; w0[1] = (GATHER && last) ? vn0[1] : vc0[1]; w1[0] = (GATHER && last) ? vn1[0] : vc1[0]; w1[1] = (GATHER && last) ? vn1[1] : vc1[1];
            PG8_LDB(B0, 0, 0); PG8_LDB(B1, 0, 1); PG8_SCHED; PG8_LDA(At, 0, 0); PG8_STAGE(PG8_SA(1, 1), a1 + hstepA, vc1);
            PG8_WAIT_V(8); PG8_WAIT_L(0); PG8_BAR; PG8_MMA(0, 0, At, B0); PG8_MMA(0, 1, At, B1); PG8_BAR; PG8_SCHED;
            PG8_LDA(At, 0, 1); PG8_STAGE(PG8_SB(0, 0), b2, voffB); PG8_STAGE(PG8_SB(0, 1), b2 + hstepB, voffB); PG8_STAGE(PG8_SA(0, 0), a2, w0);
            PG8_WAIT_V(8); PG8_WAIT_L(0); PG8_BAR; PG8_MMA(1, 0, At, B0); PG8_MMA(1, 1, At, B1); PG8_BAR; PG8_SCHED;
            PG8_LDB(B0, 1, 0); PG8_LDB(B1, 1, 1); PG8_SCHED; PG8_LDA(At, 1, 0); PG8_STAGE(PG8_SA(0, 1), a2 + hstepA, w1);
            PG8_WAIT_V(8); PG8_WAIT_L(0); PG8_BAR; PG8_MMA(0, 0, At, B0); PG8_MMA(0, 1, At, B1); PG8_BAR; PG8_SCHED;
            PG8_LDA(At, 1, 1); PG8_STAGE(PG8_SB(1, 0), b3, voffB); PG8_STAGE(PG8_SB(1, 1), b3 + hstepB, voffB); PG8_STAGE(PG8_SA(1, 0), a3, w0);
            PG8_WAIT_V(8); PG8_WAIT_L(0); PG8_BAR; PG8_MMA(1, 0, At, B0); PG8_MMA(1, 1, At, B1); PG8_BAR; PG8_SCHED;
        }
        if (wr == 0) PG8_BAR;
        if constexpr (FP8) asm volatile("s_nop 15\n\ts_nop 7" ::: "memory");
        if constexpr (KREP > 1) {
#pragma unroll
            for (int a = 0; a < 2; ++a)
#pragma unroll
                for (int b = 0; b < 2; ++b)
#pragma unroll
                    for (int m = 0; m < 4; ++m)
#pragma unroll
                        for (int n = 0; n < 2; ++n) acc[a][b][m][n] = acc[a][b][m][n] * (KREP == 3 ? 1.f : 1.f / KREP); }
        if constexpr (Epi::SIDE) {
            SideItem sit; f32x4 sv[4]; const bool side = (E.side_r0 >= 0);
            if (side) { sit = moe_side_item(E.side_r0 + wid + 2048 * ui); side_load(sit, lane, 0, sv); }
            asm volatile("" ::: "memory"); PG8_SCHED;
            if constexpr (Epi::HOOKS) E.template finh<0>(acc, cur, ui, wr, wc, fr, fq); else E.template half<0>(acc, cur, wr, wc, fr, fq);
            asm volatile("" ::: "memory"); PG8_SCHED;
            if (side) { side_store(sit, lane, 0, sv, (const LAS float*)(lds + GF_OFF)); side_load(sit, lane, 1, sv); }
            asm volatile("" ::: "memory"); PG8_SCHED;
            if constexpr (Epi::HOOKS) E.template finh<1>(acc, cur, ui, wr, wc, fr, fq); else E.template half<1>(acc, cur, wr, wc, fr, fq);
            asm volatile("" ::: "memory"); PG8_SCHED;
            if (side) side_store(sit, lane, 1, sv, (const LAS float*)(lds + GF_OFF));
        } else { if constexpr (Epi::HOOKS) E.fin(acc, cur, ui, wr, wc, fr, fq); else E(acc, cur, wr, wc, fr, fq); }
        if (!has_next) break;
#pragma unroll
        for (int a = 0; a < 2; ++a)
#pragma unroll
            for (int b = 0; b < 2; ++b)
#pragma unroll
                for (int m = 0; m < 4; ++m)
#pragma unroll
                    for (int n = 0; n < 2; ++n) acc[a][b][m][n] = (f32x4){0.f, 0.f, 0.f, 0.f};
        cur = nxt; cA = nA; cB = nB; ++ui;
        if (GATHER) { vc0[0] = vn0[0]; vc0[1] = vn0[1]; vc1[0] = vn1[0]; vc1[1] = vn1[1]; }
        if (wr == 1) PG8_BAR;
    }
    PG8_WAIT_V(0);
    PG8_BAR;
#undef PG8_GOFF
#undef PG8_SA
#undef PG8_SB
#undef PG8_STAGE
#undef PG8_LDA
#undef PG8_LDB
#undef PG8_MMA
#undef PG8_WAIT_V
#undef PG8_WAIT_L
#undef PG8_BAR
#undef PG8_SCHED
}

struct DenseOrder {
    const char* A; const char* B; size_t a_tile, b_tile; int nM, nN, nwg, G, c;
    __device__ __forceinline__ bool next(int i, Unit& u) const {
        const long L = (long)i * G + c; if (L >= nwg) return false;
        int wgid = (int)L; { const int q = nwg / 8, r = nwg % 8, xcd = wgid % 8, off = wgid / 8; wgid = (xcd < r ? xcd * (q + 1) : r * (q + 1) + (xcd - r) * q) + off; }
        const int nig = 8 * nN, gid = wgid / nig, fm = gid * 8, gsz = (nM - fm) < 8 ? (nM - fm) : 8;
        u.pm = fm + ((wgid % nig) % gsz); u.pn = (wgid % nig) / gsz; u.aux = 0;
        u.a = A + (size_t)u.pm * a_tile; u.b = B + (size_t)u.pn * b_tile; return true;
    }
};
struct GroupOrder {
    const char* A; const char* B; size_t a_grp, b_grp, a_tile, b_tile; int nM, nN, nwg, G, c;
    __device__ __forceinline__ bool next(int i, Unit& u) const {
        const long L = (long)i * G + c; if (L >= nwg) return false;
        const int per = nM * nN, g = (int)L / per, r = (int)L % per;
        u.pn = r / nM; u.pm = r % nM; u.aux = g;
        u.a = A + (size_t)g * a_grp + (size_t)u.pm * a_tile; u.b = B + (size_t)g * b_grp + (size_t)u.pn * b_tile; return true;
    }
};
__device__ __forceinline__ void moe_unit(int L, int ntiles, int& pm, int& pn) {
    const int j = L >> 5, full = ntiles >> 3;
    if (j < full) { const int r = L & 31; pm = 8 * j + (r & 7); pn = r >> 3; }
    else { const int gsz = ntiles - 8 * full, r = L - 32 * full; pm = 8 * full + r % gsz; pn = r / gsz; }
}
struct MoeOrder {
    const char* A; const char* B; size_t a_tile, b_exp, b_tile; const LAS unsigned char* t2e; int ntiles, G, c;
    __device__ __forceinline__ bool next(int i, Unit& u) const {
        const long L = (long)i * G + c; if (L >= (long)ntiles * 4) return false;
        moe_unit((int)L, ntiles, u.pm, u.pn); u.aux = t2e[u.pm];
        u.a = A + (size_t)u.pm * a_tile; u.b = B + (size_t)u.aux * b_exp + (size_t)u.pn * b_tile; return true;
    }
};

typedef f32x4 Acc[2][2][4][2];
constexpr float YE_SCALE = 8.f;

__device__ __forceinline__ void store_pair(bf16* row_even, size_t pitch, u32x4 p0, u32x4 p1, int fr, int fq) {
    const bool odd = fr & 1;
    const u32x4 send = odd ? p0 : p1; u32x4 recv;
    recv.x = dppu<0xB1>(send.x); recv.y = dppu<0xB1>(send.y); recv.z = dppu<0xB1>(send.z); recv.w = dppu<0xB1>(send.w);
    const u32x4 a = odd ? recv : p0, b = odd ? p1 : recv;
    bf16* d = row_even + (odd ? 32 : 0) + 8 * fq;
#ifdef NT_STORES
    __builtin_nontemporal_store(a, (u32x4*)d); __builtin_nontemporal_store(b, (u32x4*)(d + pitch));
#else
    *(u32x4*)d = a; *(u32x4*)(d + pitch) = b;
#endif
}
struct EpiProj {
    static constexpr bool HALFN = false, HOOKS = false, PERM = true, SIDE = true;
    bf16* U2; bf16* QKV; const LAS float* GQK; int side_r0; unsigned char* side_ws;
    __device__ __forceinline__ void operator()(const Acc& acc, const Unit& u, int wr, int wc, int fr, int fq) const { half<0>(acc, u, wr, wc, fr, fq); half<1>(acc, u, wr, wc, fr, fq); }
    template <int AI> __device__ __forceinline__ void half(const Acc& acc, const Unit& u, int wr, int wc, int fr, int fq) const {
        asm volatile("" : "+v"(fr), "+v"(fq));
        const int typ = u.pn >> 1;
        if (typ == 1 || typ == 2) run<true, AI>(acc, u, wr, wc, fr, fq); else run<false, AI>(acc, u, wr, wc, fr, fq);
    }
    template <bool nrm, int AI> __device__ __forceinline__ void run(const Acc& acc, const Unit& u, int wr, int wc, int fr, int fq) const {
        const int typ = u.pn >> 1, sub = u.pn & 1;
        const LAS float* gg = GQK + ((typ == 1) ? 0 : 64);
        f32x4 gn[2][2];
#pragma unroll
        for (int bj = 0; bj < 2; ++bj)
#pragma unroll
            for (int n = 0; n < 2; ++n) gn[bj][n] = nrm ? *(const LAS f32x4*)(gg + 32 * bj + 8 * fq + 4 * n) : (f32x4){1.f, 1.f, 1.f, 1.f};
        { constexpr int ai = AI;
#pragma unroll
            for (int m = 0; m < 4; ++m) {
                const int r = u.pm * BM + ai * HALF + wr * 64 + m * 16 + fr;
                f32x4 v[2][2];
#pragma unroll
                for (int bj = 0; bj < 2; ++bj)
#pragma unroll
                    for (int n = 0; n < 2; ++n) v[bj][n] = acc[ai][bj][m][n];
                if constexpr (nrm) {
                    float s = 0.f;
#pragma unroll
                    for (int bj = 0; bj < 2; ++bj)
#pragma unroll
                        for (int n = 0; n < 2; ++n) s += (v[bj][n].x * v[bj][n].x + v[bj][n].y * v[bj][n].y) + (v[bj][n].z * v[bj][n].z + v[bj][n].w * v[bj][n].w);
                    s = xor32_sum(xor16_sum(s));
                    const float rstd = nrm ? __builtin_amdgcn_rsqf(s * (1.f / 64.f) + EPS) : 1.f;
#pragma unroll
                    for (int bj = 0; bj < 2; ++bj)
#pragma unroll
                        for (int n = 0; n < 2; ++n) v[bj][n] = v[bj][n] * (gn[bj][n] * rstd);
                }
                u32x4 p[2];
#pragma unroll
                for (int bj = 0; bj < 2; ++bj) { p[bj].x = cvtpk(v[bj][0].x, v[bj][0].y); p[bj].y = cvtpk(v[bj][0].z, v[bj][0].w); p[bj].z = cvtpk(v[bj][1].x, v[bj][1].y); p[bj].w = cvtpk(v[bj][1].z, v[bj][1].w); }
                if (!nrm && typ == 0) {
#pragma unroll
                    for (int bj = 0; bj < 2; ++bj) { const int f = sub * 256 + 64 * wc + 32 * bj + 8 * fq, g = f >> 4, h = f & 15;
                        *(u32x4*)(U2 + ((size_t)g * NCH + (r >> 5)) * U2P + (r & 31) * 16 + h) = p[bj]; }
                } else store_pair(QKV + (size_t)(typ - 1) * ((size_t)M * 512) + (size_t)(r & ~1) * 512 + sub * 256 + 64 * wc, 512, p[0], p[1], fr, fq);
            } }
    }
};
struct EpiState {
    static constexpr bool HALFN = true, HOOKS = false, PERM = false, SIDE = false;
    float* SST;
    __device__ __forceinline__ void operator()(const Acc& acc, const Unit& u, int wr, int wc, int fr, int fq) const {
#pragma unroll
        for (int ai = 0; ai < 2; ++ai)
#pragma unroll
            for (int m = 0; m < 4; ++m) { const int r = u.pm * BM + ai * HALF + wr * 64 + m * 16 + fr;
#pragma unroll
                for (int n = 0; n < 2; ++n) *(f32x4*)(SST + ((size_t)u.aux * NCH + r) * 128 + 32 * wc + 16 * n + 4 * fq) = acc[ai][0][m][n]; }
    }
};
struct EpiS5 {
    static constexpr bool HALFN = false, HOOKS = false, PERM = true, SIDE = false;
    bf16* Z;
    __device__ __forceinline__ void operator()(const Acc& acc, const Unit& u, int wr, int wc, int fr, int fq) const {
#pragma unroll
        for (int ai = 0; ai < 2; ++ai)
#pragma unroll
            for (int m = 0; m < 4; ++m) { const int r = u.pm * BM + ai * HALF + wr * 64 + m * 16 + fr;
#pragma unroll
                for (int bj = 0; bj < 2; ++bj) { const int c0 = u.pn * BM + bj * HALF + 32 * wc + 8 * fq, i = c0 >> 4, h = c0 & 15;
                    const f32x4 a = acc[ai][bj][m][0], b = acc[ai][bj][m][1];
                    u32x4 w; w.x = cvtpk(gelu_tanh(a.x), gelu_tanh(a.y)); w.y = cvtpk(gelu_tanh(a.z), gelu_tanh(a.w)); w.z = cvtpk(gelu_tanh(b.x), gelu_tanh(b.y)); w.w = cvtpk(gelu_tanh(b.z), gelu_tanh(b.w));
                    *(u32x4*)(Z + ((size_t)r * 32 + i) * DSSM + u.aux * 16 + h) = w; } }
    }
};
struct EpiGlu {
    static constexpr bool HALFN = false, HOOKS = false, PERM = true, SIDE = false;
    const bf16* Z; const float* bias; bf16* MIX; float* SSQ;
    __device__ __forceinline__ void operator()(const Acc& acc, const Unit& u, int wr, int wc, int fr, int fq) const {
        float ss[2][4];
#pragma unroll
        for (int ai = 0; ai < 2; ++ai)
#pragma unroll
            for (int m = 0; m < 4; ++m) ss[ai][m] = 0.f;
#pragma unroll
        for (int bj = 0; bj < 2; ++bj) { const int c0 = u.pn * BM + bj * HALF + 32 * wc + 8 * fq;
            constexpr float NL2E = -1.4426950408889634f;
            const f32x4 b0 = *(const GAS f32x4*)(bias + c0) * NL2E, b1 = *(const GAS f32x4*)(bias + c0 + 4) * NL2E;
#pragma unroll
            for (int ai = 0; ai < 2; ++ai)
#pragma unroll
                for (int m = 0; m < 4; ++m) { const size_t row = (size_t)(u.pm * BM + ai * HALF + wr * 64 + m * 16 + fr);
                    const u32x4 zz = *(const u32x4*)(Z + row * DSSM + c0);
                    const f32x4 a = acc[ai][bj][m][0], b = acc[ai][bj][m][1];
#define GLU_SG(v_, b_) __builtin_amdgcn_rcpf(1.f + __builtin_amdgcn_exp2f(__builtin_fmaf((v_), NL2E, (b_))))
                    float y[8];
                    y[0] = bf2f(zz.x & 0xffff) * GLU_SG(a.x, b0.x); y[1] = bf2f(zz.x >> 16) * GLU_SG(a.y, b0.y); y[2] = bf2f(zz.y & 0xffff) * GLU_SG(a.z, b0.z); y[3] = bf2f(zz.y >> 16) * GLU_SG(a.w, b0.w);
                    y[4] = bf2f(zz.z & 0xffff) * GLU_SG(b.x, b1.x); y[5] = bf2f(zz.z >> 16) * GLU_SG(b.y, b1.y); y[6] = bf2f(zz.w & 0xffff) * GLU_SG(b.z, b1.z); y[7] = bf2f(zz.w >> 16) * GLU_SG(b.w, b1.w);
#undef GLU_SG
                    { float sq = ss[ai][m];
#pragma unroll
                      for (int e = 0; e < 8; ++e) sq = __builtin_fmaf(y[e], y[e], sq);
                      ss[ai][m] = sq; }
                    u32x4 w; w.x = cvtpk(y[0], y[1]); w.y = cvtpk(y[2], y[3]); w.z = cvtpk(y[4], y[5]); w.w = cvtpk(y[6], y[7]);
                    *(u32x4*)(MIX + row * PX + c0) = w; } }
#pragma unroll
        for (int ai = 0; ai < 2; ++ai)
#pragma unroll
            for (int m = 0; m < 4; ++m) { float v = xor32_sum(xor16_sum(ss[ai][m]));
                if (fq == 0) atomicAdd(SSQ + (u.pm * BM + ai * HALF + wr * 64 + m * 16 + fr), v); }
    }
};
struct EpiX1B {
#ifndef SIDE7
#define SIDE7 1
#endif
    static constexpr bool HALFN = false, HOOKS = true, PERM = true, SIDE = (SIDE7 != 0);
    int side_r0; unsigned char* side_ws;
    const float* RSTDX; bf16* X1B; const float* SSQS; const float* SSQA; LAS float* RSC;
    __device__ __forceinline__ void begin(const Unit&, int, int) const {}
    __device__ __forceinline__ void fill(int ui, int pm, int tid) const {
        if (tid < 256) { const int row = pm * BM + tid; const float rs = __builtin_amdgcn_rsqf(SSQS[row] * (1.f / 512.f) + EPS), ra = __builtin_amdgcn_rsqf(SSQA[row] * (1.f / 512.f) + EPS);
            LAS float* d = RSC + (ui * 256 + tid) * 3; d[0] = rs * __builtin_amdgcn_rcpf(ra); d[1] = ra; d[2] = __builtin_amdgcn_rcpf(RSTDX[row]); }
    }
    __device__ __forceinline__ void mid(Acc& acc, int ui, int wr, int fr) const {
#pragma unroll
        for (int ai = 0; ai < 2; ++ai)
#pragma unroll
            for (int m = 0; m < 4; ++m) { const float f = RSC[(ui * 256 + ai * HALF + wr * 64 + m * 16 + fr) * 3];
#pragma unroll
                for (int bj = 0; bj < 2; ++bj)
#pragma unroll
                    for (int n = 0; n < 2; ++n) acc[ai][bj][m][n] = acc[ai][bj][m][n] * f; }
    }
    __device__ __forceinline__ void fin(const Acc& acc, const Unit& u, int ui, int wr, int wc, int fr, int fq) const { finh<0>(acc, u, ui, wr, wc, fr, fq); finh<1>(acc, u, ui, wr, wc, fr, fq); }
    template <int AI> __device__ __forceinline__ void finh(const Acc& acc, const Unit& u, int ui, int wr, int wc, int fr, int fq) const {
        constexpr int ai = AI;
#pragma unroll
            for (int m = 0; m < 4; ++m) { const int rl = ai * HALF + wr * 64 + m * 16 + fr; const LAS float* rc = RSC + (ui * 256 + rl) * 3; const float ra = rc[1], ix = rc[2];
                const size_t ro = (size_t)(u.pm * BM + rl) * PX + u.pn * BM + 64 * wc + 8 * fq;
                u32x4 p[2];
#pragma unroll
                for (int bj = 0; bj < 2; ++bj) { const u32x4 xn = *(const u32x4*)(X1B + ro + 32 * bj);
                    const f32x4 xa = (f32x4){bf2f(xn.x & 0xffff), bf2f(xn.x >> 16), bf2f(xn.y & 0xffff), bf2f(xn.y >> 16)} * ix, xb = (f32x4){bf2f(xn.z & 0xffff), bf2f(xn.z >> 16), bf2f(xn.w & 0xffff), bf2f(xn.w >> 16)} * ix;
                    const f32x4 a = xa + acc[ai][bj][m][0] * ra, b = xb + acc[ai][bj][m][1] * ra;
                    p[bj].x = cvtpk(a.x, a.y); p[bj].y = cvtpk(a.z, a.w); p[bj].z = cvtpk(b.x, b.y); p[bj].w = cvtpk(b.z, b.w); }
                store_pair(X1B + (size_t)(u.pm * BM + (rl & ~1)) * PX + u.pn * BM + 64 * wc, PX, p[0], p[1], fr, fq); }
    }
};
struct EpiGU {
    static constexpr bool HALFN = false, HOOKS = true, PERM = true, SIDE = false;
    __device__ __forceinline__ void begin(const Unit&, int, int) const {}
    __device__ __forceinline__ void mid(Acc&, int, int, int) const {}
    unsigned char* HH; const LAS unsigned* RCW;
    __device__ __forceinline__ void fin(const Acc& acc, const Unit& u, int ui, int wr, int wc, int fr, int fq) const {
#pragma unroll
        for (int ai = 0; ai < 2; ++ai)
#pragma unroll
            for (int m = 0; m < 4; ++m) { const int rl = ai * HALF + wr * 64 + m * 16 + fr, rr = u.pm * BM + rl; const size_t off = (size_t)rr * DE + u.pn * 128 + 32 * wc + 8 * fq;
                const float sc = __uint_as_float(RCW[ui * 256 + rl] & 0xffff0000u) * (1.f / W8SC), k1 = sc * -1.4426950408889634f, sc2 = sc * sc;
#define GU_H(g_, u_) (((g_) * (u_)) * __builtin_amdgcn_rcpf(1.f + __builtin_amdgcn_exp2f((g_) * k1)) * sc2)
                float hv[8];
#pragma unroll
                for (int n = 0; n < 2; ++n) { const f32x4 gt = acc[ai][0][m][n], up = acc[ai][1][m][n];
                    hv[4 * n] = GU_H(gt.x, up.x); hv[4 * n + 1] = GU_H(gt.y, up.y); hv[4 * n + 2] = GU_H(gt.z, up.z); hv[4 * n + 3] = GU_H(gt.w, up.w); }
#undef GU_H
                u32x2 w; w.x = pk4_fp8(hv[0], hv[1], hv[2], hv[3]); w.y = pk4_fp8(hv[4], hv[5], hv[6], hv[7]);
                *(u32x2*)(HH + off) = w; }
    }
};
struct EpiDown {
    static constexpr bool HALFN = false, HOOKS = true, PERM = true, SIDE = false;
    __device__ __forceinline__ void begin(const Unit&, int, int) const {}
    __device__ __forceinline__ void mid(Acc&, int, int, int) const {}
    unsigned char* YE; const LAS float* RGC;
    __device__ __forceinline__ void fin(const Acc& acc, const Unit& u, int ui, int wr, int wc, int fr, int fq) const {
#pragma unroll
        for (int ai = 0; ai < 2; ++ai)
#pragma unroll
            for (int m = 0; m < 4; ++m) { const int rl = ai * HALF + wr * 64 + m * 16 + fr; const float gw_ = RGC[ui * 256 + rl] * (YE_SCALE / W8SC);
                u32x2 p[2];
#pragma unroll
                for (int bj = 0; bj < 2; ++bj) { const f32x4 a = acc[ai][bj][m][0] * gw_, b = acc[ai][bj][m][1] * gw_; p[bj].x = pk4_fp8(a.x, a.y, a.z, a.w); p[bj].y = pk4_fp8(b.x, b.y, b.z, b.w); }
                const bool od = fq & 1; const u32x2 send = od ? p[0] : p[1]; u32x2 recv; recv.x = xor16_get(send.x, od); recv.y = xor16_get(send.y, od);
                u32x4 w; if (od) { w.x = recv.x; w.y = recv.y; w.z = p[1].x; w.w = p[1].y; } else { w.x = p[0].x; w.y = p[0].y; w.z = recv.x; w.w = recv.y; }
                *(u32x4*)(YE + (size_t)(u.pm * BM + rl) * DM + u.pn * BM + 64 * wc + (od ? 32 : 0) + 8 * (fq & ~1)) = w; }
    }
};

template <int K> __device__ __forceinline__ const float* karg() {
    const float* p;
    asm volatile("s_load_dwordx2 %0, %1, %2\n\ts_waitcnt lgkmcnt(0)" : "=s"(p) : "s"(__builtin_amdgcn_kernarg_segment_ptr()), "i"(K * 8) : "memory");
    return p;
}
struct Args { const float* in[26]; float* out; unsigned char* ws; int ph_lo, ph_hi; };
struct Frame { LAS unsigned char* lds; volatile LAS unsigned* MISC; unsigned* ctl; int tid, lane, wave, G, c; };

struct TItem { const float* W; int ldw, srccol0; const float* kscale; bf16* WT; int ldt, dstrow0, k0; int fp8; };
__device__ __forceinline__ void titem_load(const TItem& t, int lane, f32x4 (&v)[8]) {
#pragma unroll
    for (int i = 0; i < 8; ++i) { const int kk = 8 * i + (lane >> 3); v[i] = *(const GAS f32x4*)(t.W + (size_t)(t.k0 + kk) * t.ldw + t.srccol0 + (lane & 7) * 4); }
}
__device__ __forceinline__ void titem_store(const TItem& t, int lane, const f32x4 (&v)[8], LAS float* scr) {
#pragma unroll
    for (int i = 0; i < 8; ++i) { const int kk = 8 * i + (lane >> 3); const float sc = t.kscale ? t.kscale[t.k0 + kk] : 1.f; LAS float* d = scr + kk * 33 + (lane & 7) * 4;
        d[0] = v[i].x * sc; d[1] = v[i].y * sc; d[2] = v[i].z * sc; d[3] = v[i].w * sc; }
    asm volatile("s_waitcnt lgkmcnt(0)" ::: "memory");
    const int c = lane & 7;
#pragma unroll
    for (int j = 0; j < 4; ++j) { const int n = (lane >> 3) + 8 * j; const LAS float* s = scr + (8 * c) * 33 + n;
        if (t.fp8) { u32x2 o; o.x = pk4_fp8(s[0 * 33] * W8SC, s[1 * 33] * W8SC, s[2 * 33] * W8SC, s[3 * 33] * W8SC); o.y = pk4_fp8(s[4 * 33] * W8SC, s[5 * 33] * W8SC, s[6 * 33] * W8SC, s[7 * 33] * W8SC);
            *(u32x2*)((unsigned char*)t.WT + (size_t)(t.dstrow0 + n) * t.ldt + t.k0 + 8 * c) = o; }
        else { u32x4 o; o.x = pk2(s[0 * 33], s[1 * 33]); o.y = pk2(s[2 * 33], s[3 * 33]); o.z = pk2(s[4 * 33], s[5 * 33]); o.w = pk2(s[6 * 33], s[7 * 33]);
            *(u32x4*)(t.WT + (size_t)(t.dstrow0 + n) * t.ldt + t.k0 + 8 * c) = o; } }
    asm volatile("s_waitcnt lgkmcnt(0)" ::: "memory");
}
__device__ __forceinline__ void s5_tables_item(Frame& F, const Args& a, int g, int part) {
    const float* lre = karg<3>(); const float* lim = karg<4>(); const float* ldt = karg<5>(); const float* bre = karg<6>(); const float* bim = karg<7>();
    const float* cre = karg<8>(); const float* cim = karg<9>(); const float* dsk = karg<10>();
    LAS float* PWr = (LAS float*)F.lds; LAS float* PWi = PWr + 33 * 64; LAS float* BBr = PWi + 33 * 64; LAS float* BBi = BBr + 1024; LAS float* CCr = BBi + 1024; LAS float* CCi = CCr + 1024; LAS float* CF = CCi + 1024;
    const int tid = F.tid;
    if (tid < 64) { const int p = tid;
        const double dt = exp((double)ldt[g]), lr = lre[g * PST + p], li = lim[g * PST + p];
        double sn, cs; sincos_d(li * dt, sn, cs); const double mag = exp(lr * dt);
        const double ar = mag * cs, ai = mag * sn, den = lr * lr + li * li, nr = ar - 1.0, ni = ai;
        CF[2 * p] = (float)((nr * lr + ni * li) / den); CF[2 * p + 1] = (float)((ni * lr - nr * li) / den);
        double pr = 1.0, pi = 0.0;
        for (int l = 0; l <= 32; ++l) { PWr[l * 64 + p] = (float)pr; PWi[l * 64 + p] = (float)pi; if (l == 32 && part == 0) { float* A32 = (float*)(a.ws + FW_A32) + (g * PST + p) * 2; A32[0] = (float)pr; A32[1] = (float)pi; }
            const double t = pr * ar - pi * ai; pi = pr * ai + pi * ar; pr = t; }
    }
    __syncthreads();
    for (int idx = tid; idx < 1024; idx += NTHR) { const int p = idx >> 4; const float cfr = CF[2 * p], cfi = CF[2 * p + 1], br = bre[(size_t)g * 1024 + idx], bi = bim[(size_t)g * 1024 + idx];
        BBr[idx] = cfr * br - cfi * bi; BBi[idx] = cfr * bi + cfi * br; CCr[idx] = cre[(size_t)g * 1024 + idx]; CCi[idx] = cim[(size_t)g * 1024 + idx]; }
    __syncthreads();
    bf16* TBg = (bf16*)(a.ws + FW_TB) + (size_t)g * 512 * U2P; bf16* W1g = (bf16*)(a.ws + FW_W1) + (size_t)g * 256 * 512;
    for (int l = part; l < 32; l += 8) {
        if (tid < 256) { const int h = tid >> 4, hp = tid & 15; float k = 0.f;
#pragma unroll 16
            for (int p = 0; p < 64; ++p) { const float wr_ = PWr[l * 64 + p], wi_ = PWi[l * 64 + p], br = BBr[p * 16 + hp], bi = BBi[p * 16 + hp];
                k += CCr[h * 64 + p] * (wr_ * br - wi_ * bi) - CCi[h * 64 + p] * (wr_ * bi + wi_ * br); }
            if (l == 0 && h == hp) k += dsk[g * 16 + h];
            const bf16 v = (bf16)f2bf(k);
            for (int i = l; i < 32; ++i) TBg[(size_t)(i * 16 + h) * U2P + (i - l) * 16 + hp] = v;
            if (l >= 1) for (int i = 0; i < 32 - l; ++i) TBg[(size_t)(i * 16 + h) * U2P + (i + l) * 16 + hp] = 0;
        } else { const int t2 = tid - 256;
#pragma unroll
            for (int x = 0; x < 8; ++x) { const int e = t2 * 8 + x;
                { const int h = e >> 7, q = e & 127, p = q & 63; const float cr = CCr[h * 64 + p], ci = CCi[h * 64 + p], wr_ = PWr[(l + 1) * 64 + p], wi_ = PWi[(l + 1) * 64 + p];
                  const float re = cr * wr_ - ci * wi_, im = cr * wi_ + ci * wr_; TBg[(size_t)(l * 16 + h) * U2P + 512 + q] = (bf16)f2bf(q < 64 ? re : -im); }
                { const int rho = e >> 4, hp = e & 15, p = rho & 63; const float wr_ = PWr[(31 - l) * 64 + p], wi_ = PWi[(31 - l) * 64 + p], br = BBr[p * 16 + hp], bi = BBi[p * 16 + hp];
                  const float re = wr_ * br - wi_ * bi, im = wr_ * bi + wi_ * br; W1g[(size_t)rho * 512 + l * 16 + hp] = (bf16)f2bf(rho < 64 ? re : im); W1g[(size_t)(128 + rho) * 512 + l * 16 + hp] = 0; }
            }
        }
    }
    __syncthreads();
}
#ifndef XNR
#define XNR 8
#endif
__device__ __forceinline__ void p0_prologue(Frame& F, const Args& a) {
    const float* x = karg<0>();
    for (int it = F.c; it < 256; it += F.G) s5_tables_item(F, a, it >> 3, it & 7);
    LAS float* scr = (LAS float*)(F.lds + F.wave * 16384);
    const int gw = F.c * NWAVES + F.wave, NGW = F.G * NWAVES;
    constexpr int I_IN = 16 * 64, I_GLU = 8 * 16, I_OUT = 16 * 32, I_GU = 32 * 16 * 32, I_D = 32 * 8 * 32, NITEMS = I_IN + I_GLU + I_OUT + I_GU + I_D;
    bf16* WIN = (bf16*)(a.ws + FW_WIN); bf16* WGLU = (bf16*)(a.ws + FW_WGLU); bf16* WOUT = (bf16*)(a.ws + FW_WOUT); bf16* WGU = (bf16*)(a.ws + FW_WGU); bf16* WD = (bf16*)(a.ws + FW_WD);
    auto mkitem = [&](int it) -> TItem {
        int r = it;
        if (r < I_IN) { const int kb = r >> 6, d = r & 63, pn = d >> 3, beta = d & 7, bj = beta >> 2, wc = beta & 3;
            return TItem{karg<2>(), DIN, 256 * pn + 32 * (2 * wc + bj), karg<1>(), WIN, PW, 32 * d, 64 * kb, 0}; } r -= I_IN;
        if (r < I_GLU) { const int kb = r >> 4, d = r & 15; return TItem{karg<11>(), DSSM, 32 * d, nullptr, WGLU, DSSM, 32 * d, 64 * kb, 0}; } r -= I_GLU;
        if (r < I_OUT) { const int kb = r >> 5, d = r & 31; const float* ks = (kb < 8) ? karg<15>() : (karg<16>() - 512);
            return TItem{karg<17>(), DM, 32 * (8 * (d >> 3) + 2 * (d & 3) + ((d & 7) >> 2)), ks, WOUT, PW, 32 * d, 64 * kb, 0}; } r -= I_OUT;
        if (r < I_GU) { const int e = r >> 9, q = r & 511, kb = q >> 5, d = q & 31, pn = d >> 3, beta = d & 7;
            const float* W = (beta < 4 ? karg<23>() : karg<24>()) + (size_t)e * DM * DE;
            return TItem{W, DE, 128 * pn + 32 * (beta & 3), karg<18>(), (bf16*)((unsigned char*)WGU + (size_t)e * DM * DM), DM, 32 * d, 64 * kb, 1}; } r -= I_GU;
        const int e = r >> 8, q = r & 255, kb = q >> 5, d = q & 31;
        return TItem{karg<25>() + (size_t)e * DE * DM, DM, 32 * (8 * (d >> 3) + 2 * (d & 3) + ((d & 7) >> 2)), nullptr, (bf16*)((unsigned char*)WD + (size_t)e * DM * DE), DE, 32 * d, 64 * kb, 1};
    };
    const int nitems = (F.G == 256) ? (I_IN + I_GLU + I_OUT + (SIDE7 ? 0 : I_D)) : NITEMS;
    auto remap = [&](int it) { return (F.G == 256 && it >= I_IN + I_GLU + I_OUT) ? it + I_GU : it; };
    if (gw < nitems) {
        TItem cur = mkitem(remap(gw)); f32x4 vc[8]; titem_load(cur, F.lane, vc);
        for (int it = gw; it < nitems; it += NGW) {
            const bool more = it + NGW < nitems; TItem nxt = cur; f32x4 vn[8];
            if (more) { nxt = mkitem(remap(it + NGW)); titem_load(nxt, F.lane, vn); }
            titem_store(cur, F.lane, vc, scr);
            if (more) { cur = nxt;
#pragma unroll
                for (int i = 0; i < 8; ++i) vc[i] = vn[i]; }
        }
    }
    { bf16* WR = (bf16*)(a.ws + FW_WR);
      for (int idx = F.c * NTHR + F.tid; idx < 64 * DM; idx += F.G * NTHR) { const int n = idx >> 10, k = idx & 1023;
          float v = 0.f; if (n < 4) v = karg<19>()[k * 4 + n]; else if (n < 36) v = karg<21>()[k * 32 + (n - 4)];
          WR[idx] = (bf16)f2bf(v * karg<18>()[k]); } }
    bf16* XN = (bf16*)(a.ws + FW_XN); float* RSTDX = (float*)(a.ws + FW_RSTDX);
    for (int m0 = gw * XNR; m0 < M; m0 += NGW * XNR) {
        f32x4 v[XNR][4];
#pragma unroll
        for (int rr = 0; rr < XNR; ++rr) { const GAS f32x4* xr = (const GAS f32x4*)(x + (size_t)(m0 + rr) * DM);
            v[rr][0] = __builtin_nontemporal_load(xr + 2 * F.lane); v[rr][1] = __builtin_nontemporal_load(xr + 2 * F.lane + 1);
            v[rr][2] = __builtin_nontemporal_load(xr + 128 + 2 * F.lane); v[rr][3] = __builtin_nontemporal_load(xr + 128 + 2 * F.lane + 1); }
#pragma unroll
        for (int rr = 0; rr < XNR; ++rr) { float s = 0.f;
#pragma unroll
            for (int j = 0; j < 4; ++j) s += v[rr][j].x * v[rr][j].x + v[rr][j].y * v[rr][j].y + v[rr][j].z * v[rr][j].z + v[rr][j].w * v[rr][j].w;
            const float rstd = __builtin_amdgcn_rsqf(wave_sum(s) * (1.f / DM) + EPS);
            if (F.lane == 0) RSTDX[m0 + rr] = rstd;
            u32x4* o = (u32x4*)(XN + (size_t)(m0 + rr) * PX);
#pragma unroll
            for (int j = 0; j < 2; ++j) { const f32x4 a = v[rr][2 * j] * rstd, b = v[rr][2 * j + 1] * rstd; u32x4 w; w.x = cvtpk(a.x, a.y); w.y = cvtpk(a.z, a.w); w.z = cvtpk(b.x, b.y); w.w = cvtpk(b.z, b.w); o[64 * j + F.lane] = w; } }
    }
}

__device__ __forceinline__ void s5_scan_local(Frame& F, const Args& a, int g, int pm) {
    const float* SST = (const float*)(a.ws + FW_SST); bf16* U2 = (bf16*)(a.ws + FW_U2);
    if (F.tid < 256) {
        const int p = F.tid & 63;
        const float* A32 = (const float*)(a.ws + FW_A32) + (g * PST + p) * 2; const float ar = A32[0], ai = A32[1];
        float xr = 0.f, xi = 0.f;
        const size_t row0 = (size_t)g * NCH + (size_t)pm * 256 + (size_t)(F.tid >> 6) * 64;
        for (int c0 = 0; c0 < 64; c0 += 16) {
            float sr[16], si[16];
#pragma unroll
            for (int j = 0; j < 16; ++j) { sr[j] = SST[(row0 + c0 + j) * 128 + p]; si[j] = SST[(row0 + c0 + j) * 128 + 64 + p]; }
#pragma unroll
            for (int j = 0; j < 16; ++j) { bf16* up = U2 + (row0 + c0 + j) * U2P + 512; up[p] = (bf16)f2bf(xr); up[64 + p] = (bf16)f2bf(xi);
                const float t = ar * xr - ai * xi + sr[j]; xi = ar * xi + ai * xr + si[j]; xr = t; }
        }
    }
}
__device__ __forceinline__ void s5_scan(Frame& F, const Args& a) {
    const float* SST = (const float*)(a.ws + FW_SST); bf16* U2 = (bf16*)(a.ws + FW_U2);
    for (int idx = F.c * NTHR + F.tid; idx < BATCH * NG * PST; idx += F.G * NTHR) {
        const int p = idx & 63, g = (idx >> 6) & 31, b = idx >> 11;
        const double dt = exp((double)karg<5>()[g]), lr = karg<3>()[g * PST + p], li = karg<4>()[g * PST + p];
        double sn, cs; sincos_d(32.0 * li * dt, sn, cs); const double mag = exp(32.0 * lr * dt);
        const float ar = (float)(mag * cs), ai = (float)(mag * sn);
        float xr = 0.f, xi = 0.f;
        const size_t row0 = (size_t)g * NCH + (size_t)b * 64;
        for (int c0 = 0; c0 < 64; c0 += 16) {
            float sr[16], si[16];
#pragma unroll
            for (int j = 0; j < 16; ++j) { sr[j] = SST[(row0 + c0 + j) * 128 + p]; si[j] = SST[(row0 + c0 + j) * 128 + 64 + p]; }
#pragma unroll
            for (int j = 0; j < 16; ++j) { bf16* up = U2 + (row0 + c0 + j) * U2P + 512; up[p] = (bf16)f2bf(xr); up[64 + p] = (bf16)f2bf(xi);
                const float t = ar * xr - ai * xi + sr[j]; xi = ar * xi + ai * xr + si[j]; xr = t; }
        }
    }
}

#ifndef ATT_THR_V
#define ATT_THR_V -32.f
#endif
constexpr float ATT_THR = ATT_THR_V;
__device__ __forceinline__ s16x4 vtr(const LAS unsigned char* p) { typedef short v4i16_t __attribute__((ext_vector_type(4))); return __builtin_bit_cast(s16x4, __builtin_amdgcn_ds_read_tr16_b64_v4i16((LAS v4i16_t*)p)); }
__device__ __forceinline__ int crow(int r, int hi) { return (r & 3) + 8 * (r >> 2) + 4 * hi; }
#define MFMA32(a, b, c) __builtin_amdgcn_mfma_f32_32x32x16_bf16((a), (b), (c), 0, 0, 0)
template <bool DIAG, int P, int KH, int KD, int VD>
__device__ __forceinline__ float attn_half(const LAS unsigned char* Kb, const LAS unsigned char* Vb, const bf16x8 (&qr)[4], const bf16x8 (&tri)[2], f32x16 (&o)[2], float base, int lim, int lane) {
    const int r32 = lane & 31, hi = lane >> 5;
    const LAS unsigned char* kp = Kb + hi * KH + r32 * 16 + P * 512;
    const int lim2 = lim - 4 * hi;
    f32x16 z = {};
#pragma unroll
    for (int d0 = 0; d0 < 4; ++d0) { const bf16x8 kf = *(const LAS bf16x8*)(kp + d0 * KD); z = MFMA32(kf, qr[d0], z); }
    float l[16];
#pragma unroll
    for (int r = 0; r < 16; ++r) { l[r] = -__builtin_amdgcn_logf(1.f + __builtin_amdgcn_exp2f(z[r])); if (DIAG) { if (!((r & 3) + 8 * (r >> 2) + 32 * P < lim2)) l[r] = 0.f; } }
    u32x4 wa, wb;
    wa.x = cvtpk(l[0], l[1]); wa.y = cvtpk(l[2], l[3]); wa.z = cvtpk(l[4], l[5]); wa.w = cvtpk(l[6], l[7]);
    wb.x = cvtpk(l[8], l[9]); wb.y = cvtpk(l[10], l[11]); wb.z = cvtpk(l[12], l[13]); wb.w = cvtpk(l[14], l[15]);
    const bf16x8 La = __builtin_bit_cast(bf16x8, wa), Lb = __builtin_bit_cast(bf16x8, wb);
    f32x16 T = {};
    T = MFMA32(tri[0], La, T); T = MFMA32(tri[1], Lb, T);
    float av[16];
#pragma unroll
    for (int r = 0; r < 16; ++r) { av[r] = __builtin_amdgcn_exp2f((z[r] + base) + T[r]); if (DIAG) { if (!((r & 3) + 8 * (r >> 2) + 32 * P < lim2)) av[r] = 0.f; } }
    wa.x = cvtpk(av[0], av[1]); wa.y = cvtpk(av[2], av[3]); wa.z = cvtpk(av[4], av[5]); wa.w = cvtpk(av[6], av[7]);
    wb.x = cvtpk(av[8], av[9]); wb.y = cvtpk(av[10], av[11]); wb.z = cvtpk(av[12], av[13]); wb.w = cvtpk(av[14], av[15]);
    const bf16x8 Pa = __builtin_bit_cast(bf16x8, wa), Pb = __builtin_bit_cast(bf16x8, wb);
    const LAS unsigned char* vp = Vb + ((lane >> 4) & 1) * 32 + (lane & 3) * 8 + (4 * hi + ((lane & 15) >> 2)) * 64 + P * 2048;
#pragma unroll
    for (int d0 = 0; d0 < 2; ++d0) {
        const s16x4 lo0 = vtr(vp + d0 * VD), hi0 = vtr(vp + d0 * VD + 512), lo1 = vtr(vp + d0 * VD + 1024), hi1 = vtr(vp + d0 * VD + 1536);
        const bf16x8 v0 = {lo0[0], lo0[1], lo0[2], lo0[3], hi0[0], hi0[1], hi0[2], hi0[3]}, v1 = {lo1[0], lo1[1], lo1[2], lo1[3], hi1[0], hi1[1], hi1[2], hi1[3]};
        o[d0] = MFMA32(Pa, v0, o[d0]); o[d0] = MFMA32(Pb, v1, o[d0]);
    }
    { const unsigned u = __builtin_bit_cast(unsigned, T[0]); auto r = __builtin_amdgcn_permlane32_swap(u, u, false, false); return __builtin_bit_cast(float, (unsigned)r[0]); }
}
#ifndef ASPAN_N
#define ASPAN_N 13
#endif
constexpr int ASPAN = ASPAN_N;
__device__ __forceinline__ void attn_span_phase(Frame& F, const bf16* Q, const bf16* Kg, const bf16* Vg, bf16* MIX, float* SSQA) {
    const int lane = F.lane, wid = F.wave, r32 = lane & 31, hi = lane >> 5;
    volatile LAS int* FLG = (volatile LAS int*)(F.lds + ASPAN * 8192 + 8 * 4096);
    bf16x8 tri[2];
#pragma unroll
    for (int s = 0; s < 2; ++s)
#pragma unroll
        for (int j = 0; j < 8; ++j) tri[s][j] = ((16 * s + 8 * (j >> 2) + 4 * hi + (j & 3)) >= r32) ? (short)0x3F80 : (short)0;
    for (int L = F.c; L < BATCH * NH * 8; L += F.G) {
        const int bh = L >> 3, qb = L & 7, b = bh >> 3, h = bh & 7, a0 = 8 * qb, a = a0 + wid;
        const size_t row0 = (size_t)b * SEQ; const int qg = 32 * a + r32;
        bf16x8 qr[4];
#pragma unroll
        for (int d0 = 0; d0 < 4; ++d0) qr[d0] = *(const bf16x8*)(Q + (row0 + qg) * DATT + h * HD + d0 * 16 + hi * 8);
        const bf16* src = (wid < 4) ? (Kg + (row0 + (lane & 31)) * DATT + h * HD + (lane >> 5) * 8 + 16 * wid)
                                    : (Vg + (row0 + 16 * (wid & 1) + (lane >> 2)) * DATT + h * HD + (lane & 3) * 8 + 32 * ((wid - 4) >> 1));
        const int dsto = (wid < 4) ? wid * 1024 : 4096 + (wid - 4) * 1024;
        f32x16 o[2] = {}; float Rc = 0.f; bool done = false;
        for (int k = 0;; ++k) {
            const int top = a0 + 7 - ASPAN * k, bot = (top - (ASPAN - 1) > 0) ? top - (ASPAN - 1) : 0;
#pragma unroll 1
            for (int jj = top; jj >= bot; --jj)
                __builtin_amdgcn_global_load_lds((const unsigned*)(src + (size_t)(32 * jj) * DATT), (LAS unsigned*)(F.lds + (top - jj) * 8192 + dsto), 16, 0, 0);
            asm volatile("s_waitcnt vmcnt(0)" ::: "memory");
            __syncthreads();
            if (!done) {
                for (int jj = (a < top ? a : top); jj >= bot; --jj) {
                    const LAS unsigned char* Kb = F.lds + (top - jj) * 8192; const LAS unsigned char* Vb = Kb + 4096;
                    const int lim = qg - 32 * jj;
                    float sh;
                    if (jj == a) sh = attn_half<true, 0, 512, 1024, 2048>(Kb, Vb, qr, tri, o, Rc, lim, lane);
                    else sh = attn_half<false, 0, 512, 1024, 2048>(Kb, Vb, qr, tri, o, Rc, lim, lane);
                    Rc += sh;
                    if (jj == 0 || __all(Rc < ATT_THR)) { done = true; break; }
                }
            }
            if (lane == 0) FLG[wid] = done ? 1 : 0;
            asm volatile("s_waitcnt lgkmcnt(0)" ::: "memory");
            __syncthreads();
            if (bot == 0) break;
            int alld = 1;
#pragma unroll
            for (int w = 0; w < 8; ++w) alld &= FLG[w];
            if (alld) break;
        }
        { LAS unsigned char* stg = F.lds + ASPAN * 8192 + wid * 4096; LAS unsigned short* sp = (LAS unsigned short*)(stg + hi * 512 + r32 * 2);
#pragma unroll
          for (int r = 0; r < 16; ++r) { const int ro = ((r & 3) + 8 * (r >> 2)) * 64; sp[ro] = (unsigned short)f2bf(o[0][r]); sp[ro + 32] = (unsigned short)f2bf(o[1][r]); }
          asm volatile("s_waitcnt lgkmcnt(0)" ::: "memory");
          bf16* ow = MIX + (row0 + 32 * a) * PX + 512 + h * HD;
#pragma unroll
          for (int i = 0; i < 4; ++i) { const int row = i * 8 + (lane >> 3), ch = lane & 7; const u32x4 v = *(const LAS u32x4*)(stg + row * 128 + ch * 16); *(u32x4*)(ow + (size_t)row * PX + ch * 8) = v;
              const float f0 = bf2f(v.x & 0xffff), f1 = bf2f(v.x >> 16), f2 = bf2f(v.y & 0xffff), f3 = bf2f(v.y >> 16), f4 = bf2f(v.z & 0xffff), f5 = bf2f(v.z >> 16), f6 = bf2f(v.w & 0xffff), f7 = bf2f(v.w >> 16);
              float ss = ((f0 * f0 + f1 * f1) + (f2 * f2 + f3 * f3)) + ((f4 * f4 + f5 * f5) + (f6 * f6 + f7 * f7));
              ss += dppf<0xB1>(ss); ss += dppf<0x4E>(ss); ss += dppf<0x141>(ss);
              if (ch == 0) atomicAdd(SSQA + (row0 + 32 * a + row), ss); }
          asm volatile("s_waitcnt lgkmcnt(0)" ::: "memory"); }
    }
    asm volatile("s_waitcnt vmcnt(0)" ::: "memory");
    __syncthreads();
}
static_assert(ASPAN * 8192 + 8 * 4096 + 64 <= MISC_OFF, "attention LDS map");

constexpr int RT_PITCH = 2064;
__device__ __forceinline__ void router_phase(Frame& F, const Args& a) {
    const bf16* X1B = (const bf16*)(a.ws + FW_X1B); unsigned char* X1Q = (unsigned char*)(a.ws + FW_X1Q); int* TOK = (int*)(a.ws + FW_TOK); const bf16* WR = (const bf16*)(a.ws + FW_WR);
    const float* brg = karg<20>(); const float* bre_ = karg<22>();
    const int tid = F.tid, lane = F.lane, wid = F.wave, r32 = lane & 31, hi = lane >> 5;
    LAS unsigned char* TILE = F.lds;
    LAS float* PART = (LAS float*)(F.lds + 66048);
    LAS float* LOGIT = (LAS float*)(F.lds + 66048 + 65536);
    LAS int* HIST = (LAS int*)(F.lds + 66048 + 65536 + 5120);
    LAS int* TREC = HIST + 64;
    LAS float* RS = (LAS float*)(TREC + 1024);
    LAS float* TRS = RS + 32;
    LAS float* TRG = TRS + 256;
    LAS float* BIAS = TRG + 512;
    static_assert(66048 + 65536 + 5120 + 256 + 4096 + 128 + 1024 + 2048 + 160 <= MISC_OFF, "router LDS");
    bf16x8 Bf[8][2];
#pragma unroll
    for (int s = 0; s < 8; ++s)
#pragma unroll
        for (int nb = 0; nb < 2; ++nb) Bf[s][nb] = *(const bf16x8*)(WR + (size_t)(32 * nb + r32) * DM + 128 * wid + 16 * s + 8 * hi);
    if (tid < 64) HIST[tid] = 0;
    if (tid >= 64 && tid < 104) { const int c = tid - 64; BIAS[c] = c < 4 ? brg[c] : (c < 36 ? bre_[c - 4] : 0.f); }
    __syncthreads();
    int ntl = 0;
#define RT_BAR() do { asm volatile("s_waitcnt lgkmcnt(0)" ::: "memory"); __builtin_amdgcn_s_barrier(); asm volatile("" ::: "memory"); } while (0)
#define RT_LOAD(tile_) do { _Pragma("unroll") for (int rr = 0; rr < 4; ++rr) { const u32x4* xr = (const u32x4*)(X1B + (size_t)((tile_) * 32 + 4 * wid + rr) * PX); v[rr][0] = xr[lane]; v[rr][1] = xr[64 + lane]; } } while (0)
    u32x4 v[4][2];
    if (F.c < M / 32) RT_LOAD(F.c);
    for (int tile = F.c; tile < M / 32; tile += F.G, ++ntl) {
        {
#pragma unroll
          for (int rr = 0; rr < 4; ++rr) { const int lr = 4 * wid + rr; float s = 0.f;
#pragma unroll
              for (int j = 0; j < 2; ++j) { const u32x4 w = v[rr][j];
                  const float f0 = bf2f(w.x & 0xffff), f1 = bf2f(w.x >> 16), f2 = bf2f(w.y & 0xffff), f3 = bf2f(w.y >> 16), f4 = bf2f(w.z & 0xffff), f5 = bf2f(w.z >> 16), f6 = bf2f(w.w & 0xffff), f7 = bf2f(w.w >> 16);
                  s += (f0 * f0 + f1 * f1) + (f2 * f2 + f3 * f3) + (f4 * f4 + f5 * f5) + (f6 * f6 + f7 * f7);
                  { u32x2 q8; q8.x = pk4_fp8(f0, f1, f2, f3); q8.y = pk4_fp8(f4, f5, f6, f7); *(u32x2*)(X1Q + (size_t)(tile * 32 + lr) * DM + (64 * j + lane) * 8) = q8; }
                  *(LAS u32x4*)(TILE + lr * RT_PITCH + (64 * j + lane) * 16) = w; }
              const float rstd = __builtin_amdgcn_rsqf(wave_sum(s) * (1.f / DM) + EPS);
              if (lane == 0) RS[lr] = rstd; } }
        if (tile + F.G < M / 32) RT_LOAD(tile + F.G);
        RT_BAR();
        { f32x16 c0 = {}, c1 = {};
#pragma unroll
          for (int s = 0; s < 8; ++s) { const bf16x8 af = *(const LAS bf16x8*)(TILE + r32 * RT_PITCH + (128 * wid + 16 * s + 8 * hi) * 2);
              c0 = MFMA32(af, Bf[s][0], c0); c1 = MFMA32(af, Bf[s][1], c1); }
#pragma unroll
          for (int r = 0; r < 16; ++r) { const int t = crow(r, hi); PART[(wid * 32 + t) * 64 + r32] = c0[r]; PART[(wid * 32 + t) * 64 + 32 + r32] = c1[r]; } }
        RT_BAR();
        { const int t = tid >> 4, c4 = (tid & 15) * 4;
          if (c4 < 40) { f32x4 s = {0.f, 0.f, 0.f, 0.f};
#pragma unroll
              for (int w = 0; w < 8; ++w) s += *(const LAS f32x4*)(PART + (w * 32 + t) * 64 + c4);
              *(LAS f32x4*)(LOGIT + t * 40 + c4) = s * RS[t] + *(const LAS f32x4*)(BIAS + c4); } }
        RT_BAR();
        if (tid < 32) { const int m = tile * 32 + tid; float lg[36];
#pragma unroll
            for (int c = 0; c < 36; ++c) lg[c] = LOGIT[tid * 40 + c];
            int gi = 0; float gm = lg[0];
#pragma unroll
            for (int c = 1; c < 4; ++c) if (lg[c] > gm) { gm = lg[c]; gi = c; }
            float gsum = 0.f;
#pragma unroll
            for (int c = 0; c < 4; ++c) gsum += __expf(lg[c] - gm);
            const float pgrp = 1.f / gsum;
            float el[8];
#pragma unroll
            for (int e = 0; e < 8; ++e) { float t = 0.f;
#pragma unroll
                for (int g2 = 0; g2 < 4; ++g2) if (g2 == gi) t = lg[4 + g2 * 8 + e];
                el[e] = t; }
            int i0 = 0; float m0 = el[0];
#pragma unroll
            for (int e = 1; e < 8; ++e) if (el[e] > m0) { m0 = el[e]; i0 = e; }
            int i1 = 0; float m1 = -3.0e38f;
#pragma unroll
            for (int e = 0; e < 8; ++e) if (e != i0 && el[e] > m1) { m1 = el[e]; i1 = e; }
            const float e1 = __expf(m1 - m0), p0 = 1.f / (1.f + e1), p1 = e1 / (1.f + e1);
            const int ex0 = gi * 8 + i0, ex1 = gi * 8 + i1;
            const int rk0 = atomicAdd((int*)&HIST[ex0], 1), rk1 = atomicAdd((int*)&HIST[ex1], 1);
            int* tk = TOK + (size_t)m * 8; tk[0] = ex0; tk[1] = ex1; tk[2] = __float_as_int(pgrp * p0); tk[3] = __float_as_int(pgrp * p1);
            LAS int* tr = TREC + (ntl * 32 + tid) * 4; tr[0] = ex0; tr[1] = ex1; tr[2] = rk0; tr[3] = rk1;
            TRS[ntl * 32 + tid] = RS[tid]; TRG[2 * (ntl * 32 + tid)] = pgrp * p0; TRG[2 * (ntl * 32 + tid) + 1] = pgrp * p1;
        }
        RT_BAR();
    }
#undef RT_BAR
#undef RT_LOAD
    if (tid < 32) { const int cnt = HIST[tid]; int base = 0; if (cnt > 0) base = (int)__hip_atomic_fetch_add(F.ctl + CW_CNT + tid, (unsigned)cnt, RLX_AGENT); HIST[32 + tid] = base; }
    __syncthreads();
    unsigned* ETOK = (unsigned*)(a.ws + FW_ETOK); float* EG = (float*)(a.ws + FW_EG);
    for (int i = tid; i < ntl * 32; i += NTHR) { const int tile = F.c + (i >> 5) * F.G, m = tile * 32 + (i & 31); const LAS int* tr = TREC + i * 4;
        int* tk = TOK + (size_t)m * 8; const int s0 = HIST[32 + tr[0]] + tr[2], s1 = HIST[32 + tr[1]] + tr[3]; tk[4] = s0; tk[5] = s1;
        const unsigned word = (unsigned)m | (f2bf(TRS[i]) << 16);
        ETOK[(size_t)tr[0] * M + s0] = word; ETOK[(size_t)tr[1] * M + s1] = word; EG[(size_t)tr[0] * M + s0] = TRG[2 * i]; EG[(size_t)tr[1] * M + s1] = TRG[2 * i + 1]; }
    __syncthreads();
}
__device__ __forceinline__ int moe_tables(Frame& F) {
    LAS int* TST = (LAS int*)(F.lds + SCR2_OFF); LAS unsigned char* T2E = F.lds + SCR2_OFF + 256;
    if (F.tid < 64) {
        const int e = F.tid; int nt = 0;
        if (e < NE) { const int cnt = (int)__hip_atomic_load(F.ctl + CW_CNT + e, RLX_AGENT); nt = (cnt + 255) >> 8; TST[208 + e] = cnt; }
        int incl = nt;
#pragma unroll
        for (int o = 1; o < 32; o <<= 1) { const int v = __shfl_up(incl, o); if ((e & 31) >= o) incl += v; }
        const int start = incl - nt;
        if (e < NE) { TST[e] = start; for (int t = 0; t < nt; ++t) T2E[start + t] = (unsigned char)e; }
        if (e == NE - 1) TST[NE] = incl;
    }
    __syncthreads();
    return TST[NE];
}
#ifndef CTPT
#define CTPT 4
#endif
__device__ __forceinline__ void combine_phase(Frame& F, const Args& a) {
    const unsigned char* YE = (const unsigned char*)(a.ws + FW_YE); const bf16* X1B = (const bf16*)(a.ws + FW_X1B); const int* TOK = (const int*)(a.ws + FW_TOK); float* out = a.out;
    const LAS int* TST = (const LAS int*)(F.lds + SCR2_OFF);
    const int gw = F.c * NWAVES + F.wave, NGW = F.G * NWAVES, lane = F.lane;
    static_assert(CTPT * 8 <= 64, "one routing word per lane");
    int m0 = gw * CTPT;
    int w = 0; if (m0 < M) w = TOK[(size_t)m0 * 8 + (lane & (CTPT * 8 - 1))];
    for (; m0 < M; m0 += NGW * CTPT) {
        const int mn = m0 + NGW * CTPT;
        int wn = 0; if (mn < M) wn = TOK[(size_t)mn * 8 + (lane & (CTPT * 8 - 1))];
        const int tl = TST[w & 31];
        u32x2 xv[CTPT][4]; unsigned y0[CTPT][4], y1[CTPT][4];
#pragma unroll
        for (int t = 0; t < CTPT; ++t) {
            const size_t p0 = (size_t)__builtin_amdgcn_readlane(tl, 8 * t) * 256 + (size_t)__builtin_amdgcn_readlane(w, 8 * t + 4), p1 = (size_t)__builtin_amdgcn_readlane(tl, 8 * t + 1) * 256 + (size_t)__builtin_amdgcn_readlane(w, 8 * t + 5);
            const bf16* xr = X1B + (size_t)(m0 + t) * PX + 4 * lane; const unsigned* ya = (const unsigned*)(YE + p0 * DM) + lane; const unsigned* yb = (const unsigned*)(YE + p1 * DM) + lane;
#pragma unroll
            for (int q = 0; q < 4; ++q) { xv[t][q] = *(const u32x2*)(xr + 256 * q); y0[t][q] = ya[64 * q]; y1[t][q] = yb[64 * q]; } }
#pragma unroll
        for (int t = 0; t < CTPT; ++t) { float* o = out + (size_t)(m0 + t) * DM + 4 * lane;
#pragma unroll
            for (int q = 0; q < 4; ++q) { const unsigned wa = y0[t][q], wb = y1[t][q]; const unsigned xa = xv[t][q].x, xb = xv[t][q].y;
                const f32x2 a0 = __builtin_amdgcn_cvt_pk_f32_fp8((int)wa, false), a1 = __builtin_amdgcn_cvt_pk_f32_fp8((int)wa, true), b0 = __builtin_amdgcn_cvt_pk_f32_fp8((int)wb, false), b1 = __builtin_amdgcn_cvt_pk_f32_fp8((int)wb, true);
                f32x4 r; r.x = bf2f(xa & 0xffff) + (a0.x + b0.x) * (1.f / YE_SCALE); r.y = bf2f(xa >> 16) + (a0.y + b0.y) * (1.f / YE_SCALE);
                r.z = bf2f(xb & 0xffff) + (a1.x + b1.x) * (1.f / YE_SCALE); r.w = bf2f(xb >> 16) + (a1.y + b1.y) * (1.f / YE_SCALE);
                *(f32x4*)(o + 256 * q) = r; } }
        w = wn;
    }
}

#ifndef STG1
#define STG1 0
#endif
#ifndef STG10
#define STG10 0
#endif
#ifndef STG11
#define STG11 0
#endif
#ifndef KREP1
#define KREP1 1
#endif
#ifndef KREP10
#define KREP10 1
#endif
#ifndef KREP11
#define KREP11 1
#endif
constexpr int NPHASE = 13;
__global__ void __launch_bounds__(NTHR, 2) mk_fwd(Args args) {
    extern __shared__ __attribute__((aligned(16))) unsigned char lds_raw[];
    Frame F;
    F.lds = (LAS unsigned char*)lds_raw; F.MISC = (volatile LAS unsigned*)(F.lds + MISC_OFF);
    F.tid = threadIdx.x; F.lane = F.tid & 63; F.wave = __builtin_amdgcn_readfirstlane(F.tid >> 6);
    F.G = gridDim.x; F.c = blockIdx.x; F.ctl = (unsigned*)(args.ws + WS_CTL);
    if (F.tid < 64) F.MISC[F.tid] = 0u;
    __syncthreads();
    XcdBarrier bar = xcd_barrier_post(F.ctl + CW_BAR, F.MISC + 8);
    const int lo = args.ph_lo, hi = args.ph_hi;
    unsigned char* ws = args.ws;
#ifndef PH_MASK
#define PH_MASK 0x1fff
#endif
#define IN(k) ((((PH_MASK) >> (k)) & 1) && lo <= (k) && (k) < hi)
#define SEAM(k) do { if (IN(k) && IN((k) + 1)) xcd_barrier(bar); } while (0)
#define REFRESH() do { int t_ = threadIdx.x; asm volatile("" : "+v"(t_)); F.tid = t_; F.lane = t_ & 63; F.wave = __builtin_amdgcn_readfirstlane(t_ >> 6); } while (0)
#ifndef REP_MASK
#define REP_MASK 0
#endif
#define REPS(k) _Pragma("unroll") for (int rep_ = 0; rep_ < ((((REP_MASK) >> (k)) & 1) ? 2 : 1); ++rep_)
    if (IN(0)) REPS(0) { REFRESH(); p0_prologue(F, args); } SEAM(0);
    if (IN(1)) REPS(1) { REFRESH();
        GemmP g{PX * 2, PW * 2, DM}; DenseOrder S{(const char*)(ws + FW_XN), (const char*)(ws + FW_WIN), (size_t)256 * PX * 2, (size_t)256 * PW * 2, M / 256, DIN / 256, (M / 256) * (DIN / 256), F.G, F.c};
        LAS float* GQK = (LAS float*)(F.lds + SCR2_OFF); if (F.tid < 128) GQK[F.tid] = (F.tid < 64) ? karg<13>()[F.tid] * C2 : karg<14>()[F.tid - 64];
        { LAS float* GF = (LAS float*)(F.lds + GF_OFF); GF[F.tid] = W8SC * karg<18>()[F.tid]; GF[F.tid + 512] = W8SC * karg<18>()[F.tid + 512]; } __syncthreads();
        EpiProj E{(bf16*)(ws + FW_U2), (bf16*)(ws + FW_Q), (const LAS float*)GQK, (F.G == 256) ? F.c * NWAVES : -1, ws};
        gemm_phase<EpiProj, DenseOrder, false, KREP1>(F.lds, g, S, E, nullptr, ((F.c >> 3) & 7) * STG1); } SEAM(1);
    if (IN(2)) REPS(2) { REFRESH();
        GemmP g{U2P * 2, 512 * 2, 512}; GroupOrder S{(const char*)(ws + FW_U2), (const char*)(ws + FW_W1), (size_t)NCH * U2P * 2, (size_t)256 * 512 * 2, (size_t)256 * U2P * 2, 0, NCH / 256, 1, NG * (NCH / 256), F.G, F.c};
        EpiState E{(float*)(ws + FW_SST)};
        gemm_phase(F.lds, g, S, E);
        if (F.G == NG * (NCH / 256)) s5_scan_local(F, args, F.c >> 3, F.c & 7); }
    if (F.G != NG * (NCH / 256)) SEAM(2);
    if (IN(3)) REPS(3) { REFRESH();
#ifndef NO_SCAN
        if (F.G != NG * (NCH / 256)) s5_scan(F, args);
#ifdef REP_SCAN
        s5_scan(F, args);
#endif
#endif
#ifndef NO_ATTN
        const bf16* Q = (const bf16*)(ws + FW_Q); const bf16* Kg = (const bf16*)(ws + FW_K); const bf16* Vg = (const bf16*)(ws + FW_V);
        attn_span_phase(F, Q, Kg, Vg, (bf16*)(ws + FW_MIX), (float*)(F.ctl + CW_SSQA));
#endif
    } SEAM(3);
    if (IN(4)) REPS(4) { REFRESH();
        GemmP g{U2P * 2, U2P * 2, U2P}; GroupOrder S{(const char*)(ws + FW_U2), (const char*)(ws + FW_TB), (size_t)NCH * U2P * 2, (size_t)512 * U2P * 2, (size_t)256 * U2P * 2, (size_t)256 * U2P * 2, NCH / 256, 2, NG * (NCH / 256) * 2, F.G, F.c};
        EpiS5 E{(bf16*)(ws + FW_Z)};
        gemm_phase(F.lds, g, S, E); } SEAM(4);
    if (IN(5)) REPS(5) { REFRESH();
        GemmP g{DSSM * 2, DSSM * 2, DSSM}; DenseOrder S{(const char*)(ws + FW_Z), (const char*)(ws + FW_WGLU), (size_t)256 * DSSM * 2, (size_t)256 * DSSM * 2, M / 256, 2, (M / 256) * 2, F.G, F.c};
        EpiGlu E{(const bf16*)(ws + FW_Z), karg<12>(), (bf16*)(ws + FW_MIX), (float*)(F.ctl + CW_SSQS)};
        gemm_phase(F.lds, g, S, E); } if (IN(5) && IN(7)) xcd_barrier(bar);
    if (IN(7)) REPS(7) { REFRESH();
        GemmP g{PX * 2, PW * 2, DM}; DenseOrder S{(const char*)(ws + FW_MIX), (const char*)(ws + FW_WOUT), (size_t)256 * PX * 2, (size_t)256 * PW * 2, M / 256, 4, (M / 256) * 4, F.G, F.c};
        EpiX1B E{(F.G == 256) ? F.c * NWAVES + 2048 * 8 : -1, ws, (const float*)(ws + FW_RSTDX), (bf16*)(ws + FW_X1B), (const float*)(F.ctl + CW_SSQS), (const float*)(F.ctl + CW_SSQA), (LAS float*)(F.lds + SCR2_OFF + 1024)};
        { LAS float* GF = (LAS float*)(F.lds + GF_OFF); GF[F.tid] = W8SC * karg<18>()[F.tid]; GF[F.tid + 512] = W8SC * karg<18>()[F.tid + 512]; }
        { Unit uu; for (int i = 0; i < 4 && S.next(i, uu); ++i) E.fill(i, uu.pm, F.tid); __syncthreads(); }
        gemm_phase(F.lds, g, S, E); } SEAM(7);
    if (IN(8)) { REFRESH(); router_phase(F, args); } if (IN(8) && IN(10)) xcd_barrier(bar);
    int ntiles = 0;
    if (IN(10) || IN(11) || IN(12)) { REFRESH(); ntiles = moe_tables(F); }
    if (IN(10)) REPS(10) { REFRESH();
        LAS int* RC = (LAS int*)(F.lds + SCR2_OFF + 1024); const unsigned* ETOK = (const unsigned*)(ws + FW_ETOK); const LAS int* TSTc = (const LAS int*)(F.lds + SCR2_OFF); const LAS unsigned char* T2Ec = F.lds + SCR2_OFF + 256;
        { unsigned v[5];
#pragma unroll
          for (int k = 0; k < 5; ++k) { const int j = F.tid + 512 * k, i = j >> 8, r = j & 255; v[k] = 0u;
              if ((long)i * F.G + F.c < (long)ntiles * 4) { int pm, pn; moe_unit(i * F.G + F.c, ntiles, pm, pn);
                  const int e = T2Ec[pm], idx = (pm - TSTc[e]) * 256 + r;
                  if (idx < TSTc[208 + e]) v[k] = ETOK[(size_t)e * M + idx]; } }
#pragma unroll
          for (int k = 0; k < 5; ++k) { const int j = F.tid + 512 * k; if ((long)(j >> 8) * F.G + F.c < (long)ntiles * 4) RC[j] = (int)v[k]; } }
        __syncthreads();
        GemmP g{DM, DM, DM / 2}; MoeOrder S{(const char*)(ws + FW_X1Q), (const char*)(ws + FW_WGU), (size_t)0, (size_t)DM * DM, (size_t)256 * DM, F.lds + SCR2_OFF + 256, ntiles, F.G, F.c};
        EpiGU E{(unsigned char*)(ws + FW_HH), (const LAS unsigned*)RC};
        gemm_phase<EpiGU, MoeOrder, true, KREP10, true>(F.lds, g, S, E, RC, ((F.c >> 3) & 7) * STG10); } SEAM(10);
    if (IN(11)) REPS(11) { REFRESH();
        LAS float* RGC = (LAS float*)(F.lds + SCR2_OFF + 1024); const float* EG = (const float*)(ws + FW_EG); const LAS int* TSTc = (const LAS int*)(F.lds + SCR2_OFF); const LAS unsigned char* T2Ec = F.lds + SCR2_OFF + 256;
        { float v[5];
#pragma unroll
          for (int k = 0; k < 5; ++k) { const int j = F.tid + 512 * k, i = j >> 8, r = j & 255; v[k] = 0.f;
              if ((long)i * F.G + F.c < (long)ntiles * 4) { int pm, pn; moe_unit(i * F.G + F.c, ntiles, pm, pn);
                  const int e = T2Ec[pm], idx = (pm - TSTc[e]) * 256 + r;
                  if (idx < TSTc[208 + e]) v[k] = EG[(size_t)e * M + idx]; } }
#pragma unroll
          for (int k = 0; k < 5; ++k) { const int j = F.tid + 512 * k; if ((long)(j >> 8) * F.G + F.c < (long)ntiles * 4) RGC[j] = v[k]; } }
        __syncthreads();
        GemmP g{DE, DE, DE / 2}; MoeOrder S{(const char*)(ws + FW_HH), (const char*)(ws + FW_WD), (size_t)256 * DE, (size_t)DM * DE, (size_t)256 * DE, F.lds + SCR2_OFF + 256, ntiles, F.G, F.c};
        EpiDown E{(unsigned char*)(ws + FW_YE), (const LAS float*)RGC};
        gemm_phase<EpiDown, MoeOrder, false, KREP11, true>(F.lds, g, S, E, nullptr, ((F.c >> 3) & 7) * STG11); } SEAM(11);
    if (IN(12)) REPS(12) { REFRESH(); combine_phase(F, args); }
#undef IN
#undef SEAM
}
}

extern "C" void kernel_launch(void* const* d_in, const int* in_sizes, int n_in, void* d_out, int out_size, void* d_ws, size_t ws_size, hipStream_t stream) {
    static int grid = 0;
    if (grid == 0) {
        if (n_in != 26 || out_size != M * DM || ws_size < mk::FW_END2) { fprintf(stderr, "kernel_launch: unexpected shapes (n_in %d out %d ws %zu, need %zu)\n", n_in, out_size, ws_size, (size_t)mk::FW_END2); grid = -1; return; }
        int dev = 0, cus = 0, per_cu = 0;
        if (hipGetDevice(&dev) != hipSuccess || hipDeviceGetAttribute(&cus, hipDeviceAttributeMultiprocessorCount, dev) != hipSuccess) { grid = -1; return; }
        if (hipFuncSetAttribute((const void*)mk::mk_fwd, hipFuncAttributeMaxDynamicSharedMemorySize, mk::LDS_BYTES) != hipSuccess) { fprintf(stderr, "kernel_launch: hipFuncSetAttribute failed\n"); grid = -1; return; }
        if (hipOccupancyMaxActiveBlocksPerMultiprocessor(&per_cu, (const void*)mk::mk_fwd, mk::NTHR, mk::LDS_BYTES) != hipSuccess || per_cu < 1) { fprintf(stderr, "kernel_launch: occupancy query says %d\n", per_cu); }
        (void)hipGetLastError();
        grid = cus;
        if (grid != 256) fprintf(stderr, "kernel_launch: %d CUs (built for 256)\n", grid);
    }
    if (grid < 0) return;
    mk::Args a{};
    for (int i = 0; i < 26; ++i) a.in[i] = (const float*)d_in[i];
    a.out = (float*)d_out; a.ws = (unsigned char*)d_ws; a.ph_lo = 0; a.ph_hi = mk::NPHASE;
    (void)hipMemsetAsync((unsigned char*)d_ws + WS_CTL, 0, mk::CTL_ZERO_BYTES, stream);
    hipLaunchKernelGGL(mk::mk_fwd, dim3(grid), dim3(mk::NTHR), mk::LDS_BYTES, stream, a);
}
```

```cpp
#define ASPAN_N 10
#define PADX 0

#include <hip/hip_runtime.h>
#include <cstdio>
#include <cstdint>

typedef unsigned short bf16;
typedef float f32x4 __attribute__((ext_vector_type(4)));
typedef unsigned u32x4 __attribute__((ext_vector_type(4)));
typedef unsigned u32x2 __attribute__((ext_vector_type(2)));

constexpr int DM = 1024, BATCH = 32, SEQ = 2048, M = BATCH * SEQ;
constexpr int DSSM = 512, NG = 32, GS = 16, PST = 64, HD = 64, DATT = 512, NH = 8, DIN = 2048;
constexpr int NEG = 4, EPG = 8, NE = 32, DE = 512;
constexpr float EPS = 1e-6f;
constexpr int LCH = 32;
constexpr int NCH = M / LCH;
constexpr int U2P = 640;
constexpr float C2 = 0.125f * 1.4426950408889634f;

constexpr size_t MiB = 1u << 20;
constexpr size_t WS_CTL = 0;
constexpr size_t WS_TOK = 2 * MiB;
constexpr size_t WS_XN = 8 * MiB;
constexpr size_t WS_Q = WS_XN + 128 * MiB;
constexpr size_t WS_K = WS_Q + 64 * MiB;
constexpr size_t WS_V = WS_K + 64 * MiB;
constexpr size_t WS_U2 = WS_V + 64 * MiB;
constexpr size_t WS_Z = WS_U2 + 80 * MiB;
constexpr size_t WS_YS = WS_Z + 64 * MiB;
constexpr size_t WS_YA = WS_YS + 64 * MiB;
constexpr size_t WS_MIX = WS_YA + 64 * MiB;
constexpr size_t WS_H2 = WS_XN;
constexpr size_t WS_PROJ = WS_Z;
constexpr size_t WS_END = WS_PROJ + 512 * MiB;

__device__ __forceinline__ unsigned f2bf(float f) { unsigned u = __builtin_bit_cast(unsigned, f); return (u + 0x7fffu + ((u >> 16) & 1u)) >> 16; }
__device__ __forceinline__ float bf2f(unsigned short h) { return __builtin_bit_cast(float, (unsigned)h << 16); }
__device__ __forceinline__ unsigned pk2(float lo, float hi) { return f2bf(lo) | (f2bf(hi) << 16); }
template <int CTRL> __device__ __forceinline__ float dppf(float x) { return __builtin_bit_cast(float, __builtin_amdgcn_update_dpp(0, __builtin_bit_cast(int, x), CTRL, 0xF, 0xF, true)); }
template <int CTRL> __device__ __forceinline__ unsigned dppu(unsigned x) { return (unsigned)__builtin_amdgcn_update_dpp(0, (int)x, CTRL, 0xF, 0xF, true); }
__device__ __forceinline__ float xor16_sum(float v) { const unsigned u = __builtin_bit_cast(unsigned, v); auto r = __builtin_amdgcn_permlane16_swap(u, u, false, false); return __builtin_bit_cast(float, (unsigned)r[0]) + __builtin_bit_cast(float, (unsigned)r[1]); }
__device__ __forceinline__ float xor32_sum(float v) { const unsigned u = __builtin_bit_cast(unsigned, v); auto r = __builtin_amdgcn_permlane32_swap(u, u, false, false); return __builtin_bit_cast(float, (unsigned)r[0]) + __builtin_bit_cast(float, (unsigned)r[1]); }
__device__ __forceinline__ unsigned xor16_get(unsigned u, bool odd_row) { auto r = __builtin_amdgcn_permlane16_swap(u, u, false, false); return odd_row ? (unsigned)r[0] : (unsigned)r[1]; }
__device__ __forceinline__ float wave_sum(float v) {
    v += dppf<0xB1>(v); v += dppf<0x4E>(v); v += dppf<0x141>(v); v += dppf<0x140>(v);
    return xor32_sum(xor16_sum(v));
}
__device__ __forceinline__ void sincos_d(double th, double& s, double& c) {
    const double q = rint(th * 0.63661977236758134308);
    const double r = (th - q * 1.57079632679489655800) - q * 6.12323399573676603587e-17;
    const double r2 = r * r;
    double sp = -1.0 / 1307674368000.0; sp = sp * r2 + 1.0 / 6227020800.0; sp = sp * r2 - 1.0 / 39916800.0; sp = sp * r2 + 1.0 / 362880.0; sp = sp * r2 - 1.0 / 5040.0; sp = sp * r2 + 1.0 / 120.0; sp = sp * r2 - 1.0 / 6.0; sp = sp * r2 + 1.0;
    const double sn = sp * r;
    double cp = 1.0 / 20922789888000.0; cp = cp * r2 - 1.0 / 87178291200.0; cp = cp * r2 + 1.0 / 479001600.0; cp = cp * r2 - 1.0 / 3628800.0; cp = cp * r2 + 1.0 / 40320.0; cp = cp * r2 - 1.0 / 720.0; cp = cp * r2 + 1.0 / 24.0; cp = cp * r2 - 0.5; cp = cp * r2 + 1.0;
    const int qi = ((int)q) & 3;
    s = (qi == 0) ? sn : (qi == 1) ? cp : (qi == 2) ? -sn : -cp;
    c = (qi == 0) ? cp : (qi == 1) ? -sn : (qi == 2) ? -cp : sn;
}
__device__ __forceinline__ float gelu_tanh(float x) {
    constexpr float K1 = -2.885390081777927f * 0.7978845608028654f, K3 = K1 * 0.044715f;
    const float e = __builtin_amdgcn_exp2f(x * (K1 + K3 * (x * x)));
    return x * __builtin_amdgcn_rcpf(1.f + e);
}
__device__ __forceinline__ float sigmoidf_(float x) { return __builtin_amdgcn_rcpf(1.f + __builtin_amdgcn_exp2f(-1.4426950408889634f * x)); }


#include <type_traits>
namespace mk {
#define LAS __attribute__((address_space(3)))
#define GAS __attribute__((address_space(1)))
typedef short bf16x8 __attribute__((ext_vector_type(8)));
typedef short s16x4 __attribute__((ext_vector_type(4)));
typedef float f32x16 __attribute__((ext_vector_type(16)));
typedef float f32x2 __attribute__((ext_vector_type(2)));
typedef __bf16 bf16x2_t __attribute__((ext_vector_type(2)));
typedef GAS unsigned gu32;

constexpr int NWAVES = 8, NTHR = 512;
constexpr int RING_BYTES = 131072, SCR2_OFF = RING_BYTES, SCR2_BYTES = 16128, MISC_OFF = SCR2_OFF + SCR2_BYTES, GF_OFF = MISC_OFF + 256, LDS_BYTES = GF_OFF + 4096;
static_assert(GF_OFF == 147456 && LDS_BYTES <= 163840, "LDS map");

#ifndef PADX
#define PADX 64
#endif
constexpr int PX = DM + PADX;
constexpr int PW = DM + PADX;
constexpr size_t FW_TOK = 2 * MiB, FW_WIN = 4 * MiB, FW_WOUT = 9 * MiB, FW_WGLU = 12 * MiB - 512 * 1024, FW_WR = 12 * MiB, FW_TB = 13 * MiB, FW_W1 = 33 * MiB,
                 FW_WGU = 41 * MiB, FW_WD = 110 * MiB, FW_SST = 142 * MiB, FW_XN = 174 * MiB, FW_Q = 310 * MiB, FW_K = 374 * MiB, FW_V = 438 * MiB, FW_U2 = 502 * MiB,
                 FW_Z = 582 * MiB, FW_MIX = 646 * MiB, FW_ROW = 782 * MiB, FW_END2 = 784 * MiB,
                 FW_X1B = FW_XN, FW_HH = 582 * MiB, FW_YE = FW_Q;
static_assert(FW_WIN + (size_t)DIN * PW * 2 <= FW_WOUT && FW_WOUT + (size_t)DM * PW * 2 <= FW_WGLU && FW_WGU + (size_t)NE * DM * PW * 2 <= FW_WD && FW_XN + (size_t)M * PX * 2 <= FW_Q && FW_MIX + (size_t)M * PX * 2 <= FW_ROW, "padded buffers");
static_assert(FW_K - FW_Q == (size_t)M * 512 * 2 && FW_V - FW_K == (size_t)M * 512 * 2, "Q|K|V contiguous");
constexpr size_t FW_RSTDX = FW_ROW + 3 * (size_t)(544 * 256) * 4;
constexpr size_t FW_ETOK = FW_SST, FW_EG = FW_SST + (size_t)NE * M * 4;
static_assert(FW_EG + (size_t)NE * M * 4 <= FW_XN, "expert lists");
constexpr float W8SC = 64.f;
constexpr size_t FW_X1Q = FW_U2;
static_assert(FW_X1Q + (size_t)M * DM <= FW_HH && FW_YE + (size_t)(544 * 256) * DM <= FW_X1Q && FW_HH + (size_t)(544 * 256) * DE <= FW_ROW, "X1Q / HH / YE must not overlap");
constexpr size_t FW_A32 = FW_WR + 256 * 1024;
constexpr int MAXTILES = 544, MAXROWS = MAXTILES * 256;
static_assert(FW_RSTDX + (size_t)M * 4 <= FW_END2, "row arrays");
static_assert(FW_YE + (size_t)MAXROWS * DM <= FW_U2 && FW_HH + (size_t)MAXROWS * DE * 2 <= FW_ROW, "MoE overlay");
constexpr int CW_TMO = 0, CW_CNT = 64, CW_BAR = 4096, CW_SSQS = 65536, CW_SSQA = 131072;
static_assert((CW_SSQA + M) * 4 <= (int)(1 * MiB), "ssq arrays inside the memset region");
constexpr size_t CTL_ZERO_BYTES = 1 * MiB;

#define RLX_AGENT __ATOMIC_RELAXED, __HIP_MEMORY_SCOPE_AGENT
__device__ __forceinline__ unsigned cvtpk(float lo, float hi) { f32x2 v = {lo, hi}; bf16x2_t b = __builtin_convertvector(v, bf16x2_t); return __builtin_bit_cast(unsigned, b); }

#define XB_TMO      128
#define XB_XCNT(j)  (256  + 64 * (j))
#define XB_XSUB(j)  (1280 + 64 * (j))
#define XB_XGEN(j)  (2304 + 64 * (j))
#define XB_TOP      3328
#define XB_TOPGEN   3392
#define XCD_BAR_WORDS 3456
#define XB_SPIN_CAP (1u << 18)
__device__ __forceinline__ unsigned xb_ld(unsigned* p)              { return __hip_atomic_load(p, __ATOMIC_RELAXED, __HIP_MEMORY_SCOPE_AGENT); }
__device__ __forceinline__ unsigned xb_add(unsigned* p, unsigned v) { return __hip_atomic_fetch_add(p, v, __ATOMIC_RELAXED, __HIP_MEMORY_SCOPE_AGENT); }
__device__ __forceinline__ unsigned xb_xcc_id() { return (unsigned)__builtin_amdgcn_s_getreg((3 << 11) | 20) & 0xFu; }
#define XB_SPIN(cond, bar) do { unsigned _sp = 0; while (cond) { __builtin_amdgcn_s_sleep(1); \
    if ((++_sp & 255u) == 0u) { if (xb_ld(&(bar)[XB_TMO])) break; if (_sp > XB_SPIN_CAP) { atomicAdd(&(bar)[XB_TMO], 1u); break; } } } } while (0)
struct XcdBarrier { unsigned* bar; unsigned x; volatile LAS unsigned* st; };
__device__ __forceinline__ XcdBarrier xcd_barrier_post(unsigned* bar, volatile LAS unsigned* st) {
    XcdBarrier b; b.bar = bar; b.x = xb_xcc_id(); b.st = st;
    if (threadIdx.x == 0) (void)xb_add(&bar[XB_XCNT(b.x)], 1u);
    return b;
}
__device__ __forceinline__ void xcd_barrier_complete(unsigned* bar, unsigned x, unsigned& nloc, unsigned& nx) {
    const unsigned G = gridDim.x * gridDim.y * gridDim.z;
    unsigned sum, cnt, mine, sp = 0u;
    for (;;) {
        sum = 0u; cnt = 0u; mine = 0u;
#pragma unroll
        for (unsigned j = 0; j < 16; ++j) { const unsigned c = xb_ld(&bar[XB_XCNT(j)]); sum += c; cnt += (c > 0u) ? 1u : 0u; mine = (j == x) ? c : mine; }
        if (sum == G) break;
        __builtin_amdgcn_s_sleep(1);
        if ((++sp & 255u) == 0u) { if (xb_ld(&bar[XB_TMO])) break; if (sp > XB_SPIN_CAP) { atomicAdd(&bar[XB_TMO], 1u); break; } }
    }
    nloc = mine > 0u ? mine : 1u; nx = cnt > 0u ? cnt : 1u;
}
__device__ __forceinline__ void xcd_barrier(const XcdBarrier& b) {
    asm volatile("s_waitcnt vmcnt(0)" ::: "memory");
    __syncthreads();
    if (threadIdx.x == 0) {
        unsigned* bar = b.bar;
        __builtin_amdgcn_s_waitcnt(0);
        unsigned nloc = b.st[0], nx = b.st[1];
        if (nloc == 0u) { xcd_barrier_complete(bar, b.x, nloc, nx); b.st[0] = nloc; b.st[1] = nx; }
        const unsigned old = xb_add(&bar[XB_XSUB(b.x)], 1u);
        const unsigned gen = old / nloc;
        if (old + 1u == (gen + 1u) * nloc) {
            __builtin_amdgcn_fence(__ATOMIC_RELEASE, "agent");
            asm volatile("s_waitcnt vmcnt(0)" ::: "memory");
            const unsigned og = xb_add(&bar[XB_TOP], 1u);
            const unsigned tg = og / nx;
            if (og + 1u == (tg + 1u) * nx) xb_add(&bar[XB_TOPGEN], 1u);
            else XB_SPIN(xb_ld(&bar[XB_TOPGEN]) == tg, bar);
            __builtin_amdgcn_fence(__ATOMIC_ACQUIRE, "agent");
            xb_add(&bar[XB_XGEN(b.x)], 1u);
            asm volatile("s_waitcnt vmcnt(0)" ::: "memory");
        } else {
            XB_SPIN(xb_ld(&bar[XB_XGEN(b.x)]) == gen, bar);
            __builtin_amdgcn_fence(__ATOMIC_ACQUIRE, "agent");
            asm volatile("s_waitcnt vmcnt(0)" ::: "memory");
        }
    }
    __syncthreads();
}

__device__ __forceinline__ unsigned pk4_fp8(float a, float b, float c, float d) { int w = 0; w = __builtin_amdgcn_cvt_pk_fp8_f32(a, b, w, false); w = __builtin_amdgcn_cvt_pk_fp8_f32(c, d, w, true); return (unsigned)w; }
template <int K> __device__ __forceinline__ const float* karg();
struct SideItem { const float* W; unsigned char* WT; int ldw, srccol0, ldt, dstrow0, k0, scaled; };
__device__ __forceinline__ SideItem moe_side_item(int r) {
    unsigned char* ws;
    asm volatile("s_load_dwordx2 %0, %1, 216\n\ts_waitcnt lgkmcnt(0)" : "=s"(ws) : "s"(__builtin_amdgcn_kernarg_segment_ptr()) : "memory");
    if (r < 16384) { const int e = r >> 9, q = r & 511, kb = q >> 5, d = q & 31, pn = d >> 3, beta = d & 7;
        const float* W = (beta < 4 ? karg<23>() : karg<24>()) + (size_t)e * DM * DE;
        return SideItem{W, ws + FW_WGU + (size_t)e * DM * DM, DE, 128 * pn + 32 * (beta & 3), DM, 32 * d, 64 * kb, 1}; }
    r -= 16384; const int e = r >> 8, q = r & 255, kb = q >> 5, d = q & 31;
    return SideItem{karg<25>() + (size_t)e * DE * DM, ws + FW_WD + (size_t)e * DM * DE, DM, 32 * (8 * (d >> 3) + 2 * (d & 3) + ((d & 7) >> 2)), DE, 32 * d, 64 * kb, 0};
}
__device__ __forceinline__ void side_load(const SideItem& t, int lane, int hb, f32x4 (&v)[4]) {
    asm volatile("" : "+v"(lane));
    const int kh = lane >> 3, nq = lane & 7;
#pragma unroll
    for (int i = 0; i < 4; ++i) v[i] = *(const GAS f32x4*)(t.W + (size_t)(t.k0 + 8 * kh + 4 * hb + i) * t.ldw + t.srccol0 + 4 * nq);
}
__device__ __forceinline__ void side_store(const SideItem& t, int lane, int hb, const f32x4 (&v)[4], const LAS float* GF) {
    asm volatile("" : "+v"(lane));
    const int kh = lane >> 3, nq = lane & 7;
    f32x4 g0 = (f32x4){W8SC, W8SC, W8SC, W8SC};
    if (t.scaled) g0 = *(const LAS f32x4*)(GF + t.k0 + 8 * kh + 4 * hb);
#pragma unroll
    for (int e = 0; e < 4; ++e)
        *(unsigned*)(t.WT + (size_t)(t.dstrow0 + 4 * nq + e) * t.ldt + t.k0 + 8 * kh + 4 * hb) = pk4_fp8(v[0][e] * g0.x, v[1][e] * g0.y, v[2][e] * g0.z, v[3][e] * g0.w);
}
constexpr int BM = 256, BK = 64, HALF = 128, HTB = HALF * BK * 2;
__device__ __forceinline__ int lds_byte(int r, int c) { const int st = (r >> 4) * 2 + (c >> 5), rr = r & 15, cc = c & 31, ob = rr * 64 + cc * 2; return st * 1024 + (ob ^ (((ob >> 9) & 1) << 5)); }
__device__ __forceinline__ void stage_rc(int b, int& R, int& C) { const int st = b / 1024, sb = b % 1024, swz = sb ^ (((sb >> 9) & 1) << 5); R = (st >> 1) * 16 + swz / 64; C = (st & 1) * 32 + (swz % 64) / 2; }
__device__ __forceinline__ int perm32(int rho) { const int n = rho >> 4, i = rho & 15; return 8 * (i >> 2) + 4 * n + (i & 3); }
struct Unit { const char* a; const char* b; int pm, pn, aux; };
struct GemmP { int lda_b, ldb_b, K; };

template <class Epi, class Sched, bool GATHER = false, int KREP = 1, bool FP8 = false>
__device__ __forceinline__ void gemm_phase(LAS unsigned char* lds, const GemmP g, const Sched& S, const Epi& E, const LAS int* rowcache = nullptr, int stagger_ticks = 0) {
    const int tid = threadIdx.x, wid = __builtin_amdgcn_readfirstlane(tid >> 6), lane = tid & 63, wr = wid >> 2, wc = wid & 3, fr = lane & 15, fq = lane >> 4;
    const int ntk = g.K / BK, nt = ntk * (KREP == 3 ? 1 : KREP);
    unsigned voffA[2], voffB[2]; int gR[2], gC[2];
#pragma unroll
    for (int i = 0; i < 2; ++i) { int R, C; stage_rc(tid * 16 + i * 8192, R, C); const int Rb = Epi::PERM ? ((R & ~31) + perm32(R & 31)) : R; gR[i] = R; gC[i] = C * 2;
        voffA[i] = (unsigned)(R * g.lda_b + C * 2); voffB[i] = (unsigned)(Rb * g.ldb_b + C * 2); }
    unsigned vc0[2] = {voffA[0], voffA[1]}, vc1[2] = {voffA[0], voffA[1]}, vn0[2] = {voffA[0], voffA[1]}, vn1[2] = {voffA[0], voffA[1]};
#define PG8_GOFF(dst0, dst1, ui_) do { _Pragma("unroll") for (int _i = 0; _i < 2; ++_i) { \
        dst0[_i] = ((unsigned)rowcache[(ui_) * 256 + gR[_i]] & 0xffffu) * (unsigned)g.lda_b + (unsigned)gC[_i]; dst1[_i] = ((unsigned)rowcache[(ui_) * 256 + 128 + gR[_i]] & 0xffffu) * (unsigned)g.lda_b + (unsigned)gC[_i]; } } while (0)
    const size_t kstep = (size_t)(BK * 2);
    const size_t hstepA = GATHER ? 0 : (size_t)HALF * g.lda_b, hstepB = (size_t)HALF * g.ldb_b;
    const unsigned ldsw = (unsigned)wid * 1024u;
    const int aoff = lds_byte(wr * 64 + fr, fq * 8), boff = lds_byte(wc * 32 + fr, fq * 8);
#ifndef OPAQ_VO
#define OPAQ_VO 1
#endif
#define PG8_SA(b, h) (((b) * 2 + (h)) * HTB)
#define PG8_SB(b, h) ((4 + (b) * 2 + (h)) * HTB)
#define PG8_STAGE(bufoff, gbase, voff) do { _Pragma("unroll") for (int _i = 0; _i < 2; ++_i) { unsigned _vo = (voff)[_i]; if (OPAQ_VO) asm volatile("" : "+v"(_vo)); \
        __builtin_amdgcn_global_load_lds((const unsigned*)((const char*)(gbase) + _vo), (LAS unsigned*)(lds + (bufoff) + ldsw + _i * 8192), 16, 0, 0); } } while (0)
#define PG8_LDA(dst, b, h) do { _Pragma("unroll") for (int m = 0; m < 4; ++m) { const LAS unsigned char* p_ = lds + PG8_SA(b, h) + aoff + m * 2048; \
        if constexpr (FP8) { dst[m].v.lo = *(const LAS v4i_*)p_; dst[m].v.hi = *(const LAS v4i_*)(p_ + 1024); } else { dst[m].v[0] = *(const LAS bf16x8*)p_; dst[m].v[1] = *(const LAS bf16x8*)(p_ + 1024); } } } while (0)
#define PG8_LDB(dst, b, h) do { _Pragma("unroll") for (int n = 0; n < 2; ++n) { const LAS unsigned char* p_ = lds + PG8_SB(b, h) + boff + n * 2048; \
        if constexpr (FP8) { dst[n].v.lo = *(const LAS v4i_*)p_; dst[n].v.hi = *(const LAS v4i_*)(p_ + 1024); } else { dst[n].v[0] = *(const LAS bf16x8*)p_; dst[n].v[1] = *(const LAS bf16x8*)(p_ + 1024); } } } while (0)
#define PG8_MMA(ai, bj, At, Bt) do { if (Epi::HALFN && (bj) == 1) break; __builtin_amdgcn_s_setprio(1); \
        if constexpr (FP8) { asm volatile("s_nop 1\n\t" "v_mfma_scale_f32_16x16x128_f8f6f4 %0, %8, %10, %0, %14, %14 op_sel_hi:[0,0,0]\n\t" "v_mfma_scale_f32_16x16x128_f8f6f4 %1, %9, %10, %1, %14, %14 op_sel_hi:[0,0,0]\n\t" "v_mfma_scale_f32_16x16x128_f8f6f4 %2, %8, %11, %2, %14, %14 op_sel_hi:[0,0,0]\n\t" "v_mfma_scale_f32_16x16x128_f8f6f4 %3, %9, %11, %3, %14, %14 op_sel_hi:[0,0,0]\n\t" "v_mfma_scale_f32_16x16x128_f8f6f4 %4, %8, %12, %4, %14, %14 op_sel_hi:[0,0,0]\n\t" "v_mfma_scale_f32_16x16x128_f8f6f4 %5, %9, %12, %5, %14, %14 op_sel_hi:[0,0,0]\n\t" "v_mfma_scale_f32_16x16x128_f8f6f4 %6, %8, %13, %6, %14, %14 op_sel_hi:[0,0,0]\n\t" "v_mfma_scale_f32_16x16x128_f8f6f4 %7, %9, %13, %7, %14, %14 op_sel_hi:[0,0,0]\n\t" "s_nop 1" \
            : "+v"(acc[ai][bj][0][0]), "+v"(acc[ai][bj][0][1]), "+v"(acc[ai][bj][1][0]), "+v"(acc[ai][bj][1][1]), "+v"(acc[ai][bj][2][0]), "+v"(acc[ai][bj][2][1]), "+v"(acc[ai][bj][3][0]), "+v"(acc[ai][bj][3][1]) \
            : "v"(Bt[0].v), "v"(Bt[1].v), "v"(At[0].v), "v"(At[1].v), "v"(At[2].v), "v"(At[3].v), "v"(mxs)); } \
        else { _Pragma("unroll") for (int m = 0; m < 4; ++m) _Pragma("unroll") for (int n = 0; n < 2; ++n) _Pragma("unroll") for (int k = 0; k < 2; ++k) \
            acc[ai][bj][m][n] = __builtin_amdgcn_mfma_f32_16x16x32_bf16(Bt[n].v[k], At[m].v[k], acc[ai][bj][m][n], 0, 0, 0); } \
        __builtin_amdgcn_s_setprio(0); } while (0)
#define PG8_WAIT_V(n) asm volatile("s_waitcnt vmcnt(" #n ")" ::: "memory")
#define PG8_WAIT_L(n) asm volatile("s_waitcnt lgkmcnt(" #n ")" ::: "memory")
#define PG8_BAR __builtin_amdgcn_s_barrier()
#define PG8_SCHED __builtin_amdgcn_sched_barrier(0)
    int mxs = 0x7F7F7F7F; asm volatile("" : "+v"(mxs));
    Unit cur, nxt; int ui = 0;
    if (!S.next(0, cur)) return;
    if (stagger_ticks > 0) { const unsigned long long t0 = __builtin_amdgcn_s_memrealtime(); while ((long long)(__builtin_amdgcn_s_memrealtime() - t0) < (long long)stagger_ticks) __builtin_amdgcn_s_sleep(8); }
    f32x4 acc[2][2][4][2];
#pragma unroll
    for (int a = 0; a < 2; ++a)
#pragma unroll
        for (int b = 0; b < 2; ++b)
#pragma unroll
            for (int m = 0; m < 4; ++m)
#pragma unroll
                for (int n = 0; n < 2; ++n) acc[a][b][m][n] = (f32x4){0.f, 0.f, 0.f, 0.f};
    typedef int v4i_ __attribute__((ext_vector_type(4))); typedef int v8i_ __attribute__((ext_vector_type(8)));
    struct FragB { bf16x8 v[2]; }; struct Frag8 { v8i_ v; };
    typename std::conditional<FP8, Frag8, FragB>::type At[4], B0[2], B1[2];
    const char* cA = cur.a; const char* cB = cur.b;
    if (GATHER) { PG8_GOFF(vc0, vc1, 0); }
    PG8_STAGE(PG8_SB(0, 0), cB, voffB); PG8_STAGE(PG8_SB(0, 1), cB + hstepB, voffB); PG8_STAGE(PG8_SA(0, 0), cA, vc0); PG8_STAGE(PG8_SA(0, 1), cA + hstepA, vc1);
    if (wr == 1) PG8_BAR;
    PG8_WAIT_V(2); PG8_BAR;
    PG8_STAGE(PG8_SB(1, 0), cB + kstep, voffB); PG8_STAGE(PG8_SA(1, 0), cA + kstep, vc0); PG8_STAGE(PG8_SB(1, 1), cB + hstepB + kstep, voffB);
    PG8_WAIT_V(6); PG8_BAR;
    for (;;) {
        const bool has_next = S.next(ui + 1, nxt);
        const char* nA = has_next ? nxt.a : cA; const char* nB = has_next ? nxt.b : cB;
        if constexpr (Epi::HOOKS) E.begin(cur, ui, tid);
        if (GATHER) { if (has_next) { PG8_GOFF(vn0, vn1, ui + 1); } else { vn0[0] = vc0[0]; vn0[1] = vc0[1]; vn1[0] = vc1[0]; vn1[1] = vc1[1]; } }
        for (int t = 0; t < nt; t += 2) {
            const bool last = (t == nt - 2);
            if constexpr (Epi::HOOKS) { if (t == nt / 2) E.mid(acc, ui, wr, fr); }
#ifdef PROBE_EPI_TWICE
            if constexpr (KREP == 3) { if (t == ntk / 2) E.fin(acc, cur, ui, wr, wc, fr, fq); }
#endif
            const char* a1 = cA + (size_t)((t + 1) % ntk) * kstep;
            const char* a2 = last ? nA : cA + (size_t)((t + 2) % ntk) * kstep; const char* b2 = last ? nB : cB + (size_t)((t + 2) % ntk) * kstep;
            const char* a3 = a2 + kstep; const char* b3 = b2 + kstep;
            unsigned w0[2], w1[2];
            w0[0] = (GATHER && last) ? vn0[0] : vc0[0]; w0[1] = (GATHER && last) ? vn0[1] : vc0[1]; w1[0] = (GATHER && last) ? vn1[0] : vc1[0]; w1[1] = (GATHER && last) ? vn1[1] : vc1[1];
            PG8_LDB(B0, 0, 0); PG8_LDB(B1, 0, 1); PG8_SCHED; PG8_LDA(At, 0, 0); PG8_STAGE(PG8_SA(1, 1), a1 + hstepA, vc1);
            PG8_WAIT_V(8); PG8_WAIT_L(0); PG8_BAR; PG8_MMA(0, 0, At, B0); PG8_MMA(0, 1, At, B1); PG8_BAR; PG8_SCHED;
            PG8_LDA(At, 0, 1); PG8_STAGE(PG8_SB(0, 0), b2, voffB); PG8_STAGE(PG8_SB(0, 1), b2 + hstepB, voffB); PG8_STAGE(PG8_SA(0, 0), a2, w0);
            PG8_WAIT_V(8); PG8_WAIT_L(0); PG8_BAR; PG8_MMA(1, 0, At, B0); PG8_MMA(1, 1, At, B1); PG8_BAR; PG8_SCHED;
            PG8_LDB(B0, 1, 0); PG8_LDB(B1, 1, 1); PG8_SCHED; PG8_LDA(At, 1, 0); PG8_STAGE(PG8_SA(0, 1), a2 + hstepA, w1);
            PG8_WAIT_V(8); PG8_WAIT_L(0); PG8_BAR; PG8_MMA(0, 0, At, B0); PG8_MMA(0, 1, At, B1); PG8_BAR; PG8_SCHED;
            PG8_LDA(At, 1, 1); PG8_STAGE(PG8_SB(1, 0), b3, voffB); PG8_STAGE(PG8_SB(1, 1), b3 + hstepB, voffB); PG8_STAGE(PG8_SA(1, 0), a3, w0);
            PG8_WAIT_V(8); PG8_WAIT_L(0); PG8_BAR; PG8_MMA(1, 0, At, B0); PG8_MMA(1, 1, At, B1); PG8_BAR; PG8_SCHED;
        }
        if (wr == 0) PG8_BAR;
        if constexpr (FP8) asm volatile("s_nop 15\n\ts_nop 7" ::: "memory");
        if constexpr (KREP > 1) {
#pragma unroll
            for (int a = 0; a < 2; ++a)
#pragma unroll
                for (int b = 0; b < 2; ++b)
#pragma unroll
                    for (int m = 0; m < 4; ++m)
#pragma unroll
                        for (int n = 0; n < 2; ++n) acc[a][b][m][n] = acc[a][b][m][n] * (KREP == 3 ? 1.f : 1.f / KREP); }
        if constexpr (Epi::SIDE) {
            constexpr int SIDE_MODE = Epi::SIDE_WHOLE ? 1 : 0;
            SideItem sit; f32x4 sv[4], sw[4]; const bool side = (E.side_r0 >= 0);
            if (side) { sit = moe_side_item(E.side_r0 + wid + 2048 * ui); side_load(sit, lane, 0, sv); if (SIDE_MODE == 1) side_load(sit, lane, 1, sw); }
            asm volatile("" ::: "memory"); PG8_SCHED;
            if constexpr (Epi::HOOKS) E.template finh<0>(acc, cur, ui, wr, wc, fr, fq); else E.template half<0>(acc, cur, wr, wc, fr, fq);
            asm volatile("" ::: "memory"); PG8_SCHED;
            if (side && SIDE_MODE == 0) { side_store(sit, lane, 0, sv, (const LAS float*)(lds + GF_OFF)); side_load(sit, lane, 1, sw); }
            asm volatile("" ::: "memory"); PG8_SCHED;
            if constexpr (Epi::HOOKS) E.template finh<1>(acc, cur, ui, wr, wc, fr, fq); else E.template half<1>(acc, cur, wr, wc, fr, fq);
            asm volatile("" ::: "memory"); PG8_SCHED;
            if (side) { if (SIDE_MODE == 1) side_store(sit, lane, 0, sv, (const LAS float*)(lds + GF_OFF)); side_store(sit, lane, 1, sw, (const LAS float*)(lds + GF_OFF)); }
        } else { if constexpr (Epi::HOOKS) E.fin(acc, cur, ui, wr, wc, fr, fq); else E(acc, cur, wr, wc, fr, fq); }
        if (!has_next) break;
#pragma unroll
        for (int a = 0; a < 2; ++a)
#pragma unroll
            for (int b = 0; b < 2; ++b)
#pragma unroll
                for (int m = 0; m < 4; ++m)
#pragma unroll
                    for (int n = 0; n < 2; ++n) acc[a][b][m][n] = (f32x4){0.f, 0.f, 0.f, 0.f};
        cur = nxt; cA = nA; cB = nB; ++ui;
        if (GATHER) { vc0[0] = vn0[0]; vc0[1] = vn0[1]; vc1[0] = vn1[0]; vc1[1] = vn1[1]; }
        if (wr == 1) PG8_BAR;
    }
    PG8_WAIT_V(0);
    PG8_BAR;
#undef PG8_GOFF
#undef PG8_SA
#undef PG8_SB
#undef PG8_STAGE
#undef PG8_LDA
#undef PG8_LDB
#undef PG8_MMA
#undef PG8_WAIT_V
#undef PG8_WAIT_L
#undef PG8_BAR
#undef PG8_SCHED
}

struct DenseOrder {
    const char* A; const char* B; size_t a_tile, b_tile; int nM, nN, nwg, G, c;
    __device__ __forceinline__ bool next(int i, Unit& u) const {
        const long L = (long)i * G + c; if (L >= nwg) return false;
        int wgid = (int)L; { const int q = nwg / 8, r = nwg % 8, xcd = wgid % 8, off = wgid / 8; wgid = (xcd < r ? xcd * (q + 1) : r * (q + 1) + (xcd - r) * q) + off; }
        const int nig = 8 * nN, gid = wgid / nig, fm = gid * 8, gsz = (nM - fm) < 8 ? (nM - fm) : 8;
        u.pm = fm + ((wgid % nig) % gsz); u.pn = (wgid % nig) / gsz; u.aux = 0;
        u.a = A + (size_t)u.pm * a_tile; u.b = B + (size_t)u.pn * b_tile; return true;
    }
};
struct GroupOrder {
    const char* A; const char* B; size_t a_grp, b_grp, a_tile, b_tile; int nM, nN, nwg, G, c;
    __device__ __forceinline__ bool next(int i, Unit& u) const {
        const long L = (long)i * G + c; if (L >= nwg) return false;
        const int per = nM * nN, g = (int)L / per, r = (int)L % per;
        u.pn = r / nM; u.pm = r % nM; u.aux = g;
        u.a = A + (size_t)g * a_grp + (size_t)u.pm * a_tile; u.b = B + (size_t)g * b_grp + (size_t)u.pn * b_tile; return true;
    }
};
__device__ __forceinline__ void moe_unit(int L, int ntiles, int& pm, int& pn) {
    const int j = L >> 5, full = ntiles >> 3;
    if (j < full) { const int r = L & 31; pm = 8 * j + (r & 7); pn = r >> 3; }
    else { const int gsz = ntiles - 8 * full, r = L - 32 * full; pm = 8 * full + r % gsz; pn = r / gsz; }
}
struct MoeOrder {
    const char* A; const char* B; size_t a_tile, b_exp, b_tile; const LAS unsigned char* t2e; int ntiles, G, c;
    __device__ __forceinline__ bool next(int i, Unit& u) const {
        const long L = (long)i * G + c; if (L >= (long)ntiles * 4) return false;
        moe_unit((int)L, ntiles, u.pm, u.pn); u.aux = t2e[u.pm];
        u.a = A + (size_t)u.pm * a_tile; u.b = B + (size_t)u.aux * b_exp + (size_t)u.pn * b_tile; return true;
    }
};

typedef f32x4 Acc[2][2][4][2];
constexpr float YE_SCALE = 8.f;

__device__ __forceinline__ void store_pair(bf16* row_even, size_t pitch, u32x4 p0, u32x4 p1, int fr, int fq) {
    const bool odd = fr & 1;
    const u32x4 send = odd ? p0 : p1; u32x4 recv;
    recv.x = dppu<0xB1>(send.x); recv.y = dppu<0xB1>(send.y); recv.z = dppu<0xB1>(send.z); recv.w = dppu<0xB1>(send.w);
    const u32x4 a = odd ? recv : p0, b = odd ? p1 : recv;
    bf16* d = row_even + (odd ? 32 : 0) + 8 * fq;
#ifdef NT_STORES
    __builtin_nontemporal_store(a, (u32x4*)d); __builtin_nontemporal_store(b, (u32x4*)(d + pitch));
#else
    *(u32x4*)d = a; *(u32x4*)(d + pitch) = b;
#endif
}
struct EpiProj {
#ifndef SIDE_WHOLE1
#define SIDE_WHOLE1 1
#endif
    static constexpr bool HALFN = false, HOOKS = false, PERM = true, SIDE = true, SIDE_WHOLE = (SIDE_WHOLE1 != 0);
    bf16* U2; bf16* QKV; const LAS float* GQK; int side_r0; unsigned char* side_ws;
    __device__ __forceinline__ void operator()(const Acc& acc, const Unit& u, int wr, int wc, int fr, int fq) const { half<0>(acc, u, wr, wc, fr, fq); half<1>(acc, u, wr, wc, fr, fq); }
    template <int AI> __device__ __forceinline__ void half(const Acc& acc, const Unit& u, int wr, int wc, int fr, int fq) const {
        asm volatile("" : "+v"(fr), "+v"(fq));
        const int typ = u.pn >> 1;
        if (typ == 1 || typ == 2) run<true, AI>(acc, u, wr, wc, fr, fq); else run<false, AI>(acc, u, wr, wc, fr, fq);
    }
    template <bool nrm, int AI> __device__ __forceinline__ void run(const Acc& acc, const Unit& u, int wr, int wc, int fr, int fq) const {
        const int typ = u.pn >> 1, sub = u.pn & 1;
        const LAS float* gg = GQK + ((typ == 1) ? 0 : 64);
        f32x4 gn[2][2];
#pragma unroll
        for (int bj = 0; bj < 2; ++bj)
#pragma unroll
            for (int n = 0; n < 2; ++n) gn[bj][n] = nrm ? *(const LAS f32x4*)(gg + 32 * bj + 8 * fq + 4 * n) : (f32x4){1.f, 1.f, 1.f, 1.f};
        { constexpr int ai = AI;
#pragma unroll
            for (int m = 0; m < 4; ++m) {
                const int r = u.pm * BM + ai * HALF + wr * 64 + m * 16 + fr;
                f32x4 v[2][2];
#pragma unroll
                for (int bj = 0; bj < 2; ++bj)
#pragma unroll
                    for (int n = 0; n < 2; ++n) v[bj][n] = acc[ai][bj][m][n];
                if constexpr (nrm) {
                    float s = 0.f;
#pragma unroll
                    for (int bj = 0; bj < 2; ++bj)
#pragma unroll
                        for (int n = 0; n < 2; ++n) s += (v[bj][n].x * v[bj][n].x + v[bj][n].y * v[bj][n].y) + (v[bj][n].z * v[bj][n].z + v[bj][n].w * v[bj][n].w);
                    s = xor32_sum(xor16_sum(s));
                    const float rstd = nrm ? __builtin_amdgcn_rsqf(s * (1.f / 64.f) + EPS) : 1.f;
#pragma unroll
                    for (int bj = 0; bj < 2; ++bj)
#pragma unroll
                        for (int n = 0; n < 2; ++n) v[bj][n] = v[bj][n] * (gn[bj][n] * rstd);
                }
                u32x4 p[2];
#pragma unroll
                for (int bj = 0; bj < 2; ++bj) { p[bj].x = cvtpk(v[bj][0].x, v[bj][0].y); p[bj].y = cvtpk(v[bj][0].z, v[bj][0].w); p[bj].z = cvtpk(v[bj][1].x, v[bj][1].y); p[bj].w = cvtpk(v[bj][1].z, v[bj][1].w); }
                if (!nrm && typ == 0) {
#pragma unroll
                    for (int bj = 0; bj < 2; ++bj) { const int f = sub * 256 + 64 * wc + 32 * bj + 8 * fq, g = f >> 4, h = f & 15;
                        *(u32x4*)(U2 + ((size_t)g * NCH + (r >> 5)) * U2P + (r & 31) * 16 + h) = p[bj]; }
                } else store_pair(QKV + (size_t)(typ - 1) * ((size_t)M * 512) + (size_t)(r & ~1) * 512 + sub * 256 + 64 * wc, 512, p[0], p[1], fr, fq);
            } }
    }
};
struct EpiState {
    static constexpr bool HALFN = true, HOOKS = false, PERM = false, SIDE = false;
    float* SST;
    __device__ __forceinline__ void operator()(const Acc& acc, const Unit& u, int wr, int wc, int fr, int fq) const {
#pragma unroll
        for (int ai = 0; ai < 2; ++ai)
#pragma unroll
            for (int m = 0; m < 4; ++m) { const int r = u.pm * BM + ai * HALF + wr * 64 + m * 16 + fr;
#pragma unroll
                for (int n = 0; n < 2; ++n) *(f32x4*)(SST + ((size_t)u.aux * NCH + r) * 128 + 32 * wc + 16 * n + 4 * fq) = acc[ai][0][m][n]; }
    }
};
struct EpiS5 {
    static constexpr bool HALFN = false, HOOKS = false, PERM = true, SIDE = false;
    bf16* Z;
    __device__ __forceinline__ void operator()(const Acc& acc, const Unit& u, int wr, int wc, int fr, int fq) const {
#pragma unroll
        for (int ai = 0; ai < 2; ++ai)
#pragma unroll
            for (int m = 0; m < 4; ++m) { const int r = u.pm * BM + ai * HALF + wr * 64 + m * 16 + fr;
#pragma unroll
                for (int bj = 0; bj < 2; ++bj) { const int c0 = u.pn * BM + bj * HALF + 32 * wc + 8 * fq, i = c0 >> 4, h = c0 & 15;
                    const f32x4 a = acc[ai][bj][m][0], b = acc[ai][bj][m][1];
                    u32x4 w; w.x = cvtpk(gelu_tanh(a.x), gelu_tanh(a.y)); w.y = cvtpk(gelu_tanh(a.z), gelu_tanh(a.w)); w.z = cvtpk(gelu_tanh(b.x), gelu_tanh(b.y)); w.w = cvtpk(gelu_tanh(b.z), gelu_tanh(b.w));
                    *(u32x4*)(Z + ((size_t)r * 32 + i) * DSSM + u.aux * 16 + h) = w; } }
    }
};
struct EpiGlu {
    static constexpr bool HALFN = false, HOOKS = false, PERM = true, SIDE = false;
    const bf16* Z; const float* bias; bf16* MIX; float* SSQ;
    __device__ __forceinline__ void operator()(const Acc& acc, const Unit& u, int wr, int wc, int fr, int fq) const {
        float ss[2][4];
#pragma unroll
        for (int ai = 0; ai < 2; ++ai)
#pragma unroll
            for (int m = 0; m < 4; ++m) ss[ai][m] = 0.f;
#pragma unroll
        for (int bj = 0; bj < 2; ++bj) { const int c0 = u.pn * BM + bj * HALF + 32 * wc + 8 * fq;
            constexpr float NL2E = -1.4426950408889634f;
            const f32x4 b0 = *(const GAS f32x4*)(bias + c0) * NL2E, b1 = *(const GAS f32x4*)(bias + c0 + 4) * NL2E;
#pragma unroll
            for (int ai = 0; ai < 2; ++ai)
#pragma unroll
                for (int m = 0; m < 4; ++m) { const size_t row = (size_t)(u.pm * BM + ai * HALF + wr * 64 + m * 16 + fr);
                    const u32x4 zz = *(const u32x4*)(Z + row * DSSM + c0);
                    const f32x4 a = acc[ai][bj][m][0], b = acc[ai][bj][m][1];
#define GLU_SG(v_, b_) __builtin_amdgcn_rcpf(1.f + __builtin_amdgcn_exp2f(__builtin_fmaf((v_), NL2E, (b_))))
                    float y[8];
                    y[0] = bf2f(zz.x & 0xffff) * GLU_SG(a.x, b0.x); y[1] = bf2f(zz.x >> 16) * GLU_SG(a.y, b0.y); y[2] = bf2f(zz.y & 0xffff) * GLU_SG(a.z, b0.z); y[3] = bf2f(zz.y >> 16) * GLU_SG(a.w, b0.w);
                    y[4] = bf2f(zz.z & 0xffff) * GLU_SG(b.x, b1.x); y[5] = bf2f(zz.z >> 16) * GLU_SG(b.y, b1.y); y[6] = bf2f(zz.w & 0xffff) * GLU_SG(b.z, b1.z); y[7] = bf2f(zz.w >> 16) * GLU_SG(b.w, b1.w);
#undef GLU_SG
                    { float sq = ss[ai][m];
#pragma unroll
                      for (int e = 0; e < 8; ++e) sq = __builtin_fmaf(y[e], y[e], sq);
                      ss[ai][m] = sq; }
                    u32x4 w; w.x = cvtpk(y[0], y[1]); w.y = cvtpk(y[2], y[3]); w.z = cvtpk(y[4], y[5]); w.w = cvtpk(y[6], y[7]);
                    *(u32x4*)(MIX + row * PX + c0) = w; } }
#pragma unroll
        for (int ai = 0; ai < 2; ++ai)
#pragma unroll
            for (int m = 0; m < 4; ++m) { float v = xor32_sum(xor16_sum(ss[ai][m]));
                if (fq == 0) atomicAdd(SSQ + (u.pm * BM + ai * HALF + wr * 64 + m * 16 + fr), v); }
    }
};
struct EpiX1B {
#ifndef SIDE7
#define SIDE7 1
#endif
    static constexpr bool HALFN = false, HOOKS = true, PERM = true, SIDE = (SIDE7 != 0), SIDE_WHOLE = false;
    int side_r0; unsigned char* side_ws;
    const float* RSTDX; bf16* X1B; const float* SSQS; const float* SSQA; LAS float* RSC;
    __device__ __forceinline__ void begin(const Unit&, int, int) const {}
    __device__ __forceinline__ void fill(int ui, int pm, int tid) const {
        if (tid < 256) { const int row = pm * BM + tid; const float rs = __builtin_amdgcn_rsqf(SSQS[row] * (1.f / 512.f) + EPS), ra = __builtin_amdgcn_rsqf(SSQA[row] * (1.f / 512.f) + EPS);
            LAS float* d = RSC + (ui * 256 + tid) * 3; d[0] = rs * __builtin_amdgcn_rcpf(ra); d[1] = ra; d[2] = __builtin_amdgcn_rcpf(RSTDX[row]); }
    }
    __device__ __forceinline__ void mid(Acc& acc, int ui, int wr, int fr) const {
#pragma unroll
        for (int ai = 0; ai < 2; ++ai)
#pragma unroll
            for (int m = 0; m < 4; ++m) { const float f = RSC[(ui * 256 + ai * HALF + wr * 64 + m * 16 + fr) * 3];
#pragma unroll
                for (int bj = 0; bj < 2; ++bj)
#pragma unroll
                    for (int n = 0; n < 2; ++n) acc[ai][bj][m][n] = acc[ai][bj][m][n] * f; }
    }
    __device__ __forceinline__ void fin(const Acc& acc, const Unit& u, int ui, int wr, int wc, int fr, int fq) const { finh<0>(acc, u, ui, wr, wc, fr, fq); finh<1>(acc, u, ui, wr, wc, fr, fq); }
    template <int AI> __device__ __forceinline__ void finh(const Acc& acc, const Unit& u, int ui, int wr, int wc, int fr, int fq) const {
        constexpr int ai = AI;
#pragma unroll
            for (int m = 0; m < 4; ++m) { const int rl = ai * HALF + wr * 64 + m * 16 + fr; const LAS float* rc = RSC + (ui * 256 + rl) * 3; const float ra = rc[1], ix = rc[2];
                const size_t ro = (size_t)(u.pm * BM + rl) * PX + u.pn * BM + 64 * wc + 8 * fq;
                u32x4 p[2];
#pragma unroll
                for (int bj = 0; bj < 2; ++bj) { const u32x4 xn = *(const u32x4*)(X1B + ro + 32 * bj);
                    const f32x4 xa = (f32x4){bf2f(xn.x & 0xffff), bf2f(xn.x >> 16), bf2f(xn.y & 0xffff), bf2f(xn.y >> 16)} * ix, xb = (f32x4){bf2f(xn.z & 0xffff), bf2f(xn.z >> 16), bf2f(xn.w & 0xffff), bf2f(xn.w >> 16)} * ix;
                    const f32x4 a = xa + acc[ai][bj][m][0] * ra, b = xb + acc[ai][bj][m][1] * ra;
                    p[bj].x = cvtpk(a.x, a.y); p[bj].y = cvtpk(a.z, a.w); p[bj].z = cvtpk(b.x, b.y); p[bj].w = cvtpk(b.z, b.w); }
                store_pair(X1B + (size_t)(u.pm * BM + (rl & ~1)) * PX + u.pn * BM + 64 * wc, PX, p[0], p[1], fr, fq); }
    }
};
struct EpiGU {
    static constexpr bool HALFN = false, HOOKS = true, PERM = true, SIDE = false;
    __device__ __forceinline__ void begin(const Unit&, int, int) const {}
    __device__ __forceinline__ void mid(Acc&, int, int, int) const {}
    unsigned char* HH; const LAS unsigned* RCW;
    __device__ __forceinline__ void fin(const Acc& acc, const Unit& u, int ui, int wr, int wc, int fr, int fq) const {
#pragma unroll
        for (int ai = 0; ai < 2; ++ai)
#pragma unroll
            for (int m = 0; m < 4; ++m) { const int rl = ai * HALF + wr * 64 + m * 16 + fr, rr = u.pm * BM + rl; const size_t off = (size_t)rr * DE + u.pn * 128 + 32 * wc + 8 * fq;
                const float sc = __uint_as_float(RCW[ui * 256 + rl] & 0xffff0000u) * (1.f / W8SC), k1 = sc * -1.4426950408889634f, sc2 = sc * sc;
#define GU_H(g_, u_) (((g_) * (u_)) * __builtin_amdgcn_rcpf(1.f + __builtin_amdgcn_exp2f((g_) * k1)) * sc2)
                float hv[8];
#pragma unroll
                for (int n = 0; n < 2; ++n) { const f32x4 gt = acc[ai][0][m][n], up = acc[ai][1][m][n];
                    hv[4 * n] = GU_H(gt.x, up.x); hv[4 * n + 1] = GU_H(gt.y, up.y); hv[4 * n + 2] = GU_H(gt.z, up.z); hv[4 * n + 3] = GU_H(gt.w, up.w); }
#undef GU_H
                u32x2 w; w.x = pk4_fp8(hv[0], hv[1], hv[2], hv[3]); w.y = pk4_fp8(hv[4], hv[5], hv[6], hv[7]);
                *(u32x2*)(HH + off) = w; }
    }
};
struct EpiDown {
    static constexpr bool HALFN = false, HOOKS = true, PERM = true, SIDE = false;
    __device__ __forceinline__ void begin(const Unit&, int, int) const {}
    __device__ __forceinline__ void mid(Acc&, int, int, int) const {}
    unsigned char* YE; const LAS float* RGC;
    __device__ __forceinline__ void fin(const Acc& acc, const Unit& u, int ui, int wr, int wc, int fr, int fq) const {
#pragma unroll
        for (int ai = 0; ai < 2; ++ai)
#pragma unroll
            for (int m = 0; m < 4; ++m) { const int rl = ai * HALF + wr * 64 + m * 16 + fr; const float gw_ = RGC[ui * 256 + rl] * (YE_SCALE / W8SC);
                u32x2 p[2];
#pragma unroll
                for (int bj = 0; bj < 2; ++bj) { const f32x4 a = acc[ai][bj][m][0] * gw_, b = acc[ai][bj][m][1] * gw_; p[bj].x = pk4_fp8(a.x, a.y, a.z, a.w); p[bj].y = pk4_fp8(b.x, b.y, b.z, b.w); }
                const bool od = fq & 1; const u32x2 send = od ? p[0] : p[1]; u32x2 recv; recv.x = xor16_get(send.x, od); recv.y = xor16_get(send.y, od);
                u32x4 w; if (od) { w.x = recv.x; w.y = recv.y; w.z = p[1].x; w.w = p[1].y; } else { w.x = p[0].x; w.y = p[0].y; w.z = recv.x; w.w = recv.y; }
                *(u32x4*)(YE + (size_t)(u.pm * BM + rl) * DM + u.pn * BM + 64 * wc + (od ? 32 : 0) + 8 * (fq & ~1)) = w; }
    }
};

template <int K> __device__ __forceinline__ const float* karg() {
    const float* p;
    asm volatile("s_load_dwordx2 %0, %1, %2\n\ts_waitcnt lgkmcnt(0)" : "=s"(p) : "s"(__builtin_amdgcn_kernarg_segment_ptr()), "i"(K * 8) : "memory");
    return p;
}
struct Args { const float* in[26]; float* out; unsigned char* ws; int ph_lo, ph_hi; };
struct Frame { LAS unsigned char* lds; volatile LAS unsigned* MISC; unsigned* ctl; int tid, lane, wave, G, c; };

struct TItem { const float* W; int ldw, srccol0; const float* kscale; bf16* WT; int ldt, dstrow0, k0; int fp8; };
__device__ __forceinline__ void titem_load(const TItem& t, int lane, f32x4 (&v)[8]) {
#pragma unroll
    for (int i = 0; i < 8; ++i) { const int kk = 8 * i + (lane >> 3); v[i] = *(const GAS f32x4*)(t.W + (size_t)(t.k0 + kk) * t.ldw + t.srccol0 + (lane & 7) * 4); }
}
__device__ __forceinline__ void titem_store(const TItem& t, int lane, const f32x4 (&v)[8], LAS float* scr) {
#pragma unroll
    for (int i = 0; i < 8; ++i) { const int kk = 8 * i + (lane >> 3); const float sc = t.kscale ? t.kscale[t.k0 + kk] : 1.f; LAS float* d = scr + kk * 33 + (lane & 7) * 4;
        d[0] = v[i].x * sc; d[1] = v[i].y * sc; d[2] = v[i].z * sc; d[3] = v[i].w * sc; }
    asm volatile("s_waitcnt lgkmcnt(0)" ::: "memory");
    const int c = lane & 7;
#pragma unroll
    for (int j = 0; j < 4; ++j) { const int n = (lane >> 3) + 8 * j; const LAS float* s = scr + (8 * c) * 33 + n;
        if (t.fp8) { u32x2 o; o.x = pk4_fp8(s[0 * 33] * W8SC, s[1 * 33] * W8SC, s[2 * 33] * W8SC, s[3 * 33] * W8SC); o.y = pk4_fp8(s[4 * 33] * W8SC, s[5 * 33] * W8SC, s[6 * 33] * W8SC, s[7 * 33] * W8SC);
            *(u32x2*)((unsigned char*)t.WT + (size_t)(t.dstrow0 + n) * t.ldt + t.k0 + 8 * c) = o; }
        else { u32x4 o; o.x = pk2(s[0 * 33], s[1 * 33]); o.y = pk2(s[2 * 33], s[3 * 33]); o.z = pk2(s[4 * 33], s[5 * 33]); o.w = pk2(s[6 * 33], s[7 * 33]);
            *(u32x4*)(t.WT + (size_t)(t.dstrow0 + n) * t.ldt + t.k0 + 8 * c) = o; } }
    asm volatile("s_waitcnt lgkmcnt(0)" ::: "memory");
}
__device__ __forceinline__ void s5_tables_item(Frame& F, const Args& a, int g, int part) {
    const float* lre = karg<3>(); const float* lim = karg<4>(); const float* ldt = karg<5>(); const float* bre = karg<6>(); const float* bim = karg<7>();
    const float* cre = karg<8>(); const float* cim = karg<9>(); const float* dsk = karg<10>();
    LAS float* PWr = (LAS float*)F.lds; LAS float* PWi = PWr + 33 * 64; LAS float* BBr = PWi + 33 * 64; LAS float* BBi = BBr + 1024; LAS float* CCr = BBi + 1024; LAS float* CCi = CCr + 1024; LAS float* CF = CCi + 1024;
    const int tid = F.tid;
    if (tid < 64) { const int p = tid;
        const double dt = exp((double)ldt[g]), lr = lre[g * PST + p], li = lim[g * PST + p];
        double sn, cs; sincos_d(li * dt, sn, cs); const double mag = exp(lr * dt);
        const double ar = mag * cs, ai = mag * sn, den = lr * lr + li * li, nr = ar - 1.0, ni = ai;
        CF[2 * p] = (float)((nr * lr + ni * li) / den); CF[2 * p + 1] = (float)((ni * lr - nr * li) / den);
        double pr = 1.0, pi = 0.0;
        for (int l = 0; l <= 32; ++l) { PWr[l * 64 + p] = (float)pr; PWi[l * 64 + p] = (float)pi; if (l == 32 && part == 0) { float* A32 = (float*)(a.ws + FW_A32) + (g * PST + p) * 2; A32[0] = (float)pr; A32[1] = (float)pi; }
            const double t = pr * ar - pi * ai; pi = pr * ai + pi * ar; pr = t; }
    }
    __syncthreads();
    for (int idx = tid; idx < 1024; idx += NTHR) { const int p = idx >> 4; const float cfr = CF[2 * p], cfi = CF[2 * p + 1], br = bre[(size_t)g * 1024 + idx], bi = bim[(size_t)g * 1024 + idx];
        BBr[idx] = cfr * br - cfi * bi; BBi[idx] = cfr * bi + cfi * br; CCr[idx] = cre[(size_t)g * 1024 + idx]; CCi[idx] = cim[(size_t)g * 1024 + idx]; }
    __syncthreads();
    bf16* TBg = (bf16*)(a.ws + FW_TB) + (size_t)g * 512 * U2P; bf16* W1g = (bf16*)(a.ws + FW_W1) + (size_t)g * 256 * 512;
    for (int l = part; l < 32; l += 8) {
        if (tid < 256) { const int h = tid >> 4, hp = tid & 15; float k = 0.f;
#pragma unroll 16
            for (int p = 0; p < 64; ++p) { const float wr_ = PWr[l * 64 + p], wi_ = PWi[l * 64 + p], br = BBr[p * 16 + hp], bi = BBi[p * 16 + hp];
                k += CCr[h * 64 + p] * (wr_ * br - wi_ * bi) - CCi[h * 64 + p] * (wr_ * bi + wi_ * br); }
            if (l == 0 && h == hp) k += dsk[g * 16 + h];
            const bf16 v = (bf16)f2bf(k);
            for (int i = l; i < 32; ++i) TBg[(size_t)(i * 16 + h) * U2P + (i - l) * 16 + hp] = v;
            if (l >= 1) for (int i = 0; i < 32 - l; ++i) TBg[(size_t)(i * 16 + h) * U2P + (i + l) * 16 + hp] = 0;
        } else { const int t2 = tid - 256;
#pragma unroll
            for (int x = 0; x < 8; ++x) { const int e = t2 * 8 + x;
                { const int h = e >> 7, q = e & 127, p = q & 63; const float cr = CCr[h * 64 + p], ci = CCi[h * 64 + p], wr_ = PWr[(l + 1) * 64 + p], wi_ = PWi[(l + 1) * 64 + p];
                  const float re = cr * wr_ - ci * wi_, im = cr * wi_ + ci * wr_; TBg[(size_t)(l * 16 + h) * U2P + 512 + q] = (bf16)f2bf(q < 64 ? re : -im); }
                { const int rho = e >> 4, hp = e & 15, p = rho & 63; const float wr_ = PWr[(31 - l) * 64 + p], wi_ = PWi[(31 - l) * 64 + p], br = BBr[p * 16 + hp], bi = BBi[p * 16 + hp];
                  const float re = wr_ * br - wi_ * bi, im = wr_ * bi + wi_ * br; W1g[(size_t)rho * 512 + l * 16 + hp] = (bf16)f2bf(rho < 64 ? re : im); W1g[(size_t)(128 + rho) * 512 + l * 16 + hp] = 0; }
            }
        }
    }
    __syncthreads();
}
#ifndef XNR
#define XNR 8
#endif
__device__ __forceinline__ void p0_prologue(Frame& F, const Args& a) {
    const float* x = karg<0>();
    for (int it = F.c; it < 256; it += F.G) s5_tables_item(F, a, it >> 3, it & 7);
    LAS float* scr = (LAS float*)(F.lds + F.wave * 16384);
    const int gw = F.c * NWAVES + F.wave, NGW = F.G * NWAVES;
    constexpr int I_IN = 16 * 64, I_GLU = 8 * 16, I_OUT = 16 * 32, I_GU = 32 * 16 * 32, I_D = 32 * 8 * 32, NITEMS = I_IN + I_GLU + I_OUT + I_GU + I_D;
    bf16* WIN = (bf16*)(a.ws + FW_WIN); bf16* WGLU = (bf16*)(a.ws + FW_WGLU); bf16* WOUT = (bf16*)(a.ws + FW_WOUT); bf16* WGU = (bf16*)(a.ws + FW_WGU); bf16* WD = (bf16*)(a.ws + FW_WD);
    auto mkitem = [&](int it) -> TItem {
        int r = it;
        if (r < I_IN) { const int kb = r >> 6, d = r & 63, pn = d >> 3, beta = d & 7, bj = beta >> 2, wc = beta & 3;
            return TItem{karg<2>(), DIN, 256 * pn + 32 * (2 * wc + bj), karg<1>(), WIN, PW, 32 * d, 64 * kb, 0}; } r -= I_IN;
        if (r < I_GLU) { const int kb = r >> 4, d = r & 15; return TItem{karg<11>(), DSSM, 32 * d, nullptr, WGLU, DSSM, 32 * d, 64 * kb, 0}; } r -= I_GLU;
        if (r < I_OUT) { const int kb = r >> 5, d = r & 31; const float* ks = (kb < 8) ? karg<15>() : (karg<16>() - 512);
            return TItem{karg<17>(), DM, 32 * (8 * (d >> 3) + 2 * (d & 3) + ((d & 7) >> 2)), ks, WOUT, PW, 32 * d, 64 * kb, 0}; } r -= I_OUT;
        if (r < I_GU) { const int e = r >> 9, q = r & 511, kb = q >> 5, d = q & 31, pn = d >> 3, beta = d & 7;
            const float* W = (beta < 4 ? karg<23>() : karg<24>()) + (size_t)e * DM * DE;
            return TItem{W, DE, 128 * pn + 32 * (beta & 3), karg<18>(), (bf16*)((unsigned char*)WGU + (size_t)e * DM * DM), DM, 32 * d, 64 * kb, 1}; } r -= I_GU;
        const int e = r >> 8, q = r & 255, kb = q >> 5, d = q & 31;
        return TItem{karg<25>() + (size_t)e * DE * DM, DM, 32 * (8 * (d >> 3) + 2 * (d & 3) + ((d & 7) >> 2)), nullptr, (bf16*)((unsigned char*)WD + (size_t)e * DM * DE), DE, 32 * d, 64 * kb, 1};
    };
    const int nitems = (F.G == 256) ? (I_IN + I_GLU + I_OUT) : NITEMS;
    if (gw < nitems) {
        TItem cur = mkitem(gw); f32x4 vc[8]; titem_load(cur, F.lane, vc);
        for (int it = gw; it < nitems; it += NGW) {
            const bool more = it + NGW < nitems; TItem nxt = cur; f32x4 vn[8];
            if (more) { nxt = mkitem(it + NGW); titem_load(nxt, F.lane, vn); }
            titem_store(cur, F.lane, vc, scr);
            if (more) { cur = nxt;
#pragma unroll
                for (int i = 0; i < 8; ++i) vc[i] = vn[i]; }
        }
    }
    { bf16* WR = (bf16*)(a.ws + FW_WR);
      for (int idx = F.c * NTHR + F.tid; idx < 64 * DM; idx += F.G * NTHR) { const int n = idx >> 10, k = idx & 1023;
          float v = 0.f; if (n < 4) v = karg<19>()[k * 4 + n]; else if (n < 36) v = karg<21>()[k * 32 + (n - 4)];
          WR[idx] = (bf16)f2bf(v * karg<18>()[k]); } }
    bf16* XN = (bf16*)(a.ws + FW_XN); float* RSTDX = (float*)(a.ws + FW_RSTDX);
    for (int m0 = gw * XNR; m0 < M; m0 += NGW * XNR) {
        f32x4 v[XNR][4];
#pragma unroll
        for (int rr = 0; rr < XNR; ++rr) { const GAS f32x4* xr = (const GAS f32x4*)(x + (size_t)(m0 + rr) * DM);
            v[rr][0] = __builtin_nontemporal_load(xr + 2 * F.lane); v[rr][1] = __builtin_nontemporal_load(xr + 2 * F.lane + 1);
            v[rr][2] = __builtin_nontemporal_load(xr + 128 + 2 * F.lane); v[rr][3] = __builtin_nontemporal_load(xr + 128 + 2 * F.lane + 1); }
#pragma unroll
        for (int rr = 0; rr < XNR; ++rr) { float s = 0.f;
#pragma unroll
            for (int j = 0; j < 4; ++j) s += v[rr][j].x * v[rr][j].x + v[rr][j].y * v[rr][j].y + v[rr][j].z * v[rr][j].z + v[rr][j].w * v[rr][j].w;
            const float rstd = __builtin_amdgcn_rsqf(wave_sum(s) * (1.f / DM) + EPS);
            if (F.lane == 0) RSTDX[m0 + rr] = rstd;
            u32x4* o = (u32x4*)(XN + (size_t)(m0 + rr) * PX);
#pragma unroll
            for (int j = 0; j < 2; ++j) { const f32x4 a = v[rr][2 * j] * rstd, b = v[rr][2 * j + 1] * rstd; u32x4 w; w.x = cvtpk(a.x, a.y); w.y = cvtpk(a.z, a.w); w.z = cvtpk(b.x, b.y); w.w = cvtpk(b.z, b.w); o[64 * j + F.lane] = w; } }
    }
}

__device__ __forceinline__ void s5_scan_local(Frame& F, const Args& a, int g, int pm) {
    const float* SST = (const float*)(a.ws + FW_SST); bf16* U2 = (bf16*)(a.ws + FW_U2);
    if (F.tid < 256) {
        const int p = F.tid & 63;
        const float* A32 = (const float*)(a.ws + FW_A32) + (g * PST + p) * 2; const float ar = A32[0], ai = A32[1];
        float xr = 0.f, xi = 0.f;
        const size_t row0 = (size_t)g * NCH + (size_t)pm * 256 + (size_t)(F.tid >> 6) * 64;
        for (int c0 = 0; c0 < 64; c0 += 16) {
            float sr[16], si[16];
#pragma unroll
            for (int j = 0; j < 16; ++j) { sr[j] = SST[(row0 + c0 + j) * 128 + p]; si[j] = SST[(row0 + c0 + j) * 128 + 64 + p]; }
#pragma unroll
            for (int j = 0; j < 16; ++j) { bf16* up = U2 + (row0 + c0 + j) * U2P + 512; up[p] = (bf16)f2bf(xr); up[64 + p] = (bf16)f2bf(xi);
                const float t = ar * xr - ai * xi + sr[j]; xi = ar * xi + ai * xr + si[j]; xr = t; }
        }
    }
}
__device__ __forceinline__ void s5_scan(Frame& F, const Args& a) {
    const float* SST = (const float*)(a.ws + FW_SST); bf16* U2 = (bf16*)(a.ws + FW_U2);
    for (int idx = F.c * NTHR + F.tid; idx < BATCH * NG * PST; idx += F.G * NTHR) {
        const int p = idx & 63, g = (idx >> 6) & 31, b = idx >> 11;
        const double dt = exp((double)karg<5>()[g]), lr = karg<3>()[g * PST + p], li = karg<4>()[g * PST + p];
        double sn, cs; sincos_d(32.0 * li * dt, sn, cs); const double mag = exp(32.0 * lr * dt);
        const float ar = (float)(mag * cs), ai = (float)(mag * sn);
        float xr = 0.f, xi = 0.f;
        const size_t row0 = (size_t)g * NCH + (size_t)b * 64;
        for (int c0 = 0; c0 < 64; c0 += 16) {
            float sr[16], si[16];
#pragma unroll
            for (int j = 0; j < 16; ++j) { sr[j] = SST[(row0 + c0 + j) * 128 + p]; si[j] = SST[(row0 + c0 + j) * 128 + 64 + p]; }
#pragma unroll
            for (int j = 0; j < 16; ++j) { bf16* up = U2 + (row0 + c0 + j) * U2P + 512; up[p] = (bf16)f2bf(xr); up[64 + p] = (bf16)f2bf(xi);
                const float t = ar * xr - ai * xi + sr[j]; xi = ar * xi + ai * xr + si[j]; xr = t; }
        }
    }
}

#ifndef ATT_THR_V
#define ATT_THR_V -32.f
#endif
constexpr float ATT_THR = ATT_THR_V;
__device__ __forceinline__ s16x4 vtr(const LAS unsigned char* p) { typedef short v4i16_t __attribute__((ext_vector_type(4))); return __builtin_bit_cast(s16x4, __builtin_amdgcn_ds_read_tr16_b64_v4i16((LAS v4i16_t*)p)); }
__device__ __forceinline__ int crow(int r, int hi) { return (r & 3) + 8 * (r >> 2) + 4 * hi; }
#define MFMA32(a, b, c) __builtin_amdgcn_mfma_f32_32x32x16_bf16((a), (b), (c), 0, 0, 0)
template <bool DIAG, int P, int KH, int KD, int VD>
__device__ __forceinline__ float attn_half(const LAS unsigned char* Kb, const LAS unsigned char* Vb, const bf16x8 (&qr)[4], const bf16x8 (&tri)[2], f32x16 (&o)[2], float base, int lim, int lane) {
    const int r32 = lane & 31, hi = lane >> 5;
    const LAS unsigned char* kp = Kb + hi * KH + r32 * 16 + P * 512;
    const int lim2 = lim - 4 * hi;
    f32x16 z = {};
#pragma unroll
    for (int d0 = 0; d0 < 4; ++d0) { const bf16x8 kf = *(const LAS bf16x8*)(kp + d0 * KD); z = MFMA32(kf, qr[d0], z); }
    float l[16];
#pragma unroll
    for (int r = 0; r < 16; ++r) { l[r] = -__builtin_amdgcn_logf(1.f + __builtin_amdgcn_exp2f(z[r])); if (DIAG) { if (!((r & 3) + 8 * (r >> 2) + 32 * P < lim2)) l[r] = 0.f; } }
    u32x4 wa, wb;
    wa.x = cvtpk(l[0], l[1]); wa.y = cvtpk(l[2], l[3]); wa.z = cvtpk(l[4], l[5]); wa.w = cvtpk(l[6], l[7]);
    wb.x = cvtpk(l[8], l[9]); wb.y = cvtpk(l[10], l[11]); wb.z = cvtpk(l[12], l[13]); wb.w = cvtpk(l[14], l[15]);
    const bf16x8 La = __builtin_bit_cast(bf16x8, wa), Lb = __builtin_bit_cast(bf16x8, wb);
    f32x16 T = {};
    T = MFMA32(tri[0], La, T); T = MFMA32(tri[1], Lb, T);
    float av[16];
#pragma unroll
    for (int r = 0; r < 16; ++r) { av[r] = __builtin_amdgcn_exp2f((z[r] + base) + T[r]); if (DIAG) { if (!((r & 3) + 8 * (r >> 2) + 32 * P < lim2)) av[r] = 0.f; } }
    wa.x = cvtpk(av[0], av[1]); wa.y = cvtpk(av[2], av[3]); wa.z = cvtpk(av[4], av[5]); wa.w = cvtpk(av[6], av[7]);
    wb.x = cvtpk(av[8], av[9]); wb.y = cvtpk(av[10], av[11]); wb.z = cvtpk(av[12], av[13]); wb.w = cvtpk(av[14], av[15]);
    const bf16x8 Pa = __builtin_bit_cast(bf16x8, wa), Pb = __builtin_bit_cast(bf16x8, wb);
    const LAS unsigned char* vp = Vb + ((lane >> 4) & 1) * 32 + (lane & 3) * 8 + (4 * hi + ((lane & 15) >> 2)) * 64 + P * 2048;
#pragma unroll
    for (int d0 = 0; d0 < 2; ++d0) {
        const s16x4 lo0 = vtr(vp + d0 * VD), hi0 = vtr(vp + d0 * VD + 512), lo1 = vtr(vp + d0 * VD + 1024), hi1 = vtr(vp + d0 * VD + 1536);
        const bf16x8 v0 = {lo0[0], lo0[1], lo0[2], lo0[3], hi0[0], hi0[1], hi0[2], hi0[3]}, v1 = {lo1[0], lo1[1], lo1[2], lo1[3], hi1[0], hi1[1], hi1[2], hi1[3]};
        o[d0] = MFMA32(Pa, v0, o[d0]); o[d0] = MFMA32(Pb, v1, o[d0]);
    }
    { const unsigned u = __builtin_bit_cast(unsigned, T[0]); auto r = __builtin_amdgcn_permlane32_swap(u, u, false, false); return __builtin_bit_cast(float, (unsigned)r[0]); }
}
#ifndef ASPAN_N
#define ASPAN_N 13
#endif
constexpr int ASPAN = ASPAN_N;
__device__ __forceinline__ void attn_span_phase(Frame& F, const bf16* Q, const bf16* Kg, const bf16* Vg, bf16* MIX, float* SSQA) {
    const int lane = F.lane, wid = F.wave, r32 = lane & 31, hi = lane >> 5;
    volatile LAS int* FLG = (volatile LAS int*)(F.lds + ASPAN * 8192 + 8 * 4096);
    bf16x8 tri[2];
#pragma unroll
    for (int s = 0; s < 2; ++s)
#pragma unroll
        for (int j = 0; j < 8; ++j) tri[s][j] = ((16 * s + 8 * (j >> 2) + 4 * hi + (j & 3)) >= r32) ? (short)0x3F80 : (short)0;
    for (int L = F.c; L < BATCH * NH * 8; L += F.G) {
        const int bh = L >> 3, qb = L & 7, b = bh >> 3, h = bh & 7, a0 = 8 * qb, a = a0 + wid;
        const size_t row0 = (size_t)b * SEQ; const int qg = 32 * a + r32;
        bf16x8 qr[4];
#pragma unroll
        for (int d0 = 0; d0 < 4; ++d0) qr[d0] = *(const bf16x8*)(Q + (row0 + qg) * DATT + h * HD + d0 * 16 + hi * 8);
        const bf16* src = (wid < 4) ? (Kg + (row0 + (lane & 31)) * DATT + h * HD + (lane >> 5) * 8 + 16 * wid)
                                    : (Vg + (row0 + 16 * (wid & 1) + (lane >> 2)) * DATT + h * HD + (lane & 3) * 8 + 32 * ((wid - 4) >> 1));
        const int dsto = (wid < 4) ? wid * 1024 : 4096 + (wid - 4) * 1024;
        f32x16 o[2] = {}; float Rc = 0.f; bool done = false;
        for (int k = 0;; ++k) {
            const int top = a0 + 7 - ASPAN * k, bot = (top - (ASPAN - 1) > 0) ? top - (ASPAN - 1) : 0;
#pragma unroll 1
            for (int jj = top; jj >= bot; --jj)
                __builtin_amdgcn_global_load_lds((const unsigned*)(src + (size_t)(32 * jj) * DATT), (LAS unsigned*)(F.lds + (top - jj) * 8192 + dsto), 16, 0, 0);
            asm volatile("s_waitcnt vmcnt(0)" ::: "memory");
            __syncthreads();
            if (!done) {
                for (int jj = (a < top ? a : top); jj >= bot; --jj) {
                    const LAS unsigned char* Kb = F.lds + (top - jj) * 8192; const LAS unsigned char* Vb = Kb + 4096;
                    const int lim = qg - 32 * jj;
                    float sh;
                    if (jj == a) sh = attn_half<true, 0, 512, 1024, 2048>(Kb, Vb, qr, tri, o, Rc, lim, lane);
                    else sh = attn_half<false, 0, 512, 1024, 2048>(Kb, Vb, qr, tri, o, Rc, lim, lane);
                    Rc += sh;
                    if (jj == 0 || __all(Rc < ATT_THR)) { done = true; break; }
                }
            }
            if (lane == 0) FLG[wid] = done ? 1 : 0;
            asm volatile("s_waitcnt lgkmcnt(0)" ::: "memory");
            __syncthreads();
            if (bot == 0) break;
            int alld = 1;
#pragma unroll
            for (int w = 0; w < 8; ++w) alld &= FLG[w];
            if (alld) break;
        }
        { LAS unsigned char* stg = F.lds + ASPAN * 8192 + wid * 4096; LAS unsigned short* sp = (LAS unsigned short*)(stg + hi * 512 + r32 * 2);
#pragma unroll
          for (int r = 0; r < 16; ++r) { const int ro = ((r & 3) + 8 * (r >> 2)) * 64; sp[ro] = (unsigned short)f2bf(o[0][r]); sp[ro + 32] = (unsigned short)f2bf(o[1][r]); }
          asm volatile("s_waitcnt lgkmcnt(0)" ::: "memory");
          bf16* ow = MIX + (row0 + 32 * a) * PX + 512 + h * HD;
#pragma unroll
          for (int i = 0; i < 4; ++i) { const int row = i * 8 + (lane >> 3), ch = lane & 7; const u32x4 v = *(const LAS u32x4*)(stg + row * 128 + ch * 16); *(u32x4*)(ow + (size_t)row * PX + ch * 8) = v;
              const float f0 = bf2f(v.x & 0xffff), f1 = bf2f(v.x >> 16), f2 = bf2f(v.y & 0xffff), f3 = bf2f(v.y >> 16), f4 = bf2f(v.z & 0xffff), f5 = bf2f(v.z >> 16), f6 = bf2f(v.w & 0xffff), f7 = bf2f(v.w >> 16);
              float ss = ((f0 * f0 + f1 * f1) + (f2 * f2 + f3 * f3)) + ((f4 * f4 + f5 * f5) + (f6 * f6 + f7 * f7));
              ss += dppf<0xB1>(ss); ss += dppf<0x4E>(ss); ss += dppf<0x141>(ss);
              if (ch == 0) atomicAdd(SSQA + (row0 + 32 * a + row), ss); }
          asm volatile("s_waitcnt lgkmcnt(0)" ::: "memory"); }
    }
    asm volatile("s_waitcnt vmcnt(0)" ::: "memory");
    __syncthreads();
}
static_assert(ASPAN * 8192 + 8 * 4096 + 64 <= MISC_OFF, "attention LDS map");

constexpr int RT_PITCH = 2064;
__device__ __forceinline__ void router_phase(Frame& F, const Args& a) {
    const bf16* X1B = (const bf16*)(a.ws + FW_X1B); unsigned char* X1Q = (unsigned char*)(a.ws + FW_X1Q); int* TOK = (int*)(a.ws + FW_TOK); const bf16* WR = (const bf16*)(a.ws + FW_WR);
    const float* brg = karg<20>(); const float* bre_ = karg<22>();
    const int tid = F.tid, lane = F.lane, wid = F.wave, r32 = lane & 31, hi = lane >> 5;
    LAS unsigned char* TILE = F.lds;
    LAS float* PART = (LAS float*)(F.lds + 66048);
    LAS float* LOGIT = (LAS float*)(F.lds + 66048 + 65536);
    LAS int* HIST = (LAS int*)(F.lds + 66048 + 65536 + 5120);
    LAS int* TREC = HIST + 64;
    LAS float* RS = (LAS float*)(TREC + 1024);
    LAS float* TRS = RS + 32;
    LAS float* TRG = TRS + 256;
    LAS float* BIAS = TRG + 512;
    static_assert(66048 + 65536 + 5120 + 256 + 4096 + 128 + 1024 + 2048 + 160 <= MISC_OFF, "router LDS");
    bf16x8 Bf[8][2];
#pragma unroll
    for (int s = 0; s < 8; ++s)
#pragma unroll
        for (int nb = 0; nb < 2; ++nb) Bf[s][nb] = *(const bf16x8*)(WR + (size_t)(32 * nb + r32) * DM + 128 * wid + 16 * s + 8 * hi);
    if (tid < 64) HIST[tid] = 0;
    if (tid >= 64 && tid < 104) { const int c = tid - 64; BIAS[c] = c < 4 ? brg[c] : (c < 36 ? bre_[c - 4] : 0.f); }
    __syncthreads();
    int ntl = 0;
#define RT_BAR() do { asm volatile("s_waitcnt lgkmcnt(0)" ::: "memory"); __builtin_amdgcn_s_barrier(); asm volatile("" ::: "memory"); } while (0)
#define RT_LOAD(tile_) do { _Pragma("unroll") for (int rr = 0; rr < 4; ++rr) { const u32x4* xr = (const u32x4*)(X1B + (size_t)((tile_) * 32 + 4 * wid + rr) * PX); v[rr][0] = xr[lane]; v[rr][1] = xr[64 + lane]; } } while (0)
    u32x4 v[4][2];
    if (F.c < M / 32) RT_LOAD(F.c);
    for (int tile = F.c; tile < M / 32; tile += F.G, ++ntl) {
        {
#pragma unroll
          for (int rr = 0; rr < 4; ++rr) { const int lr = 4 * wid + rr; float s = 0.f;
#pragma unroll
              for (int j = 0; j < 2; ++j) { const u32x4 w = v[rr][j];
                  const float f0 = bf2f(w.x & 0xffff), f1 = bf2f(w.x >> 16), f2 = bf2f(w.y & 0xffff), f3 = bf2f(w.y >> 16), f4 = bf2f(w.z & 0xffff), f5 = bf2f(w.z >> 16), f6 = bf2f(w.w & 0xffff), f7 = bf2f(w.w >> 16);
                  s += (f0 * f0 + f1 * f1) + (f2 * f2 + f3 * f3) + (f4 * f4 + f5 * f5) + (f6 * f6 + f7 * f7);
                  { u32x2 q8; q8.x = pk4_fp8(f0, f1, f2, f3); q8.y = pk4_fp8(f4, f5, f6, f7); *(u32x2*)(X1Q + (size_t)(tile * 32 + lr) * DM + (64 * j + lane) * 8) = q8; }
                  *(LAS u32x4*)(TILE + lr * RT_PITCH + (64 * j + lane) * 16) = w; }
              const float rstd = __builtin_amdgcn_rsqf(wave_sum(s) * (1.f / DM) + EPS);
              if (lane == 0) RS[lr] = rstd; } }
        if (tile + F.G < M / 32) RT_LOAD(tile + F.G);
        RT_BAR();
        { f32x16 c0 = {}, c1 = {};
#pragma unroll
          for (int s = 0; s < 8; ++s) { const bf16x8 af = *(const LAS bf16x8*)(TILE + r32 * RT_PITCH + (128 * wid + 16 * s + 8 * hi) * 2);
              c0 = MFMA32(af, Bf[s][0], c0); c1 = MFMA32(af, Bf[s][1], c1); }
#pragma unroll
          for (int r = 0; r < 16; ++r) { const int t = crow(r, hi); PART[(wid * 32 + t) * 64 + r32] = c0[r]; PART[(wid * 32 + t) * 64 + 32 + r32] = c1[r]; } }
        RT_BAR();
        { const int t = tid >> 4, c4 = (tid & 15) * 4;
          if (c4 < 40) { f32x4 s = {0.f, 0.f, 0.f, 0.f};
#pragma unroll
              for (int w = 0; w < 8; ++w) s += *(const LAS f32x4*)(PART + (w * 32 + t) * 64 + c4);
              *(LAS f32x4*)(LOGIT + t * 40 + c4) = s * RS[t] + *(const LAS f32x4*)(BIAS + c4); } }
        RT_BAR();
        if (tid < 32) { const int m = tile * 32 + tid; float lg[36];
#pragma unroll
            for (int c = 0; c < 36; ++c) lg[c] = LOGIT[tid * 40 + c];
            int gi = 0; float gm = lg[0];
#pragma unroll
            for (int c = 1; c < 4; ++c) if (lg[c] > gm) { gm = lg[c]; gi = c; }
            float gsum = 0.f;
#pragma unroll
            for (int c = 0; c < 4; ++c) gsum += __expf(lg[c] - gm);
            const float pgrp = 1.f / gsum;
            float el[8];
#pragma unroll
            for (int e = 0; e < 8; ++e) { float t = 0.f;
#pragma unroll
                for (int g2 = 0; g2 < 4; ++g2) if (g2 == gi) t = lg[4 + g2 * 8 + e];
                el[e] = t; }
            int i0 = 0; float m0 = el[0];
#pragma unroll
            for (int e = 1; e < 8; ++e) if (el[e] > m0) { m0 = el[e]; i0 = e; }
            int i1 = 0; float m1 = -3.0e38f;
#pragma unroll
            for (int e = 0; e < 8; ++e) if (e != i0 && el[e] > m1) { m1 = el[e]; i1 = e; }
            const float e1 = __expf(m1 - m0), p0 = 1.f / (1.f + e1), p1 = e1 / (1.f + e1);
            const int ex0 = gi * 8 + i0, ex1 = gi * 8 + i1;
            const int rk0 = atomicAdd((int*)&HIST[ex0], 1), rk1 = atomicAdd((int*)&HIST[ex1], 1);
            int* tk = TOK + (size_t)m * 8; tk[0] = ex0; tk[1] = ex1; tk[2] = __float_as_int(pgrp * p0); tk[3] = __float_as_int(pgrp * p1);
            LAS int* tr = TREC + (ntl * 32 + tid) * 4; tr[0] = ex0; tr[1] = ex1; tr[2] = rk0; tr[3] = rk1;
            TRS[ntl * 32 + tid] = RS[tid]; TRG[2 * (ntl * 32 + tid)] = pgrp * p0; TRG[2 * (ntl * 32 + tid) + 1] = pgrp * p1;
        }
        RT_BAR();
    }
#undef RT_BAR
#undef RT_LOAD
    if (tid < 32) { const int cnt = HIST[tid]; int base = 0; if (cnt > 0) base = (int)__hip_atomic_fetch_add(F.ctl + CW_CNT + tid, (unsigned)cnt, RLX_AGENT); HIST[32 + tid] = base; }
    __syncthreads();
    unsigned* ETOK = (unsigned*)(a.ws + FW_ETOK); float* EG = (float*)(a.ws + FW_EG);
    for (int i = tid; i < ntl * 32; i += NTHR) { const int tile = F.c + (i >> 5) * F.G, m = tile * 32 + (i & 31); const LAS int* tr = TREC + i * 4;
        int* tk = TOK + (size_t)m * 8; const int s0 = HIST[32 + tr[0]] + tr[2], s1 = HIST[32 + tr[1]] + tr[3]; tk[4] = s0; tk[5] = s1;
        const unsigned word = (unsigned)m | (f2bf(TRS[i]) << 16);
        ETOK[(size_t)tr[0] * M + s0] = word; ETOK[(size_t)tr[1] * M + s1] = word; EG[(size_t)tr[0] * M + s0] = TRG[2 * i]; EG[(size_t)tr[1] * M + s1] = TRG[2 * i + 1]; }
    __syncthreads();
}
__device__ __forceinline__ int moe_tables(Frame& F) {
    LAS int* TST = (LAS int*)(F.lds + SCR2_OFF); LAS unsigned char* T2E = F.lds + SCR2_OFF + 256;
    if (F.tid < 64) {
        const int e = F.tid; int nt = 0;
        if (e < NE) { const int cnt = (int)__hip_atomic_load(F.ctl + CW_CNT + e, RLX_AGENT); nt = (cnt + 255) >> 8; TST[208 + e] = cnt; }
        int incl = nt;
#pragma unroll
        for (int o = 1; o < 32; o <<= 1) { const int v = __shfl_up(incl, o); if ((e & 31) >= o) incl += v; }
        const int start = incl - nt;
        if (e < NE) { TST[e] = start; for (int t = 0; t < nt; ++t) T2E[start + t] = (unsigned char)e; }
        if (e == NE - 1) TST[NE] = incl;
    }
    __syncthreads();
    return TST[NE];
}
#ifndef CTPT
#define CTPT 4
#endif
__device__ __forceinline__ void combine_phase(Frame& F, const Args& a) {
    const unsigned char* YE = (const unsigned char*)(a.ws + FW_YE); const bf16* X1B = (const bf16*)(a.ws + FW_X1B); const int* TOK = (const int*)(a.ws + FW_TOK); float* out = a.out;
    const LAS int* TST = (const LAS int*)(F.lds + SCR2_OFF);
    const int gw = F.c * NWAVES + F.wave, NGW = F.G * NWAVES, lane = F.lane;
    static_assert(CTPT * 8 <= 64, "one routing word per lane");
    int m0 = gw * CTPT;
    int w = 0; if (m0 < M) w = TOK[(size_t)m0 * 8 + (lane & (CTPT * 8 - 1))];
    for (; m0 < M; m0 += NGW * CTPT) {
        const int mn = m0 + NGW * CTPT;
        int wn = 0; if (mn < M) wn = TOK[(size_t)mn * 8 + (lane & (CTPT * 8 - 1))];
        const int tl = TST[w & 31];
        u32x2 xv[CTPT][4]; unsigned y0[CTPT][4], y1[CTPT][4];
#pragma unroll
        for (int t = 0; t < CTPT; ++t) {
            const size_t p0 = (size_t)__builtin_amdgcn_readlane(tl, 8 * t) * 256 + (size_t)__builtin_amdgcn_readlane(w, 8 * t + 4), p1 = (size_t)__builtin_amdgcn_readlane(tl, 8 * t + 1) * 256 + (size_t)__builtin_amdgcn_readlane(w, 8 * t + 5);
            const bf16* xr = X1B + (size_t)(m0 + t) * PX + 4 * lane; const unsigned* ya = (const unsigned*)(YE + p0 * DM) + lane; const unsigned* yb = (const unsigned*)(YE + p1 * DM) + lane;
#pragma unroll
            for (int q = 0; q < 4; ++q) { xv[t][q] = *(const u32x2*)(xr + 256 * q); y0[t][q] = ya[64 * q]; y1[t][q] = yb[64 * q]; } }
#pragma unroll
        for (int t = 0; t < CTPT; ++t) { float* o = out + (size_t)(m0 + t) * DM + 4 * lane;
#pragma unroll
            for (int q = 0; q < 4; ++q) { const unsigned wa = y0[t][q], wb = y1[t][q]; const unsigned xa = xv[t][q].x, xb = xv[t][q].y;
                const f32x2 a0 = __builtin_amdgcn_cvt_pk_f32_fp8((int)wa, false), a1 = __builtin_amdgcn_cvt_pk_f32_fp8((int)wa, true), b0 = __builtin_amdgcn_cvt_pk_f32_fp8((int)wb, false), b1 = __builtin_amdgcn_cvt_pk_f32_fp8((int)wb, true);
                f32x4 r; r.x = bf2f(xa & 0xffff) + (a0.x + b0.x) * (1.f / YE_SCALE); r.y = bf2f(xa >> 16) + (a0.y + b0.y) * (1.f / YE_SCALE);
                r.z = bf2f(xb & 0xffff) + (a1.x + b1.x) * (1.f / YE_SCALE); r.w = bf2f(xb >> 16) + (a1.y + b1.y) * (1.f / YE_SCALE);
                *(f32x4*)(o + 256 * q) = r; } }
        w = wn;
    }
}

#ifndef STG1
#define STG1 0
#endif
#ifndef STG10
#define STG10 0
#endif
#ifndef STG11
#define STG11 0
#endif
#ifndef KREP1
#define KREP1 1
#endif
#ifndef KREP10
#define KREP10 1
#endif
#ifndef KREP11
#define KREP11 1
#endif
constexpr int NPHASE = 13;
__global__ void __launch_bounds__(NTHR, 2) mk_fwd(Args args) {
    extern __shared__ __attribute__((aligned(16))) unsigned char lds_raw[];
    Frame F;
    F.lds = (LAS unsigned char*)lds_raw; F.MISC = (volatile LAS unsigned*)(F.lds + MISC_OFF);
    F.tid = threadIdx.x; F.lane = F.tid & 63; F.wave = __builtin_amdgcn_readfirstlane(F.tid >> 6);
    F.G = gridDim.x; F.c = blockIdx.x; F.ctl = (unsigned*)(args.ws + WS_CTL);
    if (F.tid < 64) F.MISC[F.tid] = 0u;
    __syncthreads();
    XcdBarrier bar = xcd_barrier_post(F.ctl + CW_BAR, F.MISC + 8);
    const int lo = args.ph_lo, hi = args.ph_hi;
    unsigned char* ws = args.ws;
#ifndef PH_MASK
#define PH_MASK 0x1fff
#endif
#define IN(k) ((((PH_MASK) >> (k)) & 1) && lo <= (k) && (k) < hi)
#define SEAM(k) do { if (IN(k) && IN((k) + 1)) xcd_barrier(bar); } while (0)
#define REFRESH() do { int t_ = threadIdx.x; asm volatile("" : "+v"(t_)); F.tid = t_; F.lane = t_ & 63; F.wave = __builtin_amdgcn_readfirstlane(t_ >> 6); } while (0)
#ifndef REP_MASK
#define REP_MASK 0
#endif
#define REPS(k) _Pragma("unroll") for (int rep_ = 0; rep_ < ((((REP_MASK) >> (k)) & 1) ? 2 : 1); ++rep_)
    if (IN(0)) REPS(0) { REFRESH(); p0_prologue(F, args); } SEAM(0);
    if (IN(1)) REPS(1) { REFRESH();
        GemmP g{PX * 2, PW * 2, DM}; DenseOrder S{(const char*)(ws + FW_XN), (const char*)(ws + FW_WIN), (size_t)256 * PX * 2, (size_t)256 * PW * 2, M / 256, DIN / 256, (M / 256) * (DIN / 256), F.G, F.c};
        LAS float* GQK = (LAS float*)(F.lds + SCR2_OFF); if (F.tid < 128) GQK[F.tid] = (F.tid < 64) ? karg<13>()[F.tid] * C2 : karg<14>()[F.tid - 64];
        { LAS float* GF = (LAS float*)(F.lds + GF_OFF); GF[F.tid] = W8SC * karg<18>()[F.tid]; GF[F.tid + 512] = W8SC * karg<18>()[F.tid + 512]; } __syncthreads();
        EpiProj E{(bf16*)(ws + FW_U2), (bf16*)(ws + FW_Q), (const LAS float*)GQK, (F.G == 256) ? F.c * NWAVES : -1, ws};
        gemm_phase<EpiProj, DenseOrder, false, KREP1>(F.lds, g, S, E, nullptr, ((F.c >> 3) & 7) * STG1); } SEAM(1);
    if (IN(2)) REPS(2) { REFRESH();
        GemmP g{U2P * 2, 512 * 2, 512}; GroupOrder S{(const char*)(ws + FW_U2), (const char*)(ws + FW_W1), (size_t)NCH * U2P * 2, (size_t)256 * 512 * 2, (size_t)256 * U2P * 2, 0, NCH / 256, 1, NG * (NCH / 256), F.G, F.c};
        EpiState E{(float*)(ws + FW_SST)};
        gemm_phase(F.lds, g, S, E);
        if (F.G == NG * (NCH / 256)) s5_scan_local(F, args, F.c >> 3, F.c & 7); }
    if (F.G != NG * (NCH / 256)) SEAM(2);
    if (IN(3)) REPS(3) { REFRESH();
#ifndef NO_SCAN
        if (F.G != NG * (NCH / 256)) s5_scan(F, args);
#ifdef REP_SCAN
        s5_scan(F, args);
#endif
#endif
#ifndef NO_ATTN
        const bf16* Q = (const bf16*)(ws + FW_Q); const bf16* Kg = (const bf16*)(ws + FW_K); const bf16* Vg = (const bf16*)(ws + FW_V);
        attn_span_phase(F, Q, Kg, Vg, (bf16*)(ws + FW_MIX), (float*)(F.ctl + CW_SSQA));
#endif
    } SEAM(3);
    if (IN(4)) REPS(4) { REFRESH();
        GemmP g{U2P * 2, U2P * 2, U2P}; GroupOrder S{(const char*)(ws + FW_U2), (const char*)(ws + FW_TB), (size_t)NCH * U2P * 2, (size_t)512 * U2P * 2, (size_t)256 * U2P * 2, (size_t)256 * U2P * 2, NCH / 256, 2, NG * (NCH / 256) * 2, F.G, F.c};
        EpiS5 E{(bf16*)(ws + FW_Z)};
        gemm_phase(F.lds, g, S, E); } SEAM(4);
    if (IN(5)) REPS(5) { REFRESH();
        GemmP g{DSSM * 2, DSSM * 2, DSSM}; DenseOrder S{(const char*)(ws + FW_Z), (const char*)(ws + FW_WGLU), (size_t)256 * DSSM * 2, (size_t)256 * DSSM * 2, M / 256, 2, (M / 256) * 2, F.G, F.c};
        EpiGlu E{(const bf16*)(ws + FW_Z), karg<12>(), (bf16*)(ws + FW_MIX), (float*)(F.ctl + CW_SSQS)};
        gemm_phase(F.lds, g, S, E); } if (IN(5) && IN(7)) xcd_barrier(bar);
    if (IN(7)) REPS(7) { REFRESH();
        GemmP g{PX * 2, PW * 2, DM}; DenseOrder S{(const char*)(ws + FW_MIX), (const char*)(ws + FW_WOUT), (size_t)256 * PX * 2, (size_t)256 * PW * 2, M / 256, 4, (M / 256) * 4, F.G, F.c};
        EpiX1B E{(F.G == 256) ? F.c * NWAVES + 2048 * 8 : -1, ws, (const float*)(ws + FW_RSTDX), (bf16*)(ws + FW_X1B), (const float*)(F.ctl + CW_SSQS), (const float*)(F.ctl + CW_SSQA), (LAS float*)(F.lds + SCR2_OFF + 1024)};
        { LAS float* GF = (LAS float*)(F.lds + GF_OFF); GF[F.tid] = W8SC * karg<18>()[F.tid]; GF[F.tid + 512] = W8SC * karg<18>()[F.tid + 512]; }
        { Unit uu; for (int i = 0; i < 4 && S.next(i, uu); ++i) E.fill(i, uu.pm, F.tid); __syncthreads(); }
        gemm_phase(F.lds, g, S, E); } SEAM(7);
    if (IN(8)) { REFRESH(); router_phase(F, args); } if (IN(8) && IN(10)) xcd_barrier(bar);
    int ntiles = 0;
    if (IN(10) || IN(11) || IN(12)) { REFRESH(); ntiles = moe_tables(F); }
    if (IN(10)) REPS(10) { REFRESH();
        LAS int* RC = (LAS int*)(F.lds + SCR2_OFF + 1024); const unsigned* ETOK = (const unsigned*)(ws + FW_ETOK); const LAS int* TSTc = (const LAS int*)(F.lds + SCR2_OFF); const LAS unsigned char* T2Ec = F.lds + SCR2_OFF + 256;
        { unsigned v[5];
#pragma unroll
          for (int k = 0; k < 5; ++k) { const int j = F.tid + 512 * k, i = j >> 8, r = j & 255; v[k] = 0u;
              if ((long)i * F.G + F.c < (long)ntiles * 4) { int pm, pn; moe_unit(i * F.G + F.c, ntiles, pm, pn);
                  const int e = T2Ec[pm], idx = (pm - TSTc[e]) * 256 + r;
                  if (idx < TSTc[208 + e]) v[k] = ETOK[(size_t)e * M + idx]; } }
#pragma unroll
          for (int k = 0; k < 5; ++k) { const int j = F.tid + 512 * k; if ((long)(j >> 8) * F.G + F.c < (long)ntiles * 4) RC[j] = (int)v[k]; } }
        __syncthreads();
        GemmP g{DM, DM, DM / 2}; MoeOrder S{(const char*)(ws + FW_X1Q), (const char*)(ws + FW_WGU), (size_t)0, (size_t)DM * DM, (size_t)256 * DM, F.lds + SCR2_OFF + 256, ntiles, F.G, F.c};
        EpiGU E{(unsigned char*)(ws + FW_HH), (const LAS unsigned*)RC};
        gemm_phase<EpiGU, MoeOrder, true, KREP10, true>(F.lds, g, S, E, RC, ((F.c >> 3) & 7) * STG10); } SEAM(10);
    if (IN(11)) REPS(11) { REFRESH();
        LAS float* RGC = (LAS float*)(F.lds + SCR2_OFF + 1024); const float* EG = (const float*)(ws + FW_EG); const LAS int* TSTc = (const LAS int*)(F.lds + SCR2_OFF); const LAS unsigned char* T2Ec = F.lds + SCR2_OFF + 256;
        { float v[5];
#pragma unroll
          for (int k = 0; k < 5; ++k) { const int j = F.tid + 512 * k, i = j >> 8, r = j & 255; v[k] = 0.f;
              if ((long)i * F.G + F.c < (long)ntiles * 4) { int pm, pn; moe_unit(i * F.G + F.c, ntiles, pm, pn);
                  const int e = T2Ec[pm], idx = (pm - TSTc[e]) * 256 + r;
                  if (idx < TSTc[208 + e]) v[k] = EG[(size_t)e * M + idx]; } }
#pragma unroll
          for (int k = 0; k < 5; ++k) { const int j = F.tid + 512 * k; if ((long)(j >> 8) * F.G + F.c < (long)ntiles * 4) RGC[j] = v[k]; } }
        __syncthreads();
        GemmP g{DE, DE, DE / 2}; MoeOrder S{(const char*)(ws + FW_HH), (const char*)(ws + FW_WD), (size_t)256 * DE, (size_t)DM * DE, (size_t)256 * DE, F.lds + SCR2_OFF + 256, ntiles, F.G, F.c};
        EpiDown E{(unsigned char*)(ws + FW_YE), (const LAS float*)RGC};
        gemm_phase<EpiDown, MoeOrder, false, KREP11, true>(F.lds, g, S, E, nullptr, ((F.c >> 3) & 7) * STG11); } SEAM(11);
    if (IN(12)) REPS(12) { REFRESH(); combine_phase(F, args); }
#undef IN
#undef SEAM
}
}

extern "C" void kernel_launch(void* const* d_in, const int* in_sizes, int n_in, void* d_out, int out_size, void* d_ws, size_t ws_size, hipStream_t stream) {
    static int grid = 0;
    if (grid == 0) {
        if (n_in != 26 || out_size != M * DM || ws_size < mk::FW_END2) { fprintf(stderr, "kernel_launch: unexpected shapes (n_in %d out %d ws %zu, need %zu)\n", n_in, out_size, ws_size, (size_t)mk::FW_END2); grid = -1; return; }
        int dev = 0, cus = 0, per_cu = 0;
        if (hipGetDevice(&dev) != hipSuccess || hipDeviceGetAttribute(&cus, hipDeviceAttributeMultiprocessorCount, dev) != hipSuccess) { grid = -1; return; }
        if (hipFuncSetAttribute((const void*)mk::mk_fwd, hipFuncAttributeMaxDynamicSharedMemorySize, mk::LDS_BYTES) != hipSuccess) { fprintf(stderr, "kernel_launch: hipFuncSetAttribute failed\n"); grid = -1; return; }
        if (hipOccupancyMaxActiveBlocksPerMultiprocessor(&per_cu, (const void*)mk::mk_fwd, mk::NTHR, mk::LDS_BYTES) != hipSuccess || per_cu < 1) { fprintf(stderr, "kernel_launch: occupancy query says %d\n", per_cu); }
        (void)hipGetLastError();
        grid = cus;
        if (grid != 256) fprintf(stderr, "kernel_launch: %d CUs (built for 256)\n", grid);
    }
    if (grid < 0) return;
    mk::Args a{};
    for (int i = 0; i < 26; ++i) a.in[i] = (const float*)d_in[i];
    a.out = (float*)d_out; a.ws = (unsigned char*)d_ws; a.ph_lo = 0; a.ph_hi = mk::NPHASE;
    (void)hipMemsetAsync((unsigned char*)d_ws + WS_CTL, 0, mk::CTL_ZERO_BYTES, stream);
    hipLaunchKernelGGL(mk::mk_fwd, dim3(grid), dim3(mk::NTHR), mk::LDS_BYTES, stream, a);
}
```

```cpp
#define ASPAN_N 10
#define PADX 0

#include <hip/hip_runtime.h>
#include <cstdio>
#include <cstdint>

typedef unsigned short bf16;
typedef float f32x4 __attribute__((ext_vector_type(4)));
typedef unsigned u32x4 __attribute__((ext_vector_type(4)));
typedef unsigned u32x2 __attribute__((ext_vector_type(2)));

constexpr int DM = 1024, BATCH = 32, SEQ = 2048, M = BATCH * SEQ;
constexpr int DSSM = 512, NG = 32, GS = 16, PST = 64, HD = 64, DATT = 512, NH = 8, DIN = 2048;
constexpr int NEG = 4, EPG = 8, NE = 32, DE = 512;
constexpr float EPS = 1e-6f;
constexpr int LCH = 32;
constexpr int NCH = M / LCH;
constexpr int U2P = 640;
constexpr float C2 = 0.125f * 1.4426950408889634f;

constexpr size_t MiB = 1u << 20;
constexpr size_t WS_CTL = 0;
constexpr size_t WS_TOK = 2 * MiB;
constexpr size_t WS_XN = 8 * MiB;
constexpr size_t WS_Q = WS_XN + 128 * MiB;
constexpr size_t WS_K = WS_Q + 64 * MiB;
constexpr size_t WS_V = WS_K + 64 * MiB;
constexpr size_t WS_U2 = WS_V + 64 * MiB;
constexpr size_t WS_Z = WS_U2 + 80 * MiB;
constexpr size_t WS_YS = WS_Z + 64 * MiB;
constexpr size_t WS_YA = WS_YS + 64 * MiB;
constexpr size_t WS_MIX = WS_YA + 64 * MiB;
constexpr size_t WS_H2 = WS_XN;
constexpr size_t WS_PROJ = WS_Z;
constexpr size_t WS_END = WS_PROJ + 512 * MiB;

__device__ __forceinline__ unsigned f2bf(float f) { unsigned u = __builtin_bit_cast(unsigned, f); return (u + 0x7fffu + ((u >> 16) & 1u)) >> 16; }
__device__ __forceinline__ float bf2f(unsigned short h) { return __builtin_bit_cast(float, (unsigned)h << 16); }
__device__ __forceinline__ unsigned pk2(float lo, float hi) { return f2bf(lo) | (f2bf(hi) << 16); }
template <int CTRL> __device__ __forceinline__ float dppf(float x) { return __builtin_bit_cast(float, __builtin_amdgcn_update_dpp(0, __builtin_bit_cast(int, x), CTRL, 0xF, 0xF, true)); }
template <int CTRL> __device__ __forceinline__ unsigned dppu(unsigned x) { return (unsigned)__builtin_amdgcn_update_dpp(0, (int)x, CTRL, 0xF, 0xF, true); }
__device__ __forceinline__ float xor16_sum(float v) { const unsigned u = __builtin_bit_cast(unsigned, v); auto r = __builtin_amdgcn_permlane16_swap(u, u, false, false); return __builtin_bit_cast(float, (unsigned)r[0]) + __builtin_bit_cast(float, (unsigned)r[1]); }
__device__ __forceinline__ float xor32_sum(float v) { const unsigned u = __builtin_bit_cast(unsigned, v); auto r = __builtin_amdgcn_permlane32_swap(u, u, false, false); return __builtin_bit_cast(float, (unsigned)r[0]) + __builtin_bit_cast(float, (unsigned)r[1]); }
__device__ __forceinline__ unsigned xor16_get(unsigned u, bool odd_row) { auto r = __builtin_amdgcn_permlane16_swap(u, u, false, false); return odd_row ? (unsigned)r[0] : (unsigned)r[1]; }
__device__ __forceinline__ float wave_sum(float v) {
    v += dppf<0xB1>(v); v += dppf<0x4E>(v); v += dppf<0x141>(v); v += dppf<0x140>(v);
    return xor32_sum(xor16_sum(v));
}
__device__ __forceinline__ void sincos_d(double th, double& s, double& c) {
    const double q = rint(th * 0.63661977236758134308);
    const double r = (th - q * 1.57079632679489655800) - q * 6.12323399573676603587e-17;
    const double r2 = r * r;
    double sp = -1.0 / 1307674368000.0; sp = sp * r2 + 1.0 / 6227020800.0; sp = sp * r2 - 1.0 / 39916800.0; sp = sp * r2 + 1.0 / 362880.0; sp = sp * r2 - 1.0 / 5040.0; sp = sp * r2 + 1.0 / 120.0; sp = sp * r2 - 1.0 / 6.0; sp = sp * r2 + 1.0;
    const double sn = sp * r;
    double cp = 1.0 / 20922789888000.0; cp = cp * r2 - 1.0 / 87178291200.0; cp = cp * r2 + 1.0 / 479001600.0; cp = cp * r2 - 1.0 / 3628800.0; cp = cp * r2 + 1.0 / 40320.0; cp = cp * r2 - 1.0 / 720.0; cp = cp * r2 + 1.0 / 24.0; cp = cp * r2 - 0.5; cp = cp * r2 + 1.0;
    const int qi = ((int)q) & 3;
    s = (qi == 0) ? sn : (qi == 1) ? cp : (qi == 2) ? -sn : -cp;
    c = (qi == 0) ? cp : (qi == 1) ? -sn : (qi == 2) ? -cp : sn;
}
__device__ __forceinline__ float gelu_tanh(float x) {
    constexpr float K1 = -2.885390081777927f * 0.7978845608028654f, K3 = K1 * 0.044715f;
    const float e = __builtin_amdgcn_exp2f(x * (K1 + K3 * (x * x)));
    return x * __builtin_amdgcn_rcpf(1.f + e);
}
__device__ __forceinline__ float sigmoidf_(float x) { return __builtin_amdgcn_rcpf(1.f + __builtin_amdgcn_exp2f(-1.4426950408889634f * x)); }


#include <type_traits>
namespace mk {
#define LAS __attribute__((address_space(3)))
#define GAS __attribute__((address_space(1)))
typedef short bf16x8 __attribute__((ext_vector_type(8)));
typedef short s16x4 __attribute__((ext_vector_type(4)));
typedef float f32x16 __attribute__((ext_vector_type(16)));
typedef float f32x2 __attribute__((ext_vector_type(2)));
typedef __bf16 bf16x2_t __attribute__((ext_vector_type(2)));
typedef GAS unsigned gu32;

constexpr int NWAVES = 8, NTHR = 512;
constexpr int RING_BYTES = 131072, SCR2_OFF = RING_BYTES, SCR2_BYTES = 16128, MISC_OFF = SCR2_OFF + SCR2_BYTES, GF_OFF = MISC_OFF + 256, LDS_BYTES = GF_OFF + 4096;
static_assert(GF_OFF == 147456 && LDS_BYTES <= 163840, "LDS map");

#ifndef PADX
#define PADX 64
#endif
constexpr int PX = DM + PADX;
constexpr int PW = DM + PADX;
constexpr size_t FW_TOK = 2 * MiB, FW_WIN = 4 * MiB, FW_WOUT = 9 * MiB, FW_WGLU = 12 * MiB - 512 * 1024, FW_WR = 12 * MiB, FW_TB = 13 * MiB, FW_W1 = 33 * MiB,
                 FW_WGU = 41 * MiB, FW_WD = 110 * MiB, FW_SST = 142 * MiB, FW_XN = 174 * MiB, FW_Q = 310 * MiB, FW_K = 374 * MiB, FW_V = 438 * MiB, FW_U2 = 502 * MiB,
                 FW_Z = 582 * MiB, FW_MIX = 646 * MiB, FW_ROW = 782 * MiB, FW_END2 = 784 * MiB,
                 FW_X1B = FW_XN, FW_HH = 582 * MiB, FW_YE = FW_Q;
static_assert(FW_WIN + (size_t)DIN * PW * 2 <= FW_WOUT && FW_WOUT + (size_t)DM * PW * 2 <= FW_WGLU && FW_WGU + (size_t)NE * DM * PW * 2 <= FW_WD && FW_XN + (size_t)M * PX * 2 <= FW_Q && FW_MIX + (size_t)M * PX * 2 <= FW_ROW, "padded buffers");
static_assert(FW_K - FW_Q == (size_t)M * 512 * 2 && FW_V - FW_K == (size_t)M * 512 * 2, "Q|K|V contiguous");
constexpr size_t FW_RSTDX = FW_ROW + 3 * (size_t)(544 * 256) * 4;
constexpr size_t FW_ETOK = FW_SST, FW_EG = FW_SST + (size_t)NE * M * 4;
static_assert(FW_EG + (size_t)NE * M * 4 <= FW_XN, "expert lists");
constexpr float W8SC = 64.f;
constexpr size_t FW_X1Q = FW_U2;
static_assert(FW_X1Q + (size_t)M * DM <= FW_HH && FW_YE + (size_t)(544 * 256) * DM <= FW_X1Q && FW_HH + (size_t)(544 * 256) * DE <= FW_ROW, "X1Q / HH / YE must not overlap");
constexpr size_t FW_A32 = FW_WR + 256 * 1024;
constexpr int MAXTILES = 544, MAXROWS = MAXTILES * 256;
static_assert(FW_RSTDX + (size_t)M * 4 <= FW_END2, "row arrays");
static_assert(FW_YE + (size_t)MAXROWS * DM <= FW_U2 && FW_HH + (size_t)MAXROWS * DE * 2 <= FW_ROW, "MoE overlay");
constexpr int CW_TMO = 0, CW_CNT = 64, CW_BAR = 4096, CW_SSQS = 65536, CW_SSQA = 131072;
static_assert((CW_SSQA + M) * 4 <= (int)(1 * MiB), "ssq arrays inside the memset region");
constexpr size_t CTL_ZERO_BYTES = 1 * MiB;

#define RLX_AGENT __ATOMIC_RELAXED, __HIP_MEMORY_SCOPE_AGENT
__device__ __forceinline__ unsigned cvtpk(float lo, float hi) { f32x2 v = {lo, hi}; bf16x2_t b = __builtin_convertvector(v, bf16x2_t); return __builtin_bit_cast(unsigned, b); }

#define XB_TMO      128
#define XB_XCNT(j)  (256  + 64 * (j))
#define XB_XSUB(j)  (1280 + 64 * (j))
#define XB_XGEN(j)  (2304 + 64 * (j))
#define XB_TOP      3328
#define XB_TOPGEN   3392
#define XCD_BAR_WORDS 3456
#define XB_SPIN_CAP (1u << 18)
__device__ __forceinline__ unsigned xb_ld(unsigned* p)              { return __hip_atomic_load(p, __ATOMIC_RELAXED, __HIP_MEMORY_SCOPE_AGENT); }
__device__ __forceinline__ unsigned xb_add(unsigned* p, unsigned v) { return __hip_atomic_fetch_add(p, v, __ATOMIC_RELAXED, __HIP_MEMORY_SCOPE_AGENT); }
__device__ __forceinline__ unsigned xb_xcc_id() { return (unsigned)__builtin_amdgcn_s_getreg((3 << 11) | 20) & 0xFu; }
#define XB_SPIN(cond, bar) do { unsigned _sp = 0; while (cond) { __builtin_amdgcn_s_sleep(1); \
    if ((++_sp & 255u) == 0u) { if (xb_ld(&(bar)[XB_TMO])) break; if (_sp > XB_SPIN_CAP) { atomicAdd(&(bar)[XB_TMO], 1u); break; } } } } while (0)
struct XcdBarrier { unsigned* bar; unsigned x; volatile LAS unsigned* st; };
__device__ __forceinline__ XcdBarrier xcd_barrier_post(unsigned* bar, volatile LAS unsigned* st) {
    XcdBarrier b; b.bar = bar; b.x = xb_xcc_id(); b.st = st;
    if (threadIdx.x == 0) (void)xb_add(&bar[XB_XCNT(b.x)], 1u);
    return b;
}
__device__ __forceinline__ void xcd_barrier_complete(unsigned* bar, unsigned x, unsigned& nloc, unsigned& nx) {
    const unsigned G = gridDim.x * gridDim.y * gridDim.z;
    unsigned sum, cnt, mine, sp = 0u;
    for (;;) {
        sum = 0u; cnt = 0u; mine = 0u;
#pragma unroll
        for (unsigned j = 0; j < 16; ++j) { const unsigned c = xb_ld(&bar[XB_XCNT(j)]); sum += c; cnt += (c > 0u) ? 1u : 0u; mine = (j == x) ? c : mine; }
        if (sum == G) break;
        __builtin_amdgcn_s_sleep(1);
        if ((++sp & 255u) == 0u) { if (xb_ld(&bar[XB_TMO])) break; if (sp > XB_SPIN_CAP) { atomicAdd(&bar[XB_TMO], 1u); break; } }
    }
    nloc = mine > 0u ? mine : 1u; nx = cnt > 0u ? cnt : 1u;
}
__device__ __forceinline__ void xcd_barrier(const XcdBarrier& b) {
    asm volatile("s_waitcnt vmcnt(0)" ::: "memory");
    __syncthreads();
    if (threadIdx.x == 0) {
        unsigned* bar = b.bar;
        __builtin_amdgcn_s_waitcnt(0);
        unsigned nloc = b.st[0], nx = b.st[1];
        if (nloc == 0u) { xcd_barrier_complete(bar, b.x, nloc, nx); b.st[0] = nloc; b.st[1] = nx; }
        const unsigned old = xb_add(&bar[XB_XSUB(b.x)], 1u);
        const unsigned gen = old / nloc;
        if (old + 1u == (gen + 1u) * nloc) {
            __builtin_amdgcn_fence(__ATOMIC_RELEASE, "agent");
            asm volatile("s_waitcnt vmcnt(0)" ::: "memory");
            const unsigned og = xb_add(&bar[XB_TOP], 1u);
            const unsigned tg = og / nx;
            if (og + 1u == (tg + 1u) * nx) xb_add(&bar[XB_TOPGEN], 1u);
            else XB_SPIN(xb_ld(&bar[XB_TOPGEN]) == tg, bar);
            __builtin_amdgcn_fence(__ATOMIC_ACQUIRE, "agent");
            xb_add(&bar[XB_XGEN(b.x)], 1u);
            asm volatile("s_waitcnt vmcnt(0)" ::: "memory");
        } else {
            XB_SPIN(xb_ld(&bar[XB_XGEN(b.x)]) == gen, bar);
            __builtin_amdgcn_fence(__ATOMIC_ACQUIRE, "agent");
            asm volatile("s_waitcnt vmcnt(0)" ::: "memory");
        }
    }
    __syncthreads();
}

__device__ __forceinline__ unsigned pk4_fp8(float a, float b, float c, float d) { int w = 0; w = __builtin_amdgcn_cvt_pk_fp8_f32(a, b, w, false); w = __builtin_amdgcn_cvt_pk_fp8_f32(c, d, w, true); return (unsigned)w; }
template <int K> __device__ __forceinline__ const float* karg();
struct SideItem { const float* W; unsigned char* WT; int ldw, srccol0, ldt, dstrow0, k0, scaled; };
__device__ __forceinline__ SideItem moe_side_item(int r) {
    unsigned char* ws;
    asm volatile("s_load_dwordx2 %0, %1, 216\n\ts_waitcnt lgkmcnt(0)" : "=s"(ws) : "s"(__builtin_amdgcn_kernarg_segment_ptr()) : "memory");
    if (r < 16384) { const int e = r >> 9, q = r & 511, kb = q >> 5, d = q & 31, pn = d >> 3, beta = d & 7;
        const float* W = (beta < 4 ? karg<23>() : karg<24>()) + (size_t)e * DM * DE;
        return SideItem{W, ws + FW_WGU + (size_t)e * DM * DM, DE, 128 * pn + 32 * (beta & 3), DM, 32 * d, 64 * kb, 1}; }
    r -= 16384; const int e = r >> 8, q = r & 255, kb = q >> 5, d = q & 31;
    return SideItem{karg<25>() + (size_t)e * DE * DM, ws + FW_WD + (size_t)e * DM * DE, DM, 32 * (8 * (d >> 3) + 2 * (d & 3) + ((d & 7) >> 2)), DE, 32 * d, 64 * kb, 0};
}
__device__ __forceinline__ void side_load(const SideItem& t, int lane, int hb, f32x4 (&v)[4]) {
    asm volatile("" : "+v"(lane));
    const int kh = lane >> 3, nq = lane & 7;
#pragma unroll
    for (int i = 0; i < 4; ++i) v[i] = *(const GAS f32x4*)(t.W + (size_t)(t.k0 + 8 * kh + 4 * hb + i) * t.ldw + t.srccol0 + 4 * nq);
}
__device__ __forceinline__ void side_store(const SideItem& t, int lane, int hb, const f32x4 (&v)[4], const LAS float* GF) {
    asm volatile("" : "+v"(lane));
    const int kh = lane >> 3, nq = lane & 7;
    f32x4 g0 = (f32x4){W8SC, W8SC, W8SC, W8SC};
    if (t.scaled) g0 = *(const LAS f32x4*)(GF + t.k0 + 8 * kh + 4 * hb);
#pragma unroll
    for (int e = 0; e < 4; ++e)
        *(unsigned*)(t.WT + (size_t)(t.dstrow0 + 4 * nq + e) * t.ldt + t.k0 + 8 * kh + 4 * hb) = pk4_fp8(v[0][e] * g0.x, v[1][e] * g0.y, v[2][e] * g0.z, v[3][e] * g0.w);
}
constexpr int BM = 256, BK = 64, HALF = 128, HTB = HALF * BK * 2;
__device__ __forceinline__ int lds_byte(int r, int c) { const int st = (r >> 4) * 2 + (c >> 5), rr = r & 15, cc = c & 31, ob = rr * 64 + cc * 2; return st * 1024 + (ob ^ (((ob >> 9) & 1) << 5)); }
__device__ __forceinline__ void stage_rc(int b, int& R, int& C) { const int st = b / 1024, sb = b % 1024, swz = sb ^ (((sb >> 9) & 1) << 5); R = (st >> 1) * 16 + swz / 64; C = (st & 1) * 32 + (swz % 64) / 2; }
__device__ __forceinline__ int perm32(int rho) { const int n = rho >> 4, i = rho & 15; return 8 * (i >> 2) + 4 * n + (i & 3); }
struct Unit { const char* a; const char* b; int pm, pn, aux; };
struct GemmP { int lda_b, ldb_b, K; };

template <class Epi, class Sched, bool GATHER = false, int KREP = 1, bool FP8 = false>
__device__ __forceinline__ void gemm_phase(LAS unsigned char* lds, const GemmP g, const Sched& S, const Epi& E, const LAS int* rowcache = nullptr, int stagger_ticks = 0) {
    const int tid = threadIdx.x, wid = __builtin_amdgcn_readfirstlane(tid >> 6), lane = tid & 63, wr = wid >> 2, wc = wid & 3, fr = lane & 15, fq = lane >> 4;
    const int ntk = g.K / BK, nt = ntk * (KREP == 3 ? 1 : KREP);
    unsigned voffA[2], voffB[2]; int gR[2], gC[2];
#pragma unroll
    for (int i = 0; i < 2; ++i) { int R, C; stage_rc(tid * 16 + i * 8192, R, C); const int Rb = Epi::PERM ? ((R & ~31) + perm32(R & 31)) : R; gR[i] = R; gC[i] = C * 2;
        voffA[i] = (unsigned)(R * g.lda_b + C * 2); voffB[i] = (unsigned)(Rb * g.ldb_b + C * 2); }
    unsigned vc0[2] = {voffA[0], voffA[1]}, vc1[2] = {voffA[0], voffA[1]}, vn0[2] = {voffA[0], voffA[1]}, vn1[2] = {voffA[0], voffA[1]};
#define PG8_GOFF(dst0, dst1, ui_) do { _Pragma("unroll") for (int _i = 0; _i < 2; ++_i) { \
        dst0[_i] = ((unsigned)rowcache[(ui_) * 256 + gR[_i]] & 0xffffu) * (unsigned)g.lda_b + (unsigned)gC[_i]; dst1[_i] = ((unsigned)rowcache[(ui_) * 256 + 128 + gR[_i]] & 0xffffu) * (unsigned)g.lda_b + (unsigned)gC[_i]; } } while (0)
    const size_t kstep = (size_t)(BK * 2);
    const size_t hstepA = GATHER ? 0 : (size_t)HALF * g.lda_b, hstepB = (size_t)HALF * g.ldb_b;
    const unsigned ldsw = (unsigned)wid * 1024u;
    const int aoff = lds_byte(wr * 64 + fr, fq * 8), boff = lds_byte(wc * 32 + fr, fq * 8);
#ifndef OPAQ_VO
#define OPAQ_VO 1
#endif
#define PG8_SA(b, h) (((b) * 2 + (h)) * HTB)
#define PG8_SB(b, h) ((4 + (b) * 2 + (h)) * HTB)
#define PG8_STAGE(bufoff, gbase, voff) do { _Pragma("unroll") for (int _i = 0; _i < 2; ++_i) { unsigned _vo = (voff)[_i]; if (OPAQ_VO) asm volatile("" : "+v"(_vo)); \
        __builtin_amdgcn_global_load_lds((const unsigned*)((const char*)(gbase) + _vo), (LAS unsigned*)(lds + (bufoff) + ldsw + _i * 8192), 16, 0, 0); } } while (0)
#define PG8_LDA(dst, b, h) do { _Pragma("unroll") for (int m = 0; m < 4; ++m) { const LAS unsigned char* p_ = lds + PG8_SA(b, h) + aoff + m * 2048; \
        if constexpr (FP8) { dst[m].v.lo = *(const LAS v4i_*)p_; dst[m].v.hi = *(const LAS v4i_*)(p_ + 1024); } else { dst[m].v[0] = *(const LAS bf16x8*)p_; dst[m].v[1] = *(const LAS bf16x8*)(p_ + 1024); } } } while (0)
#define PG8_LDB(dst, b, h) do { _Pragma("unroll") for (int n = 0; n < 2; ++n) { const LAS unsigned char* p_ = lds + PG8_SB(b, h) + boff + n * 2048; \
        if constexpr (FP8) { dst[n].v.lo = *(const LAS v4i_*)p_; dst[n].v.hi = *(const LAS v4i_*)(p_ + 1024); } else { dst[n].v[0] = *(const LAS bf16x8*)p_; dst[n].v[1] = *(const LAS bf16x8*)(p_ + 1024); } } } while (0)
#define PG8_MMA(ai, bj, At, Bt) do { if (Epi::HALFN && (bj) == 1) break; __builtin_amdgcn_s_setprio(1); \
        if constexpr (FP8) { asm volatile("s_nop 1\n\t" "v_mfma_scale_f32_16x16x128_f8f6f4 %0, %8, %10, %0, %14, %14 op_sel_hi:[0,0,0]\n\t" "v_mfma_scale_f32_16x16x128_f8f6f4 %1, %9, %10, %1, %14, %14 op_sel_hi:[0,0,0]\n\t" "v_mfma_scale_f32_16x16x128_f8f6f4 %2, %8, %11, %2, %14, %14 op_sel_hi:[0,0,0]\n\t" "v_mfma_scale_f32_16x16x128_f8f6f4 %3, %9, %11, %3, %14, %14 op_sel_hi:[0,0,0]\n\t" "v_mfma_scale_f32_16x16x128_f8f6f4 %4, %8, %12, %4, %14, %14 op_sel_hi:[0,0,0]\n\t" "v_mfma_scale_f32_16x16x128_f8f6f4 %5, %9, %12, %5, %14, %14 op_sel_hi:[0,0,0]\n\t" "v_mfma_scale_f32_16x16x128_f8f6f4 %6, %8, %13, %6, %14, %14 op_sel_hi:[0,0,0]\n\t" "v_mfma_scale_f32_16x16x128_f8f6f4 %7, %9, %13, %7, %14, %14 op_sel_hi:[0,0,0]\n\t" "s_nop 1" \
            : "+v"(acc[ai][bj][0][0]), "+v"(acc[ai][bj][0][1]), "+v"(acc[ai][bj][1][0]), "+v"(acc[ai][bj][1][1]), "+v"(acc[ai][bj][2][0]), "+v"(acc[ai][bj][2][1]), "+v"(acc[ai][bj][3][0]), "+v"(acc[ai][bj][3][1]) \
            : "v"(Bt[0].v), "v"(Bt[1].v), "v"(At[0].v), "v"(At[1].v), "v"(At[2].v), "v"(At[3].v), "v"(mxs)); } \
        else { _Pragma("unroll") for (int m = 0; m < 4; ++m) _Pragma("unroll") for (int n = 0; n < 2; ++n) _Pragma("unroll") for (int k = 0; k < 2; ++k) \
            acc[ai][bj][m][n] = __builtin_amdgcn_mfma_f32_16x16x32_bf16(Bt[n].v[k], At[m].v[k], acc[ai][bj][m][n], 0, 0, 0); } \
        __builtin_amdgcn_s_setprio(0); } while (0)
#define PG8_WAIT_V(n) asm volatile("s_waitcnt vmcnt(" #n ")" ::: "memory")
#define PG8_WAIT_L(n) asm volatile("s_waitcnt lgkmcnt(" #n ")" ::: "memory")
#define PG8_BAR __builtin_amdgcn_s_barrier()
#define PG8_SCHED __builtin_amdgcn_sched_barrier(0)
    int mxs = 0x7F7F7F7F; asm volatile("" : "+v"(mxs));
    Unit cur, nxt; int ui = 0;
    if (!S.next(0, cur)) return;
    if (stagger_ticks > 0) { const unsigned long long t0 = __builtin_amdgcn_s_memrealtime(); while ((long long)(__builtin_amdgcn_s_memrealtime() - t0) < (long long)stagger_ticks) __builtin_amdgcn_s_sleep(8); }
    f32x4 acc[2][2][4][2];
#pragma unroll
    for (int a = 0; a < 2; ++a)
#pragma unroll
        for (int b = 0; b < 2; ++b)
#pragma unroll
            for (int m = 0; m < 4; ++m)
#pragma unroll
                for (int n = 0; n < 2; ++n) acc[a][b][m][n] = (f32x4){0.f, 0.f, 0.f, 0.f};
    typedef int v4i_ __attribute__((ext_vector_type(4))); typedef int v8i_ __attribute__((ext_vector_type(8)));
    struct FragB { bf16x8 v[2]; }; struct Frag8 { v8i_ v; };
    typename std::conditional<FP8, Frag8, FragB>::type At[4], B0[2], B1[2];
    const char* cA = cur.a; const char* cB = cur.b;
    if (GATHER) { PG8_GOFF(vc0, vc1, 0); }
    PG8_STAGE(PG8_SB(0, 0), cB, voffB); PG8_STAGE(PG8_SB(0, 1), cB + hstepB, voffB); PG8_STAGE(PG8_SA(0, 0), cA, vc0); PG8_STAGE(PG8_SA(0, 1), cA + hstepA, vc1);
    if (wr == 1) PG8_BAR;
    PG8_WAIT_V(2); PG8_BAR;
    PG8_STAGE(PG8_SB(1, 0), cB + kstep, voffB); PG8_STAGE(PG8_SA(1, 0), cA + kstep, vc0); PG8_STAGE(PG8_SB(1, 1), cB + hstepB + kstep, voffB);
    PG8_WAIT_V(6); PG8_BAR;
    for (;;) {
        const bool has_next = S.next(ui + 1, nxt);
        const char* nA = has_next ? nxt.a : cA; const char* nB = has_next ? nxt.b : cB;
        if constexpr (Epi::HOOKS) E.begin(cur, ui, tid);
        if (GATHER) { if (has_next) { PG8_GOFF(vn0, vn1, ui + 1); } else { vn0[0] = vc0[0]; vn0[1] = vc0[1]; vn1[0] = vc1[0]; vn1[1] = vc1[1]; } }
        int ntu = nt, kskip = 0; if constexpr (Sched::KMAP) { ntu = __builtin_amdgcn_readfirstlane(S.nk(ui)); kskip = __builtin_amdgcn_readfirstlane(S.kskip(ui)); asm volatile("" : "+s"(ntu), "+s"(kskip)); }
        for (int t = 0; t < ntu; t += 2) {
            const bool last = (t == ntu - 2);
            if constexpr (Epi::HOOKS) { if (t == nt / 2) E.mid(acc, ui, wr, fr); }
#ifdef PROBE_EPI_TWICE
            if constexpr (KREP == 3) { if (t == ntk / 2) E.fin(acc, cur, ui, wr, wc, fr, fq); }
#endif
            int k1 = (t + 1) % ntk, k2 = (t + 2) % ntk; if constexpr (Sched::KMAP) { k1 = t + 1 + ((t + 1 >= 4) ? kskip : 0); k2 = t + 2 + ((t + 2 >= 4) ? kskip : 0); }
            const char* a1 = cA + (size_t)k1 * kstep;
            const char* a2 = last ? nA : cA + (size_t)k2 * kstep; const char* b2 = last ? nB : cB + (size_t)k2 * kstep;
            const char* a3 = a2 + kstep; const char* b3 = b2 + kstep;
            unsigned w0[2], w1[2];
            w0[0] = (GATHER && last) ? vn0[0] : vc0[0]; w0[1] = (GATHER && last) ? vn0[1] : vc0[1]; w1[0] = (GATHER && last) ? vn1[0] : vc1[0]; w1[1] = (GATHER && last) ? vn1[1] : vc1[1];
            PG8_LDB(B0, 0, 0); PG8_LDB(B1, 0, 1); PG8_SCHED; PG8_LDA(At, 0, 0); PG8_STAGE(PG8_SA(1, 1), a1 + hstepA, vc1);
            PG8_WAIT_V(8); PG8_WAIT_L(0); PG8_BAR; PG8_MMA(0, 0, At, B0); PG8_MMA(0, 1, At, B1); PG8_BAR; PG8_SCHED;
            PG8_LDA(At, 0, 1); PG8_STAGE(PG8_SB(0, 0), b2, voffB); PG8_STAGE(PG8_SB(0, 1), b2 + hstepB, voffB); PG8_STAGE(PG8_SA(0, 0), a2, w0);
            PG8_WAIT_V(8); PG8_WAIT_L(0); PG8_BAR; PG8_MMA(1, 0, At, B0); PG8_MMA(1, 1, At, B1); PG8_BAR; PG8_SCHED;
            PG8_LDB(B0, 1, 0); PG8_LDB(B1, 1, 1); PG8_SCHED; PG8_LDA(At, 1, 0); PG8_STAGE(PG8_SA(0, 1), a2 + hstepA, w1);
            PG8_WAIT_V(8); PG8_WAIT_L(0); PG8_BAR; PG8_MMA(0, 0, At, B0); PG8_MMA(0, 1, At, B1); PG8_BAR; PG8_SCHED;
            PG8_LDA(At, 1, 1); PG8_STAGE(PG8_SB(1, 0), b3, voffB); PG8_STAGE(PG8_SB(1, 1), b3 + hstepB, voffB); PG8_STAGE(PG8_SA(1, 0), a3, w0);
            PG8_WAIT_V(8); PG8_WAIT_L(0); PG8_BAR; PG8_MMA(1, 0, At, B0); PG8_MMA(1, 1, At, B1); PG8_BAR; PG8_SCHED;
        }
        if (wr == 0) PG8_BAR;
        if constexpr (FP8) asm volatile("s_nop 15\n\ts_nop 7" ::: "memory");
        if constexpr (KREP > 1) {
#pragma unroll
            for (int a = 0; a < 2; ++a)
#pragma unroll
                for (int b = 0; b < 2; ++b)
#pragma unroll
                    for (int m = 0; m < 4; ++m)
#pragma unroll
                        for (int n = 0; n < 2; ++n) acc[a][b][m][n] = acc[a][b][m][n] * (KREP == 3 ? 1.f : 1.f / KREP); }
        if constexpr (Epi::SIDE) {
            constexpr int SIDE_MODE = Epi::SIDE_WHOLE ? 1 : 0;
            SideItem sit; f32x4 sv[4], sw[4]; const bool side = (E.side_r0 >= 0);
            if (side) { sit = moe_side_item(E.side_r0 + wid + 2048 * ui); side_load(sit, lane, 0, sv); if (SIDE_MODE == 1) side_load(sit, lane, 1, sw); }
            asm volatile("" ::: "memory"); PG8_SCHED;
            if constexpr (Epi::HOOKS) E.template finh<0>(acc, cur, ui, wr, wc, fr, fq); else E.template half<0>(acc, cur, wr, wc, fr, fq);
            asm volatile("" ::: "memory"); PG8_SCHED;
            if (side && SIDE_MODE == 0) { side_store(sit, lane, 0, sv, (const LAS float*)(lds + GF_OFF)); side_load(sit, lane, 1, sw); }
            asm volatile("" ::: "memory"); PG8_SCHED;
            if constexpr (Epi::HOOKS) E.template finh<1>(acc, cur, ui, wr, wc, fr, fq); else E.template half<1>(acc, cur, wr, wc, fr, fq);
            asm volatile("" ::: "memory"); PG8_SCHED;
            if (side) { if (SIDE_MODE == 1) side_store(sit, lane, 0, sv, (const LAS float*)(lds + GF_OFF)); side_store(sit, lane, 1, sw, (const LAS float*)(lds + GF_OFF)); }
        } else { if constexpr (Epi::HOOKS) E.fin(acc, cur, ui, wr, wc, fr, fq); else E(acc, cur, wr, wc, fr, fq); }
        if (!has_next) break;
#pragma unroll
        for (int a = 0; a < 2; ++a)
#pragma unroll
            for (int b = 0; b < 2; ++b)
#pragma unroll
                for (int m = 0; m < 4; ++m)
#pragma unroll
                    for (int n = 0; n < 2; ++n) acc[a][b][m][n] = (f32x4){0.f, 0.f, 0.f, 0.f};
        cur = nxt; cA = nA; cB = nB; ++ui;
        if (GATHER) { vc0[0] = vn0[0]; vc0[1] = vn0[1]; vc1[0] = vn1[0]; vc1[1] = vn1[1]; }
        if (wr == 1) PG8_BAR;
    }
    PG8_WAIT_V(0);
    PG8_BAR;
#undef PG8_GOFF
#undef PG8_SA
#undef PG8_SB
#undef PG8_STAGE
#undef PG8_LDA
#undef PG8_LDB
#undef PG8_MMA
#undef PG8_WAIT_V
#undef PG8_WAIT_L
#undef PG8_BAR
#undef PG8_SCHED
}

struct DenseOrder {
    static constexpr bool KMAP = false;
    const char* A; const char* B; size_t a_tile, b_tile; int nM, nN, nwg, G, c;
    __device__ __forceinline__ bool next(int i, Unit& u) const {
        const long L = (long)i * G + c; if (L >= nwg) return false;
        int wgid = (int)L; { const int q = nwg / 8, r = nwg % 8, xcd = wgid % 8, off = wgid / 8; wgid = (xcd < r ? xcd * (q + 1) : r * (q + 1) + (xcd - r) * q) + off; }
        const int nig = 8 * nN, gid = wgid / nig, fm = gid * 8, gsz = (nM - fm) < 8 ? (nM - fm) : 8;
        u.pm = fm + ((wgid % nig) % gsz); u.pn = (wgid % nig) / gsz; u.aux = 0;
        u.a = A + (size_t)u.pm * a_tile; u.b = B + (size_t)u.pn * b_tile; return true;
    }
};
struct GroupOrder {
    static constexpr bool KMAP = false;
    const char* A; const char* B; size_t a_grp, b_grp, a_tile, b_tile; int nM, nN, nwg, G, c;
    __device__ __forceinline__ bool next(int i, Unit& u) const {
        const long L = (long)i * G + c; if (L >= nwg) return false;
        const int per = nM * nN, g = (int)L / per, r = (int)L % per;
        u.pn = r / nM; u.pm = r % nM; u.aux = g;
        u.a = A + (size_t)g * a_grp + (size_t)u.pm * a_tile; u.b = B + (size_t)g * b_grp + (size_t)u.pn * b_tile; return true;
    }
};
struct S5MainOrder {
    static constexpr bool KMAP = true;
    __device__ __forceinline__ int nk(int ui) const { return ((((c >> 3) & 1) ^ ui) == 0) ? 6 : 10; }
    __device__ __forceinline__ int kskip(int ui) const { return ((((c >> 3) & 1) ^ ui) == 0) ? 4 : 0; }
    const char* A; const char* B; size_t a_grp, b_grp, a_tile, b_tile; int c;
    __device__ __forceinline__ bool next(int i, Unit& u) const {
        if (i >= 2) return false;
        u.aux = 16 * i + (c >> 4); u.pm = c & 7; u.pn = ((c >> 3) & 1) ^ i;
        u.a = A + (size_t)u.aux * a_grp + (size_t)u.pm * a_tile; u.b = B + (size_t)u.aux * b_grp + (size_t)u.pn * b_tile; return true;
    }
};
__device__ __forceinline__ void moe_unit(int L, int ntiles, int& pm, int& pn) {
    const int j = L >> 5, full = ntiles >> 3;
    if (j < full) { const int r = L & 31; pm = 8 * j + (r & 7); pn = r >> 3; }
    else { const int gsz = ntiles - 8 * full, r = L - 32 * full; pm = 8 * full + r % gsz; pn = r / gsz; }
}
struct MoeOrder {
    static constexpr bool KMAP = false;
    const char* A; const char* B; size_t a_tile, b_exp, b_tile; const LAS unsigned char* t2e; int ntiles, G, c;
    __device__ __forceinline__ bool next(int i, Unit& u) const {
        const long L = (long)i * G + c; if (L >= (long)ntiles * 4) return false;
        moe_unit((int)L, ntiles, u.pm, u.pn); u.aux = t2e[u.pm];
        u.a = A + (size_t)u.pm * a_tile; u.b = B + (size_t)u.aux * b_exp + (size_t)u.pn * b_tile; return true;
    }
};

typedef f32x4 Acc[2][2][4][2];
constexpr float YE_SCALE = 8.f;

__device__ __forceinline__ void store_pair(bf16* row_even, size_t pitch, u32x4 p0, u32x4 p1, int fr, int fq) {
    const bool odd = fr & 1;
    const u32x4 send = odd ? p0 : p1; u32x4 recv;
    recv.x = dppu<0xB1>(send.x); recv.y = dppu<0xB1>(send.y); recv.z = dppu<0xB1>(send.z); recv.w = dppu<0xB1>(send.w);
    const u32x4 a = odd ? recv : p0, b = odd ? p1 : recv;
    bf16* d = row_even + (odd ? 32 : 0) + 8 * fq;
#ifdef NT_STORES
    __builtin_nontemporal_store(a, (u32x4*)d); __builtin_nontemporal_store(b, (u32x4*)(d + pitch));
#else
    *(u32x4*)d = a; *(u32x4*)(d + pitch) = b;
#endif
}
struct EpiProj {
#ifndef SIDE_WHOLE1
#define SIDE_WHOLE1 1
#endif
    static constexpr bool HALFN = false, HOOKS = false, PERM = true, SIDE = true, SIDE_WHOLE = (SIDE_WHOLE1 != 0);
    bf16* U2; bf16* QKV; const LAS float* GQK; int side_r0; unsigned char* side_ws;
    __device__ __forceinline__ void operator()(const Acc& acc, const Unit& u, int wr, int wc, int fr, int fq) const { half<0>(acc, u, wr, wc, fr, fq); half<1>(acc, u, wr, wc, fr, fq); }
    template <int AI> __device__ __forceinline__ void half(const Acc& acc, const Unit& u, int wr, int wc, int fr, int fq) const {
        asm volatile("" : "+v"(fr), "+v"(fq));
        const int typ = u.pn >> 1;
        if (typ == 1 || typ == 2) run<true, AI>(acc, u, wr, wc, fr, fq); else run<false, AI>(acc, u, wr, wc, fr, fq);
    }
    template <bool nrm, int AI> __device__ __forceinline__ void run(const Acc& acc, const Unit& u, int wr, int wc, int fr, int fq) const {
        const int typ = u.pn >> 1, sub = u.pn & 1;
        const LAS float* gg = GQK + ((typ == 1) ? 0 : 64);
        f32x4 gn[2][2];
#pragma unroll
        for (int bj = 0; bj < 2; ++bj)
#pragma unroll
            for (int n = 0; n < 2; ++n) gn[bj][n] = nrm ? *(const LAS f32x4*)(gg + 32 * bj + 8 * fq + 4 * n) : (f32x4){1.f, 1.f, 1.f, 1.f};
        { constexpr int ai = AI;
#pragma unroll
            for (int m = 0; m < 4; ++m) {
                const int r = u.pm * BM + ai * HALF + wr * 64 + m * 16 + fr;
                f32x4 v[2][2];
#pragma unroll
                for (int bj = 0; bj < 2; ++bj)
#pragma unroll
                    for (int n = 0; n < 2; ++n) v[bj][n] = acc[ai][bj][m][n];
                if constexpr (nrm) {
                    float s = 0.f;
#pragma unroll
                    for (int bj = 0; bj < 2; ++bj)
#pragma unroll
                        for (int n = 0; n < 2; ++n) s += (v[bj][n].x * v[bj][n].x + v[bj][n].y * v[bj][n].y) + (v[bj][n].z * v[bj][n].z + v[bj][n].w * v[bj][n].w);
                    s = xor32_sum(xor16_sum(s));
                    const float rstd = nrm ? __builtin_amdgcn_rsqf(s * (1.f / 64.f) + EPS) : 1.f;
#pragma unroll
                    for (int bj = 0; bj < 2; ++bj)
#pragma unroll
                        for (int n = 0; n < 2; ++n) v[bj][n] = v[bj][n] * (gn[bj][n] * rstd);
                }
                u32x4 p[2];
#pragma unroll
                for (int bj = 0; bj < 2; ++bj) { p[bj].x = cvtpk(v[bj][0].x, v[bj][0].y); p[bj].y = cvtpk(v[bj][0].z, v[bj][0].w); p[bj].z = cvtpk(v[bj][1].x, v[bj][1].y); p[bj].w = cvtpk(v[bj][1].z, v[bj][1].w); }
                if (!nrm && typ == 0) {
#pragma unroll
                    for (int bj = 0; bj < 2; ++bj) { const int f = sub * 256 + 64 * wc + 32 * bj + 8 * fq, g = f >> 4, h = f & 15;
                        *(u32x4*)(U2 + ((size_t)g * NCH + (r >> 5)) * U2P + (r & 31) * 16 + h) = p[bj]; }
                } else store_pair(QKV + (size_t)(typ - 1) * ((size_t)M * 512) + (size_t)(r & ~1) * 512 + sub * 256 + 64 * wc, 512, p[0], p[1], fr, fq);
            } }
    }
};
struct EpiState {
    static constexpr bool HALFN = true, HOOKS = false, PERM = false, SIDE = false;
    float* SST;
    __device__ __forceinline__ void operator()(const Acc& acc, const Unit& u, int wr, int wc, int fr, int fq) const {
#pragma unroll
        for (int ai = 0; ai < 2; ++ai)
#pragma unroll
            for (int m = 0; m < 4; ++m) { const int r = u.pm * BM + ai * HALF + wr * 64 + m * 16 + fr;
#pragma unroll
                for (int n = 0; n < 2; ++n) *(f32x4*)(SST + ((size_t)u.aux * NCH + r) * 128 + 32 * wc + 16 * n + 4 * fq) = acc[ai][0][m][n]; }
    }
};
struct EpiS5 {
    static constexpr bool HALFN = false, HOOKS = false, PERM = true, SIDE = false;
    bf16* Z;
    __device__ __forceinline__ void operator()(const Acc& acc, const Unit& u, int wr, int wc, int fr, int fq) const {
#pragma unroll
        for (int ai = 0; ai < 2; ++ai)
#pragma unroll
            for (int m = 0; m < 4; ++m) { const int r = u.pm * BM + ai * HALF + wr * 64 + m * 16 + fr;
#pragma unroll
                for (int bj = 0; bj < 2; ++bj) { const int c0 = u.pn * BM + bj * HALF + 32 * wc + 8 * fq, i = c0 >> 4, h = c0 & 15;
                    const f32x4 a = acc[ai][bj][m][0], b = acc[ai][bj][m][1];
                    u32x4 w; w.x = cvtpk(gelu_tanh(a.x), gelu_tanh(a.y)); w.y = cvtpk(gelu_tanh(a.z), gelu_tanh(a.w)); w.z = cvtpk(gelu_tanh(b.x), gelu_tanh(b.y)); w.w = cvtpk(gelu_tanh(b.z), gelu_tanh(b.w));
                    *(u32x4*)(Z + ((size_t)r * 32 + i) * DSSM + u.aux * 16 + h) = w; } }
    }
};
struct EpiGlu {
    static constexpr bool HALFN = false, HOOKS = false, PERM = true, SIDE = false;
    const bf16* Z; const float* bias; bf16* MIX; float* SSQ;
    __device__ __forceinline__ void operator()(const Acc& acc, const Unit& u, int wr, int wc, int fr, int fq) const {
        float ss[2][4];
#pragma unroll
        for (int ai = 0; ai < 2; ++ai)
#pragma unroll
            for (int m = 0; m < 4; ++m) ss[ai][m] = 0.f;
#pragma unroll
        for (int bj = 0; bj < 2; ++bj) { const int c0 = u.pn * BM + bj * HALF + 32 * wc + 8 * fq;
            constexpr float NL2E = -1.4426950408889634f;
            const f32x4 b0 = *(const GAS f32x4*)(bias + c0) * NL2E, b1 = *(const GAS f32x4*)(bias + c0 + 4) * NL2E;
#pragma unroll
            for (int ai = 0; ai < 2; ++ai)
#pragma unroll
                for (int m = 0; m < 4; ++m) { const size_t row = (size_t)(u.pm * BM + ai * HALF + wr * 64 + m * 16 + fr);
                    const u32x4 zz = *(const u32x4*)(Z + row * DSSM + c0);
                    const f32x4 a = acc[ai][bj][m][0], b = acc[ai][bj][m][1];
#define GLU_SG(v_, b_) __builtin_amdgcn_rcpf(1.f + __builtin_amdgcn_exp2f(__builtin_fmaf((v_), NL2E, (b_))))
                    float y[8];
                    y[0] = bf2f(zz.x & 0xffff) * GLU_SG(a.x, b0.x); y[1] = bf2f(zz.x >> 16) * GLU_SG(a.y, b0.y); y[2] = bf2f(zz.y & 0xffff) * GLU_SG(a.z, b0.z); y[3] = bf2f(zz.y >> 16) * GLU_SG(a.w, b0.w);
                    y[4] = bf2f(zz.z & 0xffff) * GLU_SG(b.x, b1.x); y[5] = bf2f(zz.z >> 16) * GLU_SG(b.y, b1.y); y[6] = bf2f(zz.w & 0xffff) * GLU_SG(b.z, b1.z); y[7] = bf2f(zz.w >> 16) * GLU_SG(b.w, b1.w);
#undef GLU_SG
                    { float sq = ss[ai][m];
#pragma unroll
                      for (int e = 0; e < 8; ++e) sq = __builtin_fmaf(y[e], y[e], sq);
                      ss[ai][m] = sq; }
                    u32x4 w; w.x = cvtpk(y[0], y[1]); w.y = cvtpk(y[2], y[3]); w.z = cvtpk(y[4], y[5]); w.w = cvtpk(y[6], y[7]);
                    *(u32x4*)(MIX + row * PX + c0) = w; } }
#pragma unroll
        for (int ai = 0; ai < 2; ++ai)
#pragma unroll
            for (int m = 0; m < 4; ++m) { float v = xor32_sum(xor16_sum(ss[ai][m]));
                if (fq == 0) atomicAdd(SSQ + (u.pm * BM + ai * HALF + wr * 64 + m * 16 + fr), v); }
    }
};
struct EpiX1B {
#ifndef SIDE7
#define SIDE7 1
#endif
    static constexpr bool HALFN = false, HOOKS = true, PERM = true, SIDE = (SIDE7 != 0), SIDE_WHOLE = false;
    int side_r0; unsigned char* side_ws;
    const float* RSTDX; bf16* X1B; const float* SSQS; const float* SSQA; LAS float* RSC;
    __device__ __forceinline__ void begin(const Unit&, int, int) const {}
    __device__ __forceinline__ void fill(int ui, int pm, int tid) const {
        if (tid < 256) { const int row = pm * BM + tid; const float rs = __builtin_amdgcn_rsqf(SSQS[row] * (1.f / 512.f) + EPS), ra = __builtin_amdgcn_rsqf(SSQA[row] * (1.f / 512.f) + EPS);
            LAS float* d = RSC + (ui * 256 + tid) * 3; d[0] = rs * __builtin_amdgcn_rcpf(ra); d[1] = ra; d[2] = __builtin_amdgcn_rcpf(RSTDX[row]); }
    }
    __device__ __forceinline__ void mid(Acc& acc, int ui, int wr, int fr) const {
#pragma unroll
        for (int ai = 0; ai < 2; ++ai)
#pragma unroll
            for (int m = 0; m < 4; ++m) { const float f = RSC[(ui * 256 + ai * HALF + wr * 64 + m * 16 + fr) * 3];
#pragma unroll
                for (int bj = 0; bj < 2; ++bj)
#pragma unroll
                    for (int n = 0; n < 2; ++n) acc[ai][bj][m][n] = acc[ai][bj][m][n] * f; }
    }
    __device__ __forceinline__ void fin(const Acc& acc, const Unit& u, int ui, int wr, int wc, int fr, int fq) const { finh<0>(acc, u, ui, wr, wc, fr, fq); finh<1>(acc, u, ui, wr, wc, fr, fq); }
    template <int AI> __device__ __forceinline__ void finh(const Acc& acc, const Unit& u, int ui, int wr, int wc, int fr, int fq) const {
        constexpr int ai = AI;
#pragma unroll
            for (int m = 0; m < 4; ++m) { const int rl = ai * HALF + wr * 64 + m * 16 + fr; const LAS float* rc = RSC + (ui * 256 + rl) * 3; const float ra = rc[1], ix = rc[2];
                const size_t ro = (size_t)(u.pm * BM + rl) * PX + u.pn * BM + 64 * wc + 8 * fq;
                u32x4 p[2];
#pragma unroll
                for (int bj = 0; bj < 2; ++bj) { const u32x4 xn = *(const u32x4*)(X1B + ro + 32 * bj);
                    const f32x4 xa = (f32x4){bf2f(xn.x & 0xffff), bf2f(xn.x >> 16), bf2f(xn.y & 0xffff), bf2f(xn.y >> 16)} * ix, xb = (f32x4){bf2f(xn.z & 0xffff), bf2f(xn.z >> 16), bf2f(xn.w & 0xffff), bf2f(xn.w >> 16)} * ix;
                    const f32x4 a = xa + acc[ai][bj][m][0] * ra, b = xb + acc[ai][bj][m][1] * ra;
                    p[bj].x = cvtpk(a.x, a.y); p[bj].y = cvtpk(a.z, a.w); p[bj].z = cvtpk(b.x, b.y); p[bj].w = cvtpk(b.z, b.w); }
                store_pair(X1B + (size_t)(u.pm * BM + (rl & ~1)) * PX + u.pn * BM + 64 * wc, PX, p[0], p[1], fr, fq); }
    }
};
struct EpiGU {
    static constexpr bool HALFN = false, HOOKS = true, PERM = true, SIDE = false;
    __device__ __forceinline__ void begin(const Unit&, int, int) const {}
    __device__ __forceinline__ void mid(Acc&, int, int, int) const {}
    unsigned char* HH; const LAS unsigned* RCW;
    __device__ __forceinline__ void fin(const Acc& acc, const Unit& u, int ui, int wr, int wc, int fr, int fq) const {
#pragma unroll
        for (int ai = 0; ai < 2; ++ai)
#pragma unroll
            for (int m = 0; m < 4; ++m) { const int rl = ai * HALF + wr * 64 + m * 16 + fr, rr = u.pm * BM + rl; const size_t off = (size_t)rr * DE + u.pn * 128 + 32 * wc + 8 * fq;
                const float sc = __uint_as_float(RCW[ui * 256 + rl] & 0xffff0000u) * (1.f / W8SC), k1 = sc * -1.4426950408889634f, sc2 = sc * sc;
#define GU_H(g_, u_) (((g_) * (u_)) * __builtin_amdgcn_rcpf(1.f + __builtin_amdgcn_exp2f((g_) * k1)) * sc2)
                float hv[8];
#pragma unroll
                for (int n = 0; n < 2; ++n) { const f32x4 gt = acc[ai][0][m][n], up = acc[ai][1][m][n];
                    hv[4 * n] = GU_H(gt.x, up.x); hv[4 * n + 1] = GU_H(gt.y, up.y); hv[4 * n + 2] = GU_H(gt.z, up.z); hv[4 * n + 3] = GU_H(gt.w, up.w); }
#undef GU_H
                u32x2 w; w.x = pk4_fp8(hv[0], hv[1], hv[2], hv[3]); w.y = pk4_fp8(hv[4], hv[5], hv[6], hv[7]);
                *(u32x2*)(HH + off) = w; }
    }
};
struct EpiDown {
    static constexpr bool HALFN = false, HOOKS = true, PERM = true, SIDE = false;
    __device__ __forceinline__ void begin(const Unit&, int, int) const {}
    __device__ __forceinline__ void mid(Acc&, int, int, int) const {}
    unsigned char* YE; const LAS float* RGC;
    __device__ __forceinline__ void fin(const Acc& acc, const Unit& u, int ui, int wr, int wc, int fr, int fq) const {
#pragma unroll
        for (int ai = 0; ai < 2; ++ai)
#pragma unroll
            for (int m = 0; m < 4; ++m) { const int rl = ai * HALF + wr * 64 + m * 16 + fr; const float gw_ = RGC[ui * 256 + rl] * (YE_SCALE / W8SC);
                u32x2 p[2];
#pragma unroll
                for (int bj = 0; bj < 2; ++bj) { const f32x4 a = acc[ai][bj][m][0] * gw_, b = acc[ai][bj][m][1] * gw_; p[bj].x = pk4_fp8(a.x, a.y, a.z, a.w); p[bj].y = pk4_fp8(b.x, b.y, b.z, b.w); }
                const bool od = fq & 1; const u32x2 send = od ? p[0] : p[1]; u32x2 recv; recv.x = xor16_get(send.x, od); recv.y = xor16_get(send.y, od);
                u32x4 w; if (od) { w.x = recv.x; w.y = recv.y; w.z = p[1].x; w.w = p[1].y; } else { w.x = p[0].x; w.y = p[0].y; w.z = recv.x; w.w = recv.y; }
                *(u32x4*)(YE + (size_t)(u.pm * BM + rl) * DM + u.pn * BM + 64 * wc + (od ? 32 : 0) + 8 * (fq & ~1)) = w; }
    }
};

template <int K> __device__ __forceinline__ const float* karg() {
    const float* p;
    asm volatile("s_load_dwordx2 %0, %1, %2\n\ts_waitcnt lgkmcnt(0)" : "=s"(p) : "s"(__builtin_amdgcn_kernarg_segment_ptr()), "i"(K * 8) : "memory");
    return p;
}
struct Args { const float* in[26]; float* out; unsigned char* ws; int ph_lo, ph_hi; };
struct Frame { LAS unsigned char* lds; volatile LAS unsigned* MISC; unsigned* ctl; int tid, lane, wave, G, c; };

struct TItem { const float* W; int ldw, srccol0; const float* kscale; bf16* WT; int ldt, dstrow0, k0; int fp8; };
__device__ __forceinline__ void titem_load(const TItem& t, int lane, f32x4 (&v)[8]) {
#pragma unroll
    for (int i = 0; i < 8; ++i) { const int kk = 8 * i + (lane >> 3); v[i] = *(const GAS f32x4*)(t.W + (size_t)(t.k0 + kk) * t.ldw + t.srccol0 + (lane & 7) * 4); }
}
__device__ __forceinline__ void titem_store(const TItem& t, int lane, const f32x4 (&v)[8], LAS float* scr) {
#pragma unroll
    for (int i = 0; i < 8; ++i) { const int kk = 8 * i + (lane >> 3); const float sc = t.kscale ? t.kscale[t.k0 + kk] : 1.f; LAS float* d = scr + kk * 33 + (lane & 7) * 4;
        d[0] = v[i].x * sc; d[1] = v[i].y * sc; d[2] = v[i].z * sc; d[3] = v[i].w * sc; }
    asm volatile("s_waitcnt lgkmcnt(0)" ::: "memory");
    const int c = lane & 7;
#pragma unroll
    for (int j = 0; j < 4; ++j) { const int n = (lane >> 3) + 8 * j; const LAS float* s = scr + (8 * c) * 33 + n;
        if (t.fp8) { u32x2 o; o.x = pk4_fp8(s[0 * 33] * W8SC, s[1 * 33] * W8SC, s[2 * 33] * W8SC, s[3 * 33] * W8SC); o.y = pk4_fp8(s[4 * 33] * W8SC, s[5 * 33] * W8SC, s[6 * 33] * W8SC, s[7 * 33] * W8SC);
            *(u32x2*)((unsigned char*)t.WT + (size_t)(t.dstrow0 + n) * t.ldt + t.k0 + 8 * c) = o; }
        else { u32x4 o; o.x = pk2(s[0 * 33], s[1 * 33]); o.y = pk2(s[2 * 33], s[3 * 33]); o.z = pk2(s[4 * 33], s[5 * 33]); o.w = pk2(s[6 * 33], s[7 * 33]);
            *(u32x4*)(t.WT + (size_t)(t.dstrow0 + n) * t.ldt + t.k0 + 8 * c) = o; } }
    asm volatile("s_waitcnt lgkmcnt(0)" ::: "memory");
}
__device__ __forceinline__ void s5_tables_item(Frame& F, const Args& a, int g, int part) {
    const float* lre = karg<3>(); const float* lim = karg<4>(); const float* ldt = karg<5>(); const float* bre = karg<6>(); const float* bim = karg<7>();
    const float* cre = karg<8>(); const float* cim = karg<9>(); const float* dsk = karg<10>();
    LAS float* PWr = (LAS float*)F.lds; LAS float* PWi = PWr + 33 * 64; LAS float* BBr = PWi + 33 * 64; LAS float* BBi = BBr + 1024; LAS float* CCr = BBi + 1024; LAS float* CCi = CCr + 1024; LAS float* CF = CCi + 1024;
    const int tid = F.tid;
    if (tid < 64) { const int p = tid;
        const double dt = exp((double)ldt[g]), lr = lre[g * PST + p], li = lim[g * PST + p];
        double sn, cs; sincos_d(li * dt, sn, cs); const double mag = exp(lr * dt);
        const double ar = mag * cs, ai = mag * sn, den = lr * lr + li * li, nr = ar - 1.0, ni = ai;
        CF[2 * p] = (float)((nr * lr + ni * li) / den); CF[2 * p + 1] = (float)((ni * lr - nr * li) / den);
        double pr = 1.0, pi = 0.0;
        for (int l = 0; l <= 32; ++l) { PWr[l * 64 + p] = (float)pr; PWi[l * 64 + p] = (float)pi; if (l == 32 && part == 0) { float* A32 = (float*)(a.ws + FW_A32) + (g * PST + p) * 2; A32[0] = (float)pr; A32[1] = (float)pi; }
            const double t = pr * ar - pi * ai; pi = pr * ai + pi * ar; pr = t; }
    }
    __syncthreads();
    for (int idx = tid; idx < 1024; idx += NTHR) { const int p = idx >> 4; const float cfr = CF[2 * p], cfi = CF[2 * p + 1], br = bre[(size_t)g * 1024 + idx], bi = bim[(size_t)g * 1024 + idx];
        BBr[idx] = cfr * br - cfi * bi; BBi[idx] = cfr * bi + cfi * br; CCr[idx] = cre[(size_t)g * 1024 + idx]; CCi[idx] = cim[(size_t)g * 1024 + idx]; }
    __syncthreads();
    bf16* TBg = (bf16*)(a.ws + FW_TB) + (size_t)g * 512 * U2P; bf16* W1g = (bf16*)(a.ws + FW_W1) + (size_t)g * 256 * 512;
    for (int l = part; l < 32; l += 8) {
        if (tid < 256) { const int h = tid >> 4, hp = tid & 15; float k = 0.f;
#pragma unroll 16
            for (int p = 0; p < 64; ++p) { const float wr_ = PWr[l * 64 + p], wi_ = PWi[l * 64 + p], br = BBr[p * 16 + hp], bi = BBi[p * 16 + hp];
                k += CCr[h * 64 + p] * (wr_ * br - wi_ * bi) - CCi[h * 64 + p] * (wr_ * bi + wi_ * br); }
            if (l == 0 && h == hp) k += dsk[g * 16 + h];
            const bf16 v = (bf16)f2bf(k);
            for (int i = l; i < 32; ++i) TBg[(size_t)(i * 16 + h) * U2P + (i - l) * 16 + hp] = v;
            if (l >= 1) for (int i = 0; i < 32 - l; ++i) TBg[(size_t)(i * 16 + h) * U2P + (i + l) * 16 + hp] = 0;
        } else { const int t2 = tid - 256;
#pragma unroll
            for (int x = 0; x < 8; ++x) { const int e = t2 * 8 + x;
                { const int h = e >> 7, q = e & 127, p = q & 63; const float cr = CCr[h * 64 + p], ci = CCi[h * 64 + p], wr_ = PWr[(l + 1) * 64 + p], wi_ = PWi[(l + 1) * 64 + p];
                  const float re = cr * wr_ - ci * wi_, im = cr * wi_ + ci * wr_; TBg[(size_t)(l * 16 + h) * U2P + 512 + q] = (bf16)f2bf(q < 64 ? re : -im); }
                { const int rho = e >> 4, hp = e & 15, p = rho & 63; const float wr_ = PWr[(31 - l) * 64 + p], wi_ = PWi[(31 - l) * 64 + p], br = BBr[p * 16 + hp], bi = BBi[p * 16 + hp];
                  const float re = wr_ * br - wi_ * bi, im = wr_ * bi + wi_ * br; W1g[(size_t)rho * 512 + l * 16 + hp] = (bf16)f2bf(rho < 64 ? re : im); W1g[(size_t)(128 + rho) * 512 + l * 16 + hp] = 0; }
            }
        }
    }
    __syncthreads();
}
#ifndef XNR
#define XNR 8
#endif
__device__ __forceinline__ void p0_prologue(Frame& F, const Args& a) {
    const float* x = karg<0>();
    for (int it = F.c; it < 256; it += F.G) s5_tables_item(F, a, it >> 3, it & 7);
    LAS float* scr = (LAS float*)(F.lds + F.wave * 16384);
    const int gw = F.c * NWAVES + F.wave, NGW = F.G * NWAVES;
    constexpr int I_IN = 16 * 64, I_GLU = 8 * 16, I_OUT = 16 * 32, I_GU = 32 * 16 * 32, I_D = 32 * 8 * 32, NITEMS = I_IN + I_GLU + I_OUT + I_GU + I_D;
    bf16* WIN = (bf16*)(a.ws + FW_WIN); bf16* WGLU = (bf16*)(a.ws + FW_WGLU); bf16* WOUT = (bf16*)(a.ws + FW_WOUT); bf16* WGU = (bf16*)(a.ws + FW_WGU); bf16* WD = (bf16*)(a.ws + FW_WD);
    auto mkitem = [&](int it) -> TItem {
        int r = it;
        if (r < I_IN) { const int kb = r >> 6, d = r & 63, pn = d >> 3, beta = d & 7, bj = beta >> 2, wc = beta & 3;
            return TItem{karg<2>(), DIN, 256 * pn + 32 * (2 * wc + bj), karg<1>(), WIN, PW, 32 * d, 64 * kb, 0}; } r -= I_IN;
        if (r < I_GLU) { const int kb = r >> 4, d = r & 15; return TItem{karg<11>(), DSSM, 32 * d, nullptr, WGLU, DSSM, 32 * d, 64 * kb, 0}; } r -= I_GLU;
        if (r < I_OUT) { const int kb = r >> 5, d = r & 31; const float* ks = (kb < 8) ? karg<15>() : (karg<16>() - 512);
            return TItem{karg<17>(), DM, 32 * (8 * (d >> 3) + 2 * (d & 3) + ((d & 7) >> 2)), ks, WOUT, PW, 32 * d, 64 * kb, 0}; } r -= I_OUT;
        if (r < I_GU) { const int e = r >> 9, q = r & 511, kb = q >> 5, d = q & 31, pn = d >> 3, beta = d & 7;
            const float* W = (beta < 4 ? karg<23>() : karg<24>()) + (size_t)e * DM * DE;
            return TItem{W, DE, 128 * pn + 32 * (beta & 3), karg<18>(), (bf16*)((unsigned char*)WGU + (size_t)e * DM * DM), DM, 32 * d, 64 * kb, 1}; } r -= I_GU;
        const int e = r >> 8, q = r & 255, kb = q >> 5, d = q & 31;
        return TItem{karg<25>() + (size_t)e * DE * DM, DM, 32 * (8 * (d >> 3) + 2 * (d & 3) + ((d & 7) >> 2)), nullptr, (bf16*)((unsigned char*)WD + (size_t)e * DM * DE), DE, 32 * d, 64 * kb, 1};
    };
    const int nitems = (F.G == 256) ? (I_IN + I_GLU + I_OUT) : NITEMS;
    if (gw < nitems) {
        TItem cur = mkitem(gw); f32x4 vc[8]; titem_load(cur, F.lane, vc);
        for (int it = gw; it < nitems; it += NGW) {
            const bool more = it + NGW < nitems; TItem nxt = cur; f32x4 vn[8];
            if (more) { nxt = mkitem(it + NGW); titem_load(nxt, F.lane, vn); }
            titem_store(cur, F.lane, vc, scr);
            if (more) { cur = nxt;
#pragma unroll
                for (int i = 0; i < 8; ++i) vc[i] = vn[i]; }
        }
    }
    { bf16* WR = (bf16*)(a.ws + FW_WR);
      for (int idx = F.c * NTHR + F.tid; idx < 64 * DM; idx += F.G * NTHR) { const int n = idx >> 10, k = idx & 1023;
          float v = 0.f; if (n < 4) v = karg<19>()[k * 4 + n]; else if (n < 36) v = karg<21>()[k * 32 + (n - 4)];
          WR[idx] = (bf16)f2bf(v * karg<18>()[k]); } }
    bf16* XN = (bf16*)(a.ws + FW_XN); float* RSTDX = (float*)(a.ws + FW_RSTDX);
    for (int m0 = gw * XNR; m0 < M; m0 += NGW * XNR) {
        f32x4 v[XNR][4];
#pragma unroll
        for (int rr = 0; rr < XNR; ++rr) { const GAS f32x4* xr = (const GAS f32x4*)(x + (size_t)(m0 + rr) * DM);
            v[rr][0] = __builtin_nontemporal_load(xr + 2 * F.lane); v[rr][1] = __builtin_nontemporal_load(xr + 2 * F.lane + 1);
            v[rr][2] = __builtin_nontemporal_load(xr + 128 + 2 * F.lane); v[rr][3] = __builtin_nontemporal_load(xr + 128 + 2 * F.lane + 1); }
#pragma unroll
        for (int rr = 0; rr < XNR; ++rr) { float s = 0.f;
#pragma unroll
            for (int j = 0; j < 4; ++j) s += v[rr][j].x * v[rr][j].x + v[rr][j].y * v[rr][j].y + v[rr][j].z * v[rr][j].z + v[rr][j].w * v[rr][j].w;
            const float rstd = __builtin_amdgcn_rsqf(wave_sum(s) * (1.f / DM) + EPS);
            if (F.lane == 0) RSTDX[m0 + rr] = rstd;
            u32x4* o = (u32x4*)(XN + (size_t)(m0 + rr) * PX);
#pragma unroll
            for (int j = 0; j < 2; ++j) { const f32x4 a = v[rr][2 * j] * rstd, b = v[rr][2 * j + 1] * rstd; u32x4 w; w.x = cvtpk(a.x, a.y); w.y = cvtpk(a.z, a.w); w.z = cvtpk(b.x, b.y); w.w = cvtpk(b.z, b.w); o[64 * j + F.lane] = w; } }
    }
}

__device__ __forceinline__ void s5_scan_local(Frame& F, const Args& a, int g, int pm) {
    const float* SST = (const float*)(a.ws + FW_SST); bf16* U2 = (bf16*)(a.ws + FW_U2);
    if (F.tid < 256) {
        const int p = F.tid & 63;
        const float* A32 = (const float*)(a.ws + FW_A32) + (g * PST + p) * 2; const float ar = A32[0], ai = A32[1];
        float xr = 0.f, xi = 0.f;
        const size_t row0 = (size_t)g * NCH + (size_t)pm * 256 + (size_t)(F.tid >> 6) * 64;
        for (int c0 = 0; c0 < 64; c0 += 16) {
            float sr[16], si[16];
#pragma unroll
            for (int j = 0; j < 16; ++j) { sr[j] = SST[(row0 + c0 + j) * 128 + p]; si[j] = SST[(row0 + c0 + j) * 128 + 64 + p]; }
#pragma unroll
            for (int j = 0; j < 16; ++j) { bf16* up = U2 + (row0 + c0 + j) * U2P + 512; up[p] = (bf16)f2bf(xr); up[64 + p] = (bf16)f2bf(xi);
                const float t = ar * xr - ai * xi + sr[j]; xi = ar * xi + ai * xr + si[j]; xr = t; }
        }
    }
}
__device__ __forceinline__ void s5_scan(Frame& F, const Args& a) {
    const float* SST = (const float*)(a.ws + FW_SST); bf16* U2 = (bf16*)(a.ws + FW_U2);
    for (int idx = F.c * NTHR + F.tid; idx < BATCH * NG * PST; idx += F.G * NTHR) {
        const int p = idx & 63, g = (idx >> 6) & 31, b = idx >> 11;
        const double dt = exp((double)karg<5>()[g]), lr = karg<3>()[g * PST + p], li = karg<4>()[g * PST + p];
        double sn, cs; sincos_d(32.0 * li * dt, sn, cs); const double mag = exp(32.0 * lr * dt);
        const float ar = (float)(mag * cs), ai = (float)(mag * sn);
        float xr = 0.f, xi = 0.f;
        const size_t row0 = (size_t)g * NCH + (size_t)b * 64;
        for (int c0 = 0; c0 < 64; c0 += 16) {
            float sr[16], si[16];
#pragma unroll
            for (int j = 0; j < 16; ++j) { sr[j] = SST[(row0 + c0 + j) * 128 + p]; si[j] = SST[(row0 + c0 + j) * 128 + 64 + p]; }
#pragma unroll
            for (int j = 0; j < 16; ++j) { bf16* up = U2 + (row0 + c0 + j) * U2P + 512; up[p] = (bf16)f2bf(xr); up[64 + p] = (bf16)f2bf(xi);
                const float t = ar * xr - ai * xi + sr[j]; xi = ar * xi + ai * xr + si[j]; xr = t; }
        }
    }
}

#ifndef ATT_THR_V
#define ATT_THR_V -32.f
#endif
constexpr float ATT_THR = ATT_THR_V;
__device__ __forceinline__ s16x4 vtr(const LAS unsigned char* p) { typedef short v4i16_t __attribute__((ext_vector_type(4))); return __builtin_bit_cast(s16x4, __builtin_amdgcn_ds_read_tr16_b64_v4i16((LAS v4i16_t*)p)); }
__device__ __forceinline__ int crow(int r, int hi) { return (r & 3) + 8 * (r >> 2) + 4 * hi; }
#define MFMA32(a, b, c) __builtin_amdgcn_mfma_f32_32x32x16_bf16((a), (b), (c), 0, 0, 0)
template <bool DIAG, int P, int KH, int KD, int VD>
__device__ __forceinline__ float attn_half(const LAS unsigned char* Kb, const LAS unsigned char* Vb, const bf16x8 (&qr)[4], const bf16x8 (&tri)[2], f32x16 (&o)[2], float base, int lim, int lane) {
    const int r32 = lane & 31, hi = lane >> 5;
    const LAS unsigned char* kp = Kb + hi * KH + r32 * 16 + P * 512;
    const int lim2 = lim - 4 * hi;
    f32x16 z = {};
#pragma unroll
    for (int d0 = 0; d0 < 4; ++d0) { const bf16x8 kf = *(const LAS bf16x8*)(kp + d0 * KD); z = MFMA32(kf, qr[d0], z); }
    float l[16];
#pragma unroll
    for (int r = 0; r < 16; ++r) { l[r] = -__builtin_amdgcn_logf(1.f + __builtin_amdgcn_exp2f(z[r])); if (DIAG) { if (!((r & 3) + 8 * (r >> 2) + 32 * P < lim2)) l[r] = 0.f; } }
    u32x4 wa, wb;
    wa.x = cvtpk(l[0], l[1]); wa.y = cvtpk(l[2], l[3]); wa.z = cvtpk(l[4], l[5]); wa.w = cvtpk(l[6], l[7]);
    wb.x = cvtpk(l[8], l[9]); wb.y = cvtpk(l[10], l[11]); wb.z = cvtpk(l[12], l[13]); wb.w = cvtpk(l[14], l[15]);
    const bf16x8 La = __builtin_bit_cast(bf16x8, wa), Lb = __builtin_bit_cast(bf16x8, wb);
    f32x16 T = {};
    T = MFMA32(tri[0], La, T); T = MFMA32(tri[1], Lb, T);
    float av[16];
#pragma unroll
    for (int r = 0; r < 16; ++r) { av[r] = __builtin_amdgcn_exp2f((z[r] + base) + T[r]); if (DIAG) { if (!((r & 3) + 8 * (r >> 2) + 32 * P < lim2)) av[r] = 0.f; } }
    wa.x = cvtpk(av[0], av[1]); wa.y = cvtpk(av[2], av[3]); wa.z = cvtpk(av[4], av[5]); wa.w = cvtpk(av[6], av[7]);
    wb.x = cvtpk(av[8], av[9]); wb.y = cvtpk(av[10], av[11]); wb.z = cvtpk(av[12], av[13]); wb.w = cvtpk(av[14], av[15]);
    const bf16x8 Pa = __builtin_bit_cast(bf16x8, wa), Pb = __builtin_bit_cast(bf16x8, wb);
    const LAS unsigned char* vp = Vb + ((lane >> 4) & 1) * 32 + (lane & 3) * 8 + (4 * hi + ((lane & 15) >> 2)) * 64 + P * 2048;
#pragma unroll
    for (int d0 = 0; d0 < 2; ++d0) {
        const s16x4 lo0 = vtr(vp + d0 * VD), hi0 = vtr(vp + d0 * VD + 512), lo1 = vtr(vp + d0 * VD + 1024), hi1 = vtr(vp + d0 * VD + 1536);
        const bf16x8 v0 = {lo0[0], lo0[1], lo0[2], lo0[3], hi0[0], hi0[1], hi0[2], hi0[3]}, v1 = {lo1[0], lo1[1], lo1[2], lo1[3], hi1[0], hi1[1], hi1[2], hi1[3]};
        o[d0] = MFMA32(Pa, v0, o[d0]); o[d0] = MFMA32(Pb, v1, o[d0]);
    }
    { const unsigned u = __builtin_bit_cast(unsigned, T[0]); auto r = __builtin_amdgcn_permlane32_swap(u, u, false, false); return __builtin_bit_cast(float, (unsigned)r[0]); }
}
#ifndef ASPAN_N
#define ASPAN_N 13
#endif
constexpr int ASPAN = ASPAN_N;
__device__ __forceinline__ void attn_span_phase(Frame& F, const bf16* Q, const bf16* Kg, const bf16* Vg, bf16* MIX, float* SSQA) {
    const int lane = F.lane, wid = F.wave, r32 = lane & 31, hi = lane >> 5;
    volatile LAS int* FLG = (volatile LAS int*)(F.lds + ASPAN * 8192 + 8 * 4096);
    bf16x8 tri[2];
#pragma unroll
    for (int s = 0; s < 2; ++s)
#pragma unroll
        for (int j = 0; j < 8; ++j) tri[s][j] = ((16 * s + 8 * (j >> 2) + 4 * hi + (j & 3)) >= r32) ? (short)0x3F80 : (short)0;
    for (int L = F.c; L < BATCH * NH * 8; L += F.G) {
        const int bh = L >> 3, qb = L & 7, b = bh >> 3, h = bh & 7, a0 = 8 * qb, a = a0 + wid;
        const size_t row0 = (size_t)b * SEQ; const int qg = 32 * a + r32;
        bf16x8 qr[4];
#pragma unroll
        for (int d0 = 0; d0 < 4; ++d0) qr[d0] = *(const bf16x8*)(Q + (row0 + qg) * DATT + h * HD + d0 * 16 + hi * 8);
        const bf16* src = (wid < 4) ? (Kg + (row0 + (lane & 31)) * DATT + h * HD + (lane >> 5) * 8 + 16 * wid)
                                    : (Vg + (row0 + 16 * (wid & 1) + (lane >> 2)) * DATT + h * HD + (lane & 3) * 8 + 32 * ((wid - 4) >> 1));
        const int dsto = (wid < 4) ? wid * 1024 : 4096 + (wid - 4) * 1024;
        f32x16 o[2] = {}; float Rc = 0.f; bool done = false;
        for (int k = 0;; ++k) {
            const int top = a0 + 7 - ASPAN * k, bot = (top - (ASPAN - 1) > 0) ? top - (ASPAN - 1) : 0;
#pragma unroll 1
            for (int jj = top; jj >= bot; --jj)
                __builtin_amdgcn_global_load_lds((const unsigned*)(src + (size_t)(32 * jj) * DATT), (LAS unsigned*)(F.lds + (top - jj) * 8192 + dsto), 16, 0, 0);
            asm volatile("s_waitcnt vmcnt(0)" ::: "memory");
            __syncthreads();
            if (!done) {
                for (int jj = (a < top ? a : top); jj >= bot; --jj) {
                    const LAS unsigned char* Kb = F.lds + (top - jj) * 8192; const LAS unsigned char* Vb = Kb + 4096;
                    const int lim = qg - 32 * jj;
                    float sh;
                    if (jj == a) sh = attn_half<true, 0, 512, 1024, 2048>(Kb, Vb, qr, tri, o, Rc, lim, lane);
                    else sh = attn_half<false, 0, 512, 1024, 2048>(Kb, Vb, qr, tri, o, Rc, lim, lane);
                    Rc += sh;
                    if (jj == 0 || __all(Rc < ATT_THR)) { done = true; break; }
                }
            }
            if (lane == 0) FLG[wid] = done ? 1 : 0;
            asm volatile("s_waitcnt lgkmcnt(0)" ::: "memory");
            __syncthreads();
            if (bot == 0) break;
            int alld = 1;
#pragma unroll
            for (int w = 0; w < 8; ++w) alld &= FLG[w];
            if (alld) break;
        }
        { LAS unsigned char* stg = F.lds + ASPAN * 8192 + wid * 4096; LAS unsigned short* sp = (LAS unsigned short*)(stg + hi * 512 + r32 * 2);
#pragma unroll
          for (int r = 0; r < 16; ++r) { const int ro = ((r & 3) + 8 * (r >> 2)) * 64; sp[ro] = (unsigned short)f2bf(o[0][r]); sp[ro + 32] = (unsigned short)f2bf(o[1][r]); }
          asm volatile("s_waitcnt lgkmcnt(0)" ::: "memory");
          bf16* ow = MIX + (row0 + 32 * a) * PX + 512 + h * HD;
#pragma unroll
          for (int i = 0; i < 4; ++i) { const int row = i * 8 + (lane >> 3), ch = lane & 7; const u32x4 v = *(const LAS u32x4*)(stg + row * 128 + ch * 16); *(u32x4*)(ow + (size_t)row * PX + ch * 8) = v;
              const float f0 = bf2f(v.x & 0xffff), f1 = bf2f(v.x >> 16), f2 = bf2f(v.y & 0xffff), f3 = bf2f(v.y >> 16), f4 = bf2f(v.z & 0xffff), f5 = bf2f(v.z >> 16), f6 = bf2f(v.w & 0xffff), f7 = bf2f(v.w >> 16);
              float ss = ((f0 * f0 + f1 * f1) + (f2 * f2 + f3 * f3)) + ((f4 * f4 + f5 * f5) + (f6 * f6 + f7 * f7));
              ss += dppf<0xB1>(ss); ss += dppf<0x4E>(ss); ss += dppf<0x141>(ss);
              if (ch == 0) atomicAdd(SSQA + (row0 + 32 * a + row), ss); }
          asm volatile("s_waitcnt lgkmcnt(0)" ::: "memory"); }
    }
    asm volatile("s_waitcnt vmcnt(0)" ::: "memory");
    __syncthreads();
}
static_assert(ASPAN * 8192 + 8 * 4096 + 64 <= MISC_OFF, "attention LDS map");

constexpr int RT_PITCH = 2064;
__device__ __forceinline__ void router_phase(Frame& F, const Args& a) {
    const bf16* X1B = (const bf16*)(a.ws + FW_X1B); unsigned char* X1Q = (unsigned char*)(a.ws + FW_X1Q); int* TOK = (int*)(a.ws + FW_TOK); const bf16* WR = (const bf16*)(a.ws + FW_WR);
    const float* brg = karg<20>(); const float* bre_ = karg<22>();
    const int tid = F.tid, lane = F.lane, wid = F.wave, r32 = lane & 31, hi = lane >> 5;
    LAS unsigned char* TILE = F.lds;
    LAS float* PART = (LAS float*)(F.lds + 66048);
    LAS float* LOGIT = (LAS float*)(F.lds + 66048 + 65536);
    LAS int* HIST = (LAS int*)(F.lds + 66048 + 65536 + 5120);
    LAS int* TREC = HIST + 64;
    LAS float* RS = (LAS float*)(TREC + 1024);
    LAS float* TRS = RS + 32;
    LAS float* TRG = TRS + 256;
    LAS float* BIAS = TRG + 512;
    static_assert(66048 + 65536 + 5120 + 256 + 4096 + 128 + 1024 + 2048 + 160 <= MISC_OFF, "router LDS");
    bf16x8 Bf[8][2];
#pragma unroll
    for (int s = 0; s < 8; ++s)
#pragma unroll
        for (int nb = 0; nb < 2; ++nb) Bf[s][nb] = *(const bf16x8*)(WR + (size_t)(32 * nb + r32) * DM + 128 * wid + 16 * s + 8 * hi);
    if (tid < 64) HIST[tid] = 0;
    if (tid >= 64 && tid < 104) { const int c = tid - 64; BIAS[c] = c < 4 ? brg[c] : (c < 36 ? bre_[c - 4] : 0.f); }
    __syncthreads();
    int ntl = 0;
#define RT_BAR() do { asm volatile("s_waitcnt lgkmcnt(0)" ::: "memory"); __builtin_amdgcn_s_barrier(); asm volatile("" ::: "memory"); } while (0)
#define RT_LOAD(tile_) do { _Pragma("unroll") for (int rr = 0; rr < 4; ++rr) { const u32x4* xr = (const u32x4*)(X1B + (size_t)((tile_) * 32 + 4 * wid + rr) * PX); v[rr][0] = xr[lane]; v[rr][1] = xr[64 + lane]; } } while (0)
    u32x4 v[4][2];
    if (F.c < M / 32) RT_LOAD(F.c);
    for (int tile = F.c; tile < M / 32; tile += F.G, ++ntl) {
        {
#pragma unroll
          for (int rr = 0; rr < 4; ++rr) { const int lr = 4 * wid + rr; float s = 0.f;
#pragma unroll
              for (int j = 0; j < 2; ++j) { const u32x4 w = v[rr][j];
                  const float f0 = bf2f(w.x & 0xffff), f1 = bf2f(w.x >> 16), f2 = bf2f(w.y & 0xffff), f3 = bf2f(w.y >> 16), f4 = bf2f(w.z & 0xffff), f5 = bf2f(w.z >> 16), f6 = bf2f(w.w & 0xffff), f7 = bf2f(w.w >> 16);
                  s += (f0 * f0 + f1 * f1) + (f2 * f2 + f3 * f3) + (f4 * f4 + f5 * f5) + (f6 * f6 + f7 * f7);
                  { u32x2 q8; q8.x = pk4_fp8(f0, f1, f2, f3); q8.y = pk4_fp8(f4, f5, f6, f7); *(u32x2*)(X1Q + (size_t)(tile * 32 + lr) * DM + (64 * j + lane) * 8) = q8; }
                  *(LAS u32x4*)(TILE + lr * RT_PITCH + (64 * j + lane) * 16) = w; }
              const float rstd = __builtin_amdgcn_rsqf(wave_sum(s) * (1.f / DM) + EPS);
              if (lane == 0) RS[lr] = rstd; } }
        if (tile + F.G < M / 32) RT_LOAD(tile + F.G);
        RT_BAR();
        { f32x16 c0 = {}, c1 = {};
#pragma unroll
          for (int s = 0; s < 8; ++s) { const bf16x8 af = *(const LAS bf16x8*)(TILE + r32 * RT_PITCH + (128 * wid + 16 * s + 8 * hi) * 2);
              c0 = MFMA32(af, Bf[s][0], c0); c1 = MFMA32(af, Bf[s][1], c1); }
#pragma unroll
          for (int r = 0; r < 16; ++r) { const int t = crow(r, hi); PART[(wid * 32 + t) * 64 + r32] = c0[r]; PART[(wid * 32 + t) * 64 + 32 + r32] = c1[r]; } }
        RT_BAR();
        { const int t = tid >> 4, c4 = (tid & 15) * 4;
          if (c4 < 40) { f32x4 s = {0.f, 0.f, 0.f, 0.f};
#pragma unroll
              for (int w = 0; w < 8; ++w) s += *(const LAS f32x4*)(PART + (w * 32 + t) * 64 + c4);
              *(LAS f32x4*)(LOGIT + t * 40 + c4) = s * RS[t] + *(const LAS f32x4*)(BIAS + c4); } }
        RT_BAR();
        if (tid < 32) { const int m = tile * 32 + tid; float lg[36];
#pragma unroll
            for (int c = 0; c < 36; ++c) lg[c] = LOGIT[tid * 40 + c];
            int gi = 0; float gm = lg[0];
#pragma unroll
            for (int c = 1; c < 4; ++c) if (lg[c] > gm) { gm = lg[c]; gi = c; }
            float gsum = 0.f;
#pragma unroll
            for (int c = 0; c < 4; ++c) gsum += __expf(lg[c] - gm);
            const float pgrp = 1.f / gsum;
            float el[8];
#pragma unroll
            for (int e = 0; e < 8; ++e) { float t = 0.f;
#pragma unroll
                for (int g2 = 0; g2 < 4; ++g2) if (g2 == gi) t = lg[4 + g2 * 8 + e];
                el[e] = t; }
            int i0 = 0; float m0 = el[0];
#pragma unroll
            for (int e = 1; e < 8; ++e) if (el[e] > m0) { m0 = el[e]; i0 = e; }
            int i1 = 0; float m1 = -3.0e38f;
#pragma unroll
            for (int e = 0; e < 8; ++e) if (e != i0 && el[e] > m1) { m1 = el[e]; i1 = e; }
            const float e1 = __expf(m1 - m0), p0 = 1.f / (1.f + e1), p1 = e1 / (1.f + e1);
            const int ex0 = gi * 8 + i0, ex1 = gi * 8 + i1;
            const int rk0 = atomicAdd((int*)&HIST[ex0], 1), rk1 = atomicAdd((int*)&HIST[ex1], 1);
            int* tk = TOK + (size_t)m * 8; tk[0] = ex0; tk[1] = ex1; tk[2] = __float_as_int(pgrp * p0); tk[3] = __float_as_int(pgrp * p1);
            LAS int* tr = TREC + (ntl * 32 + tid) * 4; tr[0] = ex0; tr[1] = ex1; tr[2] = rk0; tr[3] = rk1;
            TRS[ntl * 32 + tid] = RS[tid]; TRG[2 * (ntl * 32 + tid)] = pgrp * p0; TRG[2 * (ntl * 32 + tid) + 1] = pgrp * p1;
        }
        RT_BAR();
    }
#undef RT_BAR
#undef RT_LOAD
    if (tid < 32) { const int cnt = HIST[tid]; int base = 0; if (cnt > 0) base = (int)__hip_atomic_fetch_add(F.ctl + CW_CNT + tid, (unsigned)cnt, RLX_AGENT); HIST[32 + tid] = base; }
    __syncthreads();
    unsigned* ETOK = (unsigned*)(a.ws + FW_ETOK); float* EG = (float*)(a.ws + FW_EG);
    for (int i = tid; i < ntl * 32; i += NTHR) { const int tile = F.c + (i >> 5) * F.G, m = tile * 32 + (i & 31); const LAS int* tr = TREC + i * 4;
        int* tk = TOK + (size_t)m * 8; const int s0 = HIST[32 + tr[0]] + tr[2], s1 = HIST[32 + tr[1]] + tr[3]; tk[4] = s0; tk[5] = s1;
        const unsigned word = (unsigned)m | (f2bf(TRS[i]) << 16);
        ETOK[(size_t)tr[0] * M + s0] = word; ETOK[(size_t)tr[1] * M + s1] = word; EG[(size_t)tr[0] * M + s0] = TRG[2 * i]; EG[(size_t)tr[1] * M + s1] = TRG[2 * i + 1]; }
    __syncthreads();
}
__device__ __forceinline__ int moe_tables(Frame& F) {
    LAS int* TST = (LAS int*)(F.lds + SCR2_OFF); LAS unsigned char* T2E = F.lds + SCR2_OFF + 256;
    if (F.tid < 64) {
        const int e = F.tid; int nt = 0;
        if (e < NE) { const int cnt = (int)__hip_atomic_load(F.ctl + CW_CNT + e, RLX_AGENT); nt = (cnt + 255) >> 8; TST[208 + e] = cnt; }
        int incl = nt;
#pragma unroll
        for (int o = 1; o < 32; o <<= 1) { const int v = __shfl_up(incl, o); if ((e & 31) >= o) incl += v; }
        const int start = incl - nt;
        if (e < NE) { TST[e] = start; for (int t = 0; t < nt; ++t) T2E[start + t] = (unsigned char)e; }
        if (e == NE - 1) TST[NE] = incl;
    }
    __syncthreads();
    return TST[NE];
}
#ifndef CTPT
#define CTPT 4
#endif
__device__ __forceinline__ void combine_phase(Frame& F, const Args& a) {
    const unsigned char* YE = (const unsigned char*)(a.ws + FW_YE); const bf16* X1B = (const bf16*)(a.ws + FW_X1B); const int* TOK = (const int*)(a.ws + FW_TOK); float* out = a.out;
    const LAS int* TST = (const LAS int*)(F.lds + SCR2_OFF);
    const int gw = F.c * NWAVES + F.wave, NGW = F.G * NWAVES, lane = F.lane;
    static_assert(CTPT * 8 <= 64, "one routing word per lane");
    int m0 = gw * CTPT;
    int w = 0; if (m0 < M) w = TOK[(size_t)m0 * 8 + (lane & (CTPT * 8 - 1))];
    for (; m0 < M; m0 += NGW * CTPT) {
        const int mn = m0 + NGW * CTPT;
        int wn = 0; if (mn < M) wn = TOK[(size_t)mn * 8 + (lane & (CTPT * 8 - 1))];
        const int tl = TST[w & 31];
        u32x2 xv[CTPT][4]; unsigned y0[CTPT][4], y1[CTPT][4];
#pragma unroll
        for (int t = 0; t < CTPT; ++t) {
            const size_t p0 = (size_t)__builtin_amdgcn_readlane(tl, 8 * t) * 256 + (size_t)__builtin_amdgcn_readlane(w, 8 * t + 4), p1 = (size_t)__builtin_amdgcn_readlane(tl, 8 * t + 1) * 256 + (size_t)__builtin_amdgcn_readlane(w, 8 * t + 5);
            const bf16* xr = X1B + (size_t)(m0 + t) * PX + 4 * lane; const unsigned* ya = (const unsigned*)(YE + p0 * DM) + lane; const unsigned* yb = (const unsigned*)(YE + p1 * DM) + lane;
#pragma unroll
            for (int q = 0; q < 4; ++q) { xv[t][q] = *(const u32x2*)(xr + 256 * q); y0[t][q] = ya[64 * q]; y1[t][q] = yb[64 * q]; } }
#pragma unroll
        for (int t = 0; t < CTPT; ++t) { float* o = out + (size_t)(m0 + t) * DM + 4 * lane;
#pragma unroll
            for (int q = 0; q < 4; ++q) { const unsigned wa = y0[t][q], wb = y1[t][q]; const unsigned xa = xv[t][q].x, xb = xv[t][q].y;
                const f32x2 a0 = __builtin_amdgcn_cvt_pk_f32_fp8((int)wa, false), a1 = __builtin_amdgcn_cvt_pk_f32_fp8((int)wa, true), b0 = __builtin_amdgcn_cvt_pk_f32_fp8((int)wb, false), b1 = __builtin_amdgcn_cvt_pk_f32_fp8((int)wb, true);
                f32x4 r; r.x = bf2f(xa & 0xffff) + (a0.x + b0.x) * (1.f / YE_SCALE); r.y = bf2f(xa >> 16) + (a0.y + b0.y) * (1.f / YE_SCALE);
                r.z = bf2f(xb & 0xffff) + (a1.x + b1.x) * (1.f / YE_SCALE); r.w = bf2f(xb >> 16) + (a1.y + b1.y) * (1.f / YE_SCALE);
                *(f32x4*)(o + 256 * q) = r; } }
        w = wn;
    }
}

#ifndef STG1
#define STG1 0
#endif
#ifndef STG10
#define STG10 0
#endif
#ifndef STG11
#define STG11 0
#endif
#ifndef KREP1
#define KREP1 1
#endif
#ifndef KREP10
#define KREP10 1
#endif
#ifndef KREP11
#define KREP11 1
#endif
constexpr int NPHASE = 13;
__global__ void __launch_bounds__(NTHR, 2) mk_fwd(Args args) {
    extern __shared__ __attribute__((aligned(16))) unsigned char lds_raw[];
    Frame F;
    F.lds = (LAS unsigned char*)lds_raw; F.MISC = (volatile LAS unsigned*)(F.lds + MISC_OFF);
    F.tid = threadIdx.x; F.lane = F.tid & 63; F.wave = __builtin_amdgcn_readfirstlane(F.tid >> 6);
    F.G = gridDim.x; F.c = blockIdx.x; F.ctl = (unsigned*)(args.ws + WS_CTL);
    if (F.tid < 64) F.MISC[F.tid] = 0u;
    __syncthreads();
    XcdBarrier bar = xcd_barrier_post(F.ctl + CW_BAR, F.MISC + 8);
    const int lo = args.ph_lo, hi = args.ph_hi;
    unsigned char* ws = args.ws;
#ifndef PH_MASK
#define PH_MASK 0x1fff
#endif
#define IN(k) ((((PH_MASK) >> (k)) & 1) && lo <= (k) && (k) < hi)
#define SEAM(k) do { if (IN(k) && IN((k) + 1)) xcd_barrier(bar); } while (0)
#define REFRESH() do { int t_ = threadIdx.x; asm volatile("" : "+v"(t_)); F.tid = t_; F.lane = t_ & 63; F.wave = __builtin_amdgcn_readfirstlane(t_ >> 6); } while (0)
#ifndef REP_MASK
#define REP_MASK 0
#endif
#define REPS(k) _Pragma("unroll") for (int rep_ = 0; rep_ < ((((REP_MASK) >> (k)) & 1) ? 2 : 1); ++rep_)
    if (IN(0)) REPS(0) { REFRESH(); p0_prologue(F, args); } SEAM(0);
    if (IN(1)) REPS(1) { REFRESH();
        GemmP g{PX * 2, PW * 2, DM}; DenseOrder S{(const char*)(ws + FW_XN), (const char*)(ws + FW_WIN), (size_t)256 * PX * 2, (size_t)256 * PW * 2, M / 256, DIN / 256, (M / 256) * (DIN / 256), F.G, F.c};
        LAS float* GQK = (LAS float*)(F.lds + SCR2_OFF); if (F.tid < 128) GQK[F.tid] = (F.tid < 64) ? karg<13>()[F.tid] * C2 : karg<14>()[F.tid - 64];
        { LAS float* GF = (LAS float*)(F.lds + GF_OFF); GF[F.tid] = W8SC * karg<18>()[F.tid]; GF[F.tid + 512] = W8SC * karg<18>()[F.tid + 512]; } __syncthreads();
        EpiProj E{(bf16*)(ws + FW_U2), (bf16*)(ws + FW_Q), (const LAS float*)GQK, (F.G == 256) ? F.c * NWAVES : -1, ws};
        gemm_phase<EpiProj, DenseOrder, false, KREP1>(F.lds, g, S, E, nullptr, ((F.c >> 3) & 7) * STG1); } SEAM(1);
    if (IN(2)) REPS(2) { REFRESH();
        GemmP g{U2P * 2, 512 * 2, 512}; GroupOrder S{(const char*)(ws + FW_U2), (const char*)(ws + FW_W1), (size_t)NCH * U2P * 2, (size_t)256 * 512 * 2, (size_t)256 * U2P * 2, 0, NCH / 256, 1, NG * (NCH / 256), F.G, F.c};
        EpiState E{(float*)(ws + FW_SST)};
        gemm_phase(F.lds, g, S, E);
        if (F.G == NG * (NCH / 256)) s5_scan_local(F, args, F.c >> 3, F.c & 7); }
    if (F.G != NG * (NCH / 256)) SEAM(2);
    if (IN(3)) REPS(3) { REFRESH();
#ifndef NO_SCAN
        if (F.G != NG * (NCH / 256)) s5_scan(F, args);
#ifdef REP_SCAN
        s5_scan(F, args);
#endif
#endif
#ifndef NO_ATTN
        const bf16* Q = (const bf16*)(ws + FW_Q); const bf16* Kg = (const bf16*)(ws + FW_K); const bf16* Vg = (const bf16*)(ws + FW_V);
        attn_span_phase(F, Q, Kg, Vg, (bf16*)(ws + FW_MIX), (float*)(F.ctl + CW_SSQA));
#endif
    } SEAM(3);
    if (IN(4)) REPS(4) { REFRESH();
        GemmP g{U2P * 2, U2P * 2, U2P}; EpiS5 E{(bf16*)(ws + FW_Z)};
        if (F.G == 256) { S5MainOrder S{(const char*)(ws + FW_U2), (const char*)(ws + FW_TB), (size_t)NCH * U2P * 2, (size_t)512 * U2P * 2, (size_t)256 * U2P * 2, (size_t)256 * U2P * 2, F.c}; gemm_phase(F.lds, g, S, E); }
        else { GroupOrder S{(const char*)(ws + FW_U2), (const char*)(ws + FW_TB), (size_t)NCH * U2P * 2, (size_t)512 * U2P * 2, (size_t)256 * U2P * 2, (size_t)256 * U2P * 2, NCH / 256, 2, NG * (NCH / 256) * 2, F.G, F.c}; gemm_phase(F.lds, g, S, E); } } SEAM(4);
    if (IN(5)) REPS(5) { REFRESH();
        GemmP g{DSSM * 2, DSSM * 2, DSSM}; DenseOrder S{(const char*)(ws + FW_Z), (const char*)(ws + FW_WGLU), (size_t)256 * DSSM * 2, (size_t)256 * DSSM * 2, M / 256, 2, (M / 256) * 2, F.G, F.c};
        EpiGlu E{(const bf16*)(ws + FW_Z), karg<12>(), (bf16*)(ws + FW_MIX), (float*)(F.ctl + CW_SSQS)};
        gemm_phase(F.lds, g, S, E); } if (IN(5) && IN(7)) xcd_barrier(bar);
    if (IN(7)) REPS(7) { REFRESH();
        GemmP g{PX * 2, PW * 2, DM}; DenseOrder S{(const char*)(ws + FW_MIX), (const char*)(ws + FW_WOUT), (size_t)256 * PX * 2, (size_t)256 * PW * 2, M / 256, 4, (M / 256) * 4, F.G, F.c};
        EpiX1B E{(F.G == 256) ? F.c * NWAVES + 2048 * 8 : -1, ws, (const float*)(ws + FW_RSTDX), (bf16*)(ws + FW_X1B), (const float*)(F.ctl + CW_SSQS), (const float*)(F.ctl + CW_SSQA), (LAS float*)(F.lds + SCR2_OFF + 1024)};
        { LAS float* GF = (LAS float*)(F.lds + GF_OFF); GF[F.tid] = W8SC * karg<18>()[F.tid]; GF[F.tid + 512] = W8SC * karg<18>()[F.tid + 512]; }
        { Unit uu; for (int i = 0; i < 4 && S.next(i, uu); ++i) E.fill(i, uu.pm, F.tid); __syncthreads(); }
        gemm_phase(F.lds, g, S, E); } SEAM(7);
    if (IN(8)) { REFRESH(); router_phase(F, args); } if (IN(8) && IN(10)) xcd_barrier(bar);
    int ntiles = 0;
    if (IN(10) || IN(11) || IN(12)) { REFRESH(); ntiles = moe_tables(F); }
    if (IN(10)) REPS(10) { REFRESH();
        LAS int* RC = (LAS int*)(F.lds + SCR2_OFF + 1024); const unsigned* ETOK = (const unsigned*)(ws + FW_ETOK); const LAS int* TSTc = (const LAS int*)(F.lds + SCR2_OFF); const LAS unsigned char* T2Ec = F.lds + SCR2_OFF + 256;
        { unsigned v[5];
#pragma unroll
          for (int k = 0; k < 5; ++k) { const int j = F.tid + 512 * k, i = j >> 8, r = j & 255; v[k] = 0u;
              if ((long)i * F.G + F.c < (long)ntiles * 4) { int pm, pn; moe_unit(i * F.G + F.c, ntiles, pm, pn);
                  const int e = T2Ec[pm], idx = (pm - TSTc[e]) * 256 + r;
                  if (idx < TSTc[208 + e]) v[k] = ETOK[(size_t)e * M + idx]; } }
#pragma unroll
          for (int k = 0; k < 5; ++k) { const int j = F.tid + 512 * k; if ((long)(j >> 8) * F.G + F.c < (long)ntiles * 4) RC[j] = (int)v[k]; } }
        __syncthreads();
        GemmP g{DM, DM, DM / 2}; MoeOrder S{(const char*)(ws + FW_X1Q), (const char*)(ws + FW_WGU), (size_t)0, (size_t)DM * DM, (size_t)256 * DM, F.lds + SCR2_OFF + 256, ntiles, F.G, F.c};
        EpiGU E{(unsigned char*)(ws + FW_HH), (const LAS unsigned*)RC};
        gemm_phase<EpiGU, MoeOrder, true, KREP10, true>(F.lds, g, S, E, RC, ((F.c >> 3) & 7) * STG10); } SEAM(10);
    if (IN(11)) REPS(11) { REFRESH();
        LAS float* RGC = (LAS float*)(F.lds + SCR2_OFF + 1024); const float* EG = (const float*)(ws + FW_EG); const LAS int* TSTc = (const LAS int*)(F.lds + SCR2_OFF); const LAS unsigned char* T2Ec = F.lds + SCR2_OFF + 256;
        { float v[5];
#pragma unroll
          for (int k = 0; k < 5; ++k) { const int j = F.tid + 512 * k, i = j >> 8, r = j & 255; v[k] = 0.f;
              if ((long)i * F.G + F.c < (long)ntiles * 4) { int pm, pn; moe_unit(i * F.G + F.c, ntiles, pm, pn);
                  const int e = T2Ec[pm], idx = (pm - TSTc[e]) * 256 + r;
                  if (idx < TSTc[208 + e]) v[k] = EG[(size_t)e * M + idx]; } }
#pragma unroll
          for (int k = 0; k < 5; ++k) { const int j = F.tid + 512 * k; if ((long)(j >> 8) * F.G + F.c < (long)ntiles * 4) RGC[j] = v[k]; } }
        __syncthreads();
        GemmP g{DE, DE, DE / 2}; MoeOrder S{(const char*)(ws + FW_HH), (const char*)(ws + FW_WD), (size_t)256 * DE, (size_t)DM * DE, (size_t)256 * DE, F.lds + SCR2_OFF + 256, ntiles, F.G, F.c};
        EpiDown E{(unsigned char*)(ws + FW_YE), (const LAS float*)RGC};
        gemm_phase<EpiDown, MoeOrder, false, KREP11, true>(F.lds, g, S, E, nullptr, ((F.c >> 3) & 7) * STG11); } SEAM(11);
    if (IN(12)) REPS(12) { REFRESH(); combine_phase(F, args); }
#undef IN
#undef SEAM
}
}

extern "C" void kernel_launch(void* const* d_in, const int* in_sizes, int n_in, void* d_out, int out_size, void* d_ws, size_t ws_size, hipStream_t stream) {
    static int grid = 0;
    if (grid == 0) {
        if (n_in != 26 || out_size != M * DM || ws_size < mk::FW_END2) { fprintf(stderr, "kernel_launch: unexpected shapes (n_in %d out %d ws %zu, need %zu)\n", n_in, out_size, ws_size, (size_t)mk::FW_END2); grid = -1; return; }
        int dev = 0, cus = 0, per_cu = 0;
        if (hipGetDevice(&dev) != hipSuccess || hipDeviceGetAttribute(&cus, hipDeviceAttributeMultiprocessorCount, dev) != hipSuccess) { grid = -1; return; }
        if (hipFuncSetAttribute((const void*)mk::mk_fwd, hipFuncAttributeMaxDynamicSharedMemorySize, mk::LDS_BYTES) != hipSuccess) { fprintf(stderr, "kernel_launch: hipFuncSetAttribute failed\n"); grid = -1; return; }
        if (hipOccupancyMaxActiveBlocksPerMultiprocessor(&per_cu, (const void*)mk::mk_fwd, mk::NTHR, mk::LDS_BYTES) != hipSuccess || per_cu < 1) { fprintf(stderr, "kernel_launch: occupancy query says %d\n", per_cu); }
        (void)hipGetLastError();
        grid = cus;
        if (grid != 256) fprintf(stderr, "kernel_launch: %d CUs (built for 256)\n", grid);
    }
    if (grid < 0) return;
    mk::Args a{};
    for (int i = 0; i < 26; ++i) a.in[i] = (const float*)d_in[i];
    a.out = (float*)d_out; a.ws = (unsigned char*)d_ws; a.ph_lo = 0; a.ph_hi = mk::NPHASE;
    (void)hipMemsetAsync((unsigned char*)d_ws + WS_CTL, 0, mk::CTL_ZERO_BYTES, stream);
    hipLaunchKernelGGL(mk::mk_fwd, dim3(grid), dim3(mk::NTHR), mk::LDS_BYTES, stream, a);
}
```

```cpp
#define ASPAN_N 10
#define PADX 0
#define NTS_MASK 0x77
#define NT_COMBINE 1

#include <hip/hip_runtime.h>
#include <cstdio>
#include <cstdint>

typedef unsigned short bf16;
typedef float f32x4 __attribute__((ext_vector_type(4)));
typedef unsigned u32x4 __attribute__((ext_vector_type(4)));
typedef unsigned u32x2 __attribute__((ext_vector_type(2)));

constexpr int DM = 1024, BATCH = 32, SEQ = 2048, M = BATCH * SEQ;
constexpr int DSSM = 512, NG = 32, GS = 16, PST = 64, HD = 64, DATT = 512, NH = 8, DIN = 2048;
constexpr int NEG = 4, EPG = 8, NE = 32, DE = 512;
constexpr float EPS = 1e-6f;
constexpr int LCH = 32;
constexpr int NCH = M / LCH;
constexpr int U2P = 640;
constexpr float C2 = 0.125f * 1.4426950408889634f;

constexpr size_t MiB = 1u << 20;
constexpr size_t WS_CTL = 0;
constexpr size_t WS_TOK = 2 * MiB;
constexpr size_t WS_XN = 8 * MiB;
constexpr size_t WS_Q = WS_XN + 128 * MiB;
constexpr size_t WS_K = WS_Q + 64 * MiB;
constexpr size_t WS_V = WS_K + 64 * MiB;
constexpr size_t WS_U2 = WS_V + 64 * MiB;
constexpr size_t WS_Z = WS_U2 + 80 * MiB;
constexpr size_t WS_YS = WS_Z + 64 * MiB;
constexpr size_t WS_YA = WS_YS + 64 * MiB;
constexpr size_t WS_MIX = WS_YA + 64 * MiB;
constexpr size_t WS_H2 = WS_XN;
constexpr size_t WS_PROJ = WS_Z;
constexpr size_t WS_END = WS_PROJ + 512 * MiB;

__device__ __forceinline__ unsigned f2bf(float f) { unsigned u = __builtin_bit_cast(unsigned, f); return (u + 0x7fffu + ((u >> 16) & 1u)) >> 16; }
__device__ __forceinline__ float bf2f(unsigned short h) { return __builtin_bit_cast(float, (unsigned)h << 16); }
__device__ __forceinline__ unsigned pk2(float lo, float hi) { return f2bf(lo) | (f2bf(hi) << 16); }
template <int CTRL> __device__ __forceinline__ float dppf(float x) { return __builtin_bit_cast(float, __builtin_amdgcn_update_dpp(0, __builtin_bit_cast(int, x), CTRL, 0xF, 0xF, true)); }
template <int CTRL> __device__ __forceinline__ unsigned dppu(unsigned x) { return (unsigned)__builtin_amdgcn_update_dpp(0, (int)x, CTRL, 0xF, 0xF, true); }
__device__ __forceinline__ float xor16_sum(float v) { const unsigned u = __builtin_bit_cast(unsigned, v); auto r = __builtin_amdgcn_permlane16_swap(u, u, false, false); return __builtin_bit_cast(float, (unsigned)r[0]) + __builtin_bit_cast(float, (unsigned)r[1]); }
__device__ __forceinline__ float xor32_sum(float v) { const unsigned u = __builtin_bit_cast(unsigned, v); auto r = __builtin_amdgcn_permlane32_swap(u, u, false, false); return __builtin_bit_cast(float, (unsigned)r[0]) + __builtin_bit_cast(float, (unsigned)r[1]); }
__device__ __forceinline__ unsigned xor16_get(unsigned u, bool odd_row) { auto r = __builtin_amdgcn_permlane16_swap(u, u, false, false); return odd_row ? (unsigned)r[0] : (unsigned)r[1]; }
__device__ __forceinline__ float wave_sum(float v) {
    v += dppf<0xB1>(v); v += dppf<0x4E>(v); v += dppf<0x141>(v); v += dppf<0x140>(v);
    return xor32_sum(xor16_sum(v));
}
__device__ __forceinline__ void sincos_d(double th, double& s, double& c) {
    const double q = rint(th * 0.63661977236758134308);
    const double r = (th - q * 1.57079632679489655800) - q * 6.12323399573676603587e-17;
    const double r2 = r * r;
    double sp = -1.0 / 1307674368000.0; sp = sp * r2 + 1.0 / 6227020800.0; sp = sp * r2 - 1.0 / 39916800.0; sp = sp * r2 + 1.0 / 362880.0; sp = sp * r2 - 1.0 / 5040.0; sp = sp * r2 + 1.0 / 120.0; sp = sp * r2 - 1.0 / 6.0; sp = sp * r2 + 1.0;
    const double sn = sp * r;
    double cp = 1.0 / 20922789888000.0; cp = cp * r2 - 1.0 / 87178291200.0; cp = cp * r2 + 1.0 / 479001600.0; cp = cp * r2 - 1.0 / 3628800.0; cp = cp * r2 + 1.0 / 40320.0; cp = cp * r2 - 1.0 / 720.0; cp = cp * r2 + 1.0 / 24.0; cp = cp * r2 - 0.5; cp = cp * r2 + 1.0;
    const int qi = ((int)q) & 3;
    s = (qi == 0) ? sn : (qi == 1) ? cp : (qi == 2) ? -sn : -cp;
    c = (qi == 0) ? cp : (qi == 1) ? -sn : (qi == 2) ? -cp : sn;
}
__device__ __forceinline__ float gelu_tanh(float x) {
    constexpr float K1 = -2.885390081777927f * 0.7978845608028654f, K3 = K1 * 0.044715f;
    const float e = __builtin_amdgcn_exp2f(x * (K1 + K3 * (x * x)));
    return x * __builtin_amdgcn_rcpf(1.f + e);
}
__device__ __forceinline__ float sigmoidf_(float x) { return __builtin_amdgcn_rcpf(1.f + __builtin_amdgcn_exp2f(-1.4426950408889634f * x)); }


#include <type_traits>
namespace mk {
#define LAS __attribute__((address_space(3)))
#define GAS __attribute__((address_space(1)))
typedef short bf16x8 __attribute__((ext_vector_type(8)));
typedef short s16x4 __attribute__((ext_vector_type(4)));
typedef float f32x16 __attribute__((ext_vector_type(16)));
typedef float f32x2 __attribute__((ext_vector_type(2)));
typedef __bf16 bf16x2_t __attribute__((ext_vector_type(2)));
typedef GAS unsigned gu32;

constexpr int NWAVES = 8, NTHR = 512;
constexpr int RING_BYTES = 131072, SCR2_OFF = RING_BYTES, SCR2_BYTES = 16128, MISC_OFF = SCR2_OFF + SCR2_BYTES, GF_OFF = MISC_OFF + 256, LDS_BYTES = GF_OFF + 4096;
static_assert(GF_OFF == 147456 && LDS_BYTES <= 163840, "LDS map");

#ifndef PADX
#define PADX 64
#endif
constexpr int PX = DM + PADX;
constexpr int PW = DM + PADX;
constexpr size_t FW_TOK = 2 * MiB, FW_WIN = 4 * MiB, FW_WOUT = 9 * MiB, FW_WGLU = 12 * MiB - 512 * 1024, FW_WR = 12 * MiB, FW_TB = 13 * MiB, FW_W1 = 33 * MiB,
                 FW_WGU = 41 * MiB, FW_WD = 110 * MiB, FW_SST = 142 * MiB, FW_XN = 174 * MiB, FW_Q = 310 * MiB, FW_K = 374 * MiB, FW_V = 438 * MiB, FW_U2 = 502 * MiB,
                 FW_Z = 582 * MiB, FW_MIX = 646 * MiB, FW_ROW = 782 * MiB, FW_SSQP = 784 * MiB, FW_SSQAP = 786 * MiB, FW_END2 = 788 * MiB,
                 FW_X1B = FW_XN, FW_HH = 582 * MiB, FW_YE = FW_Q;
static_assert(FW_WIN + (size_t)DIN * PW * 2 <= FW_WOUT && FW_WOUT + (size_t)DM * PW * 2 <= FW_WGLU && FW_WGU + (size_t)NE * DM * PW * 2 <= FW_WD && FW_XN + (size_t)M * PX * 2 <= FW_Q && FW_MIX + (size_t)M * PX * 2 <= FW_ROW, "padded buffers");
static_assert(FW_K - FW_Q == (size_t)M * 512 * 2 && FW_V - FW_K == (size_t)M * 512 * 2, "Q|K|V contiguous");
constexpr size_t FW_RSTDX = FW_ROW + 3 * (size_t)(544 * 256) * 4;
constexpr size_t FW_ETOK = FW_SST, FW_EG = FW_SST + (size_t)NE * M * 4;
static_assert(FW_EG + (size_t)NE * M * 4 <= FW_XN, "expert lists");
constexpr float W8SC = 64.f;
constexpr size_t FW_X1Q = FW_U2;
static_assert(FW_X1Q + (size_t)M * DM <= FW_HH && FW_YE + (size_t)(544 * 256) * DM <= FW_X1Q && FW_HH + (size_t)(544 * 256) * DE <= FW_ROW, "X1Q / HH / YE must not overlap");
constexpr size_t FW_A32 = FW_WR + 256 * 1024;
constexpr int MAXTILES = 544, MAXROWS = MAXTILES * 256;
static_assert(FW_RSTDX + (size_t)M * 4 <= FW_END2, "row arrays");
static_assert(FW_YE + (size_t)MAXROWS * DM <= FW_U2 && FW_HH + (size_t)MAXROWS * DE * 2 <= FW_ROW, "MoE overlay");
constexpr int XCD_BAR_WORDS_C = 3456;
constexpr int CW_TMO = 0, CW_CNT = 64, CW_BAR = 4096, CW_SSQS = 65536, CW_SSQA = 131072;
static_assert((CW_SSQA + M) * 4 <= (int)(1 * MiB), "ssq arrays inside the memset region");
constexpr size_t CTL_ZERO_BYTES = 64 * 1024;
static_assert((CW_BAR + XCD_BAR_WORDS_C) * 4 <= 64 * 1024 && (CW_CNT + 64) * 4 <= 64 * 1024, "control words inside the memset region");

#define RLX_AGENT __ATOMIC_RELAXED, __HIP_MEMORY_SCOPE_AGENT
__device__ __forceinline__ unsigned cvtpk(float lo, float hi) { f32x2 v = {lo, hi}; bf16x2_t b = __builtin_convertvector(v, bf16x2_t); return __builtin_bit_cast(unsigned, b); }

#define XB_TMO      128
#define XB_XCNT(j)  (256  + 64 * (j))
#define XB_XSUB(j)  (1280 + 64 * (j))
#define XB_XGEN(j)  (2304 + 64 * (j))
#define XB_TOP      3328
#define XB_TOPGEN   3392
#define XCD_BAR_WORDS 3456
#define XB_SPIN_CAP (1u << 18)
__device__ __forceinline__ unsigned xb_ld(unsigned* p)              { return __hip_atomic_load(p, __ATOMIC_RELAXED, __HIP_MEMORY_SCOPE_AGENT); }
__device__ __forceinline__ unsigned xb_add(unsigned* p, unsigned v) { return __hip_atomic_fetch_add(p, v, __ATOMIC_RELAXED, __HIP_MEMORY_SCOPE_AGENT); }
__device__ __forceinline__ unsigned xb_xcc_id() { return (unsigned)__builtin_amdgcn_s_getreg((3 << 11) | 20) & 0xFu; }
#define XB_SPIN(cond, bar) do { unsigned _sp = 0; while (cond) { __builtin_amdgcn_s_sleep(1); \
    if ((++_sp & 255u) == 0u) { if (xb_ld(&(bar)[XB_TMO])) break; if (_sp > XB_SPIN_CAP) { atomicAdd(&(bar)[XB_TMO], 1u); break; } } } } while (0)
struct XcdBarrier { unsigned* bar; unsigned x; volatile LAS unsigned* st; };
__device__ __forceinline__ XcdBarrier xcd_barrier_post(unsigned* bar, volatile LAS unsigned* st) {
    XcdBarrier b; b.bar = bar; b.x = xb_xcc_id(); b.st = st;
    if (threadIdx.x == 0) (void)xb_add(&bar[XB_XCNT(b.x)], 1u);
    return b;
}
__device__ __forceinline__ void xcd_barrier_complete(unsigned* bar, unsigned x, unsigned& nloc, unsigned& nx) {
    const unsigned G = gridDim.x * gridDim.y * gridDim.z;
    unsigned sum, cnt, mine, sp = 0u;
    for (;;) {
        sum = 0u; cnt = 0u; mine = 0u;
#pragma unroll
        for (unsigned j = 0; j < 16; ++j) { const unsigned c = xb_ld(&bar[XB_XCNT(j)]); sum += c; cnt += (c > 0u) ? 1u : 0u; mine = (j == x) ? c : mine; }
        if (sum == G) break;
        __builtin_amdgcn_s_sleep(1);
        if ((++sp & 255u) == 0u) { if (xb_ld(&bar[XB_TMO])) break; if (sp > XB_SPIN_CAP) { atomicAdd(&bar[XB_TMO], 1u); break; } }
    }
    nloc = mine > 0u ? mine : 1u; nx = cnt > 0u ? cnt : 1u;
}
__device__ __forceinline__ void xcd_barrier(const XcdBarrier& b) {
    asm volatile("s_waitcnt vmcnt(0)" ::: "memory");
    __syncthreads();
    if (threadIdx.x == 0) {
        unsigned* bar = b.bar;
        __builtin_amdgcn_s_waitcnt(0);
        unsigned nloc = b.st[0], nx = b.st[1];
        if (nloc == 0u) { xcd_barrier_complete(bar, b.x, nloc, nx); b.st[0] = nloc; b.st[1] = nx; }
        const unsigned old = xb_add(&bar[XB_XSUB(b.x)], 1u);
        const unsigned gen = old / nloc;
        if (old + 1u == (gen + 1u) * nloc) {
            __builtin_amdgcn_fence(__ATOMIC_RELEASE, "agent");
            asm volatile("s_waitcnt vmcnt(0)" ::: "memory");
            const unsigned og = xb_add(&bar[XB_TOP], 1u);
            const unsigned tg = og / nx;
            if (og + 1u == (tg + 1u) * nx) xb_add(&bar[XB_TOPGEN], 1u);
            else XB_SPIN(xb_ld(&bar[XB_TOPGEN]) == tg, bar);
            __builtin_amdgcn_fence(__ATOMIC_ACQUIRE, "agent");
            xb_add(&bar[XB_XGEN(b.x)], 1u);
            asm volatile("s_waitcnt vmcnt(0)" ::: "memory");
        } else {
            XB_SPIN(xb_ld(&bar[XB_XGEN(b.x)]) == gen, bar);
            __builtin_amdgcn_fence(__ATOMIC_ACQUIRE, "agent");
            asm volatile("s_waitcnt vmcnt(0)" ::: "memory");
        }
    }
    __syncthreads();
}

__device__ __forceinline__ unsigned pk4_fp8(float a, float b, float c, float d) { int w = 0; w = __builtin_amdgcn_cvt_pk_fp8_f32(a, b, w, false); w = __builtin_amdgcn_cvt_pk_fp8_f32(c, d, w, true); return (unsigned)w; }
template <int K> __device__ __forceinline__ const float* karg();
struct SideItem { const float* W; unsigned char* WT; int ldw, srccol0, ldt, dstrow0, k0, scaled; };
__device__ __forceinline__ SideItem moe_side_item(int r) {
    unsigned char* ws;
    asm volatile("s_load_dwordx2 %0, %1, 216\n\ts_waitcnt lgkmcnt(0)" : "=s"(ws) : "s"(__builtin_amdgcn_kernarg_segment_ptr()) : "memory");
    if (r < 16384) { const int e = r >> 9, q = r & 511, kb = q >> 5, d = q & 31, pn = d >> 3, beta = d & 7;
        const float* W = (beta < 4 ? karg<23>() : karg<24>()) + (size_t)e * DM * DE;
        return SideItem{W, ws + FW_WGU + (size_t)e * DM * DM, DE, 128 * pn + 32 * (beta & 3), DM, 32 * d, 64 * kb, 1}; }
    r -= 16384; const int e = r >> 8, q = r & 255, kb = q >> 5, d = q & 31;
    return SideItem{karg<25>() + (size_t)e * DE * DM, ws + FW_WD + (size_t)e * DM * DE, DM, 32 * (8 * (d >> 3) + 2 * (d & 3) + ((d & 7) >> 2)), DE, 32 * d, 64 * kb, 0};
}
__device__ __forceinline__ void side_load(const SideItem& t, int lane, int hb, f32x4 (&v)[4]) {
    asm volatile("" : "+v"(lane));
    const int kh = lane >> 3, nq = lane & 7;
#pragma unroll
    for (int i = 0; i < 4; ++i) v[i] = __builtin_nontemporal_load((const GAS f32x4*)(t.W + (size_t)(t.k0 + 8 * kh + 4 * hb + i) * t.ldw + t.srccol0 + 4 * nq));
}
__device__ __forceinline__ void side_store(const SideItem& t, int lane, int hb, const f32x4 (&v)[4], const LAS float* GF) {
    asm volatile("" : "+v"(lane));
    const int kh = lane >> 3, nq = lane & 7;
    f32x4 g0 = (f32x4){W8SC, W8SC, W8SC, W8SC};
    if (t.scaled) g0 = *(const LAS f32x4*)(GF + t.k0 + 8 * kh + 4 * hb);
#pragma unroll
    for (int e = 0; e < 4; ++e)
        *(unsigned*)(t.WT + (size_t)(t.dstrow0 + 4 * nq + e) * t.ldt + t.k0 + 8 * kh + 4 * hb) = pk4_fp8(v[0][e] * g0.x, v[1][e] * g0.y, v[2][e] * g0.z, v[3][e] * g0.w);
}
constexpr int BM = 256, BK = 64, HALF = 128, HTB = HALF * BK * 2;
__device__ __forceinline__ int lds_byte(int r, int c) { const int st = (r >> 4) * 2 + (c >> 5), rr = r & 15, cc = c & 31, ob = rr * 64 + cc * 2; return st * 1024 + (ob ^ (((ob >> 9) & 1) << 5)); }
__device__ __forceinline__ void stage_rc(int b, int& R, int& C) { const int st = b / 1024, sb = b % 1024, swz = sb ^ (((sb >> 9) & 1) << 5); R = (st >> 1) * 16 + swz / 64; C = (st & 1) * 32 + (swz % 64) / 2; }
__device__ __forceinline__ int perm32(int rho) { const int n = rho >> 4, i = rho & 15; return 8 * (i >> 2) + 4 * n + (i & 3); }
struct Unit { const char* a; const char* b; int pm, pn, aux; };
struct GemmP { int lda_b, ldb_b, K, ksa = 0, a_gs = 0; };

template <class Epi, class Sched, bool GATHER = false, int KREP = 1, bool FP8 = false>
__device__ __forceinline__ void gemm_phase(LAS unsigned char* lds, const GemmP g, const Sched& S, const Epi& E, const LAS int* rowcache = nullptr, int stagger_ticks = 0) {
    const int tid = threadIdx.x, wid = __builtin_amdgcn_readfirstlane(tid >> 6), lane = tid & 63, wr = wid >> 2, wc = wid & 3, fr = lane & 15, fq = lane >> 4;
    const int ntk = g.K / BK, nt = ntk * (KREP == 3 ? 1 : KREP);
    unsigned voffA[2], voffB[2]; int gR[2], gC[2];
#pragma unroll
    for (int i = 0; i < 2; ++i) { int R, C; stage_rc(tid * 16 + i * 8192, R, C); const int Rb = Epi::PERM ? ((R & ~31) + perm32(R & 31)) : R; gR[i] = R; gC[i] = C * 2;
        voffA[i] = g.a_gs ? (unsigned)(R * g.lda_b + (C >> 4) * g.a_gs + (C & 15) * 2) : (unsigned)(R * g.lda_b + C * 2); voffB[i] = (unsigned)(Rb * g.ldb_b + C * 2); }
    unsigned vc0[2] = {voffA[0], voffA[1]}, vc1[2] = {voffA[0], voffA[1]}, vn0[2] = {voffA[0], voffA[1]}, vn1[2] = {voffA[0], voffA[1]};
#define PG8_GOFF(dst0, dst1, ui_) do { _Pragma("unroll") for (int _i = 0; _i < 2; ++_i) { \
        dst0[_i] = ((unsigned)rowcache[(ui_) * 256 + gR[_i]] & 0xffffu) * (unsigned)g.lda_b + (unsigned)gC[_i]; dst1[_i] = ((unsigned)rowcache[(ui_) * 256 + 128 + gR[_i]] & 0xffffu) * (unsigned)g.lda_b + (unsigned)gC[_i]; } } while (0)
    const size_t kstep = (size_t)(BK * 2), kstepA = g.ksa ? (size_t)g.ksa : kstep;
    const size_t hstepA = GATHER ? 0 : (size_t)HALF * g.lda_b, hstepB = (size_t)HALF * g.ldb_b;
    const unsigned ldsw = (unsigned)wid * 1024u;
    const int aoff = lds_byte(wr * 64 + fr, fq * 8), boff = lds_byte(wc * 32 + fr, fq * 8);
#ifndef OPAQ_VO
#define OPAQ_VO 1
#endif
#define PG8_SA(b, h) (((b) * 2 + (h)) * HTB)
#define PG8_SB(b, h) ((4 + (b) * 2 + (h)) * HTB)
#define PG8_STAGE(bufoff, gbase, voff) do { _Pragma("unroll") for (int _i = 0; _i < 2; ++_i) { unsigned _vo = (voff)[_i]; if (OPAQ_VO) asm volatile("" : "+v"(_vo)); \
        __builtin_amdgcn_global_load_lds((const unsigned*)((const char*)(gbase) + _vo), (LAS unsigned*)(lds + (bufoff) + ldsw + _i * 8192), 16, 0, 0); } } while (0)
#define PG8_LDA(dst, b, h) do { _Pragma("unroll") for (int m = 0; m < 4; ++m) { const LAS unsigned char* p_ = lds + PG8_SA(b, h) + aoff + m * 2048; \
        if constexpr (FP8) { dst[m].v.lo = *(const LAS v4i_*)p_; dst[m].v.hi = *(const LAS v4i_*)(p_ + 1024); } else { dst[m].v[0] = *(const LAS bf16x8*)p_; dst[m].v[1] = *(const LAS bf16x8*)(p_ + 1024); } } } while (0)
#define PG8_LDB(dst, b, h) do { _Pragma("unroll") for (int n = 0; n < 2; ++n) { const LAS unsigned char* p_ = lds + PG8_SB(b, h) + boff + n * 2048; \
        if constexpr (FP8) { dst[n].v.lo = *(const LAS v4i_*)p_; dst[n].v.hi = *(const LAS v4i_*)(p_ + 1024); } else { dst[n].v[0] = *(const LAS bf16x8*)p_; dst[n].v[1] = *(const LAS bf16x8*)(p_ + 1024); } } } while (0)
#define PG8_MMA(ai, bj, At, Bt) do { if (Epi::HALFN && (bj) == 1) break; __builtin_amdgcn_s_setprio(1); \
        if constexpr (FP8) { asm volatile("s_nop 1\n\t" "v_mfma_scale_f32_16x16x128_f8f6f4 %0, %8, %10, %0, %14, %14 op_sel_hi:[0,0,0]\n\t" "v_mfma_scale_f32_16x16x128_f8f6f4 %1, %9, %10, %1, %14, %14 op_sel_hi:[0,0,0]\n\t" "v_mfma_scale_f32_16x16x128_f8f6f4 %2, %8, %11, %2, %14, %14 op_sel_hi:[0,0,0]\n\t" "v_mfma_scale_f32_16x16x128_f8f6f4 %3, %9, %11, %3, %14, %14 op_sel_hi:[0,0,0]\n\t" "v_mfma_scale_f32_16x16x128_f8f6f4 %4, %8, %12, %4, %14, %14 op_sel_hi:[0,0,0]\n\t" "v_mfma_scale_f32_16x16x128_f8f6f4 %5, %9, %12, %5, %14, %14 op_sel_hi:[0,0,0]\n\t" "v_mfma_scale_f32_16x16x128_f8f6f4 %6, %8, %13, %6, %14, %14 op_sel_hi:[0,0,0]\n\t" "v_mfma_scale_f32_16x16x128_f8f6f4 %7, %9, %13, %7, %14, %14 op_sel_hi:[0,0,0]\n\t" "s_nop 1" \
            : "+v"(acc[ai][bj][0][0]), "+v"(acc[ai][bj][0][1]), "+v"(acc[ai][bj][1][0]), "+v"(acc[ai][bj][1][1]), "+v"(acc[ai][bj][2][0]), "+v"(acc[ai][bj][2][1]), "+v"(acc[ai][bj][3][0]), "+v"(acc[ai][bj][3][1]) \
            : "v"(Bt[0].v), "v"(Bt[1].v), "v"(At[0].v), "v"(At[1].v), "v"(At[2].v), "v"(At[3].v), "v"(mxs)); } \
        else { _Pragma("unroll") for (int m = 0; m < 4; ++m) _Pragma("unroll") for (int n = 0; n < 2; ++n) _Pragma("unroll") for (int k = 0; k < 2; ++k) \
            acc[ai][bj][m][n] = __builtin_amdgcn_mfma_f32_16x16x32_bf16(Bt[n].v[k], At[m].v[k], acc[ai][bj][m][n], 0, 0, 0); } \
        __builtin_amdgcn_s_setprio(0); } while (0)
#define PG8_WAIT_V(n) asm volatile("s_waitcnt vmcnt(" #n ")" ::: "memory")
#define PG8_WAIT_L(n) asm volatile("s_waitcnt lgkmcnt(" #n ")" ::: "memory")
#define PG8_BAR __builtin_amdgcn_s_barrier()
#define PG8_SCHED __builtin_amdgcn_sched_barrier(0)
    int mxs = 0x7F7F7F7F; asm volatile("" : "+v"(mxs));
    Unit cur, nxt; int ui = 0;
    if (!S.next(0, cur)) return;
    if (stagger_ticks > 0) { const unsigned long long t0 = __builtin_amdgcn_s_memrealtime(); while ((long long)(__builtin_amdgcn_s_memrealtime() - t0) < (long long)stagger_ticks) __builtin_amdgcn_s_sleep(8); }
    f32x4 acc[2][2][4][2];
#pragma unroll
    for (int a = 0; a < 2; ++a)
#pragma unroll
        for (int b = 0; b < 2; ++b)
#pragma unroll
            for (int m = 0; m < 4; ++m)
#pragma unroll
                for (int n = 0; n < 2; ++n) acc[a][b][m][n] = (f32x4){0.f, 0.f, 0.f, 0.f};
    typedef int v4i_ __attribute__((ext_vector_type(4))); typedef int v8i_ __attribute__((ext_vector_type(8)));
    struct FragB { bf16x8 v[2]; }; struct Frag8 { v8i_ v; };
    typename std::conditional<FP8, Frag8, FragB>::type At[4], B0[2], B1[2];
    const char* cA = cur.a; const char* cB = cur.b;
    if (GATHER) { PG8_GOFF(vc0, vc1, 0); }
    PG8_STAGE(PG8_SB(0, 0), cB, voffB); PG8_STAGE(PG8_SB(0, 1), cB + hstepB, voffB); PG8_STAGE(PG8_SA(0, 0), cA, vc0); PG8_STAGE(PG8_SA(0, 1), cA + hstepA, vc1);
    if (wr == 1) PG8_BAR;
    PG8_WAIT_V(2); PG8_BAR;
    PG8_STAGE(PG8_SB(1, 0), cB + kstep, voffB); PG8_STAGE(PG8_SA(1, 0), cA + kstepA, vc0); PG8_STAGE(PG8_SB(1, 1), cB + hstepB + kstep, voffB);
    PG8_WAIT_V(6); PG8_BAR;
    for (;;) {
        const bool has_next = S.next(ui + 1, nxt);
        const char* nA = has_next ? nxt.a : cA; const char* nB = has_next ? nxt.b : cB;
        if constexpr (Epi::HOOKS) E.begin(cur, ui, tid);
        if (GATHER) { if (has_next) { PG8_GOFF(vn0, vn1, ui + 1); } else { vn0[0] = vc0[0]; vn0[1] = vc0[1]; vn1[0] = vc1[0]; vn1[1] = vc1[1]; } }
        int ntu = nt, kskip = 0; if constexpr (Sched::KMAP) { ntu = __builtin_amdgcn_readfirstlane(S.nk(ui)); kskip = __builtin_amdgcn_readfirstlane(S.kskip(ui)); asm volatile("" : "+s"(ntu), "+s"(kskip)); }
        for (int t = 0; t < ntu; t += 2) {
            const bool last = (t == ntu - 2);
            if constexpr (Epi::HOOKS) { if (t == nt / 2) E.mid(acc, ui, wr, fr); }
#ifdef PROBE_EPI_TWICE
            if constexpr (KREP == 3) { if (t == ntk / 2) E.fin(acc, cur, ui, wr, wc, fr, fq); }
#endif
            int k1 = (t + 1) % ntk, k2 = (t + 2) % ntk; if constexpr (Sched::KMAP) { k1 = t + 1 + ((t + 1 >= 4) ? kskip : 0); k2 = t + 2 + ((t + 2 >= 4) ? kskip : 0); }
            const char* a1 = cA + (size_t)k1 * kstepA;
            const char* a2 = last ? nA : cA + (size_t)k2 * kstepA; const char* b2 = last ? nB : cB + (size_t)k2 * kstep;
            const char* a3 = a2 + kstepA; const char* b3 = b2 + kstep;
            unsigned w0[2], w1[2];
            w0[0] = (GATHER && last) ? vn0[0] : vc0[0]; w0[1] = (GATHER && last) ? vn0[1] : vc0[1]; w1[0] = (GATHER && last) ? vn1[0] : vc1[0]; w1[1] = (GATHER && last) ? vn1[1] : vc1[1];
            PG8_LDB(B0, 0, 0); PG8_LDB(B1, 0, 1); PG8_SCHED; PG8_LDA(At, 0, 0); PG8_STAGE(PG8_SA(1, 1), a1 + hstepA, vc1);
            PG8_WAIT_V(8); PG8_WAIT_L(0); PG8_BAR; PG8_MMA(0, 0, At, B0); PG8_MMA(0, 1, At, B1); PG8_BAR; PG8_SCHED;
            PG8_LDA(At, 0, 1); PG8_STAGE(PG8_SB(0, 0), b2, voffB); PG8_STAGE(PG8_SB(0, 1), b2 + hstepB, voffB); PG8_STAGE(PG8_SA(0, 0), a2, w0);
            PG8_WAIT_V(8); PG8_WAIT_L(0); PG8_BAR; PG8_MMA(1, 0, At, B0); PG8_MMA(1, 1, At, B1); PG8_BAR; PG8_SCHED;
            PG8_LDB(B0, 1, 0); PG8_LDB(B1, 1, 1); PG8_SCHED; PG8_LDA(At, 1, 0); PG8_STAGE(PG8_SA(0, 1), a2 + hstepA, w1);
            PG8_WAIT_V(8); PG8_WAIT_L(0); PG8_BAR; PG8_MMA(0, 0, At, B0); PG8_MMA(0, 1, At, B1); PG8_BAR; PG8_SCHED;
            PG8_LDA(At, 1, 1); PG8_STAGE(PG8_SB(1, 0), b3, voffB); PG8_STAGE(PG8_SB(1, 1), b3 + hstepB, voffB); PG8_STAGE(PG8_SA(1, 0), a3, w0);
            PG8_WAIT_V(8); PG8_WAIT_L(0); PG8_BAR; PG8_MMA(1, 0, At, B0); PG8_MMA(1, 1, At, B1); PG8_BAR; PG8_SCHED;
        }
        if (wr == 0) PG8_BAR;
        if constexpr (FP8) asm volatile("s_nop 15\n\ts_nop 7" ::: "memory");
        if constexpr (KREP > 1) {
#pragma unroll
            for (int a = 0; a < 2; ++a)
#pragma unroll
                for (int b = 0; b < 2; ++b)
#pragma unroll
                    for (int m = 0; m < 4; ++m)
#pragma unroll
                        for (int n = 0; n < 2; ++n) acc[a][b][m][n] = acc[a][b][m][n] * (KREP == 3 ? 1.f : 1.f / KREP); }
        if constexpr (Epi::SIDE) {
            constexpr int SIDE_MODE = Epi::SIDE_WHOLE ? 1 : 0;
            SideItem sit; f32x4 sv[4], sw[4]; const bool side = (E.side_r0 >= 0);
            if (side) { sit = moe_side_item(E.side_r0 + wid + 2048 * ui); side_load(sit, lane, 0, sv); if (SIDE_MODE == 1) side_load(sit, lane, 1, sw); }
            asm volatile("" ::: "memory"); PG8_SCHED;
            if constexpr (Epi::HOOKS) E.template finh<0>(acc, cur, ui, wr, wc, fr, fq); else E.template half<0>(acc, cur, wr, wc, fr, fq);
            asm volatile("" ::: "memory"); PG8_SCHED;
            if (side && SIDE_MODE == 0) { side_store(sit, lane, 0, sv, (const LAS float*)(lds + GF_OFF)); side_load(sit, lane, 1, sw); }
            asm volatile("" ::: "memory"); PG8_SCHED;
            if constexpr (Epi::HOOKS) E.template finh<1>(acc, cur, ui, wr, wc, fr, fq); else E.template half<1>(acc, cur, wr, wc, fr, fq);
            asm volatile("" ::: "memory"); PG8_SCHED;
            if (side) { if (SIDE_MODE == 1) side_store(sit, lane, 0, sv, (const LAS float*)(lds + GF_OFF)); side_store(sit, lane, 1, sw, (const LAS float*)(lds + GF_OFF)); }
        } else { if constexpr (Epi::HOOKS) E.fin(acc, cur, ui, wr, wc, fr, fq); else E(acc, cur, wr, wc, fr, fq); }
        if (!has_next) break;
#pragma unroll
        for (int a = 0; a < 2; ++a)
#pragma unroll
            for (int b = 0; b < 2; ++b)
#pragma unroll
                for (int m = 0; m < 4; ++m)
#pragma unroll
                    for (int n = 0; n < 2; ++n) acc[a][b][m][n] = (f32x4){0.f, 0.f, 0.f, 0.f};
        cur = nxt; cA = nA; cB = nB; ++ui;
        if (GATHER) { vc0[0] = vn0[0]; vc0[1] = vn0[1]; vc1[0] = vn1[0]; vc1[1] = vn1[1]; }
        if (wr == 1) PG8_BAR;
    }
    PG8_WAIT_V(0);
    PG8_BAR;
#undef PG8_GOFF
#undef PG8_SA
#undef PG8_SB
#undef PG8_STAGE
#undef PG8_LDA
#undef PG8_LDB
#undef PG8_MMA
#undef PG8_WAIT_V
#undef PG8_WAIT_L
#undef PG8_BAR
#undef PG8_SCHED
}

struct DenseOrder {
    static constexpr bool KMAP = false;
    const char* A; const char* B; size_t a_tile, b_tile; int nM, nN, nwg, G, c;
    __device__ __forceinline__ bool next(int i, Unit& u) const {
        const long L = (long)i * G + c; if (L >= nwg) return false;
        int wgid = (int)L; { const int q = nwg / 8, r = nwg % 8, xcd = wgid % 8, off = wgid / 8; wgid = (xcd < r ? xcd * (q + 1) : r * (q + 1) + (xcd - r) * q) + off; }
        const int nig = 8 * nN, gid = wgid / nig, fm = gid * 8, gsz = (nM - fm) < 8 ? (nM - fm) : 8;
        u.pm = fm + ((wgid % nig) % gsz); u.pn = (wgid % nig) / gsz; u.aux = 0;
        u.a = A + (size_t)u.pm * a_tile; u.b = B + (size_t)u.pn * b_tile; return true;
    }
};
struct GroupOrder {
    static constexpr bool KMAP = false;
    const char* A; const char* B; size_t a_grp, b_grp, a_tile, b_tile; int nM, nN, nwg, G, c;
    __device__ __forceinline__ bool next(int i, Unit& u) const {
        const long L = (long)i * G + c; if (L >= nwg) return false;
        const int per = nM * nN, g = (int)L / per, r = (int)L % per;
        u.pn = r / nM; u.pm = r % nM; u.aux = g;
        u.a = A + (size_t)g * a_grp + (size_t)u.pm * a_tile; u.b = B + (size_t)g * b_grp + (size_t)u.pn * b_tile; return true;
    }
};
struct S5MainOrder {
    static constexpr bool KMAP = true;
    __device__ __forceinline__ int nk(int ui) const { return ((((c >> 3) & 1) ^ ui) == 0) ? 6 : 10; }
    __device__ __forceinline__ int kskip(int ui) const { return ((((c >> 3) & 1) ^ ui) == 0) ? 4 : 0; }
    const char* A; const char* B; size_t a_grp, b_grp, a_tile, b_tile; int c;
    __device__ __forceinline__ bool next(int i, Unit& u) const {
        if (i >= 2) return false;
        u.aux = 16 * i + (c >> 4); u.pm = c & 7; u.pn = ((c >> 3) & 1) ^ i;
        u.a = A + (size_t)u.aux * a_grp + (size_t)u.pm * a_tile; u.b = B + (size_t)u.aux * b_grp + (size_t)u.pn * b_tile; return true;
    }
};
__device__ __forceinline__ void moe_unit(int L, int ntiles, int& pm, int& pn) {
    const int j = L >> 5, full = ntiles >> 3;
    if (j < full) { const int r = L & 31; pm = 8 * j + (r & 7); pn = r >> 3; }
    else { const int gsz = ntiles - 8 * full, r = L - 32 * full; pm = 8 * full + r % gsz; pn = r / gsz; }
}
struct MoeOrder {
    static constexpr bool KMAP = false;
    const char* A; const char* B; size_t a_tile, b_exp, b_tile; const LAS unsigned char* t2e; int ntiles, G, c;
    __device__ __forceinline__ bool next(int i, Unit& u) const {
        const long L = (long)i * G + c; if (L >= (long)ntiles * 4) return false;
        moe_unit((int)L, ntiles, u.pm, u.pn); u.aux = t2e[u.pm];
        u.a = A + (size_t)u.pm * a_tile; u.b = B + (size_t)u.aux * b_exp + (size_t)u.pn * b_tile; return true;
    }
};

#ifndef Z_PLANES
#define Z_PLANES 1
#endif
__device__ __forceinline__ size_t z_off(size_t tok, int c) { return Z_PLANES ? (((size_t)(c >> 4) * M + tok) * 16 + (size_t)(c & 15)) : (tok * DSSM + (size_t)c); }
typedef f32x4 Acc[2][2][4][2];
constexpr float YE_SCALE = 8.f;

#ifndef NTS_MASK
#define NTS_MASK 0
#endif
template <int SITE, class V> __device__ __forceinline__ void st_s(V* p, const V v) { if constexpr (((NTS_MASK) >> SITE) & 1) __builtin_nontemporal_store(v, p); else *p = v; }
__device__ __forceinline__ void store_pair(bf16* row_even, size_t pitch, u32x4 p0, u32x4 p1, int fr, int fq) {
    const bool odd = fr & 1;
    const u32x4 send = odd ? p0 : p1; u32x4 recv;
    recv.x = dppu<0xB1>(send.x); recv.y = dppu<0xB1>(send.y); recv.z = dppu<0xB1>(send.z); recv.w = dppu<0xB1>(send.w);
    const u32x4 a = odd ? recv : p0, b = odd ? p1 : recv;
    bf16* d = row_even + (odd ? 32 : 0) + 8 * fq;
    st_s<0>((u32x4*)d, a); st_s<0>((u32x4*)(d + pitch), b);
}
struct EpiProj {
#ifndef SIDE_WHOLE1
#define SIDE_WHOLE1 1
#endif
    static constexpr bool HALFN = false, HOOKS = false, PERM = true, SIDE = true, SIDE_WHOLE = (SIDE_WHOLE1 != 0);
    bf16* U2; bf16* QKV; const LAS float* GQK; int side_r0; unsigned char* side_ws;
    __device__ __forceinline__ void operator()(const Acc& acc, const Unit& u, int wr, int wc, int fr, int fq) const { half<0>(acc, u, wr, wc, fr, fq); half<1>(acc, u, wr, wc, fr, fq); }
    template <int AI> __device__ __forceinline__ void half(const Acc& acc, const Unit& u, int wr, int wc, int fr, int fq) const {
        asm volatile("" : "+v"(fr), "+v"(fq));
        const int typ = u.pn >> 1;
        if (typ == 1 || typ == 2) run<true, AI>(acc, u, wr, wc, fr, fq); else run<false, AI>(acc, u, wr, wc, fr, fq);
    }
    template <bool nrm, int AI> __device__ __forceinline__ void run(const Acc& acc, const Unit& u, int wr, int wc, int fr, int fq) const {
        const int typ = u.pn >> 1, sub = u.pn & 1;
        const LAS float* gg = GQK + ((typ == 1) ? 0 : 64);
        f32x4 gn[2][2];
#pragma unroll
        for (int bj = 0; bj < 2; ++bj)
#pragma unroll
            for (int n = 0; n < 2; ++n) gn[bj][n] = nrm ? *(const LAS f32x4*)(gg + 32 * bj + 8 * fq + 4 * n) : (f32x4){1.f, 1.f, 1.f, 1.f};
        { constexpr int ai = AI;
#pragma unroll
            for (int m = 0; m < 4; ++m) {
                const int r = u.pm * BM + ai * HALF + wr * 64 + m * 16 + fr;
                f32x4 v[2][2];
#pragma unroll
                for (int bj = 0; bj < 2; ++bj)
#pragma unroll
                    for (int n = 0; n < 2; ++n) v[bj][n] = acc[ai][bj][m][n];
                if constexpr (nrm) {
                    float s = 0.f;
#pragma unroll
                    for (int bj = 0; bj < 2; ++bj)
#pragma unroll
                        for (int n = 0; n < 2; ++n) s += (v[bj][n].x * v[bj][n].x + v[bj][n].y * v[bj][n].y) + (v[bj][n].z * v[bj][n].z + v[bj][n].w * v[bj][n].w);
                    s = xor32_sum(xor16_sum(s));
                    const float rstd = nrm ? __builtin_amdgcn_rsqf(s * (1.f / 64.f) + EPS) : 1.f;
#pragma unroll
                    for (int bj = 0; bj < 2; ++bj)
#pragma unroll
                        for (int n = 0; n < 2; ++n) v[bj][n] = v[bj][n] * (gn[bj][n] * rstd);
                }
                u32x4 p[2];
#pragma unroll
                for (int bj = 0; bj < 2; ++bj) { p[bj].x = cvtpk(v[bj][0].x, v[bj][0].y); p[bj].y = cvtpk(v[bj][0].z, v[bj][0].w); p[bj].z = cvtpk(v[bj][1].x, v[bj][1].y); p[bj].w = cvtpk(v[bj][1].z, v[bj][1].w); }
                if (!nrm && typ == 0) {
#pragma unroll
                    for (int bj = 0; bj < 2; ++bj) { const int f = sub * 256 + 64 * wc + 32 * bj + 8 * fq, g = f >> 4, h = f & 15;
                        st_s<1>((u32x4*)(U2 + ((size_t)g * NCH + (r >> 5)) * U2P + (r & 31) * 16 + h), p[bj]); }
                } else store_pair(QKV + (size_t)(typ - 1) * ((size_t)M * 512) + (size_t)(r & ~1) * 512 + sub * 256 + 64 * wc, 512, p[0], p[1], fr, fq);
            } }
    }
};
struct EpiState {
    static constexpr bool HALFN = true, HOOKS = false, PERM = false, SIDE = false;
    float* SST;
    __device__ __forceinline__ void operator()(const Acc& acc, const Unit& u, int wr, int wc, int fr, int fq) const {
#pragma unroll
        for (int ai = 0; ai < 2; ++ai)
#pragma unroll
            for (int m = 0; m < 4; ++m) { const int r = u.pm * BM + ai * HALF + wr * 64 + m * 16 + fr;
#pragma unroll
                for (int n = 0; n < 2; ++n) *(f32x4*)(SST + ((size_t)u.aux * NCH + r) * 128 + 32 * wc + 16 * n + 4 * fq) = acc[ai][0][m][n]; }
    }
};
struct EpiS5 {
    static constexpr bool HALFN = false, HOOKS = false, PERM = true, SIDE = false;
    bf16* Z;
    __device__ __forceinline__ void operator()(const Acc& acc, const Unit& u, int wr, int wc, int fr, int fq) const {
#pragma unroll
        for (int ai = 0; ai < 2; ++ai)
#pragma unroll
            for (int m = 0; m < 4; ++m) { const int r = u.pm * BM + ai * HALF + wr * 64 + m * 16 + fr;
#pragma unroll
                for (int bj = 0; bj < 2; ++bj) { const int c0 = u.pn * BM + bj * HALF + 32 * wc + 8 * fq, i = c0 >> 4, h = c0 & 15;
                    const f32x4 a = acc[ai][bj][m][0], b = acc[ai][bj][m][1];
                    u32x4 w; w.x = cvtpk(gelu_tanh(a.x), gelu_tanh(a.y)); w.y = cvtpk(gelu_tanh(a.z), gelu_tanh(a.w)); w.z = cvtpk(gelu_tanh(b.x), gelu_tanh(b.y)); w.w = cvtpk(gelu_tanh(b.z), gelu_tanh(b.w));
                    st_s<6>((u32x4*)(Z + z_off((size_t)r * 32 + i, u.aux * 16 + h)), w); } }
    }
};
struct EpiGlu {
    static constexpr bool HALFN = false, HOOKS = false, PERM = true, SIDE = false;
    const bf16* Z; const float* bias; bf16* MIX; float* SSQ;
    __device__ __forceinline__ void operator()(const Acc& acc, const Unit& u, int wr, int wc, int fr, int fq) const {
        float ss[2][4];
#pragma unroll
        for (int ai = 0; ai < 2; ++ai)
#pragma unroll
            for (int m = 0; m < 4; ++m) ss[ai][m] = 0.f;
#pragma unroll
        for (int bj = 0; bj < 2; ++bj) { const int c0 = u.pn * BM + bj * HALF + 32 * wc + 8 * fq;
            constexpr float NL2E = -1.4426950408889634f;
            const f32x4 b0 = *(const GAS f32x4*)(bias + c0) * NL2E, b1 = *(const GAS f32x4*)(bias + c0 + 4) * NL2E;
#pragma unroll
            for (int ai = 0; ai < 2; ++ai)
#pragma unroll
                for (int m = 0; m < 4; ++m) { const size_t row = (size_t)(u.pm * BM + ai * HALF + wr * 64 + m * 16 + fr);
                    const u32x4 zz = *(const u32x4*)(Z + z_off(row, c0));
                    const f32x4 a = acc[ai][bj][m][0], b = acc[ai][bj][m][1];
#define GLU_SG(v_, b_) __builtin_amdgcn_rcpf(1.f + __builtin_amdgcn_exp2f(__builtin_fmaf((v_), NL2E, (b_))))
                    float y[8];
                    y[0] = bf2f(zz.x & 0xffff) * GLU_SG(a.x, b0.x); y[1] = bf2f(zz.x >> 16) * GLU_SG(a.y, b0.y); y[2] = bf2f(zz.y & 0xffff) * GLU_SG(a.z, b0.z); y[3] = bf2f(zz.y >> 16) * GLU_SG(a.w, b0.w);
                    y[4] = bf2f(zz.z & 0xffff) * GLU_SG(b.x, b1.x); y[5] = bf2f(zz.z >> 16) * GLU_SG(b.y, b1.y); y[6] = bf2f(zz.w & 0xffff) * GLU_SG(b.z, b1.z); y[7] = bf2f(zz.w >> 16) * GLU_SG(b.w, b1.w);
#undef GLU_SG
                    { float sq = ss[ai][m];
#pragma unroll
                      for (int e = 0; e < 8; ++e) sq = __builtin_fmaf(y[e], y[e], sq);
                      ss[ai][m] = sq; }
                    u32x4 w; w.x = cvtpk(y[0], y[1]); w.y = cvtpk(y[2], y[3]); w.z = cvtpk(y[4], y[5]); w.w = cvtpk(y[6], y[7]);
                    st_s<5>((u32x4*)(MIX + row * PX + c0), w); } }
#pragma unroll
        for (int ai = 0; ai < 2; ++ai)
#pragma unroll
            for (int m = 0; m < 4; ++m) { float v = xor32_sum(xor16_sum(ss[ai][m]));
                if (fq == 0) SSQ[(size_t)(u.pm * BM + ai * HALF + wr * 64 + m * 16 + fr) * 8 + u.pn * 4 + wc] = v; }
    }
};
struct EpiX1B {
#ifndef SIDE7
#define SIDE7 1
#endif
    static constexpr bool HALFN = false, HOOKS = true, PERM = true, SIDE = (SIDE7 != 0), SIDE_WHOLE = false;
    int side_r0; unsigned char* side_ws;
    const float* RSTDX; bf16* X1B; const float* SSQS; const float* SSQA; LAS float* RSC;
    __device__ __forceinline__ void begin(const Unit&, int, int) const {}
    __device__ __forceinline__ void fill(int ui, int pm, int tid) const {
        if (tid < 256) { const int row = pm * BM + tid;
            const f32x4 s0 = *(const f32x4*)(SSQS + (size_t)row * 8), s1 = *(const f32x4*)(SSQS + (size_t)row * 8 + 4), a0 = *(const f32x4*)(SSQA + (size_t)row * 8), a1 = *(const f32x4*)(SSQA + (size_t)row * 8 + 4);
            const float sqs = ((s0.x + s0.y) + (s0.z + s0.w)) + ((s1.x + s1.y) + (s1.z + s1.w)), sqa = ((a0.x + a0.y) + (a0.z + a0.w)) + ((a1.x + a1.y) + (a1.z + a1.w));
            const float rs = __builtin_amdgcn_rsqf(sqs * (1.f / 512.f) + EPS), ra = __builtin_amdgcn_rsqf(sqa * (1.f / 512.f) + EPS);
            LAS float* d = RSC + (ui * 256 + tid) * 3; d[0] = rs * __builtin_amdgcn_rcpf(ra); d[1] = ra; d[2] = __builtin_amdgcn_rcpf(RSTDX[row]); }
    }
    __device__ __forceinline__ void mid(Acc& acc, int ui, int wr, int fr) const {
#pragma unroll
        for (int ai = 0; ai < 2; ++ai)
#pragma unroll
            for (int m = 0; m < 4; ++m) { const float f = RSC[(ui * 256 + ai * HALF + wr * 64 + m * 16 + fr) * 3];
#pragma unroll
                for (int bj = 0; bj < 2; ++bj)
#pragma unroll
                    for (int n = 0; n < 2; ++n) acc[ai][bj][m][n] = acc[ai][bj][m][n] * f; }
    }
    __device__ __forceinline__ void fin(const Acc& acc, const Unit& u, int ui, int wr, int wc, int fr, int fq) const { finh<0>(acc, u, ui, wr, wc, fr, fq); finh<1>(acc, u, ui, wr, wc, fr, fq); }
    template <int AI> __device__ __forceinline__ void finh(const Acc& acc, const Unit& u, int ui, int wr, int wc, int fr, int fq) const {
        constexpr int ai = AI;
#pragma unroll
            for (int m = 0; m < 4; ++m) { const int rl = ai * HALF + wr * 64 + m * 16 + fr; const LAS float* rc = RSC + (ui * 256 + rl) * 3; const float ra = rc[1], ix = rc[2];
                const size_t ro = (size_t)(u.pm * BM + rl) * PX + u.pn * BM + 64 * wc + 8 * fq;
                u32x4 p[2];
#pragma unroll
                for (int bj = 0; bj < 2; ++bj) { const u32x4 xn = *(const u32x4*)(X1B + ro + 32 * bj);
                    const f32x4 xa = (f32x4){bf2f(xn.x & 0xffff), bf2f(xn.x >> 16), bf2f(xn.y & 0xffff), bf2f(xn.y >> 16)} * ix, xb = (f32x4){bf2f(xn.z & 0xffff), bf2f(xn.z >> 16), bf2f(xn.w & 0xffff), bf2f(xn.w >> 16)} * ix;
                    const f32x4 a = xa + acc[ai][bj][m][0] * ra, b = xb + acc[ai][bj][m][1] * ra;
                    p[bj].x = cvtpk(a.x, a.y); p[bj].y = cvtpk(a.z, a.w); p[bj].z = cvtpk(b.x, b.y); p[bj].w = cvtpk(b.z, b.w); }
                store_pair(X1B + (size_t)(u.pm * BM + (rl & ~1)) * PX + u.pn * BM + 64 * wc, PX, p[0], p[1], fr, fq); }
    }
};
struct EpiGU {
    static constexpr bool HALFN = false, HOOKS = true, PERM = true, SIDE = false;
    __device__ __forceinline__ void begin(const Unit&, int, int) const {}
    __device__ __forceinline__ void mid(Acc&, int, int, int) const {}
    unsigned char* HH; const LAS unsigned* RCW;
    __device__ __forceinline__ void fin(const Acc& acc, const Unit& u, int ui, int wr, int wc, int fr, int fq) const {
#pragma unroll
        for (int ai = 0; ai < 2; ++ai)
#pragma unroll
            for (int m = 0; m < 4; ++m) { const int rl = ai * HALF + wr * 64 + m * 16 + fr, rr = u.pm * BM + rl; const size_t off = (size_t)rr * DE + u.pn * 128 + 32 * wc + 8 * fq;
                const float sc = __uint_as_float(RCW[ui * 256 + rl] & 0xffff0000u) * (1.f / W8SC), k1 = sc * -1.4426950408889634f, sc2 = sc * sc;
#define GU_H(g_, u_) (((g_) * (u_)) * __builtin_amdgcn_rcpf(1.f + __builtin_amdgcn_exp2f((g_) * k1)) * sc2)
                float hv[8];
#pragma unroll
                for (int n = 0; n < 2; ++n) { const f32x4 gt = acc[ai][0][m][n], up = acc[ai][1][m][n];
                    hv[4 * n] = GU_H(gt.x, up.x); hv[4 * n + 1] = GU_H(gt.y, up.y); hv[4 * n + 2] = GU_H(gt.z, up.z); hv[4 * n + 3] = GU_H(gt.w, up.w); }
#undef GU_H
                u32x2 w; w.x = pk4_fp8(hv[0], hv[1], hv[2], hv[3]); w.y = pk4_fp8(hv[4], hv[5], hv[6], hv[7]);
                st_s<7>((u32x2*)(HH + off), w); }
    }
};
struct EpiDown {
    static constexpr bool HALFN = false, HOOKS = true, PERM = true, SIDE = false;
    __device__ __forceinline__ void begin(const Unit&, int, int) const {}
    __device__ __forceinline__ void mid(Acc&, int, int, int) const {}
    unsigned char* YE; const LAS float* RGC;
    __device__ __forceinline__ void fin(const Acc& acc, const Unit& u, int ui, int wr, int wc, int fr, int fq) const {
#pragma unroll
        for (int ai = 0; ai < 2; ++ai)
#pragma unroll
            for (int m = 0; m < 4; ++m) { const int rl = ai * HALF + wr * 64 + m * 16 + fr; const float gw_ = RGC[ui * 256 + rl] * (YE_SCALE / W8SC);
                u32x2 p[2];
#pragma unroll
                for (int bj = 0; bj < 2; ++bj) { const f32x4 a = acc[ai][bj][m][0] * gw_, b = acc[ai][bj][m][1] * gw_; p[bj].x = pk4_fp8(a.x, a.y, a.z, a.w); p[bj].y = pk4_fp8(b.x, b.y, b.z, b.w); }
                const bool od = fq & 1; const u32x2 send = od ? p[0] : p[1]; u32x2 recv; recv.x = xor16_get(send.x, od); recv.y = xor16_get(send.y, od);
                u32x4 w; if (od) { w.x = recv.x; w.y = recv.y; w.z = p[1].x; w.w = p[1].y; } else { w.x = p[0].x; w.y = p[0].y; w.z = recv.x; w.w = recv.y; }
                st_s<4>((u32x4*)(YE + (size_t)(u.pm * BM + rl) * DM + u.pn * BM + 64 * wc + (od ? 32 : 0) + 8 * (fq & ~1)), w); }
    }
};

template <int K> __device__ __forceinline__ const float* karg() {
    const float* p;
    asm volatile("s_load_dwordx2 %0, %1, %2\n\ts_waitcnt lgkmcnt(0)" : "=s"(p) : "s"(__builtin_amdgcn_kernarg_segment_ptr()), "i"(K * 8) : "memory");
    return p;
}
struct Args { const float* in[26]; float* out; unsigned char* ws; int ph_lo, ph_hi; };
struct Frame { LAS unsigned char* lds; volatile LAS unsigned* MISC; unsigned* ctl; int tid, lane, wave, G, c; };

struct TItem { const float* W; int ldw, srccol0; const float* kscale; bf16* WT; int ldt, dstrow0, k0; int fp8; };
__device__ __forceinline__ void titem_load(const TItem& t, int lane, f32x4 (&v)[8]) {
#pragma unroll
    for (int i = 0; i < 8; ++i) { const int kk = 8 * i + (lane >> 3); v[i] = *(const GAS f32x4*)(t.W + (size_t)(t.k0 + kk) * t.ldw + t.srccol0 + (lane & 7) * 4); }
}
__device__ __forceinline__ void titem_store(const TItem& t, int lane, const f32x4 (&v)[8], LAS float* scr) {
#pragma unroll
    for (int i = 0; i < 8; ++i) { const int kk = 8 * i + (lane >> 3); const float sc = t.kscale ? t.kscale[t.k0 + kk] : 1.f; LAS float* d = scr + kk * 33 + (lane & 7) * 4;
        d[0] = v[i].x * sc; d[1] = v[i].y * sc; d[2] = v[i].z * sc; d[3] = v[i].w * sc; }
    asm volatile("s_waitcnt lgkmcnt(0)" ::: "memory");
    const int c = lane & 7;
#pragma unroll
    for (int j = 0; j < 4; ++j) { const int n = (lane >> 3) + 8 * j; const LAS float* s = scr + (8 * c) * 33 + n;
        if (t.fp8) { u32x2 o; o.x = pk4_fp8(s[0 * 33] * W8SC, s[1 * 33] * W8SC, s[2 * 33] * W8SC, s[3 * 33] * W8SC); o.y = pk4_fp8(s[4 * 33] * W8SC, s[5 * 33] * W8SC, s[6 * 33] * W8SC, s[7 * 33] * W8SC);
            *(u32x2*)((unsigned char*)t.WT + (size_t)(t.dstrow0 + n) * t.ldt + t.k0 + 8 * c) = o; }
        else { u32x4 o; o.x = pk2(s[0 * 33], s[1 * 33]); o.y = pk2(s[2 * 33], s[3 * 33]); o.z = pk2(s[4 * 33], s[5 * 33]); o.w = pk2(s[6 * 33], s[7 * 33]);
            *(u32x4*)(t.WT + (size_t)(t.dstrow0 + n) * t.ldt + t.k0 + 8 * c) = o; } }
    asm volatile("s_waitcnt lgkmcnt(0)" ::: "memory");
}
__device__ __forceinline__ void s5_tables_item(Frame& F, const Args& a, int g, int part) {
    const float* lre = karg<3>(); const float* lim = karg<4>(); const float* ldt = karg<5>(); const float* bre = karg<6>(); const float* bim = karg<7>();
    const float* cre = karg<8>(); const float* cim = karg<9>(); const float* dsk = karg<10>();
    LAS float* PWr = (LAS float*)F.lds; LAS float* PWi = PWr + 33 * 64; LAS float* BBr = PWi + 33 * 64; LAS float* BBi = BBr + 1024; LAS float* CCr = BBi + 1024; LAS float* CCi = CCr + 1024; LAS float* CF = CCi + 1024;
    const int tid = F.tid;
    if (tid < 64) { const int p = tid;
        const double dt = exp((double)ldt[g]), lr = lre[g * PST + p], li = lim[g * PST + p];
        double sn, cs; sincos_d(li * dt, sn, cs); const double mag = exp(lr * dt);
        const double ar = mag * cs, ai = mag * sn, den = lr * lr + li * li, nr = ar - 1.0, ni = ai;
        CF[2 * p] = (float)((nr * lr + ni * li) / den); CF[2 * p + 1] = (float)((ni * lr - nr * li) / den);
        double pr = 1.0, pi = 0.0;
        for (int l = 0; l <= 32; ++l) { PWr[l * 64 + p] = (float)pr; PWi[l * 64 + p] = (float)pi; if (l == 32 && part == 0) { float* A32 = (float*)(a.ws + FW_A32) + (g * PST + p) * 2; A32[0] = (float)pr; A32[1] = (float)pi; }
            const double t = pr * ar - pi * ai; pi = pr * ai + pi * ar; pr = t; }
    }
    __syncthreads();
    for (int idx = tid; idx < 1024; idx += NTHR) { const int p = idx >> 4; const float cfr = CF[2 * p], cfi = CF[2 * p + 1], br = bre[(size_t)g * 1024 + idx], bi = bim[(size_t)g * 1024 + idx];
        BBr[idx] = cfr * br - cfi * bi; BBi[idx] = cfr * bi + cfi * br; CCr[idx] = cre[(size_t)g * 1024 + idx]; CCi[idx] = cim[(size_t)g * 1024 + idx]; }
    __syncthreads();
    bf16* TBg = (bf16*)(a.ws + FW_TB) + (size_t)g * 512 * U2P; bf16* W1g = (bf16*)(a.ws + FW_W1) + (size_t)g * 256 * 512;
    for (int l = part; l < 32; l += 8) {
        if (tid < 256) { const int h = tid >> 4, hp = tid & 15; float k = 0.f;
#pragma unroll 16
            for (int p = 0; p < 64; ++p) { const float wr_ = PWr[l * 64 + p], wi_ = PWi[l * 64 + p], br = BBr[p * 16 + hp], bi = BBi[p * 16 + hp];
                k += CCr[h * 64 + p] * (wr_ * br - wi_ * bi) - CCi[h * 64 + p] * (wr_ * bi + wi_ * br); }
            if (l == 0 && h == hp) k += dsk[g * 16 + h];
            const bf16 v = (bf16)f2bf(k);
            for (int i = l; i < 32; ++i) TBg[(size_t)(i * 16 + h) * U2P + (i - l) * 16 + hp] = v;
            if (l >= 1) for (int i = 0; i < 32 - l; ++i) TBg[(size_t)(i * 16 + h) * U2P + (i + l) * 16 + hp] = 0;
        } else { const int t2 = tid - 256;
#pragma unroll
            for (int x = 0; x < 8; ++x) { const int e = t2 * 8 + x;
                { const int h = e >> 7, q = e & 127, p = q & 63; const float cr = CCr[h * 64 + p], ci = CCi[h * 64 + p], wr_ = PWr[(l + 1) * 64 + p], wi_ = PWi[(l + 1) * 64 + p];
                  const float re = cr * wr_ - ci * wi_, im = cr * wi_ + ci * wr_; TBg[(size_t)(l * 16 + h) * U2P + 512 + q] = (bf16)f2bf(q < 64 ? re : -im); }
                { const int rho = e >> 4, hp = e & 15, p = rho & 63; const float wr_ = PWr[(31 - l) * 64 + p], wi_ = PWi[(31 - l) * 64 + p], br = BBr[p * 16 + hp], bi = BBi[p * 16 + hp];
                  const float re = wr_ * br - wi_ * bi, im = wr_ * bi + wi_ * br; W1g[(size_t)rho * 512 + l * 16 + hp] = (bf16)f2bf(rho < 64 ? re : im); W1g[(size_t)(128 + rho) * 512 + l * 16 + hp] = 0; }
            }
        }
    }
    __syncthreads();
}
#ifndef XNR
#define XNR 8
#endif
__device__ __forceinline__ void p0_prologue(Frame& F, const Args& a) {
    const float* x = karg<0>();
    for (int it = F.c; it < 256; it += F.G) s5_tables_item(F, a, it >> 3, it & 7);
    LAS float* scr = (LAS float*)(F.lds + F.wave * 16384);
    const int gw = F.c * NWAVES + F.wave, NGW = F.G * NWAVES;
    constexpr int I_IN = 16 * 64, I_GLU = 8 * 16, I_OUT = 16 * 32, I_GU = 32 * 16 * 32, I_D = 32 * 8 * 32, NITEMS = I_IN + I_GLU + I_OUT + I_GU + I_D;
    bf16* WIN = (bf16*)(a.ws + FW_WIN); bf16* WGLU = (bf16*)(a.ws + FW_WGLU); bf16* WOUT = (bf16*)(a.ws + FW_WOUT); bf16* WGU = (bf16*)(a.ws + FW_WGU); bf16* WD = (bf16*)(a.ws + FW_WD);
    auto mkitem = [&](int it) -> TItem {
        int r = it;
        if (r < I_IN) { const int kb = r >> 6, d = r & 63, pn = d >> 3, beta = d & 7, bj = beta >> 2, wc = beta & 3;
            return TItem{karg<2>(), DIN, 256 * pn + 32 * (2 * wc + bj), karg<1>(), WIN, PW, 32 * d, 64 * kb, 0}; } r -= I_IN;
        if (r < I_GLU) { const int kb = r >> 4, d = r & 15; return TItem{karg<11>(), DSSM, 32 * d, nullptr, WGLU, DSSM, 32 * d, 64 * kb, 0}; } r -= I_GLU;
        if (r < I_OUT) { const int kb = r >> 5, d = r & 31; const float* ks = (kb < 8) ? karg<15>() : (karg<16>() - 512);
            return TItem{karg<17>(), DM, 32 * (8 * (d >> 3) + 2 * (d & 3) + ((d & 7) >> 2)), ks, WOUT, PW, 32 * d, 64 * kb, 0}; } r -= I_OUT;
        if (r < I_GU) { const int e = r >> 9, q = r & 511, kb = q >> 5, d = q & 31, pn = d >> 3, beta = d & 7;
            const float* W = (beta < 4 ? karg<23>() : karg<24>()) + (size_t)e * DM * DE;
            return TItem{W, DE, 128 * pn + 32 * (beta & 3), karg<18>(), (bf16*)((unsigned char*)WGU + (size_t)e * DM * DM), DM, 32 * d, 64 * kb, 1}; } r -= I_GU;
        const int e = r >> 8, q = r & 255, kb = q >> 5, d = q & 31;
        return TItem{karg<25>() + (size_t)e * DE * DM, DM, 32 * (8 * (d >> 3) + 2 * (d & 3) + ((d & 7) >> 2)), nullptr, (bf16*)((unsigned char*)WD + (size_t)e * DM * DE), DE, 32 * d, 64 * kb, 1};
    };
    const int nitems = (F.G == 256) ? (I_IN + I_GLU + I_OUT) : NITEMS;
    if (gw < nitems) {
        TItem cur = mkitem(gw); f32x4 vc[8]; titem_load(cur, F.lane, vc);
        for (int it = gw; it < nitems; it += NGW) {
            const bool more = it + NGW < nitems; TItem nxt = cur; f32x4 vn[8];
            if (more) { nxt = mkitem(it + NGW); titem_load(nxt, F.lane, vn); }
            titem_store(cur, F.lane, vc, scr);
            if (more) { cur = nxt;
#pragma unroll
                for (int i = 0; i < 8; ++i) vc[i] = vn[i]; }
        }
    }
    { bf16* WR = (bf16*)(a.ws + FW_WR);
      for (int idx = F.c * NTHR + F.tid; idx < 64 * DM; idx += F.G * NTHR) { const int n = idx >> 10, k = idx & 1023;
          float v = 0.f; if (n < 4) v = karg<19>()[k * 4 + n]; else if (n < 36) v = karg<21>()[k * 32 + (n - 4)];
          WR[idx] = (bf16)f2bf(v * karg<18>()[k]); } }
    bf16* XN = (bf16*)(a.ws + FW_XN); float* RSTDX = (float*)(a.ws + FW_RSTDX);
    for (int m0 = gw * XNR; m0 < M; m0 += NGW * XNR) {
        f32x4 v[XNR][4];
#pragma unroll
        for (int rr = 0; rr < XNR; ++rr) { const GAS f32x4* xr = (const GAS f32x4*)(x + (size_t)(m0 + rr) * DM);
            v[rr][0] = __builtin_nontemporal_load(xr + 2 * F.lane); v[rr][1] = __builtin_nontemporal_load(xr + 2 * F.lane + 1);
            v[rr][2] = __builtin_nontemporal_load(xr + 128 + 2 * F.lane); v[rr][3] = __builtin_nontemporal_load(xr + 128 + 2 * F.lane + 1); }
#pragma unroll
        for (int rr = 0; rr < XNR; ++rr) { float s = 0.f;
#pragma unroll
            for (int j = 0; j < 4; ++j) s += v[rr][j].x * v[rr][j].x + v[rr][j].y * v[rr][j].y + v[rr][j].z * v[rr][j].z + v[rr][j].w * v[rr][j].w;
            const float rstd = __builtin_amdgcn_rsqf(wave_sum(s) * (1.f / DM) + EPS);
            if (F.lane == 0) RSTDX[m0 + rr] = rstd;
            u32x4* o = (u32x4*)(XN + (size_t)(m0 + rr) * PX);
#pragma unroll
            for (int j = 0; j < 2; ++j) { const f32x4 a = v[rr][2 * j] * rstd, b = v[rr][2 * j + 1] * rstd; u32x4 w; w.x = cvtpk(a.x, a.y); w.y = cvtpk(a.z, a.w); w.z = cvtpk(b.x, b.y); w.w = cvtpk(b.z, b.w); st_s<3>(o + 64 * j + F.lane, w); } }
    }
}

__device__ __forceinline__ void s5_scan_local(Frame& F, const Args& a, int g, int pm) {
    const float* SST = (const float*)(a.ws + FW_SST); bf16* U2 = (bf16*)(a.ws + FW_U2);
    if (F.tid < 256) {
        const int p = F.tid & 63;
        const float* A32 = (const float*)(a.ws + FW_A32) + (g * PST + p) * 2; const float ar = A32[0], ai = A32[1];
        float xr = 0.f, xi = 0.f;
        const size_t row0 = (size_t)g * NCH + (size_t)pm * 256 + (size_t)(F.tid >> 6) * 64;
        for (int c0 = 0; c0 < 64; c0 += 16) {
            float sr[16], si[16];
#pragma unroll
            for (int j = 0; j < 16; ++j) { sr[j] = SST[(row0 + c0 + j) * 128 + p]; si[j] = SST[(row0 + c0 + j) * 128 + 64 + p]; }
#pragma unroll
            for (int j = 0; j < 16; ++j) { bf16* up = U2 + (row0 + c0 + j) * U2P + 512; up[p] = (bf16)f2bf(xr); up[64 + p] = (bf16)f2bf(xi);
                const float t = ar * xr - ai * xi + sr[j]; xi = ar * xi + ai * xr + si[j]; xr = t; }
        }
    }
}
__device__ __forceinline__ void s5_scan(Frame& F, const Args& a) {
    const float* SST = (const float*)(a.ws + FW_SST); bf16* U2 = (bf16*)(a.ws + FW_U2);
    for (int idx = F.c * NTHR + F.tid; idx < BATCH * NG * PST; idx += F.G * NTHR) {
        const int p = idx & 63, g = (idx >> 6) & 31, b = idx >> 11;
        const double dt = exp((double)karg<5>()[g]), lr = karg<3>()[g * PST + p], li = karg<4>()[g * PST + p];
        double sn, cs; sincos_d(32.0 * li * dt, sn, cs); const double mag = exp(32.0 * lr * dt);
        const float ar = (float)(mag * cs), ai = (float)(mag * sn);
        float xr = 0.f, xi = 0.f;
        const size_t row0 = (size_t)g * NCH + (size_t)b * 64;
        for (int c0 = 0; c0 < 64; c0 += 16) {
            float sr[16], si[16];
#pragma unroll
            for (int j = 0; j < 16; ++j) { sr[j] = SST[(row0 + c0 + j) * 128 + p]; si[j] = SST[(row0 + c0 + j) * 128 + 64 + p]; }
#pragma unroll
            for (int j = 0; j < 16; ++j) { bf16* up = U2 + (row0 + c0 + j) * U2P + 512; up[p] = (bf16)f2bf(xr); up[64 + p] = (bf16)f2bf(xi);
                const float t = ar * xr - ai * xi + sr[j]; xi = ar * xi + ai * xr + si[j]; xr = t; }
        }
    }
}

#ifndef ATT_THR_V
#define ATT_THR_V -32.f
#endif
constexpr float ATT_THR = ATT_THR_V;
__device__ __forceinline__ s16x4 vtr(const LAS unsigned char* p) { typedef short v4i16_t __attribute__((ext_vector_type(4))); return __builtin_bit_cast(s16x4, __builtin_amdgcn_ds_read_tr16_b64_v4i16((LAS v4i16_t*)p)); }
__device__ __forceinline__ int crow(int r, int hi) { return (r & 3) + 8 * (r >> 2) + 4 * hi; }
#define MFMA32(a, b, c) __builtin_amdgcn_mfma_f32_32x32x16_bf16((a), (b), (c), 0, 0, 0)
template <bool DIAG, int P, int KH, int KD, int VD>
__device__ __forceinline__ float attn_half(const LAS unsigned char* Kb, const LAS unsigned char* Vb, const bf16x8 (&qr)[4], const bf16x8 (&tri)[2], f32x16 (&o)[2], float base, int lim, int lane) {
    const int r32 = lane & 31, hi = lane >> 5;
    const LAS unsigned char* kp = Kb + hi * KH + r32 * 16 + P * 512;
    const int lim2 = lim - 4 * hi;
    f32x16 z = {};
#pragma unroll
    for (int d0 = 0; d0 < 4; ++d0) { const bf16x8 kf = *(const LAS bf16x8*)(kp + d0 * KD); z = MFMA32(kf, qr[d0], z); }
    float l[16];
#pragma unroll
    for (int r = 0; r < 16; ++r) { l[r] = -__builtin_amdgcn_logf(1.f + __builtin_amdgcn_exp2f(z[r])); if (DIAG) { if (!((r & 3) + 8 * (r >> 2) + 32 * P < lim2)) l[r] = 0.f; } }
    u32x4 wa, wb;
    wa.x = cvtpk(l[0], l[1]); wa.y = cvtpk(l[2], l[3]); wa.z = cvtpk(l[4], l[5]); wa.w = cvtpk(l[6], l[7]);
    wb.x = cvtpk(l[8], l[9]); wb.y = cvtpk(l[10], l[11]); wb.z = cvtpk(l[12], l[13]); wb.w = cvtpk(l[14], l[15]);
    const bf16x8 La = __builtin_bit_cast(bf16x8, wa), Lb = __builtin_bit_cast(bf16x8, wb);
    f32x16 T = {};
    T = MFMA32(tri[0], La, T); T = MFMA32(tri[1], Lb, T);
    float av[16];
#pragma unroll
    for (int r = 0; r < 16; ++r) { av[r] = __builtin_amdgcn_exp2f((z[r] + base) + T[r]); if (DIAG) { if (!((r & 3) + 8 * (r >> 2) + 32 * P < lim2)) av[r] = 0.f; } }
    wa.x = cvtpk(av[0], av[1]); wa.y = cvtpk(av[2], av[3]); wa.z = cvtpk(av[4], av[5]); wa.w = cvtpk(av[6], av[7]);
    wb.x = cvtpk(av[8], av[9]); wb.y = cvtpk(av[10], av[11]); wb.z = cvtpk(av[12], av[13]); wb.w = cvtpk(av[14], av[15]);
    const bf16x8 Pa = __builtin_bit_cast(bf16x8, wa), Pb = __builtin_bit_cast(bf16x8, wb);
    const LAS unsigned char* vp = Vb + ((lane >> 4) & 1) * 32 + (lane & 3) * 8 + (4 * hi + ((lane & 15) >> 2)) * 64 + P * 2048;
#pragma unroll
    for (int d0 = 0; d0 < 2; ++d0) {
        const s16x4 lo0 = vtr(vp + d0 * VD), hi0 = vtr(vp + d0 * VD + 512), lo1 = vtr(vp + d0 * VD + 1024), hi1 = vtr(vp + d0 * VD + 1536);
        const bf16x8 v0 = {lo0[0], lo0[1], lo0[2], lo0[3], hi0[0], hi0[1], hi0[2], hi0[3]}, v1 = {lo1[0], lo1[1], lo1[2], lo1[3], hi1[0], hi1[1], hi1[2], hi1[3]};
        o[d0] = MFMA32(Pa, v0, o[d0]); o[d0] = MFMA32(Pb, v1, o[d0]);
    }
    { const unsigned u = __builtin_bit_cast(unsigned, T[0]); auto r = __builtin_amdgcn_permlane32_swap(u, u, false, false); return __builtin_bit_cast(float, (unsigned)r[0]); }
}
#ifndef ASPAN_N
#define ASPAN_N 13
#endif
constexpr int ASPAN = ASPAN_N;
__device__ __forceinline__ void attn_span_phase(Frame& F, const bf16* Q, const bf16* Kg, const bf16* Vg, bf16* MIX, float* SSQA) {
    const int lane = F.lane, wid = F.wave, r32 = lane & 31, hi = lane >> 5;
    volatile LAS int* FLG = (volatile LAS int*)(F.lds + ASPAN * 8192 + 8 * 4096);
    bf16x8 tri[2];
#pragma unroll
    for (int s = 0; s < 2; ++s)
#pragma unroll
        for (int j = 0; j < 8; ++j) tri[s][j] = ((16 * s + 8 * (j >> 2) + 4 * hi + (j & 3)) >= r32) ? (short)0x3F80 : (short)0;
    const int dsto = (wid < 4) ? wid * 1024 : 4096 + (wid - 4) * 1024;
    auto tile_src = [&](int b_, int h_) -> const bf16* { const size_t r0 = (size_t)b_ * SEQ;
        return (wid < 4) ? (Kg + (r0 + (lane & 31)) * DATT + h_ * HD + (lane >> 5) * 8 + 16 * wid) : (Vg + (r0 + 16 * (wid & 1) + (lane >> 2)) * DATT + h_ * HD + (lane & 3) * 8 + 32 * ((wid - 4) >> 1)); };
    auto issue0 = [&](int L_, bf16x8 (&q_)[4]) { const int bh_ = L_ >> 3, qb_ = L_ & 7, b_ = bh_ >> 3, h_ = bh_ & 7, a0_ = 8 * qb_; const size_t r0 = (size_t)b_ * SEQ;
#pragma unroll
        for (int d0 = 0; d0 < 4; ++d0) q_[d0] = *(const bf16x8*)(Q + (r0 + 32 * (a0_ + wid) + r32) * DATT + h_ * HD + d0 * 16 + hi * 8);
        const bf16* src_ = tile_src(b_, h_); const int top_ = a0_ + 7, bot_ = (top_ - (ASPAN - 1) > 0) ? top_ - (ASPAN - 1) : 0;
#pragma unroll 1
        for (int jj = top_; jj >= bot_; --jj)
            __builtin_amdgcn_global_load_lds((const unsigned*)(src_ + (size_t)(32 * jj) * DATT), (LAS unsigned*)(F.lds + (top_ - jj) * 8192 + dsto), 16, 0, 0); };
    bf16x8 qr[4];
    if (F.c < BATCH * NH * 8) issue0(F.c, qr);
    for (int L = F.c; L < BATCH * NH * 8; L += F.G) {
        const int bh = L >> 3, qb = L & 7, b = bh >> 3, h = bh & 7, a0 = 8 * qb, a = a0 + wid;
        const size_t row0 = (size_t)b * SEQ; const int qg = 32 * a + r32;
        const bf16* src = tile_src(b, h);
        f32x16 o[2] = {}; float Rc = 0.f; bool done = false;
        for (int k = 0;; ++k) {
            const int top = a0 + 7 - ASPAN * k, bot = (top - (ASPAN - 1) > 0) ? top - (ASPAN - 1) : 0;
            if (k > 0) {
#pragma unroll 1
                for (int jj = top; jj >= bot; --jj)
                    __builtin_amdgcn_global_load_lds((const unsigned*)(src + (size_t)(32 * jj) * DATT), (LAS unsigned*)(F.lds + (top - jj) * 8192 + dsto), 16, 0, 0); }
            asm volatile("s_waitcnt vmcnt(0)" ::: "memory");
            __syncthreads();
            if (!done) {
                for (int jj = (a < top ? a : top); jj >= bot; --jj) {
                    const LAS unsigned char* Kb = F.lds + (top - jj) * 8192; const LAS unsigned char* Vb = Kb + 4096;
                    const int lim = qg - 32 * jj;
                    float sh;
                    if (jj == a) sh = attn_half<true, 0, 512, 1024, 2048>(Kb, Vb, qr, tri, o, Rc, lim, lane);
                    else sh = attn_half<false, 0, 512, 1024, 2048>(Kb, Vb, qr, tri, o, Rc, lim, lane);
                    Rc += sh;
                    if (jj == 0 || __all(Rc < ATT_THR)) { done = true; break; }
                }
            }
            if (lane == 0) FLG[wid] = done ? 1 : 0;
            asm volatile("s_waitcnt lgkmcnt(0)" ::: "memory");
            __syncthreads();
            if (bot == 0) break;
            int alld = 1;
#pragma unroll
            for (int w = 0; w < 8; ++w) alld &= FLG[w];
            if (alld) break;
        }
        bf16x8 qn[4]; const bool more = L + F.G < BATCH * NH * 8;
        if (more) issue0(L + F.G, qn);
        { LAS unsigned char* stg = F.lds + ASPAN * 8192 + wid * 4096; LAS unsigned short* sp = (LAS unsigned short*)(stg + hi * 512 + r32 * 2);
#pragma unroll
          for (int r = 0; r < 16; ++r) { const int ro = ((r & 3) + 8 * (r >> 2)) * 64; sp[ro] = (unsigned short)f2bf(o[0][r]); sp[ro + 32] = (unsigned short)f2bf(o[1][r]); }
          asm volatile("s_waitcnt lgkmcnt(0)" ::: "memory");
          bf16* ow = MIX + (row0 + 32 * a) * PX + 512 + h * HD;
#pragma unroll
          for (int i = 0; i < 4; ++i) { const int row = i * 8 + (lane >> 3), ch = lane & 7; const u32x4 v = *(const LAS u32x4*)(stg + row * 128 + ch * 16); st_s<2>((u32x4*)(ow + (size_t)row * PX + ch * 8), v);
              const float f0 = bf2f(v.x & 0xffff), f1 = bf2f(v.x >> 16), f2 = bf2f(v.y & 0xffff), f3 = bf2f(v.y >> 16), f4 = bf2f(v.z & 0xffff), f5 = bf2f(v.z >> 16), f6 = bf2f(v.w & 0xffff), f7 = bf2f(v.w >> 16);
              float ss = ((f0 * f0 + f1 * f1) + (f2 * f2 + f3 * f3)) + ((f4 * f4 + f5 * f5) + (f6 * f6 + f7 * f7));
              ss += dppf<0xB1>(ss); ss += dppf<0x4E>(ss); ss += dppf<0x141>(ss);
              if (ch == 0) SSQA[(row0 + 32 * a + row) * 8 + h] = ss; }
          asm volatile("s_waitcnt lgkmcnt(0)" ::: "memory"); }
        if (more) {
#pragma unroll
            for (int d0 = 0; d0 < 4; ++d0) qr[d0] = qn[d0]; }
    }
    asm volatile("s_waitcnt vmcnt(0)" ::: "memory");
    __syncthreads();
}
static_assert(ASPAN * 8192 + 8 * 4096 + 64 <= MISC_OFF, "attention LDS map");

constexpr int RT_PITCH = 2064;
__device__ __forceinline__ void router_phase(Frame& F, const Args& a) {
    const bf16* X1B = (const bf16*)(a.ws + FW_X1B); unsigned char* X1Q = (unsigned char*)(a.ws + FW_X1Q); int* TOK = (int*)(a.ws + FW_TOK); const bf16* WR = (const bf16*)(a.ws + FW_WR);
    const float* brg = karg<20>(); const float* bre_ = karg<22>();
    const int tid = F.tid, lane = F.lane, wid = F.wave, r32 = lane & 31, hi = lane >> 5;
    LAS unsigned char* TILE = F.lds;
    LAS float* PART = (LAS float*)(F.lds + 66048);
    LAS float* LOGIT = (LAS float*)(F.lds + 66048 + 65536);
    LAS int* HIST = (LAS int*)(F.lds + 66048 + 65536 + 5120);
    LAS int* TREC = HIST + 64;
    LAS float* RS = (LAS float*)(TREC + 1024);
    LAS float* TRS = RS + 32;
    LAS float* TRG = TRS + 256;
    LAS float* BIAS = TRG + 512;
    static_assert(66048 + 65536 + 5120 + 256 + 4096 + 128 + 1024 + 2048 + 160 <= MISC_OFF, "router LDS");
    bf16x8 Bf[8][2];
#pragma unroll
    for (int s = 0; s < 8; ++s)
#pragma unroll
        for (int nb = 0; nb < 2; ++nb) Bf[s][nb] = *(const bf16x8*)(WR + (size_t)(32 * nb + r32) * DM + 128 * wid + 16 * s + 8 * hi);
    if (tid < 64) HIST[tid] = 0;
    if (tid >= 64 && tid < 104) { const int c = tid - 64; BIAS[c] = c < 4 ? brg[c] : (c < 36 ? bre_[c - 4] : 0.f); }
    __syncthreads();
    int ntl = 0;
#define RT_BAR() do { asm volatile("s_waitcnt lgkmcnt(0)" ::: "memory"); __builtin_amdgcn_s_barrier(); asm volatile("" ::: "memory"); } while (0)
#define RT_LOAD(tile_) do { _Pragma("unroll") for (int rr = 0; rr < 4; ++rr) { const u32x4* xr = (const u32x4*)(X1B + (size_t)((tile_) * 32 + 4 * wid + rr) * PX); v[rr][0] = xr[lane]; v[rr][1] = xr[64 + lane]; } } while (0)
    u32x4 v[4][2];
    if (F.c < M / 32) RT_LOAD(F.c);
    for (int tile = F.c; tile < M / 32; tile += F.G, ++ntl) {
        {
#pragma unroll
          for (int rr = 0; rr < 4; ++rr) { const int lr = 4 * wid + rr; float s = 0.f;
#pragma unroll
              for (int j = 0; j < 2; ++j) { const u32x4 w = v[rr][j];
                  const float f0 = bf2f(w.x & 0xffff), f1 = bf2f(w.x >> 16), f2 = bf2f(w.y & 0xffff), f3 = bf2f(w.y >> 16), f4 = bf2f(w.z & 0xffff), f5 = bf2f(w.z >> 16), f6 = bf2f(w.w & 0xffff), f7 = bf2f(w.w >> 16);
                  s += (f0 * f0 + f1 * f1) + (f2 * f2 + f3 * f3) + (f4 * f4 + f5 * f5) + (f6 * f6 + f7 * f7);
                  { u32x2 q8; q8.x = pk4_fp8(f0, f1, f2, f3); q8.y = pk4_fp8(f4, f5, f6, f7); st_s<8>((u32x2*)(X1Q + (size_t)(tile * 32 + lr) * DM + (64 * j + lane) * 8), q8); }
                  *(LAS u32x4*)(TILE + lr * RT_PITCH + (64 * j + lane) * 16) = w; }
              const float rstd = __builtin_amdgcn_rsqf(wave_sum(s) * (1.f / DM) + EPS);
              if (lane == 0) RS[lr] = rstd; } }
        if (tile + F.G < M / 32) RT_LOAD(tile + F.G);
        RT_BAR();
        { f32x16 c0 = {}, c1 = {};
#pragma unroll
          for (int s = 0; s < 8; ++s) { const bf16x8 af = *(const LAS bf16x8*)(TILE + r32 * RT_PITCH + (128 * wid + 16 * s + 8 * hi) * 2);
              c0 = MFMA32(af, Bf[s][0], c0); c1 = MFMA32(af, Bf[s][1], c1); }
#pragma unroll
          for (int r = 0; r < 16; ++r) { const int t = crow(r, hi); PART[(wid * 32 + t) * 64 + r32] = c0[r]; PART[(wid * 32 + t) * 64 + 32 + r32] = c1[r]; } }
        RT_BAR();
        { const int t = tid >> 4, c4 = (tid & 15) * 4;
          if (c4 < 40) { f32x4 s = {0.f, 0.f, 0.f, 0.f};
#pragma unroll
              for (int w = 0; w < 8; ++w) s += *(const LAS f32x4*)(PART + (w * 32 + t) * 64 + c4);
              *(LAS f32x4*)(LOGIT + t * 40 + c4) = s * RS[t] + *(const LAS f32x4*)(BIAS + c4); } }
        RT_BAR();
        if (tid < 32) { const int m = tile * 32 + tid; float lg[36];
#pragma unroll
            for (int c = 0; c < 36; ++c) lg[c] = LOGIT[tid * 40 + c];
            int gi = 0; float gm = lg[0];
#pragma unroll
            for (int c = 1; c < 4; ++c) if (lg[c] > gm) { gm = lg[c]; gi = c; }
            float gsum = 0.f;
#pragma unroll
            for (int c = 0; c < 4; ++c) gsum += __expf(lg[c] - gm);
            const float pgrp = 1.f / gsum;
            float el[8];
#pragma unroll
            for (int e = 0; e < 8; ++e) { float t = 0.f;
#pragma unroll
                for (int g2 = 0; g2 < 4; ++g2) if (g2 == gi) t = lg[4 + g2 * 8 + e];
                el[e] = t; }
            int i0 = 0; float m0 = el[0];
#pragma unroll
            for (int e = 1; e < 8; ++e) if (el[e] > m0) { m0 = el[e]; i0 = e; }
            int i1 = 0; float m1 = -3.0e38f;
#pragma unroll
            for (int e = 0; e < 8; ++e) if (e != i0 && el[e] > m1) { m1 = el[e]; i1 = e; }
            const float e1 = __expf(m1 - m0), p0 = 1.f / (1.f + e1), p1 = e1 / (1.f + e1);
            const int ex0 = gi * 8 + i0, ex1 = gi * 8 + i1;
            const int rk0 = atomicAdd((int*)&HIST[ex0], 1), rk1 = atomicAdd((int*)&HIST[ex1], 1);
            int* tk = TOK + (size_t)m * 8; tk[0] = ex0; tk[1] = ex1; tk[2] = __float_as_int(pgrp * p0); tk[3] = __float_as_int(pgrp * p1);
            LAS int* tr = TREC + (ntl * 32 + tid) * 4; tr[0] = ex0; tr[1] = ex1; tr[2] = rk0; tr[3] = rk1;
            TRS[ntl * 32 + tid] = RS[tid]; TRG[2 * (ntl * 32 + tid)] = pgrp * p0; TRG[2 * (ntl * 32 + tid) + 1] = pgrp * p1;
        }
        RT_BAR();
    }
#undef RT_BAR
#undef RT_LOAD
    if (tid < 32) { const int cnt = HIST[tid]; int base = 0; if (cnt > 0) base = (int)__hip_atomic_fetch_add(F.ctl + CW_CNT + tid, (unsigned)cnt, RLX_AGENT); HIST[32 + tid] = base; }
    __syncthreads();
    unsigned* ETOK = (unsigned*)(a.ws + FW_ETOK); float* EG = (float*)(a.ws + FW_EG);
    for (int i = tid; i < ntl * 32; i += NTHR) { const int tile = F.c + (i >> 5) * F.G, m = tile * 32 + (i & 31); const LAS int* tr = TREC + i * 4;
        int* tk = TOK + (size_t)m * 8; const int s0 = HIST[32 + tr[0]] + tr[2], s1 = HIST[32 + tr[1]] + tr[3]; tk[4] = s0; tk[5] = s1;
        const unsigned word = (unsigned)m | (f2bf(TRS[i]) << 16);
        ETOK[(size_t)tr[0] * M + s0] = word; ETOK[(size_t)tr[1] * M + s1] = word; EG[(size_t)tr[0] * M + s0] = TRG[2 * i]; EG[(size_t)tr[1] * M + s1] = TRG[2 * i + 1]; }
    __syncthreads();
}
__device__ __forceinline__ int moe_tables(Frame& F) {
    LAS int* TST = (LAS int*)(F.lds + SCR2_OFF); LAS unsigned char* T2E = F.lds + SCR2_OFF + 256;
    if (F.tid < 64) {
        const int e = F.tid; int nt = 0;
        if (e < NE) { const int cnt = (int)__hip_atomic_load(F.ctl + CW_CNT + e, RLX_AGENT); nt = (cnt + 255) >> 8; TST[208 + e] = cnt; }
        int incl = nt;
#pragma unroll
        for (int o = 1; o < 32; o <<= 1) { const int v = __shfl_up(incl, o); if ((e & 31) >= o) incl += v; }
        const int start = incl - nt;
        if (e < NE) { TST[e] = start; for (int t = 0; t < nt; ++t) T2E[start + t] = (unsigned char)e; }
        if (e == NE - 1) TST[NE] = incl;
    }
    __syncthreads();
    return TST[NE];
}
#ifndef CTPT
#define CTPT 4
#endif
__device__ __forceinline__ void combine_phase(Frame& F, const Args& a) {
    const unsigned char* YE = (const unsigned char*)(a.ws + FW_YE); const bf16* X1B = (const bf16*)(a.ws + FW_X1B); const int* TOK = (const int*)(a.ws + FW_TOK); float* out = a.out;
    const LAS int* TST = (const LAS int*)(F.lds + SCR2_OFF);
    const int gw = F.c * NWAVES + F.wave, NGW = F.G * NWAVES, lane = F.lane;
    static_assert(CTPT * 8 <= 64, "one routing word per lane");
    int m0 = gw * CTPT;
    int w = 0; if (m0 < M) w = TOK[(size_t)m0 * 8 + (lane & (CTPT * 8 - 1))];
    for (; m0 < M; m0 += NGW * CTPT) {
        const int mn = m0 + NGW * CTPT;
        int wn = 0; if (mn < M) wn = TOK[(size_t)mn * 8 + (lane & (CTPT * 8 - 1))];
        const int tl = TST[w & 31];
        u32x2 xv[CTPT][4]; unsigned y0[CTPT][4], y1[CTPT][4];
#pragma unroll
        for (int t = 0; t < CTPT; ++t) {
            const size_t p0 = (size_t)__builtin_amdgcn_readlane(tl, 8 * t) * 256 + (size_t)__builtin_amdgcn_readlane(w, 8 * t + 4), p1 = (size_t)__builtin_amdgcn_readlane(tl, 8 * t + 1) * 256 + (size_t)__builtin_amdgcn_readlane(w, 8 * t + 5);
            const bf16* xr = X1B + (size_t)(m0 + t) * PX + 4 * lane; const unsigned* ya = (const unsigned*)(YE + p0 * DM) + lane; const unsigned* yb = (const unsigned*)(YE + p1 * DM) + lane;
#pragma unroll
            for (int q = 0; q < 4; ++q) {
#ifdef NT_COMBINE
                xv[t][q] = __builtin_nontemporal_load((const u32x2*)(xr + 256 * q)); y0[t][q] = __builtin_nontemporal_load(ya + 64 * q); y1[t][q] = __builtin_nontemporal_load(yb + 64 * q); } }
#else
                xv[t][q] = *(const u32x2*)(xr + 256 * q); y0[t][q] = ya[64 * q]; y1[t][q] = yb[64 * q]; } }
#endif
#pragma unroll
        for (int t = 0; t < CTPT; ++t) { float* o = out + (size_t)(m0 + t) * DM + 4 * lane;
#pragma unroll
            for (int q = 0; q < 4; ++q) { const unsigned wa = y0[t][q], wb = y1[t][q]; const unsigned xa = xv[t][q].x, xb = xv[t][q].y;
                const f32x2 a0 = __builtin_amdgcn_cvt_pk_f32_fp8((int)wa, false), a1 = __builtin_amdgcn_cvt_pk_f32_fp8((int)wa, true), b0 = __builtin_amdgcn_cvt_pk_f32_fp8((int)wb, false), b1 = __builtin_amdgcn_cvt_pk_f32_fp8((int)wb, true);
                f32x4 r; r.x = bf2f(xa & 0xffff) + (a0.x + b0.x) * (1.f / YE_SCALE); r.y = bf2f(xa >> 16) + (a0.y + b0.y) * (1.f / YE_SCALE);
                r.z = bf2f(xb & 0xffff) + (a1.x + b1.x) * (1.f / YE_SCALE); r.w = bf2f(xb >> 16) + (a1.y + b1.y) * (1.f / YE_SCALE);
                *(f32x4*)(o + 256 * q) = r; } }
        w = wn;
    }
}

#ifndef STG1
#define STG1 0
#endif
#ifndef STG10
#define STG10 0
#endif
#ifndef STG11
#define STG11 0
#endif
#ifndef KREP1
#define KREP1 1
#endif
#ifndef KREP10
#define KREP10 1
#endif
#ifndef KREP11
#define KREP11 1
#endif
constexpr int NPHASE = 13;
__global__ void __launch_bounds__(NTHR, 2) mk_fwd(Args args) {
    extern __shared__ __attribute__((aligned(16))) unsigned char lds_raw[];
    Frame F;
    F.lds = (LAS unsigned char*)lds_raw; F.MISC = (volatile LAS unsigned*)(F.lds + MISC_OFF);
    F.tid = threadIdx.x; F.lane = F.tid & 63; F.wave = __builtin_amdgcn_readfirstlane(F.tid >> 6);
    F.G = gridDim.x; F.c = blockIdx.x; F.ctl = (unsigned*)(args.ws + WS_CTL);
    if (F.tid < 64) F.MISC[F.tid] = 0u;
    __syncthreads();
    XcdBarrier bar = xcd_barrier_post(F.ctl + CW_BAR, F.MISC + 8);
    const int lo = args.ph_lo, hi = args.ph_hi;
    unsigned char* ws = args.ws;
#ifndef PH_MASK
#define PH_MASK 0x1fff
#endif
#define IN(k) ((((PH_MASK) >> (k)) & 1) && lo <= (k) && (k) < hi)
#define SEAM(k) do { if (IN(k) && IN((k) + 1)) xcd_barrier(bar); } while (0)
#define REFRESH() do { int t_ = threadIdx.x; asm volatile("" : "+v"(t_)); F.tid = t_; F.lane = t_ & 63; F.wave = __builtin_amdgcn_readfirstlane(t_ >> 6); } while (0)
#ifndef REP_MASK
#define REP_MASK 0
#endif
#define REPS(k) _Pragma("unroll") for (int rep_ = 0; rep_ < ((((REP_MASK) >> (k)) & 1) ? 2 : 1); ++rep_)
    if (IN(0)) REPS(0) { REFRESH(); p0_prologue(F, args); } SEAM(0);
    if (IN(1)) REPS(1) { REFRESH();
        GemmP g{PX * 2, PW * 2, DM}; DenseOrder S{(const char*)(ws + FW_XN), (const char*)(ws + FW_WIN), (size_t)256 * PX * 2, (size_t)256 * PW * 2, M / 256, DIN / 256, (M / 256) * (DIN / 256), F.G, F.c};
        LAS float* GQK = (LAS float*)(F.lds + SCR2_OFF); if (F.tid < 128) GQK[F.tid] = (F.tid < 64) ? karg<13>()[F.tid] * C2 : karg<14>()[F.tid - 64];
        { LAS float* GF = (LAS float*)(F.lds + GF_OFF); GF[F.tid] = W8SC * karg<18>()[F.tid]; GF[F.tid + 512] = W8SC * karg<18>()[F.tid + 512]; } __syncthreads();
        EpiProj E{(bf16*)(ws + FW_U2), (bf16*)(ws + FW_Q), (const LAS float*)GQK, (F.G == 256) ? F.c * NWAVES : -1, ws};
        gemm_phase<EpiProj, DenseOrder, false, KREP1>(F.lds, g, S, E, nullptr, ((F.c >> 3) & 7) * STG1); } SEAM(1);
    if (IN(2)) REPS(2) { REFRESH();
        GemmP g{U2P * 2, 512 * 2, 512}; GroupOrder S{(const char*)(ws + FW_U2), (const char*)(ws + FW_W1), (size_t)NCH * U2P * 2, (size_t)256 * 512 * 2, (size_t)256 * U2P * 2, 0, NCH / 256, 1, NG * (NCH / 256), F.G, F.c};
        EpiState E{(float*)(ws + FW_SST)};
        gemm_phase(F.lds, g, S, E);
        if (F.G == NG * (NCH / 256)) s5_scan_local(F, args, F.c >> 3, F.c & 7); }
    if (F.G != NG * (NCH / 256)) SEAM(2);
    if (IN(3)) REPS(3) { REFRESH();
#ifndef NO_SCAN
        if (F.G != NG * (NCH / 256)) s5_scan(F, args);
#ifdef REP_SCAN
        s5_scan(F, args);
#endif
#endif
#ifndef NO_ATTN
        const bf16* Q = (const bf16*)(ws + FW_Q); const bf16* Kg = (const bf16*)(ws + FW_K); const bf16* Vg = (const bf16*)(ws + FW_V);
        attn_span_phase(F, Q, Kg, Vg, (bf16*)(ws + FW_MIX), (float*)(ws + FW_SSQAP));
#endif
    } SEAM(3);
    if (IN(4)) REPS(4) { REFRESH();
        GemmP g{U2P * 2, U2P * 2, U2P}; EpiS5 E{(bf16*)(ws + FW_Z)};
        if (F.G == 256) { S5MainOrder S{(const char*)(ws + FW_U2), (const char*)(ws + FW_TB), (size_t)NCH * U2P * 2, (size_t)512 * U2P * 2, (size_t)256 * U2P * 2, (size_t)256 * U2P * 2, F.c}; gemm_phase(F.lds, g, S, E); }
        else { GroupOrder S{(const char*)(ws + FW_U2), (const char*)(ws + FW_TB), (size_t)NCH * U2P * 2, (size_t)512 * U2P * 2, (size_t)256 * U2P * 2, (size_t)256 * U2P * 2, NCH / 256, 2, NG * (NCH / 256) * 2, F.G, F.c}; gemm_phase(F.lds, g, S, E); } } SEAM(4);
    if (IN(5)) REPS(5) { REFRESH();
        GemmP g{Z_PLANES ? 32 : DSSM * 2, DSSM * 2, DSSM, Z_PLANES ? 4 * M * 32 : 0, Z_PLANES ? M * 32 : 0};
        DenseOrder S{(const char*)(ws + FW_Z), (const char*)(ws + FW_WGLU), Z_PLANES ? (size_t)256 * 32 : (size_t)256 * DSSM * 2, (size_t)256 * DSSM * 2, M / 256, 2, (M / 256) * 2, F.G, F.c};
        EpiGlu E{(const bf16*)(ws + FW_Z), karg<12>(), (bf16*)(ws + FW_MIX), (float*)(ws + FW_SSQP)};
        gemm_phase(F.lds, g, S, E); } if (IN(5) && IN(7)) xcd_barrier(bar);
    if (IN(7)) REPS(7) { REFRESH();
        GemmP g{PX * 2, PW * 2, DM}; DenseOrder S{(const char*)(ws + FW_MIX), (const char*)(ws + FW_WOUT), (size_t)256 * PX * 2, (size_t)256 * PW * 2, M / 256, 4, (M / 256) * 4, F.G, F.c};
        EpiX1B E{(F.G == 256) ? F.c * NWAVES + 2048 * 8 : -1, ws, (const float*)(ws + FW_RSTDX), (bf16*)(ws + FW_X1B), (const float*)(ws + FW_SSQP), (const float*)(ws + FW_SSQAP), (LAS float*)(F.lds + SCR2_OFF + 1024)};
        { LAS float* GF = (LAS float*)(F.lds + GF_OFF); GF[F.tid] = W8SC * karg<18>()[F.tid]; GF[F.tid + 512] = W8SC * karg<18>()[F.tid + 512]; }
        { Unit uu; for (int i = 0; i < 4 && S.next(i, uu); ++i) E.fill(i, uu.pm, F.tid); __syncthreads(); }
        gemm_phase(F.lds, g, S, E); } SEAM(7);
    if (IN(8)) { REFRESH(); router_phase(F, args); } if (IN(8) && IN(10)) xcd_barrier(bar);
    int ntiles = 0;
    if (IN(10) || IN(11) || IN(12)) { REFRESH(); ntiles = moe_tables(F); }
    if (IN(10)) REPS(10) { REFRESH();
        LAS int* RC = (LAS int*)(F.lds + SCR2_OFF + 1024); const unsigned* ETOK = (const unsigned*)(ws + FW_ETOK); const LAS int* TSTc = (const LAS int*)(F.lds + SCR2_OFF); const LAS unsigned char* T2Ec = F.lds + SCR2_OFF + 256;
        { unsigned v[5];
#pragma unroll
          for (int k = 0; k < 5; ++k) { const int j = F.tid + 512 * k, i = j >> 8, r = j & 255; v[k] = 0u;
              if ((long)i * F.G + F.c < (long)ntiles * 4) { int pm, pn; moe_unit(i * F.G + F.c, ntiles, pm, pn);
                  const int e = T2Ec[pm], idx = (pm - TSTc[e]) * 256 + r;
                  if (idx < TSTc[208 + e]) v[k] = ETOK[(size_t)e * M + idx]; } }
#pragma unroll
          for (int k = 0; k < 5; ++k) { const int j = F.tid + 512 * k; if ((long)(j >> 8) * F.G + F.c < (long)ntiles * 4) RC[j] = (int)v[k]; } }
        __syncthreads();
        GemmP g{DM, DM, DM / 2}; MoeOrder S{(const char*)(ws + FW_X1Q), (const char*)(ws + FW_WGU), (size_t)0, (size_t)DM * DM, (size_t)256 * DM, F.lds + SCR2_OFF + 256, ntiles, F.G, F.c};
        EpiGU E{(unsigned char*)(ws + FW_HH), (const LAS unsigned*)RC};
        gemm_phase<EpiGU, MoeOrder, true, KREP10, true>(F.lds, g, S, E, RC, ((F.c >> 3) & 7) * STG10); } SEAM(10);
    if (IN(11)) REPS(11) { REFRESH();
        LAS float* RGC = (LAS float*)(F.lds + SCR2_OFF + 1024); const float* EG = (const float*)(ws + FW_EG); const LAS int* TSTc = (const LAS int*)(F.lds + SCR2_OFF); const LAS unsigned char* T2Ec = F.lds + SCR2_OFF + 256;
        { float v[5];
#pragma unroll
          for (int k = 0; k < 5; ++k) { const int j = F.tid + 512 * k, i = j >> 8, r = j & 255; v[k] = 0.f;
              if ((long)i * F.G + F.c < (long)ntiles * 4) { int pm, pn; moe_unit(i * F.G + F.c, ntiles, pm, pn);
                  const int e = T2Ec[pm], idx = (pm - TSTc[e]) * 256 + r;
                  if (idx < TSTc[208 + e]) v[k] = EG[(size_t)e * M + idx]; } }
#pragma unroll
          for (int k = 0; k < 5; ++k) { const int j = F.tid + 512 * k; if ((long)(j >> 8) * F.G + F.c < (long)ntiles * 4) RGC[j] = v[k]; } }
        __syncthreads();
        GemmP g{DE, DE, DE / 2}; MoeOrder S{(const char*)(ws + FW_HH), (const char*)(ws + FW_WD), (size_t)256 * DE, (size_t)DM * DE, (size_t)256 * DE, F.lds + SCR2_OFF + 256, ntiles, F.G, F.c};
        EpiDown E{(unsigned char*)(ws + FW_YE), (const LAS float*)RGC};
        gemm_phase<EpiDown, MoeOrder, false, KREP11, true>(F.lds, g, S, E, nullptr, ((F.c >> 3) & 7) * STG11); } SEAM(11);
    if (IN(12)) REPS(12) { REFRESH(); combine_phase(F, args); }
#undef IN
#undef SEAM
}
}

extern "C" void kernel_launch(void* const* d_in, const int* in_sizes, int n_in, void* d_out, int out_size, void* d_ws, size_t ws_size, hipStream_t stream) {
    static int grid = 0;
    if (grid == 0) {
        if (n_in != 26 || out_size != M * DM || ws_size < mk::FW_END2) { fprintf(stderr, "kernel_launch: unexpected shapes (n_in %d out %d ws %zu, need %zu)\n", n_in, out_size, ws_size, (size_t)mk::FW_END2); grid = -1; return; }
        int dev = 0, cus = 0, per_cu = 0;
        if (hipGetDevice(&dev) != hipSuccess || hipDeviceGetAttribute(&cus, hipDeviceAttributeMultiprocessorCount, dev) != hipSuccess) { grid = -1; return; }
        if (hipFuncSetAttribute((const void*)mk::mk_fwd, hipFuncAttributeMaxDynamicSharedMemorySize, mk::LDS_BYTES) != hipSuccess) { fprintf(stderr, "kernel_launch: hipFuncSetAttribute failed\n"); grid = -1; return; }
        if (hipOccupancyMaxActiveBlocksPerMultiprocessor(&per_cu, (const void*)mk::mk_fwd, mk::NTHR, mk::LDS_BYTES) != hipSuccess || per_cu < 1) { fprintf(stderr, "kernel_launch: occupancy query says %d\n", per_cu); }
        (void)hipGetLastError();
        grid = cus;
        if (grid != 256) fprintf(stderr, "kernel_launch: %d CUs (built for 256)\n", grid);
    }
    if (grid < 0) return;
    mk::Args a{};
    for (int i = 0; i < 26; ++i) a.in[i] = (const float*)d_in[i];
    a.out = (float*)d_out; a.ws = (unsigned char*)d_ws; a.ph_lo = 0; a.ph_hi = mk::NPHASE;
    (void)hipMemsetAsync((unsigned char*)d_ws + WS_CTL, 0, mk::CTL_ZERO_BYTES, stream);
    hipLaunchKernelGGL(mk::mk_fwd, dim3(grid), dim3(mk::NTHR), mk::LDS_BYTES, stream, a);
}
```
